# Optimizing an MI355X kernel written in HIP

```python
import jax, jax.numpy as jnp
from jax import lax
import numpy as np


D_MODEL = 1024
BATCH = 8
SEQ = 4096
DEPTH = 4

GRID_W = 64
CTX_LEN = 256
MIXER_KINDS = ('rwkv7', 'rglru', 'natten')
RMS_EPS = 1e-6

RW_HEAD_DIM = 64
RW_HEADS = D_MODEL // RW_HEAD_DIM
RW_LORA = 64
RW_GN_EPS = 64e-5

LRU_WIDTH = 1408
LRU_BLOCKS = 16
LRU_BLOCK_DIM = LRU_WIDTH // LRU_BLOCKS
LRU_CONV = 4
LRU_C = 8.0

NA_HEAD_DIM = 64
NA_HEADS = D_MODEL // NA_HEAD_DIM
NA_WIDTH = NA_HEADS * NA_HEAD_DIM
WIN_H = 8
WIN_W = 16
ROPE_THETA = 10000.0

kernel_name = 'hybrid_rwkv7_rglru_natten_dit'


def rms_norm(x, g, eps=RMS_EPS):
    xf = x.astype(jnp.float32)
    xf = xf * lax.rsqrt(jnp.mean(xf * xf, axis=-1, keepdims=True) + eps)
    return xf.astype(x.dtype) * g


def centred_shift(h):
    prev = jnp.pad(h[:, :-1], ((0, 0), (1, 0), (0, 0)))
    nxt = jnp.pad(h[:, 1:], ((0, 0), (0, 1), (0, 0)))
    return 0.5 * (prev + nxt)


def rwkv7_project(h, p):
    B, T, D = h.shape
    heads = lambda t: t.reshape(B, T, RW_HEADS, RW_HEAD_DIM)
    xx = centred_shift(h) - h
    mu = p['mu']
    xr, xw, xk, xv, xa, xg = [h + xx * mu[j] for j in range(6)]
    w_in = p['w_in']
    r = heads(xr @ w_in[0])
    k = heads(xk @ w_in[1])
    v = heads(xv @ w_in[2])
    gate = jax.nn.silu(xg @ w_in[3])
    k_k = p['k_ka'][0].reshape(RW_HEADS, RW_HEAD_DIM)
    k_a = p['k_ka'][1].reshape(RW_HEADS, RW_HEAD_DIM)
    kkf = (k * k_k).astype(jnp.float32)
    kk = (kkf / jnp.maximum(jnp.sqrt(jnp.sum(kkf * kkf, -1, keepdims=True)), 1e-12)).astype(k.dtype)
    b0, down, up = p['lora_b0'], p['lora_down'], p['lora_up']
    decay, a, k_dir = [], [], []
    for d in range(2):
        w_log = -jax.nn.softplus(-(b0[d, 0] + jnp.tanh(xw @ down[d, 0]) @ up[d, 0])) - 0.5
        a_d = heads(jax.nn.sigmoid(b0[d, 1] + (xa @ down[d, 1]) @ up[d, 1]))
        decay.append(heads(jnp.exp(-jnp.exp(w_log))))
        a.append(a_d)
        k_dir.append(k * (1.0 + (a_d - 1.0) * k_a))
    return dict(r=r, v=v, kk=kk, decay=decay, a=a, k=k_dir, gate=gate)


def rwkv7_scan(proj, d, s0, reverse):
    def step(S, inp):
        r_t, w_t, k_t, kk_t, a_t, v_t = inp
        sa = jnp.einsum('bhvk,bhk->bhv', S, -kk_t)
        S = (S * w_t[:, :, None, :] + sa[..., None] * (kk_t * a_t)[:, :, None, :]
             + v_t[..., None] * k_t[:, :, None, :])
        return S, jnp.einsum('bhvk,bhk->bhv', S, r_t)
    xs = tuple(jnp.moveaxis(t, 1, 0) for t in
               (proj['r'], proj['decay'][d], proj['k'][d], proj['kk'], proj['a'][d], proj['v']))
    s_final, ys = lax.scan(step, s0, xs, reverse=reverse)
    return jnp.moveaxis(ys, 0, 1), s_final


def rwkv7_output(proj, y, p):
    B, T, H, Dh = y.shape
    yf = y.astype(jnp.float32)
    mean = jnp.mean(yf, -1, keepdims=True)
    var = jnp.mean(jnp.square(yf - mean), -1, keepdims=True)
    yn = ((yf - mean) * lax.rsqrt(var + RW_GN_EPS)).astype(y.dtype).reshape(B, T, H * Dh)
    yn = yn * p['gn'][0] + p['gn'][1]
    r, v, r_k = proj['r'], proj['v'], p['r_k']
    bonus = (jnp.sum(r * proj['k'][0] * r_k, -1, keepdims=True)
             + jnp.sum(r * proj['k'][1] * r_k, -1, keepdims=True)) * v
    return ((yn + bonus.reshape(B, T, H * Dh)) * proj['gate']) @ p['w_out']


def rwkv7_mixer(h_l, h_c, p, ctx_out):
    proj_c = rwkv7_project(h_c, p)
    proj_l = rwkv7_project(h_l, p)
    s0 = jnp.zeros((h_l.shape[0], RW_HEADS, RW_HEAD_DIM, RW_HEAD_DIM), h_l.dtype)
    ys_c, ys_l = [], []
    for d in range(2):
        rev = d == 1
        y_c, s_c = rwkv7_scan(proj_c, d, s0, rev)
        y_l, _ = rwkv7_scan(proj_l, d, s_c, rev)
        ys_c.append(y_c)
        ys_l.append(y_l)
    out_l = rwkv7_output(proj_l, ys_l[0] + ys_l[1], p)
    out_c = rwkv7_output(proj_c, ys_c[0] + ys_c[1], p) if ctx_out else None
    return out_l, out_c


def depthwise_conv_centred(x, w, b):
    T = x.shape[1]
    xp = jnp.pad(x, ((0, 0), (LRU_CONV // 2, LRU_CONV - 1 - LRU_CONV // 2), (0, 0)))
    out = b + xp[:, 0:T] * w[0]
    for j in range(1, LRU_CONV):
        out = out + xp[:, j:j + T] * w[j]
    return out


def block_diag(x, w, b):
    B, T, _ = x.shape
    xb = x.reshape(B, T, LRU_BLOCKS, LRU_BLOCK_DIM)
    return jnp.einsum('btnc,ncd->btnd', xb, w).reshape(B, T, LRU_WIDTH) + b


def rglru_coeffs(x, p, d):
    r = jax.nn.sigmoid(block_diag(x, p['gate_w'][d, 0], p['gate_b'][d, 0]))
    i = jax.nn.sigmoid(block_diag(x, p['gate_w'][d, 1], p['gate_b'][d, 1]))
    log_a = -LRU_C * r * jax.nn.softplus(-p['lam'][d])
    a = jnp.exp(log_a)
    b = jnp.sqrt(-jnp.expm1(2.0 * log_a)) * (i * x)
    return a, b


def linear_scan(a, b, h0, reverse):
    def combine(e1, e2):
        a1, b1 = e1
        a2, b2 = e2
        return a1 * a2, a2 * b1 + b2
    a_cum, b_cum = lax.associative_scan(combine, (a, b), axis=1, reverse=reverse)
    h = a_cum * h0[:, None, :] + b_cum
    final = h[:, 0] if reverse else h[:, -1]
    return h, final


def rglru_mixer(h_l, h_c, p, ctx_out):
    def pre(h):
        z = h @ p['w_in']
        xr, g = z[..., :LRU_WIDTH], z[..., LRU_WIDTH:]
        return depthwise_conv_centred(xr, p['conv_w'], p['conv_b']), jax.nn.silu(g)
    x_c, g_c = pre(h_c)
    x_l, g_l = pre(h_l)
    h0 = jnp.zeros((h_l.shape[0], LRU_WIDTH), h_l.dtype)
    hs_c, hs_l = [], []
    for d in range(2):
        rev = d == 1
        a, b = rglru_coeffs(x_c, p, d)
        hc, hc_final = linear_scan(a, b, h0, rev)
        a, b = rglru_coeffs(x_l, p, d)
        hl, _ = linear_scan(a, b, hc_final, rev)
        hs_c.append(hc)
        hs_l.append(hl)
    out_l = ((hs_l[0] + hs_l[1]) * g_l) @ p['w_out']
    out_c = ((hs_c[0] + hs_c[1]) * g_c) @ p['w_out'] if ctx_out else None
    return out_l, out_c


def axial_rope(x, row, col):
    half = x.shape[-1] // 2
    nfreq = half // 2
    inv = ROPE_THETA ** (-jnp.arange(nfreq, dtype=jnp.float32) / nfreq)
    def rot(xp, pos):
        ang = pos.astype(jnp.float32)[:, None] * inv
        cos = jnp.cos(ang)[None, :, None, :]
        sin = jnp.sin(ang)[None, :, None, :]
        x1, x2 = xp[..., :nfreq], xp[..., nfreq:]
        return jnp.concatenate([x1 * cos - x2 * sin, x1 * sin + x2 * cos], -1).astype(x.dtype)
    return jnp.concatenate([rot(x[..., :half], row), rot(x[..., half:], col)], -1)


def natten_mixer(h_l, h_c, p, ctx_out):
    B, T, _ = h_l.shape
    rows = T // GRID_W
    kh = min(WIN_H, rows)
    H, Dh = NA_HEADS, NA_HEAD_DIM
    scale = Dh ** -0.5

    def project(h):
        n = h.shape[1]
        q, k, v, g = jnp.split(h @ p['w_in'], 4, axis=-1)
        q = rms_norm(q.reshape(B, n, H, Dh), p['qk_g'][0])
        k = rms_norm(k.reshape(B, n, H, Dh), p['qk_g'][1])
        return q, k, v.reshape(B, n, H, Dh), jax.nn.silu(g)

    q_c, k_c, v_c, g_c = project(h_c)
    q_l, k_l, v_l, g_l = project(h_l)
    pos = jnp.arange(T)
    row, col = pos // GRID_W, pos % GRID_W
    q_rot = axial_rope(q_l, row, col)
    k_rot = axial_rope(k_l, row, col)
    to_rows = lambda t: jnp.moveaxis(t.reshape(B, rows, GRID_W, H, Dh), 1, 0)
    k_grid = k_rot.reshape(B, rows, GRID_W, H, Dh)
    v_grid = v_l.reshape(B, rows, GRID_W, H, Dh)

    cols = np.arange(GRID_W)
    c_start = np.clip(cols - WIN_W // 2, 0, GRID_W - WIN_W)
    col_ok = (cols[None, :] >= c_start[:, None]) & (cols[None, :] < c_start[:, None] + WIN_W)
    col_ok = jnp.asarray(col_ok)[:, None, :]
    dc_idx = np.clip(cols[None, :] - cols[:, None] + WIN_W - 1, 0, 2 * WIN_W - 2)
    n_band = kh * GRID_W

    def row_block(args):
        r, q_r, q_p = args
        start = jnp.clip(r - kh // 2, 0, rows - kh)
        k_band = lax.dynamic_slice_in_dim(k_grid, start, kh, axis=1)
        v_band = lax.dynamic_slice_in_dim(v_grid, start, kh, axis=1)
        s_band = jnp.einsum('bqhd,bikhd->bhqik', q_r, k_band).astype(jnp.float32) * scale
        dr_idx = start + jnp.arange(kh) - r + WIN_H - 1
        bias = p['rpb'][:, dr_idx[None, :, None], dc_idx[:, None, :]]
        s_band = jnp.where(col_ok, s_band + bias.astype(jnp.float32), -jnp.inf)
        s_band = s_band.reshape(B, H, GRID_W, n_band)
        s_ctx = jnp.einsum('bqhd,bchd->bhqc', q_p, k_c).astype(jnp.float32) * scale
        prob = jax.nn.softmax(jnp.concatenate([s_band, s_ctx], -1), axis=-1).astype(v_l.dtype)
        o = jnp.einsum('bhqj,bjhd->bqhd', prob[..., :n_band], v_band.reshape(B, n_band, H, Dh))
        return o + jnp.einsum('bhqc,bchd->bqhd', prob[..., n_band:], v_c)

    o = lax.map(row_block, (jnp.arange(rows), to_rows(q_rot), to_rows(q_l)))
    o = jnp.moveaxis(o, 0, 1).reshape(B, T, NA_WIDTH)
    out_l = (o * g_l) @ p['w_out']
    out_c = None
    if ctx_out:
        s = jnp.einsum('bqhd,bkhd->bhqk', q_c, k_c).astype(jnp.float32) * scale
        prob = jax.nn.softmax(s, axis=-1).astype(v_c.dtype)
        o_c = jnp.einsum('bhqk,bkhd->bqhd', prob, v_c).reshape(B, h_c.shape[1], NA_WIDTH)
        out_c = (o_c * g_c) @ p['w_out']
    return out_l, out_c


MIXERS = {'rwkv7': rwkv7_mixer, 'rglru': rglru_mixer, 'natten': natten_mixer}


def layer_forward(x, ctx, c_act, cctx_act, p, kind, ctx_out):
    mod_l = c_act @ p['ada_w'] + p['ada_b']
    mod_c = cctx_act @ p['ada_w'] + p['ada_b']
    shift_l, scale_l, gate_l = jnp.split(mod_l[:, None, :], 3, axis=-1)
    shift_c, scale_c, gate_c = jnp.split(mod_c, 3, axis=-1)
    h_l = rms_norm(x, p['norm_g']) * (1.0 + scale_l) + shift_l
    h_c = rms_norm(ctx, p['norm_g']) * (1.0 + scale_c) + shift_c
    y_l, y_c = MIXERS[kind](h_l, h_c, p, ctx_out)
    x = x + gate_l * y_l
    if ctx_out:
        ctx = ctx + gate_c * y_c
    return x, ctx


def _normal(key, shape, scale):
    return scale * jax.random.normal(key, shape, jnp.float32)


def _ada_params(ks, pre):
    return {
        pre + 'norm_g': 1.0 + _normal(ks[0], (D_MODEL,), 0.02),
        pre + 'ada_w': _normal(ks[1], (D_MODEL, 3 * D_MODEL), 0.5 * D_MODEL ** -0.5),
        pre + 'ada_b': _normal(ks[2], (3 * D_MODEL,), 0.01),
    }


def _rwkv7_params(key, pre):
    ks = jax.random.split(key, 16)
    d = _ada_params(ks, pre)
    d[pre + 'w_in'] = _normal(ks[3], (4, D_MODEL, D_MODEL), D_MODEL ** -0.5)
    d[pre + 'mu'] = jax.random.uniform(ks[4], (6, D_MODEL), jnp.float32)
    w0 = jax.random.uniform(ks[5], (2, D_MODEL), jnp.float32, minval=-6.0, maxval=0.0)
    a0 = _normal(ks[6], (2, D_MODEL), 0.1)
    d[pre + 'lora_b0'] = jnp.stack([w0, a0], axis=1)
    d[pre + 'lora_down'] = _normal(ks[7], (2, 2, D_MODEL, RW_LORA), D_MODEL ** -0.5)
    d[pre + 'lora_up'] = _normal(ks[8], (2, 2, RW_LORA, D_MODEL), 0.1 * RW_LORA ** -0.5)
    d[pre + 'k_ka'] = jnp.stack([0.85 + _normal(ks[9], (D_MODEL,), 0.02),
                                 1.0 + _normal(ks[10], (D_MODEL,), 0.02)])
    d[pre + 'r_k'] = _normal(ks[11], (RW_HEADS, RW_HEAD_DIM), 0.1)
    d[pre + 'gn'] = jnp.stack([1.0 + _normal(ks[12], (D_MODEL,), 0.02),
                               _normal(ks[13], (D_MODEL,), 0.01)])
    d[pre + 'w_out'] = _normal(ks[14], (D_MODEL, D_MODEL), D_MODEL ** -0.5)
    return d


def _rglru_params(key, pre):
    ks = jax.random.split(key, 12)
    d = _ada_params(ks, pre)
    d[pre + 'w_in'] = _normal(ks[3], (D_MODEL, 2 * LRU_WIDTH), D_MODEL ** -0.5)
    d[pre + 'conv_w'] = _normal(ks[4], (LRU_CONV, LRU_WIDTH), LRU_CONV ** -0.5)
    d[pre + 'conv_b'] = _normal(ks[5], (LRU_WIDTH,), 0.01)
    d[pre + 'gate_w'] = _normal(ks[6], (2, 2, LRU_BLOCKS, LRU_BLOCK_DIM, LRU_BLOCK_DIM), LRU_BLOCK_DIM ** -0.5)
    d[pre + 'gate_b'] = _normal(ks[7], (2, 2, LRU_WIDTH), 0.01)
    u = jax.random.uniform(ks[8], (2, LRU_WIDTH), jnp.float32, minval=0.9, maxval=0.999)
    a_base = u ** (1.0 / LRU_C)
    d[pre + 'lam'] = jnp.log(a_base) - jnp.log1p(-a_base)
    d[pre + 'w_out'] = _normal(ks[9], (LRU_WIDTH, D_MODEL), LRU_WIDTH ** -0.5)
    return d


def _natten_params(key, pre):
    ks = jax.random.split(key, 8)
    d = _ada_params(ks, pre)
    d[pre + 'w_in'] = _normal(ks[3], (D_MODEL, 4 * NA_WIDTH), D_MODEL ** -0.5)
    d[pre + 'qk_g'] = 1.0 + _normal(ks[4], (2, NA_HEAD_DIM), 0.02)
    d[pre + 'rpb'] = _normal(ks[5], (NA_HEADS, 2 * WIN_H - 1, 2 * WIN_W - 1), 0.1)
    d[pre + 'w_out'] = _normal(ks[6], (NA_WIDTH, D_MODEL), NA_WIDTH ** -0.5)
    return d


def setup_inputs(seed: int = 0) -> dict:
    key = jax.random.key(seed)
    ks = jax.random.split(key, 4 + DEPTH)
    inputs = {
        'x': jax.random.normal(ks[0], (BATCH, SEQ, D_MODEL), jnp.float32),
        'c': jax.random.normal(ks[1], (BATCH, D_MODEL), jnp.float32),
        'ctx': jax.random.normal(ks[2], (BATCH, CTX_LEN, D_MODEL), jnp.float32),
        'c_ctx': jax.random.normal(ks[3], (D_MODEL,), jnp.float32),
    }
    makers = (_rwkv7_params, _rglru_params, _natten_params)
    for i in range(DEPTH):
        inputs.update(makers[i % len(makers)](ks[4 + i], 'l%d_' % i))
    return inputs


def reference(x, c, ctx, c_ctx,
              l0_norm_g, l0_ada_w, l0_ada_b, l0_w_in, l0_mu, l0_lora_b0, l0_lora_down, l0_lora_up,
              l0_k_ka, l0_r_k, l0_gn, l0_w_out,
              l1_norm_g, l1_ada_w, l1_ada_b, l1_w_in, l1_conv_w, l1_conv_b, l1_gate_w, l1_gate_b,
              l1_lam, l1_w_out,
              l2_norm_g, l2_ada_w, l2_ada_b, l2_w_in, l2_qk_g, l2_rpb, l2_w_out,
              l3_norm_g, l3_ada_w, l3_ada_b, l3_w_in, l3_mu, l3_lora_b0, l3_lora_down, l3_lora_up,
              l3_k_ka, l3_r_k, l3_gn, l3_w_out):
    layer_params = (
        dict(norm_g=l0_norm_g, ada_w=l0_ada_w, ada_b=l0_ada_b, w_in=l0_w_in, mu=l0_mu,
             lora_b0=l0_lora_b0, lora_down=l0_lora_down, lora_up=l0_lora_up, k_ka=l0_k_ka,
             r_k=l0_r_k, gn=l0_gn, w_out=l0_w_out),
        dict(norm_g=l1_norm_g, ada_w=l1_ada_w, ada_b=l1_ada_b, w_in=l1_w_in, conv_w=l1_conv_w,
             conv_b=l1_conv_b, gate_w=l1_gate_w, gate_b=l1_gate_b, lam=l1_lam, w_out=l1_w_out),
        dict(norm_g=l2_norm_g, ada_w=l2_ada_w, ada_b=l2_ada_b, w_in=l2_w_in, qk_g=l2_qk_g,
             rpb=l2_rpb, w_out=l2_w_out),
        dict(norm_g=l3_norm_g, ada_w=l3_ada_w, ada_b=l3_ada_b, w_in=l3_w_in, mu=l3_mu,
             lora_b0=l3_lora_b0, lora_down=l3_lora_down, lora_up=l3_lora_up, k_ka=l3_k_ka,
             r_k=l3_r_k, gn=l3_gn, w_out=l3_w_out),
    )
    c_act = jax.nn.silu(c)
    cctx_act = jax.nn.silu(c_ctx)
    for i in range(DEPTH):
        x, ctx = layer_forward(x, ctx, c_act, cctx_act, layer_params[i],
                               MIXER_KINDS[i % len(MIXER_KINDS)], ctx_out=i < DEPTH - 1)
    return x
```

```cpp
#include <hip/hip_runtime.h>
#include <hip/hip_cooperative_groups.h>
#include <cstdio>
#include <cstdint>
namespace cg = cooperative_groups;

#ifndef N_LAUNCH_MODE
#define N_LAUNCH_MODE 1
#endif

typedef unsigned short bf16_t;
typedef short bf16x8 __attribute__((ext_vector_type(8)));
typedef float f32x4 __attribute__((ext_vector_type(4)));
typedef float f32x16 __attribute__((ext_vector_type(16)));
typedef float f32x2 __attribute__((ext_vector_type(2)));
typedef unsigned u32x4 __attribute__((ext_vector_type(4)));
typedef unsigned u32x2 __attribute__((ext_vector_type(2)));

#define DEVI __device__ __forceinline__

constexpr int D = 1024, NB = 8, SEQ = 4096, CTX = 256;
constexpr int ML = NB * SEQ;
constexpr int MC = NB * CTX;
constexpr int MT = ML + MC;
constexpr int LW = 1408;
constexpr int NTHR = 512;
constexpr int NPHASE = 21;
constexpr int LDS_BYTES = 126976;

constexpr size_t SZ_ACT = (size_t)MT * 1024 * 2;
constexpr size_t OFF_MOD = 0;
constexpr size_t OFF_W0IN = 524288;
constexpr size_t SZ_RWIN = (size_t)4352 * 1024 * 2;
constexpr size_t SZ_RWUP = (size_t)4 * 1024 * 64 * 2;
constexpr size_t SZ_SQ = (size_t)1024 * 1024 * 2;
constexpr size_t OFF_W0UP = OFF_W0IN + SZ_RWIN;
constexpr size_t OFF_W0OUT = OFF_W0UP + SZ_RWUP;
constexpr size_t OFF_W3IN = OFF_W0OUT + SZ_SQ;
constexpr size_t OFF_W3UP = OFF_W3IN + SZ_RWIN;
constexpr size_t OFF_W3OUT = OFF_W3UP + SZ_RWUP;
constexpr size_t OFF_W1IN = OFF_W3OUT + SZ_SQ;
constexpr size_t OFF_W1G = OFF_W1IN + (size_t)2816 * 1024 * 2;
constexpr size_t OFF_W1OUT = OFF_W1G + (size_t)16 * 4 * 96 * 96 * 2;
constexpr size_t OFF_W2IN = OFF_W1OUT + (size_t)1024 * 1408 * 2;
constexpr size_t OFF_W2OUT = OFF_W2IN + (size_t)4096 * 1024 * 2;
constexpr size_t OFF_XC = OFF_W2OUT + SZ_SQ;
constexpr size_t OFF_BON = OFF_XC + (size_t)MC * 1024 * 4;
constexpr size_t OFF_BIG = OFF_BON + (size_t)2 * MT * 16 * 4;
constexpr size_t OFF_HB = OFF_BIG;
constexpr size_t OFF_A0 = OFF_BIG + SZ_ACT;
constexpr size_t OFF_A1 = OFF_A0 + SZ_ACT;
constexpr size_t OFF_A2 = OFF_A1 + SZ_ACT;
constexpr size_t OFF_A3 = OFF_A2 + SZ_ACT;
constexpr size_t OFF_A4 = OFF_A3 + SZ_ACT;
constexpr size_t OFF_WD = OFF_A4 + SZ_ACT;
constexpr size_t OFF_AD = OFF_WD + (size_t)MT * 128 * 2;
constexpr size_t WS_END = OFF_AD + (size_t)MT * 128 * 2;
constexpr size_t SZ_LRU = (size_t)MT * LW * 2;
constexpr size_t OFF_HS0 = OFF_BIG;
constexpr size_t OFF_XR = OFF_BIG + SZ_LRU;
constexpr size_t OFF_GG = OFF_XR + SZ_LRU;
constexpr size_t OFF_HS1 = OFF_GG + SZ_LRU;
static_assert(OFF_HS1 + SZ_LRU <= WS_END, "lru overlay");
static_assert(WS_END <= (size_t)536870912, "ws");

struct Params {
  const float* in[45];
  float* out;
  char* ws;
  int ph_lo, ph_hi;
};

DEVI u32x4 mk4(unsigned a, unsigned b, unsigned c, unsigned d) { u32x4 r = {a, b, c, d}; return r; }
DEVI float bf_lo(unsigned u) { return __uint_as_float(u << 16); }
DEVI float bf_hi(unsigned u) { return __uint_as_float(u & 0xffff0000u); }
DEVI float bf2f(bf16_t h) { return __uint_as_float(((unsigned)h) << 16); }
DEVI unsigned pk_bf16(float lo, float hi) { unsigned r; asm("v_cvt_pk_bf16_f32 %0, %1, %2" : "=v"(r) : "v"(lo), "v"(hi)); return r; }
DEVI bf16_t f2bf(float f) { return (bf16_t)(pk_bf16(f, 0.f) & 0xffffu); }
DEVI float wave_sum(float v) {
#pragma unroll
  for (int o = 32; o; o >>= 1) v += __shfl_xor(v, o);
  return v;
}
DEVI float sigmoidf_(float x) { return 1.f / (1.f + __expf(-x)); }
DEVI float siluf_(float x) { return x / (1.f + __expf(-x)); }
DEVI float softplusf_(float x) { return fmaxf(x, 0.f) + log1pf(__expf(-fabsf(x))); }
DEVI f32x16 mfma32(u32x4 a, u32x4 b, f32x16 c) {
  return __builtin_amdgcn_mfma_f32_32x32x16_bf16(__builtin_bit_cast(bf16x8, a), __builtin_bit_cast(bf16x8, b), c, 0, 0, 0);
}
DEVI f32x4 mfma16(u32x4 a, u32x4 b, f32x4 c) {
  return __builtin_amdgcn_mfma_f32_16x16x32_bf16(__builtin_bit_cast(bf16x8, a), __builtin_bit_cast(bf16x8, b), c, 0, 0, 0);
}
template <int CTRL> DEVI float dpp_f(float v) {
  return __int_as_float(__builtin_amdgcn_update_dpp(0, __float_as_int(v), CTRL, 0xf, 0xf, true));
}
DEVI float sum8(float v) {
  v += dpp_f<0xB1>(v);
  v += dpp_f<0x4E>(v);
  v += dpp_f<0x141>(v);
  return v;
}

struct TJob { const float* src; int K, N; bf16_t* dst; int ldd; };

DEVI TJob get_tjob(const Params& p, int j) {
  TJob t;
  if (j < 26) {
    const int l = j / 13, jj = j % 13;
    const int ib = l ? 33 : 4;
    bf16_t* win = (bf16_t*)(p.ws + (l ? OFF_W3IN : OFF_W0IN));
    bf16_t* wup = (bf16_t*)(p.ws + (l ? OFF_W3UP : OFF_W0UP));
    bf16_t* wout = (bf16_t*)(p.ws + (l ? OFF_W3OUT : OFF_W0OUT));
    if (jj < 4) { t.src = p.in[ib + 3] + (size_t)jj * 1048576; t.K = 1024; t.N = 1024; t.dst = win + (size_t)jj * 1048576; t.ldd = 1024; }
    else if (jj < 8) { const int idx = jj - 4, d = idx >> 1, kind = idx & 1;
      t.src = p.in[ib + 6] + (size_t)idx * 65536; t.K = 1024; t.N = 64; t.dst = win + (size_t)(4096 + kind * 128 + d * 64) * 1024; t.ldd = 1024; }
    else if (jj < 12) { const int idx = jj - 8;
      t.src = p.in[ib + 7] + (size_t)idx * 65536; t.K = 64; t.N = 1024; t.dst = wup + (size_t)idx * 65536; t.ldd = 64; }
    else { t.src = p.in[ib + 11]; t.K = 1024; t.N = 1024; t.dst = wout; t.ldd = 1024; }
  } else if (j == 26) { t.src = p.in[19]; t.K = 1024; t.N = 2816; t.dst = (bf16_t*)(p.ws + OFF_W1IN); t.ldd = 1024; }
  else if (j == 27) { t.src = p.in[25]; t.K = 1408; t.N = 1024; t.dst = (bf16_t*)(p.ws + OFF_W1OUT); t.ldd = 1408; }
  else if (j == 28) { t.src = p.in[29]; t.K = 1024; t.N = 4096; t.dst = (bf16_t*)(p.ws + OFF_W2IN); t.ldd = 1024; }
  else { t.src = p.in[32]; t.K = 1024; t.N = 1024; t.dst = (bf16_t*)(p.ws + OFF_W2OUT); t.ldd = 1024; }
  return t;
}

__device__ __forceinline__ void phase0(const Params& p, char* lds) {
  const int tid = threadIdx.x;
  {
    bf16_t* wg = (bf16_t*)(p.ws + OFF_W1G);
    const float* gw = p.in[22];
    const int total = 16 * 4 * 96 * 96;
    for (int e = blockIdx.x * NTHR + tid; e < total; e += gridDim.x * NTHR) {
      const int k = e % 96, n = (e / 96) % 96, dg = (e / 9216) & 3, blk = e / 36864;
      float v = 0.f;
      if (k < 88 && n < 88) v = gw[((size_t)(dg * 16 + blk) * 88 + k) * 88 + n];
      wg[e] = f2bf(v);
    }
  }
  constexpr int N_MOD_ITEMS = 96;
  constexpr int N_TILES = 5152;
  float* act = (float*)lds;
  float* red = (float*)(lds + 36864);
  float* tl = (float*)lds;
  for (int item = blockIdx.x; item < N_MOD_ITEMS + N_TILES; item += gridDim.x) {
    __syncthreads();
    if (item < N_MOD_ITEMS) {
      const int L = item / 24, nc = item % 24;
      const int ib = (L == 0) ? 4 : (L == 1) ? 16 : (L == 2) ? 26 : 33;
      const float* ada_w = p.in[ib + 1];
      const float* ada_b = p.in[ib + 2];
      for (int e = tid; e < 9 * 1024; e += NTHR) {
        const int i = e >> 10, k = e & 1023;
        const float c = (i < 8) ? p.in[1][i * 1024 + k] : p.in[3][k];
        act[e] = siluf_(c);
      }
      __syncthreads();
      const int kq = tid >> 7, nl = tid & 127, n = nc * 128 + nl;
      float acc[9];
#pragma unroll
      for (int i = 0; i < 9; ++i) acc[i] = 0.f;
      for (int k = kq * 256; k < kq * 256 + 256; ++k) {
        const float w = ada_w[(size_t)k * 3072 + n];
#pragma unroll
        for (int i = 0; i < 9; ++i) acc[i] += act[i * 1024 + k] * w;
      }
#pragma unroll
      for (int i = 0; i < 9; ++i) red[(kq * 9 + i) * 128 + nl] = acc[i];
      __syncthreads();
      float* mod = (float*)(p.ws + OFF_MOD) + (size_t)L * 9 * 3072;
      for (int e = tid; e < 9 * 128; e += NTHR) {
        const int i = e >> 7, c = e & 127;
        const float s = red[(0 * 9 + i) * 128 + c] + red[(1 * 9 + i) * 128 + c] + red[(2 * 9 + i) * 128 + c] + red[(3 * 9 + i) * 128 + c];
        mod[i * 3072 + nc * 128 + c] = s + ada_b[nc * 128 + c];
      }
    } else {
      int t = item - N_MOD_ITEMS;
      int j = 0;
      TJob job = get_tjob(p, 0);
      for (;;) {
        const int nt = (job.K >> 6) * (job.N >> 6);
        if (t < nt) break;
        t -= nt; ++j; job = get_tjob(p, j);
      }
      const int ntn = job.N >> 6;
      const int k0 = (t / ntn) * 64, n0 = (t % ntn) * 64;
#pragma unroll
      for (int i = 0; i < 2; ++i) {
        const int k = (tid >> 4) + 32 * i, n4 = (tid & 15) * 4;
        const float4 v = *(const float4*)(job.src + (size_t)(k0 + k) * job.N + n0 + n4);
        tl[k * 65 + n4 + 0] = v.x; tl[k * 65 + n4 + 1] = v.y; tl[k * 65 + n4 + 2] = v.z; tl[k * 65 + n4 + 3] = v.w;
      }
      __syncthreads();
      const int n = tid >> 3, k8 = (tid & 7) * 8;
      u32x4 o;
      o.x = pk_bf16(tl[(k8 + 0) * 65 + n], tl[(k8 + 1) * 65 + n]);
      o.y = pk_bf16(tl[(k8 + 2) * 65 + n], tl[(k8 + 3) * 65 + n]);
      o.z = pk_bf16(tl[(k8 + 4) * 65 + n], tl[(k8 + 5) * 65 + n]);
      o.w = pk_bf16(tl[(k8 + 6) * 65 + n], tl[(k8 + 7) * 65 + n]);
      *(u32x4*)(job.dst + (size_t)(n0 + n) * job.ldd + k0 + k8) = o;
    }
  }
}

DEVI void norm_row(const float* __restrict__ xr, const float* __restrict__ g, const float* __restrict__ mod, int lane, float (&h)[16]) {
  float4 x[4];
  float ss = 0.f;
#pragma unroll
  for (int i = 0; i < 4; ++i) {
    x[i] = *(const float4*)(xr + lane * 4 + 256 * i);
    ss += x[i].x * x[i].x + x[i].y * x[i].y + x[i].z * x[i].z + x[i].w * x[i].w;
  }
  ss = wave_sum(ss);
  const float rstd = rsqrtf(ss * (1.f / 1024.f) + 1e-6f);
#pragma unroll
  for (int i = 0; i < 4; ++i) {
    const int c = lane * 4 + 256 * i;
    const float4 gg = *(const float4*)(g + c);
    const float4 sh = *(const float4*)(mod + c);
    const float4 sc = *(const float4*)(mod + 1024 + c);
    h[i * 4 + 0] = x[i].x * rstd * gg.x * (1.f + sc.x) + sh.x;
    h[i * 4 + 1] = x[i].y * rstd * gg.y * (1.f + sc.y) + sh.y;
    h[i * 4 + 2] = x[i].z * rstd * gg.z * (1.f + sc.z) + sh.z;
    h[i * 4 + 3] = x[i].w * rstd * gg.w * (1.f + sc.w) + sh.w;
  }
}

template <bool WITH_HS>
__device__ __forceinline__ void norm_phase(const float* __restrict__ xl, const float* __restrict__ xc, const float* __restrict__ g,
                           const float* __restrict__ modL, bf16_t* __restrict__ H, bf16_t* __restrict__ HS) {
  const int lane = threadIdx.x & 63;
  const int gw = blockIdx.x * (NTHR / 64) + (threadIdx.x >> 6), nw = gridDim.x * (NTHR / 64);
  for (int row = gw; row < MT; row += nw) {
    const bool lat = row < ML;
    const float* xbase = lat ? xl + (size_t)row * 1024 : xc + (size_t)(row - ML) * 1024;
    const float* mod = modL + (lat ? (row >> 12) : 8) * 3072;
    float h[16];
    norm_row(xbase, g, mod, lane, h);
#pragma unroll
    for (int i = 0; i < 4; ++i) {
      u32x2 o; o.x = pk_bf16(h[i * 4], h[i * 4 + 1]); o.y = pk_bf16(h[i * 4 + 2], h[i * 4 + 3]);
      *(u32x2*)(H + (size_t)row * 1024 + lane * 4 + 256 * i) = o;
    }
    if (WITH_HS) {
      const int t = lat ? (row & 4095) : ((row - ML) & 255);
      const int T = lat ? 4096 : 256;
      float s[16];
#pragma unroll
      for (int i = 0; i < 16; ++i) s[i] = 0.f;
      if (t > 0) { float hp[16]; norm_row(xbase - 1024, g, mod, lane, hp);
#pragma unroll
        for (int i = 0; i < 16; ++i) s[i] += hp[i]; }
      if (t < T - 1) { float hn[16]; norm_row(xbase + 1024, g, mod, lane, hn);
#pragma unroll
        for (int i = 0; i < 16; ++i) s[i] += hn[i]; }
#pragma unroll
      for (int i = 0; i < 4; ++i) {
        u32x2 o; o.x = pk_bf16(0.5f * s[i * 4], 0.5f * s[i * 4 + 1]); o.y = pk_bf16(0.5f * s[i * 4 + 2], 0.5f * s[i * 4 + 3]);
        *(u32x2*)(HS + (size_t)row * 1024 + lane * 4 + 256 * i) = o;
      }
    }
  }
}

struct ALPlain {
  const bf16_t* A; int lda;
  typedef u32x4 Regs;
  DEVI void stage(float*, int) const {}
  DEVI void issue(Regs& r, int row, int k) const { r = *(const u32x4*)(A + (size_t)row * lda + k); }
  DEVI u32x4 finish(const Regs& r, const float*, int) const { return r; }
};
struct ALMix {
  const bf16_t* H; const bf16_t* HS; const float* mu;
  struct Regs { u32x4 h, s; };
  DEVI void stage(float* sMu, int nt) const {
    const int j = nt < 8 ? 0 : nt < 16 ? 2 : nt < 24 ? 3 : nt < 32 ? 5 : nt == 32 ? 1 : 4;
    for (int e = threadIdx.x; e < 1024; e += NTHR) sMu[e] = mu[j * 1024 + e];
  }
  DEVI void issue(Regs& r, int row, int k) const {
    r.h = *(const u32x4*)(H + (size_t)row * 1024 + k);
    r.s = *(const u32x4*)(HS + (size_t)row * 1024 + k);
  }
  DEVI unsigned mix2(unsigned h, unsigned s, float m0, float m1) const {
    const float h0 = bf_lo(h), h1 = bf_hi(h), s0 = bf_lo(s), s1 = bf_hi(s);
    return pk_bf16(h0 + (s0 - h0) * m0, h1 + (s1 - h1) * m1);
  }
  DEVI u32x4 finish(const Regs& r, const float* sMu, int k) const {
    const float4 ma = *(const float4*)(sMu + k), mb = *(const float4*)(sMu + k + 4);
    u32x4 o;
    o.x = mix2(r.h.x, r.s.x, ma.x, ma.y); o.y = mix2(r.h.y, r.s.y, ma.z, ma.w);
    o.z = mix2(r.h.z, r.s.z, mb.x, mb.y); o.w = mix2(r.h.w, r.s.w, mb.z, mb.w);
    return o;
  }
};

template <class AL, class EP>
__device__ __forceinline__ void gemm_phase(char* lds, const bf16_t* __restrict__ Bt, int K, int mtiles, int ntiles, const AL al, const EP ep) {
  bf16_t* sA = (bf16_t*)lds;
  bf16_t* sB = (bf16_t*)(lds + 73728);
  float* sMu = (float*)(lds + 110592);
  const int tid = threadIdx.x, lane = tid & 63, wv = tid >> 6, wm = wv >> 1, wn = wv & 1;
  const int l31 = lane & 31, lh = lane >> 5;
  const int nk = K >> 6;
  const int ldrow = tid >> 3, ldk = (tid & 7) * 8;
  const int total = mtiles * ntiles;
  for (int tile = blockIdx.x; tile < total; tile += gridDim.x) {
    const int mt = tile / ntiles, nt = tile - mt * ntiles;
    const int m0 = mt * 256, n0 = nt * 128;
    __syncthreads();
    al.stage(sMu, nt);
    f32x16 acc[2][2];
#pragma unroll
    for (int a = 0; a < 2; ++a)
#pragma unroll
      for (int b = 0; b < 2; ++b)
#pragma unroll
        for (int r = 0; r < 16; ++r) acc[a][b][r] = 0.f;
    typename AL::Regs ar[4];
    u32x4 br[2];
#pragma unroll
    for (int i = 0; i < 4; ++i) al.issue(ar[i], m0 + ldrow + 64 * i, ldk);
#pragma unroll
    for (int i = 0; i < 2; ++i) br[i] = *(const u32x4*)(Bt + (size_t)(n0 + ldrow + 64 * i) * K + ldk);
    __syncthreads();
#pragma unroll
    for (int i = 0; i < 4; ++i) *(u32x4*)(sA + (ldrow + 64 * i) * 72 + ldk) = al.finish(ar[i], sMu, ldk);
#pragma unroll
    for (int i = 0; i < 2; ++i) *(u32x4*)(sB + (ldrow + 64 * i) * 72 + ldk) = br[i];
    __syncthreads();
    for (int kt = 0; kt < nk; ++kt) {
      const int cur = kt & 1;
      const bool more = (kt + 1) < nk;
      const int k0n = (kt + 1) * 64 + ldk;
      if (more) {
#pragma unroll
        for (int i = 0; i < 4; ++i) al.issue(ar[i], m0 + ldrow + 64 * i, k0n);
#pragma unroll
        for (int i = 0; i < 2; ++i) br[i] = *(const u32x4*)(Bt + (size_t)(n0 + ldrow + 64 * i) * K + k0n);
      }
      const bf16_t* a_ = sA + cur * (256 * 72);
      const bf16_t* b_ = sB + cur * (128 * 72);
#pragma unroll
      for (int kk = 0; kk < 4; ++kk) {
        u32x4 af[2], bfr[2];
#pragma unroll
        for (int mi = 0; mi < 2; ++mi) af[mi] = *(const u32x4*)(a_ + (wm * 64 + mi * 32 + l31) * 72 + kk * 16 + lh * 8);
#pragma unroll
        for (int ni = 0; ni < 2; ++ni) bfr[ni] = *(const u32x4*)(b_ + (wn * 64 + ni * 32 + l31) * 72 + kk * 16 + lh * 8);
#pragma unroll
        for (int mi = 0; mi < 2; ++mi)
#pragma unroll
          for (int ni = 0; ni < 2; ++ni) acc[mi][ni] = mfma32(bfr[ni], af[mi], acc[mi][ni]);
      }
      if (more) {
        bf16_t* an = sA + (cur ^ 1) * (256 * 72);
        bf16_t* bn = sB + (cur ^ 1) * (128 * 72);
#pragma unroll
        for (int i = 0; i < 4; ++i) *(u32x4*)(an + (ldrow + 64 * i) * 72 + ldk) = al.finish(ar[i], sMu, k0n);
#pragma unroll
        for (int i = 0; i < 2; ++i) *(u32x4*)(bn + (ldrow + 64 * i) * 72 + ldk) = br[i];
      }
      __syncthreads();
    }
#pragma unroll
    for (int mi = 0; mi < 2; ++mi)
#pragma unroll
      for (int ni = 0; ni < 2; ++ni)
#pragma unroll
        for (int q = 0; q < 4; ++q) {
          const int row = m0 + wm * 64 + mi * 32 + l31;
          const int col = n0 + wn * 64 + ni * 32 + 8 * q + 4 * lh;
          f32x4 v = {acc[mi][ni][4 * q], acc[mi][ni][4 * q + 1], acc[mi][ni][4 * q + 2], acc[mi][ni][4 * q + 3]};
          ep(row, col, v);
        }
  }
}

DEVI void st_bf16x4(bf16_t* p, f32x4 v) { u32x2 o; o.x = pk_bf16(v[0], v[1]); o.y = pk_bf16(v[2], v[3]); *(u32x2*)p = o; }

struct EpRwkvIn {
  bf16_t *R, *K, *V, *G, *WD, *AD;
  DEVI void operator()(int row, int col, f32x4 v) const {
    const int grp = col >> 10;
    if (grp < 4) {
      const int c = col & 1023;
      bf16_t* dst = grp == 0 ? R : grp == 1 ? K : grp == 2 ? V : G;
      if (grp == 3) { v[0] = siluf_(v[0]); v[1] = siluf_(v[1]); v[2] = siluf_(v[2]); v[3] = siluf_(v[3]); }
      st_bf16x4(dst + (size_t)row * 1024 + c, v);
    } else {
      const int c = col - 4096;
      if (c < 128) {
#pragma unroll
        for (int i = 0; i < 4; ++i) { const float t = __expf(2.f * v[i]); v[i] = 1.f - 2.f / (t + 1.f); }
        st_bf16x4(WD + (size_t)row * 128 + c, v);
      } else st_bf16x4(AD + (size_t)row * 128 + (c - 128), v);
    }
  }
};
struct EpRes {
  const float* xl_src; const float* xc_src; float* xl_dst; float* xc_dst; const float* modL;
  DEVI void operator()(int row, int col, f32x4 v) const {
    const bool lat = row < ML;
    const size_t off = lat ? (size_t)row * 1024 + col : (size_t)(row - ML) * 1024 + col;
    const float* src = (lat ? xl_src : xc_src) + off;
    float* dst = (lat ? xl_dst : xc_dst) + off;
    const f32x4 g = *(const f32x4*)(modL + (lat ? (row >> 12) : 8) * 3072 + 2048 + col);
    f32x4 x = *(const f32x4*)src;
    x += g * v;
    *(f32x4*)dst = x;
  }
};
struct EpLruIn {
  bf16_t *XR, *GG;
  DEVI void operator()(int row, int col, f32x4 v) const {
    if (col < LW) st_bf16x4(XR + (size_t)row * LW + col, v);
    else { v[0] = siluf_(v[0]); v[1] = siluf_(v[1]); v[2] = siluf_(v[2]); v[3] = siluf_(v[3]); st_bf16x4(GG + (size_t)row * LW + (col - LW), v); }
  }
};
struct EpNatIn {
  bf16_t *Q, *K, *VT, *G;
  DEVI void operator()(int row, int col, f32x4 v) const {
    const int grp = col >> 10, c = col & 1023;
    if (grp == 0) st_bf16x4(Q + (size_t)row * 1024 + c, v);
    else if (grp == 1) st_bf16x4(K + (size_t)row * 1024 + c, v);
    else if (grp == 3) { v[0] = siluf_(v[0]); v[1] = siluf_(v[1]); v[2] = siluf_(v[2]); v[3] = siluf_(v[3]); st_bf16x4(G + (size_t)row * 1024 + c, v); }
    else {
      const int h = c >> 6, dh = c & 63;
      bf16_t* base; int T, t;
      if (row < ML) { const int b = row >> 12; t = row & 4095; T = 4096; base = VT + ((size_t)(b * 16 + h) * 64 + dh) * 4096; }
      else { const int r2 = row - ML; const int b = r2 >> 8; t = r2 & 255; T = 256; base = VT + (size_t)ML * 1024 + ((size_t)(b * 16 + h) * 64 + dh) * 256; }
#pragma unroll
      for (int i = 0; i < 4; ++i) base[(size_t)i * T + t] = f2bf(v[i]);
    }
  }
};

constexpr int SSTR = 388;
DEVI int rwkv_row(int b, int d, int s) {
  if (s < 256) return ML + b * 256 + (d ? 255 - s : s);
  const int t = s - 256;
  return b * 4096 + (d ? 4095 - t : t);
}

__device__ __forceinline__ void rwkv_scan_phase(char* lds, const bf16_t* __restrict__ R, const bf16_t* __restrict__ Kb, const bf16_t* __restrict__ V,
                                const bf16_t* __restrict__ WD, const bf16_t* __restrict__ AD, const bf16_t* __restrict__ Wup,
                                const float* __restrict__ b0, const float* __restrict__ k_ka, const float* __restrict__ r_k,
                                bf16_t* __restrict__ Y0, bf16_t* __restrict__ Y1, float* __restrict__ BON) {
  float* stepbuf = (float*)lds;
  float* wbuf = stepbuf + 2 * 16 * SSTR;
  float* abuf = wbuf + 1024;
  float* ybuf = abuf + 1024;
  const int tid = threadIdx.x, lane = tid & 63, wv = tid >> 6;
  for (int chain = blockIdx.x; chain < 256; chain += gridDim.x) {
    const int d = chain & 1, h = (chain >> 1) & 15, b = chain >> 5;
    bf16_t* Y = d ? Y1 : Y0;
    const int kind = wv >> 2, ct = wv & 3;
    const int ncol = h * 64 + ct * 16 + (lane & 15);
    const bf16_t* wu = Wup + ((size_t)(d * 2 + kind) * 1024 + ncol) * 64 + 8 * (lane >> 4);
    const u32x4 bu0 = *(const u32x4*)(wu), bu1 = *(const u32x4*)(wu + 32);
    const float bias_u = b0[(d * 2 + kind) * 1024 + ncol];
    const bf16_t* XD = kind ? AD : WD;
    const int ti = tid >> 5, dp = tid & 31;
    const int hc = h * 64 + 2 * dp;
    const float kk0 = k_ka[hc], kk1 = k_ka[hc + 1], ka0 = k_ka[1024 + hc], ka1 = k_ka[1024 + hc + 1];
    const float rk0 = r_k[hc], rk1 = r_k[hc + 1];
    const int srow = wv * 8 + (lane >> 3), sp = lane & 7;
    float S[8];
#pragma unroll
    for (int j = 0; j < 8; ++j) S[j] = 0.f;

    u32x4 xa0, xa1; unsigned rr, kr, vr;
    auto issue = [&](int c) {
      const int rowA = rwkv_row(b, d, c * 16 + (lane & 15));
      const bf16_t* xp = XD + (size_t)rowA * 128 + d * 64 + 8 * (lane >> 4);
      xa0 = *(const u32x4*)xp; xa1 = *(const u32x4*)(xp + 32);
      const int rowB = rwkv_row(b, d, c * 16 + ti);
      rr = *(const unsigned*)(R + (size_t)rowB * 1024 + hc);
      kr = *(const unsigned*)(Kb + (size_t)rowB * 1024 + hc);
      vr = *(const unsigned*)(V + (size_t)rowB * 1024 + hc);
    };
    auto stepA = [&]() {
      f32x4 acc = {0.f, 0.f, 0.f, 0.f};
      acc = mfma16(xa0, bu0, acc);
      acc = mfma16(xa1, bu1, acc);
      float* dst = kind ? abuf : wbuf;
#pragma unroll
      for (int r = 0; r < 4; ++r) {
        const float z = acc[r] + bias_u;
        float o;
        if (kind) o = sigmoidf_(z);
        else { const float wl = -softplusf_(-z) - 0.5f; o = __expf(-__expf(wl)); }
        dst[((lane >> 4) * 4 + r) * 64 + ct * 16 + (lane & 15)] = o;
      }
    };
    auto stepB = [&](int c, float* sb) {
      const float r0 = bf_lo(rr), r1 = bf_hi(rr), k0 = bf_lo(kr), k1 = bf_hi(kr), v0 = bf_lo(vr), v1 = bf_hi(vr);
      const float a0 = abuf[ti * 64 + 2 * dp], a1 = abuf[ti * 64 + 2 * dp + 1];
      const float w0 = wbuf[ti * 64 + 2 * dp], w1 = wbuf[ti * 64 + 2 * dp + 1];
      const float q0 = k0 * kk0, q1 = k1 * kk1;
      float ss = q0 * q0 + q1 * q1;
#pragma unroll
      for (int o = 16; o; o >>= 1) ss += __shfl_xor(ss, o);
      const float inv = 1.f / fmaxf(sqrtf(ss), 1e-12f);
      const float n0 = q0 * inv, n1 = q1 * inv;
      const float kd0 = k0 * (1.f + (a0 - 1.f) * ka0), kd1 = k1 * (1.f + (a1 - 1.f) * ka1);
      const float ka_0 = n0 * a0, ka_1 = n1 * a1;
      float c1 = ka_0 * r0 + ka_1 * r1, c2 = kd0 * r0 + kd1 * r1, bn = r0 * kd0 * rk0 + r1 * kd1 * rk1;
#pragma unroll
      for (int o = 16; o; o >>= 1) { c1 += __shfl_xor(c1, o); c2 += __shfl_xor(c2, o); bn += __shfl_xor(bn, o); }
      float* rec = sb + ti * SSTR;
      *(f32x2*)(rec + 2 * dp) = (f32x2){-n0, -n1};
      *(f32x2*)(rec + 64 + 2 * dp) = (f32x2){w0 * r0, w1 * r1};
      *(f32x2*)(rec + 128 + 2 * dp) = (f32x2){w0, w1};
      *(f32x2*)(rec + 192 + 2 * dp) = (f32x2){ka_0, ka_1};
      *(f32x2*)(rec + 256 + 2 * dp) = (f32x2){kd0, kd1};
      *(f32x2*)(rec + 320 + 2 * dp) = (f32x2){v0, v1};
      if (dp == 0) {
        rec[384] = c1; rec[385] = c2;
        BON[((size_t)d * MT + rwkv_row(b, d, c * 16 + ti)) * 16 + h] = bn;
      }
    };

    __syncthreads();
    issue(0);
    stepA();
    __syncthreads();
    stepB(0, stepbuf);
    __syncthreads();
    constexpr int NCH = (256 + 4096) / 16;
    for (int c = 0; c < NCH; ++c) {
      const int cur = c & 1;
      const bool more = (c + 1) < NCH;
      if (more) issue(c + 1);
      const float* sb = stepbuf + cur * 16 * SSTR;
#pragma unroll 4
      for (int i = 0; i < 16; ++i) {
        const float* rec = sb + i * SSTR;
        const f32x4 na = *(const f32x4*)(rec + 8 * sp), nb = *(const f32x4*)(rec + 8 * sp + 4);
        const f32x4 ra = *(const f32x4*)(rec + 64 + 8 * sp), rb = *(const f32x4*)(rec + 64 + 8 * sp + 4);
        const f32x4 wa = *(const f32x4*)(rec + 128 + 8 * sp), wb = *(const f32x4*)(rec + 128 + 8 * sp + 4);
        const f32x4 ka = *(const f32x4*)(rec + 192 + 8 * sp), kb = *(const f32x4*)(rec + 192 + 8 * sp + 4);
        const f32x4 da = *(const f32x4*)(rec + 256 + 8 * sp), db = *(const f32x4*)(rec + 256 + 8 * sp + 4);
        const float vv = rec[320 + srow];
        const f32x2 cc = *(const f32x2*)(rec + 384);
        float sa = S[0] * na[0] + S[1] * na[1] + S[2] * na[2] + S[3] * na[3] + S[4] * nb[0] + S[5] * nb[1] + S[6] * nb[2] + S[7] * nb[3];
        float y0 = S[0] * ra[0] + S[1] * ra[1] + S[2] * ra[2] + S[3] * ra[3] + S[4] * rb[0] + S[5] * rb[1] + S[6] * rb[2] + S[7] * rb[3];
        sa = sum8(sa); y0 = sum8(y0);
#pragma unroll
        for (int j = 0; j < 4; ++j) {
          S[j] = S[j] * wa[j] + (sa * ka[j] + vv * da[j]);
          S[j + 4] = S[j + 4] * wb[j] + (sa * kb[j] + vv * db[j]);
        }
        if (sp == 0) ybuf[i * 64 + srow] = y0 + sa * cc[0] + vv * cc[1];
      }
      if (more) stepA();
      __syncthreads();
      {
        const float ya = ybuf[ti * 64 + 2 * dp], yb = ybuf[ti * 64 + 2 * dp + 1];
        *(unsigned*)(Y + (size_t)rwkv_row(b, d, c * 16 + ti) * 1024 + hc) = pk_bf16(ya, yb);
      }
      if (more) stepB(c + 1, stepbuf + (cur ^ 1) * 16 * SSTR);
      __syncthreads();
    }
  }
}

__device__ __forceinline__ void rwkv_post_phase(const bf16_t* __restrict__ Y0, const bf16_t* __restrict__ Y1, const bf16_t* __restrict__ V,
                                bf16_t* __restrict__ G, const float* __restrict__ BON, const float* __restrict__ gn, int nrows) {
  const int lane = threadIdx.x & 63;
  const int gw = blockIdx.x * (NTHR / 64) + (threadIdx.x >> 6), nw = gridDim.x * (NTHR / 64);
  const int head = lane >> 2, c0 = lane * 16;
  for (int row = gw; row < nrows; row += nw) {
    const size_t off = (size_t)row * 1024 + c0;
    float y[16], v[16], g[16];
#pragma unroll
    for (int i = 0; i < 2; ++i) {
      const u32x4 a0 = *(const u32x4*)(Y0 + off + 8 * i), a1 = *(const u32x4*)(Y1 + off + 8 * i);
      const u32x4 av = *(const u32x4*)(V + off + 8 * i), ag = *(const u32x4*)(G + off + 8 * i);
      y[8 * i + 0] = bf_lo(a0.x) + bf_lo(a1.x); y[8 * i + 1] = bf_hi(a0.x) + bf_hi(a1.x);
      y[8 * i + 2] = bf_lo(a0.y) + bf_lo(a1.y); y[8 * i + 3] = bf_hi(a0.y) + bf_hi(a1.y);
      y[8 * i + 4] = bf_lo(a0.z) + bf_lo(a1.z); y[8 * i + 5] = bf_hi(a0.z) + bf_hi(a1.z);
      y[8 * i + 6] = bf_lo(a0.w) + bf_lo(a1.w); y[8 * i + 7] = bf_hi(a0.w) + bf_hi(a1.w);
      v[8 * i + 0] = bf_lo(av.x); v[8 * i + 1] = bf_hi(av.x); v[8 * i + 2] = bf_lo(av.y); v[8 * i + 3] = bf_hi(av.y);
      v[8 * i + 4] = bf_lo(av.z); v[8 * i + 5] = bf_hi(av.z); v[8 * i + 6] = bf_lo(av.w); v[8 * i + 7] = bf_hi(av.w);
      g[8 * i + 0] = bf_lo(ag.x); g[8 * i + 1] = bf_hi(ag.x); g[8 * i + 2] = bf_lo(ag.y); g[8 * i + 3] = bf_hi(ag.y);
      g[8 * i + 4] = bf_lo(ag.z); g[8 * i + 5] = bf_hi(ag.z); g[8 * i + 6] = bf_lo(ag.w); g[8 * i + 7] = bf_hi(ag.w);
    }
    float s = 0.f;
#pragma unroll
    for (int i = 0; i < 16; ++i) s += y[i];
    s += __shfl_xor(s, 1); s += __shfl_xor(s, 2);
    const float mean = s * (1.f / 64.f);
    float q = 0.f;
#pragma unroll
    for (int i = 0; i < 16; ++i) { const float dlt = y[i] - mean; q += dlt * dlt; }
    q += __shfl_xor(q, 1); q += __shfl_xor(q, 2);
    const float rstd = rsqrtf(q * (1.f / 64.f) + 64e-5f);
    const float bonus = BON[(size_t)row * 16 + head] + BON[((size_t)MT + row) * 16 + head];
    unsigned o[8];
#pragma unroll
    for (int i = 0; i < 8; ++i) {
      const float z0 = ((y[2 * i] - mean) * rstd * gn[c0 + 2 * i] + gn[1024 + c0 + 2 * i] + bonus * v[2 * i]) * g[2 * i];
      const float z1 = ((y[2 * i + 1] - mean) * rstd * gn[c0 + 2 * i + 1] + gn[1024 + c0 + 2 * i + 1] + bonus * v[2 * i + 1]) * g[2 * i + 1];
      o[i] = pk_bf16(z0, z1);
    }
    *(u32x4*)(G + off) = mk4(o[0], o[1], o[2], o[3]);
    *(u32x4*)(G + off + 8) = mk4(o[4], o[5], o[6], o[7]);
  }
}

__device__ __forceinline__ void rglru_phase(char* lds, const bf16_t* __restrict__ XR, const bf16_t* __restrict__ Wg, const float* __restrict__ conv_w,
                            const float* __restrict__ conv_b, const float* __restrict__ gate_b, const float* __restrict__ lam,
                            bf16_t* __restrict__ HS0, bf16_t* __restrict__ HS1) {
  bf16_t* xcT = (bf16_t*)lds;
  f32x2* AB = (f32x2*)(lds + 26624);
  float* segP = (float*)(lds + 26624 + 90112);
  float* segH = segP + 352;
  float* segC = segH + 352;
  const int tid = threadIdx.x, lane = tid & 63, wv = tid >> 6;
  for (int chain = blockIdx.x; chain < 256; chain += gridDim.x) {
    const int d = chain & 1, blk = (chain >> 1) & 15, b = chain >> 5;
    bf16_t* HS = d ? HS1 : HS0;
    float carry = 0.f;
    for (int ti = 0; ti < 34; ++ti) {
      int seqbase, t0, T;
      if (ti < 2) { seqbase = ML + b * 256; T = 256; t0 = (d ? 1 - ti : ti) * 128; }
      else { seqbase = b * 4096; T = 4096; t0 = (d ? 31 - (ti - 2) : (ti - 2)) * 128; }
      __syncthreads();
      for (int e = tid; e < 128 * 88; e += NTHR) {
        const int tl = e / 88, c = e - tl * 88, t = t0 + tl, ch = blk * 88 + c;
        float acc = conv_b[ch];
#pragma unroll
        for (int j = 0; j < 4; ++j) {
          const int tt = t + j - 2;
          if (tt >= 0 && tt < T) acc += bf2f(XR[(size_t)(seqbase + tt) * LW + ch]) * conv_w[j * LW + ch];
        }
        xcT[tl * 104 + c] = f2bf(acc);
      }
      for (int e = tid; e < 128 * 8; e += NTHR) xcT[(e >> 3) * 104 + 88 + (e & 7)] = 0;
      __syncthreads();
      {
        const int tok = wv * 16 + (lane & 15);
        u32x4 af[3];
#pragma unroll
        for (int kk = 0; kk < 3; ++kk) af[kk] = *(const u32x4*)(xcT + tok * 104 + kk * 32 + 8 * (lane >> 4));
#pragma unroll
        for (int n6 = 0; n6 < 6; ++n6) {
          f32x4 accr = {0.f, 0.f, 0.f, 0.f}, acci = {0.f, 0.f, 0.f, 0.f};
          const int ncol = n6 * 16 + (lane & 15);
          const bf16_t* wr_ = Wg + ((size_t)((blk * 4 + d * 2 + 0) * 96 + ncol)) * 96 + 8 * (lane >> 4);
          const bf16_t* wi_ = Wg + ((size_t)((blk * 4 + d * 2 + 1) * 96 + ncol)) * 96 + 8 * (lane >> 4);
#pragma unroll
          for (int kk = 0; kk < 3; ++kk) {
            accr = mfma16(af[kk], *(const u32x4*)(wr_ + kk * 32), accr);
            acci = mfma16(af[kk], *(const u32x4*)(wi_ + kk * 32), acci);
          }
          if (ncol < 88) {
            const int ch = blk * 88 + ncol;
            const float gbr = gate_b[(d * 2 + 0) * LW + ch], gbi = gate_b[(d * 2 + 1) * LW + ch];
            const float spl = softplusf_(-lam[d * LW + ch]);
#pragma unroll
            for (int r = 0; r < 4; ++r) {
              const int tk = wv * 16 + (lane >> 4) * 4 + r;
              const float rg = sigmoidf_(accr[r] + gbr), ig = sigmoidf_(acci[r] + gbi);
              const float la = -8.f * rg * spl;
              const float a = __expf(la);
              const float bb = sqrtf(-expm1f(2.f * la)) * ig * bf2f(xcT[tk * 104 + ncol]);
              AB[tk * 88 + ncol] = (f32x2){a, bb};
            }
          }
        }
      }
      __syncthreads();
      if (tid < 352) {
        const int seg = tid / 88, c = tid - seg * 88;
        float hl = 0.f, P = 1.f;
        for (int u = seg * 32; u < seg * 32 + 32; ++u) {
          const int tl = d ? 127 - u : u;
          const f32x2 ab = AB[tl * 88 + c];
          hl = ab[0] * hl + ab[1];
          P *= ab[0];
          AB[tl * 88 + c] = (f32x2){hl, P};
        }
        segH[seg * 88 + c] = hl; segP[seg * 88 + c] = P;
      }
      __syncthreads();
      if (tid < 88) {
        float cur = carry;
#pragma unroll
        for (int seg = 0; seg < 4; ++seg) { segC[seg * 88 + tid] = cur; cur = segP[seg * 88 + tid] * cur + segH[seg * 88 + tid]; }
        carry = cur;
      }
      __syncthreads();
      for (int e = tid; e < 128 * 88; e += NTHR) {
        const int tl = e / 88, c = e - tl * 88;
        const int u = d ? 127 - tl : tl;
        const f32x2 hp = AB[tl * 88 + c];
        const float hv = hp[0] + hp[1] * segC[(u >> 5) * 88 + c];
        HS[(size_t)(seqbase + t0 + tl) * LW + blk * 88 + c] = f2bf(hv);
      }
    }
  }
}

__device__ __forceinline__ void lru_z_phase(const bf16_t* __restrict__ HS0, const bf16_t* __restrict__ HS1, bf16_t* __restrict__ GG) {
  const size_t n8 = (size_t)MT * LW / 8;
  for (size_t e = (size_t)blockIdx.x * NTHR + threadIdx.x; e < n8; e += (size_t)gridDim.x * NTHR) {
    const u32x4 a = *(const u32x4*)(HS0 + e * 8), b = *(const u32x4*)(HS1 + e * 8), g = *(const u32x4*)(GG + e * 8);
    u32x4 o;
    o.x = pk_bf16((bf_lo(a.x) + bf_lo(b.x)) * bf_lo(g.x), (bf_hi(a.x) + bf_hi(b.x)) * bf_hi(g.x));
    o.y = pk_bf16((bf_lo(a.y) + bf_lo(b.y)) * bf_lo(g.y), (bf_hi(a.y) + bf_hi(b.y)) * bf_hi(g.y));
    o.z = pk_bf16((bf_lo(a.z) + bf_lo(b.z)) * bf_lo(g.z), (bf_hi(a.z) + bf_hi(b.z)) * bf_hi(g.z));
    o.w = pk_bf16((bf_lo(a.w) + bf_lo(b.w)) * bf_lo(g.w), (bf_hi(a.w) + bf_hi(b.w)) * bf_hi(g.w));
    *(u32x4*)(GG + e * 8) = o;
  }
}

__device__ __forceinline__ void nat_qk_phase(bf16_t* __restrict__ Q, bf16_t* __restrict__ Kb, bf16_t* __restrict__ QR, const float* __restrict__ qk_g) {
  const int lane = threadIdx.x & 63;
  const int gw = blockIdx.x * (NTHR / 64) + (threadIdx.x >> 6), nw = gridDim.x * (NTHR / 64);
  const int qd = lane & 3;
  float gq[16], gk[16], inv[16];
#pragma unroll
  for (int i = 0; i < 16; ++i) { gq[i] = qk_g[qd * 16 + i]; gk[i] = qk_g[64 + qd * 16 + i]; inv[i] = exp2f(-(float)i * (13.287712379549449f / 16.f)); }
  for (int row = gw; row < MT; row += nw) {
    const bool lat = row < ML;
    const size_t off = (size_t)row * 1024 + lane * 16;
    float cs[16], sn[16];
    if (lat) {
      const int t = row & 4095;
      const float pos = (float)((qd >> 1) ? (t & 63) : (t >> 6));
#pragma unroll
      for (int i = 0; i < 16; ++i) {
        float rev = pos * inv[i] * 0.15915494309189535f;
        rev -= floorf(rev);
        sn[i] = __builtin_amdgcn_sinf(rev); cs[i] = __builtin_amdgcn_cosf(rev);
      }
    }
#pragma unroll
    for (int which = 0; which < 2; ++which) {
      bf16_t* P = which ? Kb : Q;
      const u32x4 a = *(const u32x4*)(P + off), b2 = *(const u32x4*)(P + off + 8);
      const unsigned u[8] = {a.x, a.y, a.z, a.w, b2.x, b2.y, b2.z, b2.w};
      float x[16];
#pragma unroll
      for (int i = 0; i < 8; ++i) { x[2 * i] = bf_lo(u[i]); x[2 * i + 1] = bf_hi(u[i]); }
      float ss = 0.f;
#pragma unroll
      for (int i = 0; i < 16; ++i) ss += x[i] * x[i];
      ss += __shfl_xor(ss, 1); ss += __shfl_xor(ss, 2);
      const float rstd = rsqrtf(ss * (1.f / 64.f) + 1e-6f);
#pragma unroll
      for (int i = 0; i < 16; ++i) x[i] = x[i] * rstd * (which ? gk[i] : gq[i]);
      unsigned pl[8];
#pragma unroll
      for (int i = 0; i < 8; ++i) pl[i] = pk_bf16(x[2 * i], x[2 * i + 1]);
      unsigned rt[8];
      if (lat) {
        float y[16];
#pragma unroll
        for (int i = 0; i < 16; ++i) {
          const float pr = __shfl_xor(x[i], 1);
          y[i] = x[i] * cs[i] + ((qd & 1) ? pr * sn[i] : -pr * sn[i]);
        }
#pragma unroll
        for (int i = 0; i < 8; ++i) rt[i] = pk_bf16(y[2 * i], y[2 * i + 1]);
      }
      if (which == 0) {
        *(u32x4*)(Q + off) = mk4(pl[0], pl[1], pl[2], pl[3]);
        *(u32x4*)(Q + off + 8) = mk4(pl[4], pl[5], pl[6], pl[7]);
        if (lat) { *(u32x4*)(QR + off) = mk4(rt[0], rt[1], rt[2], rt[3]); *(u32x4*)(QR + off + 8) = mk4(rt[4], rt[5], rt[6], rt[7]); }
      } else {
        if (lat) { *(u32x4*)(Kb + off) = mk4(rt[0], rt[1], rt[2], rt[3]); *(u32x4*)(Kb + off + 8) = mk4(rt[4], rt[5], rt[6], rt[7]); }
        else { *(u32x4*)(Kb + off) = mk4(pl[0], pl[1], pl[2], pl[3]); *(u32x4*)(Kb + off + 8) = mk4(pl[4], pl[5], pl[6], pl[7]); }
      }
    }
  }
}

struct AttnState { f32x16 O[2][2]; float m[2], l[2]; };

template <bool BAND>
DEVI void attn_chunk(AttnState& st, const u32x4 (&qf)[2][4], const bf16_t* __restrict__ kbase, const bf16_t* __restrict__ vtbase, int vtT,
                     const float* __restrict__ rpbs, int brow, int half, int lane) {
  const int l31 = lane & 31, lh = lane >> 5;
  u32x4 kf[4];
#pragma unroll
  for (int ks = 0; ks < 4; ++ks) kf[ks] = *(const u32x4*)(kbase + (size_t)l31 * 1024 + ks * 16 + 8 * lh);
  constexpr float SC = 0.125f * 1.4426950408889634f;
  u32x4 pf[2][2];
#pragma unroll
  for (int qt = 0; qt < 2; ++qt) {
    f32x16 S;
#pragma unroll
    for (int r = 0; r < 16; ++r) S[r] = 0.f;
#pragma unroll
    for (int ks = 0; ks < 4; ++ks) S = mfma32(kf[ks], qf[qt][ks], S);
    float cmax = -INFINITY;
    if (BAND) {
      const int qc = qt * 32 + l31;
      const int cst = min(max(qc - 8, 0), 48);
#pragma unroll
      for (int r = 0; r < 16; ++r) {
        const int key = (r & 3) + 8 * (r >> 2) + 4 * lh;
        const int kc = half * 32 + key;
        const bool ok = (kc >= cst) && (kc < cst + 16);
        const int bi = ok ? (brow * 31 + kc - qc + 15) : 0;
        const float sv = S[r] * SC + rpbs[bi];
        S[r] = ok ? sv : -INFINITY;
        cmax = fmaxf(cmax, S[r]);
      }
    } else {
#pragma unroll
      for (int r = 0; r < 16; ++r) { S[r] *= SC; cmax = fmaxf(cmax, S[r]); }
    }
    cmax = fmaxf(cmax, __shfl_xor(cmax, 32));
    const float mnew = fmaxf(st.m[qt], cmax);
    const float alpha = exp2f(st.m[qt] - mnew);
    st.m[qt] = mnew;
    float ps = 0.f;
#pragma unroll
    for (int r = 0; r < 16; ++r) { S[r] = exp2f(S[r] - mnew); ps += S[r]; }
    st.l[qt] = st.l[qt] * alpha + ps;
#pragma unroll
    for (int dt = 0; dt < 2; ++dt)
#pragma unroll
      for (int r = 0; r < 16; ++r) st.O[qt][dt][r] *= alpha;
    pf[qt][0] = mk4(pk_bf16(S[0], S[1]), pk_bf16(S[2], S[3]), pk_bf16(S[4], S[5]), pk_bf16(S[6], S[7]));
    pf[qt][1] = mk4(pk_bf16(S[8], S[9]), pk_bf16(S[10], S[11]), pk_bf16(S[12], S[13]), pk_bf16(S[14], S[15]));
  }
#pragma unroll
  for (int dt = 0; dt < 2; ++dt)
#pragma unroll
    for (int s = 0; s < 2; ++s) {
      const bf16_t* vp = vtbase + (size_t)(dt * 32 + l31) * vtT + 16 * s + 4 * lh;
      const u32x2 lo = *(const u32x2*)vp, hi = *(const u32x2*)(vp + 8);
      const u32x4 vf = mk4(lo.x, lo.y, hi.x, hi.y);
      st.O[0][dt] = mfma32(vf, pf[0][s], st.O[0][dt]);
      st.O[1][dt] = mfma32(vf, pf[1][s], st.O[1][dt]);
    }
}

__device__ __forceinline__ void natten_phase(char* lds, const bf16_t* __restrict__ Q, const bf16_t* __restrict__ QR, const bf16_t* __restrict__ Kb,
                             const bf16_t* __restrict__ VT, bf16_t* __restrict__ G, const float* __restrict__ rpb) {
  float* rpbs = (float*)lds;
  __syncthreads();
  for (int e = threadIdx.x; e < 16 * 465; e += NTHR) rpbs[e] = rpb[e] * 1.4426950408889634f;
  __syncthreads();
  const int lane = threadIdx.x & 63, l31 = lane & 31, lh = lane >> 5;
  const int gw = blockIdx.x * (NTHR / 64) + (threadIdx.x >> 6), nw = gridDim.x * (NTHR / 64);
  const bf16_t* VTC = VT + (size_t)ML * 1024;
  for (int item = gw; item < 8192 + 512; item += nw) {
    const bool lat = item < 8192;
    int b, h, r = 0, qrow0;
    if (lat) { h = item & 15; r = (item >> 4) & 63; b = item >> 10; qrow0 = b * 4096 + r * 64; }
    else { const int it = item - 8192; h = it & 15; const int qt64 = (it >> 4) & 3; b = it >> 6; qrow0 = ML + b * 256 + qt64 * 64; }
    AttnState st;
#pragma unroll
    for (int a = 0; a < 2; ++a) { st.m[a] = -INFINITY; st.l[a] = 0.f;
#pragma unroll
      for (int c = 0; c < 2; ++c)
#pragma unroll
        for (int rr = 0; rr < 16; ++rr) st.O[a][c][rr] = 0.f; }
    u32x4 qf[2][4];
#pragma unroll
    for (int qt = 0; qt < 2; ++qt)
#pragma unroll
      for (int ks = 0; ks < 4; ++ks) qf[qt][ks] = *(const u32x4*)(Q + (size_t)(qrow0 + qt * 32 + l31) * 1024 + h * 64 + ks * 16 + 8 * lh);
    for (int kc = 0; kc < 8; ++kc) {
      const bf16_t* kbase = Kb + (size_t)(ML + b * 256 + kc * 32) * 1024 + h * 64;
      const bf16_t* vtb = VTC + (size_t)(b * 16 + h) * 64 * 256 + kc * 32;
      attn_chunk<false>(st, qf, kbase, vtb, 256, rpbs, 0, 0, lane);
    }
    if (lat) {
#pragma unroll
      for (int qt = 0; qt < 2; ++qt)
#pragma unroll
        for (int ks = 0; ks < 4; ++ks) qf[qt][ks] = *(const u32x4*)(QR + (size_t)(qrow0 + qt * 32 + l31) * 1024 + h * 64 + ks * 16 + 8 * lh);
      const int start = min(max(r - 4, 0), 56);
      for (int i = 0; i < 16; ++i) {
        const int kr = start + (i >> 1), half = i & 1;
        const bf16_t* kbase = Kb + (size_t)(b * 4096 + kr * 64 + half * 32) * 1024 + h * 64;
        const bf16_t* vtb = VT + (size_t)(b * 16 + h) * 64 * 4096 + kr * 64 + half * 32;
        attn_chunk<true>(st, qf, kbase, vtb, 4096, rpbs, h * 15 + (kr - r + 7), half, lane);
      }
    }
#pragma unroll
    for (int qt = 0; qt < 2; ++qt) {
      const float lt = st.l[qt] + __shfl_xor(st.l[qt], 32);
      const float inv = 1.f / lt;
      bf16_t* grow = G + (size_t)(qrow0 + qt * 32 + l31) * 1024 + h * 64;
#pragma unroll
      for (int dt = 0; dt < 2; ++dt)
#pragma unroll
        for (int q4 = 0; q4 < 4; ++q4) {
          bf16_t* gp = grow + dt * 32 + 8 * q4 + 4 * lh;
          const u32x2 gv = *(const u32x2*)gp;
          u32x2 o;
          o.x = pk_bf16(st.O[qt][dt][4 * q4] * inv * bf_lo(gv.x), st.O[qt][dt][4 * q4 + 1] * inv * bf_hi(gv.x));
          o.y = pk_bf16(st.O[qt][dt][4 * q4 + 2] * inv * bf_lo(gv.y), st.O[qt][dt][4 * q4 + 3] * inv * bf_hi(gv.y));
          *(u32x2*)gp = o;
        }
    }
  }
}

template <int ph>
__device__ __forceinline__ void run_phase(const Params& p, char* lds) {
  char* ws = p.ws;
  const float* MOD = (const float*)(ws + OFF_MOD);
  float* XC = (float*)(ws + OFF_XC);
  bf16_t* HB = (bf16_t*)(ws + OFF_HB);
  bf16_t* A0 = (bf16_t*)(ws + OFF_A0); bf16_t* A1 = (bf16_t*)(ws + OFF_A1); bf16_t* A2 = (bf16_t*)(ws + OFF_A2);
  bf16_t* A3 = (bf16_t*)(ws + OFF_A3); bf16_t* A4 = (bf16_t*)(ws + OFF_A4);
  bf16_t* WD = (bf16_t*)(ws + OFF_WD); bf16_t* AD = (bf16_t*)(ws + OFF_AD);
  float* BON = (float*)(ws + OFF_BON);
  if (ph == 0) { phase0(p, lds); return; }
  constexpr int layer = (ph - 1) / 5, sub = (ph - 1) % 5;
  const float* modL = MOD + (size_t)layer * 9 * 3072;
  const float* xl_cur = layer == 0 ? p.in[0] : p.out;
  const float* xc_cur = layer == 0 ? p.in[2] : XC;
  if (layer == 0 || layer == 3) {
    const int ib = layer ? 33 : 4;
    const bf16_t* WIN = (const bf16_t*)(ws + (layer ? OFF_W3IN : OFF_W0IN));
    const bf16_t* WUP = (const bf16_t*)(ws + (layer ? OFF_W3UP : OFF_W0UP));
    const bf16_t* WOUT = (const bf16_t*)(ws + (layer ? OFF_W3OUT : OFF_W0OUT));
    if (sub == 0) norm_phase<true>(xl_cur, xc_cur, p.in[ib], modL, HB, A4);
    else if (sub == 1) { ALMix al{HB, A4, p.in[ib + 4]}; EpRwkvIn ep{A0, A1, A2, A3, WD, AD}; gemm_phase(lds, WIN, 1024, MT / 256, 34, al, ep); }
    else if (sub == 2) rwkv_scan_phase(lds, A0, A1, A2, WD, AD, WUP, p.in[ib + 5], p.in[ib + 8], p.in[ib + 9], HB, A4, BON);
    else if (sub == 3) rwkv_post_phase(HB, A4, A2, A3, BON, p.in[ib + 10], layer == 3 ? ML : MT);
    else { ALPlain al{A3, 1024}; EpRes ep{xl_cur, xc_cur, p.out, XC, modL}; gemm_phase(lds, WOUT, 1024, (layer == 3 ? ML : MT) / 256, 8, al, ep); }
  } else if (layer == 1) {
    bf16_t* HS0 = (bf16_t*)(ws + OFF_HS0); bf16_t* XR = (bf16_t*)(ws + OFF_XR); bf16_t* GG = (bf16_t*)(ws + OFF_GG); bf16_t* HS1 = (bf16_t*)(ws + OFF_HS1);
    if (sub == 0) norm_phase<false>(xl_cur, xc_cur, p.in[16], modL, HB, nullptr);
    else if (sub == 1) { ALPlain al{HB, 1024}; EpLruIn ep{XR, GG}; gemm_phase(lds, (const bf16_t*)(ws + OFF_W1IN), 1024, MT / 256, 22, al, ep); }
    else if (sub == 2) rglru_phase(lds, XR, (const bf16_t*)(ws + OFF_W1G), p.in[20], p.in[21], p.in[23], p.in[24], HS0, HS1);
    else if (sub == 3) lru_z_phase(HS0, HS1, GG);
    else { ALPlain al{GG, LW}; EpRes ep{xl_cur, xc_cur, p.out, XC, modL}; gemm_phase(lds, (const bf16_t*)(ws + OFF_W1OUT), LW, MT / 256, 8, al, ep); }
  } else {
    if (sub == 0) norm_phase<false>(xl_cur, xc_cur, p.in[26], modL, HB, nullptr);
    else if (sub == 1) { ALPlain al{HB, 1024}; EpNatIn ep{A0, A1, A2, A3}; gemm_phase(lds, (const bf16_t*)(ws + OFF_W2IN), 1024, MT / 256, 32, al, ep); }
    else if (sub == 2) nat_qk_phase(A0, A1, A4, p.in[30]);
    else if (sub == 3) natten_phase(lds, A0, A4, A1, A2, A3, p.in[31]);
    else { ALPlain al{A3, 1024}; EpRes ep{xl_cur, xc_cur, p.out, XC, modL}; gemm_phase(lds, (const bf16_t*)(ws + OFF_W2OUT), 1024, MT / 256, 8, al, ep); }
  }
}

__global__ void __launch_bounds__(NTHR) mega_kernel(Params p) {
  __shared__ __attribute__((aligned(16))) char lds[LDS_BYTES];
  cg::grid_group grid = cg::this_grid();
#define PHASE(k) if (p.ph_lo <= k && k < p.ph_hi) { run_phase<k>(p, lds); if (k + 1 < p.ph_hi) grid.sync(); }
  PHASE(0) PHASE(1) PHASE(2) PHASE(3) PHASE(4) PHASE(5) PHASE(6) PHASE(7) PHASE(8) PHASE(9) PHASE(10)
  PHASE(11) PHASE(12) PHASE(13) PHASE(14) PHASE(15) PHASE(16) PHASE(17) PHASE(18) PHASE(19) PHASE(20)
#undef PHASE
}

extern "C" void kernel_launch(void* const* d_in, const int* in_sizes, int n_in, void* d_out, int out_size, void* d_ws, size_t ws_size,
                              hipStream_t stream) {
  static int grid_blocks = 0;
  if (!grid_blocks) {
    int dev = 0, cus = 0, per_cu = 0;
    hipGetDevice(&dev);
    hipDeviceGetAttribute(&cus, hipDeviceAttributeMultiprocessorCount, dev);
    hipOccupancyMaxActiveBlocksPerMultiprocessor(&per_cu, mega_kernel, NTHR, 0);
    if (per_cu < 1) { fprintf(stderr, "occupancy query returned %d\n", per_cu); per_cu = 1; }
    if (per_cu > 1) per_cu = 1;
    grid_blocks = cus * per_cu;
    if (n_in != 45 || ws_size < WS_END) fprintf(stderr, "unexpected n_in %d / ws %zu (need %zu)\n", n_in, ws_size, (size_t)WS_END);
  }
  Params p{};
  for (int i = 0; i < 45; ++i) p.in[i] = (const float*)d_in[i];
  p.out = (float*)d_out;
  p.ws = (char*)d_ws;
#if N_LAUNCH_MODE == 1
  p.ph_lo = 0; p.ph_hi = NPHASE;
  void* args[] = {&p};
  hipError_t e = hipLaunchCooperativeKernel((void*)mega_kernel, dim3(grid_blocks), dim3(NTHR), args, 0, stream);
  if (e != hipSuccess) fprintf(stderr, "cooperative launch failed: %s (grid %d)\n", hipGetErrorString(e), grid_blocks);
#else
  for (int ph = 0; ph < NPHASE; ++ph) {
    p.ph_lo = ph; p.ph_hi = ph + 1;
    hipLaunchKernelGGL(mega_kernel, dim3(grid_blocks), dim3(NTHR), 0, stream, p);
  }
#endif
}
```

```cpp
#include <hip/hip_runtime.h>
#include <hip/hip_cooperative_groups.h>
#include <cstdio>
#include <cstdint>
namespace cg = cooperative_groups;

#ifndef N_LAUNCH_MODE
#define N_LAUNCH_MODE 1
#endif

typedef unsigned short bf16_t;
typedef short bf16x8 __attribute__((ext_vector_type(8)));
typedef float f32x4 __attribute__((ext_vector_type(4)));
typedef float f32x16 __attribute__((ext_vector_type(16)));
typedef float f32x2 __attribute__((ext_vector_type(2)));
typedef unsigned u32x4 __attribute__((ext_vector_type(4)));
typedef unsigned u32x2 __attribute__((ext_vector_type(2)));

#define DEVI __device__ __forceinline__

constexpr int D = 1024, NB = 8, SEQ = 4096, CTX = 256;
constexpr int ML = NB * SEQ;
constexpr int MC = NB * CTX;
constexpr int MT = ML + MC;
constexpr int LW = 1408;
constexpr int NTHR = 512;
constexpr int NPHASE = 21;
constexpr int LDS_BYTES = 163840;
__device__ constexpr int REP[21] = {1,1,1,1,1,1,1,1,1,1,1,1,1,1,1,1,1,1,1,1,1};

constexpr size_t SZ_ACT = (size_t)MT * 1024 * 2;
constexpr size_t OFF_MOD = 0;
constexpr size_t OFF_W0IN = 524288;
constexpr size_t SZ_RWIN = (size_t)4352 * 1024 * 2;
constexpr size_t SZ_RWUP = (size_t)4 * 1024 * 64 * 2;
constexpr size_t SZ_SQ = (size_t)1024 * 1024 * 2;
constexpr size_t OFF_W0UP = OFF_W0IN + SZ_RWIN;
constexpr size_t OFF_W0OUT = OFF_W0UP + SZ_RWUP;
constexpr size_t OFF_W3IN = OFF_W0OUT + SZ_SQ;
constexpr size_t OFF_W3UP = OFF_W3IN + SZ_RWIN;
constexpr size_t OFF_W3OUT = OFF_W3UP + SZ_RWUP;
constexpr size_t OFF_W1IN = OFF_W3OUT + SZ_SQ;
constexpr size_t OFF_W1G = OFF_W1IN + (size_t)2816 * 1024 * 2;
constexpr size_t OFF_W1OUT = OFF_W1G + (size_t)16 * 4 * 96 * 96 * 2;
constexpr size_t OFF_W2IN = OFF_W1OUT + (size_t)1024 * 1408 * 2;
constexpr size_t OFF_W2OUT = OFF_W2IN + (size_t)4096 * 1024 * 2;
constexpr size_t OFF_XC = OFF_W2OUT + SZ_SQ;
constexpr size_t OFF_BON = OFF_XC + (size_t)MC * 1024 * 4;
constexpr size_t OFF_BIG = OFF_BON + (size_t)2 * MT * 16 * 4;
constexpr size_t OFF_HB = OFF_BIG;
constexpr size_t OFF_A0 = OFF_BIG + SZ_ACT;
constexpr size_t OFF_A1 = OFF_A0 + SZ_ACT;
constexpr size_t OFF_A2 = OFF_A1 + SZ_ACT;
constexpr size_t OFF_A3 = OFF_A2 + SZ_ACT;
constexpr size_t OFF_A4 = OFF_A3 + SZ_ACT;
constexpr size_t OFF_WD = OFF_A4 + SZ_ACT;
constexpr size_t OFF_AD = OFF_WD + (size_t)MT * 128 * 2;
constexpr size_t WS_END = OFF_AD + (size_t)MT * 128 * 2;
constexpr size_t SZ_LRU = (size_t)MT * LW * 2;
constexpr size_t OFF_HS0 = OFF_BIG;
constexpr size_t OFF_XR = OFF_BIG + SZ_LRU;
constexpr size_t OFF_GG = OFF_XR + SZ_LRU;
constexpr size_t OFF_HS1 = OFF_GG + SZ_LRU;
static_assert(OFF_HS1 + SZ_LRU <= WS_END, "lru overlay");
static_assert(WS_END <= (size_t)536870912, "ws");

struct Params {
  const float* in[45];
  float* out;
  char* ws;
  int ph_lo, ph_hi;
};

DEVI u32x4 mk4(unsigned a, unsigned b, unsigned c, unsigned d) { u32x4 r = {a, b, c, d}; return r; }
DEVI float bf_lo(unsigned u) { return __uint_as_float(u << 16); }
DEVI float bf_hi(unsigned u) { return __uint_as_float(u & 0xffff0000u); }
DEVI float bf2f(bf16_t h) { return __uint_as_float(((unsigned)h) << 16); }
DEVI unsigned pk_bf16(float lo, float hi) { unsigned r; asm("v_cvt_pk_bf16_f32 %0, %1, %2" : "=v"(r) : "v"(lo), "v"(hi)); return r; }
DEVI bf16_t f2bf(float f) { return (bf16_t)(pk_bf16(f, 0.f) & 0xffffu); }
DEVI float wave_sum(float v) {
#pragma unroll
  for (int o = 32; o; o >>= 1) v += __shfl_xor(v, o);
  return v;
}
DEVI float sigmoidf_(float x) { return 1.f / (1.f + __expf(-x)); }
DEVI float siluf_(float x) { return x / (1.f + __expf(-x)); }
DEVI float softplusf_(float x) { return fmaxf(x, 0.f) + log1pf(__expf(-fabsf(x))); }
DEVI f32x16 mfma32(u32x4 a, u32x4 b, f32x16 c) {
  return __builtin_amdgcn_mfma_f32_32x32x16_bf16(__builtin_bit_cast(bf16x8, a), __builtin_bit_cast(bf16x8, b), c, 0, 0, 0);
}
DEVI f32x4 mfma16(u32x4 a, u32x4 b, f32x4 c) {
  return __builtin_amdgcn_mfma_f32_16x16x32_bf16(__builtin_bit_cast(bf16x8, a), __builtin_bit_cast(bf16x8, b), c, 0, 0, 0);
}
template <int CTRL> DEVI float dpp_f(float v) {
  return __int_as_float(__builtin_amdgcn_update_dpp(0, __float_as_int(v), CTRL, 0xf, 0xf, true));
}
DEVI float sum8(float v) {
  v += dpp_f<0xB1>(v);
  v += dpp_f<0x4E>(v);
  v += dpp_f<0x141>(v);
  return v;
}

struct TJob { const float* src; int K, N; bf16_t* dst; int ldd; };

DEVI TJob get_tjob(const Params& p, int j) {
  TJob t;
  if (j < 26) {
    const int l = j / 13, jj = j % 13;
    const int ib = l ? 33 : 4;
    bf16_t* win = (bf16_t*)(p.ws + (l ? OFF_W3IN : OFF_W0IN));
    bf16_t* wup = (bf16_t*)(p.ws + (l ? OFF_W3UP : OFF_W0UP));
    bf16_t* wout = (bf16_t*)(p.ws + (l ? OFF_W3OUT : OFF_W0OUT));
    if (jj < 4) { t.src = p.in[ib + 3] + (size_t)jj * 1048576; t.K = 1024; t.N = 1024; t.dst = win + (size_t)jj * 1048576; t.ldd = 1024; }
    else if (jj < 8) { const int idx = jj - 4, d = idx >> 1, kind = idx & 1;
      t.src = p.in[ib + 6] + (size_t)idx * 65536; t.K = 1024; t.N = 64; t.dst = win + (size_t)(4096 + kind * 128 + d * 64) * 1024; t.ldd = 1024; }
    else if (jj < 12) { const int idx = jj - 8;
      t.src = p.in[ib + 7] + (size_t)idx * 65536; t.K = 64; t.N = 1024; t.dst = wup + (size_t)idx * 65536; t.ldd = 64; }
    else { t.src = p.in[ib + 11]; t.K = 1024; t.N = 1024; t.dst = wout; t.ldd = 1024; }
  } else if (j == 26) { t.src = p.in[19]; t.K = 1024; t.N = 2816; t.dst = (bf16_t*)(p.ws + OFF_W1IN); t.ldd = 1024; }
  else if (j == 27) { t.src = p.in[25]; t.K = 1408; t.N = 1024; t.dst = (bf16_t*)(p.ws + OFF_W1OUT); t.ldd = 1408; }
  else if (j == 28) { t.src = p.in[29]; t.K = 1024; t.N = 4096; t.dst = (bf16_t*)(p.ws + OFF_W2IN); t.ldd = 1024; }
  else { t.src = p.in[32]; t.K = 1024; t.N = 1024; t.dst = (bf16_t*)(p.ws + OFF_W2OUT); t.ldd = 1024; }
  return t;
}

__device__ __forceinline__ void phase0(const Params& p, char* lds) {
  const int tid = threadIdx.x;
  {
    bf16_t* wg = (bf16_t*)(p.ws + OFF_W1G);
    const float* gw = p.in[22];
    const int total = 16 * 4 * 96 * 96;
    for (int e = blockIdx.x * NTHR + tid; e < total; e += gridDim.x * NTHR) {
      const int k = e % 96, n = (e / 96) % 96, dg = (e / 9216) & 3, blk = e / 36864;
      float v = 0.f;
      if (k < 88 && n < 88) v = gw[((size_t)(dg * 16 + blk) * 88 + k) * 88 + n];
      wg[e] = f2bf(v);
    }
  }
  constexpr int N_MOD_ITEMS = 96;
  constexpr int N_TILES = 5152;
  float* act = (float*)lds;
  float* red = (float*)(lds + 36864);
  float* tl = (float*)lds;
  for (int item = blockIdx.x; item < N_MOD_ITEMS + N_TILES; item += gridDim.x) {
    __syncthreads();
    if (item < N_MOD_ITEMS) {
      const int L = item / 24, nc = item % 24;
      const int ib = (L == 0) ? 4 : (L == 1) ? 16 : (L == 2) ? 26 : 33;
      const float* ada_w = p.in[ib + 1];
      const float* ada_b = p.in[ib + 2];
      for (int e = tid; e < 9 * 1024; e += NTHR) {
        const int i = e >> 10, k = e & 1023;
        const float c = (i < 8) ? p.in[1][i * 1024 + k] : p.in[3][k];
        act[e] = siluf_(c);
      }
      __syncthreads();
      const int kq = tid >> 7, nl = tid & 127, n = nc * 128 + nl;
      float acc[9];
#pragma unroll
      for (int i = 0; i < 9; ++i) acc[i] = 0.f;
      for (int k = kq * 256; k < kq * 256 + 256; ++k) {
        const float w = ada_w[(size_t)k * 3072 + n];
#pragma unroll
        for (int i = 0; i < 9; ++i) acc[i] += act[i * 1024 + k] * w;
      }
#pragma unroll
      for (int i = 0; i < 9; ++i) red[(kq * 9 + i) * 128 + nl] = acc[i];
      __syncthreads();
      float* mod = (float*)(p.ws + OFF_MOD) + (size_t)L * 9 * 3072;
      for (int e = tid; e < 9 * 128; e += NTHR) {
        const int i = e >> 7, c = e & 127;
        const float s = red[(0 * 9 + i) * 128 + c] + red[(1 * 9 + i) * 128 + c] + red[(2 * 9 + i) * 128 + c] + red[(3 * 9 + i) * 128 + c];
        mod[i * 3072 + nc * 128 + c] = s + ada_b[nc * 128 + c];
      }
    } else {
      int t = item - N_MOD_ITEMS;
      int j = 0;
      TJob job = get_tjob(p, 0);
      for (;;) {
        const int nt = (job.K >> 6) * (job.N >> 6);
        if (t < nt) break;
        t -= nt; ++j; job = get_tjob(p, j);
      }
      const int ntn = job.N >> 6;
      const int k0 = (t / ntn) * 64, n0 = (t % ntn) * 64;
#pragma unroll
      for (int i = 0; i < 2; ++i) {
        const int k = (tid >> 4) + 32 * i, n4 = (tid & 15) * 4;
        const float4 v = *(const float4*)(job.src + (size_t)(k0 + k) * job.N + n0 + n4);
        tl[k * 65 + n4 + 0] = v.x; tl[k * 65 + n4 + 1] = v.y; tl[k * 65 + n4 + 2] = v.z; tl[k * 65 + n4 + 3] = v.w;
      }
      __syncthreads();
      const int n = tid >> 3, k8 = (tid & 7) * 8;
      u32x4 o;
      o.x = pk_bf16(tl[(k8 + 0) * 65 + n], tl[(k8 + 1) * 65 + n]);
      o.y = pk_bf16(tl[(k8 + 2) * 65 + n], tl[(k8 + 3) * 65 + n]);
      o.z = pk_bf16(tl[(k8 + 4) * 65 + n], tl[(k8 + 5) * 65 + n]);
      o.w = pk_bf16(tl[(k8 + 6) * 65 + n], tl[(k8 + 7) * 65 + n]);
      *(u32x4*)(job.dst + (size_t)(n0 + n) * job.ldd + k0 + k8) = o;
    }
  }
}

DEVI void norm_row(const float* __restrict__ xr, const float* __restrict__ g, const float* __restrict__ mod, int lane, float (&h)[16]) {
  float4 x[4];
  float ss = 0.f;
#pragma unroll
  for (int i = 0; i < 4; ++i) {
    x[i] = *(const float4*)(xr + lane * 4 + 256 * i);
    ss += x[i].x * x[i].x + x[i].y * x[i].y + x[i].z * x[i].z + x[i].w * x[i].w;
  }
  ss = wave_sum(ss);
  const float rstd = rsqrtf(ss * (1.f / 1024.f) + 1e-6f);
#pragma unroll
  for (int i = 0; i < 4; ++i) {
    const int c = lane * 4 + 256 * i;
    const float4 gg = *(const float4*)(g + c);
    const float4 sh = *(const float4*)(mod + c);
    const float4 sc = *(const float4*)(mod + 1024 + c);
    h[i * 4 + 0] = x[i].x * rstd * gg.x * (1.f + sc.x) + sh.x;
    h[i * 4 + 1] = x[i].y * rstd * gg.y * (1.f + sc.y) + sh.y;
    h[i * 4 + 2] = x[i].z * rstd * gg.z * (1.f + sc.z) + sh.z;
    h[i * 4 + 3] = x[i].w * rstd * gg.w * (1.f + sc.w) + sh.w;
  }
}

template <bool WITH_HS>
__device__ __forceinline__ void norm_phase(const float* __restrict__ xl, const float* __restrict__ xc, const float* __restrict__ g,
                           const float* __restrict__ modL, bf16_t* __restrict__ H, bf16_t* __restrict__ HS) {
  const int lane = threadIdx.x & 63;
  const int gw = blockIdx.x * (NTHR / 64) + (threadIdx.x >> 6), nw = gridDim.x * (NTHR / 64);
  for (int row = gw; row < MT; row += nw) {
    const bool lat = row < ML;
    const float* xbase = lat ? xl + (size_t)row * 1024 : xc + (size_t)(row - ML) * 1024;
    const float* mod = modL + (lat ? (row >> 12) : 8) * 3072;
    float h[16];
    norm_row(xbase, g, mod, lane, h);
#pragma unroll
    for (int i = 0; i < 4; ++i) {
      u32x2 o; o.x = pk_bf16(h[i * 4], h[i * 4 + 1]); o.y = pk_bf16(h[i * 4 + 2], h[i * 4 + 3]);
      *(u32x2*)(H + (size_t)row * 1024 + lane * 4 + 256 * i) = o;
    }
    if (WITH_HS) {
      const int t = lat ? (row & 4095) : ((row - ML) & 255);
      const int T = lat ? 4096 : 256;
      float s[16];
#pragma unroll
      for (int i = 0; i < 16; ++i) s[i] = 0.f;
      if (t > 0) { float hp[16]; norm_row(xbase - 1024, g, mod, lane, hp);
#pragma unroll
        for (int i = 0; i < 16; ++i) s[i] += hp[i]; }
      if (t < T - 1) { float hn[16]; norm_row(xbase + 1024, g, mod, lane, hn);
#pragma unroll
        for (int i = 0; i < 16; ++i) s[i] += hn[i]; }
#pragma unroll
      for (int i = 0; i < 4; ++i) {
        u32x2 o; o.x = pk_bf16(0.5f * s[i * 4], 0.5f * s[i * 4 + 1]); o.y = pk_bf16(0.5f * s[i * 4 + 2], 0.5f * s[i * 4 + 3]);
        *(u32x2*)(HS + (size_t)row * 1024 + lane * 4 + 256 * i) = o;
      }
    }
  }
}

struct ALPlain {
  const bf16_t* A; int lda;
  typedef u32x4 Regs;
  DEVI void stage(float*, int) const {}
  DEVI void issue(Regs& r, int row, int k) const { r = *(const u32x4*)(A + (size_t)row * lda + k); }
  DEVI u32x4 finish(const Regs& r, const float*, int) const { return r; }
};
struct ALMix {
  const bf16_t* H; const bf16_t* HS; const float* mu;
  struct Regs { u32x4 h, s; };
  DEVI void stage(float* sMu, int nt) const {
    const int j = nt < 8 ? 0 : nt < 16 ? 2 : nt < 24 ? 3 : nt < 32 ? 5 : nt == 32 ? 1 : 4;
    for (int e = threadIdx.x; e < 1024; e += NTHR) sMu[e] = mu[j * 1024 + e];
  }
  DEVI void issue(Regs& r, int row, int k) const {
    r.h = *(const u32x4*)(H + (size_t)row * 1024 + k);
    r.s = *(const u32x4*)(HS + (size_t)row * 1024 + k);
  }
  DEVI unsigned mix2(unsigned h, unsigned s, float m0, float m1) const {
    const float h0 = bf_lo(h), h1 = bf_hi(h), s0 = bf_lo(s), s1 = bf_hi(s);
    return pk_bf16(h0 + (s0 - h0) * m0, h1 + (s1 - h1) * m1);
  }
  DEVI u32x4 finish(const Regs& r, const float* sMu, int k) const {
    const float4 ma = *(const float4*)(sMu + k), mb = *(const float4*)(sMu + k + 4);
    u32x4 o;
    o.x = mix2(r.h.x, r.s.x, ma.x, ma.y); o.y = mix2(r.h.y, r.s.y, ma.z, ma.w);
    o.z = mix2(r.h.z, r.s.z, mb.x, mb.y); o.w = mix2(r.h.w, r.s.w, mb.z, mb.w);
    return o;
  }
};

template <class AL, class EP>
__device__ __forceinline__ void gemm_phase(char* lds, const bf16_t* __restrict__ Bt, int K, int mtiles, int ntiles, const AL al, const EP ep) {
  bf16_t* sA = (bf16_t*)lds;
  bf16_t* sB = (bf16_t*)(lds + 73728);
  float* sMu = (float*)(lds + 110592);
  const int tid = threadIdx.x, lane = tid & 63, wv = tid >> 6, wm = wv >> 1, wn = wv & 1;
  const int l31 = lane & 31, lh = lane >> 5;
  const int nk = K >> 6;
  const int ldrow = tid >> 3, ldk = (tid & 7) * 8;
  const int total = mtiles * ntiles;
  const int nslots = gridDim.x >> 3, xcd = blockIdx.x & 7, slot = blockIdx.x >> 3;
  const int gm = 4 * ntiles;
  for (int chunk = xcd; chunk * nslots < total; chunk += 8) {
    const int tile = chunk * nslots + slot;
    if (tile >= total) break;
    const int grp = tile / gm, rem = tile - grp * gm;
    const int mt = grp * 4 + (rem & 3), nt = rem >> 2;
    const int m0 = mt * 256, n0 = nt * 128;
    __syncthreads();
    al.stage(sMu, nt);
    f32x16 acc[2][2];
#pragma unroll
    for (int a = 0; a < 2; ++a)
#pragma unroll
      for (int b = 0; b < 2; ++b)
#pragma unroll
        for (int r = 0; r < 16; ++r) acc[a][b][r] = 0.f;
    typename AL::Regs ar[4];
    u32x4 br[2];
#pragma unroll
    for (int i = 0; i < 4; ++i) al.issue(ar[i], m0 + ldrow + 64 * i, ldk);
#pragma unroll
    for (int i = 0; i < 2; ++i) br[i] = *(const u32x4*)(Bt + (size_t)(n0 + ldrow + 64 * i) * K + ldk);
    __syncthreads();
#pragma unroll
    for (int i = 0; i < 4; ++i) *(u32x4*)(sA + (ldrow + 64 * i) * 72 + ldk) = al.finish(ar[i], sMu, ldk);
#pragma unroll
    for (int i = 0; i < 2; ++i) *(u32x4*)(sB + (ldrow + 64 * i) * 72 + ldk) = br[i];
    __syncthreads();
    for (int kt = 0; kt < nk; ++kt) {
      const int cur = kt & 1;
      const bool more = (kt + 1) < nk;
      const int k0n = (kt + 1) * 64 + ldk;
      if (more) {
#pragma unroll
        for (int i = 0; i < 4; ++i) al.issue(ar[i], m0 + ldrow + 64 * i, k0n);
#pragma unroll
        for (int i = 0; i < 2; ++i) br[i] = *(const u32x4*)(Bt + (size_t)(n0 + ldrow + 64 * i) * K + k0n);
      }
      __builtin_amdgcn_sched_barrier(0);
      const bf16_t* a_ = sA + cur * (256 * 72);
      const bf16_t* b_ = sB + cur * (128 * 72);
#pragma unroll
      for (int kk = 0; kk < 4; ++kk) {
        u32x4 af[2], bfr[2];
#pragma unroll
        for (int mi = 0; mi < 2; ++mi) af[mi] = *(const u32x4*)(a_ + (wm * 64 + mi * 32 + l31) * 72 + kk * 16 + lh * 8);
#pragma unroll
        for (int ni = 0; ni < 2; ++ni) bfr[ni] = *(const u32x4*)(b_ + (wn * 64 + ni * 32 + l31) * 72 + kk * 16 + lh * 8);
#pragma unroll
        for (int mi = 0; mi < 2; ++mi)
#pragma unroll
          for (int ni = 0; ni < 2; ++ni) acc[mi][ni] = mfma32(bfr[ni], af[mi], acc[mi][ni]);
      }
      __builtin_amdgcn_sched_barrier(0);
      if (more) {
        bf16_t* an = sA + (cur ^ 1) * (256 * 72);
        bf16_t* bn = sB + (cur ^ 1) * (128 * 72);
#pragma unroll
        for (int i = 0; i < 4; ++i) *(u32x4*)(an + (ldrow + 64 * i) * 72 + ldk) = al.finish(ar[i], sMu, k0n);
#pragma unroll
        for (int i = 0; i < 2; ++i) *(u32x4*)(bn + (ldrow + 64 * i) * 72 + ldk) = br[i];
      }
      __syncthreads();
    }
#pragma unroll
    for (int mi = 0; mi < 2; ++mi)
#pragma unroll
      for (int ni = 0; ni < 2; ++ni)
#pragma unroll
        for (int q = 0; q < 4; ++q) {
          const int row = m0 + wm * 64 + mi * 32 + l31;
          const int col = n0 + wn * 64 + ni * 32 + 8 * q + 4 * lh;
          f32x4 v = {acc[mi][ni][4 * q], acc[mi][ni][4 * q + 1], acc[mi][ni][4 * q + 2], acc[mi][ni][4 * q + 3]};
          ep(row, col, v);
        }
  }
}

DEVI void st_bf16x4(bf16_t* p, f32x4 v) { u32x2 o; o.x = pk_bf16(v[0], v[1]); o.y = pk_bf16(v[2], v[3]); *(u32x2*)p = o; }

struct EpRwkvIn {
  bf16_t *R, *K, *V, *G, *WD, *AD;
  DEVI void operator()(int row, int col, f32x4 v) const {
    const int grp = col >> 10;
    if (grp < 4) {
      const int c = col & 1023;
      bf16_t* dst = grp == 0 ? R : grp == 1 ? K : grp == 2 ? V : G;
      if (grp == 3) { v[0] = siluf_(v[0]); v[1] = siluf_(v[1]); v[2] = siluf_(v[2]); v[3] = siluf_(v[3]); }
      st_bf16x4(dst + (size_t)row * 1024 + c, v);
    } else {
      const int c = col - 4096;
      if (c < 128) {
#pragma unroll
        for (int i = 0; i < 4; ++i) { const float t = __expf(2.f * v[i]); v[i] = 1.f - 2.f / (t + 1.f); }
        st_bf16x4(WD + (size_t)row * 128 + c, v);
      } else st_bf16x4(AD + (size_t)row * 128 + (c - 128), v);
    }
  }
};
struct EpRes {
  const float* xl_src; const float* xc_src; float* xl_dst; float* xc_dst; const float* modL;
  DEVI void operator()(int row, int col, f32x4 v) const {
    const bool lat = row < ML;
    const size_t off = lat ? (size_t)row * 1024 + col : (size_t)(row - ML) * 1024 + col;
    const float* src = (lat ? xl_src : xc_src) + off;
    float* dst = (lat ? xl_dst : xc_dst) + off;
    const f32x4 g = *(const f32x4*)(modL + (lat ? (row >> 12) : 8) * 3072 + 2048 + col);
    f32x4 x = *(const f32x4*)src;
    x += g * v;
    *(f32x4*)dst = x;
  }
};
struct EpLruIn {
  bf16_t *XR, *GG;
  DEVI void operator()(int row, int col, f32x4 v) const {
    if (col < LW) st_bf16x4(XR + (size_t)row * LW + col, v);
    else { v[0] = siluf_(v[0]); v[1] = siluf_(v[1]); v[2] = siluf_(v[2]); v[3] = siluf_(v[3]); st_bf16x4(GG + (size_t)row * LW + (col - LW), v); }
  }
};
struct EpNatIn {
  bf16_t *Q, *K, *VT, *G;
  DEVI void operator()(int row, int col, f32x4 v) const {
    const int grp = col >> 10, c = col & 1023;
    if (grp == 0) st_bf16x4(Q + (size_t)row * 1024 + c, v);
    else if (grp == 1) st_bf16x4(K + (size_t)row * 1024 + c, v);
    else if (grp == 3) { v[0] = siluf_(v[0]); v[1] = siluf_(v[1]); v[2] = siluf_(v[2]); v[3] = siluf_(v[3]); st_bf16x4(G + (size_t)row * 1024 + c, v); }
    else {
      const int h = c >> 6, dh = c & 63;
      bf16_t* base; int T, t;
      if (row < ML) { const int b = row >> 12; t = row & 4095; T = 4096; base = VT + ((size_t)(b * 16 + h) * 64 + dh) * 4096; }
      else { const int r2 = row - ML; const int b = r2 >> 8; t = r2 & 255; T = 256; base = VT + (size_t)ML * 1024 + ((size_t)(b * 16 + h) * 64 + dh) * 256; }
#pragma unroll
      for (int i = 0; i < 4; ++i) base[(size_t)i * T + t] = f2bf(v[i]);
    }
  }
};

constexpr int SSTR = 388;
DEVI int rwkv_row(int b, int d, int s) {
  if (s < 256) return ML + b * 256 + (d ? 255 - s : s);
  const int t = s - 256;
  return b * 4096 + (d ? 4095 - t : t);
}

__device__ __forceinline__ void rwkv_scan_phase(char* lds, const bf16_t* __restrict__ R, const bf16_t* __restrict__ Kb, const bf16_t* __restrict__ V,
                                const bf16_t* __restrict__ WD, const bf16_t* __restrict__ AD, const bf16_t* __restrict__ Wup,
                                const float* __restrict__ b0, const float* __restrict__ k_ka, const float* __restrict__ r_k,
                                bf16_t* __restrict__ Y0, bf16_t* __restrict__ Y1, float* __restrict__ BON) {
  float* stepbuf = (float*)lds;
  float* wbuf = stepbuf + 2 * 16 * SSTR;
  float* abuf = wbuf + 1024;
  float* ybuf = abuf + 1024;
  const int tid = threadIdx.x, lane = tid & 63, wv = tid >> 6;
  for (int chain = blockIdx.x; chain < 256; chain += gridDim.x) {
    const int d = chain & 1, h = (chain >> 1) & 15, b = chain >> 5;
    bf16_t* Y = d ? Y1 : Y0;
    const int kind = wv >> 2, ct = wv & 3;
    const int ncol = h * 64 + ct * 16 + (lane & 15);
    const bf16_t* wu = Wup + ((size_t)(d * 2 + kind) * 1024 + ncol) * 64 + 8 * (lane >> 4);
    const u32x4 bu0 = *(const u32x4*)(wu), bu1 = *(const u32x4*)(wu + 32);
    const float bias_u = b0[(d * 2 + kind) * 1024 + ncol];
    const bf16_t* XD = kind ? AD : WD;
    const int ti = tid >> 5, dp = tid & 31;
    const int hc = h * 64 + 2 * dp;
    const float kk0 = k_ka[hc], kk1 = k_ka[hc + 1], ka0 = k_ka[1024 + hc], ka1 = k_ka[1024 + hc + 1];
    const float rk0 = r_k[hc], rk1 = r_k[hc + 1];
    const int srow = wv * 8 + (lane >> 3), sp = lane & 7;
    float S[8];
#pragma unroll
    for (int j = 0; j < 8; ++j) S[j] = 0.f;

    u32x4 xa0, xa1; unsigned rr, kr, vr;
    auto issue = [&](int c) {
      const int rowA = rwkv_row(b, d, c * 16 + (lane & 15));
      const bf16_t* xp = XD + (size_t)rowA * 128 + d * 64 + 8 * (lane >> 4);
      xa0 = *(const u32x4*)xp; xa1 = *(const u32x4*)(xp + 32);
      const int rowB = rwkv_row(b, d, c * 16 + ti);
      rr = *(const unsigned*)(R + (size_t)rowB * 1024 + hc);
      kr = *(const unsigned*)(Kb + (size_t)rowB * 1024 + hc);
      vr = *(const unsigned*)(V + (size_t)rowB * 1024 + hc);
    };
    auto stepA = [&]() {
      f32x4 acc = {0.f, 0.f, 0.f, 0.f};
      acc = mfma16(xa0, bu0, acc);
      acc = mfma16(xa1, bu1, acc);
      float* dst = kind ? abuf : wbuf;
#pragma unroll
      for (int r = 0; r < 4; ++r) {
        const float z = acc[r] + bias_u;
        float o;
        if (kind) o = sigmoidf_(z);
        else { const float wl = -softplusf_(-z) - 0.5f; o = __expf(-__expf(wl)); }
        dst[((lane >> 4) * 4 + r) * 64 + ct * 16 + (lane & 15)] = o;
      }
    };
    auto stepB = [&](int c, float* sb) {
      const float r0 = bf_lo(rr), r1 = bf_hi(rr), k0 = bf_lo(kr), k1 = bf_hi(kr), v0 = bf_lo(vr), v1 = bf_hi(vr);
      const float a0 = abuf[ti * 64 + 2 * dp], a1 = abuf[ti * 64 + 2 * dp + 1];
      const float w0 = wbuf[ti * 64 + 2 * dp], w1 = wbuf[ti * 64 + 2 * dp + 1];
      const float q0 = k0 * kk0, q1 = k1 * kk1;
      float ss = q0 * q0 + q1 * q1;
#pragma unroll
      for (int o = 16; o; o >>= 1) ss += __shfl_xor(ss, o);
      const float inv = 1.f / fmaxf(sqrtf(ss), 1e-12f);
      const float n0 = q0 * inv, n1 = q1 * inv;
      const float kd0 = k0 * (1.f + (a0 - 1.f) * ka0), kd1 = k1 * (1.f + (a1 - 1.f) * ka1);
      const float ka_0 = n0 * a0, ka_1 = n1 * a1;
      float c1 = ka_0 * r0 + ka_1 * r1, c2 = kd0 * r0 + kd1 * r1, bn = r0 * kd0 * rk0 + r1 * kd1 * rk1;
#pragma unroll
      for (int o = 16; o; o >>= 1) { c1 += __shfl_xor(c1, o); c2 += __shfl_xor(c2, o); bn += __shfl_xor(bn, o); }
      float* rec = sb + ti * SSTR;
      *(f32x2*)(rec + 2 * dp) = (f32x2){-n0, -n1};
      *(f32x2*)(rec + 64 + 2 * dp) = (f32x2){w0 * r0, w1 * r1};
      *(f32x2*)(rec + 128 + 2 * dp) = (f32x2){w0, w1};
      *(f32x2*)(rec + 192 + 2 * dp) = (f32x2){ka_0, ka_1};
      *(f32x2*)(rec + 256 + 2 * dp) = (f32x2){kd0, kd1};
      *(f32x2*)(rec + 320 + 2 * dp) = (f32x2){v0, v1};
      if (dp == 0) {
        rec[384] = c1; rec[385] = c2;
        BON[((size_t)d * MT + rwkv_row(b, d, c * 16 + ti)) * 16 + h] = bn;
      }
    };

    __syncthreads();
    issue(0);
    stepA();
    __syncthreads();
    stepB(0, stepbuf);
    __syncthreads();
    constexpr int NCH = (256 + 4096) / 16;
    for (int c = 0; c < NCH; ++c) {
      const int cur = c & 1;
      const bool more = (c + 1) < NCH;
      if (more) issue(c + 1);
      const float* sb = stepbuf + cur * 16 * SSTR;
#pragma unroll 4
      for (int i = 0; i < 16; ++i) {
        const float* rec = sb + i * SSTR;
        const f32x4 na = *(const f32x4*)(rec + 8 * sp), nb = *(const f32x4*)(rec + 8 * sp + 4);
        const f32x4 ra = *(const f32x4*)(rec + 64 + 8 * sp), rb = *(const f32x4*)(rec + 64 + 8 * sp + 4);
        const f32x4 wa = *(const f32x4*)(rec + 128 + 8 * sp), wb = *(const f32x4*)(rec + 128 + 8 * sp + 4);
        const f32x4 ka = *(const f32x4*)(rec + 192 + 8 * sp), kb = *(const f32x4*)(rec + 192 + 8 * sp + 4);
        const f32x4 da = *(const f32x4*)(rec + 256 + 8 * sp), db = *(const f32x4*)(rec + 256 + 8 * sp + 4);
        const float vv = rec[320 + srow];
        const f32x2 cc = *(const f32x2*)(rec + 384);
        float sa = S[0] * na[0] + S[1] * na[1] + S[2] * na[2] + S[3] * na[3] + S[4] * nb[0] + S[5] * nb[1] + S[6] * nb[2] + S[7] * nb[3];
        float y0 = S[0] * ra[0] + S[1] * ra[1] + S[2] * ra[2] + S[3] * ra[3] + S[4] * rb[0] + S[5] * rb[1] + S[6] * rb[2] + S[7] * rb[3];
        sa = sum8(sa); y0 = sum8(y0);
#pragma unroll
        for (int j = 0; j < 4; ++j) {
          S[j] = S[j] * wa[j] + (sa * ka[j] + vv * da[j]);
          S[j + 4] = S[j + 4] * wb[j] + (sa * kb[j] + vv * db[j]);
        }
        if (sp == 0) ybuf[i * 64 + srow] = y0 + sa * cc[0] + vv * cc[1];
      }
      if (more) stepA();
      __syncthreads();
      {
        const float ya = ybuf[ti * 64 + 2 * dp], yb = ybuf[ti * 64 + 2 * dp + 1];
        *(unsigned*)(Y + (size_t)rwkv_row(b, d, c * 16 + ti) * 1024 + hc) = pk_bf16(ya, yb);
      }
      if (more) stepB(c + 1, stepbuf + (cur ^ 1) * 16 * SSTR);
      __syncthreads();
    }
  }
}

__device__ __forceinline__ void rwkv_post_phase(const bf16_t* __restrict__ Y0, const bf16_t* __restrict__ Y1, const bf16_t* __restrict__ V,
                                bf16_t* __restrict__ G, const float* __restrict__ BON, const float* __restrict__ gn, int nrows) {
  const int lane = threadIdx.x & 63;
  const int gw = blockIdx.x * (NTHR / 64) + (threadIdx.x >> 6), nw = gridDim.x * (NTHR / 64);
  const int head = lane >> 2, c0 = lane * 16;
  for (int row = gw; row < nrows; row += nw) {
    const size_t off = (size_t)row * 1024 + c0;
    float y[16], v[16], g[16];
#pragma unroll
    for (int i = 0; i < 2; ++i) {
      const u32x4 a0 = *(const u32x4*)(Y0 + off + 8 * i), a1 = *(const u32x4*)(Y1 + off + 8 * i);
      const u32x4 av = *(const u32x4*)(V + off + 8 * i), ag = *(const u32x4*)(G + off + 8 * i);
      y[8 * i + 0] = bf_lo(a0.x) + bf_lo(a1.x); y[8 * i + 1] = bf_hi(a0.x) + bf_hi(a1.x);
      y[8 * i + 2] = bf_lo(a0.y) + bf_lo(a1.y); y[8 * i + 3] = bf_hi(a0.y) + bf_hi(a1.y);
      y[8 * i + 4] = bf_lo(a0.z) + bf_lo(a1.z); y[8 * i + 5] = bf_hi(a0.z) + bf_hi(a1.z);
      y[8 * i + 6] = bf_lo(a0.w) + bf_lo(a1.w); y[8 * i + 7] = bf_hi(a0.w) + bf_hi(a1.w);
      v[8 * i + 0] = bf_lo(av.x); v[8 * i + 1] = bf_hi(av.x); v[8 * i + 2] = bf_lo(av.y); v[8 * i + 3] = bf_hi(av.y);
      v[8 * i + 4] = bf_lo(av.z); v[8 * i + 5] = bf_hi(av.z); v[8 * i + 6] = bf_lo(av.w); v[8 * i + 7] = bf_hi(av.w);
      g[8 * i + 0] = bf_lo(ag.x); g[8 * i + 1] = bf_hi(ag.x); g[8 * i + 2] = bf_lo(ag.y); g[8 * i + 3] = bf_hi(ag.y);
      g[8 * i + 4] = bf_lo(ag.z); g[8 * i + 5] = bf_hi(ag.z); g[8 * i + 6] = bf_lo(ag.w); g[8 * i + 7] = bf_hi(ag.w);
    }
    float s = 0.f;
#pragma unroll
    for (int i = 0; i < 16; ++i) s += y[i];
    s += __shfl_xor(s, 1); s += __shfl_xor(s, 2);
    const float mean = s * (1.f / 64.f);
    float q = 0.f;
#pragma unroll
    for (int i = 0; i < 16; ++i) { const float dlt = y[i] - mean; q += dlt * dlt; }
    q += __shfl_xor(q, 1); q += __shfl_xor(q, 2);
    const float rstd = rsqrtf(q * (1.f / 64.f) + 64e-5f);
    const float bonus = BON[(size_t)row * 16 + head] + BON[((size_t)MT + row) * 16 + head];
    unsigned o[8];
#pragma unroll
    for (int i = 0; i < 8; ++i) {
      const float z0 = ((y[2 * i] - mean) * rstd * gn[c0 + 2 * i] + gn[1024 + c0 + 2 * i] + bonus * v[2 * i]) * g[2 * i];
      const float z1 = ((y[2 * i + 1] - mean) * rstd * gn[c0 + 2 * i + 1] + gn[1024 + c0 + 2 * i + 1] + bonus * v[2 * i + 1]) * g[2 * i + 1];
      o[i] = pk_bf16(z0, z1);
    }
    *(u32x4*)(G + off) = mk4(o[0], o[1], o[2], o[3]);
    *(u32x4*)(G + off + 8) = mk4(o[4], o[5], o[6], o[7]);
  }
}

__device__ __forceinline__ void rglru_phase(char* lds, const bf16_t* __restrict__ XR, const bf16_t* __restrict__ Wg, const float* __restrict__ conv_w,
                            const float* __restrict__ conv_b, const float* __restrict__ gate_b, const float* __restrict__ lam,
                            bf16_t* __restrict__ HS0, bf16_t* __restrict__ HS1) {
  bf16_t* xcT = (bf16_t*)lds;
  f32x2* AB = (f32x2*)(lds + 26624);
  bf16_t* raw = (bf16_t*)(lds + 26624);
  float* segP = (float*)(lds + 116736);
  float* segH = segP + 352;
  float* segC = segH + 352;
  bf16_t* wgs = (bf16_t*)(lds + 120960);
  float* cws = (float*)(lds + 160896);
  const int tid = threadIdx.x, lane = tid & 63, wv = tid >> 6;
  for (int chain = blockIdx.x; chain < 256; chain += gridDim.x) {
    const int d = chain & 1, blk = (chain >> 1) & 15, b = chain >> 5;
    bf16_t* HS = d ? HS1 : HS0;
    float carry = 0.f;
    __syncthreads();
    for (int q = tid; q < 2 * 96 * 12; q += NTHR) {
      const int g = q / 1152, rem = q - g * 1152, n = rem / 12, k8 = rem - n * 12;
      *(u32x4*)(wgs + (g * 96 + n) * 104 + k8 * 8) = *(const u32x4*)(Wg + ((size_t)((blk * 4 + d * 2 + g) * 96 + n)) * 96 + k8 * 8);
    }
    for (int e = tid; e < 5 * 88; e += NTHR) {
      const int j = e / 88, c = e - j * 88;
      cws[e] = j < 4 ? conv_w[j * LW + blk * 88 + c] : conv_b[blk * 88 + c];
    }
    for (int e = tid; e < 128 * 8; e += NTHR) xcT[(e >> 3) * 104 + 88 + (e & 7)] = 0;
    u32x4 pre[3];
    auto tile_geom = [&](int ti, int& seqbase, int& t0, int& T) {
      if (ti < 2) { seqbase = ML + b * 256; T = 256; t0 = (d ? 1 - ti : ti) * 128; }
      else { seqbase = b * 4096; T = 4096; t0 = (d ? 31 - (ti - 2) : (ti - 2)) * 128; }
    };
    auto prefetch = [&](int ti) {
      int seqbase, t0, T; tile_geom(ti, seqbase, t0, T);
#pragma unroll
      for (int i = 0; i < 3; ++i) {
        const int q = tid + NTHR * i;
        const int row = q / 11, cc = q - row * 11, t = t0 - 2 + row;
        u32x4 v = {0u, 0u, 0u, 0u};
        if (q < 131 * 11 && t >= 0 && t < T) v = *(const u32x4*)(XR + (size_t)(seqbase + t) * LW + blk * 88 + cc * 8);
        pre[i] = v;
      }
    };
    prefetch(0);
    for (int ti = 0; ti < 34; ++ti) {
      int seqbase, t0, T; tile_geom(ti, seqbase, t0, T);
      __syncthreads();
#pragma unroll
      for (int i = 0; i < 3; ++i) {
        const int q = tid + NTHR * i;
        if (q < 131 * 11) *(u32x4*)(raw + q * 8) = pre[i];
      }
      if (ti + 1 < 34) prefetch(ti + 1);
      __builtin_amdgcn_sched_barrier(0);
      __syncthreads();
      for (int e = tid; e < 128 * 44; e += NTHR) {
        const int tl = e / 44, c2 = (e - tl * 44) * 2;
        float a0 = cws[4 * 88 + c2], a1 = cws[4 * 88 + c2 + 1];
#pragma unroll
        for (int j = 0; j < 4; ++j) {
          const unsigned x = *(const unsigned*)(raw + (tl + j) * 88 + c2);
          a0 += bf_lo(x) * cws[j * 88 + c2]; a1 += bf_hi(x) * cws[j * 88 + c2 + 1];
        }
        *(unsigned*)(xcT + tl * 104 + c2) = pk_bf16(a0, a1);
      }
      __syncthreads();
      {
        const int tok = wv * 16 + (lane & 15);
        u32x4 af[3];
#pragma unroll
        for (int kk = 0; kk < 3; ++kk) af[kk] = *(const u32x4*)(xcT + tok * 104 + kk * 32 + 8 * (lane >> 4));
#pragma unroll
        for (int n6 = 0; n6 < 6; ++n6) {
          f32x4 accr = {0.f, 0.f, 0.f, 0.f}, acci = {0.f, 0.f, 0.f, 0.f};
          const int ncol = n6 * 16 + (lane & 15);
          const bf16_t* wr_ = wgs + ncol * 104 + 8 * (lane >> 4);
          const bf16_t* wi_ = wgs + (96 + ncol) * 104 + 8 * (lane >> 4);
#pragma unroll
          for (int kk = 0; kk < 3; ++kk) {
            accr = mfma16(af[kk], *(const u32x4*)(wr_ + kk * 32), accr);
            acci = mfma16(af[kk], *(const u32x4*)(wi_ + kk * 32), acci);
          }
          if (ncol < 88) {
            const int ch = blk * 88 + ncol;
            const float gbr = gate_b[(d * 2 + 0) * LW + ch], gbi = gate_b[(d * 2 + 1) * LW + ch];
            const float spl = softplusf_(-lam[d * LW + ch]);
#pragma unroll
            for (int r = 0; r < 4; ++r) {
              const int tk = wv * 16 + (lane >> 4) * 4 + r;
              const float rg = sigmoidf_(accr[r] + gbr), ig = sigmoidf_(acci[r] + gbi);
              const float a = __expf(-8.f * rg * spl);
              const float bb = sqrtf(fmaxf(1.f - a * a, 0.f)) * ig * bf2f(xcT[tk * 104 + ncol]);
              AB[tk * 88 + ncol] = (f32x2){a, bb};
            }
          }
        }
      }
      __syncthreads();
      if (tid < 352) {
        const int seg = tid / 88, c = tid - seg * 88;
        float hl = 0.f, P = 1.f;
        for (int u0 = seg * 32; u0 < seg * 32 + 32; u0 += 8) {
          f32x2 ab[8];
#pragma unroll
          for (int i = 0; i < 8; ++i) { const int tl = d ? 127 - (u0 + i) : (u0 + i); ab[i] = AB[tl * 88 + c]; }
#pragma unroll
          for (int i = 0; i < 8; ++i) { hl = ab[i][0] * hl + ab[i][1]; P *= ab[i][0]; ab[i] = (f32x2){hl, P}; }
#pragma unroll
          for (int i = 0; i < 8; ++i) { const int tl = d ? 127 - (u0 + i) : (u0 + i); AB[tl * 88 + c] = ab[i]; }
        }
        segH[seg * 88 + c] = hl; segP[seg * 88 + c] = P;
      }
      __syncthreads();
      if (tid < 88) {
        float cur = carry;
#pragma unroll
        for (int seg = 0; seg < 4; ++seg) { segC[seg * 88 + tid] = cur; cur = segP[seg * 88 + tid] * cur + segH[seg * 88 + tid]; }
        carry = cur;
      }
      __syncthreads();
      for (int q = tid; q < 128 * 11; q += NTHR) {
        const int tl = q / 11, c8 = (q - tl * 11) * 8;
        const int u = d ? 127 - tl : tl;
        const float* sc = segC + (u >> 5) * 88 + c8;
        float hv[8];
#pragma unroll
        for (int i = 0; i < 8; ++i) { const f32x2 hp = AB[tl * 88 + c8 + i]; hv[i] = hp[0] + hp[1] * sc[i]; }
        *(u32x4*)(HS + (size_t)(seqbase + t0 + tl) * LW + blk * 88 + c8) =
            mk4(pk_bf16(hv[0], hv[1]), pk_bf16(hv[2], hv[3]), pk_bf16(hv[4], hv[5]), pk_bf16(hv[6], hv[7]));
      }
    }
  }
}

__device__ __forceinline__ void lru_z_phase(const bf16_t* __restrict__ HS0, const bf16_t* __restrict__ HS1, bf16_t* __restrict__ GG) {
  const size_t n8 = (size_t)MT * LW / 8;
  for (size_t e = (size_t)blockIdx.x * NTHR + threadIdx.x; e < n8; e += (size_t)gridDim.x * NTHR) {
    const u32x4 a = *(const u32x4*)(HS0 + e * 8), b = *(const u32x4*)(HS1 + e * 8), g = *(const u32x4*)(GG + e * 8);
    u32x4 o;
    o.x = pk_bf16((bf_lo(a.x) + bf_lo(b.x)) * bf_lo(g.x), (bf_hi(a.x) + bf_hi(b.x)) * bf_hi(g.x));
    o.y = pk_bf16((bf_lo(a.y) + bf_lo(b.y)) * bf_lo(g.y), (bf_hi(a.y) + bf_hi(b.y)) * bf_hi(g.y));
    o.z = pk_bf16((bf_lo(a.z) + bf_lo(b.z)) * bf_lo(g.z), (bf_hi(a.z) + bf_hi(b.z)) * bf_hi(g.z));
    o.w = pk_bf16((bf_lo(a.w) + bf_lo(b.w)) * bf_lo(g.w), (bf_hi(a.w) + bf_hi(b.w)) * bf_hi(g.w));
    *(u32x4*)(GG + e * 8) = o;
  }
}

__device__ __forceinline__ void nat_qk_phase(bf16_t* __restrict__ Q, bf16_t* __restrict__ Kb, bf16_t* __restrict__ QR, const float* __restrict__ qk_g) {
  const int lane = threadIdx.x & 63;
  const int gw = blockIdx.x * (NTHR / 64) + (threadIdx.x >> 6), nw = gridDim.x * (NTHR / 64);
  const int qd = lane & 3;
  float gq[16], gk[16], inv[16];
#pragma unroll
  for (int i = 0; i < 16; ++i) { gq[i] = qk_g[qd * 16 + i]; gk[i] = qk_g[64 + qd * 16 + i]; inv[i] = exp2f(-(float)i * (13.287712379549449f / 16.f)); }
  for (int row = gw; row < MT; row += nw) {
    const bool lat = row < ML;
    const size_t off = (size_t)row * 1024 + lane * 16;
    float cs[16], sn[16];
    if (lat) {
      const int t = row & 4095;
      const float pos = (float)((qd >> 1) ? (t & 63) : (t >> 6));
#pragma unroll
      for (int i = 0; i < 16; ++i) {
        float rev = pos * inv[i] * 0.15915494309189535f;
        rev -= floorf(rev);
        sn[i] = __builtin_amdgcn_sinf(rev); cs[i] = __builtin_amdgcn_cosf(rev);
      }
    }
#pragma unroll
    for (int which = 0; which < 2; ++which) {
      bf16_t* P = which ? Kb : Q;
      const u32x4 a = *(const u32x4*)(P + off), b2 = *(const u32x4*)(P + off + 8);
      const unsigned u[8] = {a.x, a.y, a.z, a.w, b2.x, b2.y, b2.z, b2.w};
      float x[16];
#pragma unroll
      for (int i = 0; i < 8; ++i) { x[2 * i] = bf_lo(u[i]); x[2 * i + 1] = bf_hi(u[i]); }
      float ss = 0.f;
#pragma unroll
      for (int i = 0; i < 16; ++i) ss += x[i] * x[i];
      ss += __shfl_xor(ss, 1); ss += __shfl_xor(ss, 2);
      const float rstd = rsqrtf(ss * (1.f / 64.f) + 1e-6f);
#pragma unroll
      for (int i = 0; i < 16; ++i) x[i] = x[i] * rstd * (which ? gk[i] : gq[i]);
      unsigned pl[8];
#pragma unroll
      for (int i = 0; i < 8; ++i) pl[i] = pk_bf16(x[2 * i], x[2 * i + 1]);
      unsigned rt[8];
      if (lat) {
        float y[16];
#pragma unroll
        for (int i = 0; i < 16; ++i) {
          const float pr = __shfl_xor(x[i], 1);
          y[i] = x[i] * cs[i] + ((qd & 1) ? pr * sn[i] : -pr * sn[i]);
        }
#pragma unroll
        for (int i = 0; i < 8; ++i) rt[i] = pk_bf16(y[2 * i], y[2 * i + 1]);
      }
      if (which == 0) {
        *(u32x4*)(Q + off) = mk4(pl[0], pl[1], pl[2], pl[3]);
        *(u32x4*)(Q + off + 8) = mk4(pl[4], pl[5], pl[6], pl[7]);
        if (lat) { *(u32x4*)(QR + off) = mk4(rt[0], rt[1], rt[2], rt[3]); *(u32x4*)(QR + off + 8) = mk4(rt[4], rt[5], rt[6], rt[7]); }
      } else {
        if (lat) { *(u32x4*)(Kb + off) = mk4(rt[0], rt[1], rt[2], rt[3]); *(u32x4*)(Kb + off + 8) = mk4(rt[4], rt[5], rt[6], rt[7]); }
        else { *(u32x4*)(Kb + off) = mk4(pl[0], pl[1], pl[2], pl[3]); *(u32x4*)(Kb + off + 8) = mk4(pl[4], pl[5], pl[6], pl[7]); }
      }
    }
  }
}

struct AttnState { f32x16 O[2][2]; float m[2], l[2]; };

template <bool BAND>
DEVI void attn_chunk(AttnState& st, const u32x4 (&qf)[2][4], const bf16_t* __restrict__ kbase, const bf16_t* __restrict__ vtbase, int vtT,
                     const float* __restrict__ rpbs, int brow, int half, int lane) {
  const int l31 = lane & 31, lh = lane >> 5;
  u32x4 kf[4];
#pragma unroll
  for (int ks = 0; ks < 4; ++ks) kf[ks] = *(const u32x4*)(kbase + (size_t)l31 * 1024 + ks * 16 + 8 * lh);
  constexpr float SC = 0.125f * 1.4426950408889634f;
  u32x4 pf[2][2];
#pragma unroll
  for (int qt = 0; qt < 2; ++qt) {
    f32x16 S;
#pragma unroll
    for (int r = 0; r < 16; ++r) S[r] = 0.f;
#pragma unroll
    for (int ks = 0; ks < 4; ++ks) S = mfma32(kf[ks], qf[qt][ks], S);
    float cmax = -INFINITY;
    if (BAND) {
      const int qc = qt * 32 + l31;
      const int cst = min(max(qc - 8, 0), 48);
#pragma unroll
      for (int r = 0; r < 16; ++r) {
        const int key = (r & 3) + 8 * (r >> 2) + 4 * lh;
        const int kc = half * 32 + key;
        const bool ok = (kc >= cst) && (kc < cst + 16);
        const int bi = ok ? (brow * 31 + kc - qc + 15) : 0;
        const float sv = S[r] * SC + rpbs[bi];
        S[r] = ok ? sv : -INFINITY;
        cmax = fmaxf(cmax, S[r]);
      }
    } else {
#pragma unroll
      for (int r = 0; r < 16; ++r) { S[r] *= SC; cmax = fmaxf(cmax, S[r]); }
    }
    cmax = fmaxf(cmax, __shfl_xor(cmax, 32));
    const float mnew = fmaxf(st.m[qt], cmax);
    const float alpha = exp2f(st.m[qt] - mnew);
    st.m[qt] = mnew;
    float ps = 0.f;
#pragma unroll
    for (int r = 0; r < 16; ++r) { S[r] = exp2f(S[r] - mnew); ps += S[r]; }
    st.l[qt] = st.l[qt] * alpha + ps;
#pragma unroll
    for (int dt = 0; dt < 2; ++dt)
#pragma unroll
      for (int r = 0; r < 16; ++r) st.O[qt][dt][r] *= alpha;
    pf[qt][0] = mk4(pk_bf16(S[0], S[1]), pk_bf16(S[2], S[3]), pk_bf16(S[4], S[5]), pk_bf16(S[6], S[7]));
    pf[qt][1] = mk4(pk_bf16(S[8], S[9]), pk_bf16(S[10], S[11]), pk_bf16(S[12], S[13]), pk_bf16(S[14], S[15]));
  }
#pragma unroll
  for (int dt = 0; dt < 2; ++dt)
#pragma unroll
    for (int s = 0; s < 2; ++s) {
      const bf16_t* vp = vtbase + (size_t)(dt * 32 + l31) * vtT + 16 * s + 4 * lh;
      const u32x2 lo = *(const u32x2*)vp, hi = *(const u32x2*)(vp + 8);
      const u32x4 vf = mk4(lo.x, lo.y, hi.x, hi.y);
      st.O[0][dt] = mfma32(vf, pf[0][s], st.O[0][dt]);
      st.O[1][dt] = mfma32(vf, pf[1][s], st.O[1][dt]);
    }
}

__device__ __forceinline__ void natten_phase(char* lds, const bf16_t* __restrict__ Q, const bf16_t* __restrict__ QR, const bf16_t* __restrict__ Kb,
                             const bf16_t* __restrict__ VT, bf16_t* __restrict__ G, const float* __restrict__ rpb) {
  float* rpbs = (float*)lds;
  __syncthreads();
  for (int e = threadIdx.x; e < 16 * 465; e += NTHR) rpbs[e] = rpb[e] * 1.4426950408889634f;
  __syncthreads();
  const int lane = threadIdx.x & 63, l31 = lane & 31, lh = lane >> 5;
  const int gw = blockIdx.x * (NTHR / 64) + (threadIdx.x >> 6), nw = gridDim.x * (NTHR / 64);
  const bf16_t* VTC = VT + (size_t)ML * 1024;
  for (int item = gw; item < 8192 + 512; item += nw) {
    const bool lat = item < 8192;
    int b, h, r = 0, qrow0;
    if (lat) { h = item & 15; r = (item >> 4) & 63; b = item >> 10; qrow0 = b * 4096 + r * 64; }
    else { const int it = item - 8192; h = it & 15; const int qt64 = (it >> 4) & 3; b = it >> 6; qrow0 = ML + b * 256 + qt64 * 64; }
    AttnState st;
#pragma unroll
    for (int a = 0; a < 2; ++a) { st.m[a] = -INFINITY; st.l[a] = 0.f;
#pragma unroll
      for (int c = 0; c < 2; ++c)
#pragma unroll
        for (int rr = 0; rr < 16; ++rr) st.O[a][c][rr] = 0.f; }
    u32x4 qf[2][4];
#pragma unroll
    for (int qt = 0; qt < 2; ++qt)
#pragma unroll
      for (int ks = 0; ks < 4; ++ks) qf[qt][ks] = *(const u32x4*)(Q + (size_t)(qrow0 + qt * 32 + l31) * 1024 + h * 64 + ks * 16 + 8 * lh);
    for (int kc = 0; kc < 8; ++kc) {
      const bf16_t* kbase = Kb + (size_t)(ML + b * 256 + kc * 32) * 1024 + h * 64;
      const bf16_t* vtb = VTC + (size_t)(b * 16 + h) * 64 * 256 + kc * 32;
      attn_chunk<false>(st, qf, kbase, vtb, 256, rpbs, 0, 0, lane);
    }
    if (lat) {
#pragma unroll
      for (int qt = 0; qt < 2; ++qt)
#pragma unroll
        for (int ks = 0; ks < 4; ++ks) qf[qt][ks] = *(const u32x4*)(QR + (size_t)(qrow0 + qt * 32 + l31) * 1024 + h * 64 + ks * 16 + 8 * lh);
      const int start = min(max(r - 4, 0), 56);
      for (int i = 0; i < 16; ++i) {
        const int kr = start + (i >> 1), half = i & 1;
        const bf16_t* kbase = Kb + (size_t)(b * 4096 + kr * 64 + half * 32) * 1024 + h * 64;
        const bf16_t* vtb = VT + (size_t)(b * 16 + h) * 64 * 4096 + kr * 64 + half * 32;
        attn_chunk<true>(st, qf, kbase, vtb, 4096, rpbs, h * 15 + (kr - r + 7), half, lane);
      }
    }
#pragma unroll
    for (int qt = 0; qt < 2; ++qt) {
      const float lt = st.l[qt] + __shfl_xor(st.l[qt], 32);
      const float inv = 1.f / lt;
      bf16_t* grow = G + (size_t)(qrow0 + qt * 32 + l31) * 1024 + h * 64;
#pragma unroll
      for (int dt = 0; dt < 2; ++dt)
#pragma unroll
        for (int q4 = 0; q4 < 4; ++q4) {
          bf16_t* gp = grow + dt * 32 + 8 * q4 + 4 * lh;
          const u32x2 gv = *(const u32x2*)gp;
          u32x2 o;
          o.x = pk_bf16(st.O[qt][dt][4 * q4] * inv * bf_lo(gv.x), st.O[qt][dt][4 * q4 + 1] * inv * bf_hi(gv.x));
          o.y = pk_bf16(st.O[qt][dt][4 * q4 + 2] * inv * bf_lo(gv.y), st.O[qt][dt][4 * q4 + 3] * inv * bf_hi(gv.y));
          *(u32x2*)gp = o;
        }
    }
  }
}

template <int ph>
__device__ __forceinline__ void run_phase(const Params& p, char* lds) {
  char* ws = p.ws;
  const float* MOD = (const float*)(ws + OFF_MOD);
  float* XC = (float*)(ws + OFF_XC);
  bf16_t* HB = (bf16_t*)(ws + OFF_HB);
  bf16_t* A0 = (bf16_t*)(ws + OFF_A0); bf16_t* A1 = (bf16_t*)(ws + OFF_A1); bf16_t* A2 = (bf16_t*)(ws + OFF_A2);
  bf16_t* A3 = (bf16_t*)(ws + OFF_A3); bf16_t* A4 = (bf16_t*)(ws + OFF_A4);
  bf16_t* WD = (bf16_t*)(ws + OFF_WD); bf16_t* AD = (bf16_t*)(ws + OFF_AD);
  float* BON = (float*)(ws + OFF_BON);
  if (ph == 0) { phase0(p, lds); return; }
  constexpr int layer = (ph - 1) / 5, sub = (ph - 1) % 5;
  const float* modL = MOD + (size_t)layer * 9 * 3072;
  const float* xl_cur = layer == 0 ? p.in[0] : p.out;
  const float* xc_cur = layer == 0 ? p.in[2] : XC;
  if (layer == 0 || layer == 3) {
    const int ib = layer ? 33 : 4;
    const bf16_t* WIN = (const bf16_t*)(ws + (layer ? OFF_W3IN : OFF_W0IN));
    const bf16_t* WUP = (const bf16_t*)(ws + (layer ? OFF_W3UP : OFF_W0UP));
    const bf16_t* WOUT = (const bf16_t*)(ws + (layer ? OFF_W3OUT : OFF_W0OUT));
    if (sub == 0) norm_phase<true>(xl_cur, xc_cur, p.in[ib], modL, HB, A4);
    else if (sub == 1) { ALMix al{HB, A4, p.in[ib + 4]}; EpRwkvIn ep{A0, A1, A2, A3, WD, AD}; gemm_phase(lds, WIN, 1024, MT / 256, 34, al, ep); }
    else if (sub == 2) rwkv_scan_phase(lds, A0, A1, A2, WD, AD, WUP, p.in[ib + 5], p.in[ib + 8], p.in[ib + 9], HB, A4, BON);
    else if (sub == 3) rwkv_post_phase(HB, A4, A2, A3, BON, p.in[ib + 10], layer == 3 ? ML : MT);
    else { ALPlain al{A3, 1024}; EpRes ep{xl_cur, xc_cur, p.out, XC, modL}; gemm_phase(lds, WOUT, 1024, (layer == 3 ? ML : MT) / 256, 8, al, ep); }
  } else if (layer == 1) {
    bf16_t* HS0 = (bf16_t*)(ws + OFF_HS0); bf16_t* XR = (bf16_t*)(ws + OFF_XR); bf16_t* GG = (bf16_t*)(ws + OFF_GG); bf16_t* HS1 = (bf16_t*)(ws + OFF_HS1);
    if (sub == 0) norm_phase<false>(xl_cur, xc_cur, p.in[16], modL, HB, nullptr);
    else if (sub == 1) { ALPlain al{HB, 1024}; EpLruIn ep{XR, GG}; gemm_phase(lds, (const bf16_t*)(ws + OFF_W1IN), 1024, MT / 256, 22, al, ep); }
    else if (sub == 2) rglru_phase(lds, XR, (const bf16_t*)(ws + OFF_W1G), p.in[20], p.in[21], p.in[23], p.in[24], HS0, HS1);
    else if (sub == 3) lru_z_phase(HS0, HS1, GG);
    else { ALPlain al{GG, LW}; EpRes ep{xl_cur, xc_cur, p.out, XC, modL}; gemm_phase(lds, (const bf16_t*)(ws + OFF_W1OUT), LW, MT / 256, 8, al, ep); }
  } else {
    if (sub == 0) norm_phase<false>(xl_cur, xc_cur, p.in[26], modL, HB, nullptr);
    else if (sub == 1) { ALPlain al{HB, 1024}; EpNatIn ep{A0, A1, A2, A3}; gemm_phase(lds, (const bf16_t*)(ws + OFF_W2IN), 1024, MT / 256, 32, al, ep); }
    else if (sub == 2) nat_qk_phase(A0, A1, A4, p.in[30]);
    else if (sub == 3) natten_phase(lds, A0, A4, A1, A2, A3, p.in[31]);
    else { ALPlain al{A3, 1024}; EpRes ep{xl_cur, xc_cur, p.out, XC, modL}; gemm_phase(lds, (const bf16_t*)(ws + OFF_W2OUT), 1024, MT / 256, 8, al, ep); }
  }
}

__global__ void __launch_bounds__(NTHR) mega_kernel(Params p) {
  __shared__ __attribute__((aligned(16))) char lds[LDS_BYTES];
  cg::grid_group grid = cg::this_grid();
#define PHASE(k) if (p.ph_lo <= k && k < p.ph_hi) { for (int rep = 0; rep < REP[k]; ++rep) { run_phase<k>(p, lds); if (rep + 1 < REP[k] || k + 1 < p.ph_hi) grid.sync(); } }
  PHASE(0) PHASE(1) PHASE(2) PHASE(3) PHASE(4) PHASE(5) PHASE(6) PHASE(7) PHASE(8) PHASE(9) PHASE(10)
  PHASE(11) PHASE(12) PHASE(13) PHASE(14) PHASE(15) PHASE(16) PHASE(17) PHASE(18) PHASE(19) PHASE(20)
#undef PHASE
}

extern "C" void kernel_launch(void* const* d_in, const int* in_sizes, int n_in, void* d_out, int out_size, void* d_ws, size_t ws_size,
                              hipStream_t stream) {
  static int grid_blocks = 0;
  if (!grid_blocks) {
    int dev = 0, cus = 0, per_cu = 0;
    hipGetDevice(&dev);
    hipDeviceGetAttribute(&cus, hipDeviceAttributeMultiprocessorCount, dev);
    hipOccupancyMaxActiveBlocksPerMultiprocessor(&per_cu, mega_kernel, NTHR, 0);
    if (per_cu < 1) { fprintf(stderr, "occupancy query returned %d\n", per_cu); per_cu = 1; }
    if (per_cu > 1) per_cu = 1;
    grid_blocks = cus * per_cu;
    if (n_in != 45 || ws_size < WS_END) fprintf(stderr, "unexpected n_in %d / ws %zu (need %zu)\n", n_in, ws_size, (size_t)WS_END);
  }
  Params p{};
  for (int i = 0; i < 45; ++i) p.in[i] = (const float*)d_in[i];
  p.out = (float*)d_out;
  p.ws = (char*)d_ws;
#if N_LAUNCH_MODE == 1
  p.ph_lo = 0; p.ph_hi = NPHASE;
  void* args[] = {&p};
  hipError_t e = hipLaunchCooperativeKernel((void*)mega_kernel, dim3(grid_blocks), dim3(NTHR), args, 0, stream);
  if (e != hipSuccess) fprintf(stderr, "cooperative launch failed: %s (grid %d)\n", hipGetErrorString(e), grid_blocks);
#else
  for (int ph = 0; ph < NPHASE; ++ph) {
    p.ph_lo = ph; p.ph_hi = ph + 1;
    hipLaunchKernelGGL(mega_kernel, dim3(grid_blocks), dim3(NTHR), 0, stream, p);
  }
#endif
}
```

```cpp
#include <hip/hip_runtime.h>
#include <hip/hip_cooperative_groups.h>
#include <cstdio>
#include <cstdint>
namespace cg = cooperative_groups;

#ifndef N_LAUNCH_MODE
#define N_LAUNCH_MODE 1
#endif

typedef unsigned short bf16_t;
typedef short bf16x8 __attribute__((ext_vector_type(8)));
typedef float f32x4 __attribute__((ext_vector_type(4)));
typedef float f32x16 __attribute__((ext_vector_type(16)));
typedef float f32x2 __attribute__((ext_vector_type(2)));
typedef unsigned u32x4 __attribute__((ext_vector_type(4)));
typedef unsigned u32x2 __attribute__((ext_vector_type(2)));

#define DEVI __device__ __forceinline__

constexpr int D = 1024, NB = 8, SEQ = 4096, CTX = 256;
constexpr int ML = NB * SEQ;
constexpr int MC = NB * CTX;
constexpr int MT = ML + MC;
constexpr int LW = 1408;
constexpr int NTHR = 512;
constexpr int NPHASE = 21;
constexpr int LDS_BYTES = 163840;
__device__ constexpr int REP[21] = {1,1,1,1,1,1,1,1,1,1,1,1,1,1,1,1,1,1,1,1,1};

constexpr size_t SZ_ACT = (size_t)MT * 1024 * 2;
constexpr size_t OFF_MOD = 0;
constexpr size_t OFF_W0IN = 524288;
constexpr size_t SZ_RWIN = (size_t)4352 * 1024 * 2;
constexpr size_t SZ_RWUP = (size_t)4 * 1024 * 64 * 2;
constexpr size_t SZ_SQ = (size_t)1024 * 1024 * 2;
constexpr size_t OFF_W0UP = OFF_W0IN + SZ_RWIN;
constexpr size_t OFF_W0OUT = OFF_W0UP + SZ_RWUP;
constexpr size_t OFF_W3IN = OFF_W0OUT + SZ_SQ;
constexpr size_t OFF_W3UP = OFF_W3IN + SZ_RWIN;
constexpr size_t OFF_W3OUT = OFF_W3UP + SZ_RWUP;
constexpr size_t OFF_W1IN = OFF_W3OUT + SZ_SQ;
constexpr size_t OFF_W1G = OFF_W1IN + (size_t)2816 * 1024 * 2;
constexpr size_t OFF_W1OUT = OFF_W1G + (size_t)16 * 4 * 96 * 96 * 2;
constexpr size_t OFF_W2IN = OFF_W1OUT + (size_t)1024 * 1408 * 2;
constexpr size_t OFF_W2OUT = OFF_W2IN + (size_t)4096 * 1024 * 2;
constexpr size_t OFF_XC = OFF_W2OUT + SZ_SQ;
constexpr size_t OFF_BON = OFF_XC + (size_t)MC * 1024 * 4;
constexpr size_t OFF_BIG = OFF_BON + (size_t)2 * MT * 16 * 4;
constexpr size_t OFF_HB = OFF_BIG;
constexpr size_t OFF_A0 = OFF_BIG + SZ_ACT;
constexpr size_t OFF_A1 = OFF_A0 + SZ_ACT;
constexpr size_t OFF_A2 = OFF_A1 + SZ_ACT;
constexpr size_t OFF_A3 = OFF_A2 + SZ_ACT;
constexpr size_t OFF_A4 = OFF_A3 + SZ_ACT;
constexpr size_t OFF_WD = OFF_A4 + SZ_ACT;
constexpr size_t OFF_AD = OFF_WD + (size_t)MT * 128 * 2;
constexpr size_t WS_END = OFF_AD + (size_t)MT * 128 * 2;
constexpr size_t SZ_LRU = (size_t)MT * LW * 2;
constexpr size_t OFF_HS0 = OFF_BIG;
constexpr size_t OFF_XR = OFF_BIG + SZ_LRU;
constexpr size_t OFF_GG = OFF_XR + SZ_LRU;
constexpr size_t OFF_HS1 = OFF_GG + SZ_LRU;
static_assert(OFF_HS1 + SZ_LRU <= WS_END, "lru overlay");
static_assert(WS_END <= (size_t)536870912, "ws");

struct Params {
  const float* in[45];
  float* out;
  char* ws;
  int ph_lo, ph_hi;
};

DEVI u32x4 mk4(unsigned a, unsigned b, unsigned c, unsigned d) { u32x4 r = {a, b, c, d}; return r; }
DEVI float bf_lo(unsigned u) { return __uint_as_float(u << 16); }
DEVI float bf_hi(unsigned u) { return __uint_as_float(u & 0xffff0000u); }
DEVI float bf2f(bf16_t h) { return __uint_as_float(((unsigned)h) << 16); }
DEVI unsigned pk_bf16(float lo, float hi) { unsigned r; asm("v_cvt_pk_bf16_f32 %0, %1, %2" : "=v"(r) : "v"(lo), "v"(hi)); return r; }
DEVI bf16_t f2bf(float f) { return (bf16_t)(pk_bf16(f, 0.f) & 0xffffu); }
DEVI float wave_sum(float v) {
#pragma unroll
  for (int o = 32; o; o >>= 1) v += __shfl_xor(v, o);
  return v;
}
DEVI float sigmoidf_(float x) { return __builtin_amdgcn_rcpf(1.f + __expf(-x)); }
DEVI float siluf_(float x) { return x * __builtin_amdgcn_rcpf(1.f + __expf(-x)); }
DEVI float softplusf_(float x) { return fmaxf(x, 0.f) + __logf(1.f + __expf(-fabsf(x))); }
DEVI f32x16 mfma32(u32x4 a, u32x4 b, f32x16 c) {
  return __builtin_amdgcn_mfma_f32_32x32x16_bf16(__builtin_bit_cast(bf16x8, a), __builtin_bit_cast(bf16x8, b), c, 0, 0, 0);
}
DEVI f32x4 mfma16(u32x4 a, u32x4 b, f32x4 c) {
  return __builtin_amdgcn_mfma_f32_16x16x32_bf16(__builtin_bit_cast(bf16x8, a), __builtin_bit_cast(bf16x8, b), c, 0, 0, 0);
}
template <int CTRL> DEVI float dpp_f(float v) {
  return __int_as_float(__builtin_amdgcn_update_dpp(0, __float_as_int(v), CTRL, 0xf, 0xf, true));
}
DEVI float sum8(float v) {
  v += dpp_f<0xB1>(v);
  v += dpp_f<0x4E>(v);
  v += dpp_f<0x141>(v);
  return v;
}

struct TJob { const float* src; int K, N; bf16_t* dst; int ldd; };

DEVI TJob get_tjob(const Params& p, int j) {
  TJob t;
  if (j < 26) {
    const int l = j / 13, jj = j % 13;
    const int ib = l ? 33 : 4;
    bf16_t* win = (bf16_t*)(p.ws + (l ? OFF_W3IN : OFF_W0IN));
    bf16_t* wup = (bf16_t*)(p.ws + (l ? OFF_W3UP : OFF_W0UP));
    bf16_t* wout = (bf16_t*)(p.ws + (l ? OFF_W3OUT : OFF_W0OUT));
    if (jj < 4) { t.src = p.in[ib + 3] + (size_t)jj * 1048576; t.K = 1024; t.N = 1024; t.dst = win + (size_t)jj * 1048576; t.ldd = 1024; }
    else if (jj < 8) { const int idx = jj - 4, d = idx >> 1, kind = idx & 1;
      t.src = p.in[ib + 6] + (size_t)idx * 65536; t.K = 1024; t.N = 64; t.dst = win + (size_t)(4096 + kind * 128 + d * 64) * 1024; t.ldd = 1024; }
    else if (jj < 12) { const int idx = jj - 8;
      t.src = p.in[ib + 7] + (size_t)idx * 65536; t.K = 64; t.N = 1024; t.dst = wup + (size_t)idx * 65536; t.ldd = 64; }
    else { t.src = p.in[ib + 11]; t.K = 1024; t.N = 1024; t.dst = wout; t.ldd = 1024; }
  } else if (j == 26) { t.src = p.in[19]; t.K = 1024; t.N = 2816; t.dst = (bf16_t*)(p.ws + OFF_W1IN); t.ldd = 1024; }
  else if (j == 27) { t.src = p.in[25]; t.K = 1408; t.N = 1024; t.dst = (bf16_t*)(p.ws + OFF_W1OUT); t.ldd = 1408; }
  else if (j == 28) { t.src = p.in[29]; t.K = 1024; t.N = 4096; t.dst = (bf16_t*)(p.ws + OFF_W2IN); t.ldd = 1024; }
  else { t.src = p.in[32]; t.K = 1024; t.N = 1024; t.dst = (bf16_t*)(p.ws + OFF_W2OUT); t.ldd = 1024; }
  return t;
}

__device__ __forceinline__ void phase0(const Params& p, char* lds) {
  const int tid = threadIdx.x;
  {
    bf16_t* wg = (bf16_t*)(p.ws + OFF_W1G);
    const float* gw = p.in[22];
    const int total = 16 * 4 * 96 * 96;
    for (int e = blockIdx.x * NTHR + tid; e < total; e += gridDim.x * NTHR) {
      const int k = e % 96, n = (e / 96) % 96, dg = (e / 9216) & 3, blk = e / 36864;
      float v = 0.f;
      if (k < 88 && n < 88) v = gw[((size_t)(dg * 16 + blk) * 88 + k) * 88 + n];
      wg[e] = f2bf(v);
    }
  }
  constexpr int N_MOD_ITEMS = 96;
  constexpr int N_TILES = 5152;
  float* act = (float*)lds;
  float* red = (float*)(lds + 36864);
  float* tl = (float*)lds;
  for (int item = blockIdx.x; item < N_MOD_ITEMS + N_TILES; item += gridDim.x) {
    __syncthreads();
    if (item < N_MOD_ITEMS) {
      const int L = item / 24, nc = item % 24;
      const int ib = (L == 0) ? 4 : (L == 1) ? 16 : (L == 2) ? 26 : 33;
      const float* ada_w = p.in[ib + 1];
      const float* ada_b = p.in[ib + 2];
      for (int e = tid; e < 9 * 1024; e += NTHR) {
        const int i = e >> 10, k = e & 1023;
        const float c = (i < 8) ? p.in[1][i * 1024 + k] : p.in[3][k];
        act[e] = siluf_(c);
      }
      __syncthreads();
      const int kq = tid >> 7, nl = tid & 127, n = nc * 128 + nl;
      float acc[9];
#pragma unroll
      for (int i = 0; i < 9; ++i) acc[i] = 0.f;
      for (int k = kq * 256; k < kq * 256 + 256; ++k) {
        const float w = ada_w[(size_t)k * 3072 + n];
#pragma unroll
        for (int i = 0; i < 9; ++i) acc[i] += act[i * 1024 + k] * w;
      }
#pragma unroll
      for (int i = 0; i < 9; ++i) red[(kq * 9 + i) * 128 + nl] = acc[i];
      __syncthreads();
      float* mod = (float*)(p.ws + OFF_MOD) + (size_t)L * 9 * 3072;
      for (int e = tid; e < 9 * 128; e += NTHR) {
        const int i = e >> 7, c = e & 127;
        const float s = red[(0 * 9 + i) * 128 + c] + red[(1 * 9 + i) * 128 + c] + red[(2 * 9 + i) * 128 + c] + red[(3 * 9 + i) * 128 + c];
        mod[i * 3072 + nc * 128 + c] = s + ada_b[nc * 128 + c];
      }
    } else {
      int t = item - N_MOD_ITEMS;
      int j = 0;
      TJob job = get_tjob(p, 0);
      for (;;) {
        const int nt = (job.K >> 6) * (job.N >> 6);
        if (t < nt) break;
        t -= nt; ++j; job = get_tjob(p, j);
      }
      const int ntn = job.N >> 6;
      const int k0 = (t / ntn) * 64, n0 = (t % ntn) * 64;
#pragma unroll
      for (int i = 0; i < 2; ++i) {
        const int k = (tid >> 4) + 32 * i, n4 = (tid & 15) * 4;
        const float4 v = *(const float4*)(job.src + (size_t)(k0 + k) * job.N + n0 + n4);
        tl[k * 65 + n4 + 0] = v.x; tl[k * 65 + n4 + 1] = v.y; tl[k * 65 + n4 + 2] = v.z; tl[k * 65 + n4 + 3] = v.w;
      }
      __syncthreads();
      const int n = tid >> 3, k8 = (tid & 7) * 8;
      u32x4 o;
      o.x = pk_bf16(tl[(k8 + 0) * 65 + n], tl[(k8 + 1) * 65 + n]);
      o.y = pk_bf16(tl[(k8 + 2) * 65 + n], tl[(k8 + 3) * 65 + n]);
      o.z = pk_bf16(tl[(k8 + 4) * 65 + n], tl[(k8 + 5) * 65 + n]);
      o.w = pk_bf16(tl[(k8 + 6) * 65 + n], tl[(k8 + 7) * 65 + n]);
      *(u32x4*)(job.dst + (size_t)(n0 + n) * job.ldd + k0 + k8) = o;
    }
  }
}

DEVI void norm_row(const float* __restrict__ xr, const float* __restrict__ g, const float* __restrict__ mod, int lane, float (&h)[16]) {
  float4 x[4];
  float ss = 0.f;
#pragma unroll
  for (int i = 0; i < 4; ++i) {
    x[i] = *(const float4*)(xr + lane * 4 + 256 * i);
    ss += x[i].x * x[i].x + x[i].y * x[i].y + x[i].z * x[i].z + x[i].w * x[i].w;
  }
  ss = wave_sum(ss);
  const float rstd = rsqrtf(ss * (1.f / 1024.f) + 1e-6f);
#pragma unroll
  for (int i = 0; i < 4; ++i) {
    const int c = lane * 4 + 256 * i;
    const float4 gg = *(const float4*)(g + c);
    const float4 sh = *(const float4*)(mod + c);
    const float4 sc = *(const float4*)(mod + 1024 + c);
    h[i * 4 + 0] = x[i].x * rstd * gg.x * (1.f + sc.x) + sh.x;
    h[i * 4 + 1] = x[i].y * rstd * gg.y * (1.f + sc.y) + sh.y;
    h[i * 4 + 2] = x[i].z * rstd * gg.z * (1.f + sc.z) + sh.z;
    h[i * 4 + 3] = x[i].w * rstd * gg.w * (1.f + sc.w) + sh.w;
  }
}

template <bool WITH_HS>
__device__ __forceinline__ void norm_phase(const float* __restrict__ xl, const float* __restrict__ xc, const float* __restrict__ g,
                           const float* __restrict__ modL, bf16_t* __restrict__ H, bf16_t* __restrict__ HS) {
  const int lane = threadIdx.x & 63;
  const int gw = blockIdx.x * (NTHR / 64) + (threadIdx.x >> 6), nw = gridDim.x * (NTHR / 64);
  for (int row = gw; row < MT; row += nw) {
    const bool lat = row < ML;
    const float* xbase = lat ? xl + (size_t)row * 1024 : xc + (size_t)(row - ML) * 1024;
    const float* mod = modL + (lat ? (row >> 12) : 8) * 3072;
    float h[16];
    norm_row(xbase, g, mod, lane, h);
#pragma unroll
    for (int i = 0; i < 4; ++i) {
      u32x2 o; o.x = pk_bf16(h[i * 4], h[i * 4 + 1]); o.y = pk_bf16(h[i * 4 + 2], h[i * 4 + 3]);
      *(u32x2*)(H + (size_t)row * 1024 + lane * 4 + 256 * i) = o;
    }
    if (WITH_HS) {
      const int t = lat ? (row & 4095) : ((row - ML) & 255);
      const int T = lat ? 4096 : 256;
      float s[16];
#pragma unroll
      for (int i = 0; i < 16; ++i) s[i] = 0.f;
      if (t > 0) { float hp[16]; norm_row(xbase - 1024, g, mod, lane, hp);
#pragma unroll
        for (int i = 0; i < 16; ++i) s[i] += hp[i]; }
      if (t < T - 1) { float hn[16]; norm_row(xbase + 1024, g, mod, lane, hn);
#pragma unroll
        for (int i = 0; i < 16; ++i) s[i] += hn[i]; }
#pragma unroll
      for (int i = 0; i < 4; ++i) {
        u32x2 o; o.x = pk_bf16(0.5f * s[i * 4], 0.5f * s[i * 4 + 1]); o.y = pk_bf16(0.5f * s[i * 4 + 2], 0.5f * s[i * 4 + 3]);
        *(u32x2*)(HS + (size_t)row * 1024 + lane * 4 + 256 * i) = o;
      }
    }
  }
}

struct ALPlain {
  const bf16_t* A; int lda;
  typedef u32x4 Regs;
  DEVI void stage(float*, int) const {}
  DEVI void issue(Regs& r, int row, int k) const { r = *(const u32x4*)(A + (size_t)row * lda + k); }
  DEVI u32x4 finish(const Regs& r, const float*, int) const { return r; }
};
struct ALMix {
  const bf16_t* H; const bf16_t* HS; const float* mu;
  struct Regs { u32x4 h, s; };
  DEVI void stage(float* sMu, int n0) const {
    const int grp = n0 >> 10;
    const int j = grp == 0 ? 0 : grp == 1 ? 2 : grp == 2 ? 3 : grp == 3 ? 5 : (n0 - 4096) < 128 ? 1 : 4;
    for (int e = threadIdx.x; e < 1024; e += NTHR) sMu[e] = mu[j * 1024 + e];
  }
  DEVI void issue(Regs& r, int row, int k) const {
    r.h = *(const u32x4*)(H + (size_t)row * 1024 + k);
    r.s = *(const u32x4*)(HS + (size_t)row * 1024 + k);
  }
  DEVI unsigned mix2(unsigned h, unsigned s, float m0, float m1) const {
    const float h0 = bf_lo(h), h1 = bf_hi(h), s0 = bf_lo(s), s1 = bf_hi(s);
    return pk_bf16(h0 + (s0 - h0) * m0, h1 + (s1 - h1) * m1);
  }
  DEVI u32x4 finish(const Regs& r, const float* sMu, int k) const {
    const float4 ma = *(const float4*)(sMu + k), mb = *(const float4*)(sMu + k + 4);
    u32x4 o;
    o.x = mix2(r.h.x, r.s.x, ma.x, ma.y); o.y = mix2(r.h.y, r.s.y, ma.z, ma.w);
    o.z = mix2(r.h.z, r.s.z, mb.x, mb.y); o.w = mix2(r.h.w, r.s.w, mb.z, mb.w);
    return o;
  }
};

template <class AL, class EP>
__device__ __forceinline__ void gemm_phase(char* lds, const bf16_t* __restrict__ Bt, int K, int mtiles, int ntiles, const AL al, const EP ep, int n_base = 0, bool reverse = false) {
  bf16_t* sA = (bf16_t*)lds;
  bf16_t* sB = (bf16_t*)(lds + 73728);
  float* sMu = (float*)(lds + 110592);
  const int tid = threadIdx.x, lane = tid & 63, wv = tid >> 6, wm = wv >> 1, wn = wv & 1;
  const int l31 = lane & 31, lh = lane >> 5;
  const int nk = K >> 6;
  const int ldrow = tid >> 3, ldk = (tid & 7) * 8;
  const int total = mtiles * ntiles;
  const int bid = reverse ? (int)(gridDim.x - 1 - blockIdx.x) : (int)blockIdx.x;
  const int nslots = gridDim.x >> 3, xcd = bid & 7, slot = bid >> 3;
  const int gm = 4 * ntiles;
  for (int chunk = xcd; chunk * nslots < total; chunk += 8) {
    const int tile = chunk * nslots + slot;
    if (tile >= total) break;
    const int grp = tile / gm, rem = tile - grp * gm;
    const int mt = grp * 4 + (rem & 3), nt = rem >> 2;
    const int m0 = mt * 256, n0 = n_base + nt * 128;
    __syncthreads();
    al.stage(sMu, n0);
    f32x16 acc[2][2];
#pragma unroll
    for (int a = 0; a < 2; ++a)
#pragma unroll
      for (int b = 0; b < 2; ++b)
#pragma unroll
        for (int r = 0; r < 16; ++r) acc[a][b][r] = 0.f;
    typename AL::Regs ar[4];
    u32x4 br[2];
#pragma unroll
    for (int i = 0; i < 4; ++i) al.issue(ar[i], m0 + ldrow + 64 * i, ldk);
#pragma unroll
    for (int i = 0; i < 2; ++i) br[i] = *(const u32x4*)(Bt + (size_t)(n0 + ldrow + 64 * i) * K + ldk);
    __syncthreads();
#pragma unroll
    for (int i = 0; i < 4; ++i) *(u32x4*)(sA + (ldrow + 64 * i) * 72 + ldk) = al.finish(ar[i], sMu, ldk);
#pragma unroll
    for (int i = 0; i < 2; ++i) *(u32x4*)(sB + (ldrow + 64 * i) * 72 + ldk) = br[i];
    __syncthreads();
    for (int kt = 0; kt < nk; ++kt) {
      const int cur = kt & 1;
      const bool more = (kt + 1) < nk;
      const int k0n = (kt + 1) * 64 + ldk;
      if (more) {
#pragma unroll
        for (int i = 0; i < 4; ++i) al.issue(ar[i], m0 + ldrow + 64 * i, k0n);
#pragma unroll
        for (int i = 0; i < 2; ++i) br[i] = *(const u32x4*)(Bt + (size_t)(n0 + ldrow + 64 * i) * K + k0n);
      }
      __builtin_amdgcn_sched_barrier(0);
      const bf16_t* a_ = sA + cur * (256 * 72);
      const bf16_t* b_ = sB + cur * (128 * 72);
#pragma unroll
      for (int kk = 0; kk < 4; ++kk) {
        u32x4 af[2], bfr[2];
#pragma unroll
        for (int mi = 0; mi < 2; ++mi) af[mi] = *(const u32x4*)(a_ + (wm * 64 + mi * 32 + l31) * 72 + kk * 16 + lh * 8);
#pragma unroll
        for (int ni = 0; ni < 2; ++ni) bfr[ni] = *(const u32x4*)(b_ + (wn * 64 + ni * 32 + l31) * 72 + kk * 16 + lh * 8);
#pragma unroll
        for (int mi = 0; mi < 2; ++mi)
#pragma unroll
          for (int ni = 0; ni < 2; ++ni) acc[mi][ni] = mfma32(bfr[ni], af[mi], acc[mi][ni]);
      }
      __builtin_amdgcn_sched_barrier(0);
      if (more) {
        bf16_t* an = sA + (cur ^ 1) * (256 * 72);
        bf16_t* bn = sB + (cur ^ 1) * (128 * 72);
#pragma unroll
        for (int i = 0; i < 4; ++i) *(u32x4*)(an + (ldrow + 64 * i) * 72 + ldk) = al.finish(ar[i], sMu, k0n);
#pragma unroll
        for (int i = 0; i < 2; ++i) *(u32x4*)(bn + (ldrow + 64 * i) * 72 + ldk) = br[i];
      }
      __syncthreads();
    }
#pragma unroll
    for (int mi = 0; mi < 2; ++mi)
#pragma unroll
      for (int ni = 0; ni < 2; ++ni)
#pragma unroll
        for (int q = 0; q < 4; ++q) {
          const int row = m0 + wm * 64 + mi * 32 + l31;
          const int col = n0 + wn * 64 + ni * 32 + 8 * q + 4 * lh;
          f32x4 v = {acc[mi][ni][4 * q], acc[mi][ni][4 * q + 1], acc[mi][ni][4 * q + 2], acc[mi][ni][4 * q + 3]};
          ep(row, col, v);
        }
  }
}


template <class AL, class EP>
__device__ __forceinline__ void gemm256_phase(char* lds, const bf16_t* __restrict__ Bt, int K, int mtiles, int ntiles, const AL al, const EP ep) {
  bf16_t* sA = (bf16_t*)lds;
  bf16_t* sB = (bf16_t*)(lds + 40960);
  float* sMu = (float*)(lds + 81920);
  const int tid = threadIdx.x, lane = tid & 63, wv = tid >> 6, wm = wv >> 1, wn = wv & 1;
  const int l31 = lane & 31, lh = lane >> 5;
  const int nk = K >> 5;
  const int ldrow = tid >> 2, ldk = (tid & 3) * 8;
  const int total = mtiles * ntiles;
  const int nslots = gridDim.x >> 3, xcd = blockIdx.x & 7, slot = blockIdx.x >> 3;
  const int gm = 4 * ntiles;
  for (int chunk = xcd; chunk * nslots < total; chunk += 8) {
    const int tile = chunk * nslots + slot;
    if (tile >= total) break;
    const int grp = tile / gm, rem = tile - grp * gm;
    const int mt = grp * 4 + (rem & 3), nt = rem >> 2;
    const int m0 = mt * 256, n0 = nt * 256;
    __syncthreads();
    al.stage(sMu, n0);
    f32x16 acc[2][4];
#pragma unroll
    for (int a = 0; a < 2; ++a)
#pragma unroll
      for (int b = 0; b < 4; ++b)
#pragma unroll
        for (int r = 0; r < 16; ++r) acc[a][b][r] = 0.f;
    typename AL::Regs ar[2];
    u32x4 br[2];
#pragma unroll
    for (int i = 0; i < 2; ++i) al.issue(ar[i], m0 + ldrow + 128 * i, ldk);
#pragma unroll
    for (int i = 0; i < 2; ++i) br[i] = *(const u32x4*)(Bt + (size_t)(n0 + ldrow + 128 * i) * K + ldk);
    __syncthreads();
#pragma unroll
    for (int i = 0; i < 2; ++i) *(u32x4*)(sA + (ldrow + 128 * i) * 40 + ldk) = al.finish(ar[i], sMu, ldk);
#pragma unroll
    for (int i = 0; i < 2; ++i) *(u32x4*)(sB + (ldrow + 128 * i) * 40 + ldk) = br[i];
    __syncthreads();
    for (int kt = 0; kt < nk; ++kt) {
      const int cur = kt & 1;
      const bool more = (kt + 1) < nk;
      const int k0n = (kt + 1) * 32 + ldk;
      if (more) {
#pragma unroll
        for (int i = 0; i < 2; ++i) al.issue(ar[i], m0 + ldrow + 128 * i, k0n);
#pragma unroll
        for (int i = 0; i < 2; ++i) br[i] = *(const u32x4*)(Bt + (size_t)(n0 + ldrow + 128 * i) * K + k0n);
      }
      __builtin_amdgcn_sched_barrier(0);
      const bf16_t* a_ = sA + cur * (256 * 40);
      const bf16_t* b_ = sB + cur * (256 * 40);
#pragma unroll
      for (int kk = 0; kk < 2; ++kk) {
        u32x4 af[2];
#pragma unroll
        for (int mi = 0; mi < 2; ++mi) af[mi] = *(const u32x4*)(a_ + (wm * 64 + mi * 32 + l31) * 40 + kk * 16 + lh * 8);
#pragma unroll
        for (int ni = 0; ni < 4; ++ni) {
          const u32x4 bfr = *(const u32x4*)(b_ + (wn * 128 + ni * 32 + l31) * 40 + kk * 16 + lh * 8);
#pragma unroll
          for (int mi = 0; mi < 2; ++mi) acc[mi][ni] = mfma32(bfr, af[mi], acc[mi][ni]);
        }
      }
      __builtin_amdgcn_sched_barrier(0);
      if (more) {
        bf16_t* an = sA + (cur ^ 1) * (256 * 40);
        bf16_t* bn = sB + (cur ^ 1) * (256 * 40);
#pragma unroll
        for (int i = 0; i < 2; ++i) *(u32x4*)(an + (ldrow + 128 * i) * 40 + ldk) = al.finish(ar[i], sMu, k0n);
#pragma unroll
        for (int i = 0; i < 2; ++i) *(u32x4*)(bn + (ldrow + 128 * i) * 40 + ldk) = br[i];
      }
      __syncthreads();
    }
#pragma unroll
    for (int mi = 0; mi < 2; ++mi)
#pragma unroll
      for (int ni = 0; ni < 4; ++ni) {
#pragma unroll
        for (int q = 0; q < 4; ++q) {
          const int row = m0 + wm * 64 + mi * 32 + l31;
          const int col = n0 + wn * 128 + ni * 32 + 8 * q + 4 * lh;
          f32x4 v = {acc[mi][ni][4 * q], acc[mi][ni][4 * q + 1], acc[mi][ni][4 * q + 2], acc[mi][ni][4 * q + 3]};
          ep(row, col, v);
        }
        __builtin_amdgcn_sched_barrier(0);
      }
  }
}

DEVI void st_bf16x4(bf16_t* p, f32x4 v) { u32x2 o; o.x = pk_bf16(v[0], v[1]); o.y = pk_bf16(v[2], v[3]); *(u32x2*)p = o; }

struct EpRwkvIn {
  bf16_t *R, *K, *V, *G, *WD, *AD;
  DEVI void operator()(int row, int col, f32x4 v) const {
    const int grp = col >> 10;
    if (grp < 4) {
      const int c = col & 1023;
      bf16_t* dst = grp == 0 ? R : grp == 1 ? K : grp == 2 ? V : G;
      if (grp == 3) { v[0] = siluf_(v[0]); v[1] = siluf_(v[1]); v[2] = siluf_(v[2]); v[3] = siluf_(v[3]); }
      st_bf16x4(dst + (size_t)row * 1024 + c, v);
    } else {
      const int c = col - 4096;
      if (c < 128) {
#pragma unroll
        for (int i = 0; i < 4; ++i) { const float t = __expf(2.f * v[i]); v[i] = 1.f - 2.f / (t + 1.f); }
        st_bf16x4(WD + (size_t)row * 128 + c, v);
      } else st_bf16x4(AD + (size_t)row * 128 + (c - 128), v);
    }
  }
};
struct EpRes {
  const float* xl_src; const float* xc_src; float* xl_dst; float* xc_dst; const float* modL;
  DEVI void operator()(int row, int col, f32x4 v) const {
    const bool lat = row < ML;
    const size_t off = lat ? (size_t)row * 1024 + col : (size_t)(row - ML) * 1024 + col;
    const float* src = (lat ? xl_src : xc_src) + off;
    float* dst = (lat ? xl_dst : xc_dst) + off;
    const f32x4 g = *(const f32x4*)(modL + (lat ? (row >> 12) : 8) * 3072 + 2048 + col);
    f32x4 x = *(const f32x4*)src;
    x += g * v;
    *(f32x4*)dst = x;
  }
};
struct EpLruIn {
  bf16_t *XR, *GG;
  DEVI void operator()(int row, int col, f32x4 v) const {
    if (col < LW) st_bf16x4(XR + (size_t)row * LW + col, v);
    else { v[0] = siluf_(v[0]); v[1] = siluf_(v[1]); v[2] = siluf_(v[2]); v[3] = siluf_(v[3]); st_bf16x4(GG + (size_t)row * LW + (col - LW), v); }
  }
};
struct EpNatIn {
  bf16_t *Q, *K, *VT, *G;
  DEVI void operator()(int row, int col, f32x4 v) const {
    const int grp = col >> 10, c = col & 1023;
    if (grp == 0) st_bf16x4(Q + (size_t)row * 1024 + c, v);
    else if (grp == 1) st_bf16x4(K + (size_t)row * 1024 + c, v);
    else if (grp == 3) { v[0] = siluf_(v[0]); v[1] = siluf_(v[1]); v[2] = siluf_(v[2]); v[3] = siluf_(v[3]); st_bf16x4(G + (size_t)row * 1024 + c, v); }
    else {
      unsigned idx, T;
      if (row < ML) { const unsigned b = row >> 12, t = row & 4095; T = 4096u; idx = ((b * 1024u + (unsigned)c) << 12) + t; }
      else { const unsigned r2 = row - ML; const unsigned b = r2 >> 8, t = r2 & 255; T = 256u; idx = (unsigned)ML * 1024u + ((b * 1024u + (unsigned)c) << 8) + t; }
#pragma unroll
      for (int i = 0; i < 4; ++i) VT[idx + (unsigned)i * T] = f2bf(v[i]);
    }
  }
};

constexpr int SSTR = 388;
DEVI int rwkv_row(int b, int d, int s) {
  if (s < 256) return ML + b * 256 + (d ? 255 - s : s);
  const int t = s - 256;
  return b * 4096 + (d ? 4095 - t : t);
}

struct ScanRec { f32x4 n0, n1, r0, r1, w0, w1, k0, k1, d0, d1; f32x2 vv, cc; };
DEVI void scan_load(ScanRec& R, const float* rec, int sp, int row0) {
  R.n0 = *(const f32x4*)(rec + 8 * sp);        R.n1 = *(const f32x4*)(rec + 8 * sp + 4);
  R.r0 = *(const f32x4*)(rec + 64 + 8 * sp);   R.r1 = *(const f32x4*)(rec + 64 + 8 * sp + 4);
  R.w0 = *(const f32x4*)(rec + 128 + 8 * sp);  R.w1 = *(const f32x4*)(rec + 128 + 8 * sp + 4);
  R.k0 = *(const f32x4*)(rec + 192 + 8 * sp);  R.k1 = *(const f32x4*)(rec + 192 + 8 * sp + 4);
  R.d0 = *(const f32x4*)(rec + 256 + 8 * sp);  R.d1 = *(const f32x4*)(rec + 256 + 8 * sp + 4);
  R.vv = *(const f32x2*)(rec + 320 + row0);
  R.cc = *(const f32x2*)(rec + 384);
}
DEVI f32x2 lo2(f32x4 v) { return (f32x2){v[0], v[1]}; }
DEVI f32x2 hi2(f32x4 v) { return (f32x2){v[2], v[3]}; }
DEVI float dot8(const f32x2 (&S)[4], f32x4 a, f32x4 b) {
  f32x2 acc = S[0] * lo2(a);
  acc = S[1] * hi2(a) + acc;
  acc = S[2] * lo2(b) + acc;
  acc = S[3] * hi2(b) + acc;
  return acc[0] + acc[1];
}
DEVI void upd8(f32x2 (&S)[4], const ScanRec& R, float sa, float v) {
  const f32x2 sa2 = {sa, sa}, v2 = {v, v};
  S[0] = S[0] * lo2(R.w0) + (sa2 * lo2(R.k0) + v2 * lo2(R.d0));
  S[1] = S[1] * hi2(R.w0) + (sa2 * hi2(R.k0) + v2 * hi2(R.d0));
  S[2] = S[2] * lo2(R.w1) + (sa2 * lo2(R.k1) + v2 * lo2(R.d1));
  S[3] = S[3] * hi2(R.w1) + (sa2 * hi2(R.k1) + v2 * hi2(R.d1));
}
DEVI void scan_step(f32x2 (&SA)[4], f32x2 (&SB)[4], const ScanRec& R, float* yout, bool wr) {
  float saA = dot8(SA, R.n0, R.n1), yA = dot8(SA, R.r0, R.r1);
  float saB = dot8(SB, R.n0, R.n1), yB = dot8(SB, R.r0, R.r1);
  saA = sum8(saA); saB = sum8(saB); yA = sum8(yA); yB = sum8(yB);
  upd8(SA, R, saA, R.vv[0]);
  upd8(SB, R, saB, R.vv[1]);
  if (wr) *(f32x2*)yout = (f32x2){yA + saA * R.cc[0] + R.vv[0] * R.cc[1], yB + saB * R.cc[0] + R.vv[1] * R.cc[1]};
}
DEVI float sum16(float v) { v = sum8(v); v += dpp_f<0x140>(v); return v; }

__device__ __forceinline__ void rwkv_scan_phase(char* lds, const bf16_t* __restrict__ R, const bf16_t* __restrict__ Kb, const bf16_t* __restrict__ V,
                                const bf16_t* __restrict__ WD, const bf16_t* __restrict__ AD, const bf16_t* __restrict__ Wup,
                                const float* __restrict__ b0, const float* __restrict__ k_ka, const float* __restrict__ r_k,
                                bf16_t* __restrict__ Y0, bf16_t* __restrict__ Y1, float* __restrict__ BON) {
  float* stepbuf = (float*)lds;
  float* wbuf = stepbuf + 2 * 16 * SSTR;
  float* abuf = wbuf + 1024;
  float* ybuf = abuf + 1024;
  const int tid = threadIdx.x, lane = tid & 63, wv = tid >> 6;
  constexpr int NCH = (256 + 4096) / 16;
  for (int chain = blockIdx.x; chain < 256; chain += gridDim.x) {
    const int d = chain & 1, h = (chain >> 1) & 15, b = chain >> 5;
    __syncthreads();
    if (wv < 4) {
      const int sp = lane & 7, row0 = wv * 16 + (lane >> 3) * 2;
      const bool wr = sp == 0;
      f32x2 SA[4], SB[4];
#pragma unroll
      for (int j = 0; j < 4; ++j) { SA[j] = (f32x2){0.f, 0.f}; SB[j] = (f32x2){0.f, 0.f}; }
      __syncthreads();
      __syncthreads();
      for (int c = 0; c < NCH; ++c) {
        const float* sb = stepbuf + (c & 1) * 16 * SSTR;
        float* yb = ybuf + (c & 1) * 1024 + row0;
        ScanRec ra, rb;
        scan_load(ra, sb, sp, row0);
#pragma unroll
        for (int i = 0; i < 8; i += 2) {
          scan_load(rb, sb + (i + 1) * SSTR, sp, row0);
          scan_step(SA, SB, ra, yb + i * 64, wr);
          scan_load(ra, sb + (i + 2) * SSTR, sp, row0);
          scan_step(SA, SB, rb, yb + (i + 1) * 64, wr);
        }
        __syncthreads();
#pragma unroll
        for (int i = 8; i < 16; i += 2) {
          scan_load(rb, sb + (i + 1) * SSTR, sp, row0);
          scan_step(SA, SB, ra, yb + i * 64, wr);
          if (i + 2 < 16) scan_load(ra, sb + (i + 2) * SSTR, sp, row0);
          scan_step(SA, SB, rb, yb + (i + 1) * 64, wr);
        }
        __syncthreads();
      }
    } else {
      const int ptid = tid - 256, pw = wv - 4;
      bf16_t* Y = d ? Y1 : Y0;
      const int ncol = h * 64 + pw * 16 + (lane & 15);
      u32x4 bu[2][2];
      float bias_u[2];
#pragma unroll
      for (int kind = 0; kind < 2; ++kind) {
        const bf16_t* wu = Wup + ((size_t)(d * 2 + kind) * 1024 + ncol) * 64 + 8 * (lane >> 4);
        bu[kind][0] = *(const u32x4*)wu; bu[kind][1] = *(const u32x4*)(wu + 32);
        bias_u[kind] = b0[(d * 2 + kind) * 1024 + ncol];
      }
      const int ti = ptid >> 4, dq = ptid & 15;
      const int hc = h * 64 + 4 * dq;
      const f32x4 kkv = *(const f32x4*)(k_ka + hc), kav = *(const f32x4*)(k_ka + 1024 + hc), rkv = *(const f32x4*)(r_k + hc);
      u32x4 xw0, xw1, xa0, xa1; u32x2 rr, kr, vr;
      auto issue = [&](int c) {
        const int rowA = rwkv_row(b, d, c * 16 + (lane & 15));
        const bf16_t* xp = WD + (size_t)rowA * 128 + d * 64 + 8 * (lane >> 4);
        const bf16_t* xq = AD + (size_t)rowA * 128 + d * 64 + 8 * (lane >> 4);
        xw0 = *(const u32x4*)xp; xw1 = *(const u32x4*)(xp + 32);
        xa0 = *(const u32x4*)xq; xa1 = *(const u32x4*)(xq + 32);
        const int rowB = rwkv_row(b, d, c * 16 + ti);
        rr = *(const u32x2*)(R + (size_t)rowB * 1024 + hc);
        kr = *(const u32x2*)(Kb + (size_t)rowB * 1024 + hc);
        vr = *(const u32x2*)(V + (size_t)rowB * 1024 + hc);
      };
      auto stepA = [&]() {
        f32x4 accw = {0.f, 0.f, 0.f, 0.f}, acca = {0.f, 0.f, 0.f, 0.f};
        accw = mfma16(xw0, bu[0][0], accw); accw = mfma16(xw1, bu[0][1], accw);
        acca = mfma16(xa0, bu[1][0], acca); acca = mfma16(xa1, bu[1][1], acca);
#pragma unroll
        for (int r = 0; r < 4; ++r) {
          const int o = ((lane >> 4) * 4 + r) * 64 + pw * 16 + (lane & 15);
          const float wl = -softplusf_(-(accw[r] + bias_u[0])) - 0.5f;
          wbuf[o] = __expf(-__expf(wl));
          abuf[o] = sigmoidf_(acca[r] + bias_u[1]);
        }
      };
      auto stepB = [&](int c, float* sb) {
        const float rv[4] = {bf_lo(rr.x), bf_hi(rr.x), bf_lo(rr.y), bf_hi(rr.y)};
        const float kv[4] = {bf_lo(kr.x), bf_hi(kr.x), bf_lo(kr.y), bf_hi(kr.y)};
        const float vv[4] = {bf_lo(vr.x), bf_hi(vr.x), bf_lo(vr.y), bf_hi(vr.y)};
        const f32x4 av = *(const f32x4*)(abuf + ti * 64 + 4 * dq), wv4 = *(const f32x4*)(wbuf + ti * 64 + 4 * dq);
        float q[4], ss = 0.f;
#pragma unroll
        for (int i = 0; i < 4; ++i) { q[i] = kv[i] * kkv[i]; ss += q[i] * q[i]; }
        ss = sum16(ss);
        const float inv = __builtin_amdgcn_rsqf(fmaxf(ss, 1e-24f));
        f32x4 nk, wrr, ka, kd, vo;
        float c1 = 0.f, c2 = 0.f, bn = 0.f;
#pragma unroll
        for (int i = 0; i < 4; ++i) {
          const float n = q[i] * inv;
          kd[i] = kv[i] * (1.f + (av[i] - 1.f) * kav[i]);
          ka[i] = n * av[i];
          nk[i] = -n; wrr[i] = wv4[i] * rv[i]; vo[i] = vv[i];
          c1 += ka[i] * rv[i]; c2 += kd[i] * rv[i]; bn += rv[i] * kd[i] * rkv[i];
        }
        c1 = sum16(c1); c2 = sum16(c2); bn = sum16(bn);
        float* rec = sb + ti * SSTR;
        *(f32x4*)(rec + 4 * dq) = nk;
        *(f32x4*)(rec + 64 + 4 * dq) = wrr;
        *(f32x4*)(rec + 128 + 4 * dq) = wv4;
        *(f32x4*)(rec + 192 + 4 * dq) = ka;
        *(f32x4*)(rec + 256 + 4 * dq) = kd;
        *(f32x4*)(rec + 320 + 4 * dq) = vo;
        if (dq == 0) {
          *(f32x2*)(rec + 384) = (f32x2){c1, c2};
          BON[((size_t)d * MT + rwkv_row(b, d, c * 16 + ti)) * 16 + h] = bn;
        }
      };
      auto storeY = [&](int c) {
        const f32x4 yv = *(const f32x4*)(ybuf + (c & 1) * 1024 + ti * 64 + 4 * dq);
        u32x2 o; o.x = pk_bf16(yv[0], yv[1]); o.y = pk_bf16(yv[2], yv[3]);
        *(u32x2*)(Y + (size_t)rwkv_row(b, d, c * 16 + ti) * 1024 + hc) = o;
      };
      issue(0);
      stepA();
      __syncthreads();
      stepB(0, stepbuf);
      issue(1);
      __syncthreads();
      for (int c = 0; c < NCH; ++c) {
        const bool more = (c + 1) < NCH;
        if (more) stepA();
        if (c >= 1) storeY(c - 1);
        __syncthreads();
        if (more) {
          stepB(c + 1, stepbuf + ((c + 1) & 1) * 16 * SSTR);
          if (c + 2 < NCH) issue(c + 2);
        }
        __builtin_amdgcn_sched_barrier(0);
        __syncthreads();
        __builtin_amdgcn_sched_barrier(0);
      }
      storeY(NCH - 1);
    }
  }
}

__device__ __forceinline__ void rwkv_post_phase(const bf16_t* __restrict__ Y0, const bf16_t* __restrict__ Y1, const bf16_t* __restrict__ V,
                                bf16_t* __restrict__ G, const float* __restrict__ BON, const float* __restrict__ gn, int nrows) {
  const int lane = threadIdx.x & 63;
  const int gw = blockIdx.x * (NTHR / 64) + (threadIdx.x >> 6), nw = gridDim.x * (NTHR / 64);
  const int head = lane >> 2, c0 = lane * 16;
  for (int row = gw; row < nrows; row += nw) {
    const size_t off = (size_t)row * 1024 + c0;
    float y[16], v[16], g[16];
#pragma unroll
    for (int i = 0; i < 2; ++i) {
      const u32x4 a0 = *(const u32x4*)(Y0 + off + 8 * i), a1 = *(const u32x4*)(Y1 + off + 8 * i);
      const u32x4 av = *(const u32x4*)(V + off + 8 * i), ag = *(const u32x4*)(G + off + 8 * i);
      y[8 * i + 0] = bf_lo(a0.x) + bf_lo(a1.x); y[8 * i + 1] = bf_hi(a0.x) + bf_hi(a1.x);
      y[8 * i + 2] = bf_lo(a0.y) + bf_lo(a1.y); y[8 * i + 3] = bf_hi(a0.y) + bf_hi(a1.y);
      y[8 * i + 4] = bf_lo(a0.z) + bf_lo(a1.z); y[8 * i + 5] = bf_hi(a0.z) + bf_hi(a1.z);
      y[8 * i + 6] = bf_lo(a0.w) + bf_lo(a1.w); y[8 * i + 7] = bf_hi(a0.w) + bf_hi(a1.w);
      v[8 * i + 0] = bf_lo(av.x); v[8 * i + 1] = bf_hi(av.x); v[8 * i + 2] = bf_lo(av.y); v[8 * i + 3] = bf_hi(av.y);
      v[8 * i + 4] = bf_lo(av.z); v[8 * i + 5] = bf_hi(av.z); v[8 * i + 6] = bf_lo(av.w); v[8 * i + 7] = bf_hi(av.w);
      g[8 * i + 0] = bf_lo(ag.x); g[8 * i + 1] = bf_hi(ag.x); g[8 * i + 2] = bf_lo(ag.y); g[8 * i + 3] = bf_hi(ag.y);
      g[8 * i + 4] = bf_lo(ag.z); g[8 * i + 5] = bf_hi(ag.z); g[8 * i + 6] = bf_lo(ag.w); g[8 * i + 7] = bf_hi(ag.w);
    }
    float s = 0.f;
#pragma unroll
    for (int i = 0; i < 16; ++i) s += y[i];
    s += __shfl_xor(s, 1); s += __shfl_xor(s, 2);
    const float mean = s * (1.f / 64.f);
    float q = 0.f;
#pragma unroll
    for (int i = 0; i < 16; ++i) { const float dlt = y[i] - mean; q += dlt * dlt; }
    q += __shfl_xor(q, 1); q += __shfl_xor(q, 2);
    const float rstd = rsqrtf(q * (1.f / 64.f) + 64e-5f);
    const float bonus = BON[(size_t)row * 16 + head] + BON[((size_t)MT + row) * 16 + head];
    unsigned o[8];
#pragma unroll
    for (int i = 0; i < 8; ++i) {
      const float z0 = ((y[2 * i] - mean) * rstd * gn[c0 + 2 * i] + gn[1024 + c0 + 2 * i] + bonus * v[2 * i]) * g[2 * i];
      const float z1 = ((y[2 * i + 1] - mean) * rstd * gn[c0 + 2 * i + 1] + gn[1024 + c0 + 2 * i + 1] + bonus * v[2 * i + 1]) * g[2 * i + 1];
      o[i] = pk_bf16(z0, z1);
    }
    *(u32x4*)(G + off) = mk4(o[0], o[1], o[2], o[3]);
    *(u32x4*)(G + off + 8) = mk4(o[4], o[5], o[6], o[7]);
  }
}

__device__ __forceinline__ void rglru_phase(char* lds, const bf16_t* __restrict__ XR, const bf16_t* __restrict__ Wg, const float* __restrict__ conv_w,
                            const float* __restrict__ conv_b, const float* __restrict__ gate_b, const float* __restrict__ lam,
                            bf16_t* __restrict__ HS0, bf16_t* __restrict__ HS1) {
  bf16_t* xcT = (bf16_t*)lds;
  f32x2* AB = (f32x2*)(lds + 26624);
  bf16_t* raw = (bf16_t*)(lds + 26624);
  float* segP = (float*)(lds + 116736);
  float* segH = segP + 352;
  float* segC = segH + 352;
  bf16_t* wgs = (bf16_t*)(lds + 120960);
  float* cws = (float*)(lds + 160896);
  const int tid = threadIdx.x, lane = tid & 63, wv = tid >> 6;
  for (int chain = blockIdx.x; chain < 256; chain += gridDim.x) {
    const int d = chain & 1, blk = (chain >> 1) & 15, b = chain >> 5;
    bf16_t* HS = d ? HS1 : HS0;
    float carry = 0.f;
    __syncthreads();
    for (int q = tid; q < 2 * 96 * 12; q += NTHR) {
      const int g = q / 1152, rem = q - g * 1152, n = rem / 12, k8 = rem - n * 12;
      *(u32x4*)(wgs + (g * 96 + n) * 104 + k8 * 8) = *(const u32x4*)(Wg + ((size_t)((blk * 4 + d * 2 + g) * 96 + n)) * 96 + k8 * 8);
    }
    for (int e = tid; e < 5 * 88; e += NTHR) {
      const int j = e / 88, c = e - j * 88;
      cws[e] = j < 4 ? conv_w[j * LW + blk * 88 + c] : conv_b[blk * 88 + c];
    }
    for (int e = tid; e < 128 * 8; e += NTHR) xcT[(e >> 3) * 104 + 88 + (e & 7)] = 0;
    u32x4 pre[3];
    auto tile_geom = [&](int ti, int& seqbase, int& t0, int& T) {
      if (ti < 2) { seqbase = ML + b * 256; T = 256; t0 = (d ? 1 - ti : ti) * 128; }
      else { seqbase = b * 4096; T = 4096; t0 = (d ? 31 - (ti - 2) : (ti - 2)) * 128; }
    };
    auto prefetch = [&](int ti) {
      int seqbase, t0, T; tile_geom(ti, seqbase, t0, T);
#pragma unroll
      for (int i = 0; i < 3; ++i) {
        const int q = tid + NTHR * i;
        const int row = q / 11, cc = q - row * 11, t = t0 - 2 + row;
        u32x4 v = {0u, 0u, 0u, 0u};
        if (q < 131 * 11 && t >= 0 && t < T) v = *(const u32x4*)(XR + (size_t)(seqbase + t) * LW + blk * 88 + cc * 8);
        pre[i] = v;
      }
    };
    prefetch(0);
    for (int ti = 0; ti < 34; ++ti) {
      int seqbase, t0, T; tile_geom(ti, seqbase, t0, T);
      __syncthreads();
#pragma unroll
      for (int i = 0; i < 3; ++i) {
        const int q = tid + NTHR * i;
        if (q < 131 * 11) *(u32x4*)(raw + q * 8) = pre[i];
      }
      if (ti + 1 < 34) prefetch(ti + 1);
      __builtin_amdgcn_sched_barrier(0);
      __syncthreads();
      for (int e = tid; e < 128 * 44; e += NTHR) {
        const int tl = e / 44, c2 = (e - tl * 44) * 2;
        float a0 = cws[4 * 88 + c2], a1 = cws[4 * 88 + c2 + 1];
#pragma unroll
        for (int j = 0; j < 4; ++j) {
          const unsigned x = *(const unsigned*)(raw + (tl + j) * 88 + c2);
          a0 += bf_lo(x) * cws[j * 88 + c2]; a1 += bf_hi(x) * cws[j * 88 + c2 + 1];
        }
        *(unsigned*)(xcT + tl * 104 + c2) = pk_bf16(a0, a1);
      }
      __syncthreads();
      {
        const int tok = wv * 16 + (lane & 15);
        u32x4 af[3];
#pragma unroll
        for (int kk = 0; kk < 3; ++kk) af[kk] = *(const u32x4*)(xcT + tok * 104 + kk * 32 + 8 * (lane >> 4));
#pragma unroll
        for (int n6 = 0; n6 < 6; ++n6) {
          f32x4 accr = {0.f, 0.f, 0.f, 0.f}, acci = {0.f, 0.f, 0.f, 0.f};
          const int ncol = n6 * 16 + (lane & 15);
          const bf16_t* wr_ = wgs + ncol * 104 + 8 * (lane >> 4);
          const bf16_t* wi_ = wgs + (96 + ncol) * 104 + 8 * (lane >> 4);
#pragma unroll
          for (int kk = 0; kk < 3; ++kk) {
            accr = mfma16(af[kk], *(const u32x4*)(wr_ + kk * 32), accr);
            acci = mfma16(af[kk], *(const u32x4*)(wi_ + kk * 32), acci);
          }
          if (ncol < 88) {
            const int ch = blk * 88 + ncol;
            const float gbr = gate_b[(d * 2 + 0) * LW + ch], gbi = gate_b[(d * 2 + 1) * LW + ch];
            const float spl = softplusf_(-lam[d * LW + ch]);
#pragma unroll
            for (int r = 0; r < 4; ++r) {
              const int tk = wv * 16 + (lane >> 4) * 4 + r;
              const float rg = sigmoidf_(accr[r] + gbr), ig = sigmoidf_(acci[r] + gbi);
              const float a = __expf(-8.f * rg * spl);
              const float bb = sqrtf(fmaxf(1.f - a * a, 0.f)) * ig * bf2f(xcT[tk * 104 + ncol]);
              AB[tk * 88 + ncol] = (f32x2){a, bb};
            }
          }
        }
      }
      __syncthreads();
      if (tid < 352) {
        const int seg = tid / 88, c = tid - seg * 88;
        float hl = 0.f, P = 1.f;
        for (int u0 = seg * 32; u0 < seg * 32 + 32; u0 += 8) {
          f32x2 ab[8];
#pragma unroll
          for (int i = 0; i < 8; ++i) { const int tl = d ? 127 - (u0 + i) : (u0 + i); ab[i] = AB[tl * 88 + c]; }
#pragma unroll
          for (int i = 0; i < 8; ++i) { hl = ab[i][0] * hl + ab[i][1]; P *= ab[i][0]; ab[i] = (f32x2){hl, P}; }
#pragma unroll
          for (int i = 0; i < 8; ++i) { const int tl = d ? 127 - (u0 + i) : (u0 + i); AB[tl * 88 + c] = ab[i]; }
        }
        segH[seg * 88 + c] = hl; segP[seg * 88 + c] = P;
      }
      __syncthreads();
      if (tid < 88) {
        float cur = carry;
#pragma unroll
        for (int seg = 0; seg < 4; ++seg) { segC[seg * 88 + tid] = cur; cur = segP[seg * 88 + tid] * cur + segH[seg * 88 + tid]; }
        carry = cur;
      }
      __syncthreads();
      for (int q = tid; q < 128 * 11; q += NTHR) {
        const int tl = q / 11, c8 = (q - tl * 11) * 8;
        const int u = d ? 127 - tl : tl;
        const float* sc = segC + (u >> 5) * 88 + c8;
        float hv[8];
#pragma unroll
        for (int i = 0; i < 8; ++i) { const f32x2 hp = AB[tl * 88 + c8 + i]; hv[i] = hp[0] + hp[1] * sc[i]; }
        *(u32x4*)(HS + (size_t)(seqbase + t0 + tl) * LW + blk * 88 + c8) =
            mk4(pk_bf16(hv[0], hv[1]), pk_bf16(hv[2], hv[3]), pk_bf16(hv[4], hv[5]), pk_bf16(hv[6], hv[7]));
      }
    }
  }
}

__device__ __forceinline__ void lru_z_phase(const bf16_t* __restrict__ HS0, const bf16_t* __restrict__ HS1, bf16_t* __restrict__ GG) {
  const size_t n8 = (size_t)MT * LW / 8;
  for (size_t e = (size_t)blockIdx.x * NTHR + threadIdx.x; e < n8; e += (size_t)gridDim.x * NTHR) {
    const u32x4 a = *(const u32x4*)(HS0 + e * 8), b = *(const u32x4*)(HS1 + e * 8), g = *(const u32x4*)(GG + e * 8);
    u32x4 o;
    o.x = pk_bf16((bf_lo(a.x) + bf_lo(b.x)) * bf_lo(g.x), (bf_hi(a.x) + bf_hi(b.x)) * bf_hi(g.x));
    o.y = pk_bf16((bf_lo(a.y) + bf_lo(b.y)) * bf_lo(g.y), (bf_hi(a.y) + bf_hi(b.y)) * bf_hi(g.y));
    o.z = pk_bf16((bf_lo(a.z) + bf_lo(b.z)) * bf_lo(g.z), (bf_hi(a.z) + bf_hi(b.z)) * bf_hi(g.z));
    o.w = pk_bf16((bf_lo(a.w) + bf_lo(b.w)) * bf_lo(g.w), (bf_hi(a.w) + bf_hi(b.w)) * bf_hi(g.w));
    *(u32x4*)(GG + e * 8) = o;
  }
}

__device__ __forceinline__ void nat_qk_phase(bf16_t* __restrict__ Q, bf16_t* __restrict__ Kb, bf16_t* __restrict__ QR, const float* __restrict__ qk_g) {
  const int lane = threadIdx.x & 63;
  const int gw = blockIdx.x * (NTHR / 64) + (threadIdx.x >> 6), nw = gridDim.x * (NTHR / 64);
  const int qd = lane & 3;
  float gq[16], gk[16], inv[16];
#pragma unroll
  for (int i = 0; i < 16; ++i) { gq[i] = qk_g[qd * 16 + i]; gk[i] = qk_g[64 + qd * 16 + i]; inv[i] = exp2f(-(float)i * (13.287712379549449f / 16.f)); }
  for (int row = gw; row < MT; row += nw) {
    const bool lat = row < ML;
    const size_t off = (size_t)row * 1024 + lane * 16;
    float cs[16], sn[16];
    if (lat) {
      const int t = row & 4095;
      const float pos = (float)((qd >> 1) ? (t & 63) : (t >> 6));
#pragma unroll
      for (int i = 0; i < 16; ++i) {
        float rev = pos * inv[i] * 0.15915494309189535f;
        rev -= floorf(rev);
        sn[i] = __builtin_amdgcn_sinf(rev); cs[i] = __builtin_amdgcn_cosf(rev);
      }
    }
#pragma unroll
    for (int which = 0; which < 2; ++which) {
      bf16_t* P = which ? Kb : Q;
      const u32x4 a = *(const u32x4*)(P + off), b2 = *(const u32x4*)(P + off + 8);
      const unsigned u[8] = {a.x, a.y, a.z, a.w, b2.x, b2.y, b2.z, b2.w};
      float x[16];
#pragma unroll
      for (int i = 0; i < 8; ++i) { x[2 * i] = bf_lo(u[i]); x[2 * i + 1] = bf_hi(u[i]); }
      float ss = 0.f;
#pragma unroll
      for (int i = 0; i < 16; ++i) ss += x[i] * x[i];
      ss += __shfl_xor(ss, 1); ss += __shfl_xor(ss, 2);
      const float rstd = rsqrtf(ss * (1.f / 64.f) + 1e-6f);
#pragma unroll
      for (int i = 0; i < 16; ++i) x[i] = x[i] * rstd * (which ? gk[i] : gq[i]);
      unsigned pl[8];
#pragma unroll
      for (int i = 0; i < 8; ++i) pl[i] = pk_bf16(x[2 * i], x[2 * i + 1]);
      unsigned rt[8];
      if (lat) {
        float y[16];
#pragma unroll
        for (int i = 0; i < 16; ++i) {
          const float pr = __shfl_xor(x[i], 1);
          y[i] = x[i] * cs[i] + ((qd & 1) ? pr * sn[i] : -pr * sn[i]);
        }
#pragma unroll
        for (int i = 0; i < 8; ++i) rt[i] = pk_bf16(y[2 * i], y[2 * i + 1]);
      }
      if (which == 0) {
        *(u32x4*)(Q + off) = mk4(pl[0], pl[1], pl[2], pl[3]);
        *(u32x4*)(Q + off + 8) = mk4(pl[4], pl[5], pl[6], pl[7]);
        if (lat) { *(u32x4*)(QR + off) = mk4(rt[0], rt[1], rt[2], rt[3]); *(u32x4*)(QR + off + 8) = mk4(rt[4], rt[5], rt[6], rt[7]); }
      } else {
        if (lat) { *(u32x4*)(Kb + off) = mk4(rt[0], rt[1], rt[2], rt[3]); *(u32x4*)(Kb + off + 8) = mk4(rt[4], rt[5], rt[6], rt[7]); }
        else { *(u32x4*)(Kb + off) = mk4(pl[0], pl[1], pl[2], pl[3]); *(u32x4*)(Kb + off + 8) = mk4(pl[4], pl[5], pl[6], pl[7]); }
      }
    }
  }
}

struct AttnState { f32x16 O[2][2]; float m[2], l[2]; };

template <bool BAND>
DEVI void attn_chunk(AttnState& st, const u32x4 (&qf)[2][4], const bf16_t* __restrict__ kbase, const bf16_t* __restrict__ vtbase, int vtT,
                     const float* __restrict__ rpbs, int brow, int half, int lane) {
  const int l31 = lane & 31, lh = lane >> 5;
  u32x4 kf[4];
#pragma unroll
  for (int ks = 0; ks < 4; ++ks) kf[ks] = *(const u32x4*)(kbase + (size_t)l31 * 1024 + ks * 16 + 8 * lh);
  constexpr float SC = 0.125f * 1.4426950408889634f;
  u32x4 pf[2][2];
#pragma unroll
  for (int qt = 0; qt < 2; ++qt) {
    f32x16 S;
#pragma unroll
    for (int r = 0; r < 16; ++r) S[r] = 0.f;
#pragma unroll
    for (int ks = 0; ks < 4; ++ks) S = mfma32(kf[ks], qf[qt][ks], S);
    float cmax = -INFINITY;
    if (BAND) {
      const int qc = qt * 32 + l31;
      const int cst = min(max(qc - 8, 0), 48);
#pragma unroll
      for (int r = 0; r < 16; ++r) {
        const int key = (r & 3) + 8 * (r >> 2) + 4 * lh;
        const int kc = half * 32 + key;
        const bool ok = (kc >= cst) && (kc < cst + 16);
        const int bi = ok ? (brow * 31 + kc - qc + 15) : 0;
        const float sv = S[r] * SC + rpbs[bi];
        S[r] = ok ? sv : -INFINITY;
        cmax = fmaxf(cmax, S[r]);
      }
    } else {
#pragma unroll
      for (int r = 0; r < 16; ++r) { S[r] *= SC; cmax = fmaxf(cmax, S[r]); }
    }
    cmax = fmaxf(cmax, __shfl_xor(cmax, 32));
    const float mnew = fmaxf(st.m[qt], cmax);
    const float alpha = exp2f(st.m[qt] - mnew);
    st.m[qt] = mnew;
    float ps = 0.f;
#pragma unroll
    for (int r = 0; r < 16; ++r) { S[r] = exp2f(S[r] - mnew); ps += S[r]; }
    st.l[qt] = st.l[qt] * alpha + ps;
#pragma unroll
    for (int dt = 0; dt < 2; ++dt)
#pragma unroll
      for (int r = 0; r < 16; ++r) st.O[qt][dt][r] *= alpha;
    pf[qt][0] = mk4(pk_bf16(S[0], S[1]), pk_bf16(S[2], S[3]), pk_bf16(S[4], S[5]), pk_bf16(S[6], S[7]));
    pf[qt][1] = mk4(pk_bf16(S[8], S[9]), pk_bf16(S[10], S[11]), pk_bf16(S[12], S[13]), pk_bf16(S[14], S[15]));
  }
#pragma unroll
  for (int dt = 0; dt < 2; ++dt)
#pragma unroll
    for (int s = 0; s < 2; ++s) {
      const bf16_t* vp = vtbase + (size_t)(dt * 32 + l31) * vtT + 16 * s + 4 * lh;
      const u32x2 lo = *(const u32x2*)vp, hi = *(const u32x2*)(vp + 8);
      const u32x4 vf = mk4(lo.x, lo.y, hi.x, hi.y);
      st.O[0][dt] = mfma32(vf, pf[0][s], st.O[0][dt]);
      st.O[1][dt] = mfma32(vf, pf[1][s], st.O[1][dt]);
    }
}

__device__ __forceinline__ void natten_phase(char* lds, const bf16_t* __restrict__ Q, const bf16_t* __restrict__ QR, const bf16_t* __restrict__ Kb,
                             const bf16_t* __restrict__ VT, bf16_t* __restrict__ G, const float* __restrict__ rpb) {
  float* rpbs = (float*)lds;
  __syncthreads();
  for (int e = threadIdx.x; e < 16 * 465; e += NTHR) rpbs[e] = rpb[e] * 1.4426950408889634f;
  __syncthreads();
  const int lane = threadIdx.x & 63, l31 = lane & 31, lh = lane >> 5;
  const int gw = blockIdx.x * (NTHR / 64) + (threadIdx.x >> 6), nw = gridDim.x * (NTHR / 64);
  const bf16_t* VTC = VT + (size_t)ML * 1024;
  for (int item = gw; item < 8192 + 512; item += nw) {
    const bool lat = item < 8192;
    int b, h, r = 0, qrow0;
    if (lat) { h = item & 15; r = (item >> 4) & 63; b = item >> 10; qrow0 = b * 4096 + r * 64; }
    else { const int it = item - 8192; h = it & 15; const int qt64 = (it >> 4) & 3; b = it >> 6; qrow0 = ML + b * 256 + qt64 * 64; }
    AttnState st;
#pragma unroll
    for (int a = 0; a < 2; ++a) { st.m[a] = -INFINITY; st.l[a] = 0.f;
#pragma unroll
      for (int c = 0; c < 2; ++c)
#pragma unroll
        for (int rr = 0; rr < 16; ++rr) st.O[a][c][rr] = 0.f; }
    u32x4 qf[2][4];
#pragma unroll
    for (int qt = 0; qt < 2; ++qt)
#pragma unroll
      for (int ks = 0; ks < 4; ++ks) qf[qt][ks] = *(const u32x4*)(Q + (size_t)(qrow0 + qt * 32 + l31) * 1024 + h * 64 + ks * 16 + 8 * lh);
    for (int kc = 0; kc < 8; ++kc) {
      const bf16_t* kbase = Kb + (size_t)(ML + b * 256 + kc * 32) * 1024 + h * 64;
      const bf16_t* vtb = VTC + (size_t)(b * 16 + h) * 64 * 256 + kc * 32;
      attn_chunk<false>(st, qf, kbase, vtb, 256, rpbs, 0, 0, lane);
    }
    if (lat) {
#pragma unroll
      for (int qt = 0; qt < 2; ++qt)
#pragma unroll
        for (int ks = 0; ks < 4; ++ks) qf[qt][ks] = *(const u32x4*)(QR + (size_t)(qrow0 + qt * 32 + l31) * 1024 + h * 64 + ks * 16 + 8 * lh);
      const int start = min(max(r - 4, 0), 56);
      for (int i = 0; i < 16; ++i) {
        const int kr = start + (i >> 1), half = i & 1;
        const bf16_t* kbase = Kb + (size_t)(b * 4096 + kr * 64 + half * 32) * 1024 + h * 64;
        const bf16_t* vtb = VT + (size_t)(b * 16 + h) * 64 * 4096 + kr * 64 + half * 32;
        attn_chunk<true>(st, qf, kbase, vtb, 4096, rpbs, h * 15 + (kr - r + 7), half, lane);
      }
    }
#pragma unroll
    for (int qt = 0; qt < 2; ++qt) {
      const float lt = st.l[qt] + __shfl_xor(st.l[qt], 32);
      const float inv = 1.f / lt;
      bf16_t* grow = G + (size_t)(qrow0 + qt * 32 + l31) * 1024 + h * 64;
#pragma unroll
      for (int dt = 0; dt < 2; ++dt)
#pragma unroll
        for (int q4 = 0; q4 < 4; ++q4) {
          bf16_t* gp = grow + dt * 32 + 8 * q4 + 4 * lh;
          const u32x2 gv = *(const u32x2*)gp;
          u32x2 o;
          o.x = pk_bf16(st.O[qt][dt][4 * q4] * inv * bf_lo(gv.x), st.O[qt][dt][4 * q4 + 1] * inv * bf_hi(gv.x));
          o.y = pk_bf16(st.O[qt][dt][4 * q4 + 2] * inv * bf_lo(gv.y), st.O[qt][dt][4 * q4 + 3] * inv * bf_hi(gv.y));
          *(u32x2*)gp = o;
        }
    }
  }
}

template <int ph>
__device__ __forceinline__ void run_phase(const Params& p, char* lds) {
  char* ws = p.ws;
  const float* MOD = (const float*)(ws + OFF_MOD);
  float* XC = (float*)(ws + OFF_XC);
  bf16_t* HB = (bf16_t*)(ws + OFF_HB);
  bf16_t* A0 = (bf16_t*)(ws + OFF_A0); bf16_t* A1 = (bf16_t*)(ws + OFF_A1); bf16_t* A2 = (bf16_t*)(ws + OFF_A2);
  bf16_t* A3 = (bf16_t*)(ws + OFF_A3); bf16_t* A4 = (bf16_t*)(ws + OFF_A4);
  bf16_t* WD = (bf16_t*)(ws + OFF_WD); bf16_t* AD = (bf16_t*)(ws + OFF_AD);
  float* BON = (float*)(ws + OFF_BON);
  if (ph == 0) { phase0(p, lds); return; }
  constexpr int layer = (ph - 1) / 5, sub = (ph - 1) % 5;
  const float* modL = MOD + (size_t)layer * 9 * 3072;
  const float* xl_cur = layer == 0 ? p.in[0] : p.out;
  const float* xc_cur = layer == 0 ? p.in[2] : XC;
  if (layer == 0 || layer == 3) {
    const int ib = layer ? 33 : 4;
    const bf16_t* WIN = (const bf16_t*)(ws + (layer ? OFF_W3IN : OFF_W0IN));
    const bf16_t* WUP = (const bf16_t*)(ws + (layer ? OFF_W3UP : OFF_W0UP));
    const bf16_t* WOUT = (const bf16_t*)(ws + (layer ? OFF_W3OUT : OFF_W0OUT));
    if (sub == 0) norm_phase<true>(xl_cur, xc_cur, p.in[ib], modL, HB, A4);
    else if (sub == 1) { ALMix al{HB, A4, p.in[ib + 4]}; EpRwkvIn ep{A0, A1, A2, A3, WD, AD}; gemm256_phase(lds, WIN, 1024, MT / 256, 16, al, ep); gemm_phase(lds, WIN, 1024, MT / 256, 2, al, ep, 4096, true); }
    else if (sub == 2) rwkv_scan_phase(lds, A0, A1, A2, WD, AD, WUP, p.in[ib + 5], p.in[ib + 8], p.in[ib + 9], HB, A4, BON);
    else if (sub == 3) rwkv_post_phase(HB, A4, A2, A3, BON, p.in[ib + 10], layer == 3 ? ML : MT);
    else { ALPlain al{A3, 1024}; EpRes ep{xl_cur, xc_cur, p.out, XC, modL}; gemm256_phase(lds, WOUT, 1024, (layer == 3 ? ML : MT) / 256, 4, al, ep); }
  } else if (layer == 1) {
    bf16_t* HS0 = (bf16_t*)(ws + OFF_HS0); bf16_t* XR = (bf16_t*)(ws + OFF_XR); bf16_t* GG = (bf16_t*)(ws + OFF_GG); bf16_t* HS1 = (bf16_t*)(ws + OFF_HS1);
    if (sub == 0) norm_phase<false>(xl_cur, xc_cur, p.in[16], modL, HB, nullptr);
    else if (sub == 1) { ALPlain al{HB, 1024}; EpLruIn ep{XR, GG}; gemm256_phase(lds, (const bf16_t*)(ws + OFF_W1IN), 1024, MT / 256, 11, al, ep); }
    else if (sub == 2) rglru_phase(lds, XR, (const bf16_t*)(ws + OFF_W1G), p.in[20], p.in[21], p.in[23], p.in[24], HS0, HS1);
    else if (sub == 3) lru_z_phase(HS0, HS1, GG);
    else { ALPlain al{GG, LW}; EpRes ep{xl_cur, xc_cur, p.out, XC, modL}; gemm256_phase(lds, (const bf16_t*)(ws + OFF_W1OUT), LW, MT / 256, 4, al, ep); }
  } else {
    if (sub == 0) norm_phase<false>(xl_cur, xc_cur, p.in[26], modL, HB, nullptr);
    else if (sub == 1) { ALPlain al{HB, 1024}; EpNatIn ep{A0, A1, A2, A3}; gemm256_phase(lds, (const bf16_t*)(ws + OFF_W2IN), 1024, MT / 256, 16, al, ep); }
    else if (sub == 2) nat_qk_phase(A0, A1, A4, p.in[30]);
    else if (sub == 3) natten_phase(lds, A0, A4, A1, A2, A3, p.in[31]);
    else { ALPlain al{A3, 1024}; EpRes ep{xl_cur, xc_cur, p.out, XC, modL}; gemm256_phase(lds, (const bf16_t*)(ws + OFF_W2OUT), 1024, MT / 256, 4, al, ep); }
  }
}

__global__ void __launch_bounds__(NTHR) mega_kernel(Params p) {
  __shared__ __attribute__((aligned(16))) char lds[LDS_BYTES];
  cg::grid_group grid = cg::this_grid();
#define PHASE(k) if (p.ph_lo <= k && k < p.ph_hi) { for (int rep = 0; rep < REP[k]; ++rep) { run_phase<k>(p, lds); if (rep + 1 < REP[k] || k + 1 < p.ph_hi) grid.sync(); } }
  PHASE(0) PHASE(1) PHASE(2) PHASE(3) PHASE(4) PHASE(5) PHASE(6) PHASE(7) PHASE(8) PHASE(9) PHASE(10)
  PHASE(11) PHASE(12) PHASE(13) PHASE(14) PHASE(15) PHASE(16) PHASE(17) PHASE(18) PHASE(19) PHASE(20)
#undef PHASE
}

extern "C" void kernel_launch(void* const* d_in, const int* in_sizes, int n_in, void* d_out, int out_size, void* d_ws, size_t ws_size,
                              hipStream_t stream) {
  static int grid_blocks = 0;
  if (!grid_blocks) {
    int dev = 0, cus = 0, per_cu = 0;
    hipGetDevice(&dev);
    hipDeviceGetAttribute(&cus, hipDeviceAttributeMultiprocessorCount, dev);
    hipOccupancyMaxActiveBlocksPerMultiprocessor(&per_cu, mega_kernel, NTHR, 0);
    if (per_cu < 1) { fprintf(stderr, "occupancy query returned %d\n", per_cu); per_cu = 1; }
    if (per_cu > 1) per_cu = 1;
    grid_blocks = cus * per_cu;
    if (n_in != 45 || ws_size < WS_END) fprintf(stderr, "unexpected n_in %d / ws %zu (need %zu)\n", n_in, ws_size, (size_t)WS_END);
  }
  Params p{};
  for (int i = 0; i < 45; ++i) p.in[i] = (const float*)d_in[i];
  p.out = (float*)d_out;
  p.ws = (char*)d_ws;
#if N_LAUNCH_MODE == 1
  p.ph_lo = 0; p.ph_hi = NPHASE;
  void* args[] = {&p};
  hipError_t e = hipLaunchCooperativeKernel((void*)mega_kernel, dim3(grid_blocks), dim3(NTHR), args, 0, stream);
  if (e != hipSuccess) fprintf(stderr, "cooperative launch failed: %s (grid %d)\n", hipGetErrorString(e), grid_blocks);
#else
  for (int ph = 0; ph < NPHASE; ++ph) {
    p.ph_lo = ph; p.ph_hi = ph + 1;
    hipLaunchKernelGGL(mega_kernel, dim3(grid_blocks), dim3(NTHR), 0, stream, p);
  }
#endif
}
```

```cpp
#include <hip/hip_runtime.h>
#include <hip/hip_cooperative_groups.h>
#include <cstdio>
#include <cstdint>
namespace cg = cooperative_groups;

#ifndef N_LAUNCH_MODE
#define N_LAUNCH_MODE 1
#endif

typedef unsigned short bf16_t;
typedef short bf16x8 __attribute__((ext_vector_type(8)));
typedef float f32x4 __attribute__((ext_vector_type(4)));
typedef float f32x16 __attribute__((ext_vector_type(16)));
typedef float f32x2 __attribute__((ext_vector_type(2)));
typedef unsigned u32x4 __attribute__((ext_vector_type(4)));
typedef unsigned u32x2 __attribute__((ext_vector_type(2)));

#define DEVI __device__ __forceinline__

constexpr int D = 1024, NB = 8, SEQ = 4096, CTX = 256;
constexpr int ML = NB * SEQ;
constexpr int MC = NB * CTX;
constexpr int MT = ML + MC;
constexpr int LW = 1408;
constexpr int NTHR = 512;
constexpr int NPHASE = 21;
constexpr int LDS_BYTES = 163840 - 16;
__device__ constexpr int REP[21] = {1,1,1,1,1,1,1,1,1,1,1,1,1,1,1,1,1,1,1,1,1};

constexpr size_t SZ_ACT = (size_t)MT * 1024 * 2;
constexpr size_t OFF_MOD = 0;
constexpr size_t OFF_BAR = 458752;
constexpr size_t OFF_W0IN = 524288;
constexpr size_t SZ_RWIN = (size_t)4352 * 1024 * 2;
constexpr size_t SZ_RWUP = (size_t)4 * 1024 * 64 * 2;
constexpr size_t SZ_SQ = (size_t)1024 * 1024 * 2;
constexpr size_t OFF_W0UP = OFF_W0IN + SZ_RWIN;
constexpr size_t OFF_W0OUT = OFF_W0UP + SZ_RWUP;
constexpr size_t OFF_W3IN = OFF_W0OUT + SZ_SQ;
constexpr size_t OFF_W3UP = OFF_W3IN + SZ_RWIN;
constexpr size_t OFF_W3OUT = OFF_W3UP + SZ_RWUP;
constexpr size_t OFF_W1IN = OFF_W3OUT + SZ_SQ;
constexpr size_t OFF_W1G = OFF_W1IN + (size_t)2816 * 1024 * 2;
constexpr size_t OFF_W1OUT = OFF_W1G + (size_t)16 * 4 * 96 * 96 * 2;
constexpr size_t OFF_W2IN = OFF_W1OUT + (size_t)1024 * 1408 * 2;
constexpr size_t OFF_W2OUT = OFF_W2IN + (size_t)4096 * 1024 * 2;
constexpr size_t OFF_XC = OFF_W2OUT + SZ_SQ;
constexpr size_t OFF_BON = OFF_XC + (size_t)MC * 1024 * 4;
constexpr size_t OFF_BIG = OFF_BON + (size_t)2 * MT * 16 * 4;
constexpr size_t OFF_HB = OFF_BIG;
constexpr size_t OFF_A0 = OFF_BIG + SZ_ACT;
constexpr size_t OFF_A1 = OFF_A0 + SZ_ACT;
constexpr size_t OFF_A2 = OFF_A1 + SZ_ACT;
constexpr size_t OFF_A3 = OFF_A2 + SZ_ACT;
constexpr size_t OFF_A4 = OFF_A3 + SZ_ACT;
constexpr size_t OFF_WD = OFF_A4 + SZ_ACT;
constexpr size_t OFF_AD = OFF_WD + (size_t)MT * 128 * 2;
constexpr size_t WS_END = OFF_AD + (size_t)MT * 128 * 2;
constexpr size_t SZ_LRU = (size_t)MT * LW * 2;
constexpr size_t OFF_HS0 = OFF_BIG;
constexpr size_t OFF_XR = OFF_BIG + SZ_LRU;
constexpr size_t OFF_GG = OFF_XR + SZ_LRU;
constexpr size_t OFF_HS1 = OFF_GG + SZ_LRU;
static_assert(OFF_HS1 + SZ_LRU <= WS_END, "lru overlay");
static_assert(WS_END <= (size_t)536870912, "ws");

struct Params {
  const float* in[45];
  float* out;
  char* ws;
  int ph_lo, ph_hi;
};

DEVI u32x4 mk4(unsigned a, unsigned b, unsigned c, unsigned d) { u32x4 r = {a, b, c, d}; return r; }
DEVI float bf_lo(unsigned u) { return __uint_as_float(u << 16); }
DEVI float bf_hi(unsigned u) { return __uint_as_float(u & 0xffff0000u); }
DEVI float bf2f(bf16_t h) { return __uint_as_float(((unsigned)h) << 16); }
DEVI unsigned pk_bf16(float lo, float hi) { unsigned r; asm("v_cvt_pk_bf16_f32 %0, %1, %2" : "=v"(r) : "v"(lo), "v"(hi)); return r; }
DEVI bf16_t f2bf(float f) { return (bf16_t)(pk_bf16(f, 0.f) & 0xffffu); }
DEVI float wave_sum(float v) {
#pragma unroll
  for (int o = 32; o; o >>= 1) v += __shfl_xor(v, o);
  return v;
}
DEVI float sigmoidf_(float x) { return __builtin_amdgcn_rcpf(1.f + __expf(-x)); }
DEVI float siluf_(float x) { return x * __builtin_amdgcn_rcpf(1.f + __expf(-x)); }
DEVI float softplusf_(float x) { return fmaxf(x, 0.f) + __logf(1.f + __expf(-fabsf(x))); }
DEVI f32x16 mfma32(u32x4 a, u32x4 b, f32x16 c) {
  return __builtin_amdgcn_mfma_f32_32x32x16_bf16(__builtin_bit_cast(bf16x8, a), __builtin_bit_cast(bf16x8, b), c, 0, 0, 0);
}
DEVI f32x4 mfma16(u32x4 a, u32x4 b, f32x4 c) {
  return __builtin_amdgcn_mfma_f32_16x16x32_bf16(__builtin_bit_cast(bf16x8, a), __builtin_bit_cast(bf16x8, b), c, 0, 0, 0);
}
template <int CTRL> DEVI float dpp_f(float v) {
  return __int_as_float(__builtin_amdgcn_update_dpp(0, __float_as_int(v), CTRL, 0xf, 0xf, true));
}
DEVI float sum8(float v) {
  v += dpp_f<0xB1>(v);
  v += dpp_f<0x4E>(v);
  v += dpp_f<0x141>(v);
  return v;
}

#define XB_TMO      128
#define XB_XCNT(j)  (256  + 64 * (j))
#define XB_XSUB(j)  (1280 + 64 * (j))
#define XB_XGEN(j)  (2304 + 64 * (j))
#define XB_TOP      3328
#define XB_TOPGEN   3392
#define XCD_BAR_WORDS 3456
#define XB_SPIN_CAP (1u << 18)
#define LAS __attribute__((address_space(3)))

__device__ __forceinline__ unsigned xb_ld(unsigned* p)              { return __hip_atomic_load(p, __ATOMIC_RELAXED, __HIP_MEMORY_SCOPE_AGENT); }
__device__ __forceinline__ unsigned xb_add(unsigned* p, unsigned v) { return __hip_atomic_fetch_add(p, v, __ATOMIC_RELAXED, __HIP_MEMORY_SCOPE_AGENT); }
__device__ __forceinline__ unsigned xb_xcc_id() { return (unsigned)__builtin_amdgcn_s_getreg((3 << 11) | 20) & 0xFu; }
#define XB_SPIN(cond, bar) do { unsigned _sp = 0; while (cond) { __builtin_amdgcn_s_sleep(1); \
    if ((++_sp & 255u) == 0u) { if (xb_ld(&(bar)[XB_TMO])) break; if (_sp > XB_SPIN_CAP) { atomicAdd(&(bar)[XB_TMO], 1u); break; } } } } while (0)

struct XcdBarrier {
    unsigned* bar; unsigned x;
    volatile LAS unsigned* st;
};

__device__ __forceinline__ XcdBarrier xcd_barrier_post(unsigned* bar, volatile LAS unsigned* st) {
    XcdBarrier b; b.bar = bar; b.x = xb_xcc_id(); b.st = st;
    if (threadIdx.x == 0) (void)xb_add(&bar[XB_XCNT(b.x)], 1u);
    return b;
}
__device__ __forceinline__ void xcd_barrier_complete(unsigned* bar, unsigned x, unsigned& nloc, unsigned& nx) {
    const unsigned G = gridDim.x * gridDim.y * gridDim.z;
    unsigned sum, cnt, mine, sp = 0u;
    for (;;) {
        sum = 0u; cnt = 0u; mine = 0u;
#pragma unroll
        for (unsigned j = 0; j < 16; ++j) { const unsigned c = xb_ld(&bar[XB_XCNT(j)]); sum += c; cnt += (c > 0u) ? 1u : 0u; mine = (j == x) ? c : mine; }
        if (sum == G) break;
        __builtin_amdgcn_s_sleep(1);
        if ((++sp & 255u) == 0u) { if (xb_ld(&bar[XB_TMO])) break; if (sp > XB_SPIN_CAP) { atomicAdd(&bar[XB_TMO], 1u); break; } }
    }
    nloc = mine > 0u ? mine : 1u; nx = cnt > 0u ? cnt : 1u;
}

__device__ __forceinline__ void xcd_barrier(const XcdBarrier& b) {
    asm volatile("s_waitcnt vmcnt(0)" ::: "memory");
    __syncthreads();
    if (threadIdx.x == 0) {
        unsigned* bar = b.bar;
        __builtin_amdgcn_s_waitcnt(0);
        unsigned nloc = b.st[0], nx = b.st[1];
        if (nloc == 0u) { xcd_barrier_complete(bar, b.x, nloc, nx); b.st[0] = nloc; b.st[1] = nx; }
        const unsigned old = xb_add(&bar[XB_XSUB(b.x)], 1u);
        const unsigned gen = old / nloc;
        if (old + 1u == (gen + 1u) * nloc) {
            __builtin_amdgcn_fence(__ATOMIC_RELEASE, "agent");
            asm volatile("s_waitcnt vmcnt(0)" ::: "memory");
            const unsigned og = xb_add(&bar[XB_TOP], 1u);
            const unsigned tg = og / nx;
            if (og + 1u == (tg + 1u) * nx) xb_add(&bar[XB_TOPGEN], 1u);
            else XB_SPIN(xb_ld(&bar[XB_TOPGEN]) == tg, bar);
            __builtin_amdgcn_fence(__ATOMIC_ACQUIRE, "agent");
            xb_add(&bar[XB_XGEN(b.x)], 1u);
            asm volatile("s_waitcnt vmcnt(0)" ::: "memory");
        } else {
            XB_SPIN(xb_ld(&bar[XB_XGEN(b.x)]) == gen, bar);
            __builtin_amdgcn_fence(__ATOMIC_ACQUIRE, "agent");
            asm volatile("s_waitcnt vmcnt(0)" ::: "memory");
        }
    }
    __syncthreads();
}


struct TJob { const float* src; int K, N; bf16_t* dst; int ldd; };

DEVI TJob get_tjob(const Params& p, int j) {
  TJob t;
  if (j < 26) {
    const int l = j / 13, jj = j % 13;
    const int ib = l ? 33 : 4;
    bf16_t* win = (bf16_t*)(p.ws + (l ? OFF_W3IN : OFF_W0IN));
    bf16_t* wup = (bf16_t*)(p.ws + (l ? OFF_W3UP : OFF_W0UP));
    bf16_t* wout = (bf16_t*)(p.ws + (l ? OFF_W3OUT : OFF_W0OUT));
    if (jj < 4) { t.src = p.in[ib + 3] + (size_t)jj * 1048576; t.K = 1024; t.N = 1024; t.dst = win + (size_t)jj * 1048576; t.ldd = 1024; }
    else if (jj < 8) { const int idx = jj - 4, d = idx >> 1, kind = idx & 1;
      t.src = p.in[ib + 6] + (size_t)idx * 65536; t.K = 1024; t.N = 64; t.dst = win + (size_t)(4096 + kind * 128 + d * 64) * 1024; t.ldd = 1024; }
    else if (jj < 12) { const int idx = jj - 8;
      t.src = p.in[ib + 7] + (size_t)idx * 65536; t.K = 64; t.N = 1024; t.dst = wup + (size_t)idx * 65536; t.ldd = 64; }
    else { t.src = p.in[ib + 11]; t.K = 1024; t.N = 1024; t.dst = wout; t.ldd = 1024; }
  } else if (j == 26) { t.src = p.in[19]; t.K = 1024; t.N = 2816; t.dst = (bf16_t*)(p.ws + OFF_W1IN); t.ldd = 1024; }
  else if (j == 27) { t.src = p.in[25]; t.K = 1408; t.N = 1024; t.dst = (bf16_t*)(p.ws + OFF_W1OUT); t.ldd = 1408; }
  else if (j == 28) { t.src = p.in[29]; t.K = 1024; t.N = 4096; t.dst = (bf16_t*)(p.ws + OFF_W2IN); t.ldd = 1024; }
  else { t.src = p.in[32]; t.K = 1024; t.N = 1024; t.dst = (bf16_t*)(p.ws + OFF_W2OUT); t.ldd = 1024; }
  return t;
}

__device__ __forceinline__ void phase0(const Params& p, char* lds) {
  const int tid = threadIdx.x;
  {
    bf16_t* wg = (bf16_t*)(p.ws + OFF_W1G);
    const float* gw = p.in[22];
    const int total = 16 * 4 * 96 * 96;
    for (int e = blockIdx.x * NTHR + tid; e < total; e += gridDim.x * NTHR) {
      const int k = e % 96, n = (e / 96) % 96, dg = (e / 9216) & 3, blk = e / 36864;
      float v = 0.f;
      if (k < 88 && n < 88) v = gw[((size_t)(dg * 16 + blk) * 88 + k) * 88 + n];
      wg[e] = f2bf(v);
    }
  }
  constexpr int N_MOD_ITEMS = 96;
  constexpr int N_TILES = 5152;
  float* act = (float*)lds;
  float* red = (float*)(lds + 36864);
  float* tl = (float*)lds;
  for (int item = blockIdx.x; item < N_MOD_ITEMS + N_TILES; item += gridDim.x) {
    __syncthreads();
    if (item < N_MOD_ITEMS) {
      const int L = item / 24, nc = item % 24;
      const int ib = (L == 0) ? 4 : (L == 1) ? 16 : (L == 2) ? 26 : 33;
      const float* ada_w = p.in[ib + 1];
      const float* ada_b = p.in[ib + 2];
      for (int e = tid; e < 9 * 1024; e += NTHR) {
        const int i = e >> 10, k = e & 1023;
        const float c = (i < 8) ? p.in[1][i * 1024 + k] : p.in[3][k];
        act[e] = siluf_(c);
      }
      __syncthreads();
      const int kq = tid >> 7, nl = tid & 127, n = nc * 128 + nl;
      float acc[9];
#pragma unroll
      for (int i = 0; i < 9; ++i) acc[i] = 0.f;
      for (int k = kq * 256; k < kq * 256 + 256; ++k) {
        const float w = ada_w[(size_t)k * 3072 + n];
#pragma unroll
        for (int i = 0; i < 9; ++i) acc[i] += act[i * 1024 + k] * w;
      }
#pragma unroll
      for (int i = 0; i < 9; ++i) red[(kq * 9 + i) * 128 + nl] = acc[i];
      __syncthreads();
      float* mod = (float*)(p.ws + OFF_MOD) + (size_t)L * 9 * 3072;
      for (int e = tid; e < 9 * 128; e += NTHR) {
        const int i = e >> 7, c = e & 127;
        const float s = red[(0 * 9 + i) * 128 + c] + red[(1 * 9 + i) * 128 + c] + red[(2 * 9 + i) * 128 + c] + red[(3 * 9 + i) * 128 + c];
        mod[i * 3072 + nc * 128 + c] = s + ada_b[nc * 128 + c];
      }
    } else {
      int t = item - N_MOD_ITEMS;
      int j = 0;
      TJob job = get_tjob(p, 0);
      for (;;) {
        const int nt = (job.K >> 6) * (job.N >> 6);
        if (t < nt) break;
        t -= nt; ++j; job = get_tjob(p, j);
      }
      const int ntn = job.N >> 6;
      const int k0 = (t / ntn) * 64, n0 = (t % ntn) * 64;
#pragma unroll
      for (int i = 0; i < 2; ++i) {
        const int k = (tid >> 4) + 32 * i, n4 = (tid & 15) * 4;
        const float4 v = *(const float4*)(job.src + (size_t)(k0 + k) * job.N + n0 + n4);
        tl[k * 65 + n4 + 0] = v.x; tl[k * 65 + n4 + 1] = v.y; tl[k * 65 + n4 + 2] = v.z; tl[k * 65 + n4 + 3] = v.w;
      }
      __syncthreads();
      const int n = tid >> 3, k8 = (tid & 7) * 8;
      u32x4 o;
      o.x = pk_bf16(tl[(k8 + 0) * 65 + n], tl[(k8 + 1) * 65 + n]);
      o.y = pk_bf16(tl[(k8 + 2) * 65 + n], tl[(k8 + 3) * 65 + n]);
      o.z = pk_bf16(tl[(k8 + 4) * 65 + n], tl[(k8 + 5) * 65 + n]);
      o.w = pk_bf16(tl[(k8 + 6) * 65 + n], tl[(k8 + 7) * 65 + n]);
      *(u32x4*)(job.dst + (size_t)(n0 + n) * job.ldd + k0 + k8) = o;
    }
  }
}

DEVI void norm_row(const float* __restrict__ xr, const float* __restrict__ g, const float* __restrict__ mod, int lane, float (&h)[16]) {
  float4 x[4];
  float ss = 0.f;
#pragma unroll
  for (int i = 0; i < 4; ++i) {
    x[i] = *(const float4*)(xr + lane * 4 + 256 * i);
    ss += x[i].x * x[i].x + x[i].y * x[i].y + x[i].z * x[i].z + x[i].w * x[i].w;
  }
  ss = wave_sum(ss);
  const float rstd = rsqrtf(ss * (1.f / 1024.f) + 1e-6f);
#pragma unroll
  for (int i = 0; i < 4; ++i) {
    const int c = lane * 4 + 256 * i;
    const float4 gg = *(const float4*)(g + c);
    const float4 sh = *(const float4*)(mod + c);
    const float4 sc = *(const float4*)(mod + 1024 + c);
    h[i * 4 + 0] = x[i].x * rstd * gg.x * (1.f + sc.x) + sh.x;
    h[i * 4 + 1] = x[i].y * rstd * gg.y * (1.f + sc.y) + sh.y;
    h[i * 4 + 2] = x[i].z * rstd * gg.z * (1.f + sc.z) + sh.z;
    h[i * 4 + 3] = x[i].w * rstd * gg.w * (1.f + sc.w) + sh.w;
  }
}

template <bool WITH_HS>
__device__ __forceinline__ void norm_phase(const float* __restrict__ xl, const float* __restrict__ xc, const float* __restrict__ g,
                           const float* __restrict__ modL, bf16_t* __restrict__ H, bf16_t* __restrict__ HS) {
  const int lane = threadIdx.x & 63;
  const int gw = blockIdx.x * (NTHR / 64) + (threadIdx.x >> 6), nw = gridDim.x * (NTHR / 64);
  for (int row = gw; row < MT; row += nw) {
    const bool lat = row < ML;
    const float* xbase = lat ? xl + (size_t)row * 1024 : xc + (size_t)(row - ML) * 1024;
    const float* mod = modL + (lat ? (row >> 12) : 8) * 3072;
    float h[16];
    norm_row(xbase, g, mod, lane, h);
#pragma unroll
    for (int i = 0; i < 4; ++i) {
      u32x2 o; o.x = pk_bf16(h[i * 4], h[i * 4 + 1]); o.y = pk_bf16(h[i * 4 + 2], h[i * 4 + 3]);
      *(u32x2*)(H + (size_t)row * 1024 + lane * 4 + 256 * i) = o;
    }
    if (WITH_HS) {
      const int t = lat ? (row & 4095) : ((row - ML) & 255);
      const int T = lat ? 4096 : 256;
      float s[16];
#pragma unroll
      for (int i = 0; i < 16; ++i) s[i] = 0.f;
      if (t > 0) { float hp[16]; norm_row(xbase - 1024, g, mod, lane, hp);
#pragma unroll
        for (int i = 0; i < 16; ++i) s[i] += hp[i]; }
      if (t < T - 1) { float hn[16]; norm_row(xbase + 1024, g, mod, lane, hn);
#pragma unroll
        for (int i = 0; i < 16; ++i) s[i] += hn[i]; }
#pragma unroll
      for (int i = 0; i < 4; ++i) {
        u32x2 o; o.x = pk_bf16(0.5f * s[i * 4], 0.5f * s[i * 4 + 1]); o.y = pk_bf16(0.5f * s[i * 4 + 2], 0.5f * s[i * 4 + 3]);
        *(u32x2*)(HS + (size_t)row * 1024 + lane * 4 + 256 * i) = o;
      }
    }
  }
}

struct ALPlain {
  const bf16_t* A; int lda;
  typedef u32x4 Regs;
  DEVI void stage(float*, int) const {}
  DEVI void issue(Regs& r, int row, int k) const { r = *(const u32x4*)(A + (size_t)row * lda + k); }
  DEVI u32x4 finish(const Regs& r, const float*, int) const { return r; }
};
struct ALMix {
  const bf16_t* H; const bf16_t* HS; const float* mu;
  struct Regs { u32x4 h, s; };
  DEVI void stage(float* sMu, int n0) const {
    const int grp = n0 >> 10;
    const int j = grp == 0 ? 0 : grp == 1 ? 2 : grp == 2 ? 3 : grp == 3 ? 5 : (n0 - 4096) < 128 ? 1 : 4;
    for (int e = threadIdx.x; e < 1024; e += NTHR) sMu[e] = mu[j * 1024 + e];
  }
  DEVI void issue(Regs& r, int row, int k) const {
    r.h = *(const u32x4*)(H + (size_t)row * 1024 + k);
    r.s = *(const u32x4*)(HS + (size_t)row * 1024 + k);
  }
  DEVI unsigned mix2(unsigned h, unsigned s, float m0, float m1) const {
    const float h0 = bf_lo(h), h1 = bf_hi(h), s0 = bf_lo(s), s1 = bf_hi(s);
    return pk_bf16(h0 + (s0 - h0) * m0, h1 + (s1 - h1) * m1);
  }
  DEVI u32x4 finish(const Regs& r, const float* sMu, int k) const {
    const float4 ma = *(const float4*)(sMu + k), mb = *(const float4*)(sMu + k + 4);
    u32x4 o;
    o.x = mix2(r.h.x, r.s.x, ma.x, ma.y); o.y = mix2(r.h.y, r.s.y, ma.z, ma.w);
    o.z = mix2(r.h.z, r.s.z, mb.x, mb.y); o.w = mix2(r.h.w, r.s.w, mb.z, mb.w);
    return o;
  }
};

template <class AL, class EP>
__device__ __forceinline__ void gemm_phase(char* lds, const bf16_t* __restrict__ Bt, int K, int mtiles, int ntiles, const AL al, const EP ep, int n_base = 0, bool reverse = false) {
  bf16_t* sA = (bf16_t*)lds;
  bf16_t* sB = (bf16_t*)(lds + 73728);
  float* sMu = (float*)(lds + 110592);
  const int tid = threadIdx.x, lane = tid & 63, wv = tid >> 6, wm = wv >> 1, wn = wv & 1;
  const int l31 = lane & 31, lh = lane >> 5;
  const int nk = K >> 6;
  const int ldrow = tid >> 3, ldk = (tid & 7) * 8;
  const int total = mtiles * ntiles;
  const int bid = reverse ? (int)(gridDim.x - 1 - blockIdx.x) : (int)blockIdx.x;
  const int nslots = gridDim.x >> 3, xcd = bid & 7, slot = bid >> 3;
  const int gm = 4 * ntiles;
  for (int chunk = xcd; chunk * nslots < total; chunk += 8) {
    const int tile = chunk * nslots + slot;
    if (tile >= total) break;
    const int grp = tile / gm, rem = tile - grp * gm;
    const int mt = grp * 4 + (rem & 3), nt = rem >> 2;
    const int m0 = mt * 256, n0 = n_base + nt * 128;
    __syncthreads();
    al.stage(sMu, n0);
    f32x16 acc[2][2];
#pragma unroll
    for (int a = 0; a < 2; ++a)
#pragma unroll
      for (int b = 0; b < 2; ++b)
#pragma unroll
        for (int r = 0; r < 16; ++r) acc[a][b][r] = 0.f;
    typename AL::Regs ar[4];
    u32x4 br[2];
#pragma unroll
    for (int i = 0; i < 4; ++i) al.issue(ar[i], m0 + ldrow + 64 * i, ldk);
#pragma unroll
    for (int i = 0; i < 2; ++i) br[i] = *(const u32x4*)(Bt + (size_t)(n0 + ldrow + 64 * i) * K + ldk);
    __syncthreads();
#pragma unroll
    for (int i = 0; i < 4; ++i) *(u32x4*)(sA + (ldrow + 64 * i) * 72 + ldk) = al.finish(ar[i], sMu, ldk);
#pragma unroll
    for (int i = 0; i < 2; ++i) *(u32x4*)(sB + (ldrow + 64 * i) * 72 + ldk) = br[i];
    __syncthreads();
    for (int kt = 0; kt < nk; ++kt) {
      const int cur = kt & 1;
      const bool more = (kt + 1) < nk;
      const int k0n = (kt + 1) * 64 + ldk;
      if (more) {
#pragma unroll
        for (int i = 0; i < 4; ++i) al.issue(ar[i], m0 + ldrow + 64 * i, k0n);
#pragma unroll
        for (int i = 0; i < 2; ++i) br[i] = *(const u32x4*)(Bt + (size_t)(n0 + ldrow + 64 * i) * K + k0n);
      }
      __builtin_amdgcn_sched_barrier(0);
      const bf16_t* a_ = sA + cur * (256 * 72);
      const bf16_t* b_ = sB + cur * (128 * 72);
#pragma unroll
      for (int kk = 0; kk < 4; ++kk) {
        u32x4 af[2], bfr[2];
#pragma unroll
        for (int mi = 0; mi < 2; ++mi) af[mi] = *(const u32x4*)(a_ + (wm * 64 + mi * 32 + l31) * 72 + kk * 16 + lh * 8);
#pragma unroll
        for (int ni = 0; ni < 2; ++ni) bfr[ni] = *(const u32x4*)(b_ + (wn * 64 + ni * 32 + l31) * 72 + kk * 16 + lh * 8);
#pragma unroll
        for (int mi = 0; mi < 2; ++mi)
#pragma unroll
          for (int ni = 0; ni < 2; ++ni) acc[mi][ni] = mfma32(bfr[ni], af[mi], acc[mi][ni]);
      }
      __builtin_amdgcn_sched_barrier(0);
      if (more) {
        bf16_t* an = sA + (cur ^ 1) * (256 * 72);
        bf16_t* bn = sB + (cur ^ 1) * (128 * 72);
#pragma unroll
        for (int i = 0; i < 4; ++i) *(u32x4*)(an + (ldrow + 64 * i) * 72 + ldk) = al.finish(ar[i], sMu, k0n);
#pragma unroll
        for (int i = 0; i < 2; ++i) *(u32x4*)(bn + (ldrow + 64 * i) * 72 + ldk) = br[i];
      }
      __syncthreads();
    }
#pragma unroll
    for (int mi = 0; mi < 2; ++mi)
#pragma unroll
      for (int ni = 0; ni < 2; ++ni)
#pragma unroll
        for (int q = 0; q < 4; ++q) {
          const int row = m0 + wm * 64 + mi * 32 + l31;
          const int col = n0 + wn * 64 + ni * 32 + 8 * q + 4 * lh;
          f32x4 v = {acc[mi][ni][4 * q], acc[mi][ni][4 * q + 1], acc[mi][ni][4 * q + 2], acc[mi][ni][4 * q + 3]};
          ep(row, col, v);
        }
  }
}


template <class AL, class EP>
__device__ __forceinline__ void gemm256_phase(char* lds, const bf16_t* __restrict__ Bt, int K, int mtiles, int ntiles, const AL al, const EP ep) {
  bf16_t* sA = (bf16_t*)lds;
  bf16_t* sB = (bf16_t*)(lds + 73728);
  float* sMu = (float*)(lds + 147456);
  const int tid = threadIdx.x, lane = tid & 63, wv = tid >> 6, wm = wv >> 1, wn = wv & 1;
  const int l31 = lane & 31, lh = lane >> 5;
  const int nk = K >> 6;
  const int ldrow = tid >> 3, ldk = (tid & 7) * 8;
  const int total = mtiles * ntiles;
  const int nslots = gridDim.x >> 3, xcd = blockIdx.x & 7, slot = blockIdx.x >> 3;
  const int gm = 4 * ntiles;
  for (int chunk = xcd; chunk * nslots < total; chunk += 8) {
    const int tile = chunk * nslots + slot;
    if (tile >= total) break;
    const int grp = tile / gm, rem = tile - grp * gm;
    const int mt = grp * 4 + (rem & 3), nt = rem >> 2;
    const int m0 = mt * 256, n0 = nt * 256;
    __syncthreads();
    al.stage(sMu, n0);
    f32x16 acc[2][4];
#pragma unroll
    for (int a = 0; a < 2; ++a)
#pragma unroll
      for (int b = 0; b < 4; ++b)
#pragma unroll
        for (int r = 0; r < 16; ++r) acc[a][b][r] = 0.f;
    typename AL::Regs ar[4];
    u32x4 br[4];
#pragma unroll
    for (int i = 0; i < 4; ++i) al.issue(ar[i], m0 + ldrow + 64 * i, ldk);
#pragma unroll
    for (int i = 0; i < 4; ++i) br[i] = *(const u32x4*)(Bt + (size_t)(n0 + ldrow + 64 * i) * K + ldk);
    __syncthreads();
#pragma unroll
    for (int i = 0; i < 4; ++i) *(u32x4*)(sA + (ldrow + 64 * i) * 72 + ldk) = al.finish(ar[i], sMu, ldk);
#pragma unroll
    for (int i = 0; i < 4; ++i) *(u32x4*)(sB + (ldrow + 64 * i) * 72 + ldk) = br[i];
    __syncthreads();
    for (int kt = 0; kt < nk; ++kt) {
      const int cur = kt & 1;
      const bool more = (kt + 1) < nk;
      const int k0n = (kt + 1) * 64 + ldk;
      if (more) {
#pragma unroll
        for (int i = 0; i < 4; ++i) al.issue(ar[i], m0 + ldrow + 64 * i, k0n);
#pragma unroll
        for (int i = 0; i < 4; ++i) br[i] = *(const u32x4*)(Bt + (size_t)(n0 + ldrow + 64 * i) * K + k0n);
      }
      __builtin_amdgcn_sched_barrier(0);
      const bf16_t* a_ = sA + cur * (256 * 72);
      const bf16_t* b_ = sB + cur * (256 * 72);
#pragma unroll
      for (int kk = 0; kk < 4; ++kk) {
        u32x4 af[2];
#pragma unroll
        for (int mi = 0; mi < 2; ++mi) af[mi] = *(const u32x4*)(a_ + (wm * 64 + mi * 32 + l31) * 72 + kk * 16 + lh * 8);
#pragma unroll
        for (int ni = 0; ni < 4; ++ni) {
          const u32x4 bfr = *(const u32x4*)(b_ + (wn * 128 + ni * 32 + l31) * 72 + kk * 16 + lh * 8);
#pragma unroll
          for (int mi = 0; mi < 2; ++mi) acc[mi][ni] = mfma32(bfr, af[mi], acc[mi][ni]);
        }
      }
      __builtin_amdgcn_sched_barrier(0);
      if (more) {
        bf16_t* an = sA + (cur ^ 1) * (256 * 72);
        bf16_t* bn = sB + (cur ^ 1) * (256 * 72);
#pragma unroll
        for (int i = 0; i < 4; ++i) *(u32x4*)(an + (ldrow + 64 * i) * 72 + ldk) = al.finish(ar[i], sMu, k0n);
#pragma unroll
        for (int i = 0; i < 4; ++i) *(u32x4*)(bn + (ldrow + 64 * i) * 72 + ldk) = br[i];
      }
      __syncthreads();
    }
#pragma unroll
    for (int mi = 0; mi < 2; ++mi)
#pragma unroll
      for (int ni = 0; ni < 4; ++ni) {
#pragma unroll
        for (int q = 0; q < 4; ++q) {
          const int row = m0 + wm * 64 + mi * 32 + l31;
          const int col = n0 + wn * 128 + ni * 32 + 8 * q + 4 * lh;
          f32x4 v = {acc[mi][ni][4 * q], acc[mi][ni][4 * q + 1], acc[mi][ni][4 * q + 2], acc[mi][ni][4 * q + 3]};
          ep(row, col, v);
        }
        __builtin_amdgcn_sched_barrier(0);
      }
  }
}

DEVI void st_bf16x4(bf16_t* p, f32x4 v) { u32x2 o; o.x = pk_bf16(v[0], v[1]); o.y = pk_bf16(v[2], v[3]); *(u32x2*)p = o; }

struct EpRwkvIn {
  bf16_t *R, *K, *V, *G, *WD, *AD;
  DEVI void operator()(int row, int col, f32x4 v) const {
    const int grp = col >> 10;
    if (grp < 4) {
      const int c = col & 1023;
      bf16_t* dst = grp == 0 ? R : grp == 1 ? K : grp == 2 ? V : G;
      if (grp == 3) { v[0] = siluf_(v[0]); v[1] = siluf_(v[1]); v[2] = siluf_(v[2]); v[3] = siluf_(v[3]); }
      st_bf16x4(dst + (size_t)row * 1024 + c, v);
    } else {
      const int c = col - 4096;
      if (c < 128) {
#pragma unroll
        for (int i = 0; i < 4; ++i) { const float t = __expf(2.f * v[i]); v[i] = 1.f - 2.f / (t + 1.f); }
        st_bf16x4(WD + (size_t)row * 128 + c, v);
      } else st_bf16x4(AD + (size_t)row * 128 + (c - 128), v);
    }
  }
};
struct EpRes {
  const float* xl_src; const float* xc_src; float* xl_dst; float* xc_dst; const float* modL;
  DEVI void operator()(int row, int col, f32x4 v) const {
    const bool lat = row < ML;
    const size_t off = lat ? (size_t)row * 1024 + col : (size_t)(row - ML) * 1024 + col;
    const float* src = (lat ? xl_src : xc_src) + off;
    float* dst = (lat ? xl_dst : xc_dst) + off;
    const f32x4 g = *(const f32x4*)(modL + (lat ? (row >> 12) : 8) * 3072 + 2048 + col);
    f32x4 x = *(const f32x4*)src;
    x += g * v;
    *(f32x4*)dst = x;
  }
};
struct EpLruIn {
  bf16_t *XR, *GG;
  DEVI void operator()(int row, int col, f32x4 v) const {
    if (col < LW) st_bf16x4(XR + (size_t)row * LW + col, v);
    else { v[0] = siluf_(v[0]); v[1] = siluf_(v[1]); v[2] = siluf_(v[2]); v[3] = siluf_(v[3]); st_bf16x4(GG + (size_t)row * LW + (col - LW), v); }
  }
};
struct EpNatIn {
  bf16_t *Q, *K, *VT, *G;
  DEVI void operator()(int row, int col, f32x4 v) const {
    const int grp = col >> 10, c = col & 1023;
    if (grp == 0) st_bf16x4(Q + (size_t)row * 1024 + c, v);
    else if (grp == 1) st_bf16x4(K + (size_t)row * 1024 + c, v);
    else if (grp == 3) { v[0] = siluf_(v[0]); v[1] = siluf_(v[1]); v[2] = siluf_(v[2]); v[3] = siluf_(v[3]); st_bf16x4(G + (size_t)row * 1024 + c, v); }
    else {
      unsigned idx, T;
      if (row < ML) { const unsigned b = row >> 12, t = row & 4095; T = 4096u; idx = ((b * 1024u + (unsigned)c) << 12) + t; }
      else { const unsigned r2 = row - ML; const unsigned b = r2 >> 8, t = r2 & 255; T = 256u; idx = (unsigned)ML * 1024u + ((b * 1024u + (unsigned)c) << 8) + t; }
#pragma unroll
      for (int i = 0; i < 4; ++i) VT[idx + (unsigned)i * T] = f2bf(v[i]);
    }
  }
};

constexpr int SSTR = 388;
DEVI int rwkv_row(int b, int d, int s) {
  if (s < 256) return ML + b * 256 + (d ? 255 - s : s);
  const int t = s - 256;
  return b * 4096 + (d ? 4095 - t : t);
}

struct ScanRec { f32x4 n0, n1, r0, r1, w0, w1, k0, k1, d0, d1; f32x2 vv, cc; };
DEVI void scan_load(ScanRec& R, const float* rec, int sp, int row0) {
  R.n0 = *(const f32x4*)(rec + 8 * sp);        R.n1 = *(const f32x4*)(rec + 8 * sp + 4);
  R.r0 = *(const f32x4*)(rec + 64 + 8 * sp);   R.r1 = *(const f32x4*)(rec + 64 + 8 * sp + 4);
  R.w0 = *(const f32x4*)(rec + 128 + 8 * sp);  R.w1 = *(const f32x4*)(rec + 128 + 8 * sp + 4);
  R.k0 = *(const f32x4*)(rec + 192 + 8 * sp);  R.k1 = *(const f32x4*)(rec + 192 + 8 * sp + 4);
  R.d0 = *(const f32x4*)(rec + 256 + 8 * sp);  R.d1 = *(const f32x4*)(rec + 256 + 8 * sp + 4);
  R.vv = *(const f32x2*)(rec + 320 + row0);
  R.cc = *(const f32x2*)(rec + 384);
}
DEVI f32x2 lo2(f32x4 v) { return (f32x2){v[0], v[1]}; }
DEVI f32x2 hi2(f32x4 v) { return (f32x2){v[2], v[3]}; }
DEVI float dot8(const f32x2 (&S)[4], f32x4 a, f32x4 b) {
  f32x2 acc = S[0] * lo2(a);
  acc = S[1] * hi2(a) + acc;
  acc = S[2] * lo2(b) + acc;
  acc = S[3] * hi2(b) + acc;
  return acc[0] + acc[1];
}
DEVI void upd8(f32x2 (&S)[4], const ScanRec& R, float sa, float v) {
  const f32x2 sa2 = {sa, sa}, v2 = {v, v};
  S[0] = S[0] * lo2(R.w0) + (sa2 * lo2(R.k0) + v2 * lo2(R.d0));
  S[1] = S[1] * hi2(R.w0) + (sa2 * hi2(R.k0) + v2 * hi2(R.d0));
  S[2] = S[2] * lo2(R.w1) + (sa2 * lo2(R.k1) + v2 * lo2(R.d1));
  S[3] = S[3] * hi2(R.w1) + (sa2 * hi2(R.k1) + v2 * hi2(R.d1));
}
DEVI void scan_step(f32x2 (&SA)[4], f32x2 (&SB)[4], const ScanRec& R, float* yout, bool wr) {
  float saA = dot8(SA, R.n0, R.n1), yA = dot8(SA, R.r0, R.r1);
  float saB = dot8(SB, R.n0, R.n1), yB = dot8(SB, R.r0, R.r1);
  saA = sum8(saA); saB = sum8(saB); yA = sum8(yA); yB = sum8(yB);
  upd8(SA, R, saA, R.vv[0]);
  upd8(SB, R, saB, R.vv[1]);
  if (wr) *(f32x2*)yout = (f32x2){yA + saA * R.cc[0] + R.vv[0] * R.cc[1], yB + saB * R.cc[0] + R.vv[1] * R.cc[1]};
}
DEVI float sum16(float v) { v = sum8(v); v += dpp_f<0x140>(v); return v; }

__device__ __forceinline__ void rwkv_scan_phase(char* lds, const bf16_t* __restrict__ R, const bf16_t* __restrict__ Kb, const bf16_t* __restrict__ V,
                                const bf16_t* __restrict__ WD, const bf16_t* __restrict__ AD, const bf16_t* __restrict__ Wup,
                                const float* __restrict__ b0, const float* __restrict__ k_ka, const float* __restrict__ r_k,
                                bf16_t* __restrict__ Y0, bf16_t* __restrict__ Y1, float* __restrict__ BON) {
  float* stepbuf = (float*)lds;
  float* wbuf = stepbuf + 2 * 16 * SSTR;
  float* abuf = wbuf + 1024;
  float* ybuf = abuf + 1024;
  const int tid = threadIdx.x, lane = tid & 63, wv = tid >> 6;
  constexpr int NCH = (256 + 4096) / 16;
  for (int chain = blockIdx.x; chain < 256; chain += gridDim.x) {
    const int d = chain & 1, h = (chain >> 1) & 15, b = chain >> 5;
    __syncthreads();
    if (wv < 4) {
      const int sp = lane & 7, row0 = wv * 16 + (lane >> 3) * 2;
      const bool wr = sp == 0;
      f32x2 SA[4], SB[4];
#pragma unroll
      for (int j = 0; j < 4; ++j) { SA[j] = (f32x2){0.f, 0.f}; SB[j] = (f32x2){0.f, 0.f}; }
      __syncthreads();
      __syncthreads();
      for (int c = 0; c < NCH; ++c) {
        const float* sb = stepbuf + (c & 1) * 16 * SSTR;
        float* yb = ybuf + (c & 1) * 1024 + row0;
        ScanRec ra, rb;
        scan_load(ra, sb, sp, row0);
#pragma unroll
        for (int i = 0; i < 8; i += 2) {
          scan_load(rb, sb + (i + 1) * SSTR, sp, row0);
          scan_step(SA, SB, ra, yb + i * 64, wr);
          scan_load(ra, sb + (i + 2) * SSTR, sp, row0);
          scan_step(SA, SB, rb, yb + (i + 1) * 64, wr);
        }
        __syncthreads();
#pragma unroll
        for (int i = 8; i < 16; i += 2) {
          scan_load(rb, sb + (i + 1) * SSTR, sp, row0);
          scan_step(SA, SB, ra, yb + i * 64, wr);
          if (i + 2 < 16) scan_load(ra, sb + (i + 2) * SSTR, sp, row0);
          scan_step(SA, SB, rb, yb + (i + 1) * 64, wr);
        }
        __syncthreads();
      }
    } else {
      const int ptid = tid - 256, pw = wv - 4;
      bf16_t* Y = d ? Y1 : Y0;
      const int ncol = h * 64 + pw * 16 + (lane & 15);
      u32x4 bu[2][2];
      float bias_u[2];
#pragma unroll
      for (int kind = 0; kind < 2; ++kind) {
        const bf16_t* wu = Wup + ((size_t)(d * 2 + kind) * 1024 + ncol) * 64 + 8 * (lane >> 4);
        bu[kind][0] = *(const u32x4*)wu; bu[kind][1] = *(const u32x4*)(wu + 32);
        bias_u[kind] = b0[(d * 2 + kind) * 1024 + ncol];
      }
      const int ti = ptid >> 4, dq = ptid & 15;
      const int hc = h * 64 + 4 * dq;
      const f32x4 kkv = *(const f32x4*)(k_ka + hc), kav = *(const f32x4*)(k_ka + 1024 + hc), rkv = *(const f32x4*)(r_k + hc);
      u32x4 xw0, xw1, xa0, xa1; u32x2 rr, kr, vr;
      auto issue = [&](int c) {
        const int rowA = rwkv_row(b, d, c * 16 + (lane & 15));
        const bf16_t* xp = WD + (size_t)rowA * 128 + d * 64 + 8 * (lane >> 4);
        const bf16_t* xq = AD + (size_t)rowA * 128 + d * 64 + 8 * (lane >> 4);
        xw0 = *(const u32x4*)xp; xw1 = *(const u32x4*)(xp + 32);
        xa0 = *(const u32x4*)xq; xa1 = *(const u32x4*)(xq + 32);
        const int rowB = rwkv_row(b, d, c * 16 + ti);
        rr = *(const u32x2*)(R + (size_t)rowB * 1024 + hc);
        kr = *(const u32x2*)(Kb + (size_t)rowB * 1024 + hc);
        vr = *(const u32x2*)(V + (size_t)rowB * 1024 + hc);
      };
      auto stepA = [&]() {
        f32x4 accw = {0.f, 0.f, 0.f, 0.f}, acca = {0.f, 0.f, 0.f, 0.f};
        accw = mfma16(xw0, bu[0][0], accw); accw = mfma16(xw1, bu[0][1], accw);
        acca = mfma16(xa0, bu[1][0], acca); acca = mfma16(xa1, bu[1][1], acca);
#pragma unroll
        for (int r = 0; r < 4; ++r) {
          const int o = ((lane >> 4) * 4 + r) * 64 + pw * 16 + (lane & 15);
          const float wl = -softplusf_(-(accw[r] + bias_u[0])) - 0.5f;
          wbuf[o] = __expf(-__expf(wl));
          abuf[o] = sigmoidf_(acca[r] + bias_u[1]);
        }
      };
      auto stepB = [&](int c, float* sb) {
        const float rv[4] = {bf_lo(rr.x), bf_hi(rr.x), bf_lo(rr.y), bf_hi(rr.y)};
        const float kv[4] = {bf_lo(kr.x), bf_hi(kr.x), bf_lo(kr.y), bf_hi(kr.y)};
        const float vv[4] = {bf_lo(vr.x), bf_hi(vr.x), bf_lo(vr.y), bf_hi(vr.y)};
        const f32x4 av = *(const f32x4*)(abuf + ti * 64 + 4 * dq), wv4 = *(const f32x4*)(wbuf + ti * 64 + 4 * dq);
        float q[4], ss = 0.f;
#pragma unroll
        for (int i = 0; i < 4; ++i) { q[i] = kv[i] * kkv[i]; ss += q[i] * q[i]; }
        ss = sum16(ss);
        const float inv = __builtin_amdgcn_rsqf(fmaxf(ss, 1e-24f));
        f32x4 nk, wrr, ka, kd, vo;
        float c1 = 0.f, c2 = 0.f, bn = 0.f;
#pragma unroll
        for (int i = 0; i < 4; ++i) {
          const float n = q[i] * inv;
          kd[i] = kv[i] * (1.f + (av[i] - 1.f) * kav[i]);
          ka[i] = n * av[i];
          nk[i] = -n; wrr[i] = wv4[i] * rv[i]; vo[i] = vv[i];
          c1 += ka[i] * rv[i]; c2 += kd[i] * rv[i]; bn += rv[i] * kd[i] * rkv[i];
        }
        c1 = sum16(c1); c2 = sum16(c2); bn = sum16(bn);
        float* rec = sb + ti * SSTR;
        *(f32x4*)(rec + 4 * dq) = nk;
        *(f32x4*)(rec + 64 + 4 * dq) = wrr;
        *(f32x4*)(rec + 128 + 4 * dq) = wv4;
        *(f32x4*)(rec + 192 + 4 * dq) = ka;
        *(f32x4*)(rec + 256 + 4 * dq) = kd;
        *(f32x4*)(rec + 320 + 4 * dq) = vo;
        if (dq == 0) {
          *(f32x2*)(rec + 384) = (f32x2){c1, c2};
          BON[((size_t)d * MT + rwkv_row(b, d, c * 16 + ti)) * 16 + h] = bn;
        }
      };
      auto storeY = [&](int c) {
        const f32x4 yv = *(const f32x4*)(ybuf + (c & 1) * 1024 + ti * 64 + 4 * dq);
        u32x2 o; o.x = pk_bf16(yv[0], yv[1]); o.y = pk_bf16(yv[2], yv[3]);
        *(u32x2*)(Y + (size_t)rwkv_row(b, d, c * 16 + ti) * 1024 + hc) = o;
      };
      issue(0);
      stepA();
      __syncthreads();
      stepB(0, stepbuf);
      issue(1);
      __syncthreads();
      for (int c = 0; c < NCH; ++c) {
        const bool more = (c + 1) < NCH;
        if (more) stepA();
        if (c >= 1) storeY(c - 1);
        __syncthreads();
        if (more) {
          stepB(c + 1, stepbuf + ((c + 1) & 1) * 16 * SSTR);
          if (c + 2 < NCH) issue(c + 2);
        }
        __builtin_amdgcn_sched_barrier(0);
        __syncthreads();
        __builtin_amdgcn_sched_barrier(0);
      }
      storeY(NCH - 1);
    }
  }
}

__device__ __forceinline__ void rwkv_post_phase(const bf16_t* __restrict__ Y0, const bf16_t* __restrict__ Y1, const bf16_t* __restrict__ V,
                                bf16_t* __restrict__ G, const float* __restrict__ BON, const float* __restrict__ gn, int nrows) {
  const int lane = threadIdx.x & 63;
  const int gw = blockIdx.x * (NTHR / 64) + (threadIdx.x >> 6), nw = gridDim.x * (NTHR / 64);
  const int head = lane >> 2, c0 = lane * 16;
  for (int row = gw; row < nrows; row += nw) {
    const size_t off = (size_t)row * 1024 + c0;
    float y[16], v[16], g[16];
#pragma unroll
    for (int i = 0; i < 2; ++i) {
      const u32x4 a0 = *(const u32x4*)(Y0 + off + 8 * i), a1 = *(const u32x4*)(Y1 + off + 8 * i);
      const u32x4 av = *(const u32x4*)(V + off + 8 * i), ag = *(const u32x4*)(G + off + 8 * i);
      y[8 * i + 0] = bf_lo(a0.x) + bf_lo(a1.x); y[8 * i + 1] = bf_hi(a0.x) + bf_hi(a1.x);
      y[8 * i + 2] = bf_lo(a0.y) + bf_lo(a1.y); y[8 * i + 3] = bf_hi(a0.y) + bf_hi(a1.y);
      y[8 * i + 4] = bf_lo(a0.z) + bf_lo(a1.z); y[8 * i + 5] = bf_hi(a0.z) + bf_hi(a1.z);
      y[8 * i + 6] = bf_lo(a0.w) + bf_lo(a1.w); y[8 * i + 7] = bf_hi(a0.w) + bf_hi(a1.w);
      v[8 * i + 0] = bf_lo(av.x); v[8 * i + 1] = bf_hi(av.x); v[8 * i + 2] = bf_lo(av.y); v[8 * i + 3] = bf_hi(av.y);
      v[8 * i + 4] = bf_lo(av.z); v[8 * i + 5] = bf_hi(av.z); v[8 * i + 6] = bf_lo(av.w); v[8 * i + 7] = bf_hi(av.w);
      g[8 * i + 0] = bf_lo(ag.x); g[8 * i + 1] = bf_hi(ag.x); g[8 * i + 2] = bf_lo(ag.y); g[8 * i + 3] = bf_hi(ag.y);
      g[8 * i + 4] = bf_lo(ag.z); g[8 * i + 5] = bf_hi(ag.z); g[8 * i + 6] = bf_lo(ag.w); g[8 * i + 7] = bf_hi(ag.w);
    }
    float s = 0.f;
#pragma unroll
    for (int i = 0; i < 16; ++i) s += y[i];
    s += __shfl_xor(s, 1); s += __shfl_xor(s, 2);
    const float mean = s * (1.f / 64.f);
    float q = 0.f;
#pragma unroll
    for (int i = 0; i < 16; ++i) { const float dlt = y[i] - mean; q += dlt * dlt; }
    q += __shfl_xor(q, 1); q += __shfl_xor(q, 2);
    const float rstd = rsqrtf(q * (1.f / 64.f) + 64e-5f);
    const float bonus = BON[(size_t)row * 16 + head] + BON[((size_t)MT + row) * 16 + head];
    unsigned o[8];
#pragma unroll
    for (int i = 0; i < 8; ++i) {
      const float z0 = ((y[2 * i] - mean) * rstd * gn[c0 + 2 * i] + gn[1024 + c0 + 2 * i] + bonus * v[2 * i]) * g[2 * i];
      const float z1 = ((y[2 * i + 1] - mean) * rstd * gn[c0 + 2 * i + 1] + gn[1024 + c0 + 2 * i + 1] + bonus * v[2 * i + 1]) * g[2 * i + 1];
      o[i] = pk_bf16(z0, z1);
    }
    *(u32x4*)(G + off) = mk4(o[0], o[1], o[2], o[3]);
    *(u32x4*)(G + off + 8) = mk4(o[4], o[5], o[6], o[7]);
  }
}

__device__ __forceinline__ void rglru_phase(char* lds, const bf16_t* __restrict__ XR, const bf16_t* __restrict__ Wg, const float* __restrict__ conv_w,
                            const float* __restrict__ conv_b, const float* __restrict__ gate_b, const float* __restrict__ lam,
                            bf16_t* __restrict__ HS0, bf16_t* __restrict__ HS1) {
  bf16_t* xcT = (bf16_t*)lds;
  f32x2* AB = (f32x2*)(lds + 26624);
  bf16_t* raw = (bf16_t*)(lds + 26624);
  float* segP = (float*)(lds + 116736);
  float* segH = segP + 352;
  float* segC = segH + 352;
  bf16_t* wgs = (bf16_t*)(lds + 120960);
  float* cws = (float*)(lds + 160896);
  const int tid = threadIdx.x, lane = tid & 63, wv = tid >> 6;
  for (int chain = blockIdx.x; chain < 256; chain += gridDim.x) {
    const int d = chain & 1, blk = (chain >> 1) & 15, b = chain >> 5;
    bf16_t* HS = d ? HS1 : HS0;
    float carry = 0.f;
    __syncthreads();
    for (int q = tid; q < 2 * 96 * 12; q += NTHR) {
      const int g = q / 1152, rem = q - g * 1152, n = rem / 12, k8 = rem - n * 12;
      *(u32x4*)(wgs + (g * 96 + n) * 104 + k8 * 8) = *(const u32x4*)(Wg + ((size_t)((blk * 4 + d * 2 + g) * 96 + n)) * 96 + k8 * 8);
    }
    for (int e = tid; e < 5 * 88; e += NTHR) {
      const int j = e / 88, c = e - j * 88;
      cws[e] = j < 4 ? conv_w[j * LW + blk * 88 + c] : conv_b[blk * 88 + c];
    }
    for (int e = tid; e < 128 * 8; e += NTHR) xcT[(e >> 3) * 104 + 88 + (e & 7)] = 0;
    u32x4 pre[3];
    auto tile_geom = [&](int ti, int& seqbase, int& t0, int& T) {
      if (ti < 2) { seqbase = ML + b * 256; T = 256; t0 = (d ? 1 - ti : ti) * 128; }
      else { seqbase = b * 4096; T = 4096; t0 = (d ? 31 - (ti - 2) : (ti - 2)) * 128; }
    };
    auto prefetch = [&](int ti) {
      int seqbase, t0, T; tile_geom(ti, seqbase, t0, T);
#pragma unroll
      for (int i = 0; i < 3; ++i) {
        const int q = tid + NTHR * i;
        const int row = q / 11, cc = q - row * 11, t = t0 - 2 + row;
        u32x4 v = {0u, 0u, 0u, 0u};
        if (q < 131 * 11 && t >= 0 && t < T) v = *(const u32x4*)(XR + (size_t)(seqbase + t) * LW + blk * 88 + cc * 8);
        pre[i] = v;
      }
    };
    prefetch(0);
    for (int ti = 0; ti < 34; ++ti) {
      int seqbase, t0, T; tile_geom(ti, seqbase, t0, T);
      __syncthreads();
#pragma unroll
      for (int i = 0; i < 3; ++i) {
        const int q = tid + NTHR * i;
        if (q < 131 * 11) *(u32x4*)(raw + q * 8) = pre[i];
      }
      if (ti + 1 < 34) prefetch(ti + 1);
      __builtin_amdgcn_sched_barrier(0);
      __syncthreads();
      for (int e = tid; e < 128 * 44; e += NTHR) {
        const int tl = e / 44, c2 = (e - tl * 44) * 2;
        float a0 = cws[4 * 88 + c2], a1 = cws[4 * 88 + c2 + 1];
#pragma unroll
        for (int j = 0; j < 4; ++j) {
          const unsigned x = *(const unsigned*)(raw + (tl + j) * 88 + c2);
          a0 += bf_lo(x) * cws[j * 88 + c2]; a1 += bf_hi(x) * cws[j * 88 + c2 + 1];
        }
        *(unsigned*)(xcT + tl * 104 + c2) = pk_bf16(a0, a1);
      }
      __syncthreads();
      {
        const int tok = wv * 16 + (lane & 15);
        u32x4 af[3];
#pragma unroll
        for (int kk = 0; kk < 3; ++kk) af[kk] = *(const u32x4*)(xcT + tok * 104 + kk * 32 + 8 * (lane >> 4));
#pragma unroll
        for (int n6 = 0; n6 < 6; ++n6) {
          f32x4 accr = {0.f, 0.f, 0.f, 0.f}, acci = {0.f, 0.f, 0.f, 0.f};
          const int ncol = n6 * 16 + (lane & 15);
          const bf16_t* wr_ = wgs + ncol * 104 + 8 * (lane >> 4);
          const bf16_t* wi_ = wgs + (96 + ncol) * 104 + 8 * (lane >> 4);
#pragma unroll
          for (int kk = 0; kk < 3; ++kk) {
            accr = mfma16(af[kk], *(const u32x4*)(wr_ + kk * 32), accr);
            acci = mfma16(af[kk], *(const u32x4*)(wi_ + kk * 32), acci);
          }
          if (ncol < 88) {
            const int ch = blk * 88 + ncol;
            const float gbr = gate_b[(d * 2 + 0) * LW + ch], gbi = gate_b[(d * 2 + 1) * LW + ch];
            const float spl = softplusf_(-lam[d * LW + ch]);
#pragma unroll
            for (int r = 0; r < 4; ++r) {
              const int tk = wv * 16 + (lane >> 4) * 4 + r;
              const float rg = sigmoidf_(accr[r] + gbr), ig = sigmoidf_(acci[r] + gbi);
              const float a = __expf(-8.f * rg * spl);
              const float bb = sqrtf(fmaxf(1.f - a * a, 0.f)) * ig * bf2f(xcT[tk * 104 + ncol]);
              AB[tk * 88 + ncol] = (f32x2){a, bb};
            }
          }
        }
      }
      __syncthreads();
      if (tid < 352) {
        const int seg = tid / 88, c = tid - seg * 88;
        float hl = 0.f, P = 1.f;
        for (int u0 = seg * 32; u0 < seg * 32 + 32; u0 += 8) {
          f32x2 ab[8];
#pragma unroll
          for (int i = 0; i < 8; ++i) { const int tl = d ? 127 - (u0 + i) : (u0 + i); ab[i] = AB[tl * 88 + c]; }
#pragma unroll
          for (int i = 0; i < 8; ++i) { hl = ab[i][0] * hl + ab[i][1]; P *= ab[i][0]; ab[i] = (f32x2){hl, P}; }
#pragma unroll
          for (int i = 0; i < 8; ++i) { const int tl = d ? 127 - (u0 + i) : (u0 + i); AB[tl * 88 + c] = ab[i]; }
        }
        segH[seg * 88 + c] = hl; segP[seg * 88 + c] = P;
      }
      __syncthreads();
      if (tid < 88) {
        float cur = carry;
#pragma unroll
        for (int seg = 0; seg < 4; ++seg) { segC[seg * 88 + tid] = cur; cur = segP[seg * 88 + tid] * cur + segH[seg * 88 + tid]; }
        carry = cur;
      }
      __syncthreads();
      for (int q = tid; q < 128 * 11; q += NTHR) {
        const int tl = q / 11, c8 = (q - tl * 11) * 8;
        const int u = d ? 127 - tl : tl;
        const float* sc = segC + (u >> 5) * 88 + c8;
        float hv[8];
#pragma unroll
        for (int i = 0; i < 8; ++i) { const f32x2 hp = AB[tl * 88 + c8 + i]; hv[i] = hp[0] + hp[1] * sc[i]; }
        *(u32x4*)(HS + (size_t)(seqbase + t0 + tl) * LW + blk * 88 + c8) =
            mk4(pk_bf16(hv[0], hv[1]), pk_bf16(hv[2], hv[3]), pk_bf16(hv[4], hv[5]), pk_bf16(hv[6], hv[7]));
      }
    }
  }
}

__device__ __forceinline__ void lru_z_phase(const bf16_t* __restrict__ HS0, const bf16_t* __restrict__ HS1, bf16_t* __restrict__ GG) {
  const size_t n8 = (size_t)MT * LW / 8;
  for (size_t e = (size_t)blockIdx.x * NTHR + threadIdx.x; e < n8; e += (size_t)gridDim.x * NTHR) {
    const u32x4 a = *(const u32x4*)(HS0 + e * 8), b = *(const u32x4*)(HS1 + e * 8), g = *(const u32x4*)(GG + e * 8);
    u32x4 o;
    o.x = pk_bf16((bf_lo(a.x) + bf_lo(b.x)) * bf_lo(g.x), (bf_hi(a.x) + bf_hi(b.x)) * bf_hi(g.x));
    o.y = pk_bf16((bf_lo(a.y) + bf_lo(b.y)) * bf_lo(g.y), (bf_hi(a.y) + bf_hi(b.y)) * bf_hi(g.y));
    o.z = pk_bf16((bf_lo(a.z) + bf_lo(b.z)) * bf_lo(g.z), (bf_hi(a.z) + bf_hi(b.z)) * bf_hi(g.z));
    o.w = pk_bf16((bf_lo(a.w) + bf_lo(b.w)) * bf_lo(g.w), (bf_hi(a.w) + bf_hi(b.w)) * bf_hi(g.w));
    *(u32x4*)(GG + e * 8) = o;
  }
}

__device__ __forceinline__ void nat_qk_phase(bf16_t* __restrict__ Q, bf16_t* __restrict__ Kb, bf16_t* __restrict__ QR, const float* __restrict__ qk_g) {
  const int lane = threadIdx.x & 63;
  const int gw = blockIdx.x * (NTHR / 64) + (threadIdx.x >> 6), nw = gridDim.x * (NTHR / 64);
  const int qd = lane & 3;
  float gq[16], gk[16], inv[16];
#pragma unroll
  for (int i = 0; i < 16; ++i) { gq[i] = qk_g[qd * 16 + i]; gk[i] = qk_g[64 + qd * 16 + i]; inv[i] = exp2f(-(float)i * (13.287712379549449f / 16.f)); }
  for (int row = gw; row < MT; row += nw) {
    const bool lat = row < ML;
    const size_t off = (size_t)row * 1024 + lane * 16;
    float cs[16], sn[16];
    if (lat) {
      const int t = row & 4095;
      const float pos = (float)((qd >> 1) ? (t & 63) : (t >> 6));
#pragma unroll
      for (int i = 0; i < 16; ++i) {
        float rev = pos * inv[i] * 0.15915494309189535f;
        rev -= floorf(rev);
        sn[i] = __builtin_amdgcn_sinf(rev); cs[i] = __builtin_amdgcn_cosf(rev);
      }
    }
#pragma unroll
    for (int which = 0; which < 2; ++which) {
      bf16_t* P = which ? Kb : Q;
      const u32x4 a = *(const u32x4*)(P + off), b2 = *(const u32x4*)(P + off + 8);
      const unsigned u[8] = {a.x, a.y, a.z, a.w, b2.x, b2.y, b2.z, b2.w};
      float x[16];
#pragma unroll
      for (int i = 0; i < 8; ++i) { x[2 * i] = bf_lo(u[i]); x[2 * i + 1] = bf_hi(u[i]); }
      float ss = 0.f;
#pragma unroll
      for (int i = 0; i < 16; ++i) ss += x[i] * x[i];
      ss += __shfl_xor(ss, 1); ss += __shfl_xor(ss, 2);
      const float rstd = rsqrtf(ss * (1.f / 64.f) + 1e-6f);
#pragma unroll
      for (int i = 0; i < 16; ++i) x[i] = x[i] * rstd * (which ? gk[i] : gq[i]);
      unsigned pl[8];
#pragma unroll
      for (int i = 0; i < 8; ++i) pl[i] = pk_bf16(x[2 * i], x[2 * i + 1]);
      unsigned rt[8];
      if (lat) {
        float y[16];
#pragma unroll
        for (int i = 0; i < 16; ++i) {
          const float pr = __shfl_xor(x[i], 1);
          y[i] = x[i] * cs[i] + ((qd & 1) ? pr * sn[i] : -pr * sn[i]);
        }
#pragma unroll
        for (int i = 0; i < 8; ++i) rt[i] = pk_bf16(y[2 * i], y[2 * i + 1]);
      }
      if (which == 0) {
        *(u32x4*)(Q + off) = mk4(pl[0], pl[1], pl[2], pl[3]);
        *(u32x4*)(Q + off + 8) = mk4(pl[4], pl[5], pl[6], pl[7]);
        if (lat) { *(u32x4*)(QR + off) = mk4(rt[0], rt[1], rt[2], rt[3]); *(u32x4*)(QR + off + 8) = mk4(rt[4], rt[5], rt[6], rt[7]); }
      } else {
        if (lat) { *(u32x4*)(Kb + off) = mk4(rt[0], rt[1], rt[2], rt[3]); *(u32x4*)(Kb + off + 8) = mk4(rt[4], rt[5], rt[6], rt[7]); }
        else { *(u32x4*)(Kb + off) = mk4(pl[0], pl[1], pl[2], pl[3]); *(u32x4*)(Kb + off + 8) = mk4(pl[4], pl[5], pl[6], pl[7]); }
      }
    }
  }
}

struct AttnState { f32x16 O[2][2]; float m[2], l[2]; };

template <bool BAND>
DEVI void attn_chunk(AttnState& st, const u32x4 (&qf)[2][4], const bf16_t* __restrict__ kbase, const bf16_t* __restrict__ vtbase, int vtT,
                     const float* __restrict__ rpbs, int brow, int half, int lane) {
  const int l31 = lane & 31, lh = lane >> 5;
  u32x4 kf[4];
#pragma unroll
  for (int ks = 0; ks < 4; ++ks) kf[ks] = *(const u32x4*)(kbase + (size_t)l31 * 1024 + ks * 16 + 8 * lh);
  constexpr float SC = 0.125f * 1.4426950408889634f;
  u32x4 pf[2][2];
#pragma unroll
  for (int qt = 0; qt < 2; ++qt) {
    f32x16 S;
#pragma unroll
    for (int r = 0; r < 16; ++r) S[r] = 0.f;
#pragma unroll
    for (int ks = 0; ks < 4; ++ks) S = mfma32(kf[ks], qf[qt][ks], S);
    float cmax = -INFINITY;
    if (BAND) {
      const int qc = qt * 32 + l31;
      const int cst = min(max(qc - 8, 0), 48);
#pragma unroll
      for (int r = 0; r < 16; ++r) {
        const int key = (r & 3) + 8 * (r >> 2) + 4 * lh;
        const int kc = half * 32 + key;
        const bool ok = (kc >= cst) && (kc < cst + 16);
        const int bi = ok ? (brow * 31 + kc - qc + 15) : 0;
        const float sv = S[r] * SC + rpbs[bi];
        S[r] = ok ? sv : -INFINITY;
        cmax = fmaxf(cmax, S[r]);
      }
    } else {
#pragma unroll
      for (int r = 0; r < 16; ++r) { S[r] *= SC; cmax = fmaxf(cmax, S[r]); }
    }
    cmax = fmaxf(cmax, __shfl_xor(cmax, 32));
    const float mnew = fmaxf(st.m[qt], cmax);
    const float alpha = exp2f(st.m[qt] - mnew);
    st.m[qt] = mnew;
    float ps = 0.f;
#pragma unroll
    for (int r = 0; r < 16; ++r) { S[r] = exp2f(S[r] - mnew); ps += S[r]; }
    st.l[qt] = st.l[qt] * alpha + ps;
#pragma unroll
    for (int dt = 0; dt < 2; ++dt)
#pragma unroll
      for (int r = 0; r < 16; ++r) st.O[qt][dt][r] *= alpha;
    pf[qt][0] = mk4(pk_bf16(S[0], S[1]), pk_bf16(S[2], S[3]), pk_bf16(S[4], S[5]), pk_bf16(S[6], S[7]));
    pf[qt][1] = mk4(pk_bf16(S[8], S[9]), pk_bf16(S[10], S[11]), pk_bf16(S[12], S[13]), pk_bf16(S[14], S[15]));
  }
#pragma unroll
  for (int dt = 0; dt < 2; ++dt)
#pragma unroll
    for (int s = 0; s < 2; ++s) {
      const bf16_t* vp = vtbase + (size_t)(dt * 32 + l31) * vtT + 16 * s + 4 * lh;
      const u32x2 lo = *(const u32x2*)vp, hi = *(const u32x2*)(vp + 8);
      const u32x4 vf = mk4(lo.x, lo.y, hi.x, hi.y);
      st.O[0][dt] = mfma32(vf, pf[0][s], st.O[0][dt]);
      st.O[1][dt] = mfma32(vf, pf[1][s], st.O[1][dt]);
    }
}

__device__ __forceinline__ void natten_phase(char* lds, const bf16_t* __restrict__ Q, const bf16_t* __restrict__ QR, const bf16_t* __restrict__ Kb,
                             const bf16_t* __restrict__ VT, bf16_t* __restrict__ G, const float* __restrict__ rpb) {
  float* rpbs = (float*)lds;
  __syncthreads();
  for (int e = threadIdx.x; e < 16 * 465; e += NTHR) rpbs[e] = rpb[e] * 1.4426950408889634f;
  __syncthreads();
  const int lane = threadIdx.x & 63, l31 = lane & 31, lh = lane >> 5;
  const int gw = blockIdx.x * (NTHR / 64) + (threadIdx.x >> 6), nw = gridDim.x * (NTHR / 64);
  const bf16_t* VTC = VT + (size_t)ML * 1024;
  for (int item = gw; item < 8192 + 512; item += nw) {
    const bool lat = item < 8192;
    int b, h, r = 0, qrow0;
    if (lat) { h = item & 15; r = (item >> 4) & 63; b = item >> 10; qrow0 = b * 4096 + r * 64; }
    else { const int it = item - 8192; h = it & 15; const int qt64 = (it >> 4) & 3; b = it >> 6; qrow0 = ML + b * 256 + qt64 * 64; }
    AttnState st;
#pragma unroll
    for (int a = 0; a < 2; ++a) { st.m[a] = -INFINITY; st.l[a] = 0.f;
#pragma unroll
      for (int c = 0; c < 2; ++c)
#pragma unroll
        for (int rr = 0; rr < 16; ++rr) st.O[a][c][rr] = 0.f; }
    u32x4 qf[2][4];
#pragma unroll
    for (int qt = 0; qt < 2; ++qt)
#pragma unroll
      for (int ks = 0; ks < 4; ++ks) qf[qt][ks] = *(const u32x4*)(Q + (size_t)(qrow0 + qt * 32 + l31) * 1024 + h * 64 + ks * 16 + 8 * lh);
    for (int kc = 0; kc < 8; ++kc) {
      const bf16_t* kbase = Kb + (size_t)(ML + b * 256 + kc * 32) * 1024 + h * 64;
      const bf16_t* vtb = VTC + (size_t)(b * 16 + h) * 64 * 256 + kc * 32;
      attn_chunk<false>(st, qf, kbase, vtb, 256, rpbs, 0, 0, lane);
    }
    if (lat) {
#pragma unroll
      for (int qt = 0; qt < 2; ++qt)
#pragma unroll
        for (int ks = 0; ks < 4; ++ks) qf[qt][ks] = *(const u32x4*)(QR + (size_t)(qrow0 + qt * 32 + l31) * 1024 + h * 64 + ks * 16 + 8 * lh);
      const int start = min(max(r - 4, 0), 56);
      for (int i = 0; i < 16; ++i) {
        const int kr = start + (i >> 1), half = i & 1;
        const bf16_t* kbase = Kb + (size_t)(b * 4096 + kr * 64 + half * 32) * 1024 + h * 64;
        const bf16_t* vtb = VT + (size_t)(b * 16 + h) * 64 * 4096 + kr * 64 + half * 32;
        attn_chunk<true>(st, qf, kbase, vtb, 4096, rpbs, h * 15 + (kr - r + 7), half, lane);
      }
    }
#pragma unroll
    for (int qt = 0; qt < 2; ++qt) {
      const float lt = st.l[qt] + __shfl_xor(st.l[qt], 32);
      const float inv = 1.f / lt;
      bf16_t* grow = G + (size_t)(qrow0 + qt * 32 + l31) * 1024 + h * 64;
#pragma unroll
      for (int dt = 0; dt < 2; ++dt)
#pragma unroll
        for (int q4 = 0; q4 < 4; ++q4) {
          bf16_t* gp = grow + dt * 32 + 8 * q4 + 4 * lh;
          const u32x2 gv = *(const u32x2*)gp;
          u32x2 o;
          o.x = pk_bf16(st.O[qt][dt][4 * q4] * inv * bf_lo(gv.x), st.O[qt][dt][4 * q4 + 1] * inv * bf_hi(gv.x));
          o.y = pk_bf16(st.O[qt][dt][4 * q4 + 2] * inv * bf_lo(gv.y), st.O[qt][dt][4 * q4 + 3] * inv * bf_hi(gv.y));
          *(u32x2*)gp = o;
        }
    }
  }
}

template <int ph>
__device__ __forceinline__ void run_phase(const Params& p, char* lds) {
  char* ws = p.ws;
  const float* MOD = (const float*)(ws + OFF_MOD);
  float* XC = (float*)(ws + OFF_XC);
  bf16_t* HB = (bf16_t*)(ws + OFF_HB);
  bf16_t* A0 = (bf16_t*)(ws + OFF_A0); bf16_t* A1 = (bf16_t*)(ws + OFF_A1); bf16_t* A2 = (bf16_t*)(ws + OFF_A2);
  bf16_t* A3 = (bf16_t*)(ws + OFF_A3); bf16_t* A4 = (bf16_t*)(ws + OFF_A4);
  bf16_t* WD = (bf16_t*)(ws + OFF_WD); bf16_t* AD = (bf16_t*)(ws + OFF_AD);
  float* BON = (float*)(ws + OFF_BON);
  if (ph == 0) { phase0(p, lds); return; }
  constexpr int layer = (ph - 1) / 5, sub = (ph - 1) % 5;
  const float* modL = MOD + (size_t)layer * 9 * 3072;
  const float* xl_cur = layer == 0 ? p.in[0] : p.out;
  const float* xc_cur = layer == 0 ? p.in[2] : XC;
  if (layer == 0 || layer == 3) {
    const int ib = layer ? 33 : 4;
    const bf16_t* WIN = (const bf16_t*)(ws + (layer ? OFF_W3IN : OFF_W0IN));
    const bf16_t* WUP = (const bf16_t*)(ws + (layer ? OFF_W3UP : OFF_W0UP));
    const bf16_t* WOUT = (const bf16_t*)(ws + (layer ? OFF_W3OUT : OFF_W0OUT));
    if (sub == 0) norm_phase<true>(xl_cur, xc_cur, p.in[ib], modL, HB, A4);
    else if (sub == 1) { ALMix al{HB, A4, p.in[ib + 4]}; EpRwkvIn ep{A0, A1, A2, A3, WD, AD}; gemm256_phase(lds, WIN, 1024, MT / 256, 16, al, ep); gemm_phase(lds, WIN, 1024, MT / 256, 2, al, ep, 4096, true); }
    else if (sub == 2) rwkv_scan_phase(lds, A0, A1, A2, WD, AD, WUP, p.in[ib + 5], p.in[ib + 8], p.in[ib + 9], HB, A4, BON);
    else if (sub == 3) rwkv_post_phase(HB, A4, A2, A3, BON, p.in[ib + 10], layer == 3 ? ML : MT);
    else { ALPlain al{A3, 1024}; EpRes ep{xl_cur, xc_cur, p.out, XC, modL}; gemm256_phase(lds, WOUT, 1024, (layer == 3 ? ML : MT) / 256, 4, al, ep); }
  } else if (layer == 1) {
    bf16_t* HS0 = (bf16_t*)(ws + OFF_HS0); bf16_t* XR = (bf16_t*)(ws + OFF_XR); bf16_t* GG = (bf16_t*)(ws + OFF_GG); bf16_t* HS1 = (bf16_t*)(ws + OFF_HS1);
    if (sub == 0) norm_phase<false>(xl_cur, xc_cur, p.in[16], modL, HB, nullptr);
    else if (sub == 1) { ALPlain al{HB, 1024}; EpLruIn ep{XR, GG}; gemm256_phase(lds, (const bf16_t*)(ws + OFF_W1IN), 1024, MT / 256, 11, al, ep); }
    else if (sub == 2) rglru_phase(lds, XR, (const bf16_t*)(ws + OFF_W1G), p.in[20], p.in[21], p.in[23], p.in[24], HS0, HS1);
    else if (sub == 3) lru_z_phase(HS0, HS1, GG);
    else { ALPlain al{GG, LW}; EpRes ep{xl_cur, xc_cur, p.out, XC, modL}; gemm256_phase(lds, (const bf16_t*)(ws + OFF_W1OUT), LW, MT / 256, 4, al, ep); }
  } else {
    if (sub == 0) norm_phase<false>(xl_cur, xc_cur, p.in[26], modL, HB, nullptr);
    else if (sub == 1) { ALPlain al{HB, 1024}; EpNatIn ep{A0, A1, A2, A3}; gemm256_phase(lds, (const bf16_t*)(ws + OFF_W2IN), 1024, MT / 256, 16, al, ep); }
    else if (sub == 2) nat_qk_phase(A0, A1, A4, p.in[30]);
    else if (sub == 3) natten_phase(lds, A0, A4, A1, A2, A3, p.in[31]);
    else { ALPlain al{A3, 1024}; EpRes ep{xl_cur, xc_cur, p.out, XC, modL}; gemm256_phase(lds, (const bf16_t*)(ws + OFF_W2OUT), 1024, MT / 256, 4, al, ep); }
  }
}

__global__ void __launch_bounds__(NTHR) mega_kernel(Params p) {
  __shared__ __attribute__((aligned(16))) char lds[LDS_BYTES];
  __shared__ u32x4 xb_words;
  cg::grid_group grid = cg::this_grid();
  if (threadIdx.x == 0) xb_words = (u32x4){0u, 0u, 0u, 0u};
  __syncthreads();
  const XcdBarrier xb = xcd_barrier_post((unsigned*)(p.ws + OFF_BAR), (volatile LAS unsigned*)&xb_words);
#define PHASE(k) if (p.ph_lo <= k && k < p.ph_hi) { for (int rep = 0; rep < REP[k]; ++rep) { run_phase<k>(p, lds); if (rep + 1 < REP[k] || k + 1 < p.ph_hi) { if (k == 0) grid.sync(); else xcd_barrier(xb); } } }
  PHASE(0) PHASE(1) PHASE(2) PHASE(3) PHASE(4) PHASE(5) PHASE(6) PHASE(7) PHASE(8) PHASE(9) PHASE(10)
  PHASE(11) PHASE(12) PHASE(13) PHASE(14) PHASE(15) PHASE(16) PHASE(17) PHASE(18) PHASE(19) PHASE(20)
#undef PHASE
}

extern "C" void kernel_launch(void* const* d_in, const int* in_sizes, int n_in, void* d_out, int out_size, void* d_ws, size_t ws_size,
                              hipStream_t stream) {
  static int grid_blocks = 0;
  if (!grid_blocks) {
    int dev = 0, cus = 0, per_cu = 0;
    hipGetDevice(&dev);
    hipDeviceGetAttribute(&cus, hipDeviceAttributeMultiprocessorCount, dev);
    hipOccupancyMaxActiveBlocksPerMultiprocessor(&per_cu, mega_kernel, NTHR, 0);
    if (per_cu < 1) { fprintf(stderr, "occupancy query returned %d\n", per_cu); per_cu = 1; }
    if (per_cu > 1) per_cu = 1;
    grid_blocks = cus * per_cu;
    if (n_in != 45 || ws_size < WS_END) fprintf(stderr, "unexpected n_in %d / ws %zu (need %zu)\n", n_in, ws_size, (size_t)WS_END);
  }
  Params p{};
  for (int i = 0; i < 45; ++i) p.in[i] = (const float*)d_in[i];
  p.out = (float*)d_out;
  p.ws = (char*)d_ws;
  (void)hipMemsetAsync((char*)d_ws + OFF_BAR, 0, XCD_BAR_WORDS * 4, stream);
#if N_LAUNCH_MODE == 1
  p.ph_lo = 0; p.ph_hi = NPHASE;
  void* args[] = {&p};
  hipError_t e = hipLaunchCooperativeKernel((void*)mega_kernel, dim3(grid_blocks), dim3(NTHR), args, 0, stream);
  if (e != hipSuccess) fprintf(stderr, "cooperative launch failed: %s (grid %d)\n", hipGetErrorString(e), grid_blocks);
#else
  for (int ph = 0; ph < NPHASE; ++ph) {
    p.ph_lo = ph; p.ph_hi = ph + 1;
    hipLaunchKernelGGL(mega_kernel, dim3(grid_blocks), dim3(NTHR), 0, stream, p);
  }
#endif
}
```

```cpp
#include <hip/hip_runtime.h>
#include <hip/hip_cooperative_groups.h>
#include <cstdio>
#include <cstdint>
namespace cg = cooperative_groups;

#ifndef N_LAUNCH_MODE
#define N_LAUNCH_MODE 1
#endif

typedef unsigned short bf16_t;
typedef short bf16x8 __attribute__((ext_vector_type(8)));
typedef float f32x4 __attribute__((ext_vector_type(4)));
typedef float f32x16 __attribute__((ext_vector_type(16)));
typedef float f32x2 __attribute__((ext_vector_type(2)));
typedef unsigned u32x4 __attribute__((ext_vector_type(4)));
typedef unsigned u32x2 __attribute__((ext_vector_type(2)));

#define DEVI __device__ __forceinline__

constexpr int D = 1024, NB = 8, SEQ = 4096, CTX = 256;
constexpr int ML = NB * SEQ;
constexpr int MC = NB * CTX;
constexpr int MT = ML + MC;
constexpr int LW = 1408;
constexpr int NTHR = 512;
constexpr int NPHASE = 21;
constexpr int LDS_BYTES = 163840 - 16;
__device__ constexpr int REP[21] = {1,1,1,1,1,1,1,1,1,1,1,1,1,1,1,1,1,1,1,1,1};

constexpr size_t SZ_ACT = (size_t)MT * 1024 * 2;
constexpr size_t OFF_MOD = 0;
constexpr size_t OFF_BAR = 458752;
constexpr size_t OFF_W0IN = 524288;
constexpr size_t SZ_RWIN = (size_t)4352 * 1024 * 2;
constexpr size_t SZ_RWUP = (size_t)4 * 1024 * 64 * 2;
constexpr size_t SZ_SQ = (size_t)1024 * 1024 * 2;
constexpr size_t OFF_W0UP = OFF_W0IN + SZ_RWIN;
constexpr size_t OFF_W0OUT = OFF_W0UP + SZ_RWUP;
constexpr size_t OFF_W3IN = OFF_W0OUT + SZ_SQ;
constexpr size_t OFF_W3UP = OFF_W3IN + SZ_RWIN;
constexpr size_t OFF_W3OUT = OFF_W3UP + SZ_RWUP;
constexpr size_t OFF_W1IN = OFF_W3OUT + SZ_SQ;
constexpr size_t OFF_W1G = OFF_W1IN + (size_t)2816 * 1024 * 2;
constexpr size_t OFF_W1OUT = OFF_W1G + (size_t)16 * 4 * 96 * 96 * 2;
constexpr size_t OFF_W2IN = OFF_W1OUT + (size_t)1024 * 1408 * 2;
constexpr size_t OFF_W2OUT = OFF_W2IN + (size_t)4096 * 1024 * 2;
constexpr size_t OFF_XC = OFF_W2OUT + SZ_SQ;
constexpr size_t OFF_BON = OFF_XC + (size_t)MC * 1024 * 4;
constexpr size_t OFF_BIG = OFF_BON + (size_t)2 * MT * 16 * 4;
constexpr size_t OFF_HB = OFF_BIG;
constexpr size_t OFF_A0 = OFF_BIG + SZ_ACT;
constexpr size_t OFF_A1 = OFF_A0 + SZ_ACT;
constexpr size_t OFF_A2 = OFF_A1 + SZ_ACT;
constexpr size_t OFF_A3 = OFF_A2 + SZ_ACT;
constexpr size_t OFF_A4 = OFF_A3 + SZ_ACT;
constexpr size_t OFF_WD = OFF_A4 + SZ_ACT;
constexpr size_t OFF_AD = OFF_WD + (size_t)MT * 128 * 2;
constexpr size_t WS_END = OFF_AD + (size_t)MT * 128 * 2;
constexpr size_t SZ_LRU = (size_t)MT * LW * 2;
constexpr size_t OFF_HS0 = OFF_BIG;
constexpr size_t OFF_XR = OFF_BIG + SZ_LRU;
constexpr size_t OFF_GG = OFF_XR + SZ_LRU;
constexpr size_t OFF_HS1 = OFF_GG + SZ_LRU;
static_assert(OFF_HS1 + SZ_LRU <= WS_END, "lru overlay");
static_assert(WS_END <= (size_t)536870912, "ws");

struct Params {
  const float* in[45];
  float* out;
  char* ws;
  int ph_lo, ph_hi;
};

DEVI u32x4 mk4(unsigned a, unsigned b, unsigned c, unsigned d) { u32x4 r = {a, b, c, d}; return r; }
DEVI int opaque_tid() { int t = threadIdx.x; asm volatile("" : "+v"(t)); return t; }
DEVI float bf_lo(unsigned u) { return __uint_as_float(u << 16); }
DEVI float bf_hi(unsigned u) { return __uint_as_float(u & 0xffff0000u); }
DEVI float bf2f(bf16_t h) { return __uint_as_float(((unsigned)h) << 16); }
DEVI unsigned pk_bf16(float lo, float hi) { unsigned r; asm("v_cvt_pk_bf16_f32 %0, %1, %2" : "=v"(r) : "v"(lo), "v"(hi)); return r; }
DEVI bf16_t f2bf(float f) { return (bf16_t)(pk_bf16(f, 0.f) & 0xffffu); }
DEVI float wave_sum(float v) {
#pragma unroll
  for (int o = 32; o; o >>= 1) v += __shfl_xor(v, o);
  return v;
}
DEVI float sigmoidf_(float x) { return __builtin_amdgcn_rcpf(1.f + __expf(-x)); }
DEVI float siluf_(float x) { return x * __builtin_amdgcn_rcpf(1.f + __expf(-x)); }
DEVI float softplusf_(float x) { return fmaxf(x, 0.f) + __logf(1.f + __expf(-fabsf(x))); }
DEVI f32x16 mfma32(u32x4 a, u32x4 b, f32x16 c) {
  return __builtin_amdgcn_mfma_f32_32x32x16_bf16(__builtin_bit_cast(bf16x8, a), __builtin_bit_cast(bf16x8, b), c, 0, 0, 0);
}
DEVI f32x4 mfma16(u32x4 a, u32x4 b, f32x4 c) {
  return __builtin_amdgcn_mfma_f32_16x16x32_bf16(__builtin_bit_cast(bf16x8, a), __builtin_bit_cast(bf16x8, b), c, 0, 0, 0);
}
template <int CTRL> DEVI float dpp_f(float v) {
  return __int_as_float(__builtin_amdgcn_update_dpp(0, __float_as_int(v), CTRL, 0xf, 0xf, true));
}
DEVI float sum8(float v) {
  v += dpp_f<0xB1>(v);
  v += dpp_f<0x4E>(v);
  v += dpp_f<0x141>(v);
  return v;
}

#define XB_TMO      128
#define XB_XCNT(j)  (256  + 64 * (j))
#define XB_XSUB(j)  (1280 + 64 * (j))
#define XB_XGEN(j)  (2304 + 64 * (j))
#define XB_TOP      3328
#define XB_TOPGEN   3392
#define XCD_BAR_WORDS 3456
#define XB_SPIN_CAP (1u << 18)
#define LAS __attribute__((address_space(3)))

__device__ __forceinline__ unsigned xb_ld(unsigned* p)              { return __hip_atomic_load(p, __ATOMIC_RELAXED, __HIP_MEMORY_SCOPE_AGENT); }
__device__ __forceinline__ unsigned xb_add(unsigned* p, unsigned v) { return __hip_atomic_fetch_add(p, v, __ATOMIC_RELAXED, __HIP_MEMORY_SCOPE_AGENT); }
__device__ __forceinline__ unsigned xb_xcc_id() { return (unsigned)__builtin_amdgcn_s_getreg((3 << 11) | 20) & 0xFu; }
#define XB_SPIN(cond, bar) do { unsigned _sp = 0; while (cond) { __builtin_amdgcn_s_sleep(1); \
    if ((++_sp & 255u) == 0u) { if (xb_ld(&(bar)[XB_TMO])) break; if (_sp > XB_SPIN_CAP) { atomicAdd(&(bar)[XB_TMO], 1u); break; } } } } while (0)

struct XcdBarrier {
    unsigned* bar; unsigned x;
    volatile LAS unsigned* st;
};

__device__ __forceinline__ XcdBarrier xcd_barrier_post(unsigned* bar, volatile LAS unsigned* st) {
    XcdBarrier b; b.bar = bar; b.x = xb_xcc_id(); b.st = st;
    if (threadIdx.x == 0) (void)xb_add(&bar[XB_XCNT(b.x)], 1u);
    return b;
}
__device__ __forceinline__ void xcd_barrier_complete(unsigned* bar, unsigned x, unsigned& nloc, unsigned& nx) {
    const unsigned G = gridDim.x * gridDim.y * gridDim.z;
    unsigned sum, cnt, mine, sp = 0u;
    for (;;) {
        sum = 0u; cnt = 0u; mine = 0u;
#pragma unroll
        for (unsigned j = 0; j < 16; ++j) { const unsigned c = xb_ld(&bar[XB_XCNT(j)]); sum += c; cnt += (c > 0u) ? 1u : 0u; mine = (j == x) ? c : mine; }
        if (sum == G) break;
        __builtin_amdgcn_s_sleep(1);
        if ((++sp & 255u) == 0u) { if (xb_ld(&bar[XB_TMO])) break; if (sp > XB_SPIN_CAP) { atomicAdd(&bar[XB_TMO], 1u); break; } }
    }
    nloc = mine > 0u ? mine : 1u; nx = cnt > 0u ? cnt : 1u;
}

__device__ __forceinline__ void xcd_barrier(const XcdBarrier& b) {
    asm volatile("s_waitcnt vmcnt(0)" ::: "memory");
    __syncthreads();
    if (threadIdx.x == 0) {
        unsigned* bar = b.bar;
        __builtin_amdgcn_s_waitcnt(0);
        unsigned nloc = b.st[0], nx = b.st[1];
        if (nloc == 0u) { xcd_barrier_complete(bar, b.x, nloc, nx); b.st[0] = nloc; b.st[1] = nx; }
        const unsigned old = xb_add(&bar[XB_XSUB(b.x)], 1u);
        const unsigned gen = old / nloc;
        if (old + 1u == (gen + 1u) * nloc) {
            __builtin_amdgcn_fence(__ATOMIC_RELEASE, "agent");
            asm volatile("s_waitcnt vmcnt(0)" ::: "memory");
            const unsigned og = xb_add(&bar[XB_TOP], 1u);
            const unsigned tg = og / nx;
            if (og + 1u == (tg + 1u) * nx) xb_add(&bar[XB_TOPGEN], 1u);
            else XB_SPIN(xb_ld(&bar[XB_TOPGEN]) == tg, bar);
            __builtin_amdgcn_fence(__ATOMIC_ACQUIRE, "agent");
            xb_add(&bar[XB_XGEN(b.x)], 1u);
            asm volatile("s_waitcnt vmcnt(0)" ::: "memory");
        } else {
            XB_SPIN(xb_ld(&bar[XB_XGEN(b.x)]) == gen, bar);
            __builtin_amdgcn_fence(__ATOMIC_ACQUIRE, "agent");
            asm volatile("s_waitcnt vmcnt(0)" ::: "memory");
        }
    }
    __syncthreads();
}


struct TJob { const float* src; int K, N; bf16_t* dst; int ldd; };

DEVI TJob get_tjob(const Params& p, int j) {
  TJob t;
  if (j < 26) {
    const int l = j / 13, jj = j % 13;
    const int ib = l ? 33 : 4;
    bf16_t* win = (bf16_t*)(p.ws + (l ? OFF_W3IN : OFF_W0IN));
    bf16_t* wup = (bf16_t*)(p.ws + (l ? OFF_W3UP : OFF_W0UP));
    bf16_t* wout = (bf16_t*)(p.ws + (l ? OFF_W3OUT : OFF_W0OUT));
    if (jj < 4) { t.src = p.in[ib + 3] + (size_t)jj * 1048576; t.K = 1024; t.N = 1024; t.dst = win + (size_t)jj * 1048576; t.ldd = 1024; }
    else if (jj < 8) { const int idx = jj - 4, d = idx >> 1, kind = idx & 1;
      t.src = p.in[ib + 6] + (size_t)idx * 65536; t.K = 1024; t.N = 64; t.dst = win + (size_t)(4096 + kind * 128 + d * 64) * 1024; t.ldd = 1024; }
    else if (jj < 12) { const int idx = jj - 8;
      t.src = p.in[ib + 7] + (size_t)idx * 65536; t.K = 64; t.N = 1024; t.dst = wup + (size_t)idx * 65536; t.ldd = 64; }
    else { t.src = p.in[ib + 11]; t.K = 1024; t.N = 1024; t.dst = wout; t.ldd = 1024; }
  } else if (j == 26) { t.src = p.in[19]; t.K = 1024; t.N = 2816; t.dst = (bf16_t*)(p.ws + OFF_W1IN); t.ldd = 1024; }
  else if (j == 27) { t.src = p.in[25]; t.K = 1408; t.N = 1024; t.dst = (bf16_t*)(p.ws + OFF_W1OUT); t.ldd = 1408; }
  else if (j == 28) { t.src = p.in[29]; t.K = 1024; t.N = 4096; t.dst = (bf16_t*)(p.ws + OFF_W2IN); t.ldd = 1024; }
  else { t.src = p.in[32]; t.K = 1024; t.N = 1024; t.dst = (bf16_t*)(p.ws + OFF_W2OUT); t.ldd = 1024; }
  return t;
}

__device__ __forceinline__ void phase0(const Params& p, char* lds) {
  const int tid = opaque_tid();
  {
    bf16_t* wg = (bf16_t*)(p.ws + OFF_W1G);
    const float* gw = p.in[22];
    const int total = 16 * 4 * 96 * 96;
    for (int e = blockIdx.x * NTHR + tid; e < total; e += gridDim.x * NTHR) {
      const int k = e % 96, n = (e / 96) % 96, dg = (e / 9216) & 3, blk = e / 36864;
      float v = 0.f;
      if (k < 88 && n < 88) v = gw[((size_t)(dg * 16 + blk) * 88 + k) * 88 + n];
      wg[e] = f2bf(v);
    }
  }
  constexpr int N_MOD_ITEMS = 96;
  constexpr int N_TILES = 5152;
  float* act = (float*)lds;
  float* red = (float*)(lds + 36864);
  float* tl = (float*)lds;
  for (int item = blockIdx.x; item < N_MOD_ITEMS + N_TILES; item += gridDim.x) {
    __syncthreads();
    if (item < N_MOD_ITEMS) {
      const int L = item / 24, nc = item % 24;
      const int ib = (L == 0) ? 4 : (L == 1) ? 16 : (L == 2) ? 26 : 33;
      const float* ada_w = p.in[ib + 1];
      const float* ada_b = p.in[ib + 2];
      for (int e = tid; e < 9 * 1024; e += NTHR) {
        const int i = e >> 10, k = e & 1023;
        const float c = (i < 8) ? p.in[1][i * 1024 + k] : p.in[3][k];
        act[e] = siluf_(c);
      }
      __syncthreads();
      const int kq = tid >> 7, nl = tid & 127, n = nc * 128 + nl;
      float acc[9];
#pragma unroll
      for (int i = 0; i < 9; ++i) acc[i] = 0.f;
      for (int k = kq * 256; k < kq * 256 + 256; ++k) {
        const float w = ada_w[(size_t)k * 3072 + n];
#pragma unroll
        for (int i = 0; i < 9; ++i) acc[i] += act[i * 1024 + k] * w;
      }
#pragma unroll
      for (int i = 0; i < 9; ++i) red[(kq * 9 + i) * 128 + nl] = acc[i];
      __syncthreads();
      float* mod = (float*)(p.ws + OFF_MOD) + (size_t)L * 9 * 3072;
      for (int e = tid; e < 9 * 128; e += NTHR) {
        const int i = e >> 7, c = e & 127;
        const float s = red[(0 * 9 + i) * 128 + c] + red[(1 * 9 + i) * 128 + c] + red[(2 * 9 + i) * 128 + c] + red[(3 * 9 + i) * 128 + c];
        mod[i * 3072 + nc * 128 + c] = s + ada_b[nc * 128 + c];
      }
    } else {
      int t = item - N_MOD_ITEMS;
      int j = 0;
      TJob job = get_tjob(p, 0);
      for (;;) {
        const int nt = (job.K >> 6) * (job.N >> 6);
        if (t < nt) break;
        t -= nt; ++j; job = get_tjob(p, j);
      }
      const int ntn = job.N >> 6;
      const int k0 = (t / ntn) * 64, n0 = (t % ntn) * 64;
#pragma unroll
      for (int i = 0; i < 2; ++i) {
        const int k = (tid >> 4) + 32 * i, n4 = (tid & 15) * 4;
        const float4 v = *(const float4*)(job.src + (size_t)(k0 + k) * job.N + n0 + n4);
        tl[k * 65 + n4 + 0] = v.x; tl[k * 65 + n4 + 1] = v.y; tl[k * 65 + n4 + 2] = v.z; tl[k * 65 + n4 + 3] = v.w;
      }
      __syncthreads();
      const int n = tid >> 3, k8 = (tid & 7) * 8;
      u32x4 o;
      o.x = pk_bf16(tl[(k8 + 0) * 65 + n], tl[(k8 + 1) * 65 + n]);
      o.y = pk_bf16(tl[(k8 + 2) * 65 + n], tl[(k8 + 3) * 65 + n]);
      o.z = pk_bf16(tl[(k8 + 4) * 65 + n], tl[(k8 + 5) * 65 + n]);
      o.w = pk_bf16(tl[(k8 + 6) * 65 + n], tl[(k8 + 7) * 65 + n]);
      *(u32x4*)(job.dst + (size_t)(n0 + n) * job.ldd + k0 + k8) = o;
    }
  }
}

DEVI void norm_row(const float* __restrict__ xr, const float* __restrict__ g, const float* __restrict__ mod, int lane, float (&h)[16]) {
  float4 x[4];
  float ss = 0.f;
#pragma unroll
  for (int i = 0; i < 4; ++i) {
    x[i] = *(const float4*)(xr + lane * 4 + 256 * i);
    ss += x[i].x * x[i].x + x[i].y * x[i].y + x[i].z * x[i].z + x[i].w * x[i].w;
  }
  ss = wave_sum(ss);
  const float rstd = rsqrtf(ss * (1.f / 1024.f) + 1e-6f);
#pragma unroll
  for (int i = 0; i < 4; ++i) {
    const int c = lane * 4 + 256 * i;
    const float4 gg = *(const float4*)(g + c);
    const float4 sh = *(const float4*)(mod + c);
    const float4 sc = *(const float4*)(mod + 1024 + c);
    h[i * 4 + 0] = x[i].x * rstd * gg.x * (1.f + sc.x) + sh.x;
    h[i * 4 + 1] = x[i].y * rstd * gg.y * (1.f + sc.y) + sh.y;
    h[i * 4 + 2] = x[i].z * rstd * gg.z * (1.f + sc.z) + sh.z;
    h[i * 4 + 3] = x[i].w * rstd * gg.w * (1.f + sc.w) + sh.w;
  }
}

template <bool WITH_HS>
__device__ __forceinline__ void norm_phase(const float* __restrict__ xl, const float* __restrict__ xc, const float* __restrict__ g,
                           const float* __restrict__ modL, bf16_t* __restrict__ H, bf16_t* __restrict__ HS) {
  const int tidx = opaque_tid();
  const int lane = tidx & 63;
  const int gw = blockIdx.x * (NTHR / 64) + (tidx >> 6), nw = gridDim.x * (NTHR / 64);
  for (int row = gw; row < MT; row += nw) {
    const bool lat = row < ML;
    const float* xbase = lat ? xl + (size_t)row * 1024 : xc + (size_t)(row - ML) * 1024;
    const float* mod = modL + (lat ? (row >> 12) : 8) * 3072;
    float h[16];
    norm_row(xbase, g, mod, lane, h);
#pragma unroll
    for (int i = 0; i < 4; ++i) {
      u32x2 o; o.x = pk_bf16(h[i * 4], h[i * 4 + 1]); o.y = pk_bf16(h[i * 4 + 2], h[i * 4 + 3]);
      *(u32x2*)(H + (size_t)row * 1024 + lane * 4 + 256 * i) = o;
    }
    if (WITH_HS) {
      const int t = lat ? (row & 4095) : ((row - ML) & 255);
      const int T = lat ? 4096 : 256;
      float s[16];
#pragma unroll
      for (int i = 0; i < 16; ++i) s[i] = 0.f;
      if (t > 0) { float hp[16]; norm_row(xbase - 1024, g, mod, lane, hp);
#pragma unroll
        for (int i = 0; i < 16; ++i) s[i] += hp[i]; }
      if (t < T - 1) { float hn[16]; norm_row(xbase + 1024, g, mod, lane, hn);
#pragma unroll
        for (int i = 0; i < 16; ++i) s[i] += hn[i]; }
#pragma unroll
      for (int i = 0; i < 4; ++i) {
        u32x2 o; o.x = pk_bf16(0.5f * s[i * 4], 0.5f * s[i * 4 + 1]); o.y = pk_bf16(0.5f * s[i * 4 + 2], 0.5f * s[i * 4 + 3]);
        *(u32x2*)(HS + (size_t)row * 1024 + lane * 4 + 256 * i) = o;
      }
    }
  }
}

struct ALPlain {
  const bf16_t* A; int lda;
  typedef u32x4 Regs;
  DEVI void stage(float*, int) const {}
  DEVI void issue(Regs& r, int row, int k) const { r = *(const u32x4*)(A + (size_t)row * lda + k); }
  DEVI u32x4 finish(const Regs& r, const float*, int) const { return r; }
};
struct ALMix {
  const bf16_t* H; const bf16_t* HS; const float* mu;
  struct Regs { u32x4 h, s; };
  DEVI void stage(float* sMu, int n0) const {
    const int grp = n0 >> 10;
    const int j = grp == 0 ? 0 : grp == 1 ? 2 : grp == 2 ? 3 : grp == 3 ? 5 : (n0 - 4096) < 128 ? 1 : 4;
    for (int e = threadIdx.x; e < 1024; e += NTHR) sMu[e] = mu[j * 1024 + e];
  }
  DEVI void issue(Regs& r, int row, int k) const {
    r.h = *(const u32x4*)(H + (size_t)row * 1024 + k);
    r.s = *(const u32x4*)(HS + (size_t)row * 1024 + k);
  }
  DEVI unsigned mix2(unsigned h, unsigned s, float m0, float m1) const {
    const float h0 = bf_lo(h), h1 = bf_hi(h), s0 = bf_lo(s), s1 = bf_hi(s);
    return pk_bf16(h0 + (s0 - h0) * m0, h1 + (s1 - h1) * m1);
  }
  DEVI u32x4 finish(const Regs& r, const float* sMu, int k) const {
    const float4 ma = *(const float4*)(sMu + k), mb = *(const float4*)(sMu + k + 4);
    u32x4 o;
    o.x = mix2(r.h.x, r.s.x, ma.x, ma.y); o.y = mix2(r.h.y, r.s.y, ma.z, ma.w);
    o.z = mix2(r.h.z, r.s.z, mb.x, mb.y); o.w = mix2(r.h.w, r.s.w, mb.z, mb.w);
    return o;
  }
};

template <class AL, class EP>
__device__ __forceinline__ void gemm_phase(char* lds, const bf16_t* __restrict__ Bt, int K, int mtiles, int ntiles, const AL al, const EP ep, int n_base = 0, bool reverse = false) {
  bf16_t* sA = (bf16_t*)lds;
  bf16_t* sB = (bf16_t*)(lds + 73728);
  float* sMu = (float*)(lds + 110592);
  const int tid = opaque_tid(), lane = tid & 63, wv = tid >> 6, wm = wv >> 1, wn = wv & 1;
  const int l31 = lane & 31, lh = lane >> 5;
  const int nk = K >> 6;
  const int ldrow = tid >> 3, ldk = (tid & 7) * 8;
  const int total = mtiles * ntiles;
  const int bid = reverse ? (int)(gridDim.x - 1 - blockIdx.x) : (int)blockIdx.x;
  const int nslots = gridDim.x >> 3, xcd = bid & 7, slot = bid >> 3;
  const int gm = 4 * ntiles;
  for (int chunk = xcd; chunk * nslots < total; chunk += 8) {
    const int tile = chunk * nslots + slot;
    if (tile >= total) break;
    const int grp = tile / gm, rem = tile - grp * gm;
    const int mt = grp * 4 + (rem & 3), nt = rem >> 2;
    const int m0 = mt * 256, n0 = n_base + nt * 128;
    __syncthreads();
    al.stage(sMu, n0);
    f32x16 acc[2][2];
#pragma unroll
    for (int a = 0; a < 2; ++a)
#pragma unroll
      for (int b = 0; b < 2; ++b)
#pragma unroll
        for (int r = 0; r < 16; ++r) acc[a][b][r] = 0.f;
    typename AL::Regs ar[4];
    u32x4 br[2];
#pragma unroll
    for (int i = 0; i < 4; ++i) al.issue(ar[i], m0 + ldrow + 64 * i, ldk);
#pragma unroll
    for (int i = 0; i < 2; ++i) br[i] = *(const u32x4*)(Bt + (size_t)(n0 + ldrow + 64 * i) * K + ldk);
    __syncthreads();
#pragma unroll
    for (int i = 0; i < 4; ++i) *(u32x4*)(sA + (ldrow + 64 * i) * 72 + ldk) = al.finish(ar[i], sMu, ldk);
#pragma unroll
    for (int i = 0; i < 2; ++i) *(u32x4*)(sB + (ldrow + 64 * i) * 72 + ldk) = br[i];
    __syncthreads();
    for (int kt = 0; kt < nk; ++kt) {
      const int cur = kt & 1;
      const bool more = (kt + 1) < nk;
      const int k0n = (kt + 1) * 64 + ldk;
      if (more) {
#pragma unroll
        for (int i = 0; i < 4; ++i) al.issue(ar[i], m0 + ldrow + 64 * i, k0n);
#pragma unroll
        for (int i = 0; i < 2; ++i) br[i] = *(const u32x4*)(Bt + (size_t)(n0 + ldrow + 64 * i) * K + k0n);
      }
      __builtin_amdgcn_sched_barrier(0);
      const bf16_t* a_ = sA + cur * (256 * 72);
      const bf16_t* b_ = sB + cur * (128 * 72);
#pragma unroll
      for (int kk = 0; kk < 4; ++kk) {
        u32x4 af[2], bfr[2];
#pragma unroll
        for (int mi = 0; mi < 2; ++mi) af[mi] = *(const u32x4*)(a_ + (wm * 64 + mi * 32 + l31) * 72 + kk * 16 + lh * 8);
#pragma unroll
        for (int ni = 0; ni < 2; ++ni) bfr[ni] = *(const u32x4*)(b_ + (wn * 64 + ni * 32 + l31) * 72 + kk * 16 + lh * 8);
#pragma unroll
        for (int mi = 0; mi < 2; ++mi)
#pragma unroll
          for (int ni = 0; ni < 2; ++ni) acc[mi][ni] = mfma32(bfr[ni], af[mi], acc[mi][ni]);
      }
      __builtin_amdgcn_sched_barrier(0);
      if (more) {
        bf16_t* an = sA + (cur ^ 1) * (256 * 72);
        bf16_t* bn = sB + (cur ^ 1) * (128 * 72);
#pragma unroll
        for (int i = 0; i < 4; ++i) *(u32x4*)(an + (ldrow + 64 * i) * 72 + ldk) = al.finish(ar[i], sMu, k0n);
#pragma unroll
        for (int i = 0; i < 2; ++i) *(u32x4*)(bn + (ldrow + 64 * i) * 72 + ldk) = br[i];
      }
      __syncthreads();
    }
#pragma unroll
    for (int mi = 0; mi < 2; ++mi)
#pragma unroll
      for (int ni = 0; ni < 2; ++ni)
#pragma unroll
        for (int q = 0; q < 4; ++q) {
          const int row = m0 + wm * 64 + mi * 32 + l31;
          const int col = n0 + wn * 64 + ni * 32 + 8 * q + 4 * lh;
          f32x4 v = {acc[mi][ni][4 * q], acc[mi][ni][4 * q + 1], acc[mi][ni][4 * q + 2], acc[mi][ni][4 * q + 3]};
          ep(row, col, v);
        }
  }
}


template <class AL, class EP>
__device__ __forceinline__ void gemm256_phase(char* lds, const bf16_t* __restrict__ Bt, int K, int mtiles, int ntiles, const AL al, const EP ep) {
  bf16_t* sA = (bf16_t*)lds;
  bf16_t* sB = (bf16_t*)(lds + 73728);
  float* sMu = (float*)(lds + 147456);
  const int tid = opaque_tid(), lane = tid & 63, wv = tid >> 6, wm = wv >> 1, wn = wv & 1;
  const int l31 = lane & 31, lh = lane >> 5;
  const int nk = K >> 6;
  const int ldrow = tid >> 3, ldk = (tid & 7) * 8;
  const int total = mtiles * ntiles;
  const int nslots = gridDim.x >> 3, xcd = blockIdx.x & 7, slot = blockIdx.x >> 3;
  const int gm = 4 * ntiles;
  for (int chunk = xcd; chunk * nslots < total; chunk += 8) {
    const int tile = chunk * nslots + slot;
    if (tile >= total) break;
    const int grp = tile / gm, rem = tile - grp * gm;
    const int mt = grp * 4 + (rem & 3), nt = rem >> 2;
    const int m0 = mt * 256, n0 = nt * 256;
    __syncthreads();
    al.stage(sMu, n0);
    f32x16 acc[2][4];
#pragma unroll
    for (int a = 0; a < 2; ++a)
#pragma unroll
      for (int b = 0; b < 4; ++b)
#pragma unroll
        for (int r = 0; r < 16; ++r) acc[a][b][r] = 0.f;
    typename AL::Regs ar[4];
    u32x4 br[4];
#pragma unroll
    for (int i = 0; i < 4; ++i) al.issue(ar[i], m0 + ldrow + 64 * i, ldk);
#pragma unroll
    for (int i = 0; i < 4; ++i) br[i] = *(const u32x4*)(Bt + (size_t)(n0 + ldrow + 64 * i) * K + ldk);
    __syncthreads();
#pragma unroll
    for (int i = 0; i < 4; ++i) *(u32x4*)(sA + (ldrow + 64 * i) * 72 + ldk) = al.finish(ar[i], sMu, ldk);
#pragma unroll
    for (int i = 0; i < 4; ++i) *(u32x4*)(sB + (ldrow + 64 * i) * 72 + ldk) = br[i];
    __syncthreads();
    for (int kt = 0; kt < nk; ++kt) {
      const int cur = kt & 1;
      const bool more = (kt + 1) < nk;
      const int k0n = (kt + 1) * 64 + ldk;
      if (more) {
#pragma unroll
        for (int i = 0; i < 4; ++i) al.issue(ar[i], m0 + ldrow + 64 * i, k0n);
#pragma unroll
        for (int i = 0; i < 4; ++i) br[i] = *(const u32x4*)(Bt + (size_t)(n0 + ldrow + 64 * i) * K + k0n);
      }
      __builtin_amdgcn_sched_barrier(0);
      const bf16_t* a_ = sA + cur * (256 * 72);
      const bf16_t* b_ = sB + cur * (256 * 72);
#pragma unroll
      for (int kk = 0; kk < 4; ++kk) {
        u32x4 af[2];
#pragma unroll
        for (int mi = 0; mi < 2; ++mi) af[mi] = *(const u32x4*)(a_ + (wm * 64 + mi * 32 + l31) * 72 + kk * 16 + lh * 8);
#pragma unroll
        for (int ni = 0; ni < 4; ++ni) {
          const u32x4 bfr = *(const u32x4*)(b_ + (wn * 128 + ni * 32 + l31) * 72 + kk * 16 + lh * 8);
#pragma unroll
          for (int mi = 0; mi < 2; ++mi) acc[mi][ni] = mfma32(bfr, af[mi], acc[mi][ni]);
        }
      }
      __builtin_amdgcn_sched_barrier(0);
      if (more) {
        bf16_t* an = sA + (cur ^ 1) * (256 * 72);
        bf16_t* bn = sB + (cur ^ 1) * (256 * 72);
#pragma unroll
        for (int i = 0; i < 4; ++i) *(u32x4*)(an + (ldrow + 64 * i) * 72 + ldk) = al.finish(ar[i], sMu, k0n);
#pragma unroll
        for (int i = 0; i < 4; ++i) *(u32x4*)(bn + (ldrow + 64 * i) * 72 + ldk) = br[i];
      }
      __syncthreads();
    }
#pragma unroll
    for (int mi = 0; mi < 2; ++mi)
#pragma unroll
      for (int ni = 0; ni < 4; ++ni) {
#pragma unroll
        for (int q = 0; q < 4; ++q) {
          const int row = m0 + wm * 64 + mi * 32 + l31;
          const int col = n0 + wn * 128 + ni * 32 + 8 * q + 4 * lh;
          f32x4 v = {acc[mi][ni][4 * q], acc[mi][ni][4 * q + 1], acc[mi][ni][4 * q + 2], acc[mi][ni][4 * q + 3]};
          ep(row, col, v);
        }
        __builtin_amdgcn_sched_barrier(0);
      }
  }
}

DEVI void st_bf16x4(bf16_t* p, f32x4 v) { u32x2 o; o.x = pk_bf16(v[0], v[1]); o.y = pk_bf16(v[2], v[3]); *(u32x2*)p = o; }

struct EpRwkvIn {
  bf16_t *R, *K, *V, *G, *WD, *AD;
  DEVI void operator()(int row, int col, f32x4 v) const {
    const int grp = col >> 10;
    if (grp < 4) {
      const int c = col & 1023;
      bf16_t* dst = grp == 0 ? R : grp == 1 ? K : grp == 2 ? V : G;
      if (grp == 3) { v[0] = siluf_(v[0]); v[1] = siluf_(v[1]); v[2] = siluf_(v[2]); v[3] = siluf_(v[3]); }
      st_bf16x4(dst + (size_t)row * 1024 + c, v);
    } else {
      const int c = col - 4096;
      if (c < 128) {
#pragma unroll
        for (int i = 0; i < 4; ++i) { const float t = __expf(2.f * v[i]); v[i] = 1.f - 2.f / (t + 1.f); }
        st_bf16x4(WD + (size_t)row * 128 + c, v);
      } else st_bf16x4(AD + (size_t)row * 128 + (c - 128), v);
    }
  }
};
struct EpRes {
  const float* xl_src; const float* xc_src; float* xl_dst; float* xc_dst; const float* modL;
  DEVI void operator()(int row, int col, f32x4 v) const {
    const bool lat = row < ML;
    const size_t off = lat ? (size_t)row * 1024 + col : (size_t)(row - ML) * 1024 + col;
    const float* src = (lat ? xl_src : xc_src) + off;
    float* dst = (lat ? xl_dst : xc_dst) + off;
    const f32x4 g = *(const f32x4*)(modL + (lat ? (row >> 12) : 8) * 3072 + 2048 + col);
    f32x4 x = *(const f32x4*)src;
    x += g * v;
    *(f32x4*)dst = x;
  }
};
struct EpLruIn {
  bf16_t *XR, *GG;
  DEVI void operator()(int row, int col, f32x4 v) const {
    if (col < LW) st_bf16x4(XR + (size_t)row * LW + col, v);
    else { v[0] = siluf_(v[0]); v[1] = siluf_(v[1]); v[2] = siluf_(v[2]); v[3] = siluf_(v[3]); st_bf16x4(GG + (size_t)row * LW + (col - LW), v); }
  }
};
struct EpNatIn {
  bf16_t *Q, *K, *VT, *G;
  DEVI void operator()(int row, int col, f32x4 v) const {
    const int grp = col >> 10, c = col & 1023;
    if (grp == 0) st_bf16x4(Q + (size_t)row * 1024 + c, v);
    else if (grp == 1) st_bf16x4(K + (size_t)row * 1024 + c, v);
    else if (grp == 3) { v[0] = siluf_(v[0]); v[1] = siluf_(v[1]); v[2] = siluf_(v[2]); v[3] = siluf_(v[3]); st_bf16x4(G + (size_t)row * 1024 + c, v); }
    else {
      unsigned idx, T;
      if (row < ML) { const unsigned b = row >> 12, t = row & 4095; T = 4096u; idx = ((b * 1024u + (unsigned)c) << 12) + t; }
      else { const unsigned r2 = row - ML; const unsigned b = r2 >> 8, t = r2 & 255; T = 256u; idx = (unsigned)ML * 1024u + ((b * 1024u + (unsigned)c) << 8) + t; }
#pragma unroll
      for (int i = 0; i < 4; ++i) VT[idx + (unsigned)i * T] = f2bf(v[i]);
    }
  }
};

constexpr int SSTR = 388;
DEVI int rwkv_row(int b, int d, int s) {
  if (s < 256) return ML + b * 256 + (d ? 255 - s : s);
  const int t = s - 256;
  return b * 4096 + (d ? 4095 - t : t);
}

struct ScanRec { f32x4 n0, n1, r0, r1, w0, w1, k0, k1, d0, d1; f32x2 vv, cc; };
DEVI void scan_load(ScanRec& R, const float* rec, int sp, int row0) {
  R.n0 = *(const f32x4*)(rec + 8 * sp);        R.n1 = *(const f32x4*)(rec + 8 * sp + 4);
  R.r0 = *(const f32x4*)(rec + 64 + 8 * sp);   R.r1 = *(const f32x4*)(rec + 64 + 8 * sp + 4);
  R.w0 = *(const f32x4*)(rec + 128 + 8 * sp);  R.w1 = *(const f32x4*)(rec + 128 + 8 * sp + 4);
  R.k0 = *(const f32x4*)(rec + 192 + 8 * sp);  R.k1 = *(const f32x4*)(rec + 192 + 8 * sp + 4);
  R.d0 = *(const f32x4*)(rec + 256 + 8 * sp);  R.d1 = *(const f32x4*)(rec + 256 + 8 * sp + 4);
  R.vv = *(const f32x2*)(rec + 320 + row0);
  R.cc = *(const f32x2*)(rec + 384);
}
DEVI f32x2 lo2(f32x4 v) { return (f32x2){v[0], v[1]}; }
DEVI f32x2 hi2(f32x4 v) { return (f32x2){v[2], v[3]}; }
DEVI float dot8(const f32x2 (&S)[4], f32x4 a, f32x4 b) {
  f32x2 acc = S[0] * lo2(a);
  acc = S[1] * hi2(a) + acc;
  acc = S[2] * lo2(b) + acc;
  acc = S[3] * hi2(b) + acc;
  return acc[0] + acc[1];
}
DEVI void upd8(f32x2 (&S)[4], const ScanRec& R, float sa, float v) {
  const f32x2 sa2 = {sa, sa}, v2 = {v, v};
  S[0] = S[0] * lo2(R.w0) + (sa2 * lo2(R.k0) + v2 * lo2(R.d0));
  S[1] = S[1] * hi2(R.w0) + (sa2 * hi2(R.k0) + v2 * hi2(R.d0));
  S[2] = S[2] * lo2(R.w1) + (sa2 * lo2(R.k1) + v2 * lo2(R.d1));
  S[3] = S[3] * hi2(R.w1) + (sa2 * hi2(R.k1) + v2 * hi2(R.d1));
}
DEVI void scan_step(f32x2 (&SA)[4], f32x2 (&SB)[4], const ScanRec& R, float* yout, bool wr) {
  float saA = dot8(SA, R.n0, R.n1), yA = dot8(SA, R.r0, R.r1);
  float saB = dot8(SB, R.n0, R.n1), yB = dot8(SB, R.r0, R.r1);
  saA = sum8(saA); saB = sum8(saB); yA = sum8(yA); yB = sum8(yB);
  upd8(SA, R, saA, R.vv[0]);
  upd8(SB, R, saB, R.vv[1]);
  if (wr) *(f32x2*)yout = (f32x2){yA + saA * R.cc[0] + R.vv[0] * R.cc[1], yB + saB * R.cc[0] + R.vv[1] * R.cc[1]};
}
DEVI float sum16(float v) { v = sum8(v); v += dpp_f<0x140>(v); return v; }

__device__ __forceinline__ void rwkv_scan_phase(char* lds, const bf16_t* __restrict__ R, const bf16_t* __restrict__ Kb, const bf16_t* __restrict__ V,
                                const bf16_t* __restrict__ WD, const bf16_t* __restrict__ AD, const bf16_t* __restrict__ Wup,
                                const float* __restrict__ b0, const float* __restrict__ k_ka, const float* __restrict__ r_k,
                                bf16_t* __restrict__ Y0, bf16_t* __restrict__ Y1, float* __restrict__ BON) {
  float* stepbuf = (float*)lds;
  float* wbuf = stepbuf + 2 * 16 * SSTR;
  float* abuf = wbuf + 1024;
  float* ybuf = abuf + 1024;
  const int tid = opaque_tid(), lane = tid & 63, wv = tid >> 6;
  constexpr int NCH = (256 + 4096) / 16;
  for (int chain = blockIdx.x; chain < 256; chain += gridDim.x) {
    const int d = chain & 1, h = (chain >> 1) & 15, b = chain >> 5;
    __syncthreads();
    if (wv < 4) {
      const int sp = lane & 7, row0 = wv * 16 + (lane >> 3) * 2;
      const bool wr = sp == 0;
      f32x2 SA[4], SB[4];
#pragma unroll
      for (int j = 0; j < 4; ++j) { SA[j] = (f32x2){0.f, 0.f}; SB[j] = (f32x2){0.f, 0.f}; }
      __syncthreads();
      __syncthreads();
      for (int c = 0; c < NCH; ++c) {
        const float* sb = stepbuf + (c & 1) * 16 * SSTR;
        float* yb = ybuf + (c & 1) * 1024 + row0;
        ScanRec ra, rb;
        scan_load(ra, sb, sp, row0);
#pragma unroll
        for (int i = 0; i < 8; i += 2) {
          scan_load(rb, sb + (i + 1) * SSTR, sp, row0);
          scan_step(SA, SB, ra, yb + i * 64, wr);
          scan_load(ra, sb + (i + 2) * SSTR, sp, row0);
          scan_step(SA, SB, rb, yb + (i + 1) * 64, wr);
        }
        __syncthreads();
#pragma unroll
        for (int i = 8; i < 16; i += 2) {
          scan_load(rb, sb + (i + 1) * SSTR, sp, row0);
          scan_step(SA, SB, ra, yb + i * 64, wr);
          if (i + 2 < 16) scan_load(ra, sb + (i + 2) * SSTR, sp, row0);
          scan_step(SA, SB, rb, yb + (i + 1) * 64, wr);
        }
        __syncthreads();
      }
    } else {
      const int ptid = tid - 256, pw = wv - 4;
      bf16_t* Y = d ? Y1 : Y0;
      const int ncol = h * 64 + pw * 16 + (lane & 15);
      u32x4 bu[2][2];
      float bias_u[2];
#pragma unroll
      for (int kind = 0; kind < 2; ++kind) {
        const bf16_t* wu = Wup + ((size_t)(d * 2 + kind) * 1024 + ncol) * 64 + 8 * (lane >> 4);
        bu[kind][0] = *(const u32x4*)wu; bu[kind][1] = *(const u32x4*)(wu + 32);
        bias_u[kind] = b0[(d * 2 + kind) * 1024 + ncol];
      }
      const int ti = ptid >> 4, dq = ptid & 15;
      const int hc = h * 64 + 4 * dq;
      const f32x4 kkv = *(const f32x4*)(k_ka + hc), kav = *(const f32x4*)(k_ka + 1024 + hc), rkv = *(const f32x4*)(r_k + hc);
      u32x4 xw0, xw1, xa0, xa1; u32x2 rr, kr, vr;
      auto issue = [&](int c) {
        const int rowA = rwkv_row(b, d, c * 16 + (lane & 15));
        const bf16_t* xp = WD + (size_t)rowA * 128 + d * 64 + 8 * (lane >> 4);
        const bf16_t* xq = AD + (size_t)rowA * 128 + d * 64 + 8 * (lane >> 4);
        xw0 = *(const u32x4*)xp; xw1 = *(const u32x4*)(xp + 32);
        xa0 = *(const u32x4*)xq; xa1 = *(const u32x4*)(xq + 32);
        const int rowB = rwkv_row(b, d, c * 16 + ti);
        rr = *(const u32x2*)(R + (size_t)rowB * 1024 + hc);
        kr = *(const u32x2*)(Kb + (size_t)rowB * 1024 + hc);
        vr = *(const u32x2*)(V + (size_t)rowB * 1024 + hc);
      };
      auto stepA = [&]() {
        f32x4 accw = {0.f, 0.f, 0.f, 0.f}, acca = {0.f, 0.f, 0.f, 0.f};
        accw = mfma16(xw0, bu[0][0], accw); accw = mfma16(xw1, bu[0][1], accw);
        acca = mfma16(xa0, bu[1][0], acca); acca = mfma16(xa1, bu[1][1], acca);
#pragma unroll
        for (int r = 0; r < 4; ++r) {
          const int o = ((lane >> 4) * 4 + r) * 64 + pw * 16 + (lane & 15);
          const float wl = -softplusf_(-(accw[r] + bias_u[0])) - 0.5f;
          wbuf[o] = __expf(-__expf(wl));
          abuf[o] = sigmoidf_(acca[r] + bias_u[1]);
        }
      };
      auto stepB = [&](int c, float* sb) {
        const float rv[4] = {bf_lo(rr.x), bf_hi(rr.x), bf_lo(rr.y), bf_hi(rr.y)};
        const float kv[4] = {bf_lo(kr.x), bf_hi(kr.x), bf_lo(kr.y), bf_hi(kr.y)};
        const float vv[4] = {bf_lo(vr.x), bf_hi(vr.x), bf_lo(vr.y), bf_hi(vr.y)};
        const f32x4 av = *(const f32x4*)(abuf + ti * 64 + 4 * dq), wv4 = *(const f32x4*)(wbuf + ti * 64 + 4 * dq);
        float q[4], ss = 0.f;
#pragma unroll
        for (int i = 0; i < 4; ++i) { q[i] = kv[i] * kkv[i]; ss += q[i] * q[i]; }
        ss = sum16(ss);
        const float inv = __builtin_amdgcn_rsqf(fmaxf(ss, 1e-24f));
        f32x4 nk, wrr, ka, kd, vo;
        float c1 = 0.f, c2 = 0.f, bn = 0.f;
#pragma unroll
        for (int i = 0; i < 4; ++i) {
          const float n = q[i] * inv;
          kd[i] = kv[i] * (1.f + (av[i] - 1.f) * kav[i]);
          ka[i] = n * av[i];
          nk[i] = -n; wrr[i] = wv4[i] * rv[i]; vo[i] = vv[i];
          c1 += ka[i] * rv[i]; c2 += kd[i] * rv[i]; bn += rv[i] * kd[i] * rkv[i];
        }
        c1 = sum16(c1); c2 = sum16(c2); bn = sum16(bn);
        float* rec = sb + ti * SSTR;
        *(f32x4*)(rec + 4 * dq) = nk;
        *(f32x4*)(rec + 64 + 4 * dq) = wrr;
        *(f32x4*)(rec + 128 + 4 * dq) = wv4;
        *(f32x4*)(rec + 192 + 4 * dq) = ka;
        *(f32x4*)(rec + 256 + 4 * dq) = kd;
        *(f32x4*)(rec + 320 + 4 * dq) = vo;
        if (dq == 0) {
          *(f32x2*)(rec + 384) = (f32x2){c1, c2};
          BON[((size_t)d * MT + rwkv_row(b, d, c * 16 + ti)) * 16 + h] = bn;
        }
      };
      auto storeY = [&](int c) {
        const f32x4 yv = *(const f32x4*)(ybuf + (c & 1) * 1024 + ti * 64 + 4 * dq);
        u32x2 o; o.x = pk_bf16(yv[0], yv[1]); o.y = pk_bf16(yv[2], yv[3]);
        *(u32x2*)(Y + (size_t)rwkv_row(b, d, c * 16 + ti) * 1024 + hc) = o;
      };
      issue(0);
      stepA();
      __syncthreads();
      stepB(0, stepbuf);
      issue(1);
      __syncthreads();
      for (int c = 0; c < NCH; ++c) {
        const bool more = (c + 1) < NCH;
        if (more) stepA();
        if (c >= 1) storeY(c - 1);
        __syncthreads();
        if (more) {
          stepB(c + 1, stepbuf + ((c + 1) & 1) * 16 * SSTR);
          if (c + 2 < NCH) issue(c + 2);
        }
        __builtin_amdgcn_sched_barrier(0);
        __syncthreads();
        __builtin_amdgcn_sched_barrier(0);
      }
      storeY(NCH - 1);
    }
  }
}

__device__ __forceinline__ void rwkv_post_phase(const bf16_t* __restrict__ Y0, const bf16_t* __restrict__ Y1, const bf16_t* __restrict__ V,
                                bf16_t* __restrict__ G, const float* __restrict__ BON, const float* __restrict__ gn, int nrows) {
  const int tidx = opaque_tid();
  const int lane = tidx & 63;
  const int gw = blockIdx.x * (NTHR / 64) + (tidx >> 6), nw = gridDim.x * (NTHR / 64);
  const int head = lane >> 2, c0 = lane * 16;
  for (int row = gw; row < nrows; row += nw) {
    const size_t off = (size_t)row * 1024 + c0;
    float y[16], v[16], g[16];
#pragma unroll
    for (int i = 0; i < 2; ++i) {
      const u32x4 a0 = *(const u32x4*)(Y0 + off + 8 * i), a1 = *(const u32x4*)(Y1 + off + 8 * i);
      const u32x4 av = *(const u32x4*)(V + off + 8 * i), ag = *(const u32x4*)(G + off + 8 * i);
      y[8 * i + 0] = bf_lo(a0.x) + bf_lo(a1.x); y[8 * i + 1] = bf_hi(a0.x) + bf_hi(a1.x);
      y[8 * i + 2] = bf_lo(a0.y) + bf_lo(a1.y); y[8 * i + 3] = bf_hi(a0.y) + bf_hi(a1.y);
      y[8 * i + 4] = bf_lo(a0.z) + bf_lo(a1.z); y[8 * i + 5] = bf_hi(a0.z) + bf_hi(a1.z);
      y[8 * i + 6] = bf_lo(a0.w) + bf_lo(a1.w); y[8 * i + 7] = bf_hi(a0.w) + bf_hi(a1.w);
      v[8 * i + 0] = bf_lo(av.x); v[8 * i + 1] = bf_hi(av.x); v[8 * i + 2] = bf_lo(av.y); v[8 * i + 3] = bf_hi(av.y);
      v[8 * i + 4] = bf_lo(av.z); v[8 * i + 5] = bf_hi(av.z); v[8 * i + 6] = bf_lo(av.w); v[8 * i + 7] = bf_hi(av.w);
      g[8 * i + 0] = bf_lo(ag.x); g[8 * i + 1] = bf_hi(ag.x); g[8 * i + 2] = bf_lo(ag.y); g[8 * i + 3] = bf_hi(ag.y);
      g[8 * i + 4] = bf_lo(ag.z); g[8 * i + 5] = bf_hi(ag.z); g[8 * i + 6] = bf_lo(ag.w); g[8 * i + 7] = bf_hi(ag.w);
    }
    float s = 0.f;
#pragma unroll
    for (int i = 0; i < 16; ++i) s += y[i];
    s += __shfl_xor(s, 1); s += __shfl_xor(s, 2);
    const float mean = s * (1.f / 64.f);
    float q = 0.f;
#pragma unroll
    for (int i = 0; i < 16; ++i) { const float dlt = y[i] - mean; q += dlt * dlt; }
    q += __shfl_xor(q, 1); q += __shfl_xor(q, 2);
    const float rstd = rsqrtf(q * (1.f / 64.f) + 64e-5f);
    const float bonus = BON[(size_t)row * 16 + head] + BON[((size_t)MT + row) * 16 + head];
    unsigned o[8];
#pragma unroll
    for (int i = 0; i < 8; ++i) {
      const float z0 = ((y[2 * i] - mean) * rstd * gn[c0 + 2 * i] + gn[1024 + c0 + 2 * i] + bonus * v[2 * i]) * g[2 * i];
      const float z1 = ((y[2 * i + 1] - mean) * rstd * gn[c0 + 2 * i + 1] + gn[1024 + c0 + 2 * i + 1] + bonus * v[2 * i + 1]) * g[2 * i + 1];
      o[i] = pk_bf16(z0, z1);
    }
    *(u32x4*)(G + off) = mk4(o[0], o[1], o[2], o[3]);
    *(u32x4*)(G + off + 8) = mk4(o[4], o[5], o[6], o[7]);
  }
}

__device__ __forceinline__ void rglru_phase(char* lds, const bf16_t* __restrict__ XR, const bf16_t* __restrict__ Wg, const float* __restrict__ conv_w,
                            const float* __restrict__ conv_b, const float* __restrict__ gate_b, const float* __restrict__ lam,
                            bf16_t* __restrict__ HS0, bf16_t* __restrict__ HS1) {
  bf16_t* xcT = (bf16_t*)lds;
  f32x2* AB = (f32x2*)(lds + 26624);
  bf16_t* raw = (bf16_t*)(lds + 26624);
  float* segP = (float*)(lds + 116736);
  float* segH = segP + 352;
  float* segC = segH + 352;
  bf16_t* wgs = (bf16_t*)(lds + 120960);
  float* cws = (float*)(lds + 160896);
  const int tid = opaque_tid(), lane = tid & 63, wv = tid >> 6;
  for (int chain = blockIdx.x; chain < 256; chain += gridDim.x) {
    const int d = chain & 1, blk = (chain >> 1) & 15, b = chain >> 5;
    bf16_t* HS = d ? HS1 : HS0;
    float carry = 0.f;
    __syncthreads();
    for (int q = tid; q < 2 * 96 * 12; q += NTHR) {
      const int g = q / 1152, rem = q - g * 1152, n = rem / 12, k8 = rem - n * 12;
      *(u32x4*)(wgs + (g * 96 + n) * 104 + k8 * 8) = *(const u32x4*)(Wg + ((size_t)((blk * 4 + d * 2 + g) * 96 + n)) * 96 + k8 * 8);
    }
    for (int e = tid; e < 5 * 88; e += NTHR) {
      const int j = e / 88, c = e - j * 88;
      cws[e] = j < 4 ? conv_w[j * LW + blk * 88 + c] : conv_b[blk * 88 + c];
    }
    for (int e = tid; e < 128 * 8; e += NTHR) xcT[(e >> 3) * 104 + 88 + (e & 7)] = 0;
    u32x4 pre[3];
    auto tile_geom = [&](int ti, int& seqbase, int& t0, int& T) {
      if (ti < 2) { seqbase = ML + b * 256; T = 256; t0 = (d ? 1 - ti : ti) * 128; }
      else { seqbase = b * 4096; T = 4096; t0 = (d ? 31 - (ti - 2) : (ti - 2)) * 128; }
    };
    auto prefetch = [&](int ti) {
      int seqbase, t0, T; tile_geom(ti, seqbase, t0, T);
#pragma unroll
      for (int i = 0; i < 3; ++i) {
        const int q = tid + NTHR * i;
        const int row = q / 11, cc = q - row * 11, t = t0 - 2 + row;
        u32x4 v = {0u, 0u, 0u, 0u};
        if (q < 131 * 11 && t >= 0 && t < T) v = *(const u32x4*)(XR + (size_t)(seqbase + t) * LW + blk * 88 + cc * 8);
        pre[i] = v;
      }
    };
    prefetch(0);
    for (int ti = 0; ti < 34; ++ti) {
      int seqbase, t0, T; tile_geom(ti, seqbase, t0, T);
      __syncthreads();
#pragma unroll
      for (int i = 0; i < 3; ++i) {
        const int q = tid + NTHR * i;
        if (q < 131 * 11) *(u32x4*)(raw + q * 8) = pre[i];
      }
      if (ti + 1 < 34) prefetch(ti + 1);
      __builtin_amdgcn_sched_barrier(0);
      __syncthreads();
      for (int e = tid; e < 128 * 44; e += NTHR) {
        const int tl = e / 44, c2 = (e - tl * 44) * 2;
        float a0 = cws[4 * 88 + c2], a1 = cws[4 * 88 + c2 + 1];
#pragma unroll
        for (int j = 0; j < 4; ++j) {
          const unsigned x = *(const unsigned*)(raw + (tl + j) * 88 + c2);
          a0 += bf_lo(x) * cws[j * 88 + c2]; a1 += bf_hi(x) * cws[j * 88 + c2 + 1];
        }
        *(unsigned*)(xcT + tl * 104 + c2) = pk_bf16(a0, a1);
      }
      __syncthreads();
      {
        const int tok = wv * 16 + (lane & 15);
        u32x4 af[3];
#pragma unroll
        for (int kk = 0; kk < 3; ++kk) af[kk] = *(const u32x4*)(xcT + tok * 104 + kk * 32 + 8 * (lane >> 4));
#pragma unroll
        for (int n6 = 0; n6 < 6; ++n6) {
          f32x4 accr = {0.f, 0.f, 0.f, 0.f}, acci = {0.f, 0.f, 0.f, 0.f};
          const int ncol = n6 * 16 + (lane & 15);
          const bf16_t* wr_ = wgs + ncol * 104 + 8 * (lane >> 4);
          const bf16_t* wi_ = wgs + (96 + ncol) * 104 + 8 * (lane >> 4);
#pragma unroll
          for (int kk = 0; kk < 3; ++kk) {
            accr = mfma16(af[kk], *(const u32x4*)(wr_ + kk * 32), accr);
            acci = mfma16(af[kk], *(const u32x4*)(wi_ + kk * 32), acci);
          }
          if (ncol < 88) {
            const int ch = blk * 88 + ncol;
            const float gbr = gate_b[(d * 2 + 0) * LW + ch], gbi = gate_b[(d * 2 + 1) * LW + ch];
            const float spl = softplusf_(-lam[d * LW + ch]);
#pragma unroll
            for (int r = 0; r < 4; ++r) {
              const int tk = wv * 16 + (lane >> 4) * 4 + r;
              const float rg = sigmoidf_(accr[r] + gbr), ig = sigmoidf_(acci[r] + gbi);
              const float a = __expf(-8.f * rg * spl);
              const float bb = sqrtf(fmaxf(1.f - a * a, 0.f)) * ig * bf2f(xcT[tk * 104 + ncol]);
              AB[tk * 88 + ncol] = (f32x2){a, bb};
            }
          }
        }
      }
      __syncthreads();
      if (tid < 352) {
        const int seg = tid / 88, c = tid - seg * 88;
        float hl = 0.f, P = 1.f;
        for (int u0 = seg * 32; u0 < seg * 32 + 32; u0 += 8) {
          f32x2 ab[8];
#pragma unroll
          for (int i = 0; i < 8; ++i) { const int tl = d ? 127 - (u0 + i) : (u0 + i); ab[i] = AB[tl * 88 + c]; }
#pragma unroll
          for (int i = 0; i < 8; ++i) { hl = ab[i][0] * hl + ab[i][1]; P *= ab[i][0]; ab[i] = (f32x2){hl, P}; }
#pragma unroll
          for (int i = 0; i < 8; ++i) { const int tl = d ? 127 - (u0 + i) : (u0 + i); AB[tl * 88 + c] = ab[i]; }
        }
        segH[seg * 88 + c] = hl; segP[seg * 88 + c] = P;
      }
      __syncthreads();
      if (tid < 88) {
        float cur = carry;
#pragma unroll
        for (int seg = 0; seg < 4; ++seg) { segC[seg * 88 + tid] = cur; cur = segP[seg * 88 + tid] * cur + segH[seg * 88 + tid]; }
        carry = cur;
      }
      __syncthreads();
      for (int q = tid; q < 128 * 11; q += NTHR) {
        const int tl = q / 11, c8 = (q - tl * 11) * 8;
        const int u = d ? 127 - tl : tl;
        const float* sc = segC + (u >> 5) * 88 + c8;
        float hv[8];
#pragma unroll
        for (int i = 0; i < 8; ++i) { const f32x2 hp = AB[tl * 88 + c8 + i]; hv[i] = hp[0] + hp[1] * sc[i]; }
        *(u32x4*)(HS + (size_t)(seqbase + t0 + tl) * LW + blk * 88 + c8) =
            mk4(pk_bf16(hv[0], hv[1]), pk_bf16(hv[2], hv[3]), pk_bf16(hv[4], hv[5]), pk_bf16(hv[6], hv[7]));
      }
    }
  }
}

__device__ __forceinline__ void lru_z_phase(const bf16_t* __restrict__ HS0, const bf16_t* __restrict__ HS1, bf16_t* __restrict__ GG) {
  const size_t n8 = (size_t)MT * LW / 8;
  for (size_t e = (size_t)blockIdx.x * NTHR + threadIdx.x; e < n8; e += (size_t)gridDim.x * NTHR) {
    const u32x4 a = *(const u32x4*)(HS0 + e * 8), b = *(const u32x4*)(HS1 + e * 8), g = *(const u32x4*)(GG + e * 8);
    u32x4 o;
    o.x = pk_bf16((bf_lo(a.x) + bf_lo(b.x)) * bf_lo(g.x), (bf_hi(a.x) + bf_hi(b.x)) * bf_hi(g.x));
    o.y = pk_bf16((bf_lo(a.y) + bf_lo(b.y)) * bf_lo(g.y), (bf_hi(a.y) + bf_hi(b.y)) * bf_hi(g.y));
    o.z = pk_bf16((bf_lo(a.z) + bf_lo(b.z)) * bf_lo(g.z), (bf_hi(a.z) + bf_hi(b.z)) * bf_hi(g.z));
    o.w = pk_bf16((bf_lo(a.w) + bf_lo(b.w)) * bf_lo(g.w), (bf_hi(a.w) + bf_hi(b.w)) * bf_hi(g.w));
    *(u32x4*)(GG + e * 8) = o;
  }
}

__device__ __forceinline__ void nat_qk_phase(bf16_t* __restrict__ Q, bf16_t* __restrict__ Kb, bf16_t* __restrict__ QR, const float* __restrict__ qk_g) {
  const int tidx = opaque_tid();
  const int lane = tidx & 63;
  const int gw = blockIdx.x * (NTHR / 64) + (tidx >> 6), nw = gridDim.x * (NTHR / 64);
  const int qd = lane & 3;
  float gq[16], gk[16], inv[16];
#pragma unroll
  for (int i = 0; i < 16; ++i) { gq[i] = qk_g[qd * 16 + i]; gk[i] = qk_g[64 + qd * 16 + i]; inv[i] = exp2f(-(float)i * (13.287712379549449f / 16.f)); }
  for (int row = gw; row < MT; row += nw) {
    const bool lat = row < ML;
    const size_t off = (size_t)row * 1024 + lane * 16;
    float cs[16], sn[16];
    if (lat) {
      const int t = row & 4095;
      const float pos = (float)((qd >> 1) ? (t & 63) : (t >> 6));
#pragma unroll
      for (int i = 0; i < 16; ++i) {
        float rev = pos * inv[i] * 0.15915494309189535f;
        rev -= floorf(rev);
        sn[i] = __builtin_amdgcn_sinf(rev); cs[i] = __builtin_amdgcn_cosf(rev);
      }
    }
#pragma unroll
    for (int which = 0; which < 2; ++which) {
      bf16_t* P = which ? Kb : Q;
      const u32x4 a = *(const u32x4*)(P + off), b2 = *(const u32x4*)(P + off + 8);
      const unsigned u[8] = {a.x, a.y, a.z, a.w, b2.x, b2.y, b2.z, b2.w};
      float x[16];
#pragma unroll
      for (int i = 0; i < 8; ++i) { x[2 * i] = bf_lo(u[i]); x[2 * i + 1] = bf_hi(u[i]); }
      float ss = 0.f;
#pragma unroll
      for (int i = 0; i < 16; ++i) ss += x[i] * x[i];
      ss += __shfl_xor(ss, 1); ss += __shfl_xor(ss, 2);
      const float rstd = rsqrtf(ss * (1.f / 64.f) + 1e-6f);
#pragma unroll
      for (int i = 0; i < 16; ++i) x[i] = x[i] * rstd * (which ? gk[i] : gq[i]);
      unsigned pl[8];
#pragma unroll
      for (int i = 0; i < 8; ++i) pl[i] = pk_bf16(x[2 * i], x[2 * i + 1]);
      unsigned rt[8];
      if (lat) {
        float y[16];
#pragma unroll
        for (int i = 0; i < 16; ++i) {
          const float pr = __shfl_xor(x[i], 1);
          y[i] = x[i] * cs[i] + ((qd & 1) ? pr * sn[i] : -pr * sn[i]);
        }
#pragma unroll
        for (int i = 0; i < 8; ++i) rt[i] = pk_bf16(y[2 * i], y[2 * i + 1]);
      }
      if (which == 0) {
        *(u32x4*)(Q + off) = mk4(pl[0], pl[1], pl[2], pl[3]);
        *(u32x4*)(Q + off + 8) = mk4(pl[4], pl[5], pl[6], pl[7]);
        if (lat) { *(u32x4*)(QR + off) = mk4(rt[0], rt[1], rt[2], rt[3]); *(u32x4*)(QR + off + 8) = mk4(rt[4], rt[5], rt[6], rt[7]); }
      } else {
        if (lat) { *(u32x4*)(Kb + off) = mk4(rt[0], rt[1], rt[2], rt[3]); *(u32x4*)(Kb + off + 8) = mk4(rt[4], rt[5], rt[6], rt[7]); }
        else { *(u32x4*)(Kb + off) = mk4(pl[0], pl[1], pl[2], pl[3]); *(u32x4*)(Kb + off + 8) = mk4(pl[4], pl[5], pl[6], pl[7]); }
      }
    }
  }
}

struct AttnState { f32x16 O[2][2]; float m[2], l[2]; };

DEVI void attn_load_k(u32x4 (&kf)[4], const bf16_t* __restrict__ kbase, int lane) {
  const int l31 = lane & 31, lh = lane >> 5;
#pragma unroll
  for (int ks = 0; ks < 4; ++ks) kf[ks] = *(const u32x4*)(kbase + (size_t)l31 * 1024 + ks * 16 + 8 * lh);
}

DEVI void attn_compute(AttnState& st, const u32x4* qs, const bf16_t* __restrict__ kbase, const bf16_t* __restrict__ vtbase, int vtT,
                       const float* __restrict__ rpbs, bool band, int brow, int half, int lane) {
  const int l31 = lane & 31, lh = lane >> 5;
  u32x4 kf[4];
  attn_load_k(kf, kbase, lane);
  u32x4 vf[4];
#pragma unroll
  for (int dt = 0; dt < 2; ++dt)
#pragma unroll
    for (int s = 0; s < 2; ++s) {
      const bf16_t* vp = vtbase + (size_t)(dt * 32 + l31) * vtT + 16 * s + 4 * lh;
      const u32x2 lo = *(const u32x2*)vp, hi = *(const u32x2*)(vp + 8);
      vf[dt * 2 + s] = mk4(lo.x, lo.y, hi.x, hi.y);
    }
  __builtin_amdgcn_sched_barrier(0);
  constexpr float SC = 0.125f * 1.4426950408889634f;
  u32x4 pf[2][2];
#pragma unroll
  for (int qt = 0; qt < 2; ++qt) {
    f32x16 S;
#pragma unroll
    for (int r = 0; r < 16; ++r) S[r] = 0.f;
#pragma unroll
    for (int ks = 0; ks < 4; ++ks) S = mfma32(kf[ks], qs[(qt * 4 + ks) * 64], S);
    float cmax = -INFINITY;
    if (band) {
      const int qc = qt * 32 + l31;
      const int cst = min(max(qc - 8, 0), 48);
#pragma unroll
      for (int r = 0; r < 16; ++r) {
        const int key = (r & 3) + 8 * (r >> 2) + 4 * lh;
        const int kc = half * 32 + key;
        const bool ok = (kc >= cst) && (kc < cst + 16);
        const int bi = ok ? (brow * 31 + kc - qc + 15) : 0;
        const float sv = S[r] * SC + rpbs[bi];
        S[r] = ok ? sv : -INFINITY;
        cmax = fmaxf(cmax, S[r]);
      }
    } else {
#pragma unroll
      for (int r = 0; r < 16; ++r) { S[r] *= SC; cmax = fmaxf(cmax, S[r]); }
    }
    cmax = fmaxf(cmax, __shfl_xor(cmax, 32));
    const float mnew = fmaxf(st.m[qt], cmax);
    const float alpha = __builtin_amdgcn_exp2f(st.m[qt] - mnew);
    const bool grew = mnew > st.m[qt];
    st.m[qt] = mnew;
    float ps = 0.f;
#pragma unroll
    for (int r = 0; r < 16; ++r) { S[r] = __builtin_amdgcn_exp2f(S[r] - mnew); ps += S[r]; }
    st.l[qt] = st.l[qt] * alpha + ps;
    if (__any(grew)) {
#pragma unroll
      for (int dt = 0; dt < 2; ++dt)
#pragma unroll
        for (int r = 0; r < 16; ++r) st.O[qt][dt][r] *= alpha;
    }
    pf[qt][0] = mk4(pk_bf16(S[0], S[1]), pk_bf16(S[2], S[3]), pk_bf16(S[4], S[5]), pk_bf16(S[6], S[7]));
    pf[qt][1] = mk4(pk_bf16(S[8], S[9]), pk_bf16(S[10], S[11]), pk_bf16(S[12], S[13]), pk_bf16(S[14], S[15]));
  }
#pragma unroll
  for (int dt = 0; dt < 2; ++dt)
#pragma unroll
    for (int s = 0; s < 2; ++s) {
      st.O[0][dt] = mfma32(vf[dt * 2 + s], pf[0][s], st.O[0][dt]);
      st.O[1][dt] = mfma32(vf[dt * 2 + s], pf[1][s], st.O[1][dt]);
    }
}

__device__ __forceinline__ void natten_phase(char* lds, const bf16_t* __restrict__ Q, const bf16_t* __restrict__ QR, const bf16_t* __restrict__ Kb,
                             const bf16_t* __restrict__ VT, bf16_t* __restrict__ G, const float* __restrict__ rpb, bf16_t* __restrict__ Zd) {
  float* rpbs = (float*)lds;
  __syncthreads();
  for (int e = threadIdx.x; e < 16 * 465; e += NTHR) rpbs[e] = rpb[e] * 1.4426950408889634f;
  __syncthreads();
  const int tidx = opaque_tid();
  const int lane = tidx & 63, l31 = lane & 31, lh = lane >> 5;
  const int gw = blockIdx.x * (NTHR / 64) + (tidx >> 6), nw = gridDim.x * (NTHR / 64);
  const bf16_t* VTC = VT + (size_t)ML * 1024;
  u32x4* qs = (u32x4*)(lds + 32768) + (tidx >> 6) * 512 + lane;
  const int xcd = blockIdx.x & 7, wx = (blockIdx.x >> 3) * (NTHR / 64) + (tidx >> 6), nwx = (gridDim.x >> 3) * (NTHR / 64);
  for (int i = wx; i < 1024 + 64; i += nwx) {
    const bool lat = i < 1024;
    int b, h, r = 0, qrow0;
    if (lat) { const int pair = xcd * 16 + (i >> 6); r = i & 63; b = pair >> 4; h = pair & 15; qrow0 = b * 4096 + r * 64; }
    else { const int it = i - 1024; const int pair = xcd * 16 + (it >> 2); const int qt64 = it & 3; b = pair >> 4; h = pair & 15; qrow0 = ML + b * 256 + qt64 * 64; }
    const int start = min(max(r - 4, 0), 56);
    const int nchunks = lat ? 24 : 8;
    AttnState st;
#pragma unroll
    for (int a = 0; a < 2; ++a) { st.m[a] = -INFINITY; st.l[a] = 0.f;
#pragma unroll
      for (int c = 0; c < 2; ++c)
#pragma unroll
        for (int rr = 0; rr < 16; ++rr) st.O[a][c][rr] = 0.f; }
#pragma unroll
    for (int qt = 0; qt < 2; ++qt)
#pragma unroll
      for (int ks = 0; ks < 4; ++ks) qs[(qt * 4 + ks) * 64] = *(const u32x4*)(Q + (size_t)(qrow0 + qt * 32 + l31) * 1024 + h * 64 + ks * 16 + 8 * lh);
    for (int j = 0; j < nchunks; ++j) {
      if (j == 8) {
#pragma unroll
        for (int qt = 0; qt < 2; ++qt)
#pragma unroll
          for (int ks = 0; ks < 4; ++ks) qs[(qt * 4 + ks) * 64] = *(const u32x4*)(QR + (size_t)(qrow0 + qt * 32 + l31) * 1024 + h * 64 + ks * 16 + 8 * lh);
      }
      if (j < 8) {
        const bf16_t* kbase = Kb + (size_t)(ML + b * 256 + j * 32) * 1024 + h * 64;
        const bf16_t* vtb = VTC + (size_t)(b * 16 + h) * 64 * 256 + j * 32;
        attn_compute(st, qs, kbase, vtb, 256, rpbs, false, 0, 0, lane);
      } else {
        const int ii = j - 8, kr = start + (ii >> 1), half = ii & 1;
        const bf16_t* kbase = Kb + (size_t)(b * 4096 + kr * 64 + half * 32) * 1024 + h * 64;
        const bf16_t* vtb = VT + (size_t)(b * 16 + h) * 64 * 4096 + kr * 64 + half * 32;
        attn_compute(st, qs, kbase, vtb, 4096, rpbs, true, h * 15 + (kr - r + 7), half, lane);
      }
    }
#pragma unroll
    for (int qt = 0; qt < 2; ++qt) {
      const float lt = st.l[qt] + __shfl_xor(st.l[qt], 32);
      const float inv = 1.f / lt;
      bf16_t* grow = G + (size_t)(qrow0 + qt * 32 + l31) * 1024 + h * 64;
#pragma unroll
      for (int dt = 0; dt < 2; ++dt)
#pragma unroll
        for (int q4 = 0; q4 < 4; ++q4) {
          bf16_t* gp = grow + dt * 32 + 8 * q4 + 4 * lh;
          bf16_t* zp = Zd + (gp - G);
          const u32x2 gv = *(const u32x2*)gp;
          u32x2 o;
          o.x = pk_bf16(st.O[qt][dt][4 * q4] * inv * bf_lo(gv.x), st.O[qt][dt][4 * q4 + 1] * inv * bf_hi(gv.x));
          o.y = pk_bf16(st.O[qt][dt][4 * q4 + 2] * inv * bf_lo(gv.y), st.O[qt][dt][4 * q4 + 3] * inv * bf_hi(gv.y));
          *(u32x2*)zp = o;
        }
    }
  }
}

template <int ph>
__device__ __forceinline__ void run_phase(const Params& p, char* lds, bool last_rep) {
  char* ws = p.ws;
  const float* MOD = (const float*)(ws + OFF_MOD);
  float* XC = (float*)(ws + OFF_XC);
  bf16_t* HB = (bf16_t*)(ws + OFF_HB);
  bf16_t* A0 = (bf16_t*)(ws + OFF_A0); bf16_t* A1 = (bf16_t*)(ws + OFF_A1); bf16_t* A2 = (bf16_t*)(ws + OFF_A2);
  bf16_t* A3 = (bf16_t*)(ws + OFF_A3); bf16_t* A4 = (bf16_t*)(ws + OFF_A4);
  bf16_t* WD = (bf16_t*)(ws + OFF_WD); bf16_t* AD = (bf16_t*)(ws + OFF_AD);
  float* BON = (float*)(ws + OFF_BON);
  if (ph == 0) { phase0(p, lds); return; }
  constexpr int layer = (ph - 1) / 5, sub = (ph - 1) % 5;
  const float* modL = MOD + (size_t)layer * 9 * 3072;
  const float* xl_cur = layer == 0 ? p.in[0] : p.out;
  const float* xc_cur = layer == 0 ? p.in[2] : XC;
  if (layer == 0 || layer == 3) {
    const int ib = layer ? 33 : 4;
    const bf16_t* WIN = (const bf16_t*)(ws + (layer ? OFF_W3IN : OFF_W0IN));
    const bf16_t* WUP = (const bf16_t*)(ws + (layer ? OFF_W3UP : OFF_W0UP));
    const bf16_t* WOUT = (const bf16_t*)(ws + (layer ? OFF_W3OUT : OFF_W0OUT));
    if (sub == 0) norm_phase<true>(xl_cur, xc_cur, p.in[ib], modL, HB, A4);
    else if (sub == 1) { ALMix al{HB, A4, p.in[ib + 4]}; EpRwkvIn ep{A0, A1, A2, A3, WD, AD}; gemm256_phase(lds, WIN, 1024, MT / 256, 16, al, ep); gemm_phase(lds, WIN, 1024, MT / 256, 2, al, ep, 4096, true); }
    else if (sub == 2) rwkv_scan_phase(lds, A0, A1, A2, WD, AD, WUP, p.in[ib + 5], p.in[ib + 8], p.in[ib + 9], HB, A4, BON);
    else if (sub == 3) rwkv_post_phase(HB, A4, A2, A3, BON, p.in[ib + 10], layer == 3 ? ML : MT);
    else { ALPlain al{A3, 1024}; EpRes ep{xl_cur, xc_cur, p.out, XC, modL}; gemm256_phase(lds, WOUT, 1024, (layer == 3 ? ML : MT) / 256, 4, al, ep); }
  } else if (layer == 1) {
    bf16_t* HS0 = (bf16_t*)(ws + OFF_HS0); bf16_t* XR = (bf16_t*)(ws + OFF_XR); bf16_t* GG = (bf16_t*)(ws + OFF_GG); bf16_t* HS1 = (bf16_t*)(ws + OFF_HS1);
    if (sub == 0) norm_phase<false>(xl_cur, xc_cur, p.in[16], modL, HB, nullptr);
    else if (sub == 1) { ALPlain al{HB, 1024}; EpLruIn ep{XR, GG}; gemm256_phase(lds, (const bf16_t*)(ws + OFF_W1IN), 1024, MT / 256, 11, al, ep); }
    else if (sub == 2) rglru_phase(lds, XR, (const bf16_t*)(ws + OFF_W1G), p.in[20], p.in[21], p.in[23], p.in[24], HS0, HS1);
    else if (sub == 3) lru_z_phase(HS0, HS1, GG);
    else { ALPlain al{GG, LW}; EpRes ep{xl_cur, xc_cur, p.out, XC, modL}; gemm256_phase(lds, (const bf16_t*)(ws + OFF_W1OUT), LW, MT / 256, 4, al, ep); }
  } else {
    if (sub == 0) norm_phase<false>(xl_cur, xc_cur, p.in[26], modL, HB, nullptr);
    else if (sub == 1) { ALPlain al{HB, 1024}; EpNatIn ep{A0, A1, A2, A3}; gemm256_phase(lds, (const bf16_t*)(ws + OFF_W2IN), 1024, MT / 256, 16, al, ep); }
    else if (sub == 2) nat_qk_phase(A0, A1, A4, p.in[30]);
    else if (sub == 3) natten_phase(lds, A0, A4, A1, A2, A3, p.in[31], last_rep ? A3 : HB);
    else { ALPlain al{A3, 1024}; EpRes ep{xl_cur, xc_cur, p.out, XC, modL}; gemm256_phase(lds, (const bf16_t*)(ws + OFF_W2OUT), 1024, MT / 256, 4, al, ep); }
  }
}

__global__ void __launch_bounds__(NTHR) mega_kernel(Params p) {
  __shared__ __attribute__((aligned(16))) char lds[LDS_BYTES];
  __shared__ u32x4 xb_words;
  cg::grid_group grid = cg::this_grid();
  if (threadIdx.x == 0) xb_words = (u32x4){0u, 0u, 0u, 0u};
  __syncthreads();
  const XcdBarrier xb = xcd_barrier_post((unsigned*)(p.ws + OFF_BAR), (volatile LAS unsigned*)&xb_words);
#define PHASE(k) if (p.ph_lo <= k && k < p.ph_hi) { for (int rep = 0; rep < REP[k]; ++rep) { run_phase<k>(p, lds, rep + 1 == REP[k]); if (rep + 1 < REP[k] || k + 1 < p.ph_hi) { if (k == 0) grid.sync(); else xcd_barrier(xb); } } }
  PHASE(0) PHASE(1) PHASE(2) PHASE(3) PHASE(4) PHASE(5) PHASE(6) PHASE(7) PHASE(8) PHASE(9) PHASE(10)
  PHASE(11) PHASE(12) PHASE(13) PHASE(14) PHASE(15) PHASE(16) PHASE(17) PHASE(18) PHASE(19) PHASE(20)
#undef PHASE
}

extern "C" void kernel_launch(void* const* d_in, const int* in_sizes, int n_in, void* d_out, int out_size, void* d_ws, size_t ws_size,
                              hipStream_t stream) {
  static int grid_blocks = 0;
  if (!grid_blocks) {
    int dev = 0, cus = 0, per_cu = 0;
    hipGetDevice(&dev);
    hipDeviceGetAttribute(&cus, hipDeviceAttributeMultiprocessorCount, dev);
    hipOccupancyMaxActiveBlocksPerMultiprocessor(&per_cu, mega_kernel, NTHR, 0);
    if (per_cu < 1) { fprintf(stderr, "occupancy query returned %d\n", per_cu); per_cu = 1; }
    if (per_cu > 1) per_cu = 1;
    grid_blocks = cus * per_cu;
    if (n_in != 45 || ws_size < WS_END) fprintf(stderr, "unexpected n_in %d / ws %zu (need %zu)\n", n_in, ws_size, (size_t)WS_END);
  }
  Params p{};
  for (int i = 0; i < 45; ++i) p.in[i] = (const float*)d_in[i];
  p.out = (float*)d_out;
  p.ws = (char*)d_ws;
  (void)hipMemsetAsync((char*)d_ws + OFF_BAR, 0, XCD_BAR_WORDS * 4, stream);
#if N_LAUNCH_MODE == 1
  p.ph_lo = 0; p.ph_hi = NPHASE;
  void* args[] = {&p};
  hipError_t e = hipLaunchCooperativeKernel((void*)mega_kernel, dim3(grid_blocks), dim3(NTHR), args, 0, stream);
  if (e != hipSuccess) fprintf(stderr, "cooperative launch failed: %s (grid %d)\n", hipGetErrorString(e), grid_blocks);
#else
  for (int ph = 0; ph < NPHASE; ++ph) {
    p.ph_lo = ph; p.ph_hi = ph + 1;
    hipLaunchKernelGGL(mega_kernel, dim3(grid_blocks), dim3(NTHR), 0, stream, p);
  }
#endif
}
```

```cpp
#include <hip/hip_runtime.h>
#include <hip/hip_cooperative_groups.h>
#include <cstdio>
#include <cstdint>
namespace cg = cooperative_groups;

#ifndef N_LAUNCH_MODE
#define N_LAUNCH_MODE 1
#endif

typedef unsigned short bf16_t;
typedef short bf16x8 __attribute__((ext_vector_type(8)));
typedef float f32x4 __attribute__((ext_vector_type(4)));
typedef float f32x16 __attribute__((ext_vector_type(16)));
typedef float f32x2 __attribute__((ext_vector_type(2)));
typedef unsigned u32x4 __attribute__((ext_vector_type(4)));
typedef unsigned u32x2 __attribute__((ext_vector_type(2)));

#define DEVI __device__ __forceinline__

constexpr int D = 1024, NB = 8, SEQ = 4096, CTX = 256;
constexpr int ML = NB * SEQ;
constexpr int MC = NB * CTX;
constexpr int MT = ML + MC;
constexpr int LW = 1408;
constexpr int NTHR = 512;
constexpr int NPHASE = 21;
constexpr int LDS_BYTES = 163840 - 16;
__device__ constexpr int REP[21] = {1,1,1,1,1,1,1,1,1,1,1,1,1,1,1,1,1,1,1,1,1};

constexpr size_t SZ_ACT = (size_t)MT * 1024 * 2;
constexpr size_t OFF_MOD = 0;
constexpr size_t OFF_BAR = 458752;
constexpr size_t OFF_W0IN = 524288;
constexpr size_t SZ_RWIN = (size_t)4352 * 1024 * 2;
constexpr size_t SZ_RWUP = (size_t)4 * 1024 * 64 * 2;
constexpr size_t SZ_SQ = (size_t)1024 * 1024 * 2;
constexpr size_t OFF_W0UP = OFF_W0IN + SZ_RWIN;
constexpr size_t OFF_W0OUT = OFF_W0UP + SZ_RWUP;
constexpr size_t OFF_W3IN = OFF_W0OUT + SZ_SQ;
constexpr size_t OFF_W3UP = OFF_W3IN + SZ_RWIN;
constexpr size_t OFF_W3OUT = OFF_W3UP + SZ_RWUP;
constexpr size_t OFF_W1IN = OFF_W3OUT + SZ_SQ;
constexpr size_t OFF_W1G = OFF_W1IN + (size_t)2816 * 1024 * 2;
constexpr size_t OFF_W1OUT = OFF_W1G + (size_t)16 * 4 * 96 * 96 * 2;
constexpr size_t OFF_W2IN = OFF_W1OUT + (size_t)1024 * 1408 * 2;
constexpr size_t OFF_W2OUT = OFF_W2IN + (size_t)4096 * 1024 * 2;
constexpr size_t OFF_XC = OFF_W2OUT + SZ_SQ;
constexpr size_t OFF_BON = OFF_XC + (size_t)MC * 1024 * 4;
constexpr size_t OFF_BIG = OFF_BON + (size_t)2 * MT * 16 * 4;
constexpr size_t OFF_HB = OFF_BIG;
constexpr size_t OFF_A0 = OFF_BIG + SZ_ACT;
constexpr size_t OFF_A1 = OFF_A0 + SZ_ACT;
constexpr size_t OFF_A2 = OFF_A1 + SZ_ACT;
constexpr size_t OFF_A3 = OFF_A2 + SZ_ACT;
constexpr size_t OFF_A4 = OFF_A3 + SZ_ACT;
constexpr size_t OFF_WD = OFF_A4 + SZ_ACT;
constexpr size_t OFF_AD = OFF_WD + (size_t)MT * 128 * 2;
constexpr size_t WS_END = OFF_AD + (size_t)MT * 128 * 2;
constexpr size_t SZ_LRU = (size_t)MT * LW * 2;
constexpr size_t OFF_HS0 = OFF_BIG;
constexpr size_t OFF_XR = OFF_BIG + SZ_LRU;
constexpr size_t OFF_GG = OFF_XR + SZ_LRU;
constexpr size_t OFF_HS1 = OFF_GG + SZ_LRU;
static_assert(OFF_HS1 + SZ_LRU <= WS_END, "lru overlay");
static_assert(WS_END <= (size_t)536870912, "ws");

struct Params {
  const float* in[45];
  float* out;
  char* ws;
  int ph_lo, ph_hi;
};

DEVI u32x4 mk4(unsigned a, unsigned b, unsigned c, unsigned d) { u32x4 r = {a, b, c, d}; return r; }
DEVI int opaque_tid() { int t = threadIdx.x; asm volatile("" : "+v"(t)); return t; }
DEVI float bf_lo(unsigned u) { return __uint_as_float(u << 16); }
DEVI float bf_hi(unsigned u) { return __uint_as_float(u & 0xffff0000u); }
DEVI float bf2f(bf16_t h) { return __uint_as_float(((unsigned)h) << 16); }
typedef __bf16 bf16x2_t __attribute__((ext_vector_type(2)));
DEVI unsigned pk_bf16(float lo, float hi) { f32x2 f = {lo, hi}; bf16x2_t v = __builtin_convertvector(f, bf16x2_t); return __builtin_bit_cast(unsigned, v); }
DEVI bf16_t f2bf(float f) { return (bf16_t)(pk_bf16(f, 0.f) & 0xffffu); }
DEVI float wave_sum(float v) {
#pragma unroll
  for (int o = 32; o; o >>= 1) v += __shfl_xor(v, o);
  return v;
}
DEVI float sigmoidf_(float x) { return __builtin_amdgcn_rcpf(1.f + __expf(-x)); }
DEVI float siluf_(float x) { return x * __builtin_amdgcn_rcpf(1.f + __expf(-x)); }
DEVI float softplusf_(float x) { return fmaxf(x, 0.f) + __logf(1.f + __expf(-fabsf(x))); }
DEVI f32x16 mfma32(u32x4 a, u32x4 b, f32x16 c) {
  return __builtin_amdgcn_mfma_f32_32x32x16_bf16(__builtin_bit_cast(bf16x8, a), __builtin_bit_cast(bf16x8, b), c, 0, 0, 0);
}
DEVI f32x4 mfma16(u32x4 a, u32x4 b, f32x4 c) {
  return __builtin_amdgcn_mfma_f32_16x16x32_bf16(__builtin_bit_cast(bf16x8, a), __builtin_bit_cast(bf16x8, b), c, 0, 0, 0);
}
template <int CTRL> DEVI float dpp_f(float v) {
  return __int_as_float(__builtin_amdgcn_update_dpp(0, __float_as_int(v), CTRL, 0xf, 0xf, true));
}
DEVI float sum8(float v) {
  v += dpp_f<0xB1>(v);
  v += dpp_f<0x4E>(v);
  v += dpp_f<0x141>(v);
  return v;
}

#define XB_TMO      128
#define XB_XCNT(j)  (256  + 64 * (j))
#define XB_XSUB(j)  (1280 + 64 * (j))
#define XB_XGEN(j)  (2304 + 64 * (j))
#define XB_TOP      3328
#define XB_TOPGEN   3392
#define XCD_BAR_WORDS 3456
#define XB_SPIN_CAP (1u << 18)
#define LAS __attribute__((address_space(3)))

__device__ __forceinline__ unsigned xb_ld(unsigned* p)              { return __hip_atomic_load(p, __ATOMIC_RELAXED, __HIP_MEMORY_SCOPE_AGENT); }
__device__ __forceinline__ unsigned xb_add(unsigned* p, unsigned v) { return __hip_atomic_fetch_add(p, v, __ATOMIC_RELAXED, __HIP_MEMORY_SCOPE_AGENT); }
__device__ __forceinline__ unsigned xb_xcc_id() { return (unsigned)__builtin_amdgcn_s_getreg((3 << 11) | 20) & 0xFu; }
#define XB_SPIN(cond, bar) do { unsigned _sp = 0; while (cond) { __builtin_amdgcn_s_sleep(1); \
    if ((++_sp & 255u) == 0u) { if (xb_ld(&(bar)[XB_TMO])) break; if (_sp > XB_SPIN_CAP) { atomicAdd(&(bar)[XB_TMO], 1u); break; } } } } while (0)

struct XcdBarrier {
    unsigned* bar; unsigned x;
    volatile LAS unsigned* st;
};

__device__ __forceinline__ XcdBarrier xcd_barrier_post(unsigned* bar, volatile LAS unsigned* st) {
    XcdBarrier b; b.bar = bar; b.x = xb_xcc_id(); b.st = st;
    if (threadIdx.x == 0) (void)xb_add(&bar[XB_XCNT(b.x)], 1u);
    return b;
}
__device__ __forceinline__ void xcd_barrier_complete(unsigned* bar, unsigned x, unsigned& nloc, unsigned& nx) {
    const unsigned G = gridDim.x * gridDim.y * gridDim.z;
    unsigned sum, cnt, mine, sp = 0u;
    for (;;) {
        sum = 0u; cnt = 0u; mine = 0u;
#pragma unroll
        for (unsigned j = 0; j < 16; ++j) { const unsigned c = xb_ld(&bar[XB_XCNT(j)]); sum += c; cnt += (c > 0u) ? 1u : 0u; mine = (j == x) ? c : mine; }
        if (sum == G) break;
        __builtin_amdgcn_s_sleep(1);
        if ((++sp & 255u) == 0u) { if (xb_ld(&bar[XB_TMO])) break; if (sp > XB_SPIN_CAP) { atomicAdd(&bar[XB_TMO], 1u); break; } }
    }
    nloc = mine > 0u ? mine : 1u; nx = cnt > 0u ? cnt : 1u;
}

__device__ __forceinline__ void xcd_barrier(const XcdBarrier& b) {
    asm volatile("s_waitcnt vmcnt(0)" ::: "memory");
    __syncthreads();
    if (threadIdx.x == 0) {
        unsigned* bar = b.bar;
        __builtin_amdgcn_s_waitcnt(0);
        unsigned nloc = b.st[0], nx = b.st[1];
        if (nloc == 0u) { xcd_barrier_complete(bar, b.x, nloc, nx); b.st[0] = nloc; b.st[1] = nx; }
        const unsigned old = xb_add(&bar[XB_XSUB(b.x)], 1u);
        const unsigned gen = old / nloc;
        if (old + 1u == (gen + 1u) * nloc) {
            __builtin_amdgcn_fence(__ATOMIC_RELEASE, "agent");
            asm volatile("s_waitcnt vmcnt(0)" ::: "memory");
            const unsigned og = xb_add(&bar[XB_TOP], 1u);
            const unsigned tg = og / nx;
            if (og + 1u == (tg + 1u) * nx) xb_add(&bar[XB_TOPGEN], 1u);
            else XB_SPIN(xb_ld(&bar[XB_TOPGEN]) == tg, bar);
            __builtin_amdgcn_fence(__ATOMIC_ACQUIRE, "agent");
            xb_add(&bar[XB_XGEN(b.x)], 1u);
            asm volatile("s_waitcnt vmcnt(0)" ::: "memory");
        } else {
            XB_SPIN(xb_ld(&bar[XB_XGEN(b.x)]) == gen, bar);
            __builtin_amdgcn_fence(__ATOMIC_ACQUIRE, "agent");
            asm volatile("s_waitcnt vmcnt(0)" ::: "memory");
        }
    }
    __syncthreads();
}


struct TJob { const float* src; int K, N; bf16_t* dst; int ldd; };

DEVI TJob get_tjob(const Params& p, int j) {
  TJob t;
  if (j < 26) {
    const int l = j / 13, jj = j % 13;
    const int ib = l ? 33 : 4;
    bf16_t* win = (bf16_t*)(p.ws + (l ? OFF_W3IN : OFF_W0IN));
    bf16_t* wup = (bf16_t*)(p.ws + (l ? OFF_W3UP : OFF_W0UP));
    bf16_t* wout = (bf16_t*)(p.ws + (l ? OFF_W3OUT : OFF_W0OUT));
    if (jj < 4) { t.src = p.in[ib + 3] + (size_t)jj * 1048576; t.K = 1024; t.N = 1024; t.dst = win + (size_t)jj * 1048576; t.ldd = 1024; }
    else if (jj < 8) { const int idx = jj - 4, d = idx >> 1, kind = idx & 1;
      t.src = p.in[ib + 6] + (size_t)idx * 65536; t.K = 1024; t.N = 64; t.dst = win + (size_t)(4096 + kind * 128 + d * 64) * 1024; t.ldd = 1024; }
    else if (jj < 12) { const int idx = jj - 8;
      t.src = p.in[ib + 7] + (size_t)idx * 65536; t.K = 64; t.N = 1024; t.dst = wup + (size_t)idx * 65536; t.ldd = 64; }
    else { t.src = p.in[ib + 11]; t.K = 1024; t.N = 1024; t.dst = wout; t.ldd = 1024; }
  } else if (j == 26) { t.src = p.in[19]; t.K = 1024; t.N = 2816; t.dst = (bf16_t*)(p.ws + OFF_W1IN); t.ldd = 1024; }
  else if (j == 27) { t.src = p.in[25]; t.K = 1408; t.N = 1024; t.dst = (bf16_t*)(p.ws + OFF_W1OUT); t.ldd = 1408; }
  else if (j == 28) { t.src = p.in[29]; t.K = 1024; t.N = 4096; t.dst = (bf16_t*)(p.ws + OFF_W2IN); t.ldd = 1024; }
  else { t.src = p.in[32]; t.K = 1024; t.N = 1024; t.dst = (bf16_t*)(p.ws + OFF_W2OUT); t.ldd = 1024; }
  return t;
}

__device__ __forceinline__ void phase0(const Params& p, char* lds) {
  const int tid = opaque_tid();
  {
    bf16_t* wg = (bf16_t*)(p.ws + OFF_W1G);
    const float* gw = p.in[22];
    const int total = 16 * 4 * 96 * 96;
    for (int e = blockIdx.x * NTHR + tid; e < total; e += gridDim.x * NTHR) {
      const int k = e % 96, n = (e / 96) % 96, dg = (e / 9216) & 3, blk = e / 36864;
      float v = 0.f;
      if (k < 88 && n < 88) v = gw[((size_t)(dg * 16 + blk) * 88 + k) * 88 + n];
      wg[e] = f2bf(v);
    }
  }
  constexpr int N_MOD_ITEMS = 96;
  constexpr int N_TILES = 5152;
  float* act = (float*)lds;
  float* red = (float*)(lds + 36864);
  float* tl = (float*)lds;
  for (int item = blockIdx.x; item < N_MOD_ITEMS + N_TILES; item += gridDim.x) {
    __syncthreads();
    if (item < N_MOD_ITEMS) {
      const int L = item / 24, nc = item % 24;
      const int ib = (L == 0) ? 4 : (L == 1) ? 16 : (L == 2) ? 26 : 33;
      const float* ada_w = p.in[ib + 1];
      const float* ada_b = p.in[ib + 2];
      for (int e = tid; e < 9 * 1024; e += NTHR) {
        const int i = e >> 10, k = e & 1023;
        const float c = (i < 8) ? p.in[1][i * 1024 + k] : p.in[3][k];
        act[e] = siluf_(c);
      }
      __syncthreads();
      const int kq = tid >> 7, nl = tid & 127, n = nc * 128 + nl;
      float acc[9];
#pragma unroll
      for (int i = 0; i < 9; ++i) acc[i] = 0.f;
      for (int k = kq * 256; k < kq * 256 + 256; ++k) {
        const float w = ada_w[(size_t)k * 3072 + n];
#pragma unroll
        for (int i = 0; i < 9; ++i) acc[i] += act[i * 1024 + k] * w;
      }
#pragma unroll
      for (int i = 0; i < 9; ++i) red[(kq * 9 + i) * 128 + nl] = acc[i];
      __syncthreads();
      float* mod = (float*)(p.ws + OFF_MOD) + (size_t)L * 9 * 3072;
      for (int e = tid; e < 9 * 128; e += NTHR) {
        const int i = e >> 7, c = e & 127;
        const float s = red[(0 * 9 + i) * 128 + c] + red[(1 * 9 + i) * 128 + c] + red[(2 * 9 + i) * 128 + c] + red[(3 * 9 + i) * 128 + c];
        mod[i * 3072 + nc * 128 + c] = s + ada_b[nc * 128 + c];
      }
    } else {
      int t = item - N_MOD_ITEMS;
      int j = 0;
      TJob job = get_tjob(p, 0);
      for (;;) {
        const int nt = (job.K >> 6) * (job.N >> 6);
        if (t < nt) break;
        t -= nt; ++j; job = get_tjob(p, j);
      }
      const int ntn = job.N >> 6;
      const int k0 = (t / ntn) * 64, n0 = (t % ntn) * 64;
#pragma unroll
      for (int i = 0; i < 2; ++i) {
        const int k = (tid >> 4) + 32 * i, n4 = (tid & 15) * 4;
        const float4 v = *(const float4*)(job.src + (size_t)(k0 + k) * job.N + n0 + n4);
        tl[k * 65 + n4 + 0] = v.x; tl[k * 65 + n4 + 1] = v.y; tl[k * 65 + n4 + 2] = v.z; tl[k * 65 + n4 + 3] = v.w;
      }
      __syncthreads();
      const int n = tid >> 3, k8 = (tid & 7) * 8;
      u32x4 o;
      o.x = pk_bf16(tl[(k8 + 0) * 65 + n], tl[(k8 + 1) * 65 + n]);
      o.y = pk_bf16(tl[(k8 + 2) * 65 + n], tl[(k8 + 3) * 65 + n]);
      o.z = pk_bf16(tl[(k8 + 4) * 65 + n], tl[(k8 + 5) * 65 + n]);
      o.w = pk_bf16(tl[(k8 + 6) * 65 + n], tl[(k8 + 7) * 65 + n]);
      *(u32x4*)(job.dst + (size_t)(n0 + n) * job.ldd + k0 + k8) = o;
    }
  }
}

DEVI void norm_row(const float* __restrict__ xr, const float* __restrict__ g, const float* __restrict__ mod, int lane, float (&h)[16]) {
  float4 x[4];
  float ss = 0.f;
#pragma unroll
  for (int i = 0; i < 4; ++i) {
    x[i] = *(const float4*)(xr + lane * 4 + 256 * i);
    ss += x[i].x * x[i].x + x[i].y * x[i].y + x[i].z * x[i].z + x[i].w * x[i].w;
  }
  ss = wave_sum(ss);
  const float rstd = rsqrtf(ss * (1.f / 1024.f) + 1e-6f);
#pragma unroll
  for (int i = 0; i < 4; ++i) {
    const int c = lane * 4 + 256 * i;
    const float4 gg = *(const float4*)(g + c);
    const float4 sh = *(const float4*)(mod + c);
    const float4 sc = *(const float4*)(mod + 1024 + c);
    h[i * 4 + 0] = x[i].x * rstd * gg.x * (1.f + sc.x) + sh.x;
    h[i * 4 + 1] = x[i].y * rstd * gg.y * (1.f + sc.y) + sh.y;
    h[i * 4 + 2] = x[i].z * rstd * gg.z * (1.f + sc.z) + sh.z;
    h[i * 4 + 3] = x[i].w * rstd * gg.w * (1.f + sc.w) + sh.w;
  }
}

template <bool WITH_HS>
__device__ __forceinline__ void norm_phase(const float* __restrict__ xl, const float* __restrict__ xc, const float* __restrict__ g,
                           const float* __restrict__ modL, bf16_t* __restrict__ H, bf16_t* __restrict__ HS) {
  const int tidx = opaque_tid();
  const int lane = tidx & 63;
  const int gw = blockIdx.x * (NTHR / 64) + (tidx >> 6), nw = gridDim.x * (NTHR / 64);
  for (int row = gw; row < MT; row += nw) {
    const bool lat = row < ML;
    const float* xbase = lat ? xl + (size_t)row * 1024 : xc + (size_t)(row - ML) * 1024;
    const float* mod = modL + (lat ? (row >> 12) : 8) * 3072;
    float h[16];
    norm_row(xbase, g, mod, lane, h);
#pragma unroll
    for (int i = 0; i < 4; ++i) {
      u32x2 o; o.x = pk_bf16(h[i * 4], h[i * 4 + 1]); o.y = pk_bf16(h[i * 4 + 2], h[i * 4 + 3]);
      *(u32x2*)(H + (size_t)row * 1024 + lane * 4 + 256 * i) = o;
    }
    if (WITH_HS) {
      const int t = lat ? (row & 4095) : ((row - ML) & 255);
      const int T = lat ? 4096 : 256;
      float s[16];
#pragma unroll
      for (int i = 0; i < 16; ++i) s[i] = 0.f;
      if (t > 0) { float hp[16]; norm_row(xbase - 1024, g, mod, lane, hp);
#pragma unroll
        for (int i = 0; i < 16; ++i) s[i] += hp[i]; }
      if (t < T - 1) { float hn[16]; norm_row(xbase + 1024, g, mod, lane, hn);
#pragma unroll
        for (int i = 0; i < 16; ++i) s[i] += hn[i]; }
#pragma unroll
      for (int i = 0; i < 4; ++i) {
        u32x2 o; o.x = pk_bf16(0.5f * s[i * 4], 0.5f * s[i * 4 + 1]); o.y = pk_bf16(0.5f * s[i * 4 + 2], 0.5f * s[i * 4 + 3]);
        *(u32x2*)(HS + (size_t)row * 1024 + lane * 4 + 256 * i) = o;
      }
    }
  }
}

struct ALPlain {
  const bf16_t* A; int lda;
  typedef u32x4 Regs;
  DEVI void stage(float*, int) const {}
  DEVI void issue(Regs& r, int row, int k) const { r = *(const u32x4*)(A + (size_t)row * lda + k); }
  DEVI u32x4 finish(const Regs& r, const float*, int) const { return r; }
};
struct ALMix {
  const bf16_t* H; const bf16_t* HS; const float* mu;
  struct Regs { u32x4 h, s; };
  DEVI void stage(float* sMu, int n0) const {
    const int grp = n0 >> 10;
    const int j = grp == 0 ? 0 : grp == 1 ? 2 : grp == 2 ? 3 : grp == 3 ? 5 : (n0 - 4096) < 128 ? 1 : 4;
    for (int e = threadIdx.x; e < 1024; e += NTHR) sMu[e] = mu[j * 1024 + e];
  }
  DEVI void issue(Regs& r, int row, int k) const {
    r.h = *(const u32x4*)(H + (size_t)row * 1024 + k);
    r.s = *(const u32x4*)(HS + (size_t)row * 1024 + k);
  }
  DEVI unsigned mix2(unsigned h, unsigned s, float m0, float m1) const {
    const float h0 = bf_lo(h), h1 = bf_hi(h), s0 = bf_lo(s), s1 = bf_hi(s);
    return pk_bf16(h0 + (s0 - h0) * m0, h1 + (s1 - h1) * m1);
  }
  DEVI u32x4 finish(const Regs& r, const float* sMu, int k) const {
    const float4 ma = *(const float4*)(sMu + k), mb = *(const float4*)(sMu + k + 4);
    u32x4 o;
    o.x = mix2(r.h.x, r.s.x, ma.x, ma.y); o.y = mix2(r.h.y, r.s.y, ma.z, ma.w);
    o.z = mix2(r.h.z, r.s.z, mb.x, mb.y); o.w = mix2(r.h.w, r.s.w, mb.z, mb.w);
    return o;
  }
};

template <class AL, class EP>
__device__ __forceinline__ void gemm_phase(char* lds, const bf16_t* __restrict__ Bt, int K, int mtiles, int ntiles, const AL al, const EP ep, int n_base = 0, bool reverse = false, int mt_base = 0) {
  bf16_t* sA = (bf16_t*)lds;
  bf16_t* sB = (bf16_t*)(lds + 73728);
  float* sMu = (float*)(lds + 110592);
  const int tid = opaque_tid(), lane = tid & 63, wv = tid >> 6, wm = wv >> 1, wn = wv & 1;
  const int l31 = lane & 31, lh = lane >> 5;
  const int nk = K >> 6;
  const int ldrow = tid >> 3, ldk = (tid & 7) * 8;
  const int total = mtiles * ntiles;
  const int bid = reverse ? (int)(gridDim.x - 1 - blockIdx.x) : (int)blockIdx.x;
  const int nslots = gridDim.x >> 3, xcd = bid & 7, slot = bid >> 3;
  const int gm = 4 * ntiles;
  for (int chunk = xcd; chunk * nslots < total; chunk += 8) {
    const int tile = chunk * nslots + slot;
    if (tile >= total) break;
    const int grp = tile / gm, rem = tile - grp * gm;
    const int mt = grp * 4 + (rem & 3), nt = rem >> 2;
    const int m0 = (mt_base + mt) * 256, n0 = n_base + nt * 128;
    __syncthreads();
    al.stage(sMu, n0);
    f32x16 acc[2][2];
#pragma unroll
    for (int a = 0; a < 2; ++a)
#pragma unroll
      for (int b = 0; b < 2; ++b)
#pragma unroll
        for (int r = 0; r < 16; ++r) acc[a][b][r] = 0.f;
    typename AL::Regs ar[4];
    u32x4 br[2];
#pragma unroll
    for (int i = 0; i < 4; ++i) al.issue(ar[i], m0 + ldrow + 64 * i, ldk);
#pragma unroll
    for (int i = 0; i < 2; ++i) br[i] = *(const u32x4*)(Bt + (size_t)(n0 + ldrow + 64 * i) * K + ldk);
    __syncthreads();
#pragma unroll
    for (int i = 0; i < 4; ++i) *(u32x4*)(sA + (ldrow + 64 * i) * 72 + ldk) = al.finish(ar[i], sMu, ldk);
#pragma unroll
    for (int i = 0; i < 2; ++i) *(u32x4*)(sB + (ldrow + 64 * i) * 72 + ldk) = br[i];
    __syncthreads();
    for (int kt = 0; kt < nk; ++kt) {
      const int cur = kt & 1;
      const bool more = (kt + 1) < nk;
      const int k0n = (kt + 1) * 64 + ldk;
      if (more) {
#pragma unroll
        for (int i = 0; i < 4; ++i) al.issue(ar[i], m0 + ldrow + 64 * i, k0n);
#pragma unroll
        for (int i = 0; i < 2; ++i) br[i] = *(const u32x4*)(Bt + (size_t)(n0 + ldrow + 64 * i) * K + k0n);
      }
      __builtin_amdgcn_sched_barrier(0);
      const bf16_t* a_ = sA + cur * (256 * 72);
      const bf16_t* b_ = sB + cur * (128 * 72);
#pragma unroll
      for (int kk = 0; kk < 4; ++kk) {
        u32x4 af[2], bfr[2];
#pragma unroll
        for (int mi = 0; mi < 2; ++mi) af[mi] = *(const u32x4*)(a_ + (wm * 64 + mi * 32 + l31) * 72 + kk * 16 + lh * 8);
#pragma unroll
        for (int ni = 0; ni < 2; ++ni) bfr[ni] = *(const u32x4*)(b_ + (wn * 64 + ni * 32 + l31) * 72 + kk * 16 + lh * 8);
#pragma unroll
        for (int mi = 0; mi < 2; ++mi)
#pragma unroll
          for (int ni = 0; ni < 2; ++ni) acc[mi][ni] = mfma32(bfr[ni], af[mi], acc[mi][ni]);
      }
      __builtin_amdgcn_sched_barrier(0);
      if (more) {
        bf16_t* an = sA + (cur ^ 1) * (256 * 72);
        bf16_t* bn = sB + (cur ^ 1) * (128 * 72);
#pragma unroll
        for (int i = 0; i < 4; ++i) *(u32x4*)(an + (ldrow + 64 * i) * 72 + ldk) = al.finish(ar[i], sMu, k0n);
#pragma unroll
        for (int i = 0; i < 2; ++i) *(u32x4*)(bn + (ldrow + 64 * i) * 72 + ldk) = br[i];
      }
      __syncthreads();
    }
#pragma unroll
    for (int mi = 0; mi < 2; ++mi)
#pragma unroll
      for (int ni = 0; ni < 2; ++ni)
#pragma unroll
        for (int q = 0; q < 4; ++q) {
          const int row = m0 + wm * 64 + mi * 32 + l31;
          const int col = n0 + wn * 64 + ni * 32 + 8 * q + 4 * lh;
          f32x4 v = {acc[mi][ni][4 * q], acc[mi][ni][4 * q + 1], acc[mi][ni][4 * q + 2], acc[mi][ni][4 * q + 3]};
          ep(row, col, v);
        }
  }
}


template <class AL, class EP>
__device__ __forceinline__ void gemm256_phase(char* lds, const bf16_t* __restrict__ Bt, int K, int mtiles, int ntiles, const AL al, const EP ep) {
  bf16_t* sA = (bf16_t*)lds;
  bf16_t* sB = (bf16_t*)(lds + 73728);
  float* sMu = (float*)(lds + 147456);
  const int tid = opaque_tid(), lane = tid & 63, wv = tid >> 6, wm = wv >> 1, wn = wv & 1;
  const int l31 = lane & 31, lh = lane >> 5;
  const int nk = K >> 6;
  const int ldrow = tid >> 3, ldk = (tid & 7) * 8;
  const int total = mtiles * ntiles;
  const int nslots = gridDim.x >> 3, xcd = blockIdx.x & 7, slot = blockIdx.x >> 3;
  const int gm = 4 * ntiles;
  for (int chunk = xcd; chunk * nslots < total; chunk += 8) {
    const int tile = chunk * nslots + slot;
    if (tile >= total) break;
    const int grp = tile / gm, rem = tile - grp * gm;
    const int mt = grp * 4 + (rem & 3), nt = rem >> 2;
    const int m0 = mt * 256, n0 = nt * 256;
    __syncthreads();
    al.stage(sMu, n0);
    f32x16 acc[2][4];
#pragma unroll
    for (int a = 0; a < 2; ++a)
#pragma unroll
      for (int b = 0; b < 4; ++b)
#pragma unroll
        for (int r = 0; r < 16; ++r) acc[a][b][r] = 0.f;
    typename AL::Regs ar[4];
    u32x4 br[4];
#pragma unroll
    for (int i = 0; i < 4; ++i) al.issue(ar[i], m0 + ldrow + 64 * i, ldk);
#pragma unroll
    for (int i = 0; i < 4; ++i) br[i] = *(const u32x4*)(Bt + (size_t)(n0 + ldrow + 64 * i) * K + ldk);
    __syncthreads();
#pragma unroll
    for (int i = 0; i < 4; ++i) *(u32x4*)(sA + (ldrow + 64 * i) * 72 + ldk) = al.finish(ar[i], sMu, ldk);
#pragma unroll
    for (int i = 0; i < 4; ++i) *(u32x4*)(sB + (ldrow + 64 * i) * 72 + ldk) = br[i];
    __syncthreads();
    for (int kt = 0; kt < nk; ++kt) {
      const int cur = kt & 1;
      const bool more = (kt + 1) < nk;
      const int k0n = (kt + 1) * 64 + ldk;
      if (more) {
#pragma unroll
        for (int i = 0; i < 4; ++i) al.issue(ar[i], m0 + ldrow + 64 * i, k0n);
#pragma unroll
        for (int i = 0; i < 4; ++i) br[i] = *(const u32x4*)(Bt + (size_t)(n0 + ldrow + 64 * i) * K + k0n);
      }
      __builtin_amdgcn_sched_barrier(0);
      const bf16_t* a_ = sA + cur * (256 * 72);
      const bf16_t* b_ = sB + cur * (256 * 72);
#pragma unroll
      for (int kk = 0; kk < 4; ++kk) {
        u32x4 af[2];
#pragma unroll
        for (int mi = 0; mi < 2; ++mi) af[mi] = *(const u32x4*)(a_ + (wm * 64 + mi * 32 + l31) * 72 + kk * 16 + lh * 8);
#pragma unroll
        for (int ni = 0; ni < 4; ++ni) {
          const u32x4 bfr = *(const u32x4*)(b_ + (wn * 128 + ni * 32 + l31) * 72 + kk * 16 + lh * 8);
#pragma unroll
          for (int mi = 0; mi < 2; ++mi) acc[mi][ni] = mfma32(bfr, af[mi], acc[mi][ni]);
        }
      }
      __builtin_amdgcn_sched_barrier(0);
      if (more) {
        bf16_t* an = sA + (cur ^ 1) * (256 * 72);
        bf16_t* bn = sB + (cur ^ 1) * (256 * 72);
#pragma unroll
        for (int i = 0; i < 4; ++i) *(u32x4*)(an + (ldrow + 64 * i) * 72 + ldk) = al.finish(ar[i], sMu, k0n);
#pragma unroll
        for (int i = 0; i < 4; ++i) *(u32x4*)(bn + (ldrow + 64 * i) * 72 + ldk) = br[i];
      }
      __syncthreads();
    }
    if constexpr (EP::VIA_LDS) {
      float* reg = (float*)(lds + wv * 16896);
#pragma unroll
      for (int mi = 0; mi < 2; ++mi) {
#pragma unroll
        for (int ni = 0; ni < 4; ++ni)
#pragma unroll
          for (int q = 0; q < 4; ++q) {
            f32x4 v = {acc[mi][ni][4 * q], acc[mi][ni][4 * q + 1], acc[mi][ni][4 * q + 2], acc[mi][ni][4 * q + 3]};
            *(f32x4*)(reg + l31 * 132 + ni * 32 + 8 * q + 4 * lh) = v;
          }
#pragma unroll 4
        for (int it = 0; it < 16; ++it) {
          const int rl = it * 2 + lh;
          const f32x4 v = *(const f32x4*)(reg + rl * 132 + l31 * 4);
          ep(m0 + wm * 64 + mi * 32 + rl, n0 + wn * 128 + l31 * 4, v);
        }
      }
    } else
#pragma unroll
    for (int mi = 0; mi < 2; ++mi)
#pragma unroll
      for (int ni = 0; ni < 4; ++ni) {
#pragma unroll
        for (int q = 0; q < 4; ++q) {
          const int row = m0 + wm * 64 + mi * 32 + l31;
          const int col = n0 + wn * 128 + ni * 32 + 8 * q + 4 * lh;
          f32x4 v = {acc[mi][ni][4 * q], acc[mi][ni][4 * q + 1], acc[mi][ni][4 * q + 2], acc[mi][ni][4 * q + 3]};
          ep(row, col, v);
        }
        __builtin_amdgcn_sched_barrier(0);
      }
  }
}

DEVI void st_bf16x4(bf16_t* p, f32x4 v) { u32x2 o; o.x = pk_bf16(v[0], v[1]); o.y = pk_bf16(v[2], v[3]); *(u32x2*)p = o; }

struct EpRwkvIn {
  static constexpr bool VIA_LDS = false;
  bf16_t *R, *K, *V, *G, *WD, *AD;
  DEVI void operator()(int row, int col, f32x4 v) const {
    const int grp = col >> 10;
    if (grp < 4) {
      const int c = col & 1023;
      bf16_t* dst = grp == 0 ? R : grp == 1 ? K : grp == 2 ? V : G;
      if (grp == 3) { v[0] = siluf_(v[0]); v[1] = siluf_(v[1]); v[2] = siluf_(v[2]); v[3] = siluf_(v[3]); }
      st_bf16x4(dst + (size_t)row * 1024 + c, v);
    } else {
      const int c = col - 4096;
      if (c < 128) {
#pragma unroll
        for (int i = 0; i < 4; ++i) { const float t = __expf(2.f * v[i]); v[i] = 1.f - 2.f / (t + 1.f); }
        st_bf16x4(WD + (size_t)row * 128 + c, v);
      } else st_bf16x4(AD + (size_t)row * 128 + (c - 128), v);
    }
  }
};
struct EpRes {
  static constexpr bool VIA_LDS = true;
  const float* xl_src; const float* xc_src; float* xl_dst; float* xc_dst; const float* modL;
  DEVI void operator()(int row, int col, f32x4 v) const {
    const bool lat = row < ML;
    const size_t off = lat ? (size_t)row * 1024 + col : (size_t)(row - ML) * 1024 + col;
    const float* src = (lat ? xl_src : xc_src) + off;
    float* dst = (lat ? xl_dst : xc_dst) + off;
    const f32x4 g = *(const f32x4*)(modL + (lat ? (row >> 12) : 8) * 3072 + 2048 + col);
    f32x4 x = *(const f32x4*)src;
    x += g * v;
    *(f32x4*)dst = x;
  }
};
struct EpLruIn {
  static constexpr bool VIA_LDS = false;
  bf16_t *XR, *GG;
  DEVI void operator()(int row, int col, f32x4 v) const {
    if (col < LW) st_bf16x4(XR + (size_t)row * LW + col, v);
    else { v[0] = siluf_(v[0]); v[1] = siluf_(v[1]); v[2] = siluf_(v[2]); v[3] = siluf_(v[3]); st_bf16x4(GG + (size_t)row * LW + (col - LW), v); }
  }
};
struct EpNatIn {
  static constexpr bool VIA_LDS = false;
  bf16_t *Q, *K, *VT, *G;
  DEVI void operator()(int row, int col, f32x4 v) const {
    const int grp = col >> 10, c = col & 1023;
    if (grp == 0) st_bf16x4(Q + (size_t)row * 1024 + c, v);
    else if (grp == 1) st_bf16x4(K + (size_t)row * 1024 + c, v);
    else if (grp == 3) { v[0] = siluf_(v[0]); v[1] = siluf_(v[1]); v[2] = siluf_(v[2]); v[3] = siluf_(v[3]); st_bf16x4(G + (size_t)row * 1024 + c, v); }
    else {
      unsigned idx, T;
      if (row < ML) { const unsigned b = row >> 12, t = row & 4095; T = 4096u; idx = ((b * 1024u + (unsigned)c) << 12) + t; }
      else { const unsigned r2 = row - ML; const unsigned b = r2 >> 8, t = r2 & 255; T = 256u; idx = (unsigned)ML * 1024u + ((b * 1024u + (unsigned)c) << 8) + t; }
#pragma unroll
      for (int i = 0; i < 4; ++i) VT[idx + (unsigned)i * T] = f2bf(v[i]);
    }
  }
};

constexpr int SSTR = 356;
DEVI int rwkv_row(int b, int d, int s) {
  if (s < 256) return ML + b * 256 + (d ? 255 - s : s);
  const int t = s - 256;
  return b * 4096 + (d ? 4095 - t : t);
}

constexpr int SREC_BF = 260;
struct ScanRec { f32x4 w[4], k[4], d[4]; u32x4 a1, a2; float vv; f32x2 cc; };
DEVI void scan_load(ScanRec& R, const float* rec, int kq, int role_off, int srow) {
#pragma unroll
  for (int hf = 0; hf < 2; ++hf) {
    R.w[hf * 2] = *(const f32x4*)(rec + hf * 32 + 8 * kq);        R.w[hf * 2 + 1] = *(const f32x4*)(rec + hf * 32 + 8 * kq + 4);
    R.k[hf * 2] = *(const f32x4*)(rec + 64 + hf * 32 + 8 * kq);   R.k[hf * 2 + 1] = *(const f32x4*)(rec + 64 + hf * 32 + 8 * kq + 4);
    R.d[hf * 2] = *(const f32x4*)(rec + 128 + hf * 32 + 8 * kq);  R.d[hf * 2 + 1] = *(const f32x4*)(rec + 128 + hf * 32 + 8 * kq + 4);
  }
  const char* ab = (const char*)(rec + SREC_BF) + role_off + kq * 16;
  R.a1 = *(const u32x4*)ab; R.a2 = *(const u32x4*)(ab + 64);
  R.vv = rec[192 + srow];
  R.cc = *(const f32x2*)(rec + 256);
}
DEVI f32x2 lo2(f32x4 v) { return (f32x2){v[0], v[1]}; }
DEVI f32x2 hi2(f32x4 v) { return (f32x2){v[2], v[3]}; }
DEVI void scan_step(f32x2 (&S)[8], const ScanRec& R, float* yout, bool wr) {
  const u32x4 b1 = mk4(pk_bf16(S[0][0], S[0][1]), pk_bf16(S[1][0], S[1][1]), pk_bf16(S[2][0], S[2][1]), pk_bf16(S[3][0], S[3][1]));
  const u32x4 b2 = mk4(pk_bf16(S[4][0], S[4][1]), pk_bf16(S[5][0], S[5][1]), pk_bf16(S[6][0], S[6][1]), pk_bf16(S[7][0], S[7][1]));
  f32x4 D = {0.f, 0.f, 0.f, 0.f};
  D = mfma16(R.a1, b1, D);
  D = mfma16(R.a2, b2, D);
  const float sa = D[0], y0 = D[1], v = R.vv;
  const f32x2 sa2 = {sa, sa}, v2 = {v, v};
#pragma unroll
  for (int q = 0; q < 4; ++q) {
    S[2 * q] = S[2 * q] * lo2(R.w[q]) + (sa2 * lo2(R.k[q]) + v2 * lo2(R.d[q]));
    S[2 * q + 1] = S[2 * q + 1] * hi2(R.w[q]) + (sa2 * hi2(R.k[q]) + v2 * hi2(R.d[q]));
  }
  if (wr) *yout = y0 + sa * R.cc[0] + v * R.cc[1];
}
DEVI float sum16(float v) { v = sum8(v); v += dpp_f<0x140>(v); return v; }

__device__ __forceinline__ void rwkv_scan_phase(char* lds, const bf16_t* __restrict__ R, const bf16_t* __restrict__ Kb, const bf16_t* __restrict__ V,
                                const bf16_t* __restrict__ WD, const bf16_t* __restrict__ AD, const bf16_t* __restrict__ Wup,
                                const float* __restrict__ b0, const float* __restrict__ k_ka, const float* __restrict__ r_k,
                                bf16_t* __restrict__ Y0, bf16_t* __restrict__ Y1, float* __restrict__ BON) {
  float* stepbuf = (float*)lds;
  float* wbuf = stepbuf + 2 * 16 * SSTR;
  float* abuf = wbuf + 1024;
  float* ybuf = abuf + 1024;
  const int tid = opaque_tid(), lane = tid & 63, wv = tid >> 6;
  constexpr int NCH = (256 + 4096) / 16;
  for (int chain = blockIdx.x; chain < 256; chain += gridDim.x) {
    const int d = chain & 1, h = (chain >> 1) & 15, b = chain >> 5;
    __syncthreads();
    if (wv < 4) {
      const int kq = lane >> 4, srow = wv * 16 + (lane & 15);
      const int role = lane & 3, role_off = (role < 2 ? role : 2) * 128;
      const bool wr = kq == 0;
      f32x2 S[8];
#pragma unroll
      for (int j = 0; j < 8; ++j) S[j] = (f32x2){0.f, 0.f};
      __syncthreads();
      __syncthreads();
      for (int c = 0; c < NCH; ++c) {
        const float* sb = stepbuf + (c & 1) * 16 * SSTR;
        float* yb = ybuf + (c & 1) * 1024 + srow;
        ScanRec ra, rb;
        scan_load(ra, sb, kq, role_off, srow);
#pragma unroll
        for (int i = 0; i < 8; i += 2) {
          scan_load(rb, sb + (i + 1) * SSTR, kq, role_off, srow);
          scan_step(S, ra, yb + i * 64, wr);
          scan_load(ra, sb + (i + 2) * SSTR, kq, role_off, srow);
          scan_step(S, rb, yb + (i + 1) * 64, wr);
        }
        __syncthreads();
#pragma unroll
        for (int i = 8; i < 16; i += 2) {
          scan_load(rb, sb + (i + 1) * SSTR, kq, role_off, srow);
          scan_step(S, ra, yb + i * 64, wr);
          if (i + 2 < 16) scan_load(ra, sb + (i + 2) * SSTR, kq, role_off, srow);
          scan_step(S, rb, yb + (i + 1) * 64, wr);
        }
        __syncthreads();
      }
    } else {
      const int ptid = tid - 256, pw = wv - 4;
      bf16_t* Y = d ? Y1 : Y0;
      const int ncol = h * 64 + pw * 16 + (lane & 15);
      u32x4 bu[2][2];
      float bias_u[2];
#pragma unroll
      for (int kind = 0; kind < 2; ++kind) {
        const bf16_t* wu = Wup + ((size_t)(d * 2 + kind) * 1024 + ncol) * 64 + 8 * (lane >> 4);
        bu[kind][0] = *(const u32x4*)wu; bu[kind][1] = *(const u32x4*)(wu + 32);
        bias_u[kind] = b0[(d * 2 + kind) * 1024 + ncol];
      }
      const int ti = ptid >> 4, dq = ptid & 15;
      const int hc = h * 64 + 4 * dq;
      const f32x4 kkv = *(const f32x4*)(k_ka + hc), kav = *(const f32x4*)(k_ka + 1024 + hc), rkv = *(const f32x4*)(r_k + hc);
      u32x4 xw0, xw1, xa0, xa1; u32x2 rr, kr, vr;
      auto issue = [&](int c) {
        const int rowA = rwkv_row(b, d, c * 16 + (lane & 15));
        const bf16_t* xp = WD + (size_t)rowA * 128 + d * 64 + 8 * (lane >> 4);
        const bf16_t* xq = AD + (size_t)rowA * 128 + d * 64 + 8 * (lane >> 4);
        xw0 = *(const u32x4*)xp; xw1 = *(const u32x4*)(xp + 32);
        xa0 = *(const u32x4*)xq; xa1 = *(const u32x4*)(xq + 32);
        const int rowB = rwkv_row(b, d, c * 16 + ti);
        rr = *(const u32x2*)(R + (size_t)rowB * 1024 + hc);
        kr = *(const u32x2*)(Kb + (size_t)rowB * 1024 + hc);
        vr = *(const u32x2*)(V + (size_t)rowB * 1024 + hc);
      };
      auto stepA = [&]() {
        f32x4 accw = {0.f, 0.f, 0.f, 0.f}, acca = {0.f, 0.f, 0.f, 0.f};
        accw = mfma16(xw0, bu[0][0], accw); accw = mfma16(xw1, bu[0][1], accw);
        acca = mfma16(xa0, bu[1][0], acca); acca = mfma16(xa1, bu[1][1], acca);
#pragma unroll
        for (int r = 0; r < 4; ++r) {
          const int o = ((lane >> 4) * 4 + r) * 64 + pw * 16 + (lane & 15);
          const float wl = -softplusf_(-(accw[r] + bias_u[0])) - 0.5f;
          wbuf[o] = __expf(-__expf(wl));
          abuf[o] = sigmoidf_(acca[r] + bias_u[1]);
        }
      };
      auto stepB = [&](int c, float* sb) {
        const float rv[4] = {bf_lo(rr.x), bf_hi(rr.x), bf_lo(rr.y), bf_hi(rr.y)};
        const float kv[4] = {bf_lo(kr.x), bf_hi(kr.x), bf_lo(kr.y), bf_hi(kr.y)};
        const float vv[4] = {bf_lo(vr.x), bf_hi(vr.x), bf_lo(vr.y), bf_hi(vr.y)};
        const f32x4 av = *(const f32x4*)(abuf + ti * 64 + 4 * dq), wv4 = *(const f32x4*)(wbuf + ti * 64 + 4 * dq);
        float q[4], ss = 0.f;
#pragma unroll
        for (int i = 0; i < 4; ++i) { q[i] = kv[i] * kkv[i]; ss += q[i] * q[i]; }
        ss = sum16(ss);
        const float inv = __builtin_amdgcn_rsqf(fmaxf(ss, 1e-24f));
        f32x4 nk, wrr, ka, kd, vo;
        float c1 = 0.f, c2 = 0.f, bn = 0.f;
#pragma unroll
        for (int i = 0; i < 4; ++i) {
          const float n = q[i] * inv;
          kd[i] = kv[i] * (1.f + (av[i] - 1.f) * kav[i]);
          ka[i] = n * av[i];
          nk[i] = -n; wrr[i] = wv4[i] * rv[i]; vo[i] = vv[i];
          c1 += ka[i] * rv[i]; c2 += kd[i] * rv[i]; bn += rv[i] * kd[i] * rkv[i];
        }
        c1 = sum16(c1); c2 = sum16(c2); bn = sum16(bn);
        float* rec = sb + ti * SSTR;
        *(f32x4*)(rec + 4 * dq) = wv4;
        *(f32x4*)(rec + 64 + 4 * dq) = ka;
        *(f32x4*)(rec + 128 + 4 * dq) = kd;
        *(f32x4*)(rec + 192 + 4 * dq) = vo;
        {
          bf16_t* bb = (bf16_t*)(rec + SREC_BF);
          u32x2 t0; t0.x = pk_bf16(nk[0], nk[1]); t0.y = pk_bf16(nk[2], nk[3]);
          u32x2 t1; t1.x = pk_bf16(wrr[0], wrr[1]); t1.y = pk_bf16(wrr[2], wrr[3]);
          *(u32x2*)(bb + 4 * dq) = t0;
          *(u32x2*)(bb + 64 + 4 * dq) = t1;
          *(u32x2*)(bb + 128 + 4 * dq) = (u32x2){0u, 0u};
        }
        if (dq == 0) {
          *(f32x2*)(rec + 256) = (f32x2){c1, c2};
          BON[((size_t)d * MT + rwkv_row(b, d, c * 16 + ti)) * 16 + h] = bn;
        }
      };
      auto storeY = [&](int c) {
        const f32x4 yv = *(const f32x4*)(ybuf + (c & 1) * 1024 + ti * 64 + 4 * dq);
        u32x2 o; o.x = pk_bf16(yv[0], yv[1]); o.y = pk_bf16(yv[2], yv[3]);
        *(u32x2*)(Y + (size_t)rwkv_row(b, d, c * 16 + ti) * 1024 + hc) = o;
      };
      issue(0);
      stepA();
      __syncthreads();
      stepB(0, stepbuf);
      issue(1);
      __syncthreads();
      for (int c = 0; c < NCH; ++c) {
        const bool more = (c + 1) < NCH;
        if (more) stepA();
        if (c >= 1) storeY(c - 1);
        __syncthreads();
        if (more) {
          stepB(c + 1, stepbuf + ((c + 1) & 1) * 16 * SSTR);
          if (c + 2 < NCH) issue(c + 2);
        }
        __builtin_amdgcn_sched_barrier(0);
        __syncthreads();
        __builtin_amdgcn_sched_barrier(0);
      }
      storeY(NCH - 1);
    }
  }
}

__device__ __forceinline__ void rwkv_post_phase(const bf16_t* __restrict__ Y0, const bf16_t* __restrict__ Y1, const bf16_t* __restrict__ V,
                                bf16_t* __restrict__ G, const float* __restrict__ BON, const float* __restrict__ gn, int nrows) {
  const int tidx = opaque_tid();
  const int lane = tidx & 63;
  const int gw = blockIdx.x * (NTHR / 64) + (tidx >> 6), nw = gridDim.x * (NTHR / 64);
  const int head = lane >> 2, c0 = lane * 16;
  for (int row = gw; row < nrows; row += nw) {
    const size_t off = (size_t)row * 1024 + c0;
    float y[16], v[16], g[16];
#pragma unroll
    for (int i = 0; i < 2; ++i) {
      const u32x4 a0 = *(const u32x4*)(Y0 + off + 8 * i), a1 = *(const u32x4*)(Y1 + off + 8 * i);
      const u32x4 av = *(const u32x4*)(V + off + 8 * i), ag = *(const u32x4*)(G + off + 8 * i);
      y[8 * i + 0] = bf_lo(a0.x) + bf_lo(a1.x); y[8 * i + 1] = bf_hi(a0.x) + bf_hi(a1.x);
      y[8 * i + 2] = bf_lo(a0.y) + bf_lo(a1.y); y[8 * i + 3] = bf_hi(a0.y) + bf_hi(a1.y);
      y[8 * i + 4] = bf_lo(a0.z) + bf_lo(a1.z); y[8 * i + 5] = bf_hi(a0.z) + bf_hi(a1.z);
      y[8 * i + 6] = bf_lo(a0.w) + bf_lo(a1.w); y[8 * i + 7] = bf_hi(a0.w) + bf_hi(a1.w);
      v[8 * i + 0] = bf_lo(av.x); v[8 * i + 1] = bf_hi(av.x); v[8 * i + 2] = bf_lo(av.y); v[8 * i + 3] = bf_hi(av.y);
      v[8 * i + 4] = bf_lo(av.z); v[8 * i + 5] = bf_hi(av.z); v[8 * i + 6] = bf_lo(av.w); v[8 * i + 7] = bf_hi(av.w);
      g[8 * i + 0] = bf_lo(ag.x); g[8 * i + 1] = bf_hi(ag.x); g[8 * i + 2] = bf_lo(ag.y); g[8 * i + 3] = bf_hi(ag.y);
      g[8 * i + 4] = bf_lo(ag.z); g[8 * i + 5] = bf_hi(ag.z); g[8 * i + 6] = bf_lo(ag.w); g[8 * i + 7] = bf_hi(ag.w);
    }
    float s = 0.f;
#pragma unroll
    for (int i = 0; i < 16; ++i) s += y[i];
    s += __shfl_xor(s, 1); s += __shfl_xor(s, 2);
    const float mean = s * (1.f / 64.f);
    float q = 0.f;
#pragma unroll
    for (int i = 0; i < 16; ++i) { const float dlt = y[i] - mean; q += dlt * dlt; }
    q += __shfl_xor(q, 1); q += __shfl_xor(q, 2);
    const float rstd = rsqrtf(q * (1.f / 64.f) + 64e-5f);
    const float bonus = BON[(size_t)row * 16 + head] + BON[((size_t)MT + row) * 16 + head];
    unsigned o[8];
#pragma unroll
    for (int i = 0; i < 8; ++i) {
      const float z0 = ((y[2 * i] - mean) * rstd * gn[c0 + 2 * i] + gn[1024 + c0 + 2 * i] + bonus * v[2 * i]) * g[2 * i];
      const float z1 = ((y[2 * i + 1] - mean) * rstd * gn[c0 + 2 * i + 1] + gn[1024 + c0 + 2 * i + 1] + bonus * v[2 * i + 1]) * g[2 * i + 1];
      o[i] = pk_bf16(z0, z1);
    }
    *(u32x4*)(G + off) = mk4(o[0], o[1], o[2], o[3]);
    *(u32x4*)(G + off + 8) = mk4(o[4], o[5], o[6], o[7]);
  }
}

__device__ __forceinline__ void rglru_phase(char* lds, const bf16_t* __restrict__ XR, const bf16_t* __restrict__ Wg, const float* __restrict__ conv_w,
                            const float* __restrict__ conv_b, const float* __restrict__ gate_b, const float* __restrict__ lam,
                            bf16_t* __restrict__ HS0, bf16_t* __restrict__ HS1) {
  bf16_t* xcT = (bf16_t*)lds;
  f32x2* AB = (f32x2*)(lds + 26624);
  bf16_t* raw = (bf16_t*)(lds + 26624);
  float* segP = (float*)(lds + 116736);
  float* segH = segP + 352;
  float* segC = segH + 352;
  bf16_t* wgs = (bf16_t*)(lds + 120960);
  float* cws = (float*)(lds + 160896);
  const int tid = opaque_tid(), lane = tid & 63, wv = tid >> 6;
  for (int chain = blockIdx.x; chain < 256; chain += gridDim.x) {
    const int d = chain & 1, blk = (chain >> 1) & 15, b = chain >> 5;
    bf16_t* HS = d ? HS1 : HS0;
    float carry = 0.f;
    __syncthreads();
    for (int q = tid; q < 2 * 96 * 12; q += NTHR) {
      const int g = q / 1152, rem = q - g * 1152, n = rem / 12, k8 = rem - n * 12;
      *(u32x4*)(wgs + (g * 96 + n) * 104 + k8 * 8) = *(const u32x4*)(Wg + ((size_t)((blk * 4 + d * 2 + g) * 96 + n)) * 96 + k8 * 8);
    }
    for (int e = tid; e < 5 * 88; e += NTHR) {
      const int j = e / 88, c = e - j * 88;
      cws[e] = j < 4 ? conv_w[j * LW + blk * 88 + c] : conv_b[blk * 88 + c];
    }
    for (int e = tid; e < 128 * 8; e += NTHR) xcT[(e >> 3) * 104 + 88 + (e & 7)] = 0;
    u32x4 pre[3];
    auto tile_geom = [&](int ti, int& seqbase, int& t0, int& T) {
      if (ti < 2) { seqbase = ML + b * 256; T = 256; t0 = (d ? 1 - ti : ti) * 128; }
      else { seqbase = b * 4096; T = 4096; t0 = (d ? 31 - (ti - 2) : (ti - 2)) * 128; }
    };
    auto prefetch = [&](int ti) {
      int seqbase, t0, T; tile_geom(ti, seqbase, t0, T);
#pragma unroll
      for (int i = 0; i < 3; ++i) {
        const int q = tid + NTHR * i;
        const int row = q / 11, cc = q - row * 11, t = t0 - 2 + row;
        u32x4 v = {0u, 0u, 0u, 0u};
        if (q < 131 * 11 && t >= 0 && t < T) v = *(const u32x4*)(XR + (size_t)(seqbase + t) * LW + blk * 88 + cc * 8);
        pre[i] = v;
      }
    };
    prefetch(0);
    for (int ti = 0; ti < 34; ++ti) {
      int seqbase, t0, T; tile_geom(ti, seqbase, t0, T);
      __syncthreads();
#pragma unroll
      for (int i = 0; i < 3; ++i) {
        const int q = tid + NTHR * i;
        if (q < 131 * 11) *(u32x4*)(raw + q * 8) = pre[i];
      }
      if (ti + 1 < 34) prefetch(ti + 1);
      __builtin_amdgcn_sched_barrier(0);
      __syncthreads();
      for (int e = tid; e < 128 * 44; e += NTHR) {
        const int tl = e / 44, c2 = (e - tl * 44) * 2;
        float a0 = cws[4 * 88 + c2], a1 = cws[4 * 88 + c2 + 1];
#pragma unroll
        for (int j = 0; j < 4; ++j) {
          const unsigned x = *(const unsigned*)(raw + (tl + j) * 88 + c2);
          a0 += bf_lo(x) * cws[j * 88 + c2]; a1 += bf_hi(x) * cws[j * 88 + c2 + 1];
        }
        *(unsigned*)(xcT + tl * 104 + c2) = pk_bf16(a0, a1);
      }
      __syncthreads();
      {
        const int tok = wv * 16 + (lane & 15);
        u32x4 af[3];
#pragma unroll
        for (int kk = 0; kk < 3; ++kk) af[kk] = *(const u32x4*)(xcT + tok * 104 + kk * 32 + 8 * (lane >> 4));
#pragma unroll
        for (int n6 = 0; n6 < 6; ++n6) {
          f32x4 accr = {0.f, 0.f, 0.f, 0.f}, acci = {0.f, 0.f, 0.f, 0.f};
          const int ncol = n6 * 16 + (lane & 15);
          const bf16_t* wr_ = wgs + ncol * 104 + 8 * (lane >> 4);
          const bf16_t* wi_ = wgs + (96 + ncol) * 104 + 8 * (lane >> 4);
#pragma unroll
          for (int kk = 0; kk < 3; ++kk) {
            accr = mfma16(af[kk], *(const u32x4*)(wr_ + kk * 32), accr);
            acci = mfma16(af[kk], *(const u32x4*)(wi_ + kk * 32), acci);
          }
          if (ncol < 88) {
            const int ch = blk * 88 + ncol;
            const float gbr = gate_b[(d * 2 + 0) * LW + ch], gbi = gate_b[(d * 2 + 1) * LW + ch];
            const float spl = softplusf_(-lam[d * LW + ch]);
#pragma unroll
            for (int r = 0; r < 4; ++r) {
              const int tk = wv * 16 + (lane >> 4) * 4 + r;
              const float rg = sigmoidf_(accr[r] + gbr), ig = sigmoidf_(acci[r] + gbi);
              const float a = __expf(-8.f * rg * spl);
              const float bb = sqrtf(fmaxf(1.f - a * a, 0.f)) * ig * bf2f(xcT[tk * 104 + ncol]);
              AB[tk * 88 + ncol] = (f32x2){a, bb};
            }
          }
        }
      }
      __syncthreads();
      if (tid < 352) {
        const int seg = tid / 88, c = tid - seg * 88;
        float hl = 0.f, P = 1.f;
        for (int u0 = seg * 32; u0 < seg * 32 + 32; u0 += 8) {
          f32x2 ab[8];
#pragma unroll
          for (int i = 0; i < 8; ++i) { const int tl = d ? 127 - (u0 + i) : (u0 + i); ab[i] = AB[tl * 88 + c]; }
#pragma unroll
          for (int i = 0; i < 8; ++i) { hl = ab[i][0] * hl + ab[i][1]; P *= ab[i][0]; ab[i] = (f32x2){hl, P}; }
#pragma unroll
          for (int i = 0; i < 8; ++i) { const int tl = d ? 127 - (u0 + i) : (u0 + i); AB[tl * 88 + c] = ab[i]; }
        }
        segH[seg * 88 + c] = hl; segP[seg * 88 + c] = P;
      }
      __syncthreads();
      if (tid < 88) {
        float cur = carry;
#pragma unroll
        for (int seg = 0; seg < 4; ++seg) { segC[seg * 88 + tid] = cur; cur = segP[seg * 88 + tid] * cur + segH[seg * 88 + tid]; }
        carry = cur;
      }
      __syncthreads();
      for (int q = tid; q < 128 * 11; q += NTHR) {
        const int tl = q / 11, c8 = (q - tl * 11) * 8;
        const int u = d ? 127 - tl : tl;
        const float* sc = segC + (u >> 5) * 88 + c8;
        float hv[8];
#pragma unroll
        for (int i = 0; i < 8; ++i) { const f32x2 hp = AB[tl * 88 + c8 + i]; hv[i] = hp[0] + hp[1] * sc[i]; }
        *(u32x4*)(HS + (size_t)(seqbase + t0 + tl) * LW + blk * 88 + c8) =
            mk4(pk_bf16(hv[0], hv[1]), pk_bf16(hv[2], hv[3]), pk_bf16(hv[4], hv[5]), pk_bf16(hv[6], hv[7]));
      }
    }
  }
}

__device__ __forceinline__ void lru_z_phase(const bf16_t* __restrict__ HS0, const bf16_t* __restrict__ HS1, bf16_t* __restrict__ GG) {
  const size_t n8 = (size_t)MT * LW / 8;
  for (size_t e = (size_t)blockIdx.x * NTHR + threadIdx.x; e < n8; e += (size_t)gridDim.x * NTHR) {
    const u32x4 a = *(const u32x4*)(HS0 + e * 8), b = *(const u32x4*)(HS1 + e * 8), g = *(const u32x4*)(GG + e * 8);
    u32x4 o;
    o.x = pk_bf16((bf_lo(a.x) + bf_lo(b.x)) * bf_lo(g.x), (bf_hi(a.x) + bf_hi(b.x)) * bf_hi(g.x));
    o.y = pk_bf16((bf_lo(a.y) + bf_lo(b.y)) * bf_lo(g.y), (bf_hi(a.y) + bf_hi(b.y)) * bf_hi(g.y));
    o.z = pk_bf16((bf_lo(a.z) + bf_lo(b.z)) * bf_lo(g.z), (bf_hi(a.z) + bf_hi(b.z)) * bf_hi(g.z));
    o.w = pk_bf16((bf_lo(a.w) + bf_lo(b.w)) * bf_lo(g.w), (bf_hi(a.w) + bf_hi(b.w)) * bf_hi(g.w));
    *(u32x4*)(GG + e * 8) = o;
  }
}

__device__ __forceinline__ void nat_qk_phase(bf16_t* __restrict__ Q, bf16_t* __restrict__ Kb, bf16_t* __restrict__ QR, const float* __restrict__ qk_g) {
  const int tidx = opaque_tid();
  const int lane = tidx & 63;
  const int gw = blockIdx.x * (NTHR / 64) + (tidx >> 6), nw = gridDim.x * (NTHR / 64);
  const int qd = lane & 3;
  float gq[16], gk[16], inv[16];
#pragma unroll
  for (int i = 0; i < 16; ++i) { gq[i] = qk_g[qd * 16 + i]; gk[i] = qk_g[64 + qd * 16 + i]; inv[i] = exp2f(-(float)i * (13.287712379549449f / 16.f)); }
  for (int row = gw; row < MT; row += nw) {
    const bool lat = row < ML;
    const size_t off = (size_t)row * 1024 + lane * 16;
    float cs[16], sn[16];
    if (lat) {
      const int t = row & 4095;
      const float pos = (float)((qd >> 1) ? (t & 63) : (t >> 6));
#pragma unroll
      for (int i = 0; i < 16; ++i) {
        float rev = pos * inv[i] * 0.15915494309189535f;
        rev -= floorf(rev);
        sn[i] = __builtin_amdgcn_sinf(rev); cs[i] = __builtin_amdgcn_cosf(rev);
      }
    }
#pragma unroll
    for (int which = 0; which < 2; ++which) {
      bf16_t* P = which ? Kb : Q;
      const u32x4 a = *(const u32x4*)(P + off), b2 = *(const u32x4*)(P + off + 8);
      const unsigned u[8] = {a.x, a.y, a.z, a.w, b2.x, b2.y, b2.z, b2.w};
      float x[16];
#pragma unroll
      for (int i = 0; i < 8; ++i) { x[2 * i] = bf_lo(u[i]); x[2 * i + 1] = bf_hi(u[i]); }
      float ss = 0.f;
#pragma unroll
      for (int i = 0; i < 16; ++i) ss += x[i] * x[i];
      ss += __shfl_xor(ss, 1); ss += __shfl_xor(ss, 2);
      const float rstd = rsqrtf(ss * (1.f / 64.f) + 1e-6f);
#pragma unroll
      for (int i = 0; i < 16; ++i) x[i] = x[i] * rstd * (which ? gk[i] : gq[i]);
      unsigned pl[8];
#pragma unroll
      for (int i = 0; i < 8; ++i) pl[i] = pk_bf16(x[2 * i], x[2 * i + 1]);
      unsigned rt[8];
      if (lat) {
        float y[16];
#pragma unroll
        for (int i = 0; i < 16; ++i) {
          const float pr = __shfl_xor(x[i], 1);
          y[i] = x[i] * cs[i] + ((qd & 1) ? pr * sn[i] : -pr * sn[i]);
        }
#pragma unroll
        for (int i = 0; i < 8; ++i) rt[i] = pk_bf16(y[2 * i], y[2 * i + 1]);
      }
      if (which == 0) {
        *(u32x4*)(Q + off) = mk4(pl[0], pl[1], pl[2], pl[3]);
        *(u32x4*)(Q + off + 8) = mk4(pl[4], pl[5], pl[6], pl[7]);
        if (lat) { *(u32x4*)(QR + off) = mk4(rt[0], rt[1], rt[2], rt[3]); *(u32x4*)(QR + off + 8) = mk4(rt[4], rt[5], rt[6], rt[7]); }
      } else {
        if (lat) { *(u32x4*)(Kb + off) = mk4(rt[0], rt[1], rt[2], rt[3]); *(u32x4*)(Kb + off + 8) = mk4(rt[4], rt[5], rt[6], rt[7]); }
        else { *(u32x4*)(Kb + off) = mk4(pl[0], pl[1], pl[2], pl[3]); *(u32x4*)(Kb + off + 8) = mk4(pl[4], pl[5], pl[6], pl[7]); }
      }
    }
  }
}

struct AttnState { f32x16 O[2][2]; float m[2], l[2]; };

DEVI void attn_load_k(u32x4 (&kf)[4], const bf16_t* __restrict__ kbase, int lane) {
  const int l31 = lane & 31, lh = lane >> 5;
#pragma unroll
  for (int ks = 0; ks < 4; ++ks) kf[ks] = *(const u32x4*)(kbase + (size_t)l31 * 1024 + ks * 16 + 8 * lh);
}

DEVI void attn_compute(AttnState& st, const u32x4* qs, const bf16_t* __restrict__ kbase, const bf16_t* __restrict__ vtbase, int vtT,
                       const float* __restrict__ rpbs, bool band, int brow, int half, int lane) {
  const int l31 = lane & 31, lh = lane >> 5;
  u32x4 kf[4];
  attn_load_k(kf, kbase, lane);
  u32x4 vf[4];
#pragma unroll
  for (int dt = 0; dt < 2; ++dt)
#pragma unroll
    for (int s = 0; s < 2; ++s) {
      const bf16_t* vp = vtbase + (size_t)(dt * 32 + l31) * vtT + 16 * s + 4 * lh;
      const u32x2 lo = *(const u32x2*)vp, hi = *(const u32x2*)(vp + 8);
      vf[dt * 2 + s] = mk4(lo.x, lo.y, hi.x, hi.y);
    }
  __builtin_amdgcn_sched_barrier(0);
  constexpr float SC = 0.125f * 1.4426950408889634f;
  u32x4 pf[2][2];
#pragma unroll
  for (int qt = 0; qt < 2; ++qt) {
    f32x16 S;
#pragma unroll
    for (int r = 0; r < 16; ++r) S[r] = 0.f;
#pragma unroll
    for (int ks = 0; ks < 4; ++ks) S = mfma32(kf[ks], qs[(qt * 4 + ks) * 64], S);
    float cmax = -INFINITY;
    if (band) {
      const int qc = qt * 32 + l31;
      const int cst = min(max(qc - 8, 0), 48);
#pragma unroll
      for (int r = 0; r < 16; ++r) {
        const int key = (r & 3) + 8 * (r >> 2) + 4 * lh;
        const int kc = half * 32 + key;
        const bool ok = (kc >= cst) && (kc < cst + 16);
        const int bi = ok ? (brow * 31 + kc - qc + 15) : 0;
        const float sv = S[r] * SC + rpbs[bi];
        S[r] = ok ? sv : -INFINITY;
        cmax = fmaxf(cmax, S[r]);
      }
    } else {
#pragma unroll
      for (int r = 0; r < 16; ++r) { S[r] *= SC; cmax = fmaxf(cmax, S[r]); }
    }
    cmax = fmaxf(cmax, __shfl_xor(cmax, 32));
    const float mnew = fmaxf(st.m[qt], cmax);
    const float alpha = __builtin_amdgcn_exp2f(st.m[qt] - mnew);
    const bool grew = mnew > st.m[qt];
    st.m[qt] = mnew;
    float ps = 0.f;
#pragma unroll
    for (int r = 0; r < 16; ++r) { S[r] = __builtin_amdgcn_exp2f(S[r] - mnew); ps += S[r]; }
    st.l[qt] = st.l[qt] * alpha + ps;
    if (__any(grew)) {
#pragma unroll
      for (int dt = 0; dt < 2; ++dt)
#pragma unroll
        for (int r = 0; r < 16; ++r) st.O[qt][dt][r] *= alpha;
    }
    pf[qt][0] = mk4(pk_bf16(S[0], S[1]), pk_bf16(S[2], S[3]), pk_bf16(S[4], S[5]), pk_bf16(S[6], S[7]));
    pf[qt][1] = mk4(pk_bf16(S[8], S[9]), pk_bf16(S[10], S[11]), pk_bf16(S[12], S[13]), pk_bf16(S[14], S[15]));
  }
#pragma unroll
  for (int dt = 0; dt < 2; ++dt)
#pragma unroll
    for (int s = 0; s < 2; ++s) {
      st.O[0][dt] = mfma32(vf[dt * 2 + s], pf[0][s], st.O[0][dt]);
      st.O[1][dt] = mfma32(vf[dt * 2 + s], pf[1][s], st.O[1][dt]);
    }
}

__device__ __forceinline__ void natten_phase(char* lds, const bf16_t* __restrict__ Q, const bf16_t* __restrict__ QR, const bf16_t* __restrict__ Kb,
                             const bf16_t* __restrict__ VT, bf16_t* __restrict__ G, const float* __restrict__ rpb, bf16_t* __restrict__ Zd) {
  float* rpbs = (float*)lds;
  __syncthreads();
  for (int e = threadIdx.x; e < 16 * 465; e += NTHR) rpbs[e] = rpb[e] * 1.4426950408889634f;
  __syncthreads();
  const int tidx = opaque_tid();
  const int lane = tidx & 63, l31 = lane & 31, lh = lane >> 5;
  const int gw = blockIdx.x * (NTHR / 64) + (tidx >> 6), nw = gridDim.x * (NTHR / 64);
  const bf16_t* VTC = VT + (size_t)ML * 1024;
  u32x4* qs = (u32x4*)(lds + 32768) + (tidx >> 6) * 512 + lane;
  const int xcd = blockIdx.x & 7, wx = (blockIdx.x >> 3) * (NTHR / 64) + (tidx >> 6), nwx = (gridDim.x >> 3) * (NTHR / 64);
  for (int i = wx; i < 1024 + 64; i += nwx) {
    const bool lat = i < 1024;
    int b, h, r = 0, qrow0;
    if (lat) { const int pair = xcd * 16 + (i >> 6); r = i & 63; b = pair >> 4; h = pair & 15; qrow0 = b * 4096 + r * 64; }
    else { const int it = i - 1024; const int pair = xcd * 16 + (it >> 2); const int qt64 = it & 3; b = pair >> 4; h = pair & 15; qrow0 = ML + b * 256 + qt64 * 64; }
    const int start = min(max(r - 4, 0), 56);
    const int nchunks = lat ? 24 : 8;
    AttnState st;
#pragma unroll
    for (int a = 0; a < 2; ++a) { st.m[a] = -INFINITY; st.l[a] = 0.f;
#pragma unroll
      for (int c = 0; c < 2; ++c)
#pragma unroll
        for (int rr = 0; rr < 16; ++rr) st.O[a][c][rr] = 0.f; }
#pragma unroll
    for (int qt = 0; qt < 2; ++qt)
#pragma unroll
      for (int ks = 0; ks < 4; ++ks) qs[(qt * 4 + ks) * 64] = *(const u32x4*)(Q + (size_t)(qrow0 + qt * 32 + l31) * 1024 + h * 64 + ks * 16 + 8 * lh);
    for (int j = 0; j < nchunks; ++j) {
      if (j == 8) {
#pragma unroll
        for (int qt = 0; qt < 2; ++qt)
#pragma unroll
          for (int ks = 0; ks < 4; ++ks) qs[(qt * 4 + ks) * 64] = *(const u32x4*)(QR + (size_t)(qrow0 + qt * 32 + l31) * 1024 + h * 64 + ks * 16 + 8 * lh);
      }
      if (j < 8) {
        const bf16_t* kbase = Kb + (size_t)(ML + b * 256 + j * 32) * 1024 + h * 64;
        const bf16_t* vtb = VTC + (size_t)(b * 16 + h) * 64 * 256 + j * 32;
        attn_compute(st, qs, kbase, vtb, 256, rpbs, false, 0, 0, lane);
      } else {
        const int ii = j - 8, kr = start + (ii >> 1), half = ii & 1;
        const bf16_t* kbase = Kb + (size_t)(b * 4096 + kr * 64 + half * 32) * 1024 + h * 64;
        const bf16_t* vtb = VT + (size_t)(b * 16 + h) * 64 * 4096 + kr * 64 + half * 32;
        attn_compute(st, qs, kbase, vtb, 4096, rpbs, true, h * 15 + (kr - r + 7), half, lane);
      }
    }
#pragma unroll
    for (int qt = 0; qt < 2; ++qt) {
      const float lt = st.l[qt] + __shfl_xor(st.l[qt], 32);
      const float inv = 1.f / lt;
      bf16_t* grow = G + (size_t)(qrow0 + qt * 32 + l31) * 1024 + h * 64;
#pragma unroll
      for (int dt = 0; dt < 2; ++dt)
#pragma unroll
        for (int q4 = 0; q4 < 4; ++q4) {
          bf16_t* gp = grow + dt * 32 + 8 * q4 + 4 * lh;
          bf16_t* zp = Zd + (gp - G);
          const u32x2 gv = *(const u32x2*)gp;
          u32x2 o;
          o.x = pk_bf16(st.O[qt][dt][4 * q4] * inv * bf_lo(gv.x), st.O[qt][dt][4 * q4 + 1] * inv * bf_hi(gv.x));
          o.y = pk_bf16(st.O[qt][dt][4 * q4 + 2] * inv * bf_lo(gv.y), st.O[qt][dt][4 * q4 + 3] * inv * bf_hi(gv.y));
          *(u32x2*)zp = o;
        }
    }
  }
}

template <int ph>
__device__ __forceinline__ void run_phase(const Params& p, char* lds, bool last_rep) {
  char* ws = p.ws;
  const float* MOD = (const float*)(ws + OFF_MOD);
  float* XC = (float*)(ws + OFF_XC);
  bf16_t* HB = (bf16_t*)(ws + OFF_HB);
  bf16_t* A0 = (bf16_t*)(ws + OFF_A0); bf16_t* A1 = (bf16_t*)(ws + OFF_A1); bf16_t* A2 = (bf16_t*)(ws + OFF_A2);
  bf16_t* A3 = (bf16_t*)(ws + OFF_A3); bf16_t* A4 = (bf16_t*)(ws + OFF_A4);
  bf16_t* WD = (bf16_t*)(ws + OFF_WD); bf16_t* AD = (bf16_t*)(ws + OFF_AD);
  float* BON = (float*)(ws + OFF_BON);
  if (ph == 0) { phase0(p, lds); return; }
  constexpr int layer = (ph - 1) / 5, sub = (ph - 1) % 5;
  const float* modL = MOD + (size_t)layer * 9 * 3072;
  const float* xl_cur = layer == 0 ? p.in[0] : p.out;
  const float* xc_cur = layer == 0 ? p.in[2] : XC;
  if (layer == 0 || layer == 3) {
    const int ib = layer ? 33 : 4;
    const bf16_t* WIN = (const bf16_t*)(ws + (layer ? OFF_W3IN : OFF_W0IN));
    const bf16_t* WUP = (const bf16_t*)(ws + (layer ? OFF_W3UP : OFF_W0UP));
    const bf16_t* WOUT = (const bf16_t*)(ws + (layer ? OFF_W3OUT : OFF_W0OUT));
    if (sub == 0) norm_phase<true>(xl_cur, xc_cur, p.in[ib], modL, HB, A4);
    else if (sub == 1) { ALMix al{HB, A4, p.in[ib + 4]}; EpRwkvIn ep{A0, A1, A2, A3, WD, AD}; gemm256_phase(lds, WIN, 1024, MT / 256, 16, al, ep); gemm_phase(lds, WIN, 1024, MT / 256, 2, al, ep, 4096, true); }
    else if (sub == 2) rwkv_scan_phase(lds, A0, A1, A2, WD, AD, WUP, p.in[ib + 5], p.in[ib + 8], p.in[ib + 9], HB, A4, BON);
    else if (sub == 3) rwkv_post_phase(HB, A4, A2, A3, BON, p.in[ib + 10], layer == 3 ? ML : MT);
    else { ALPlain al{A3, 1024}; EpRes ep{xl_cur, xc_cur, p.out, XC, modL}; gemm256_phase(lds, WOUT, 1024, ML / 256, 4, al, ep); if (layer != 3) gemm_phase(lds, WOUT, 1024, MC / 256, 8, al, ep, 0, false, ML / 256); }
  } else if (layer == 1) {
    bf16_t* HS0 = (bf16_t*)(ws + OFF_HS0); bf16_t* XR = (bf16_t*)(ws + OFF_XR); bf16_t* GG = (bf16_t*)(ws + OFF_GG); bf16_t* HS1 = (bf16_t*)(ws + OFF_HS1);
    if (sub == 0) norm_phase<false>(xl_cur, xc_cur, p.in[16], modL, HB, nullptr);
    else if (sub == 1) { ALPlain al{HB, 1024}; EpLruIn ep{XR, GG}; gemm256_phase(lds, (const bf16_t*)(ws + OFF_W1IN), 1024, MT / 256, 11, al, ep); }
    else if (sub == 2) rglru_phase(lds, XR, (const bf16_t*)(ws + OFF_W1G), p.in[20], p.in[21], p.in[23], p.in[24], HS0, HS1);
    else if (sub == 3) lru_z_phase(HS0, HS1, GG);
    else { ALPlain al{GG, LW}; EpRes ep{xl_cur, xc_cur, p.out, XC, modL}; gemm256_phase(lds, (const bf16_t*)(ws + OFF_W1OUT), LW, ML / 256, 4, al, ep); gemm_phase(lds, (const bf16_t*)(ws + OFF_W1OUT), LW, MC / 256, 8, al, ep, 0, false, ML / 256); }
  } else {
    if (sub == 0) norm_phase<false>(xl_cur, xc_cur, p.in[26], modL, HB, nullptr);
    else if (sub == 1) { ALPlain al{HB, 1024}; EpNatIn ep{A0, A1, A2, A3}; gemm256_phase(lds, (const bf16_t*)(ws + OFF_W2IN), 1024, MT / 256, 16, al, ep); }
    else if (sub == 2) nat_qk_phase(A0, A1, A4, p.in[30]);
    else if (sub == 3) natten_phase(lds, A0, A4, A1, A2, A3, p.in[31], last_rep ? A3 : HB);
    else { ALPlain al{A3, 1024}; EpRes ep{xl_cur, xc_cur, p.out, XC, modL}; gemm256_phase(lds, (const bf16_t*)(ws + OFF_W2OUT), 1024, ML / 256, 4, al, ep); gemm_phase(lds, (const bf16_t*)(ws + OFF_W2OUT), 1024, MC / 256, 8, al, ep, 0, false, ML / 256); }
  }
}

__global__ void __launch_bounds__(NTHR) mega_kernel(Params p) {
  __shared__ __attribute__((aligned(16))) char lds[LDS_BYTES];
  __shared__ u32x4 xb_words;
  cg::grid_group grid = cg::this_grid();
  if (threadIdx.x == 0) xb_words = (u32x4){0u, 0u, 0u, 0u};
  __syncthreads();
  const XcdBarrier xb = xcd_barrier_post((unsigned*)(p.ws + OFF_BAR), (volatile LAS unsigned*)&xb_words);
#define PHASE(k) if (p.ph_lo <= k && k < p.ph_hi) { for (int rep = 0; rep < REP[k]; ++rep) { run_phase<k>(p, lds, rep + 1 == REP[k]); if (rep + 1 < REP[k] || k + 1 < p.ph_hi) { if (k == 0) grid.sync(); else xcd_barrier(xb); } } }
  PHASE(0) PHASE(1) PHASE(2) PHASE(3) PHASE(4) PHASE(5) PHASE(6) PHASE(7) PHASE(8) PHASE(9) PHASE(10)
  PHASE(11) PHASE(12) PHASE(13) PHASE(14) PHASE(15) PHASE(16) PHASE(17) PHASE(18) PHASE(19) PHASE(20)
#undef PHASE
}

extern "C" void kernel_launch(void* const* d_in, const int* in_sizes, int n_in, void* d_out, int out_size, void* d_ws, size_t ws_size,
                              hipStream_t stream) {
  static int grid_blocks = 0;
  if (!grid_blocks) {
    int dev = 0, cus = 0, per_cu = 0;
    hipGetDevice(&dev);
    hipDeviceGetAttribute(&cus, hipDeviceAttributeMultiprocessorCount, dev);
    hipOccupancyMaxActiveBlocksPerMultiprocessor(&per_cu, mega_kernel, NTHR, 0);
    if (per_cu < 1) { fprintf(stderr, "occupancy query returned %d\n", per_cu); per_cu = 1; }
    if (per_cu > 1) per_cu = 1;
    grid_blocks = cus * per_cu;
    if (n_in != 45 || ws_size < WS_END) fprintf(stderr, "unexpected n_in %d / ws %zu (need %zu)\n", n_in, ws_size, (size_t)WS_END);
  }
  Params p{};
  for (int i = 0; i < 45; ++i) p.in[i] = (const float*)d_in[i];
  p.out = (float*)d_out;
  p.ws = (char*)d_ws;
  (void)hipMemsetAsync((char*)d_ws + OFF_BAR, 0, XCD_BAR_WORDS * 4, stream);
#if N_LAUNCH_MODE == 1
  p.ph_lo = 0; p.ph_hi = NPHASE;
  void* args[] = {&p};
  hipError_t e = hipLaunchCooperativeKernel((void*)mega_kernel, dim3(grid_blocks), dim3(NTHR), args, 0, stream);
  if (e != hipSuccess) fprintf(stderr, "cooperative launch failed: %s (grid %d)\n", hipGetErrorString(e), grid_blocks);
#else
  for (int ph = 0; ph < NPHASE; ++ph) {
    p.ph_lo = ph; p.ph_hi = ph + 1;
    hipLaunchKernelGGL(mega_kernel, dim3(grid_blocks), dim3(NTHR), 0, stream, p);
  }
#endif
}
```

```cpp
#include <hip/hip_runtime.h>
#include <hip/hip_cooperative_groups.h>
#include <cstdio>
#include <cstdint>
namespace cg = cooperative_groups;

#ifndef N_LAUNCH_MODE
#define N_LAUNCH_MODE 1
#endif

typedef unsigned short bf16_t;
typedef short bf16x8 __attribute__((ext_vector_type(8)));
typedef float f32x4 __attribute__((ext_vector_type(4)));
typedef float f32x16 __attribute__((ext_vector_type(16)));
typedef float f32x2 __attribute__((ext_vector_type(2)));
typedef unsigned u32x4 __attribute__((ext_vector_type(4)));
typedef unsigned u32x2 __attribute__((ext_vector_type(2)));

#define DEVI __device__ __forceinline__

constexpr int D = 1024, NB = 8, SEQ = 4096, CTX = 256;
constexpr int ML = NB * SEQ;
constexpr int MC = NB * CTX;
constexpr int MT = ML + MC;
constexpr int LW = 1408;
constexpr int NTHR = 512;
constexpr int NPHASE = 21;
constexpr int LDS_BYTES = 163840 - 16;
__device__ constexpr int REP[21] = {1,1,1,1,1,1,1,1,1,1,1,1,1,1,1,1,1,1,1,1,1};

constexpr size_t SZ_ACT = (size_t)MT * 1024 * 2;
constexpr size_t OFF_MOD = 0;
constexpr size_t OFF_BAR = 458752;
constexpr size_t OFF_W0IN = 524288;
constexpr size_t SZ_RWIN = (size_t)4352 * 1024 * 2;
constexpr size_t SZ_RWUP = (size_t)4 * 1024 * 64 * 2;
constexpr size_t SZ_SQ = (size_t)1024 * 1024 * 2;
constexpr size_t OFF_W0UP = OFF_W0IN + SZ_RWIN;
constexpr size_t OFF_W0OUT = OFF_W0UP + SZ_RWUP;
constexpr size_t OFF_W3IN = OFF_W0OUT + SZ_SQ;
constexpr size_t OFF_W3UP = OFF_W3IN + SZ_RWIN;
constexpr size_t OFF_W3OUT = OFF_W3UP + SZ_RWUP;
constexpr size_t OFF_W1IN = OFF_W3OUT + SZ_SQ;
constexpr size_t OFF_W1G = OFF_W1IN + (size_t)2816 * 1024 * 2;
constexpr size_t OFF_W1OUT = OFF_W1G + (size_t)16 * 4 * 96 * 96 * 2;
constexpr size_t OFF_W2IN = OFF_W1OUT + (size_t)1024 * 1408 * 2;
constexpr size_t OFF_W2OUT = OFF_W2IN + (size_t)4096 * 1024 * 2;
constexpr size_t OFF_XC = OFF_W2OUT + SZ_SQ;
constexpr size_t OFF_BON = OFF_XC + (size_t)MC * 1024 * 4;
constexpr size_t OFF_BIG = OFF_BON + (size_t)2 * MT * 16 * 4;
constexpr size_t OFF_HB = OFF_BIG;
constexpr size_t OFF_A0 = OFF_BIG + SZ_ACT;
constexpr size_t OFF_A1 = OFF_A0 + SZ_ACT;
constexpr size_t OFF_A2 = OFF_A1 + SZ_ACT;
constexpr size_t OFF_A3 = OFF_A2 + SZ_ACT;
constexpr size_t OFF_A4 = OFF_A3 + SZ_ACT;
constexpr size_t OFF_WD = OFF_A4 + SZ_ACT;
constexpr size_t OFF_AD = OFF_WD + (size_t)MT * 128 * 2;
constexpr size_t WS_END = OFF_AD + (size_t)MT * 128 * 2;
constexpr size_t SZ_LRU = (size_t)MT * LW * 2;
constexpr size_t OFF_HS0 = OFF_BIG;
constexpr size_t OFF_XR = OFF_BIG + SZ_LRU;
constexpr size_t OFF_GG = OFF_XR + SZ_LRU;
constexpr size_t OFF_HS1 = OFF_GG + SZ_LRU;
static_assert(OFF_HS1 + SZ_LRU <= WS_END, "lru overlay");
static_assert(WS_END <= (size_t)536870912, "ws");

struct Params {
  const float* in[45];
  float* out;
  char* ws;
  int ph_lo, ph_hi;
};

DEVI u32x4 mk4(unsigned a, unsigned b, unsigned c, unsigned d) { u32x4 r = {a, b, c, d}; return r; }
DEVI int opaque_tid() { int t = threadIdx.x; asm volatile("" : "+v"(t)); return t; }
DEVI float bf_lo(unsigned u) { return __uint_as_float(u << 16); }
DEVI float bf_hi(unsigned u) { return __uint_as_float(u & 0xffff0000u); }
DEVI float bf2f(bf16_t h) { return __uint_as_float(((unsigned)h) << 16); }
typedef __bf16 bf16x2_t __attribute__((ext_vector_type(2)));
DEVI unsigned pk_bf16(float lo, float hi) { f32x2 f = {lo, hi}; bf16x2_t v = __builtin_convertvector(f, bf16x2_t); return __builtin_bit_cast(unsigned, v); }
DEVI bf16_t f2bf(float f) { return (bf16_t)(pk_bf16(f, 0.f) & 0xffffu); }
DEVI float wave_sum(float v) {
#pragma unroll
  for (int o = 32; o; o >>= 1) v += __shfl_xor(v, o);
  return v;
}
DEVI float sigmoidf_(float x) { return __builtin_amdgcn_rcpf(1.f + __expf(-x)); }
DEVI float siluf_(float x) { return x * __builtin_amdgcn_rcpf(1.f + __expf(-x)); }
DEVI float softplusf_(float x) { return fmaxf(x, 0.f) + __logf(1.f + __expf(-fabsf(x))); }
DEVI f32x16 mfma32(u32x4 a, u32x4 b, f32x16 c) {
  return __builtin_amdgcn_mfma_f32_32x32x16_bf16(__builtin_bit_cast(bf16x8, a), __builtin_bit_cast(bf16x8, b), c, 0, 0, 0);
}
DEVI f32x4 mfma16(u32x4 a, u32x4 b, f32x4 c) {
  return __builtin_amdgcn_mfma_f32_16x16x32_bf16(__builtin_bit_cast(bf16x8, a), __builtin_bit_cast(bf16x8, b), c, 0, 0, 0);
}
template <int CTRL> DEVI float dpp_f(float v) {
  return __int_as_float(__builtin_amdgcn_update_dpp(0, __float_as_int(v), CTRL, 0xf, 0xf, true));
}
DEVI float sum8(float v) {
  v += dpp_f<0xB1>(v);
  v += dpp_f<0x4E>(v);
  v += dpp_f<0x141>(v);
  return v;
}

#define XB_TMO      128
#define XB_XCNT(j)  (256  + 64 * (j))
#define XB_XSUB(j)  (1280 + 64 * (j))
#define XB_XGEN(j)  (2304 + 64 * (j))
#define XB_TOP      3328
#define XB_TOPGEN   3392
#define XCD_BAR_WORDS 3456
#define XB_SPIN_CAP (1u << 18)
#define LAS __attribute__((address_space(3)))

__device__ __forceinline__ unsigned xb_ld(unsigned* p)              { return __hip_atomic_load(p, __ATOMIC_RELAXED, __HIP_MEMORY_SCOPE_AGENT); }
__device__ __forceinline__ unsigned xb_add(unsigned* p, unsigned v) { return __hip_atomic_fetch_add(p, v, __ATOMIC_RELAXED, __HIP_MEMORY_SCOPE_AGENT); }
__device__ __forceinline__ unsigned xb_xcc_id() { return (unsigned)__builtin_amdgcn_s_getreg((3 << 11) | 20) & 0xFu; }
#define XB_SPIN(cond, bar) do { unsigned _sp = 0; while (cond) { __builtin_amdgcn_s_sleep(1); \
    if ((++_sp & 255u) == 0u) { if (xb_ld(&(bar)[XB_TMO])) break; if (_sp > XB_SPIN_CAP) { atomicAdd(&(bar)[XB_TMO], 1u); break; } } } } while (0)

struct XcdBarrier {
    unsigned* bar; unsigned x;
    volatile LAS unsigned* st;
};

__device__ __forceinline__ XcdBarrier xcd_barrier_post(unsigned* bar, volatile LAS unsigned* st) {
    XcdBarrier b; b.bar = bar; b.x = xb_xcc_id(); b.st = st;
    if (threadIdx.x == 0) (void)xb_add(&bar[XB_XCNT(b.x)], 1u);
    return b;
}
__device__ __forceinline__ void xcd_barrier_complete(unsigned* bar, unsigned x, unsigned& nloc, unsigned& nx) {
    const unsigned G = gridDim.x * gridDim.y * gridDim.z;
    unsigned sum, cnt, mine, sp = 0u;
    for (;;) {
        sum = 0u; cnt = 0u; mine = 0u;
#pragma unroll
        for (unsigned j = 0; j < 16; ++j) { const unsigned c = xb_ld(&bar[XB_XCNT(j)]); sum += c; cnt += (c > 0u) ? 1u : 0u; mine = (j == x) ? c : mine; }
        if (sum == G) break;
        __builtin_amdgcn_s_sleep(1);
        if ((++sp & 255u) == 0u) { if (xb_ld(&bar[XB_TMO])) break; if (sp > XB_SPIN_CAP) { atomicAdd(&bar[XB_TMO], 1u); break; } }
    }
    nloc = mine > 0u ? mine : 1u; nx = cnt > 0u ? cnt : 1u;
}

__device__ __forceinline__ void xcd_barrier(const XcdBarrier& b) {
    asm volatile("s_waitcnt vmcnt(0)" ::: "memory");
    __syncthreads();
    if (threadIdx.x == 0) {
        unsigned* bar = b.bar;
        __builtin_amdgcn_s_waitcnt(0);
        unsigned nloc = b.st[0], nx = b.st[1];
        if (nloc == 0u) { xcd_barrier_complete(bar, b.x, nloc, nx); b.st[0] = nloc; b.st[1] = nx; }
        const unsigned old = xb_add(&bar[XB_XSUB(b.x)], 1u);
        const unsigned gen = old / nloc;
        if (old + 1u == (gen + 1u) * nloc) {
            __builtin_amdgcn_fence(__ATOMIC_RELEASE, "agent");
            asm volatile("s_waitcnt vmcnt(0)" ::: "memory");
            const unsigned og = xb_add(&bar[XB_TOP], 1u);
            const unsigned tg = og / nx;
            if (og + 1u == (tg + 1u) * nx) xb_add(&bar[XB_TOPGEN], 1u);
            else XB_SPIN(xb_ld(&bar[XB_TOPGEN]) == tg, bar);
            __builtin_amdgcn_fence(__ATOMIC_ACQUIRE, "agent");
            xb_add(&bar[XB_XGEN(b.x)], 1u);
            asm volatile("s_waitcnt vmcnt(0)" ::: "memory");
        } else {
            XB_SPIN(xb_ld(&bar[XB_XGEN(b.x)]) == gen, bar);
            __builtin_amdgcn_fence(__ATOMIC_ACQUIRE, "agent");
            asm volatile("s_waitcnt vmcnt(0)" ::: "memory");
        }
    }
    __syncthreads();
}


struct TJob { const float* src; int K, N; bf16_t* dst; int ldd; };

DEVI TJob get_tjob(const Params& p, int j) {
  TJob t;
  if (j < 26) {
    const int l = j / 13, jj = j % 13;
    const int ib = l ? 33 : 4;
    bf16_t* win = (bf16_t*)(p.ws + (l ? OFF_W3IN : OFF_W0IN));
    bf16_t* wup = (bf16_t*)(p.ws + (l ? OFF_W3UP : OFF_W0UP));
    bf16_t* wout = (bf16_t*)(p.ws + (l ? OFF_W3OUT : OFF_W0OUT));
    if (jj < 4) { t.src = p.in[ib + 3] + (size_t)jj * 1048576; t.K = 1024; t.N = 1024; t.dst = win + (size_t)jj * 1048576; t.ldd = 1024; }
    else if (jj < 8) { const int idx = jj - 4, d = idx >> 1, kind = idx & 1;
      t.src = p.in[ib + 6] + (size_t)idx * 65536; t.K = 1024; t.N = 64; t.dst = win + (size_t)(4096 + kind * 128 + d * 64) * 1024; t.ldd = 1024; }
    else if (jj < 12) { const int idx = jj - 8;
      t.src = p.in[ib + 7] + (size_t)idx * 65536; t.K = 64; t.N = 1024; t.dst = wup + (size_t)idx * 65536; t.ldd = 64; }
    else { t.src = p.in[ib + 11]; t.K = 1024; t.N = 1024; t.dst = wout; t.ldd = 1024; }
  } else if (j == 26) { t.src = p.in[19]; t.K = 1024; t.N = 2816; t.dst = (bf16_t*)(p.ws + OFF_W1IN); t.ldd = 1024; }
  else if (j == 27) { t.src = p.in[25]; t.K = 1408; t.N = 1024; t.dst = (bf16_t*)(p.ws + OFF_W1OUT); t.ldd = 1408; }
  else if (j == 28) { t.src = p.in[29]; t.K = 1024; t.N = 4096; t.dst = (bf16_t*)(p.ws + OFF_W2IN); t.ldd = 1024; }
  else { t.src = p.in[32]; t.K = 1024; t.N = 1024; t.dst = (bf16_t*)(p.ws + OFF_W2OUT); t.ldd = 1024; }
  return t;
}

__device__ __forceinline__ void phase0(const Params& p, char* lds) {
  const int tid = opaque_tid();
  {
    bf16_t* wg = (bf16_t*)(p.ws + OFF_W1G);
    const float* gw = p.in[22];
    const int total = 16 * 4 * 96 * 96;
    for (int e = blockIdx.x * NTHR + tid; e < total; e += gridDim.x * NTHR) {
      const int k = e % 96, n = (e / 96) % 96, dg = (e / 9216) & 3, blk = e / 36864;
      float v = 0.f;
      if (k < 88 && n < 88) v = gw[((size_t)(dg * 16 + blk) * 88 + k) * 88 + n];
      wg[e] = f2bf(v);
    }
  }
  constexpr int N_MOD_ITEMS = 96;
  constexpr int N_TILES = 5152;
  float* act = (float*)lds;
  float* red = (float*)(lds + 36864);
  float* tl = (float*)lds;
  for (int item = blockIdx.x; item < N_MOD_ITEMS + N_TILES; item += gridDim.x) {
    __syncthreads();
    if (item < N_MOD_ITEMS) {
      const int L = item / 24, nc = item % 24;
      const int ib = (L == 0) ? 4 : (L == 1) ? 16 : (L == 2) ? 26 : 33;
      const float* ada_w = p.in[ib + 1];
      const float* ada_b = p.in[ib + 2];
      for (int e = tid; e < 9 * 1024; e += NTHR) {
        const int i = e >> 10, k = e & 1023;
        const float c = (i < 8) ? p.in[1][i * 1024 + k] : p.in[3][k];
        act[e] = siluf_(c);
      }
      __syncthreads();
      const int kq = tid >> 7, nl = tid & 127, n = nc * 128 + nl;
      float acc[9];
#pragma unroll
      for (int i = 0; i < 9; ++i) acc[i] = 0.f;
      for (int k = kq * 256; k < kq * 256 + 256; ++k) {
        const float w = ada_w[(size_t)k * 3072 + n];
#pragma unroll
        for (int i = 0; i < 9; ++i) acc[i] += act[i * 1024 + k] * w;
      }
#pragma unroll
      for (int i = 0; i < 9; ++i) red[(kq * 9 + i) * 128 + nl] = acc[i];
      __syncthreads();
      float* mod = (float*)(p.ws + OFF_MOD) + (size_t)L * 9 * 3072;
      for (int e = tid; e < 9 * 128; e += NTHR) {
        const int i = e >> 7, c = e & 127;
        const float s = red[(0 * 9 + i) * 128 + c] + red[(1 * 9 + i) * 128 + c] + red[(2 * 9 + i) * 128 + c] + red[(3 * 9 + i) * 128 + c];
        mod[i * 3072 + nc * 128 + c] = s + ada_b[nc * 128 + c];
      }
    } else {
      int t = item - N_MOD_ITEMS;
      int j = 0;
      TJob job = get_tjob(p, 0);
      for (;;) {
        const int nt = (job.K >> 6) * (job.N >> 6);
        if (t < nt) break;
        t -= nt; ++j; job = get_tjob(p, j);
      }
      const int ntn = job.N >> 6;
      const int k0 = (t / ntn) * 64, n0 = (t % ntn) * 64;
#pragma unroll
      for (int i = 0; i < 2; ++i) {
        const int k = (tid >> 4) + 32 * i, n4 = (tid & 15) * 4;
        const float4 v = *(const float4*)(job.src + (size_t)(k0 + k) * job.N + n0 + n4);
        tl[k * 65 + n4 + 0] = v.x; tl[k * 65 + n4 + 1] = v.y; tl[k * 65 + n4 + 2] = v.z; tl[k * 65 + n4 + 3] = v.w;
      }
      __syncthreads();
      const int n = tid >> 3, k8 = (tid & 7) * 8;
      u32x4 o;
      o.x = pk_bf16(tl[(k8 + 0) * 65 + n], tl[(k8 + 1) * 65 + n]);
      o.y = pk_bf16(tl[(k8 + 2) * 65 + n], tl[(k8 + 3) * 65 + n]);
      o.z = pk_bf16(tl[(k8 + 4) * 65 + n], tl[(k8 + 5) * 65 + n]);
      o.w = pk_bf16(tl[(k8 + 6) * 65 + n], tl[(k8 + 7) * 65 + n]);
      *(u32x4*)(job.dst + (size_t)(n0 + n) * job.ldd + k0 + k8) = o;
    }
  }
}

DEVI void norm_row(const float* __restrict__ xr, const float* __restrict__ g, const float* __restrict__ mod, int lane, float (&h)[16]) {
  float4 x[4];
  float ss = 0.f;
#pragma unroll
  for (int i = 0; i < 4; ++i) {
    x[i] = *(const float4*)(xr + lane * 4 + 256 * i);
    ss += x[i].x * x[i].x + x[i].y * x[i].y + x[i].z * x[i].z + x[i].w * x[i].w;
  }
  ss = wave_sum(ss);
  const float rstd = rsqrtf(ss * (1.f / 1024.f) + 1e-6f);
#pragma unroll
  for (int i = 0; i < 4; ++i) {
    const int c = lane * 4 + 256 * i;
    const float4 gg = *(const float4*)(g + c);
    const float4 sh = *(const float4*)(mod + c);
    const float4 sc = *(const float4*)(mod + 1024 + c);
    h[i * 4 + 0] = x[i].x * rstd * gg.x * (1.f + sc.x) + sh.x;
    h[i * 4 + 1] = x[i].y * rstd * gg.y * (1.f + sc.y) + sh.y;
    h[i * 4 + 2] = x[i].z * rstd * gg.z * (1.f + sc.z) + sh.z;
    h[i * 4 + 3] = x[i].w * rstd * gg.w * (1.f + sc.w) + sh.w;
  }
}

template <bool WITH_HS>
__device__ __forceinline__ void norm_phase(const float* __restrict__ xl, const float* __restrict__ xc, const float* __restrict__ g,
                           const float* __restrict__ modL, bf16_t* __restrict__ H, bf16_t* __restrict__ HS) {
  const int tidx = opaque_tid();
  const int lane = tidx & 63;
  const int gw = blockIdx.x * (NTHR / 64) + (tidx >> 6), nw = gridDim.x * (NTHR / 64);
  for (int row = gw; row < MT; row += nw) {
    const bool lat = row < ML;
    const float* xbase = lat ? xl + (size_t)row * 1024 : xc + (size_t)(row - ML) * 1024;
    const float* mod = modL + (lat ? (row >> 12) : 8) * 3072;
    float h[16];
    norm_row(xbase, g, mod, lane, h);
#pragma unroll
    for (int i = 0; i < 4; ++i) {
      u32x2 o; o.x = pk_bf16(h[i * 4], h[i * 4 + 1]); o.y = pk_bf16(h[i * 4 + 2], h[i * 4 + 3]);
      *(u32x2*)(H + (size_t)row * 1024 + lane * 4 + 256 * i) = o;
    }
    if (WITH_HS) {
      const int t = lat ? (row & 4095) : ((row - ML) & 255);
      const int T = lat ? 4096 : 256;
      float s[16];
#pragma unroll
      for (int i = 0; i < 16; ++i) s[i] = 0.f;
      if (t > 0) { float hp[16]; norm_row(xbase - 1024, g, mod, lane, hp);
#pragma unroll
        for (int i = 0; i < 16; ++i) s[i] += hp[i]; }
      if (t < T - 1) { float hn[16]; norm_row(xbase + 1024, g, mod, lane, hn);
#pragma unroll
        for (int i = 0; i < 16; ++i) s[i] += hn[i]; }
#pragma unroll
      for (int i = 0; i < 4; ++i) {
        u32x2 o; o.x = pk_bf16(0.5f * s[i * 4], 0.5f * s[i * 4 + 1]); o.y = pk_bf16(0.5f * s[i * 4 + 2], 0.5f * s[i * 4 + 3]);
        *(u32x2*)(HS + (size_t)row * 1024 + lane * 4 + 256 * i) = o;
      }
    }
  }
}

struct ALPlain {
  const bf16_t* A; int lda;
  typedef u32x4 Regs;
  DEVI void stage(float*, int) const {}
  DEVI void issue(Regs& r, int row, int k) const { r = *(const u32x4*)(A + (size_t)row * lda + k); }
  DEVI u32x4 finish(const Regs& r, const float*, int) const { return r; }
};
struct ALMix {
  const bf16_t* H; const bf16_t* HS; const float* mu;
  struct Regs { u32x4 h, s; };
  DEVI void stage(float* sMu, int n0) const {
    const int grp = n0 >> 10;
    const int j = grp == 0 ? 0 : grp == 1 ? 2 : grp == 2 ? 3 : grp == 3 ? 5 : (n0 - 4096) < 128 ? 1 : 4;
    for (int e = threadIdx.x; e < 1024; e += NTHR) sMu[e] = mu[j * 1024 + e];
  }
  DEVI void issue(Regs& r, int row, int k) const {
    r.h = *(const u32x4*)(H + (size_t)row * 1024 + k);
    r.s = *(const u32x4*)(HS + (size_t)row * 1024 + k);
  }
  DEVI unsigned mix2(unsigned h, unsigned s, float m0, float m1) const {
    const float h0 = bf_lo(h), h1 = bf_hi(h), s0 = bf_lo(s), s1 = bf_hi(s);
    return pk_bf16(h0 + (s0 - h0) * m0, h1 + (s1 - h1) * m1);
  }
  DEVI u32x4 finish(const Regs& r, const float* sMu, int k) const {
    const float4 ma = *(const float4*)(sMu + k), mb = *(const float4*)(sMu + k + 4);
    u32x4 o;
    o.x = mix2(r.h.x, r.s.x, ma.x, ma.y); o.y = mix2(r.h.y, r.s.y, ma.z, ma.w);
    o.z = mix2(r.h.z, r.s.z, mb.x, mb.y); o.w = mix2(r.h.w, r.s.w, mb.z, mb.w);
    return o;
  }
};

template <class AL, class EP>
__device__ __forceinline__ void gemm_phase(char* lds, const bf16_t* __restrict__ Bt, int K, int mtiles, int ntiles, const AL al, const EP ep, int n_base = 0, bool reverse = false, int mt_base = 0) {
  bf16_t* sA = (bf16_t*)lds;
  bf16_t* sB = (bf16_t*)(lds + 73728);
  float* sMu = (float*)(lds + 110592);
  const int tid = opaque_tid(), lane = tid & 63, wv = tid >> 6, wm = wv >> 1, wn = wv & 1;
  const int l31 = lane & 31, lh = lane >> 5;
  const int nk = K >> 6;
  const int ldrow = tid >> 3, ldk = (tid & 7) * 8;
  const int total = mtiles * ntiles;
  const int bid = reverse ? (int)(gridDim.x - 1 - blockIdx.x) : (int)blockIdx.x;
  const int nslots = gridDim.x >> 3, xcd = bid & 7, slot = bid >> 3;
  const int gm = 4 * ntiles;
  for (int chunk = xcd; chunk * nslots < total; chunk += 8) {
    const int tile = chunk * nslots + slot;
    if (tile >= total) break;
    const int grp = tile / gm, rem = tile - grp * gm;
    const int mt = grp * 4 + (rem & 3), nt = rem >> 2;
    const int m0 = (mt_base + mt) * 256, n0 = n_base + nt * 128;
    __syncthreads();
    al.stage(sMu, n0);
    f32x16 acc[2][2];
#pragma unroll
    for (int a = 0; a < 2; ++a)
#pragma unroll
      for (int b = 0; b < 2; ++b)
#pragma unroll
        for (int r = 0; r < 16; ++r) acc[a][b][r] = 0.f;
    typename AL::Regs ar[4];
    u32x4 br[2];
#pragma unroll
    for (int i = 0; i < 4; ++i) al.issue(ar[i], m0 + ldrow + 64 * i, ldk);
#pragma unroll
    for (int i = 0; i < 2; ++i) br[i] = *(const u32x4*)(Bt + (size_t)(n0 + ldrow + 64 * i) * K + ldk);
    __syncthreads();
#pragma unroll
    for (int i = 0; i < 4; ++i) *(u32x4*)(sA + (ldrow + 64 * i) * 72 + ldk) = al.finish(ar[i], sMu, ldk);
#pragma unroll
    for (int i = 0; i < 2; ++i) *(u32x4*)(sB + (ldrow + 64 * i) * 72 + ldk) = br[i];
    __syncthreads();
    for (int kt = 0; kt < nk; ++kt) {
      const int cur = kt & 1;
      const bool more = (kt + 1) < nk;
      const int k0n = (kt + 1) * 64 + ldk;
      if (more) {
#pragma unroll
        for (int i = 0; i < 4; ++i) al.issue(ar[i], m0 + ldrow + 64 * i, k0n);
#pragma unroll
        for (int i = 0; i < 2; ++i) br[i] = *(const u32x4*)(Bt + (size_t)(n0 + ldrow + 64 * i) * K + k0n);
      }
      __builtin_amdgcn_sched_barrier(0);
      const bf16_t* a_ = sA + cur * (256 * 72);
      const bf16_t* b_ = sB + cur * (128 * 72);
#pragma unroll
      for (int kk = 0; kk < 4; ++kk) {
        u32x4 af[2], bfr[2];
#pragma unroll
        for (int mi = 0; mi < 2; ++mi) af[mi] = *(const u32x4*)(a_ + (wm * 64 + mi * 32 + l31) * 72 + kk * 16 + lh * 8);
#pragma unroll
        for (int ni = 0; ni < 2; ++ni) bfr[ni] = *(const u32x4*)(b_ + (wn * 64 + ni * 32 + l31) * 72 + kk * 16 + lh * 8);
#pragma unroll
        for (int mi = 0; mi < 2; ++mi)
#pragma unroll
          for (int ni = 0; ni < 2; ++ni) acc[mi][ni] = mfma32(bfr[ni], af[mi], acc[mi][ni]);
      }
      __builtin_amdgcn_sched_barrier(0);
      if (more) {
        bf16_t* an = sA + (cur ^ 1) * (256 * 72);
        bf16_t* bn = sB + (cur ^ 1) * (128 * 72);
#pragma unroll
        for (int i = 0; i < 4; ++i) *(u32x4*)(an + (ldrow + 64 * i) * 72 + ldk) = al.finish(ar[i], sMu, k0n);
#pragma unroll
        for (int i = 0; i < 2; ++i) *(u32x4*)(bn + (ldrow + 64 * i) * 72 + ldk) = br[i];
      }
      __syncthreads();
    }
#pragma unroll
    for (int mi = 0; mi < 2; ++mi)
#pragma unroll
      for (int ni = 0; ni < 2; ++ni)
#pragma unroll
        for (int q = 0; q < 4; ++q) {
          const int row = m0 + wm * 64 + mi * 32 + l31;
          const int col = n0 + wn * 64 + ni * 32 + 8 * q + 4 * lh;
          f32x4 v = {acc[mi][ni][4 * q], acc[mi][ni][4 * q + 1], acc[mi][ni][4 * q + 2], acc[mi][ni][4 * q + 3]};
          ep(row, col, v);
        }
  }
}


template <class AL, class EP>
__device__ __forceinline__ void gemm256_phase(char* lds, const bf16_t* __restrict__ Bt, int K, int mtiles, int ntiles, const AL al, const EP ep) {
  bf16_t* sA = (bf16_t*)lds;
  bf16_t* sB = (bf16_t*)(lds + 73728);
  float* sMu = (float*)(lds + 147456);
  const int tid = opaque_tid(), lane = tid & 63, wv = tid >> 6, wm = wv >> 1, wn = wv & 1;
  const int l31 = lane & 31, lh = lane >> 5;
  const int nk = K >> 6;
  const int ldrow = tid >> 3, ldk = (tid & 7) * 8;
  const int total = mtiles * ntiles;
  const int nslots = gridDim.x >> 3, xcd = blockIdx.x & 7, slot = blockIdx.x >> 3;
  const int gm = 4 * ntiles;
  for (int chunk = xcd; chunk * nslots < total; chunk += 8) {
    const int tile = chunk * nslots + slot;
    if (tile >= total) break;
    const int grp = tile / gm, rem = tile - grp * gm;
    const int mt = grp * 4 + (rem & 3), nt = rem >> 2;
    const int m0 = mt * 256, n0 = nt * 256;
    __syncthreads();
    al.stage(sMu, n0);
    f32x16 acc[2][4];
#pragma unroll
    for (int a = 0; a < 2; ++a)
#pragma unroll
      for (int b = 0; b < 4; ++b)
#pragma unroll
        for (int r = 0; r < 16; ++r) acc[a][b][r] = 0.f;
    typename AL::Regs ar[4];
    u32x4 br[4];
#pragma unroll
    for (int i = 0; i < 4; ++i) al.issue(ar[i], m0 + ldrow + 64 * i, ldk);
#pragma unroll
    for (int i = 0; i < 4; ++i) br[i] = *(const u32x4*)(Bt + (size_t)(n0 + ldrow + 64 * i) * K + ldk);
    __syncthreads();
#pragma unroll
    for (int i = 0; i < 4; ++i) *(u32x4*)(sA + (ldrow + 64 * i) * 72 + ldk) = al.finish(ar[i], sMu, ldk);
#pragma unroll
    for (int i = 0; i < 4; ++i) *(u32x4*)(sB + (ldrow + 64 * i) * 72 + ldk) = br[i];
    __syncthreads();
    for (int kt = 0; kt < nk; ++kt) {
      const int cur = kt & 1;
      const bool more = (kt + 1) < nk;
      const int k0n = (kt + 1) * 64 + ldk;
      if (more) {
#pragma unroll
        for (int i = 0; i < 4; ++i) al.issue(ar[i], m0 + ldrow + 64 * i, k0n);
#pragma unroll
        for (int i = 0; i < 4; ++i) br[i] = *(const u32x4*)(Bt + (size_t)(n0 + ldrow + 64 * i) * K + k0n);
      }
      __builtin_amdgcn_sched_barrier(0);
      const bf16_t* a_ = sA + cur * (256 * 72);
      const bf16_t* b_ = sB + cur * (256 * 72);
#pragma unroll
      for (int kk = 0; kk < 4; ++kk) {
        u32x4 af[2];
#pragma unroll
        for (int mi = 0; mi < 2; ++mi) af[mi] = *(const u32x4*)(a_ + (wm * 64 + mi * 32 + l31) * 72 + kk * 16 + lh * 8);
#pragma unroll
        for (int ni = 0; ni < 4; ++ni) {
          const u32x4 bfr = *(const u32x4*)(b_ + (wn * 128 + ni * 32 + l31) * 72 + kk * 16 + lh * 8);
#pragma unroll
          for (int mi = 0; mi < 2; ++mi) acc[mi][ni] = mfma32(bfr, af[mi], acc[mi][ni]);
        }
      }
      __builtin_amdgcn_sched_barrier(0);
      if (more) {
        bf16_t* an = sA + (cur ^ 1) * (256 * 72);
        bf16_t* bn = sB + (cur ^ 1) * (256 * 72);
#pragma unroll
        for (int i = 0; i < 4; ++i) *(u32x4*)(an + (ldrow + 64 * i) * 72 + ldk) = al.finish(ar[i], sMu, k0n);
#pragma unroll
        for (int i = 0; i < 4; ++i) *(u32x4*)(bn + (ldrow + 64 * i) * 72 + ldk) = br[i];
      }
      __syncthreads();
    }
    if constexpr (EP::VIA_LDS) {
      float* reg = (float*)(lds + wv * 16896);
#pragma unroll
      for (int mi = 0; mi < 2; ++mi) {
#pragma unroll
        for (int ni = 0; ni < 4; ++ni)
#pragma unroll
          for (int q = 0; q < 4; ++q) {
            f32x4 v = {acc[mi][ni][4 * q], acc[mi][ni][4 * q + 1], acc[mi][ni][4 * q + 2], acc[mi][ni][4 * q + 3]};
            *(f32x4*)(reg + l31 * 132 + ni * 32 + 8 * q + 4 * lh) = v;
          }
#pragma unroll 4
        for (int it = 0; it < 16; ++it) {
          const int rl = it * 2 + lh;
          const f32x4 v = *(const f32x4*)(reg + rl * 132 + l31 * 4);
          ep(m0 + wm * 64 + mi * 32 + rl, n0 + wn * 128 + l31 * 4, v);
        }
      }
    } else
#pragma unroll
    for (int mi = 0; mi < 2; ++mi)
#pragma unroll
      for (int ni = 0; ni < 4; ++ni) {
#pragma unroll
        for (int q = 0; q < 4; ++q) {
          const int row = m0 + wm * 64 + mi * 32 + l31;
          const int col = n0 + wn * 128 + ni * 32 + 8 * q + 4 * lh;
          f32x4 v = {acc[mi][ni][4 * q], acc[mi][ni][4 * q + 1], acc[mi][ni][4 * q + 2], acc[mi][ni][4 * q + 3]};
          ep(row, col, v);
        }
        __builtin_amdgcn_sched_barrier(0);
      }
  }
}

DEVI void st_bf16x4(bf16_t* p, f32x4 v) { u32x2 o; o.x = pk_bf16(v[0], v[1]); o.y = pk_bf16(v[2], v[3]); *(u32x2*)p = o; }

struct EpRwkvIn {
  static constexpr bool VIA_LDS = false;
  bf16_t *R, *K, *V, *G, *WD, *AD;
  DEVI void operator()(int row, int col, f32x4 v) const {
    const int grp = col >> 10;
    if (grp < 4) {
      const int c = col & 1023;
      bf16_t* dst = grp == 0 ? R : grp == 1 ? K : grp == 2 ? V : G;
      if (grp == 3) { v[0] = siluf_(v[0]); v[1] = siluf_(v[1]); v[2] = siluf_(v[2]); v[3] = siluf_(v[3]); }
      st_bf16x4(dst + (size_t)row * 1024 + c, v);
    } else {
      const int c = col - 4096;
      if (c < 128) {
#pragma unroll
        for (int i = 0; i < 4; ++i) { const float t = __expf(2.f * v[i]); v[i] = 1.f - 2.f / (t + 1.f); }
        st_bf16x4(WD + (size_t)row * 128 + c, v);
      } else st_bf16x4(AD + (size_t)row * 128 + (c - 128), v);
    }
  }
};
struct EpRes {
  static constexpr bool VIA_LDS = true;
  const float* xl_src; const float* xc_src; float* xl_dst; float* xc_dst; const float* modL;
  DEVI void operator()(int row, int col, f32x4 v) const {
    const bool lat = row < ML;
    const size_t off = lat ? (size_t)row * 1024 + col : (size_t)(row - ML) * 1024 + col;
    const float* src = (lat ? xl_src : xc_src) + off;
    float* dst = (lat ? xl_dst : xc_dst) + off;
    const f32x4 g = *(const f32x4*)(modL + (lat ? (row >> 12) : 8) * 3072 + 2048 + col);
    f32x4 x = *(const f32x4*)src;
    x += g * v;
    *(f32x4*)dst = x;
  }
};
struct EpLruIn {
  static constexpr bool VIA_LDS = false;
  bf16_t *XR, *GG;
  DEVI void operator()(int row, int col, f32x4 v) const {
    if (col < LW) st_bf16x4(XR + (size_t)row * LW + col, v);
    else { v[0] = siluf_(v[0]); v[1] = siluf_(v[1]); v[2] = siluf_(v[2]); v[3] = siluf_(v[3]); st_bf16x4(GG + (size_t)row * LW + (col - LW), v); }
  }
};
struct EpNatIn {
  static constexpr bool VIA_LDS = false;
  bf16_t *Q, *K, *VT, *G;
  DEVI void operator()(int row, int col, f32x4 v) const {
    const int grp = col >> 10, c = col & 1023;
    if (grp == 0) st_bf16x4(Q + (size_t)row * 1024 + c, v);
    else if (grp == 1) st_bf16x4(K + (size_t)row * 1024 + c, v);
    else if (grp == 3) { v[0] = siluf_(v[0]); v[1] = siluf_(v[1]); v[2] = siluf_(v[2]); v[3] = siluf_(v[3]); st_bf16x4(G + (size_t)row * 1024 + c, v); }
    else {
      unsigned idx, T;
      if (row < ML) { const unsigned b = row >> 12, t = row & 4095; T = 4096u; idx = ((b * 1024u + (unsigned)c) << 12) + t; }
      else { const unsigned r2 = row - ML; const unsigned b = r2 >> 8, t = r2 & 255; T = 256u; idx = (unsigned)ML * 1024u + ((b * 1024u + (unsigned)c) << 8) + t; }
#pragma unroll
      for (int i = 0; i < 4; ++i) VT[idx + (unsigned)i * T] = f2bf(v[i]);
    }
  }
};

constexpr int SSTR = 356;
DEVI int rwkv_row(int b, int d, int s) {
  if (s < 256) return ML + b * 256 + (d ? 255 - s : s);
  const int t = s - 256;
  return b * 4096 + (d ? 4095 - t : t);
}

constexpr int SREC_BF = 260;
struct ScanRec { f32x4 w[4], k[4], d[4]; u32x4 a1, a2; float vv; f32x2 cc; };
DEVI void scan_load(ScanRec& R, const float* rec, int kq, int role_off, int srow) {
#pragma unroll
  for (int hf = 0; hf < 2; ++hf) {
    R.w[hf * 2] = *(const f32x4*)(rec + hf * 32 + 8 * kq);        R.w[hf * 2 + 1] = *(const f32x4*)(rec + hf * 32 + 8 * kq + 4);
    R.k[hf * 2] = *(const f32x4*)(rec + 64 + hf * 32 + 8 * kq);   R.k[hf * 2 + 1] = *(const f32x4*)(rec + 64 + hf * 32 + 8 * kq + 4);
    R.d[hf * 2] = *(const f32x4*)(rec + 128 + hf * 32 + 8 * kq);  R.d[hf * 2 + 1] = *(const f32x4*)(rec + 128 + hf * 32 + 8 * kq + 4);
  }
  const char* ab = (const char*)(rec + SREC_BF) + role_off + kq * 16;
  R.a1 = *(const u32x4*)ab; R.a2 = *(const u32x4*)(ab + 64);
  R.vv = rec[192 + srow];
  R.cc = *(const f32x2*)(rec + 256);
}
DEVI f32x2 lo2(f32x4 v) { return (f32x2){v[0], v[1]}; }
DEVI f32x2 hi2(f32x4 v) { return (f32x2){v[2], v[3]}; }
DEVI void scan_step(f32x2 (&S)[8], const ScanRec& R, float* yout, bool wr) {
  const u32x4 b1 = mk4(pk_bf16(S[0][0], S[0][1]), pk_bf16(S[1][0], S[1][1]), pk_bf16(S[2][0], S[2][1]), pk_bf16(S[3][0], S[3][1]));
  const u32x4 b2 = mk4(pk_bf16(S[4][0], S[4][1]), pk_bf16(S[5][0], S[5][1]), pk_bf16(S[6][0], S[6][1]), pk_bf16(S[7][0], S[7][1]));
  f32x4 D = {0.f, 0.f, 0.f, 0.f};
  D = mfma16(R.a1, b1, D);
  D = mfma16(R.a2, b2, D);
  const float sa = D[0], y0 = D[1], v = R.vv;
  const f32x2 sa2 = {sa, sa}, v2 = {v, v};
#pragma unroll
  for (int q = 0; q < 4; ++q) {
    S[2 * q] = S[2 * q] * lo2(R.w[q]) + (sa2 * lo2(R.k[q]) + v2 * lo2(R.d[q]));
    S[2 * q + 1] = S[2 * q + 1] * hi2(R.w[q]) + (sa2 * hi2(R.k[q]) + v2 * hi2(R.d[q]));
  }
  *yout = y0 + sa * R.cc[0] + v * R.cc[1];
}
DEVI float sum16(float v) { v = sum8(v); v += dpp_f<0x140>(v); return v; }

__device__ __forceinline__ void rwkv_scan_phase(char* lds, const bf16_t* __restrict__ R, const bf16_t* __restrict__ Kb, const bf16_t* __restrict__ V,
                                const bf16_t* __restrict__ WD, const bf16_t* __restrict__ AD, const bf16_t* __restrict__ Wup,
                                const float* __restrict__ b0, const float* __restrict__ k_ka, const float* __restrict__ r_k,
                                bf16_t* __restrict__ Y0, bf16_t* __restrict__ Y1, float* __restrict__ BON) {
  float* stepbuf = (float*)lds;
  float* wbuf = stepbuf + 2 * 16 * SSTR;
  float* abuf = wbuf + 1024;
  float* ybuf = abuf + 1024;
  const int tid = opaque_tid(), lane = tid & 63, wv = tid >> 6;
  constexpr int NCH = (256 + 4096) / 16;
  for (int chain = blockIdx.x; chain < 256; chain += gridDim.x) {
    const int d = chain & 1, h = (chain >> 1) & 15, b = chain >> 5;
    __syncthreads();
    if (wv < 4) {
      const int kq = lane >> 4, srow = wv * 16 + (lane & 15);
      const int role = lane & 3, role_off = (role < 2 ? role : 2) * 128;
      const bool wr = kq == 0;
      f32x2 S[8];
#pragma unroll
      for (int j = 0; j < 8; ++j) S[j] = (f32x2){0.f, 0.f};
      __syncthreads();
      __syncthreads();
      for (int c = 0; c < NCH; ++c) {
        const float* sb = stepbuf + (c & 1) * 16 * SSTR;
        float* yb = ybuf + (c & 1) * 4096 + kq * 64 + srow;
        ScanRec ra, rb;
        scan_load(ra, sb, kq, role_off, srow);
#pragma unroll
        for (int i = 0; i < 8; i += 2) {
          scan_load(rb, sb + (i + 1) * SSTR, kq, role_off, srow);
          scan_step(S, ra, yb + i * 256, wr);
          scan_load(ra, sb + (i + 2) * SSTR, kq, role_off, srow);
          scan_step(S, rb, yb + (i + 1) * 256, wr);
        }
        __syncthreads();
#pragma unroll
        for (int i = 8; i < 16; i += 2) {
          scan_load(rb, sb + (i + 1) * SSTR, kq, role_off, srow);
          scan_step(S, ra, yb + i * 256, wr);
          if (i + 2 < 16) scan_load(ra, sb + (i + 2) * SSTR, kq, role_off, srow);
          scan_step(S, rb, yb + (i + 1) * 256, wr);
        }
        __syncthreads();
      }
    } else {
      const int ptid = tid - 256, pw = wv - 4;
      bf16_t* Y = d ? Y1 : Y0;
      const int ncol = h * 64 + pw * 16 + (lane & 15);
      u32x4 bu[2][2];
      float bias_u[2];
#pragma unroll
      for (int kind = 0; kind < 2; ++kind) {
        const bf16_t* wu = Wup + ((size_t)(d * 2 + kind) * 1024 + ncol) * 64 + 8 * (lane >> 4);
        bu[kind][0] = *(const u32x4*)wu; bu[kind][1] = *(const u32x4*)(wu + 32);
        bias_u[kind] = b0[(d * 2 + kind) * 1024 + ncol];
      }
      const int ti = ptid >> 4, dq = ptid & 15;
      const int hc = h * 64 + 4 * dq;
      const f32x4 kkv = *(const f32x4*)(k_ka + hc), kav = *(const f32x4*)(k_ka + 1024 + hc), rkv = *(const f32x4*)(r_k + hc);
      u32x4 xw0, xw1, xa0, xa1; u32x2 rr, kr, vr;
      auto issue = [&](int c) {
        const int rowA = rwkv_row(b, d, c * 16 + (lane & 15));
        const bf16_t* xp = WD + (size_t)rowA * 128 + d * 64 + 8 * (lane >> 4);
        const bf16_t* xq = AD + (size_t)rowA * 128 + d * 64 + 8 * (lane >> 4);
        xw0 = *(const u32x4*)xp; xw1 = *(const u32x4*)(xp + 32);
        xa0 = *(const u32x4*)xq; xa1 = *(const u32x4*)(xq + 32);
        const int rowB = rwkv_row(b, d, c * 16 + ti);
        rr = *(const u32x2*)(R + (size_t)rowB * 1024 + hc);
        kr = *(const u32x2*)(Kb + (size_t)rowB * 1024 + hc);
        vr = *(const u32x2*)(V + (size_t)rowB * 1024 + hc);
      };
      auto stepA = [&]() {
        f32x4 accw = {0.f, 0.f, 0.f, 0.f}, acca = {0.f, 0.f, 0.f, 0.f};
        accw = mfma16(xw0, bu[0][0], accw); accw = mfma16(xw1, bu[0][1], accw);
        acca = mfma16(xa0, bu[1][0], acca); acca = mfma16(xa1, bu[1][1], acca);
#pragma unroll
        for (int r = 0; r < 4; ++r) {
          const int o = ((lane >> 4) * 4 + r) * 64 + pw * 16 + (lane & 15);
          const float wl = -softplusf_(-(accw[r] + bias_u[0])) - 0.5f;
          wbuf[o] = __expf(-__expf(wl));
          abuf[o] = sigmoidf_(acca[r] + bias_u[1]);
        }
      };
      auto stepB = [&](int c, float* sb) {
        const float rv[4] = {bf_lo(rr.x), bf_hi(rr.x), bf_lo(rr.y), bf_hi(rr.y)};
        const float kv[4] = {bf_lo(kr.x), bf_hi(kr.x), bf_lo(kr.y), bf_hi(kr.y)};
        const float vv[4] = {bf_lo(vr.x), bf_hi(vr.x), bf_lo(vr.y), bf_hi(vr.y)};
        const f32x4 av = *(const f32x4*)(abuf + ti * 64 + 4 * dq), wv4 = *(const f32x4*)(wbuf + ti * 64 + 4 * dq);
        float q[4], ss = 0.f;
#pragma unroll
        for (int i = 0; i < 4; ++i) { q[i] = kv[i] * kkv[i]; ss += q[i] * q[i]; }
        ss = sum16(ss);
        const float inv = __builtin_amdgcn_rsqf(fmaxf(ss, 1e-24f));
        f32x4 nk, wrr, ka, kd, vo;
        float c1 = 0.f, c2 = 0.f, bn = 0.f;
#pragma unroll
        for (int i = 0; i < 4; ++i) {
          const float n = q[i] * inv;
          kd[i] = kv[i] * (1.f + (av[i] - 1.f) * kav[i]);
          ka[i] = n * av[i];
          nk[i] = -n; wrr[i] = wv4[i] * rv[i]; vo[i] = vv[i];
          c1 += ka[i] * rv[i]; c2 += kd[i] * rv[i]; bn += rv[i] * kd[i] * rkv[i];
        }
        c1 = sum16(c1); c2 = sum16(c2); bn = sum16(bn);
        float* rec = sb + ti * SSTR;
        *(f32x4*)(rec + 4 * dq) = wv4;
        *(f32x4*)(rec + 64 + 4 * dq) = ka;
        *(f32x4*)(rec + 128 + 4 * dq) = kd;
        *(f32x4*)(rec + 192 + 4 * dq) = vo;
        {
          bf16_t* bb = (bf16_t*)(rec + SREC_BF);
          u32x2 t0; t0.x = pk_bf16(nk[0], nk[1]); t0.y = pk_bf16(nk[2], nk[3]);
          u32x2 t1; t1.x = pk_bf16(wrr[0], wrr[1]); t1.y = pk_bf16(wrr[2], wrr[3]);
          *(u32x2*)(bb + 4 * dq) = t0;
          *(u32x2*)(bb + 64 + 4 * dq) = t1;
          *(u32x2*)(bb + 128 + 4 * dq) = (u32x2){0u, 0u};
        }
        if (dq == 0) {
          *(f32x2*)(rec + 256) = (f32x2){c1, c2};
          BON[((size_t)d * MT + rwkv_row(b, d, c * 16 + ti)) * 16 + h] = bn;
        }
      };
      auto storeY = [&](int c) {
        const f32x4 yv = *(const f32x4*)(ybuf + (c & 1) * 4096 + ti * 256 + 4 * dq);
        u32x2 o; o.x = pk_bf16(yv[0], yv[1]); o.y = pk_bf16(yv[2], yv[3]);
        *(u32x2*)(Y + (size_t)rwkv_row(b, d, c * 16 + ti) * 1024 + hc) = o;
      };
      issue(0);
      stepA();
      __syncthreads();
      stepB(0, stepbuf);
      issue(1);
      __syncthreads();
      for (int c = 0; c < NCH; ++c) {
        const bool more = (c + 1) < NCH;
        if (more) stepA();
        if (c >= 1) storeY(c - 1);
        __syncthreads();
        if (more) {
          stepB(c + 1, stepbuf + ((c + 1) & 1) * 16 * SSTR);
          if (c + 2 < NCH) issue(c + 2);
        }
        __builtin_amdgcn_sched_barrier(0);
        __syncthreads();
        __builtin_amdgcn_sched_barrier(0);
      }
      storeY(NCH - 1);
    }
  }
}

__device__ __forceinline__ void rwkv_post_phase(const bf16_t* __restrict__ Y0, const bf16_t* __restrict__ Y1, const bf16_t* __restrict__ V,
                                bf16_t* __restrict__ G, const float* __restrict__ BON, const float* __restrict__ gn, int nrows) {
  const int tidx = opaque_tid();
  const int lane = tidx & 63;
  const int gw = blockIdx.x * (NTHR / 64) + (tidx >> 6), nw = gridDim.x * (NTHR / 64);
  const int head = lane >> 2, c0 = lane * 16;
  for (int row = gw; row < nrows; row += nw) {
    const size_t off = (size_t)row * 1024 + c0;
    float y[16], v[16], g[16];
#pragma unroll
    for (int i = 0; i < 2; ++i) {
      const u32x4 a0 = *(const u32x4*)(Y0 + off + 8 * i), a1 = *(const u32x4*)(Y1 + off + 8 * i);
      const u32x4 av = *(const u32x4*)(V + off + 8 * i), ag = *(const u32x4*)(G + off + 8 * i);
      y[8 * i + 0] = bf_lo(a0.x) + bf_lo(a1.x); y[8 * i + 1] = bf_hi(a0.x) + bf_hi(a1.x);
      y[8 * i + 2] = bf_lo(a0.y) + bf_lo(a1.y); y[8 * i + 3] = bf_hi(a0.y) + bf_hi(a1.y);
      y[8 * i + 4] = bf_lo(a0.z) + bf_lo(a1.z); y[8 * i + 5] = bf_hi(a0.z) + bf_hi(a1.z);
      y[8 * i + 6] = bf_lo(a0.w) + bf_lo(a1.w); y[8 * i + 7] = bf_hi(a0.w) + bf_hi(a1.w);
      v[8 * i + 0] = bf_lo(av.x); v[8 * i + 1] = bf_hi(av.x); v[8 * i + 2] = bf_lo(av.y); v[8 * i + 3] = bf_hi(av.y);
      v[8 * i + 4] = bf_lo(av.z); v[8 * i + 5] = bf_hi(av.z); v[8 * i + 6] = bf_lo(av.w); v[8 * i + 7] = bf_hi(av.w);
      g[8 * i + 0] = bf_lo(ag.x); g[8 * i + 1] = bf_hi(ag.x); g[8 * i + 2] = bf_lo(ag.y); g[8 * i + 3] = bf_hi(ag.y);
      g[8 * i + 4] = bf_lo(ag.z); g[8 * i + 5] = bf_hi(ag.z); g[8 * i + 6] = bf_lo(ag.w); g[8 * i + 7] = bf_hi(ag.w);
    }
    float s = 0.f;
#pragma unroll
    for (int i = 0; i < 16; ++i) s += y[i];
    s += __shfl_xor(s, 1); s += __shfl_xor(s, 2);
    const float mean = s * (1.f / 64.f);
    float q = 0.f;
#pragma unroll
    for (int i = 0; i < 16; ++i) { const float dlt = y[i] - mean; q += dlt * dlt; }
    q += __shfl_xor(q, 1); q += __shfl_xor(q, 2);
    const float rstd = rsqrtf(q * (1.f / 64.f) + 64e-5f);
    const float bonus = BON[(size_t)row * 16 + head] + BON[((size_t)MT + row) * 16 + head];
    unsigned o[8];
#pragma unroll
    for (int i = 0; i < 8; ++i) {
      const float z0 = ((y[2 * i] - mean) * rstd * gn[c0 + 2 * i] + gn[1024 + c0 + 2 * i] + bonus * v[2 * i]) * g[2 * i];
      const float z1 = ((y[2 * i + 1] - mean) * rstd * gn[c0 + 2 * i + 1] + gn[1024 + c0 + 2 * i + 1] + bonus * v[2 * i + 1]) * g[2 * i + 1];
      o[i] = pk_bf16(z0, z1);
    }
    *(u32x4*)(G + off) = mk4(o[0], o[1], o[2], o[3]);
    *(u32x4*)(G + off + 8) = mk4(o[4], o[5], o[6], o[7]);
  }
}

__device__ __forceinline__ void rglru_phase(char* lds, const bf16_t* __restrict__ XR, const bf16_t* __restrict__ Wg, const float* __restrict__ conv_w,
                            const float* __restrict__ conv_b, const float* __restrict__ gate_b, const float* __restrict__ lam,
                            bf16_t* __restrict__ HS0, bf16_t* __restrict__ HS1) {
  bf16_t* xcT = (bf16_t*)lds;
  f32x2* AB = (f32x2*)(lds + 26624);
  bf16_t* raw = (bf16_t*)(lds + 26624);
  float* segP = (float*)(lds + 116736);
  float* segH = segP + 352;
  float* segC = segH + 352;
  bf16_t* wgs = (bf16_t*)(lds + 120960);
  float* cws = (float*)(lds + 160896);
  const int tid = opaque_tid(), lane = tid & 63, wv = tid >> 6;
  for (int chain = blockIdx.x; chain < 256; chain += gridDim.x) {
    const int d = chain & 1, blk = (chain >> 1) & 15, b = chain >> 5;
    bf16_t* HS = d ? HS1 : HS0;
    float carry = 0.f;
    __syncthreads();
    for (int q = tid; q < 2 * 96 * 12; q += NTHR) {
      const int g = q / 1152, rem = q - g * 1152, n = rem / 12, k8 = rem - n * 12;
      *(u32x4*)(wgs + (g * 96 + n) * 104 + k8 * 8) = *(const u32x4*)(Wg + ((size_t)((blk * 4 + d * 2 + g) * 96 + n)) * 96 + k8 * 8);
    }
    for (int e = tid; e < 5 * 88; e += NTHR) {
      const int j = e / 88, c = e - j * 88;
      cws[e] = j < 4 ? conv_w[j * LW + blk * 88 + c] : conv_b[blk * 88 + c];
    }
    for (int e = tid; e < 128 * 8; e += NTHR) xcT[(e >> 3) * 104 + 88 + (e & 7)] = 0;
    u32x4 pre[3];
    auto tile_geom = [&](int ti, int& seqbase, int& t0, int& T) {
      if (ti < 2) { seqbase = ML + b * 256; T = 256; t0 = (d ? 1 - ti : ti) * 128; }
      else { seqbase = b * 4096; T = 4096; t0 = (d ? 31 - (ti - 2) : (ti - 2)) * 128; }
    };
    auto prefetch = [&](int ti) {
      int seqbase, t0, T; tile_geom(ti, seqbase, t0, T);
#pragma unroll
      for (int i = 0; i < 3; ++i) {
        const int q = tid + NTHR * i;
        const int row = q / 11, cc = q - row * 11, t = t0 - 2 + row;
        u32x4 v = {0u, 0u, 0u, 0u};
        if (q < 131 * 11 && t >= 0 && t < T) v = *(const u32x4*)(XR + (size_t)(seqbase + t) * LW + blk * 88 + cc * 8);
        pre[i] = v;
      }
    };
    prefetch(0);
    for (int ti = 0; ti < 34; ++ti) {
      int seqbase, t0, T; tile_geom(ti, seqbase, t0, T);
      __syncthreads();
#pragma unroll
      for (int i = 0; i < 3; ++i) {
        const int q = tid + NTHR * i;
        if (q < 131 * 11) *(u32x4*)(raw + q * 8) = pre[i];
      }
      if (ti + 1 < 34) prefetch(ti + 1);
      __builtin_amdgcn_sched_barrier(0);
      __syncthreads();
      for (int e = tid; e < 128 * 44; e += NTHR) {
        const int tl = e / 44, c2 = (e - tl * 44) * 2;
        float a0 = cws[4 * 88 + c2], a1 = cws[4 * 88 + c2 + 1];
#pragma unroll
        for (int j = 0; j < 4; ++j) {
          const unsigned x = *(const unsigned*)(raw + (tl + j) * 88 + c2);
          a0 += bf_lo(x) * cws[j * 88 + c2]; a1 += bf_hi(x) * cws[j * 88 + c2 + 1];
        }
        *(unsigned*)(xcT + tl * 104 + c2) = pk_bf16(a0, a1);
      }
      __syncthreads();
      {
        const int tok = wv * 16 + (lane & 15);
        u32x4 af[3];
#pragma unroll
        for (int kk = 0; kk < 3; ++kk) af[kk] = *(const u32x4*)(xcT + tok * 104 + kk * 32 + 8 * (lane >> 4));
#pragma unroll
        for (int n6 = 0; n6 < 6; ++n6) {
          f32x4 accr = {0.f, 0.f, 0.f, 0.f}, acci = {0.f, 0.f, 0.f, 0.f};
          const int ncol = n6 * 16 + (lane & 15);
          const bf16_t* wr_ = wgs + ncol * 104 + 8 * (lane >> 4);
          const bf16_t* wi_ = wgs + (96 + ncol) * 104 + 8 * (lane >> 4);
#pragma unroll
          for (int kk = 0; kk < 3; ++kk) {
            accr = mfma16(af[kk], *(const u32x4*)(wr_ + kk * 32), accr);
            acci = mfma16(af[kk], *(const u32x4*)(wi_ + kk * 32), acci);
          }
          if (ncol < 88) {
            const int ch = blk * 88 + ncol;
            const float gbr = gate_b[(d * 2 + 0) * LW + ch], gbi = gate_b[(d * 2 + 1) * LW + ch];
            const float spl = softplusf_(-lam[d * LW + ch]);
#pragma unroll
            for (int r = 0; r < 4; ++r) {
              const int tk = wv * 16 + (lane >> 4) * 4 + r;
              const float rg = sigmoidf_(accr[r] + gbr), ig = sigmoidf_(acci[r] + gbi);
              const float a = __expf(-8.f * rg * spl);
              const float bb = sqrtf(fmaxf(1.f - a * a, 0.f)) * ig * bf2f(xcT[tk * 104 + ncol]);
              AB[tk * 88 + ncol] = (f32x2){a, bb};
            }
          }
        }
      }
      __syncthreads();
      if (tid < 352) {
        const int seg = tid / 88, c = tid - seg * 88;
        float hl = 0.f, P = 1.f;
        for (int u0 = seg * 32; u0 < seg * 32 + 32; u0 += 8) {
          f32x2 ab[8];
#pragma unroll
          for (int i = 0; i < 8; ++i) { const int tl = d ? 127 - (u0 + i) : (u0 + i); ab[i] = AB[tl * 88 + c]; }
#pragma unroll
          for (int i = 0; i < 8; ++i) { hl = ab[i][0] * hl + ab[i][1]; P *= ab[i][0]; ab[i] = (f32x2){hl, P}; }
#pragma unroll
          for (int i = 0; i < 8; ++i) { const int tl = d ? 127 - (u0 + i) : (u0 + i); AB[tl * 88 + c] = ab[i]; }
        }
        segH[seg * 88 + c] = hl; segP[seg * 88 + c] = P;
      }
      __syncthreads();
      if (tid < 88) {
        float cur = carry;
#pragma unroll
        for (int seg = 0; seg < 4; ++seg) { segC[seg * 88 + tid] = cur; cur = segP[seg * 88 + tid] * cur + segH[seg * 88 + tid]; }
        carry = cur;
      }
      __syncthreads();
      for (int q = tid; q < 128 * 11; q += NTHR) {
        const int tl = q / 11, c8 = (q - tl * 11) * 8;
        const int u = d ? 127 - tl : tl;
        const float* sc = segC + (u >> 5) * 88 + c8;
        float hv[8];
#pragma unroll
        for (int i = 0; i < 8; ++i) { const f32x2 hp = AB[tl * 88 + c8 + i]; hv[i] = hp[0] + hp[1] * sc[i]; }
        *(u32x4*)(HS + (size_t)(seqbase + t0 + tl) * LW + blk * 88 + c8) =
            mk4(pk_bf16(hv[0], hv[1]), pk_bf16(hv[2], hv[3]), pk_bf16(hv[4], hv[5]), pk_bf16(hv[6], hv[7]));
      }
    }
  }
}

__device__ __forceinline__ void lru_z_phase(const bf16_t* __restrict__ HS0, const bf16_t* __restrict__ HS1, bf16_t* __restrict__ GG) {
  const size_t n8 = (size_t)MT * LW / 8;
  for (size_t e = (size_t)blockIdx.x * NTHR + threadIdx.x; e < n8; e += (size_t)gridDim.x * NTHR) {
    const u32x4 a = *(const u32x4*)(HS0 + e * 8), b = *(const u32x4*)(HS1 + e * 8), g = *(const u32x4*)(GG + e * 8);
    u32x4 o;
    o.x = pk_bf16((bf_lo(a.x) + bf_lo(b.x)) * bf_lo(g.x), (bf_hi(a.x) + bf_hi(b.x)) * bf_hi(g.x));
    o.y = pk_bf16((bf_lo(a.y) + bf_lo(b.y)) * bf_lo(g.y), (bf_hi(a.y) + bf_hi(b.y)) * bf_hi(g.y));
    o.z = pk_bf16((bf_lo(a.z) + bf_lo(b.z)) * bf_lo(g.z), (bf_hi(a.z) + bf_hi(b.z)) * bf_hi(g.z));
    o.w = pk_bf16((bf_lo(a.w) + bf_lo(b.w)) * bf_lo(g.w), (bf_hi(a.w) + bf_hi(b.w)) * bf_hi(g.w));
    *(u32x4*)(GG + e * 8) = o;
  }
}

__device__ __forceinline__ void nat_qk_phase(bf16_t* __restrict__ Q, bf16_t* __restrict__ Kb, bf16_t* __restrict__ QR, const float* __restrict__ qk_g) {
  const int tidx = opaque_tid();
  const int lane = tidx & 63;
  const int gw = blockIdx.x * (NTHR / 64) + (tidx >> 6), nw = gridDim.x * (NTHR / 64);
  const int qd = lane & 3;
  float gq[16], gk[16], inv[16];
#pragma unroll
  for (int i = 0; i < 16; ++i) { gq[i] = qk_g[qd * 16 + i]; gk[i] = qk_g[64 + qd * 16 + i]; inv[i] = exp2f(-(float)i * (13.287712379549449f / 16.f)); }
  for (int row = gw; row < MT; row += nw) {
    const bool lat = row < ML;
    const size_t off = (size_t)row * 1024 + lane * 16;
    float cs[16], sn[16];
    if (lat) {
      const int t = row & 4095;
      const float pos = (float)((qd >> 1) ? (t & 63) : (t >> 6));
#pragma unroll
      for (int i = 0; i < 16; ++i) {
        float rev = pos * inv[i] * 0.15915494309189535f;
        rev -= floorf(rev);
        sn[i] = __builtin_amdgcn_sinf(rev); cs[i] = __builtin_amdgcn_cosf(rev);
      }
    }
#pragma unroll
    for (int which = 0; which < 2; ++which) {
      bf16_t* P = which ? Kb : Q;
      const u32x4 a = *(const u32x4*)(P + off), b2 = *(const u32x4*)(P + off + 8);
      const unsigned u[8] = {a.x, a.y, a.z, a.w, b2.x, b2.y, b2.z, b2.w};
      float x[16];
#pragma unroll
      for (int i = 0; i < 8; ++i) { x[2 * i] = bf_lo(u[i]); x[2 * i + 1] = bf_hi(u[i]); }
      float ss = 0.f;
#pragma unroll
      for (int i = 0; i < 16; ++i) ss += x[i] * x[i];
      ss += __shfl_xor(ss, 1); ss += __shfl_xor(ss, 2);
      const float rstd = rsqrtf(ss * (1.f / 64.f) + 1e-6f);
#pragma unroll
      for (int i = 0; i < 16; ++i) x[i] = x[i] * rstd * (which ? gk[i] : gq[i]);
      unsigned pl[8];
#pragma unroll
      for (int i = 0; i < 8; ++i) pl[i] = pk_bf16(x[2 * i], x[2 * i + 1]);
      unsigned rt[8];
      if (lat) {
        float y[16];
#pragma unroll
        for (int i = 0; i < 16; ++i) {
          const float pr = __shfl_xor(x[i], 1);
          y[i] = x[i] * cs[i] + ((qd & 1) ? pr * sn[i] : -pr * sn[i]);
        }
#pragma unroll
        for (int i = 0; i < 8; ++i) rt[i] = pk_bf16(y[2 * i], y[2 * i + 1]);
      }
      if (which == 0) {
        *(u32x4*)(Q + off) = mk4(pl[0], pl[1], pl[2], pl[3]);
        *(u32x4*)(Q + off + 8) = mk4(pl[4], pl[5], pl[6], pl[7]);
        if (lat) { *(u32x4*)(QR + off) = mk4(rt[0], rt[1], rt[2], rt[3]); *(u32x4*)(QR + off + 8) = mk4(rt[4], rt[5], rt[6], rt[7]); }
      } else {
        if (lat) { *(u32x4*)(Kb + off) = mk4(rt[0], rt[1], rt[2], rt[3]); *(u32x4*)(Kb + off + 8) = mk4(rt[4], rt[5], rt[6], rt[7]); }
        else { *(u32x4*)(Kb + off) = mk4(pl[0], pl[1], pl[2], pl[3]); *(u32x4*)(Kb + off + 8) = mk4(pl[4], pl[5], pl[6], pl[7]); }
      }
    }
  }
}

struct AttnState { f32x16 O[2][2]; float m[2], l[2]; };

DEVI void attn_load_k(u32x4 (&kf)[4], const bf16_t* __restrict__ kbase, int lane) {
  const int l31 = lane & 31, lh = lane >> 5;
#pragma unroll
  for (int ks = 0; ks < 4; ++ks) kf[ks] = *(const u32x4*)(kbase + (size_t)l31 * 1024 + ks * 16 + 8 * lh);
}

DEVI void attn_compute(AttnState& st, const u32x4* qs, const bf16_t* __restrict__ kbase, const bf16_t* __restrict__ vtbase, int vtT,
                       const float* __restrict__ rpbs, bool band, int brow, int half, int lane) {
  const int l31 = lane & 31, lh = lane >> 5;
  u32x4 kf[4];
  attn_load_k(kf, kbase, lane);
  u32x4 vf[4];
#pragma unroll
  for (int dt = 0; dt < 2; ++dt)
#pragma unroll
    for (int s = 0; s < 2; ++s) {
      const bf16_t* vp = vtbase + (size_t)(dt * 32 + l31) * vtT + 16 * s + 4 * lh;
      const u32x2 lo = *(const u32x2*)vp, hi = *(const u32x2*)(vp + 8);
      vf[dt * 2 + s] = mk4(lo.x, lo.y, hi.x, hi.y);
    }
  __builtin_amdgcn_sched_barrier(0);
  constexpr float SC = 0.125f * 1.4426950408889634f;
  u32x4 pf[2][2];
#pragma unroll
  for (int qt = 0; qt < 2; ++qt) {
    f32x16 S;
#pragma unroll
    for (int r = 0; r < 16; ++r) S[r] = 0.f;
#pragma unroll
    for (int ks = 0; ks < 4; ++ks) S = mfma32(kf[ks], qs[(qt * 4 + ks) * 64], S);
    float cmax = -INFINITY;
    if (band) {
      const int qc = qt * 32 + l31;
      const int cst = min(max(qc - 8, 0), 48);
#pragma unroll
      for (int r = 0; r < 16; ++r) {
        const int key = (r & 3) + 8 * (r >> 2) + 4 * lh;
        const int kc = half * 32 + key;
        const bool ok = (kc >= cst) && (kc < cst + 16);
        const int bi = ok ? (brow * 31 + kc - qc + 15) : 0;
        const float sv = S[r] * SC + rpbs[bi];
        S[r] = ok ? sv : -INFINITY;
        cmax = fmaxf(cmax, S[r]);
      }
    } else {
#pragma unroll
      for (int r = 0; r < 16; ++r) { S[r] *= SC; cmax = fmaxf(cmax, S[r]); }
    }
    cmax = fmaxf(cmax, __shfl_xor(cmax, 32));
    const float mnew = fmaxf(st.m[qt], cmax);
    const float alpha = __builtin_amdgcn_exp2f(st.m[qt] - mnew);
    const bool grew = mnew > st.m[qt];
    st.m[qt] = mnew;
    float ps = 0.f;
#pragma unroll
    for (int r = 0; r < 16; ++r) { S[r] = __builtin_amdgcn_exp2f(S[r] - mnew); ps += S[r]; }
    st.l[qt] = st.l[qt] * alpha + ps;
    if (__any(grew)) {
#pragma unroll
      for (int dt = 0; dt < 2; ++dt)
#pragma unroll
        for (int r = 0; r < 16; ++r) st.O[qt][dt][r] *= alpha;
    }
    pf[qt][0] = mk4(pk_bf16(S[0], S[1]), pk_bf16(S[2], S[3]), pk_bf16(S[4], S[5]), pk_bf16(S[6], S[7]));
    pf[qt][1] = mk4(pk_bf16(S[8], S[9]), pk_bf16(S[10], S[11]), pk_bf16(S[12], S[13]), pk_bf16(S[14], S[15]));
  }
#pragma unroll
  for (int dt = 0; dt < 2; ++dt)
#pragma unroll
    for (int s = 0; s < 2; ++s) {
      st.O[0][dt] = mfma32(vf[dt * 2 + s], pf[0][s], st.O[0][dt]);
      st.O[1][dt] = mfma32(vf[dt * 2 + s], pf[1][s], st.O[1][dt]);
    }
}

__device__ __forceinline__ void natten_phase(char* lds, const bf16_t* __restrict__ Q, const bf16_t* __restrict__ QR, const bf16_t* __restrict__ Kb,
                             const bf16_t* __restrict__ VT, bf16_t* __restrict__ G, const float* __restrict__ rpb, bf16_t* __restrict__ Zd) {
  float* rpbs = (float*)lds;
  __syncthreads();
  for (int e = threadIdx.x; e < 16 * 465; e += NTHR) rpbs[e] = rpb[e] * 1.4426950408889634f;
  __syncthreads();
  const int tidx = opaque_tid();
  const int lane = tidx & 63, l31 = lane & 31, lh = lane >> 5;
  const int gw = blockIdx.x * (NTHR / 64) + (tidx >> 6), nw = gridDim.x * (NTHR / 64);
  const bf16_t* VTC = VT + (size_t)ML * 1024;
  u32x4* qs = (u32x4*)(lds + 32768) + (tidx >> 6) * 512 + lane;
  const int xcd = blockIdx.x & 7, wx = (blockIdx.x >> 3) * (NTHR / 64) + (tidx >> 6), nwx = (gridDim.x >> 3) * (NTHR / 64);
  for (int i = wx; i < 1024 + 64; i += nwx) {
    const bool lat = i < 1024;
    int b, h, r = 0, qrow0;
    if (lat) { const int pair = xcd * 16 + (i >> 6); r = i & 63; b = pair >> 4; h = pair & 15; qrow0 = b * 4096 + r * 64; }
    else { const int it = i - 1024; const int pair = xcd * 16 + (it >> 2); const int qt64 = it & 3; b = pair >> 4; h = pair & 15; qrow0 = ML + b * 256 + qt64 * 64; }
    const int start = min(max(r - 4, 0), 56);
    const int nchunks = lat ? 24 : 8;
    AttnState st;
#pragma unroll
    for (int a = 0; a < 2; ++a) { st.m[a] = -INFINITY; st.l[a] = 0.f;
#pragma unroll
      for (int c = 0; c < 2; ++c)
#pragma unroll
        for (int rr = 0; rr < 16; ++rr) st.O[a][c][rr] = 0.f; }
#pragma unroll
    for (int qt = 0; qt < 2; ++qt)
#pragma unroll
      for (int ks = 0; ks < 4; ++ks) qs[(qt * 4 + ks) * 64] = *(const u32x4*)(Q + (size_t)(qrow0 + qt * 32 + l31) * 1024 + h * 64 + ks * 16 + 8 * lh);
    for (int j = 0; j < nchunks; ++j) {
      if (j == 8) {
#pragma unroll
        for (int qt = 0; qt < 2; ++qt)
#pragma unroll
          for (int ks = 0; ks < 4; ++ks) qs[(qt * 4 + ks) * 64] = *(const u32x4*)(QR + (size_t)(qrow0 + qt * 32 + l31) * 1024 + h * 64 + ks * 16 + 8 * lh);
      }
      if (j < 8) {
        const bf16_t* kbase = Kb + (size_t)(ML + b * 256 + j * 32) * 1024 + h * 64;
        const bf16_t* vtb = VTC + (size_t)(b * 16 + h) * 64 * 256 + j * 32;
        attn_compute(st, qs, kbase, vtb, 256, rpbs, false, 0, 0, lane);
      } else {
        const int ii = j - 8, kr = start + (ii >> 1), half = ii & 1;
        const bf16_t* kbase = Kb + (size_t)(b * 4096 + kr * 64 + half * 32) * 1024 + h * 64;
        const bf16_t* vtb = VT + (size_t)(b * 16 + h) * 64 * 4096 + kr * 64 + half * 32;
        attn_compute(st, qs, kbase, vtb, 4096, rpbs, true, h * 15 + (kr - r + 7), half, lane);
      }
    }
#pragma unroll
    for (int qt = 0; qt < 2; ++qt) {
      const float lt = st.l[qt] + __shfl_xor(st.l[qt], 32);
      const float inv = 1.f / lt;
      bf16_t* grow = G + (size_t)(qrow0 + qt * 32 + l31) * 1024 + h * 64;
#pragma unroll
      for (int dt = 0; dt < 2; ++dt)
#pragma unroll
        for (int q4 = 0; q4 < 4; ++q4) {
          bf16_t* gp = grow + dt * 32 + 8 * q4 + 4 * lh;
          bf16_t* zp = Zd + (gp - G);
          const u32x2 gv = *(const u32x2*)gp;
          u32x2 o;
          o.x = pk_bf16(st.O[qt][dt][4 * q4] * inv * bf_lo(gv.x), st.O[qt][dt][4 * q4 + 1] * inv * bf_hi(gv.x));
          o.y = pk_bf16(st.O[qt][dt][4 * q4 + 2] * inv * bf_lo(gv.y), st.O[qt][dt][4 * q4 + 3] * inv * bf_hi(gv.y));
          *(u32x2*)zp = o;
        }
    }
  }
}

template <int ph>
__device__ __forceinline__ void run_phase(const Params& p, char* lds, bool last_rep) {
  char* ws = p.ws;
  const float* MOD = (const float*)(ws + OFF_MOD);
  float* XC = (float*)(ws + OFF_XC);
  bf16_t* HB = (bf16_t*)(ws + OFF_HB);
  bf16_t* A0 = (bf16_t*)(ws + OFF_A0); bf16_t* A1 = (bf16_t*)(ws + OFF_A1); bf16_t* A2 = (bf16_t*)(ws + OFF_A2);
  bf16_t* A3 = (bf16_t*)(ws + OFF_A3); bf16_t* A4 = (bf16_t*)(ws + OFF_A4);
  bf16_t* WD = (bf16_t*)(ws + OFF_WD); bf16_t* AD = (bf16_t*)(ws + OFF_AD);
  float* BON = (float*)(ws + OFF_BON);
  if (ph == 0) { phase0(p, lds); return; }
  constexpr int layer = (ph - 1) / 5, sub = (ph - 1) % 5;
  const float* modL = MOD + (size_t)layer * 9 * 3072;
  const float* xl_cur = layer == 0 ? p.in[0] : p.out;
  const float* xc_cur = layer == 0 ? p.in[2] : XC;
  if (layer == 0 || layer == 3) {
    const int ib = layer ? 33 : 4;
    const bf16_t* WIN = (const bf16_t*)(ws + (layer ? OFF_W3IN : OFF_W0IN));
    const bf16_t* WUP = (const bf16_t*)(ws + (layer ? OFF_W3UP : OFF_W0UP));
    const bf16_t* WOUT = (const bf16_t*)(ws + (layer ? OFF_W3OUT : OFF_W0OUT));
    if (sub == 0) norm_phase<true>(xl_cur, xc_cur, p.in[ib], modL, HB, A4);
    else if (sub == 1) { ALMix al{HB, A4, p.in[ib + 4]}; EpRwkvIn ep{A0, A1, A2, A3, WD, AD}; gemm256_phase(lds, WIN, 1024, MT / 256, 16, al, ep); gemm_phase(lds, WIN, 1024, MT / 256, 2, al, ep, 4096, true); }
    else if (sub == 2) rwkv_scan_phase(lds, A0, A1, A2, WD, AD, WUP, p.in[ib + 5], p.in[ib + 8], p.in[ib + 9], HB, A4, BON);
    else if (sub == 3) rwkv_post_phase(HB, A4, A2, A3, BON, p.in[ib + 10], layer == 3 ? ML : MT);
    else { ALPlain al{A3, 1024}; EpRes ep{xl_cur, xc_cur, p.out, XC, modL}; gemm256_phase(lds, WOUT, 1024, ML / 256, 4, al, ep); if (layer != 3) gemm_phase(lds, WOUT, 1024, MC / 256, 8, al, ep, 0, false, ML / 256); }
  } else if (layer == 1) {
    bf16_t* HS0 = (bf16_t*)(ws + OFF_HS0); bf16_t* XR = (bf16_t*)(ws + OFF_XR); bf16_t* GG = (bf16_t*)(ws + OFF_GG); bf16_t* HS1 = (bf16_t*)(ws + OFF_HS1);
    if (sub == 0) norm_phase<false>(xl_cur, xc_cur, p.in[16], modL, HB, nullptr);
    else if (sub == 1) { ALPlain al{HB, 1024}; EpLruIn ep{XR, GG}; gemm256_phase(lds, (const bf16_t*)(ws + OFF_W1IN), 1024, MT / 256, 11, al, ep); }
    else if (sub == 2) rglru_phase(lds, XR, (const bf16_t*)(ws + OFF_W1G), p.in[20], p.in[21], p.in[23], p.in[24], HS0, HS1);
    else if (sub == 3) lru_z_phase(HS0, HS1, GG);
    else { ALPlain al{GG, LW}; EpRes ep{xl_cur, xc_cur, p.out, XC, modL}; gemm256_phase(lds, (const bf16_t*)(ws + OFF_W1OUT), LW, ML / 256, 4, al, ep); gemm_phase(lds, (const bf16_t*)(ws + OFF_W1OUT), LW, MC / 256, 8, al, ep, 0, false, ML / 256); }
  } else {
    if (sub == 0) norm_phase<false>(xl_cur, xc_cur, p.in[26], modL, HB, nullptr);
    else if (sub == 1) { ALPlain al{HB, 1024}; EpNatIn ep{A0, A1, A2, A3}; gemm256_phase(lds, (const bf16_t*)(ws + OFF_W2IN), 1024, MT / 256, 16, al, ep); }
    else if (sub == 2) nat_qk_phase(A0, A1, A4, p.in[30]);
    else if (sub == 3) natten_phase(lds, A0, A4, A1, A2, A3, p.in[31], last_rep ? A3 : HB);
    else { ALPlain al{A3, 1024}; EpRes ep{xl_cur, xc_cur, p.out, XC, modL}; gemm256_phase(lds, (const bf16_t*)(ws + OFF_W2OUT), 1024, ML / 256, 4, al, ep); gemm_phase(lds, (const bf16_t*)(ws + OFF_W2OUT), 1024, MC / 256, 8, al, ep, 0, false, ML / 256); }
  }
}

__global__ void __launch_bounds__(NTHR) mega_kernel(Params p) {
  __shared__ __attribute__((aligned(16))) char lds[LDS_BYTES];
  __shared__ u32x4 xb_words;
  cg::grid_group grid = cg::this_grid();
  if (threadIdx.x == 0) xb_words = (u32x4){0u, 0u, 0u, 0u};
  __syncthreads();
  const XcdBarrier xb = xcd_barrier_post((unsigned*)(p.ws + OFF_BAR), (volatile LAS unsigned*)&xb_words);
#define PHASE(k) if (p.ph_lo <= k && k < p.ph_hi) { for (int rep = 0; rep < REP[k]; ++rep) { run_phase<k>(p, lds, rep + 1 == REP[k]); if (rep + 1 < REP[k] || k + 1 < p.ph_hi) { if (k == 0) grid.sync(); else xcd_barrier(xb); } } }
  PHASE(0) PHASE(1) PHASE(2) PHASE(3) PHASE(4) PHASE(5) PHASE(6) PHASE(7) PHASE(8) PHASE(9) PHASE(10)
  PHASE(11) PHASE(12) PHASE(13) PHASE(14) PHASE(15) PHASE(16) PHASE(17) PHASE(18) PHASE(19) PHASE(20)
#undef PHASE
}

extern "C" void kernel_launch(void* const* d_in, const int* in_sizes, int n_in, void* d_out, int out_size, void* d_ws, size_t ws_size,
                              hipStream_t stream) {
  static int grid_blocks = 0;
  if (!grid_blocks) {
    int dev = 0, cus = 0, per_cu = 0;
    hipGetDevice(&dev);
    hipDeviceGetAttribute(&cus, hipDeviceAttributeMultiprocessorCount, dev);
    hipOccupancyMaxActiveBlocksPerMultiprocessor(&per_cu, mega_kernel, NTHR, 0);
    if (per_cu < 1) { fprintf(stderr, "occupancy query returned %d\n", per_cu); per_cu = 1; }
    if (per_cu > 1) per_cu = 1;
    grid_blocks = cus * per_cu;
    if (n_in != 45 || ws_size < WS_END) fprintf(stderr, "unexpected n_in %d / ws %zu (need %zu)\n", n_in, ws_size, (size_t)WS_END);
  }
  Params p{};
  for (int i = 0; i < 45; ++i) p.in[i] = (const float*)d_in[i];
  p.out = (float*)d_out;
  p.ws = (char*)d_ws;
  (void)hipMemsetAsync((char*)d_ws + OFF_BAR, 0, XCD_BAR_WORDS * 4, stream);
#if N_LAUNCH_MODE == 1
  p.ph_lo = 0; p.ph_hi = NPHASE;
  void* args[] = {&p};
  hipError_t e = hipLaunchCooperativeKernel((void*)mega_kernel, dim3(grid_blocks), dim3(NTHR), args, 0, stream);
  if (e != hipSuccess) fprintf(stderr, "cooperative launch failed: %s (grid %d)\n", hipGetErrorString(e), grid_blocks);
#else
  for (int ph = 0; ph < NPHASE; ++ph) {
    p.ph_lo = ph; p.ph_hi = ph + 1;
    hipLaunchKernelGGL(mega_kernel, dim3(grid_blocks), dim3(NTHR), 0, stream, p);
  }
#endif
}
```

```cpp
#include <hip/hip_runtime.h>
#include <hip/hip_cooperative_groups.h>
#include <cstdio>
#include <cstdint>
namespace cg = cooperative_groups;

#ifndef N_LAUNCH_MODE
#define N_LAUNCH_MODE 1
#endif

typedef unsigned short bf16_t;
typedef short bf16x8 __attribute__((ext_vector_type(8)));
typedef float f32x4 __attribute__((ext_vector_type(4)));
typedef float f32x16 __attribute__((ext_vector_type(16)));
typedef float f32x2 __attribute__((ext_vector_type(2)));
typedef unsigned u32x4 __attribute__((ext_vector_type(4)));
typedef unsigned u32x2 __attribute__((ext_vector_type(2)));

#define DEVI __device__ __forceinline__

constexpr int D = 1024, NB = 8, SEQ = 4096, CTX = 256;
constexpr int ML = NB * SEQ;
constexpr int MC = NB * CTX;
constexpr int MT = ML + MC;
constexpr int LW = 1408;
constexpr int NTHR = 512;
constexpr int NPHASE = 21;
constexpr int LDS_BYTES = 163840 - 16;
__device__ constexpr int REP[21] = {1,1,1,1,1,1,1,1,1,1,1,1,1,1,1,1,1,1,1,1,1};

constexpr size_t SZ_ACT = (size_t)MT * 1024 * 2;
constexpr size_t OFF_MOD = 0;
constexpr size_t OFF_BAR = 458752;
constexpr size_t OFF_W0IN = 524288;
constexpr size_t SZ_RWIN = (size_t)4352 * 1024 * 2;
constexpr size_t SZ_RWUP = (size_t)4 * 1024 * 64 * 2;
constexpr size_t SZ_SQ = (size_t)1024 * 1024 * 2;
constexpr size_t OFF_W0UP = OFF_W0IN + SZ_RWIN;
constexpr size_t OFF_W0OUT = OFF_W0UP + SZ_RWUP;
constexpr size_t OFF_W3IN = OFF_W0OUT + SZ_SQ;
constexpr size_t OFF_W3UP = OFF_W3IN + SZ_RWIN;
constexpr size_t OFF_W3OUT = OFF_W3UP + SZ_RWUP;
constexpr size_t OFF_W1IN = OFF_W3OUT + SZ_SQ;
constexpr size_t OFF_W1G = OFF_W1IN + (size_t)2816 * 1024 * 2;
constexpr size_t OFF_W1OUT = OFF_W1G + (size_t)16 * 4 * 96 * 96 * 2;
constexpr size_t OFF_W2IN = OFF_W1OUT + (size_t)1024 * 1408 * 2;
constexpr size_t OFF_W2OUT = OFF_W2IN + (size_t)4096 * 1024 * 2;
constexpr size_t OFF_XC = OFF_W2OUT + SZ_SQ;
constexpr size_t OFF_BON = OFF_XC + (size_t)MC * 1024 * 4;
constexpr size_t OFF_BIG = OFF_BON + (size_t)2 * MT * 16 * 4;
constexpr size_t OFF_HB = OFF_BIG;
constexpr size_t OFF_A0 = OFF_BIG + SZ_ACT;
constexpr size_t OFF_A1 = OFF_A0 + SZ_ACT;
constexpr size_t OFF_A2 = OFF_A1 + SZ_ACT;
constexpr size_t OFF_A3 = OFF_A2 + SZ_ACT;
constexpr size_t OFF_A4 = OFF_A3 + SZ_ACT;
constexpr size_t OFF_WD = OFF_A4 + SZ_ACT;
constexpr size_t OFF_AD = OFF_WD + (size_t)MT * 128 * 2;
constexpr size_t WS_END = OFF_AD + (size_t)MT * 128 * 2;
constexpr size_t SZ_LRU = (size_t)MT * LW * 2;
constexpr size_t OFF_HS0 = OFF_BIG;
constexpr size_t OFF_XR = OFF_BIG + SZ_LRU;
constexpr size_t OFF_GG = OFF_XR + SZ_LRU;
constexpr size_t OFF_HS1 = OFF_GG + SZ_LRU;
static_assert(OFF_HS1 + SZ_LRU <= WS_END, "lru overlay");
static_assert(WS_END <= (size_t)536870912, "ws");

struct Params {
  const float* in[45];
  float* out;
  char* ws;
  int ph_lo, ph_hi;
};

DEVI u32x4 mk4(unsigned a, unsigned b, unsigned c, unsigned d) { u32x4 r = {a, b, c, d}; return r; }
DEVI int opaque_tid() { int t = threadIdx.x; asm volatile("" : "+v"(t)); return t; }
DEVI float bf_lo(unsigned u) { return __uint_as_float(u << 16); }
DEVI float bf_hi(unsigned u) { return __uint_as_float(u & 0xffff0000u); }
DEVI float bf2f(bf16_t h) { return __uint_as_float(((unsigned)h) << 16); }
typedef __bf16 bf16x2_t __attribute__((ext_vector_type(2)));
DEVI unsigned pk_bf16(float lo, float hi) { f32x2 f = {lo, hi}; bf16x2_t v = __builtin_convertvector(f, bf16x2_t); return __builtin_bit_cast(unsigned, v); }
DEVI bf16_t f2bf(float f) { return (bf16_t)(pk_bf16(f, 0.f) & 0xffffu); }
DEVI float wave_sum(float v) {
#pragma unroll
  for (int o = 32; o; o >>= 1) v += __shfl_xor(v, o);
  return v;
}
DEVI float sigmoidf_(float x) { return __builtin_amdgcn_rcpf(1.f + __expf(-x)); }
DEVI float siluf_(float x) { return x * __builtin_amdgcn_rcpf(1.f + __expf(-x)); }
DEVI float softplusf_(float x) { return fmaxf(x, 0.f) + __logf(1.f + __expf(-fabsf(x))); }
DEVI f32x16 mfma32(u32x4 a, u32x4 b, f32x16 c) {
  return __builtin_amdgcn_mfma_f32_32x32x16_bf16(__builtin_bit_cast(bf16x8, a), __builtin_bit_cast(bf16x8, b), c, 0, 0, 0);
}
DEVI f32x4 mfma16(u32x4 a, u32x4 b, f32x4 c) {
  return __builtin_amdgcn_mfma_f32_16x16x32_bf16(__builtin_bit_cast(bf16x8, a), __builtin_bit_cast(bf16x8, b), c, 0, 0, 0);
}
template <int CTRL> DEVI float dpp_f(float v) {
  return __int_as_float(__builtin_amdgcn_update_dpp(0, __float_as_int(v), CTRL, 0xf, 0xf, true));
}
DEVI float sum8(float v) {
  v += dpp_f<0xB1>(v);
  v += dpp_f<0x4E>(v);
  v += dpp_f<0x141>(v);
  return v;
}

#define XB_TMO      128
#define XB_XCNT(j)  (256  + 64 * (j))
#define XB_XSUB(j)  (1280 + 64 * (j))
#define XB_XGEN(j)  (2304 + 64 * (j))
#define XB_TOP      3328
#define XB_TOPGEN   3392
#define XCD_BAR_WORDS 3456
#define XB_SPIN_CAP (1u << 18)
#define LAS __attribute__((address_space(3)))

__device__ __forceinline__ unsigned xb_ld(unsigned* p)              { return __hip_atomic_load(p, __ATOMIC_RELAXED, __HIP_MEMORY_SCOPE_AGENT); }
__device__ __forceinline__ unsigned xb_add(unsigned* p, unsigned v) { return __hip_atomic_fetch_add(p, v, __ATOMIC_RELAXED, __HIP_MEMORY_SCOPE_AGENT); }
__device__ __forceinline__ unsigned xb_xcc_id() { return (unsigned)__builtin_amdgcn_s_getreg((3 << 11) | 20) & 0xFu; }
#define XB_SPIN(cond, bar) do { unsigned _sp = 0; while (cond) { __builtin_amdgcn_s_sleep(1); \
    if ((++_sp & 255u) == 0u) { if (xb_ld(&(bar)[XB_TMO])) break; if (_sp > XB_SPIN_CAP) { atomicAdd(&(bar)[XB_TMO], 1u); break; } } } } while (0)

struct XcdBarrier {
    unsigned* bar; unsigned x;
    volatile LAS unsigned* st;
};

__device__ __forceinline__ XcdBarrier xcd_barrier_post(unsigned* bar, volatile LAS unsigned* st) {
    XcdBarrier b; b.bar = bar; b.x = xb_xcc_id(); b.st = st;
    if (threadIdx.x == 0) (void)xb_add(&bar[XB_XCNT(b.x)], 1u);
    return b;
}
__device__ __forceinline__ void xcd_barrier_complete(unsigned* bar, unsigned x, unsigned& nloc, unsigned& nx) {
    const unsigned G = gridDim.x * gridDim.y * gridDim.z;
    unsigned sum, cnt, mine, sp = 0u;
    for (;;) {
        sum = 0u; cnt = 0u; mine = 0u;
#pragma unroll
        for (unsigned j = 0; j < 16; ++j) { const unsigned c = xb_ld(&bar[XB_XCNT(j)]); sum += c; cnt += (c > 0u) ? 1u : 0u; mine = (j == x) ? c : mine; }
        if (sum == G) break;
        __builtin_amdgcn_s_sleep(1);
        if ((++sp & 255u) == 0u) { if (xb_ld(&bar[XB_TMO])) break; if (sp > XB_SPIN_CAP) { atomicAdd(&bar[XB_TMO], 1u); break; } }
    }
    nloc = mine > 0u ? mine : 1u; nx = cnt > 0u ? cnt : 1u;
}

__device__ __forceinline__ void xcd_barrier(const XcdBarrier& b) {
    asm volatile("s_waitcnt vmcnt(0)" ::: "memory");
    __syncthreads();
    if (threadIdx.x == 0) {
        unsigned* bar = b.bar;
        __builtin_amdgcn_s_waitcnt(0);
        unsigned nloc = b.st[0], nx = b.st[1];
        if (nloc == 0u) { xcd_barrier_complete(bar, b.x, nloc, nx); b.st[0] = nloc; b.st[1] = nx; }
        const unsigned old = xb_add(&bar[XB_XSUB(b.x)], 1u);
        const unsigned gen = old / nloc;
        if (old + 1u == (gen + 1u) * nloc) {
            __builtin_amdgcn_fence(__ATOMIC_RELEASE, "agent");
            asm volatile("s_waitcnt vmcnt(0)" ::: "memory");
            const unsigned og = xb_add(&bar[XB_TOP], 1u);
            const unsigned tg = og / nx;
            if (og + 1u == (tg + 1u) * nx) xb_add(&bar[XB_TOPGEN], 1u);
            else XB_SPIN(xb_ld(&bar[XB_TOPGEN]) == tg, bar);
            __builtin_amdgcn_fence(__ATOMIC_ACQUIRE, "agent");
            xb_add(&bar[XB_XGEN(b.x)], 1u);
            asm volatile("s_waitcnt vmcnt(0)" ::: "memory");
        } else {
            XB_SPIN(xb_ld(&bar[XB_XGEN(b.x)]) == gen, bar);
            __builtin_amdgcn_fence(__ATOMIC_ACQUIRE, "agent");
            asm volatile("s_waitcnt vmcnt(0)" ::: "memory");
        }
    }
    __syncthreads();
}


struct TJob { const float* src; int K, N; bf16_t* dst; int ldd; };

DEVI TJob get_tjob(const Params& p, int j) {
  TJob t;
  if (j < 26) {
    const int l = j / 13, jj = j % 13;
    const int ib = l ? 33 : 4;
    bf16_t* win = (bf16_t*)(p.ws + (l ? OFF_W3IN : OFF_W0IN));
    bf16_t* wup = (bf16_t*)(p.ws + (l ? OFF_W3UP : OFF_W0UP));
    bf16_t* wout = (bf16_t*)(p.ws + (l ? OFF_W3OUT : OFF_W0OUT));
    if (jj < 4) { t.src = p.in[ib + 3] + (size_t)jj * 1048576; t.K = 1024; t.N = 1024; t.dst = win + (size_t)jj * 1048576; t.ldd = 1024; }
    else if (jj < 8) { const int idx = jj - 4, d = idx >> 1, kind = idx & 1;
      t.src = p.in[ib + 6] + (size_t)idx * 65536; t.K = 1024; t.N = 64; t.dst = win + (size_t)(4096 + kind * 128 + d * 64) * 1024; t.ldd = 1024; }
    else if (jj < 12) { const int idx = jj - 8;
      t.src = p.in[ib + 7] + (size_t)idx * 65536; t.K = 64; t.N = 1024; t.dst = wup + (size_t)idx * 65536; t.ldd = 64; }
    else { t.src = p.in[ib + 11]; t.K = 1024; t.N = 1024; t.dst = wout; t.ldd = 1024; }
  } else if (j == 26) { t.src = p.in[19]; t.K = 1024; t.N = 2816; t.dst = (bf16_t*)(p.ws + OFF_W1IN); t.ldd = 1024; }
  else if (j == 27) { t.src = p.in[25]; t.K = 1408; t.N = 1024; t.dst = (bf16_t*)(p.ws + OFF_W1OUT); t.ldd = 1408; }
  else if (j == 28) { t.src = p.in[29]; t.K = 1024; t.N = 4096; t.dst = (bf16_t*)(p.ws + OFF_W2IN); t.ldd = 1024; }
  else { t.src = p.in[32]; t.K = 1024; t.N = 1024; t.dst = (bf16_t*)(p.ws + OFF_W2OUT); t.ldd = 1024; }
  return t;
}

__device__ __forceinline__ void phase0(const Params& p, char* lds) {
  const int tid = opaque_tid();
  {
    bf16_t* wg = (bf16_t*)(p.ws + OFF_W1G);
    const float* gw = p.in[22];
    const int total = 16 * 4 * 96 * 96;
    for (int e = blockIdx.x * NTHR + tid; e < total; e += gridDim.x * NTHR) {
      const int k = e % 96, n = (e / 96) % 96, dg = (e / 9216) & 3, blk = e / 36864;
      float v = 0.f;
      if (k < 88 && n < 88) v = gw[((size_t)(dg * 16 + blk) * 88 + k) * 88 + n];
      wg[e] = f2bf(v);
    }
  }
  constexpr int N_MOD_ITEMS = 96;
  constexpr int N_TILES = 5152;
  float* act = (float*)lds;
  float* red = (float*)(lds + 36864);
  float* tl = (float*)lds;
  for (int item = blockIdx.x; item < N_MOD_ITEMS; item += gridDim.x) {
    __syncthreads();
    {
      const int L = item / 24, nc = item % 24;
      const int ib = (L == 0) ? 4 : (L == 1) ? 16 : (L == 2) ? 26 : 33;
      const float* ada_w = p.in[ib + 1];
      const float* ada_b = p.in[ib + 2];
      for (int e = tid; e < 9 * 1024; e += NTHR) {
        const int i = e >> 10, k = e & 1023;
        const float c = (i < 8) ? p.in[1][i * 1024 + k] : p.in[3][k];
        act[e] = siluf_(c);
      }
      __syncthreads();
      const int kq = tid >> 7, nl = tid & 127, n = nc * 128 + nl;
      float acc[9];
#pragma unroll
      for (int i = 0; i < 9; ++i) acc[i] = 0.f;
      for (int k0 = kq * 256; k0 < kq * 256 + 256; k0 += 16) {
        float w[16];
#pragma unroll
        for (int u = 0; u < 16; ++u) w[u] = ada_w[(size_t)(k0 + u) * 3072 + n];
#pragma unroll
        for (int u = 0; u < 16; ++u)
#pragma unroll
          for (int i = 0; i < 9; ++i) acc[i] += act[i * 1024 + k0 + u] * w[u];
      }
#pragma unroll
      for (int i = 0; i < 9; ++i) red[(kq * 9 + i) * 128 + nl] = acc[i];
      __syncthreads();
      float* mod = (float*)(p.ws + OFF_MOD) + (size_t)L * 9 * 3072;
      for (int e = tid; e < 9 * 128; e += NTHR) {
        const int i = e >> 7, c = e & 127;
        const float s = red[(0 * 9 + i) * 128 + c] + red[(1 * 9 + i) * 128 + c] + red[(2 * 9 + i) * 128 + c] + red[(3 * 9 + i) * 128 + c];
        mod[i * 3072 + nc * 128 + c] = s + ada_b[nc * 128 + c];
      }
    }
  }
  {
    struct TileRef { const float* src; bf16_t* dst; int N, ldd, k0, n0; };
    auto decode = [&](int t, TileRef& r) {
      int j = 0;
      TJob job = get_tjob(p, 0);
      for (;;) {
        const int nt = (job.K >> 6) * (job.N >> 6);
        if (t < nt) break;
        t -= nt; ++j; job = get_tjob(p, j);
      }
      const int ntn = job.N >> 6;
      r.src = job.src; r.dst = job.dst; r.N = job.N; r.ldd = job.ldd; r.k0 = (t / ntn) * 64; r.n0 = (t % ntn) * 64;
    };
    const int kk = tid >> 4, n4 = (tid & 15) * 4;
    int t = (int)(gridDim.x - 1 - blockIdx.x);
    TileRef cur, nxt;
    float4 v0 = make_float4(0.f, 0.f, 0.f, 0.f), v1 = v0;
    if (t < N_TILES) {
      decode(t, cur);
      v0 = *(const float4*)(cur.src + (size_t)(cur.k0 + kk) * cur.N + cur.n0 + n4);
      v1 = *(const float4*)(cur.src + (size_t)(cur.k0 + kk + 32) * cur.N + cur.n0 + n4);
    }
    while (t < N_TILES) {
      const int tn = t + (int)gridDim.x;
      float4 w0 = v0, w1 = v1;
      if (tn < N_TILES) {
        decode(tn, nxt);
        w0 = *(const float4*)(nxt.src + (size_t)(nxt.k0 + kk) * nxt.N + nxt.n0 + n4);
        w1 = *(const float4*)(nxt.src + (size_t)(nxt.k0 + kk + 32) * nxt.N + nxt.n0 + n4);
      }
      __builtin_amdgcn_sched_barrier(0);
      __syncthreads();
      tl[kk * 65 + n4 + 0] = v0.x; tl[kk * 65 + n4 + 1] = v0.y; tl[kk * 65 + n4 + 2] = v0.z; tl[kk * 65 + n4 + 3] = v0.w;
      tl[(kk + 32) * 65 + n4 + 0] = v1.x; tl[(kk + 32) * 65 + n4 + 1] = v1.y; tl[(kk + 32) * 65 + n4 + 2] = v1.z; tl[(kk + 32) * 65 + n4 + 3] = v1.w;
      __syncthreads();
      const int n = tid >> 3, k8 = (tid & 7) * 8;
      u32x4 o;
      o.x = pk_bf16(tl[(k8 + 0) * 65 + n], tl[(k8 + 1) * 65 + n]);
      o.y = pk_bf16(tl[(k8 + 2) * 65 + n], tl[(k8 + 3) * 65 + n]);
      o.z = pk_bf16(tl[(k8 + 4) * 65 + n], tl[(k8 + 5) * 65 + n]);
      o.w = pk_bf16(tl[(k8 + 6) * 65 + n], tl[(k8 + 7) * 65 + n]);
      *(u32x4*)(cur.dst + (size_t)(cur.n0 + n) * cur.ldd + cur.k0 + k8) = o;
      v0 = w0; v1 = w1; cur = nxt; t = tn;
    }
  }
}

DEVI void norm_row(const float* __restrict__ xr, const float* __restrict__ g, const float* __restrict__ mod, int lane, float (&h)[16]) {
  float4 x[4];
  float ss = 0.f;
#pragma unroll
  for (int i = 0; i < 4; ++i) {
    x[i] = *(const float4*)(xr + lane * 4 + 256 * i);
    ss += x[i].x * x[i].x + x[i].y * x[i].y + x[i].z * x[i].z + x[i].w * x[i].w;
  }
  ss = wave_sum(ss);
  const float rstd = rsqrtf(ss * (1.f / 1024.f) + 1e-6f);
#pragma unroll
  for (int i = 0; i < 4; ++i) {
    const int c = lane * 4 + 256 * i;
    const float4 gg = *(const float4*)(g + c);
    const float4 sh = *(const float4*)(mod + c);
    const float4 sc = *(const float4*)(mod + 1024 + c);
    h[i * 4 + 0] = x[i].x * rstd * gg.x * (1.f + sc.x) + sh.x;
    h[i * 4 + 1] = x[i].y * rstd * gg.y * (1.f + sc.y) + sh.y;
    h[i * 4 + 2] = x[i].z * rstd * gg.z * (1.f + sc.z) + sh.z;
    h[i * 4 + 3] = x[i].w * rstd * gg.w * (1.f + sc.w) + sh.w;
  }
}

template <bool WITH_HS>
__device__ __forceinline__ void norm_phase(const float* __restrict__ xl, const float* __restrict__ xc, const float* __restrict__ g,
                           const float* __restrict__ modL, bf16_t* __restrict__ H, bf16_t* __restrict__ HS) {
  const int tidx = opaque_tid();
  const int lane = tidx & 63;
  const int gw = blockIdx.x * (NTHR / 64) + (tidx >> 6), nw = gridDim.x * (NTHR / 64);
  for (int row = gw; row < MT; row += nw) {
    const bool lat = row < ML;
    const float* xbase = lat ? xl + (size_t)row * 1024 : xc + (size_t)(row - ML) * 1024;
    const float* mod = modL + (lat ? (row >> 12) : 8) * 3072;
    float h[16];
    norm_row(xbase, g, mod, lane, h);
#pragma unroll
    for (int i = 0; i < 4; ++i) {
      u32x2 o; o.x = pk_bf16(h[i * 4], h[i * 4 + 1]); o.y = pk_bf16(h[i * 4 + 2], h[i * 4 + 3]);
      *(u32x2*)(H + (size_t)row * 1024 + lane * 4 + 256 * i) = o;
    }
    if (WITH_HS) {
      const int t = lat ? (row & 4095) : ((row - ML) & 255);
      const int T = lat ? 4096 : 256;
      float s[16];
#pragma unroll
      for (int i = 0; i < 16; ++i) s[i] = 0.f;
      if (t > 0) { float hp[16]; norm_row(xbase - 1024, g, mod, lane, hp);
#pragma unroll
        for (int i = 0; i < 16; ++i) s[i] += hp[i]; }
      if (t < T - 1) { float hn[16]; norm_row(xbase + 1024, g, mod, lane, hn);
#pragma unroll
        for (int i = 0; i < 16; ++i) s[i] += hn[i]; }
#pragma unroll
      for (int i = 0; i < 4; ++i) {
        u32x2 o; o.x = pk_bf16(0.5f * s[i * 4], 0.5f * s[i * 4 + 1]); o.y = pk_bf16(0.5f * s[i * 4 + 2], 0.5f * s[i * 4 + 3]);
        *(u32x2*)(HS + (size_t)row * 1024 + lane * 4 + 256 * i) = o;
      }
    }
  }
}

struct ALPlain {
  const bf16_t* A; int lda;
  typedef u32x4 Regs;
  DEVI void stage(float*, int) const {}
  DEVI void issue(Regs& r, int row, int k) const { r = *(const u32x4*)(A + (size_t)row * lda + k); }
  DEVI u32x4 finish(const Regs& r, const float*, int) const { return r; }
};
struct ALMix {
  const bf16_t* H; const bf16_t* HS; const float* mu;
  struct Regs { u32x4 h, s; };
  DEVI void stage(float* sMu, int n0) const {
    const int grp = n0 >> 10;
    const int j = grp == 0 ? 0 : grp == 1 ? 2 : grp == 2 ? 3 : grp == 3 ? 5 : (n0 - 4096) < 128 ? 1 : 4;
    for (int e = threadIdx.x; e < 1024; e += NTHR) sMu[e] = mu[j * 1024 + e];
  }
  DEVI void issue(Regs& r, int row, int k) const {
    r.h = *(const u32x4*)(H + (size_t)row * 1024 + k);
    r.s = *(const u32x4*)(HS + (size_t)row * 1024 + k);
  }
  DEVI unsigned mix2(unsigned h, unsigned s, float m0, float m1) const {
    const float h0 = bf_lo(h), h1 = bf_hi(h), s0 = bf_lo(s), s1 = bf_hi(s);
    return pk_bf16(h0 + (s0 - h0) * m0, h1 + (s1 - h1) * m1);
  }
  DEVI u32x4 finish(const Regs& r, const float* sMu, int k) const {
    const float4 ma = *(const float4*)(sMu + k), mb = *(const float4*)(sMu + k + 4);
    u32x4 o;
    o.x = mix2(r.h.x, r.s.x, ma.x, ma.y); o.y = mix2(r.h.y, r.s.y, ma.z, ma.w);
    o.z = mix2(r.h.z, r.s.z, mb.x, mb.y); o.w = mix2(r.h.w, r.s.w, mb.z, mb.w);
    return o;
  }
};

template <class AL, class EP>
__device__ __forceinline__ void gemm_phase(char* lds, const bf16_t* __restrict__ Bt, int K, int mtiles, int ntiles, const AL al, const EP ep, int n_base = 0, bool reverse = false, int mt_base = 0) {
  bf16_t* sA = (bf16_t*)lds;
  bf16_t* sB = (bf16_t*)(lds + 73728);
  float* sMu = (float*)(lds + 110592);
  const int tid = opaque_tid(), lane = tid & 63, wv = tid >> 6, wm = wv >> 1, wn = wv & 1;
  const int l31 = lane & 31, lh = lane >> 5;
  const int nk = K >> 6;
  const int ldrow = tid >> 3, ldk = (tid & 7) * 8;
  const int total = mtiles * ntiles;
  const int bid = reverse ? (int)(gridDim.x - 1 - blockIdx.x) : (int)blockIdx.x;
  const int nslots = gridDim.x >> 3, xcd = bid & 7, slot = bid >> 3;
  const int gm = 4 * ntiles;
  for (int chunk = xcd; chunk * nslots < total; chunk += 8) {
    const int tile = chunk * nslots + slot;
    if (tile >= total) break;
    const int grp = tile / gm, rem = tile - grp * gm;
    const int mt = grp * 4 + (rem & 3), nt = rem >> 2;
    const int m0 = (mt_base + mt) * 256, n0 = n_base + nt * 128;
    __syncthreads();
    al.stage(sMu, n0);
    f32x16 acc[2][2];
#pragma unroll
    for (int a = 0; a < 2; ++a)
#pragma unroll
      for (int b = 0; b < 2; ++b)
#pragma unroll
        for (int r = 0; r < 16; ++r) acc[a][b][r] = 0.f;
    typename AL::Regs ar[4];
    u32x4 br[2];
#pragma unroll
    for (int i = 0; i < 4; ++i) al.issue(ar[i], m0 + ldrow + 64 * i, ldk);
#pragma unroll
    for (int i = 0; i < 2; ++i) br[i] = *(const u32x4*)(Bt + (size_t)(n0 + ldrow + 64 * i) * K + ldk);
    __syncthreads();
#pragma unroll
    for (int i = 0; i < 4; ++i) *(u32x4*)(sA + (ldrow + 64 * i) * 72 + ldk) = al.finish(ar[i], sMu, ldk);
#pragma unroll
    for (int i = 0; i < 2; ++i) *(u32x4*)(sB + (ldrow + 64 * i) * 72 + ldk) = br[i];
    __syncthreads();
    for (int kt = 0; kt < nk; ++kt) {
      const int cur = kt & 1;
      const bool more = (kt + 1) < nk;
      const int k0n = (kt + 1) * 64 + ldk;
      if (more) {
#pragma unroll
        for (int i = 0; i < 4; ++i) al.issue(ar[i], m0 + ldrow + 64 * i, k0n);
#pragma unroll
        for (int i = 0; i < 2; ++i) br[i] = *(const u32x4*)(Bt + (size_t)(n0 + ldrow + 64 * i) * K + k0n);
      }
      __builtin_amdgcn_sched_barrier(0);
      const bf16_t* a_ = sA + cur * (256 * 72);
      const bf16_t* b_ = sB + cur * (128 * 72);
#pragma unroll
      for (int kk = 0; kk < 4; ++kk) {
        u32x4 af[2], bfr[2];
#pragma unroll
        for (int mi = 0; mi < 2; ++mi) af[mi] = *(const u32x4*)(a_ + (wm * 64 + mi * 32 + l31) * 72 + kk * 16 + lh * 8);
#pragma unroll
        for (int ni = 0; ni < 2; ++ni) bfr[ni] = *(const u32x4*)(b_ + (wn * 64 + ni * 32 + l31) * 72 + kk * 16 + lh * 8);
#pragma unroll
        for (int mi = 0; mi < 2; ++mi)
#pragma unroll
          for (int ni = 0; ni < 2; ++ni) acc[mi][ni] = mfma32(bfr[ni], af[mi], acc[mi][ni]);
      }
      __builtin_amdgcn_sched_barrier(0);
      if (more) {
        bf16_t* an = sA + (cur ^ 1) * (256 * 72);
        bf16_t* bn = sB + (cur ^ 1) * (128 * 72);
#pragma unroll
        for (int i = 0; i < 4; ++i) *(u32x4*)(an + (ldrow + 64 * i) * 72 + ldk) = al.finish(ar[i], sMu, k0n);
#pragma unroll
        for (int i = 0; i < 2; ++i) *(u32x4*)(bn + (ldrow + 64 * i) * 72 + ldk) = br[i];
      }
      __syncthreads();
    }
#pragma unroll
    for (int mi = 0; mi < 2; ++mi)
#pragma unroll
      for (int ni = 0; ni < 2; ++ni)
#pragma unroll
        for (int q = 0; q < 4; ++q) {
          const int row = m0 + wm * 64 + mi * 32 + l31;
          const int col = n0 + wn * 64 + ni * 32 + 8 * q + 4 * lh;
          f32x4 v = {acc[mi][ni][4 * q], acc[mi][ni][4 * q + 1], acc[mi][ni][4 * q + 2], acc[mi][ni][4 * q + 3]};
          ep(row, col, v);
        }
  }
}


template <class AL, class EP>
__device__ __forceinline__ void gemm256_phase(char* lds, const bf16_t* __restrict__ Bt, int K, int mtiles, int ntiles, const AL al, const EP ep) {
  bf16_t* sA = (bf16_t*)lds;
  bf16_t* sB = (bf16_t*)(lds + 73728);
  float* sMu = (float*)(lds + 147456);
  const int tid = opaque_tid(), lane = tid & 63, wv = tid >> 6, wm = wv >> 1, wn = wv & 1;
  const int l31 = lane & 31, lh = lane >> 5;
  const int nk = K >> 6;
  const int ldrow = tid >> 3, ldk = (tid & 7) * 8;
  const int total = mtiles * ntiles;
  const int nslots = gridDim.x >> 3, xcd = blockIdx.x & 7, slot = blockIdx.x >> 3;
  const int gm = 4 * ntiles;
  for (int chunk = xcd; chunk * nslots < total; chunk += 8) {
    const int tile = chunk * nslots + slot;
    if (tile >= total) break;
    const int grp = tile / gm, rem = tile - grp * gm;
    const int mt = grp * 4 + (rem & 3), nt = rem >> 2;
    const int m0 = mt * 256, n0 = nt * 256;
    __syncthreads();
    al.stage(sMu, n0);
    f32x16 acc[2][4];
#pragma unroll
    for (int a = 0; a < 2; ++a)
#pragma unroll
      for (int b = 0; b < 4; ++b)
#pragma unroll
        for (int r = 0; r < 16; ++r) acc[a][b][r] = 0.f;
    typename AL::Regs ar[4];
    u32x4 br[4];
#pragma unroll
    for (int i = 0; i < 4; ++i) al.issue(ar[i], m0 + ldrow + 64 * i, ldk);
#pragma unroll
    for (int i = 0; i < 4; ++i) br[i] = *(const u32x4*)(Bt + (size_t)(n0 + ldrow + 64 * i) * K + ldk);
    __syncthreads();
#pragma unroll
    for (int i = 0; i < 4; ++i) *(u32x4*)(sA + (ldrow + 64 * i) * 72 + ldk) = al.finish(ar[i], sMu, ldk);
#pragma unroll
    for (int i = 0; i < 4; ++i) *(u32x4*)(sB + (ldrow + 64 * i) * 72 + ldk) = br[i];
    __syncthreads();
    const int half = __builtin_amdgcn_readfirstlane(wv >> 2);
    if (half == 1 && nk > 1) {
#pragma unroll
      for (int i = 0; i < 4; ++i) al.issue(ar[i], m0 + ldrow + 64 * i, 64 + ldk);
#pragma unroll
      for (int i = 0; i < 4; ++i) br[i] = *(const u32x4*)(Bt + (size_t)(n0 + ldrow + 64 * i) * K + 64 + ldk);
    }
    for (int step = 0; step < 2 * nk; ++step) {
      const int kc = step >> 1;
      if ((step & 1) == half) {
        const int kl = kc + 1 + half;
        if (kl < nk) {
          const int k0n = kl * 64 + ldk;
#pragma unroll
          for (int i = 0; i < 4; ++i) al.issue(ar[i], m0 + ldrow + 64 * i, k0n);
#pragma unroll
          for (int i = 0; i < 4; ++i) br[i] = *(const u32x4*)(Bt + (size_t)(n0 + ldrow + 64 * i) * K + k0n);
        }
        __builtin_amdgcn_sched_barrier(0);
        const bf16_t* a_ = sA + (kc & 1) * (256 * 72);
        const bf16_t* b_ = sB + (kc & 1) * (256 * 72);
#pragma unroll
        for (int kk = 0; kk < 4; ++kk) {
          u32x4 af[2];
#pragma unroll
          for (int mi = 0; mi < 2; ++mi) af[mi] = *(const u32x4*)(a_ + (wm * 64 + mi * 32 + l31) * 72 + kk * 16 + lh * 8);
#pragma unroll
          for (int ni = 0; ni < 4; ++ni) {
            const u32x4 bfr = *(const u32x4*)(b_ + (wn * 128 + ni * 32 + l31) * 72 + kk * 16 + lh * 8);
#pragma unroll
            for (int mi = 0; mi < 2; ++mi) acc[mi][ni] = mfma32(bfr, af[mi], acc[mi][ni]);
          }
        }
        __builtin_amdgcn_sched_barrier(0);
      } else {
        const int kf = kc + 1;
        if (kf < nk) {
          bf16_t* an = sA + (kf & 1) * (256 * 72);
          bf16_t* bn = sB + (kf & 1) * (256 * 72);
          const int k0n = kf * 64 + ldk;
#pragma unroll
          for (int i = 0; i < 4; ++i) *(u32x4*)(an + (ldrow + 64 * i) * 72 + ldk) = al.finish(ar[i], sMu, k0n);
#pragma unroll
          for (int i = 0; i < 4; ++i) *(u32x4*)(bn + (ldrow + 64 * i) * 72 + ldk) = br[i];
        }
      }
      __syncthreads();
    }
    if constexpr (EP::VIA_LDS) {
      float* reg = (float*)(lds + wv * 16896);
#pragma unroll
      for (int mi = 0; mi < 2; ++mi) {
#pragma unroll
        for (int ni = 0; ni < 4; ++ni)
#pragma unroll
          for (int q = 0; q < 4; ++q) {
            f32x4 v = {acc[mi][ni][4 * q], acc[mi][ni][4 * q + 1], acc[mi][ni][4 * q + 2], acc[mi][ni][4 * q + 3]};
            *(f32x4*)(reg + l31 * 132 + ni * 32 + 8 * q + 4 * lh) = v;
          }
#pragma unroll 4
        for (int it = 0; it < 16; ++it) {
          const int rl = it * 2 + lh;
          const f32x4 v = *(const f32x4*)(reg + rl * 132 + l31 * 4);
          ep(m0 + wm * 64 + mi * 32 + rl, n0 + wn * 128 + l31 * 4, v);
        }
      }
    } else
#pragma unroll
    for (int mi = 0; mi < 2; ++mi)
#pragma unroll
      for (int ni = 0; ni < 4; ++ni) {
#pragma unroll
        for (int q = 0; q < 4; ++q) {
          const int row = m0 + wm * 64 + mi * 32 + l31;
          const int col = n0 + wn * 128 + ni * 32 + 8 * q + 4 * lh;
          f32x4 v = {acc[mi][ni][4 * q], acc[mi][ni][4 * q + 1], acc[mi][ni][4 * q + 2], acc[mi][ni][4 * q + 3]};
          ep(row, col, v);
        }
        __builtin_amdgcn_sched_barrier(0);
      }
  }
}

DEVI void st_bf16x4(bf16_t* p, f32x4 v) { u32x2 o; o.x = pk_bf16(v[0], v[1]); o.y = pk_bf16(v[2], v[3]); *(u32x2*)p = o; }

struct EpRwkvIn {
  static constexpr bool VIA_LDS = false;
  bf16_t *R, *K, *V, *G, *WD, *AD;
  DEVI void operator()(int row, int col, f32x4 v) const {
    const int grp = col >> 10;
    if (grp < 4) {
      const int c = col & 1023;
      bf16_t* dst = grp == 0 ? R : grp == 1 ? K : grp == 2 ? V : G;
      if (grp == 3) { v[0] = siluf_(v[0]); v[1] = siluf_(v[1]); v[2] = siluf_(v[2]); v[3] = siluf_(v[3]); }
      st_bf16x4(dst + (size_t)row * 1024 + c, v);
    } else {
      const int c = col - 4096;
      if (c < 128) {
#pragma unroll
        for (int i = 0; i < 4; ++i) { const float t = __expf(2.f * v[i]); v[i] = 1.f - 2.f / (t + 1.f); }
        st_bf16x4(WD + (size_t)row * 128 + c, v);
      } else st_bf16x4(AD + (size_t)row * 128 + (c - 128), v);
    }
  }
};
struct EpRes {
  static constexpr bool VIA_LDS = false;
  const float* xl_src; const float* xc_src; float* xl_dst; float* xc_dst; const float* modL;
  DEVI void operator()(int row, int col, f32x4 v) const {
    const bool lat = row < ML;
    const size_t off = lat ? (size_t)row * 1024 + col : (size_t)(row - ML) * 1024 + col;
    const float* src = (lat ? xl_src : xc_src) + off;
    float* dst = (lat ? xl_dst : xc_dst) + off;
    const f32x4 g = *(const f32x4*)(modL + (lat ? (row >> 12) : 8) * 3072 + 2048 + col);
    f32x4 x = *(const f32x4*)src;
    x += g * v;
    *(f32x4*)dst = x;
  }
};
struct EpLruIn {
  static constexpr bool VIA_LDS = false;
  bf16_t *XR, *GG;
  DEVI void operator()(int row, int col, f32x4 v) const {
    if (col < LW) st_bf16x4(XR + (size_t)row * LW + col, v);
    else { v[0] = siluf_(v[0]); v[1] = siluf_(v[1]); v[2] = siluf_(v[2]); v[3] = siluf_(v[3]); st_bf16x4(GG + (size_t)row * LW + (col - LW), v); }
  }
};
struct EpNatIn {
  static constexpr bool VIA_LDS = false;
  bf16_t *Q, *K, *VT, *G;
  DEVI void operator()(int row, int col, f32x4 v) const {
    const int grp = col >> 10, c = col & 1023;
    if (grp == 0) st_bf16x4(Q + (size_t)row * 1024 + c, v);
    else if (grp == 1) st_bf16x4(K + (size_t)row * 1024 + c, v);
    else if (grp == 3) { v[0] = siluf_(v[0]); v[1] = siluf_(v[1]); v[2] = siluf_(v[2]); v[3] = siluf_(v[3]); st_bf16x4(G + (size_t)row * 1024 + c, v); }
    else {
      unsigned idx, T;
      if (row < ML) { const unsigned b = row >> 12, t = row & 4095; T = 4096u; idx = ((b * 1024u + (unsigned)c) << 12) + t; }
      else { const unsigned r2 = row - ML; const unsigned b = r2 >> 8, t = r2 & 255; T = 256u; idx = (unsigned)ML * 1024u + ((b * 1024u + (unsigned)c) << 8) + t; }
#pragma unroll
      for (int i = 0; i < 4; ++i) VT[idx + (unsigned)i * T] = f2bf(v[i]);
    }
  }
};

DEVI int rwkv_row(int b, int d, int s) {
  if (s < 256) return ML + b * 256 + (d ? 255 - s : s);
  const int t = s - 256;
  return b * 4096 + (d ? 4095 - t : t);
}

constexpr int PSTR = 584, PREC_SC = 448, PREC_BF = 456;
constexpr int TSTR = 388;
struct ScanHead { u32x4 a1, a2; float v0, v1; f32x4 s0, s1; };
struct BodyH { f32x4 ww[2], bw[2], kw[2], b1[2], k1[2]; };
DEVI void scan_load_head(ScanHead& R, const float* rec, int kq, int role_off, int srow) {
  const char* ab = (const char*)(rec + PREC_BF) + role_off + kq * 16;
  R.a1 = *(const u32x4*)ab; R.a2 = *(const u32x4*)(ab + 64);
  R.v0 = rec[320 + srow]; R.v1 = rec[384 + srow];
  R.s0 = *(const f32x4*)(rec + PREC_SC); R.s1 = *(const f32x4*)(rec + PREC_SC + 4);
}
DEVI void scan_load_bodyh(BodyH& R, const float* rec, int kq, int hf) {
  const int o = hf * 32 + 8 * kq;
  R.ww[0] = *(const f32x4*)(rec + o);        R.ww[1] = *(const f32x4*)(rec + o + 4);
  R.bw[0] = *(const f32x4*)(rec + 64 + o);   R.bw[1] = *(const f32x4*)(rec + 64 + o + 4);
  R.kw[0] = *(const f32x4*)(rec + 128 + o);  R.kw[1] = *(const f32x4*)(rec + 128 + o + 4);
  R.b1[0] = *(const f32x4*)(rec + 192 + o);  R.b1[1] = *(const f32x4*)(rec + 192 + o + 4);
  R.k1[0] = *(const f32x4*)(rec + 256 + o);  R.k1[1] = *(const f32x4*)(rec + 256 + o + 4);
}
DEVI f32x2 lo2(f32x4 v) { return (f32x2){v[0], v[1]}; }
DEVI f32x2 hi2(f32x4 v) { return (f32x2){v[2], v[3]}; }
DEVI void scan_upd_half(f32x2* S4, const BodyH& R, f32x2 sa0_2, f32x2 v0_2, f32x2 sa1_2, f32x2 v1_2) {
#pragma unroll
  for (int q = 0; q < 2; ++q) {
    S4[2 * q] = S4[2 * q] * lo2(R.ww[q]) + ((sa0_2 * lo2(R.bw[q]) + v0_2 * lo2(R.kw[q])) + (sa1_2 * lo2(R.b1[q]) + v1_2 * lo2(R.k1[q])));
    S4[2 * q + 1] = S4[2 * q + 1] * hi2(R.ww[q]) + ((sa0_2 * hi2(R.bw[q]) + v0_2 * hi2(R.kw[q])) + (sa1_2 * hi2(R.b1[q]) + v1_2 * hi2(R.k1[q])));
  }
}
DEVI void scan_step2(f32x2 (&S)[8], const ScanHead& H, const BodyH& B0, const float* rec, const float* rec_next, BodyH& B0n, int kq, float* yout) {
  BodyH B1;
  scan_load_bodyh(B1, rec, kq, 1);
  const u32x4 b1 = mk4(pk_bf16(S[0][0], S[0][1]), pk_bf16(S[1][0], S[1][1]), pk_bf16(S[2][0], S[2][1]), pk_bf16(S[3][0], S[3][1]));
  const u32x4 b2 = mk4(pk_bf16(S[4][0], S[4][1]), pk_bf16(S[5][0], S[5][1]), pk_bf16(S[6][0], S[6][1]), pk_bf16(S[7][0], S[7][1]));
  f32x4 D = {0.f, 0.f, 0.f, 0.f};
  D = mfma16(H.a1, b1, D);
  D = mfma16(H.a2, b2, D);
  const float v0 = H.v0, v1 = H.v1;
  const float sa0 = D[0];
  const float sa1 = D[2] + sa0 * H.s0[2] + v0 * H.s0[3];
  const f32x2 sa0_2 = {sa0, sa0}, v0_2 = {v0, v0}, sa1_2 = {sa1, sa1}, v1_2 = {v1, v1};
  scan_upd_half(&S[0], B0, sa0_2, v0_2, sa1_2, v1_2);
  if (rec_next) scan_load_bodyh(B0n, rec_next, kq, 0);
  scan_upd_half(&S[4], B1, sa0_2, v0_2, sa1_2, v1_2);
  yout[0] = D[1] + sa0 * H.s0[0] + v0 * H.s0[1];
  yout[256] = D[3] + sa0 * H.s1[0] + v0 * H.s1[1] + sa1 * H.s1[2] + v1 * H.s1[3];
}
DEVI float sum16(float v) { v = sum8(v); v += dpp_f<0x140>(v); return v; }

__device__ __forceinline__ void rwkv_scan_phase(char* lds, const bf16_t* __restrict__ R, const bf16_t* __restrict__ Kb, const bf16_t* __restrict__ V,
                                const bf16_t* __restrict__ WD, const bf16_t* __restrict__ AD, const bf16_t* __restrict__ Wup,
                                const float* __restrict__ b0, const float* __restrict__ k_ka, const float* __restrict__ r_k,
                                bf16_t* __restrict__ Y0, bf16_t* __restrict__ Y1, float* __restrict__ BON) {
  float* stepbuf = (float*)lds;
  float* tokbuf = stepbuf + 2 * 8 * PSTR;
  float* wbuf = tokbuf + 2 * 16 * TSTR;
  float* abuf = wbuf + 1024;
  float* ybuf = abuf + 1024;
  const int tid = opaque_tid(), lane = tid & 63, wv = tid >> 6;
  constexpr int NCH = (256 + 4096) / 16;
  for (int chain = blockIdx.x; chain < 256; chain += gridDim.x) {
    const int d = chain & 1, h = (chain >> 1) & 15, b = chain >> 5;
    __syncthreads();
    if (wv < 4) {
      const int kq = lane >> 4, srow = wv * 16 + (lane & 15);
      const int role_off = (lane & 3) * 128;
      f32x2 S[8];
#pragma unroll
      for (int j = 0; j < 8; ++j) S[j] = (f32x2){0.f, 0.f};
      __syncthreads();
      __syncthreads();
      __syncthreads();
      __syncthreads();
      for (int c = 0; c < NCH; ++c) {
        const float* sb = stepbuf + (c & 1) * 8 * PSTR;
        float* yb = ybuf + (c & 1) * 4096 + kq * 64 + srow;
        ScanHead ha, hb;
        BodyH ba, bb;
        scan_load_head(ha, sb, kq, role_off, srow);
        scan_load_bodyh(ba, sb, kq, 0);
#pragma unroll
        for (int i = 0; i < 4; i += 2) {
          scan_load_head(hb, sb + (i + 1) * PSTR, kq, role_off, srow);
          scan_step2(S, ha, ba, sb + i * PSTR, sb + (i + 1) * PSTR, bb, kq, yb + i * 512);
          scan_load_head(ha, sb + (i + 2) * PSTR, kq, role_off, srow);
          scan_step2(S, hb, bb, sb + (i + 1) * PSTR, sb + (i + 2) * PSTR, ba, kq, yb + (i + 1) * 512);
        }
        __syncthreads();
#pragma unroll
        for (int i = 4; i < 8; i += 2) {
          scan_load_head(hb, sb + (i + 1) * PSTR, kq, role_off, srow);
          scan_step2(S, ha, ba, sb + i * PSTR, sb + (i + 1) * PSTR, bb, kq, yb + i * 512);
          if (i + 2 < 8) scan_load_head(ha, sb + (i + 2) * PSTR, kq, role_off, srow);
          scan_step2(S, hb, bb, sb + (i + 1) * PSTR, (i + 2 < 8) ? sb + (i + 2) * PSTR : (const float*)nullptr, ba, kq, yb + (i + 1) * 512);
        }
        __syncthreads();
      }
    } else {
      const int ptid = tid - 256, pw = wv - 4;
      bf16_t* Y = d ? Y1 : Y0;
      const int ncol = h * 64 + pw * 16 + (lane & 15);
      u32x4 bu[2][2];
      float bias_u[2];
#pragma unroll
      for (int kind = 0; kind < 2; ++kind) {
        const bf16_t* wu = Wup + ((size_t)(d * 2 + kind) * 1024 + ncol) * 64 + 8 * (lane >> 4);
        bu[kind][0] = *(const u32x4*)wu; bu[kind][1] = *(const u32x4*)(wu + 32);
        bias_u[kind] = b0[(d * 2 + kind) * 1024 + ncol];
      }
      const int ti = ptid >> 4, dq = ptid & 15;
      const int hc = h * 64 + 4 * dq;
      const f32x4 kkv = *(const f32x4*)(k_ka + hc), kav = *(const f32x4*)(k_ka + 1024 + hc), rkv = *(const f32x4*)(r_k + hc);
      u32x4 xw0, xw1, xa0, xa1; u32x2 rr, kr, vr;
      auto issue = [&](int c) {
        const int rowA = rwkv_row(b, d, c * 16 + (lane & 15));
        const bf16_t* xp = WD + (size_t)rowA * 128 + d * 64 + 8 * (lane >> 4);
        const bf16_t* xq = AD + (size_t)rowA * 128 + d * 64 + 8 * (lane >> 4);
        xw0 = *(const u32x4*)xp; xw1 = *(const u32x4*)(xp + 32);
        xa0 = *(const u32x4*)xq; xa1 = *(const u32x4*)(xq + 32);
        const int rowB = rwkv_row(b, d, c * 16 + ti);
        rr = *(const u32x2*)(R + (size_t)rowB * 1024 + hc);
        kr = *(const u32x2*)(Kb + (size_t)rowB * 1024 + hc);
        vr = *(const u32x2*)(V + (size_t)rowB * 1024 + hc);
      };
      auto stepA = [&]() {
        f32x4 accw = {0.f, 0.f, 0.f, 0.f}, acca = {0.f, 0.f, 0.f, 0.f};
        accw = mfma16(xw0, bu[0][0], accw); accw = mfma16(xw1, bu[0][1], accw);
        acca = mfma16(xa0, bu[1][0], acca); acca = mfma16(xa1, bu[1][1], acca);
#pragma unroll
        for (int r = 0; r < 4; ++r) {
          const int o = ((lane >> 4) * 4 + r) * 64 + pw * 16 + (lane & 15);
          const float x = -(accw[r] + bias_u[0]);
          const float sp = fmaxf(x, 0.f) + 0.6931471805599453f * __builtin_amdgcn_logf(1.f + __builtin_amdgcn_exp2f(-1.4426950408889634f * fabsf(x)));
          const float ew = __builtin_amdgcn_exp2f(-1.4426950408889634f * (sp + 0.5f));
          wbuf[o] = __builtin_amdgcn_exp2f(-1.4426950408889634f * ew);
          abuf[o] = __builtin_amdgcn_rcpf(1.f + __builtin_amdgcn_exp2f(-1.4426950408889634f * (acca[r] + bias_u[1])));
        }
      };
      auto stepB1 = [&](int c) {
        const float rv[4] = {bf_lo(rr.x), bf_hi(rr.x), bf_lo(rr.y), bf_hi(rr.y)};
        const float kv[4] = {bf_lo(kr.x), bf_hi(kr.x), bf_lo(kr.y), bf_hi(kr.y)};
        const float vv[4] = {bf_lo(vr.x), bf_hi(vr.x), bf_lo(vr.y), bf_hi(vr.y)};
        const f32x4 av = *(const f32x4*)(abuf + ti * 64 + 4 * dq), wv4 = *(const f32x4*)(wbuf + ti * 64 + 4 * dq);
        float q[4], ss = 0.f;
#pragma unroll
        for (int i = 0; i < 4; ++i) { q[i] = kv[i] * kkv[i]; ss += q[i] * q[i]; }
        ss = sum16(ss);
        const float inv = __builtin_amdgcn_rsqf(fmaxf(ss, 1e-24f));
        f32x4 nk, wrr, ka, kd, vo;
        float c1 = 0.f, c2 = 0.f, bn = 0.f;
#pragma unroll
        for (int i = 0; i < 4; ++i) {
          const float n = q[i] * inv;
          kd[i] = kv[i] * (1.f + (av[i] - 1.f) * kav[i]);
          ka[i] = n * av[i];
          nk[i] = -n; wrr[i] = wv4[i] * rv[i]; vo[i] = vv[i];
          c1 += ka[i] * rv[i]; c2 += kd[i] * rv[i]; bn += rv[i] * kd[i] * rkv[i];
        }
        c1 = sum16(c1); c2 = sum16(c2); bn = sum16(bn);
        float* rec = tokbuf + ((c & 1) * 16 + ti) * TSTR;
        *(f32x4*)(rec + 4 * dq) = nk;
        *(f32x4*)(rec + 64 + 4 * dq) = wrr;
        *(f32x4*)(rec + 128 + 4 * dq) = wv4;
        *(f32x4*)(rec + 192 + 4 * dq) = ka;
        *(f32x4*)(rec + 256 + 4 * dq) = kd;
        *(f32x4*)(rec + 320 + 4 * dq) = vo;
        if (dq == 0) {
          *(f32x2*)(rec + 384) = (f32x2){c1, c2};
          BON[((size_t)d * MT + rwkv_row(b, d, c * 16 + ti)) * 16 + h] = bn;
        }
      };
      auto stepB2 = [&](int c) {
        const int pp = ptid >> 5, dp = ptid & 31;
        const float* t0 = tokbuf + ((c & 1) * 16 + 2 * pp) * TSTR + 2 * dp;
        const float* t1 = t0 + TSTR;
        const f32x2 a0 = *(const f32x2*)(t0), wr0 = *(const f32x2*)(t0 + 64), w0 = *(const f32x2*)(t0 + 128);
        const f32x2 b0_ = *(const f32x2*)(t0 + 192), k0_ = *(const f32x2*)(t0 + 256), v0 = *(const f32x2*)(t0 + 320);
        const f32x2 a1 = *(const f32x2*)(t1), wr1 = *(const f32x2*)(t1 + 64), w1 = *(const f32x2*)(t1 + 128);
        const f32x2 b1_ = *(const f32x2*)(t1 + 192), k1_ = *(const f32x2*)(t1 + 256), v1 = *(const f32x2*)(t1 + 320);
        float c3 = b0_[0] * a1[0] + b0_[1] * a1[1], c4 = k0_[0] * a1[0] + k0_[1] * a1[1];
        float c5 = b0_[0] * wr1[0] + b0_[1] * wr1[1], c6 = k0_[0] * wr1[0] + k0_[1] * wr1[1];
        c3 = sum16(c3); c4 = sum16(c4); c5 = sum16(c5); c6 = sum16(c6);
        c3 += __shfl_xor(c3, 16); c4 += __shfl_xor(c4, 16); c5 += __shfl_xor(c5, 16); c6 += __shfl_xor(c6, 16);
        float* rec = stepbuf + ((c & 1) * 8 + pp) * PSTR;
        *(f32x2*)(rec + 2 * dp) = w0 * w1;
        *(f32x2*)(rec + 64 + 2 * dp) = b0_ * w1;
        *(f32x2*)(rec + 128 + 2 * dp) = k0_ * w1;
        *(f32x2*)(rec + 192 + 2 * dp) = b1_;
        *(f32x2*)(rec + 256 + 2 * dp) = k1_;
        *(f32x2*)(rec + 320 + 2 * dp) = v0;
        *(f32x2*)(rec + 384 + 2 * dp) = v1;
        unsigned* bb = (unsigned*)(rec + PREC_BF);
        const f32x2 wa = w0 * a1, wwr = w0 * wr1;
        bb[dp] = pk_bf16(a0[0], a0[1]);
        bb[32 + dp] = pk_bf16(wr0[0], wr0[1]);
        bb[64 + dp] = pk_bf16(wa[0], wa[1]);
        bb[96 + dp] = pk_bf16(wwr[0], wwr[1]);
        if (dp == 0) {
          const f32x2 cc0 = *(const f32x2*)(t0 + 384), cc1 = *(const f32x2*)(t1 + 384);
          *(f32x4*)(rec + PREC_SC) = (f32x4){cc0[0], cc0[1], c3, c4};
          *(f32x4*)(rec + PREC_SC + 4) = (f32x4){c5, c6, cc1[0], cc1[1]};
        }
      };
      auto storeY = [&](int c) {
        const f32x4 yv = *(const f32x4*)(ybuf + (c & 1) * 4096 + ti * 256 + 4 * dq);
        u32x2 o; o.x = pk_bf16(yv[0], yv[1]); o.y = pk_bf16(yv[2], yv[3]);
        *(u32x2*)(Y + (size_t)rwkv_row(b, d, c * 16 + ti) * 1024 + hc) = o;
      };
      issue(0);
      stepA();
      __syncthreads();
      stepB1(0);
      issue(1);
      __syncthreads();
      stepA();
      __syncthreads();
      stepB1(1);
      stepB2(0);
      issue(2);
      __builtin_amdgcn_sched_barrier(0);
      __syncthreads();
      __builtin_amdgcn_sched_barrier(0);
      for (int c = 0; c < NCH; ++c) {
        if (c + 2 < NCH) stepA();
        if (c + 1 < NCH) stepB2(c + 1);
        if (c >= 1) storeY(c - 1);
        __syncthreads();
        if (c + 2 < NCH) stepB1(c + 2);
        if (c + 3 < NCH) issue(c + 3);
        __builtin_amdgcn_sched_barrier(0);
        __syncthreads();
        __builtin_amdgcn_sched_barrier(0);
      }
      storeY(NCH - 1);
    }
  }
}

__device__ __forceinline__ void rwkv_post_phase(const bf16_t* __restrict__ Y0, const bf16_t* __restrict__ Y1, const bf16_t* __restrict__ V,
                                bf16_t* __restrict__ G, const float* __restrict__ BON, const float* __restrict__ gn, int nrows) {
  const int tidx = opaque_tid();
  const int lane = tidx & 63;
  const int gw = blockIdx.x * (NTHR / 64) + (tidx >> 6), nw = gridDim.x * (NTHR / 64);
  const int head = lane >> 2, c0 = lane * 16;
  for (int row = gw; row < nrows; row += nw) {
    const size_t off = (size_t)row * 1024 + c0;
    float y[16], v[16], g[16];
#pragma unroll
    for (int i = 0; i < 2; ++i) {
      const u32x4 a0 = *(const u32x4*)(Y0 + off + 8 * i), a1 = *(const u32x4*)(Y1 + off + 8 * i);
      const u32x4 av = *(const u32x4*)(V + off + 8 * i), ag = *(const u32x4*)(G + off + 8 * i);
      y[8 * i + 0] = bf_lo(a0.x) + bf_lo(a1.x); y[8 * i + 1] = bf_hi(a0.x) + bf_hi(a1.x);
      y[8 * i + 2] = bf_lo(a0.y) + bf_lo(a1.y); y[8 * i + 3] = bf_hi(a0.y) + bf_hi(a1.y);
      y[8 * i + 4] = bf_lo(a0.z) + bf_lo(a1.z); y[8 * i + 5] = bf_hi(a0.z) + bf_hi(a1.z);
      y[8 * i + 6] = bf_lo(a0.w) + bf_lo(a1.w); y[8 * i + 7] = bf_hi(a0.w) + bf_hi(a1.w);
      v[8 * i + 0] = bf_lo(av.x); v[8 * i + 1] = bf_hi(av.x); v[8 * i + 2] = bf_lo(av.y); v[8 * i + 3] = bf_hi(av.y);
      v[8 * i + 4] = bf_lo(av.z); v[8 * i + 5] = bf_hi(av.z); v[8 * i + 6] = bf_lo(av.w); v[8 * i + 7] = bf_hi(av.w);
      g[8 * i + 0] = bf_lo(ag.x); g[8 * i + 1] = bf_hi(ag.x); g[8 * i + 2] = bf_lo(ag.y); g[8 * i + 3] = bf_hi(ag.y);
      g[8 * i + 4] = bf_lo(ag.z); g[8 * i + 5] = bf_hi(ag.z); g[8 * i + 6] = bf_lo(ag.w); g[8 * i + 7] = bf_hi(ag.w);
    }
    float s = 0.f;
#pragma unroll
    for (int i = 0; i < 16; ++i) s += y[i];
    s += __shfl_xor(s, 1); s += __shfl_xor(s, 2);
    const float mean = s * (1.f / 64.f);
    float q = 0.f;
#pragma unroll
    for (int i = 0; i < 16; ++i) { const float dlt = y[i] - mean; q += dlt * dlt; }
    q += __shfl_xor(q, 1); q += __shfl_xor(q, 2);
    const float rstd = rsqrtf(q * (1.f / 64.f) + 64e-5f);
    const float bonus = BON[(size_t)row * 16 + head] + BON[((size_t)MT + row) * 16 + head];
    unsigned o[8];
#pragma unroll
    for (int i = 0; i < 8; ++i) {
      const float z0 = ((y[2 * i] - mean) * rstd * gn[c0 + 2 * i] + gn[1024 + c0 + 2 * i] + bonus * v[2 * i]) * g[2 * i];
      const float z1 = ((y[2 * i + 1] - mean) * rstd * gn[c0 + 2 * i + 1] + gn[1024 + c0 + 2 * i + 1] + bonus * v[2 * i + 1]) * g[2 * i + 1];
      o[i] = pk_bf16(z0, z1);
    }
    *(u32x4*)(G + off) = mk4(o[0], o[1], o[2], o[3]);
    *(u32x4*)(G + off + 8) = mk4(o[4], o[5], o[6], o[7]);
  }
}

__device__ __forceinline__ void rglru_phase(char* lds, const bf16_t* __restrict__ XR, const bf16_t* __restrict__ Wg, const float* __restrict__ conv_w,
                            const float* __restrict__ conv_b, const float* __restrict__ gate_b, const float* __restrict__ lam,
                            bf16_t* __restrict__ HS0, bf16_t* __restrict__ HS1) {
  bf16_t* xcT = (bf16_t*)lds;
  f32x2* AB = (f32x2*)(lds + 26624);
  bf16_t* raw = (bf16_t*)(lds + 26624);
  float* segP = (float*)(lds + 116736);
  float* segH = segP + 352;
  float* segC = segH + 352;
  bf16_t* wgs = (bf16_t*)(lds + 120960);
  float* cws = (float*)(lds + 160896);
  const int tid = opaque_tid(), lane = tid & 63, wv = tid >> 6;
  for (int chain = blockIdx.x; chain < 256; chain += gridDim.x) {
    const int d = chain & 1, blk = (chain >> 1) & 15, b = chain >> 5;
    bf16_t* HS = d ? HS1 : HS0;
    float carry = 0.f;
    __syncthreads();
    for (int q = tid; q < 2 * 96 * 12; q += NTHR) {
      const int g = q / 1152, rem = q - g * 1152, n = rem / 12, k8 = rem - n * 12;
      *(u32x4*)(wgs + (g * 96 + n) * 104 + k8 * 8) = *(const u32x4*)(Wg + ((size_t)((blk * 4 + d * 2 + g) * 96 + n)) * 96 + k8 * 8);
    }
    for (int e = tid; e < 5 * 88; e += NTHR) {
      const int j = e / 88, c = e - j * 88;
      cws[e] = j < 4 ? conv_w[j * LW + blk * 88 + c] : conv_b[blk * 88 + c];
    }
    for (int e = tid; e < 128 * 8; e += NTHR) xcT[(e >> 3) * 104 + 88 + (e & 7)] = 0;
    u32x4 pre[3];
    auto tile_geom = [&](int ti, int& seqbase, int& t0, int& T) {
      if (ti < 2) { seqbase = ML + b * 256; T = 256; t0 = (d ? 1 - ti : ti) * 128; }
      else { seqbase = b * 4096; T = 4096; t0 = (d ? 31 - (ti - 2) : (ti - 2)) * 128; }
    };
    auto prefetch = [&](int ti) {
      int seqbase, t0, T; tile_geom(ti, seqbase, t0, T);
#pragma unroll
      for (int i = 0; i < 3; ++i) {
        const int q = tid + NTHR * i;
        const int row = q / 11, cc = q - row * 11, t = t0 - 2 + row;
        u32x4 v = {0u, 0u, 0u, 0u};
        if (q < 131 * 11 && t >= 0 && t < T) v = *(const u32x4*)(XR + (size_t)(seqbase + t) * LW + blk * 88 + cc * 8);
        pre[i] = v;
      }
    };
    prefetch(0);
    for (int ti = 0; ti < 34; ++ti) {
      int seqbase, t0, T; tile_geom(ti, seqbase, t0, T);
      __syncthreads();
#pragma unroll
      for (int i = 0; i < 3; ++i) {
        const int q = tid + NTHR * i;
        if (q < 131 * 11) *(u32x4*)(raw + q * 8) = pre[i];
      }
      if (ti + 1 < 34) prefetch(ti + 1);
      __builtin_amdgcn_sched_barrier(0);
      __syncthreads();
      for (int e = tid; e < 128 * 44; e += NTHR) {
        const int tl = e / 44, c2 = (e - tl * 44) * 2;
        float a0 = cws[4 * 88 + c2], a1 = cws[4 * 88 + c2 + 1];
#pragma unroll
        for (int j = 0; j < 4; ++j) {
          const unsigned x = *(const unsigned*)(raw + (tl + j) * 88 + c2);
          a0 += bf_lo(x) * cws[j * 88 + c2]; a1 += bf_hi(x) * cws[j * 88 + c2 + 1];
        }
        *(unsigned*)(xcT + tl * 104 + c2) = pk_bf16(a0, a1);
      }
      __syncthreads();
      {
        const int tok = wv * 16 + (lane & 15);
        u32x4 af[3];
#pragma unroll
        for (int kk = 0; kk < 3; ++kk) af[kk] = *(const u32x4*)(xcT + tok * 104 + kk * 32 + 8 * (lane >> 4));
#pragma unroll
        for (int n6 = 0; n6 < 6; ++n6) {
          f32x4 accr = {0.f, 0.f, 0.f, 0.f}, acci = {0.f, 0.f, 0.f, 0.f};
          const int ncol = n6 * 16 + (lane & 15);
          const bf16_t* wr_ = wgs + ncol * 104 + 8 * (lane >> 4);
          const bf16_t* wi_ = wgs + (96 + ncol) * 104 + 8 * (lane >> 4);
#pragma unroll
          for (int kk = 0; kk < 3; ++kk) {
            accr = mfma16(af[kk], *(const u32x4*)(wr_ + kk * 32), accr);
            acci = mfma16(af[kk], *(const u32x4*)(wi_ + kk * 32), acci);
          }
          if (ncol < 88) {
            const int ch = blk * 88 + ncol;
            const float gbr = gate_b[(d * 2 + 0) * LW + ch], gbi = gate_b[(d * 2 + 1) * LW + ch];
            const float spl = softplusf_(-lam[d * LW + ch]);
#pragma unroll
            for (int r = 0; r < 4; ++r) {
              const int tk = wv * 16 + (lane >> 4) * 4 + r;
              const float rg = sigmoidf_(accr[r] + gbr), ig = sigmoidf_(acci[r] + gbi);
              const float a = __expf(-8.f * rg * spl);
              const float bb = sqrtf(fmaxf(1.f - a * a, 0.f)) * ig * bf2f(xcT[tk * 104 + ncol]);
              AB[tk * 88 + ncol] = (f32x2){a, bb};
            }
          }
        }
      }
      __syncthreads();
      if (tid < 352) {
        const int seg = tid / 88, c = tid - seg * 88;
        float hl = 0.f, P = 1.f;
        for (int u0 = seg * 32; u0 < seg * 32 + 32; u0 += 8) {
          f32x2 ab[8];
#pragma unroll
          for (int i = 0; i < 8; ++i) { const int tl = d ? 127 - (u0 + i) : (u0 + i); ab[i] = AB[tl * 88 + c]; }
#pragma unroll
          for (int i = 0; i < 8; ++i) { hl = ab[i][0] * hl + ab[i][1]; P *= ab[i][0]; ab[i] = (f32x2){hl, P}; }
#pragma unroll
          for (int i = 0; i < 8; ++i) { const int tl = d ? 127 - (u0 + i) : (u0 + i); AB[tl * 88 + c] = ab[i]; }
        }
        segH[seg * 88 + c] = hl; segP[seg * 88 + c] = P;
      }
      __syncthreads();
      if (tid < 88) {
        float cur = carry;
#pragma unroll
        for (int seg = 0; seg < 4; ++seg) { segC[seg * 88 + tid] = cur; cur = segP[seg * 88 + tid] * cur + segH[seg * 88 + tid]; }
        carry = cur;
      }
      __syncthreads();
      for (int q = tid; q < 128 * 11; q += NTHR) {
        const int tl = q / 11, c8 = (q - tl * 11) * 8;
        const int u = d ? 127 - tl : tl;
        const float* sc = segC + (u >> 5) * 88 + c8;
        float hv[8];
#pragma unroll
        for (int i = 0; i < 8; ++i) { const f32x2 hp = AB[tl * 88 + c8 + i]; hv[i] = hp[0] + hp[1] * sc[i]; }
        *(u32x4*)(HS + (size_t)(seqbase + t0 + tl) * LW + blk * 88 + c8) =
            mk4(pk_bf16(hv[0], hv[1]), pk_bf16(hv[2], hv[3]), pk_bf16(hv[4], hv[5]), pk_bf16(hv[6], hv[7]));
      }
    }
  }
}

__device__ __forceinline__ void lru_z_phase(const bf16_t* __restrict__ HS0, const bf16_t* __restrict__ HS1, bf16_t* __restrict__ GG) {
  const size_t n8 = (size_t)MT * LW / 8;
  for (size_t e = (size_t)blockIdx.x * NTHR + threadIdx.x; e < n8; e += (size_t)gridDim.x * NTHR) {
    const u32x4 a = *(const u32x4*)(HS0 + e * 8), b = *(const u32x4*)(HS1 + e * 8), g = *(const u32x4*)(GG + e * 8);
    u32x4 o;
    o.x = pk_bf16((bf_lo(a.x) + bf_lo(b.x)) * bf_lo(g.x), (bf_hi(a.x) + bf_hi(b.x)) * bf_hi(g.x));
    o.y = pk_bf16((bf_lo(a.y) + bf_lo(b.y)) * bf_lo(g.y), (bf_hi(a.y) + bf_hi(b.y)) * bf_hi(g.y));
    o.z = pk_bf16((bf_lo(a.z) + bf_lo(b.z)) * bf_lo(g.z), (bf_hi(a.z) + bf_hi(b.z)) * bf_hi(g.z));
    o.w = pk_bf16((bf_lo(a.w) + bf_lo(b.w)) * bf_lo(g.w), (bf_hi(a.w) + bf_hi(b.w)) * bf_hi(g.w));
    *(u32x4*)(GG + e * 8) = o;
  }
}

__device__ __forceinline__ void nat_qk_phase(bf16_t* __restrict__ Q, bf16_t* __restrict__ Kb, bf16_t* __restrict__ QR, const float* __restrict__ qk_g) {
  const int tidx = opaque_tid();
  const int lane = tidx & 63;
  const int gw = blockIdx.x * (NTHR / 64) + (tidx >> 6), nw = gridDim.x * (NTHR / 64);
  const int qd = lane & 3;
  float gq[16], gk[16], inv[16];
#pragma unroll
  for (int i = 0; i < 16; ++i) { gq[i] = qk_g[qd * 16 + i]; gk[i] = qk_g[64 + qd * 16 + i]; inv[i] = exp2f(-(float)i * (13.287712379549449f / 16.f)); }
  for (int row = gw; row < MT; row += nw) {
    const bool lat = row < ML;
    const size_t off = (size_t)row * 1024 + lane * 16;
    float cs[16], sn[16];
    if (lat) {
      const int t = row & 4095;
      const float pos = (float)((qd >> 1) ? (t & 63) : (t >> 6));
#pragma unroll
      for (int i = 0; i < 16; ++i) {
        float rev = pos * inv[i] * 0.15915494309189535f;
        rev -= floorf(rev);
        sn[i] = __builtin_amdgcn_sinf(rev); cs[i] = __builtin_amdgcn_cosf(rev);
      }
    }
#pragma unroll
    for (int which = 0; which < 2; ++which) {
      bf16_t* P = which ? Kb : Q;
      const u32x4 a = *(const u32x4*)(P + off), b2 = *(const u32x4*)(P + off + 8);
      const unsigned u[8] = {a.x, a.y, a.z, a.w, b2.x, b2.y, b2.z, b2.w};
      float x[16];
#pragma unroll
      for (int i = 0; i < 8; ++i) { x[2 * i] = bf_lo(u[i]); x[2 * i + 1] = bf_hi(u[i]); }
      float ss = 0.f;
#pragma unroll
      for (int i = 0; i < 16; ++i) ss += x[i] * x[i];
      ss += __shfl_xor(ss, 1); ss += __shfl_xor(ss, 2);
      const float rstd = rsqrtf(ss * (1.f / 64.f) + 1e-6f);
#pragma unroll
      for (int i = 0; i < 16; ++i) x[i] = x[i] * rstd * (which ? gk[i] : gq[i]);
      unsigned pl[8];
#pragma unroll
      for (int i = 0; i < 8; ++i) pl[i] = pk_bf16(x[2 * i], x[2 * i + 1]);
      unsigned rt[8];
      if (lat) {
        float y[16];
#pragma unroll
        for (int i = 0; i < 16; ++i) {
          const float pr = __shfl_xor(x[i], 1);
          y[i] = x[i] * cs[i] + ((qd & 1) ? pr * sn[i] : -pr * sn[i]);
        }
#pragma unroll
        for (int i = 0; i < 8; ++i) rt[i] = pk_bf16(y[2 * i], y[2 * i + 1]);
      }
      if (which == 0) {
        *(u32x4*)(Q + off) = mk4(pl[0], pl[1], pl[2], pl[3]);
        *(u32x4*)(Q + off + 8) = mk4(pl[4], pl[5], pl[6], pl[7]);
        if (lat) { *(u32x4*)(QR + off) = mk4(rt[0], rt[1], rt[2], rt[3]); *(u32x4*)(QR + off + 8) = mk4(rt[4], rt[5], rt[6], rt[7]); }
      } else {
        if (lat) { *(u32x4*)(Kb + off) = mk4(rt[0], rt[1], rt[2], rt[3]); *(u32x4*)(Kb + off + 8) = mk4(rt[4], rt[5], rt[6], rt[7]); }
        else { *(u32x4*)(Kb + off) = mk4(pl[0], pl[1], pl[2], pl[3]); *(u32x4*)(Kb + off + 8) = mk4(pl[4], pl[5], pl[6], pl[7]); }
      }
    }
  }
}

struct AttnState { f32x16 O[2][2]; float m[2], l[2]; };

DEVI void attn_load_k(u32x4 (&kf)[4], const bf16_t* __restrict__ kbase, int lane) {
  const int l31 = lane & 31, lh = lane >> 5;
#pragma unroll
  for (int ks = 0; ks < 4; ++ks) kf[ks] = *(const u32x4*)(kbase + (size_t)l31 * 1024 + ks * 16 + 8 * lh);
}

DEVI void attn_compute(AttnState& st, const u32x4* qs, const bf16_t* __restrict__ kbase, const bf16_t* __restrict__ vtbase, int vtT,
                       const float* __restrict__ rpbs, bool band, int brow, int half, int lane) {
  const int l31 = lane & 31, lh = lane >> 5;
  u32x4 kf[4];
  attn_load_k(kf, kbase, lane);
  u32x4 vf[4];
#pragma unroll
  for (int dt = 0; dt < 2; ++dt)
#pragma unroll
    for (int s = 0; s < 2; ++s) {
      const bf16_t* vp = vtbase + (size_t)(dt * 32 + l31) * vtT + 16 * s + 4 * lh;
      const u32x2 lo = *(const u32x2*)vp, hi = *(const u32x2*)(vp + 8);
      vf[dt * 2 + s] = mk4(lo.x, lo.y, hi.x, hi.y);
    }
  __builtin_amdgcn_sched_barrier(0);
  constexpr float SC = 0.125f * 1.4426950408889634f;
  u32x4 pf[2][2];
#pragma unroll
  for (int qt = 0; qt < 2; ++qt) {
    f32x16 S;
#pragma unroll
    for (int r = 0; r < 16; ++r) S[r] = 0.f;
#pragma unroll
    for (int ks = 0; ks < 4; ++ks) S = mfma32(kf[ks], qs[(qt * 4 + ks) * 64], S);
    float cmax = -INFINITY;
    if (band) {
      const int qc = qt * 32 + l31;
      const int cst = min(max(qc - 8, 0), 48);
#pragma unroll
      for (int r = 0; r < 16; ++r) {
        const int key = (r & 3) + 8 * (r >> 2) + 4 * lh;
        const int kc = half * 32 + key;
        const bool ok = (kc >= cst) && (kc < cst + 16);
        const int bi = ok ? (brow * 31 + kc - qc + 15) : 0;
        const float sv = S[r] * SC + rpbs[bi];
        S[r] = ok ? sv : -INFINITY;
        cmax = fmaxf(cmax, S[r]);
      }
    } else {
#pragma unroll
      for (int r = 0; r < 16; ++r) { S[r] *= SC; cmax = fmaxf(cmax, S[r]); }
    }
    cmax = fmaxf(cmax, __shfl_xor(cmax, 32));
    const float mnew = fmaxf(st.m[qt], cmax);
    const float alpha = __builtin_amdgcn_exp2f(st.m[qt] - mnew);
    const bool grew = mnew > st.m[qt];
    st.m[qt] = mnew;
    float ps = 0.f;
#pragma unroll
    for (int r = 0; r < 16; ++r) { S[r] = __builtin_amdgcn_exp2f(S[r] - mnew); ps += S[r]; }
    st.l[qt] = st.l[qt] * alpha + ps;
    if (__any(grew)) {
#pragma unroll
      for (int dt = 0; dt < 2; ++dt)
#pragma unroll
        for (int r = 0; r < 16; ++r) st.O[qt][dt][r] *= alpha;
    }
    pf[qt][0] = mk4(pk_bf16(S[0], S[1]), pk_bf16(S[2], S[3]), pk_bf16(S[4], S[5]), pk_bf16(S[6], S[7]));
    pf[qt][1] = mk4(pk_bf16(S[8], S[9]), pk_bf16(S[10], S[11]), pk_bf16(S[12], S[13]), pk_bf16(S[14], S[15]));
  }
#pragma unroll
  for (int dt = 0; dt < 2; ++dt)
#pragma unroll
    for (int s = 0; s < 2; ++s) {
      st.O[0][dt] = mfma32(vf[dt * 2 + s], pf[0][s], st.O[0][dt]);
      st.O[1][dt] = mfma32(vf[dt * 2 + s], pf[1][s], st.O[1][dt]);
    }
}

__device__ __forceinline__ void natten_phase(char* lds, const bf16_t* __restrict__ Q, const bf16_t* __restrict__ QR, const bf16_t* __restrict__ Kb,
                             const bf16_t* __restrict__ VT, bf16_t* __restrict__ G, const float* __restrict__ rpb, bf16_t* __restrict__ Zd) {
  float* rpbs = (float*)lds;
  __syncthreads();
  for (int e = threadIdx.x; e < 16 * 465; e += NTHR) rpbs[e] = rpb[e] * 1.4426950408889634f;
  __syncthreads();
  const int tidx = opaque_tid();
  const int lane = tidx & 63, l31 = lane & 31, lh = lane >> 5;
  const int gw = blockIdx.x * (NTHR / 64) + (tidx >> 6), nw = gridDim.x * (NTHR / 64);
  const bf16_t* VTC = VT + (size_t)ML * 1024;
  u32x4* qs = (u32x4*)(lds + 32768) + (tidx >> 6) * 512 + lane;
  const int xcd = blockIdx.x & 7, wx = (blockIdx.x >> 3) * (NTHR / 64) + (tidx >> 6), nwx = (gridDim.x >> 3) * (NTHR / 64);
  for (int i = wx; i < 1024 + 64; i += nwx) {
    const bool lat = i < 1024;
    int b, h, r = 0, qrow0;
    if (lat) { const int pair = xcd * 16 + (i >> 6); r = i & 63; b = pair >> 4; h = pair & 15; qrow0 = b * 4096 + r * 64; }
    else { const int it = i - 1024; const int pair = xcd * 16 + (it >> 2); const int qt64 = it & 3; b = pair >> 4; h = pair & 15; qrow0 = ML + b * 256 + qt64 * 64; }
    const int start = min(max(r - 4, 0), 56);
    const int nchunks = lat ? 24 : 8;
    AttnState st;
#pragma unroll
    for (int a = 0; a < 2; ++a) { st.m[a] = -INFINITY; st.l[a] = 0.f;
#pragma unroll
      for (int c = 0; c < 2; ++c)
#pragma unroll
        for (int rr = 0; rr < 16; ++rr) st.O[a][c][rr] = 0.f; }
#pragma unroll
    for (int qt = 0; qt < 2; ++qt)
#pragma unroll
      for (int ks = 0; ks < 4; ++ks) qs[(qt * 4 + ks) * 64] = *(const u32x4*)(Q + (size_t)(qrow0 + qt * 32 + l31) * 1024 + h * 64 + ks * 16 + 8 * lh);
    for (int j = 0; j < nchunks; ++j) {
      if (j == 8) {
#pragma unroll
        for (int qt = 0; qt < 2; ++qt)
#pragma unroll
          for (int ks = 0; ks < 4; ++ks) qs[(qt * 4 + ks) * 64] = *(const u32x4*)(QR + (size_t)(qrow0 + qt * 32 + l31) * 1024 + h * 64 + ks * 16 + 8 * lh);
      }
      const bool band = j >= 8;
      const int ii = j - 8, kr = start + (ii >> 1), half = band ? (ii & 1) : 0;
      const size_t krow = band ? (size_t)(b * 4096 + kr * 64 + half * 32) : (size_t)(ML + b * 256 + j * 32);
      const bf16_t* kbase = Kb + krow * 1024 + h * 64;
      const bf16_t* vtb = band ? VT + (size_t)(b * 16 + h) * 64 * 4096 + kr * 64 + half * 32 : VTC + (size_t)(b * 16 + h) * 64 * 256 + j * 32;
      attn_compute(st, qs, kbase, vtb, band ? 4096 : 256, rpbs, band, band ? h * 15 + (kr - r + 7) : 0, half, lane);
    }
#pragma unroll
    for (int qt = 0; qt < 2; ++qt) {
      const float lt = st.l[qt] + __shfl_xor(st.l[qt], 32);
      const float inv = 1.f / lt;
      bf16_t* grow = G + (size_t)(qrow0 + qt * 32 + l31) * 1024 + h * 64;
#pragma unroll
      for (int dt = 0; dt < 2; ++dt)
#pragma unroll
        for (int q4 = 0; q4 < 4; ++q4) {
          bf16_t* gp = grow + dt * 32 + 8 * q4 + 4 * lh;
          bf16_t* zp = Zd + (gp - G);
          const u32x2 gv = *(const u32x2*)gp;
          u32x2 o;
          o.x = pk_bf16(st.O[qt][dt][4 * q4] * inv * bf_lo(gv.x), st.O[qt][dt][4 * q4 + 1] * inv * bf_hi(gv.x));
          o.y = pk_bf16(st.O[qt][dt][4 * q4 + 2] * inv * bf_lo(gv.y), st.O[qt][dt][4 * q4 + 3] * inv * bf_hi(gv.y));
          *(u32x2*)zp = o;
        }
    }
  }
}

namespace pg8 {
#define PG8_LAS __attribute__((address_space(3)))
typedef unsigned short bf16_t;
typedef short bf16x8 __attribute__((ext_vector_type(8)));
typedef float f32x4 __attribute__((ext_vector_type(4)));
typedef unsigned u32x4 __attribute__((ext_vector_type(4)));
constexpr int BM = 256, BK = 64, HALF = 128, HTB = HALF * BK * 2  , STAGE_BYTES = 8 * HTB, NXCD = 8, WGM = 8;

__host__ __device__ __forceinline__ int lds_byte(int r, int c) { const int st = (r >> 4) * 2 + (c >> 5), rr = r & 15, cc = c & 31, ob = rr * 64 + cc * 2; return st * 1024 + (ob ^ (((ob >> 9) & 1) << 5)); }
__host__ __device__ __forceinline__ void stage_rc(int b, int& R, int& C) { const int st = b / 1024, sb = b % 1024, swz = sb ^ (((sb >> 9) & 1) << 5); R = (st >> 1) * 16 + swz / 64; C = (st & 1) * 32 + (swz % 64) / 2; }
__host__ __device__ __forceinline__ int perm32(int rho) { const int n = rho >> 4, i = rho & 15; return 8 * (i >> 2) + 4 * n + (i & 3); }

struct Unit { int pm, pn; };
struct Gemm { const bf16_t* A; const bf16_t* Bt; int M, N, K; };

struct StaticOrder {
    int nM, nN, nwg, G, c;
    __host__ __device__ void init(int M, int N, int G_, int c_) { nM = M / BM; nN = N / BM; nwg = nM * nN; G = G_; c = c_; }
    __host__ __device__ bool next(int i, Unit& u) const {
        const long L = (long)i * G + c; if (L >= nwg) return false;
        int wgid = (int)L; { const int q = nwg / NXCD, r = nwg % NXCD, xcd = wgid % NXCD, off = wgid / NXCD; wgid = (xcd < r ? xcd * (q + 1) : r * (q + 1) + (xcd - r) * q) + off; }
        const int nig = WGM * nN, gid = wgid / nig, fm = gid * WGM, gsz = (nM - fm) < WGM ? (nM - fm) : WGM;
        u.pm = fm + ((wgid % nig) % gsz); u.pn = (wgid % nig) / gsz; return true;
    }
    __device__ __forceinline__ void a_ready(const Unit&) const {}
    __device__ __forceinline__ void done(const Unit&) const {}
};
template <class Epi, class Sched, bool STAMP = false>
__device__ __forceinline__ void gemm_phase(PG8_LAS unsigned char* lds, const Gemm g, const Sched& S, const Epi& E, unsigned long long* stamps) {
    const int tid = threadIdx.x, wid = __builtin_amdgcn_readfirstlane(tid >> 6), lane = tid & 63, wr = wid >> 2, wc = wid & 3, fr = lane & 15, fq = lane >> 4;
    const int K = g.K, nt = K / BK;
    int ts_lo = 0, ts_hi = 0, nts = 0; const unsigned long long rt_entry = STAMP ? (unsigned long long)wall_clock64() : 0ull;
#define PG8_STAMP() do { if (STAMP && wid == 0 && nts < 64) { const unsigned long long _c = (unsigned long long)clock64(); \
        ts_lo = (lane == nts) ? (int)(unsigned)_c : ts_lo; ts_hi = (lane == nts) ? (int)(unsigned)(_c >> 32) : ts_hi; ++nts; } } while (0)
    PG8_STAMP();
    unsigned voffA[2], voffB[2];
#pragma unroll
    for (int i = 0; i < 2; ++i) { int R, C; stage_rc(tid * 16 + i * 8192, R, C); const int Rb = Epi::PERM ? ((R & ~31) + perm32(R & 31)) : R;
        voffA[i] = (unsigned)(R * K + C) * 2u; voffB[i] = (unsigned)(Rb * K + C) * 2u; }
    const size_t kstep = (size_t)(BK * 2);
    const size_t hstep = (size_t)HALF * K * 2;
    const size_t tstep = 2 * hstep;
    const unsigned ldsw = (unsigned)wid * 1024u;
    const int aoff = lds_byte(wr * 64 + fr, fq * 8), boff = lds_byte(wc * 32 + fr, fq * 8);
#define PG8_SA(b, h) (((b) * 2 + (h)) * HTB)
#define PG8_SB(b, h) ((4 + (b) * 2 + (h)) * HTB)
#define PG8_STAGE(bufoff, gbase, voff) do { _Pragma("unroll") for (int _i = 0; _i < 2; ++_i) \
        __builtin_amdgcn_global_load_lds((const unsigned*)((const char*)(gbase) + (voff)[_i]), (PG8_LAS unsigned*)(lds + (bufoff) + ldsw + _i * 8192), 16, 0, 0); } while (0)
#define PG8_LDA(dst, b, h) do { _Pragma("unroll") for (int m = 0; m < 4; ++m) _Pragma("unroll") for (int k = 0; k < 2; ++k) dst[m][k] = *(const PG8_LAS bf16x8*)(lds + PG8_SA(b, h) + aoff + m * 2048 + k * 1024); } while (0)
#define PG8_LDB(dst, b, h) do { _Pragma("unroll") for (int n = 0; n < 2; ++n) _Pragma("unroll") for (int k = 0; k < 2; ++k) dst[n][k] = *(const PG8_LAS bf16x8*)(lds + PG8_SB(b, h) + boff + n * 2048 + k * 1024); } while (0)
#define PG8_MMA(ai, bj, At, Bt) do { __builtin_amdgcn_s_setprio(1); _Pragma("unroll") for (int m = 0; m < 4; ++m) _Pragma("unroll") for (int n = 0; n < 2; ++n) _Pragma("unroll") for (int k = 0; k < 2; ++k) \
        acc[ai][bj][m][n] = __builtin_amdgcn_mfma_f32_16x16x32_bf16(Bt[n][k], At[m][k], acc[ai][bj][m][n], 0, 0, 0); __builtin_amdgcn_s_setprio(0); } while (0)
#define PG8_WAIT_V(n) asm volatile("s_waitcnt vmcnt(" #n ")" ::: "memory")
#define PG8_WAIT_L(n) asm volatile("s_waitcnt lgkmcnt(" #n ")" ::: "memory")
#define PG8_BAR __builtin_amdgcn_s_barrier()
#define PG8_SCHED __builtin_amdgcn_sched_barrier(0)
    Unit cur, nxt; int ui = 0;
    if (!S.next(0, cur)) return;
    f32x4 acc[2][2][4][2];
#pragma unroll
    for (int a = 0; a < 2; ++a)
#pragma unroll
        for (int b = 0; b < 2; ++b)
#pragma unroll
            for (int m = 0; m < 4; ++m)
#pragma unroll
                for (int n = 0; n < 2; ++n) acc[a][b][m][n] = (f32x4){0.f, 0.f, 0.f, 0.f};
    bf16x8 At[4][2], B0[2][2], B1[2][2];
    const char* cA = (const char*)g.A + (size_t)cur.pm * tstep; const char* cB = (const char*)g.Bt + (size_t)cur.pn * tstep;
    S.a_ready(cur);
    PG8_STAGE(PG8_SB(0, 0), cB, voffB); PG8_STAGE(PG8_SA(0, 0), cA, voffA); PG8_STAGE(PG8_SB(0, 1), cB + hstep, voffB); PG8_STAGE(PG8_SA(0, 1), cA + hstep, voffA);
    if (wr == 1) PG8_BAR;
    PG8_WAIT_V(4); PG8_BAR;
    PG8_STAGE(PG8_SB(1, 0), cB + kstep, voffB); PG8_STAGE(PG8_SA(1, 0), cA + kstep, voffA); PG8_STAGE(PG8_SB(1, 1), cB + hstep + kstep, voffB);
    PG8_WAIT_V(6); PG8_BAR;
    PG8_STAMP();
    for (;;) {
        const bool has_next = S.next(ui + 1, nxt);
        const char* nA = has_next ? (const char*)g.A + (size_t)nxt.pm * tstep : cA; const char* nB = has_next ? (const char*)g.Bt + (size_t)nxt.pn * tstep : cB;
        for (int t = 0; t < nt; t += 2) {
            const bool last = (t == nt - 2);
            const char* a1 = cA + (size_t)(t + 1) * kstep;
            const char* a2 = last ? nA : cA + (size_t)(t + 2) * kstep; const char* b2 = last ? nB : cB + (size_t)(t + 2) * kstep;
            const char* a3 = a2 + kstep; const char* b3 = b2 + kstep;
            if (last && has_next) S.a_ready(nxt);
            PG8_LDB(B0, 0, 0); PG8_SCHED; PG8_LDA(At, 0, 0); PG8_STAGE(PG8_SA(1, 1), a1 + hstep, voffA);
            PG8_WAIT_L(8); PG8_BAR; PG8_WAIT_L(0); PG8_MMA(0, 0, At, B0); PG8_BAR; PG8_SCHED;
            PG8_LDB(B1, 0, 1); PG8_STAGE(PG8_SB(0, 0), b2, voffB);
            PG8_BAR; PG8_WAIT_L(0); PG8_MMA(0, 1, At, B1); PG8_BAR;
            PG8_LDA(At, 0, 1); PG8_STAGE(PG8_SA(0, 0), a2, voffA);
            PG8_BAR; PG8_WAIT_L(0); PG8_MMA(1, 0, At, B0); PG8_BAR; PG8_SCHED;
            PG8_STAGE(PG8_SB(0, 1), b2 + hstep, voffB);
            PG8_WAIT_V(6); PG8_BAR; PG8_MMA(1, 1, At, B1); PG8_BAR;
            PG8_LDB(B0, 1, 0); PG8_SCHED; PG8_LDA(At, 1, 0); PG8_STAGE(PG8_SA(0, 1), a2 + hstep, voffA);
            PG8_WAIT_L(8); PG8_BAR; PG8_WAIT_L(0); PG8_MMA(0, 0, At, B0); PG8_BAR; PG8_SCHED;
            PG8_LDB(B1, 1, 1); PG8_STAGE(PG8_SB(1, 0), b3, voffB);
            PG8_BAR; PG8_WAIT_L(0); PG8_MMA(0, 1, At, B1); PG8_BAR;
            PG8_LDA(At, 1, 1); PG8_STAGE(PG8_SA(1, 0), a3, voffA);
            PG8_BAR; PG8_WAIT_L(0); PG8_MMA(1, 0, At, B0); PG8_BAR; PG8_SCHED;
            PG8_STAGE(PG8_SB(1, 1), b3 + hstep, voffB);
            PG8_WAIT_V(6); PG8_BAR; PG8_MMA(1, 1, At, B1); PG8_BAR;
        }
        PG8_STAMP();
        if constexpr (!Epi::AFTER_DRAIN) { E(acc, cur, wr, wc, fr, fq); S.done(cur); }
        PG8_STAMP();
        if (!has_next) break;
#pragma unroll
        for (int a = 0; a < 2; ++a)
#pragma unroll
            for (int b = 0; b < 2; ++b)
#pragma unroll
                for (int m = 0; m < 4; ++m)
#pragma unroll
                    for (int n = 0; n < 2; ++n) acc[a][b][m][n] = (f32x4){0.f, 0.f, 0.f, 0.f};
        cur = nxt; cA = nA; cB = nB; ++ui;
    }
    PG8_WAIT_V(0);
    if (wr == 0) PG8_BAR;
    PG8_BAR;
    if constexpr (Epi::AFTER_DRAIN) { E.fused(acc, cur, wr, wc, fr, fq, lds, wid, lane); S.done(cur); }
    PG8_STAMP();
    if (STAMP && wid == 0) { stamps[lane] = lane < nts ? (((unsigned long long)(unsigned)ts_hi << 32) | (unsigned)ts_lo) : 0ull;
        if (lane == 62) stamps[62] = rt_entry; if (lane == 63) stamps[63] = (unsigned long long)wall_clock64(); }
#undef PG8_STAMP
#undef PG8_SA
#undef PG8_SB
#undef PG8_STAGE
#undef PG8_LDA
#undef PG8_LDB
#undef PG8_MMA
#undef PG8_WAIT_V
#undef PG8_WAIT_L
#undef PG8_BAR
#undef PG8_SCHED
}
}

template <class EP> struct Pg8Epi {
  static constexpr bool PERM = false, AFTER_DRAIN = false;
  EP ep;
  __device__ __forceinline__ void operator()(const pg8::f32x4 (&acc)[2][2][4][2], const pg8::Unit& u, int wr, int wc, int fr, int fq) const {
#pragma unroll
    for (int ai = 0; ai < 2; ++ai)
#pragma unroll
      for (int m = 0; m < 4; ++m)
#pragma unroll
        for (int bj = 0; bj < 2; ++bj)
#pragma unroll
          for (int n = 0; n < 2; ++n) {
            const int row = u.pm * 256 + ai * 128 + wr * 64 + m * 16 + fr;
            const int col = u.pn * 256 + bj * 128 + wc * 32 + n * 16 + fq * 4;
            ep(row, col, acc[ai][bj][m][n]);
          }
  }
};
template <class EP>
__device__ __forceinline__ void pg8_gemm(char* lds, const bf16_t* A, const bf16_t* Bt, int M, int N, int K, const EP ep) {
  __syncthreads();
  pg8::Gemm g{A, Bt, M, N, K};
  pg8::StaticOrder S; S.init(M, N, (int)gridDim.x, (int)blockIdx.x);
  Pg8Epi<EP> E{ep};
  pg8::gemm_phase<Pg8Epi<EP>, pg8::StaticOrder, false>((PG8_LAS unsigned char*)lds, g, S, E, nullptr);
  __syncthreads();
}

template <int ph>
__device__ __forceinline__ void run_phase(const Params& p, char* lds, bool last_rep) {
  char* ws = p.ws;
  const float* MOD = (const float*)(ws + OFF_MOD);
  float* XC = (float*)(ws + OFF_XC);
  bf16_t* HB = (bf16_t*)(ws + OFF_HB);
  bf16_t* A0 = (bf16_t*)(ws + OFF_A0); bf16_t* A1 = (bf16_t*)(ws + OFF_A1); bf16_t* A2 = (bf16_t*)(ws + OFF_A2);
  bf16_t* A3 = (bf16_t*)(ws + OFF_A3); bf16_t* A4 = (bf16_t*)(ws + OFF_A4);
  bf16_t* WD = (bf16_t*)(ws + OFF_WD); bf16_t* AD = (bf16_t*)(ws + OFF_AD);
  float* BON = (float*)(ws + OFF_BON);
  if (ph == 0) { phase0(p, lds); return; }
  constexpr int layer = (ph - 1) / 5, sub = (ph - 1) % 5;
  const float* modL = MOD + (size_t)layer * 9 * 3072;
  const float* xl_cur = layer == 0 ? p.in[0] : p.out;
  const float* xc_cur = layer == 0 ? p.in[2] : XC;
  if (layer == 0 || layer == 3) {
    const int ib = layer ? 33 : 4;
    const bf16_t* WIN = (const bf16_t*)(ws + (layer ? OFF_W3IN : OFF_W0IN));
    const bf16_t* WUP = (const bf16_t*)(ws + (layer ? OFF_W3UP : OFF_W0UP));
    const bf16_t* WOUT = (const bf16_t*)(ws + (layer ? OFF_W3OUT : OFF_W0OUT));
    if (sub == 0) norm_phase<true>(xl_cur, xc_cur, p.in[ib], modL, HB, A4);
    else if (sub == 1) { ALMix al{HB, A4, p.in[ib + 4]}; EpRwkvIn ep{A0, A1, A2, A3, WD, AD}; gemm256_phase(lds, WIN, 1024, MT / 256, 16, al, ep); gemm_phase(lds, WIN, 1024, MT / 256, 2, al, ep, 4096, true); }
    else if (sub == 2) rwkv_scan_phase(lds, A0, A1, A2, WD, AD, WUP, p.in[ib + 5], p.in[ib + 8], p.in[ib + 9], HB, A4, BON);
    else if (sub == 3) rwkv_post_phase(HB, A4, A2, A3, BON, p.in[ib + 10], layer == 3 ? ML : MT);
    else { ALPlain al{A3, 1024}; EpRes ep{xl_cur, xc_cur, p.out, XC, modL}; pg8_gemm(lds, A3, WOUT, ML, 1024, 1024, ep); if (layer != 3) gemm_phase(lds, WOUT, 1024, MC / 256, 8, al, ep, 0, false, ML / 256); }
  } else if (layer == 1) {
    bf16_t* HS0 = (bf16_t*)(ws + OFF_HS0); bf16_t* XR = (bf16_t*)(ws + OFF_XR); bf16_t* GG = (bf16_t*)(ws + OFF_GG); bf16_t* HS1 = (bf16_t*)(ws + OFF_HS1);
    if (sub == 0) norm_phase<false>(xl_cur, xc_cur, p.in[16], modL, HB, nullptr);
    else if (sub == 1) { ALPlain al{HB, 1024}; EpLruIn ep{XR, GG}; pg8_gemm(lds, HB, (const bf16_t*)(ws + OFF_W1IN), MT, 2816, 1024, ep); }
    else if (sub == 2) rglru_phase(lds, XR, (const bf16_t*)(ws + OFF_W1G), p.in[20], p.in[21], p.in[23], p.in[24], HS0, HS1);
    else if (sub == 3) lru_z_phase(HS0, HS1, GG);
    else { ALPlain al{GG, LW}; EpRes ep{xl_cur, xc_cur, p.out, XC, modL}; pg8_gemm(lds, GG, (const bf16_t*)(ws + OFF_W1OUT), ML, 1024, LW, ep); gemm_phase(lds, (const bf16_t*)(ws + OFF_W1OUT), LW, MC / 256, 8, al, ep, 0, false, ML / 256); }
  } else {
    if (sub == 0) norm_phase<false>(xl_cur, xc_cur, p.in[26], modL, HB, nullptr);
    else if (sub == 1) { ALPlain al{HB, 1024}; EpNatIn ep{A0, A1, A2, A3}; pg8_gemm(lds, HB, (const bf16_t*)(ws + OFF_W2IN), MT, 4096, 1024, ep); }
    else if (sub == 2) nat_qk_phase(A0, A1, A4, p.in[30]);
    else if (sub == 3) natten_phase(lds, A0, A4, A1, A2, A3, p.in[31], last_rep ? A3 : HB);
    else { ALPlain al{A3, 1024}; EpRes ep{xl_cur, xc_cur, p.out, XC, modL}; pg8_gemm(lds, A3, (const bf16_t*)(ws + OFF_W2OUT), ML, 1024, 1024, ep); gemm_phase(lds, (const bf16_t*)(ws + OFF_W2OUT), 1024, MC / 256, 8, al, ep, 0, false, ML / 256); }
  }
}

__global__ void __launch_bounds__(NTHR) mega_kernel(Params p) {
  __shared__ __attribute__((aligned(16))) char lds[LDS_BYTES];
  __shared__ u32x4 xb_words;
  cg::grid_group grid = cg::this_grid();
  if (threadIdx.x == 0) xb_words = (u32x4){0u, 0u, 0u, 0u};
  __syncthreads();
  const XcdBarrier xb = xcd_barrier_post((unsigned*)(p.ws + OFF_BAR), (volatile LAS unsigned*)&xb_words);
#define PHASE(k) if (p.ph_lo <= k && k < p.ph_hi) { for (int rep = 0; rep < REP[k]; ++rep) { run_phase<k>(p, lds, rep + 1 == REP[k]); if (rep + 1 < REP[k] || k + 1 < p.ph_hi) { if (k == 0) grid.sync(); else xcd_barrier(xb); } } }
  PHASE(0) PHASE(1) PHASE(2) PHASE(3) PHASE(4) PHASE(5) PHASE(6) PHASE(7) PHASE(8) PHASE(9) PHASE(10)
  PHASE(11) PHASE(12) PHASE(13) PHASE(14) PHASE(15) PHASE(16) PHASE(17) PHASE(18) PHASE(19) PHASE(20)
#undef PHASE
}

extern "C" void kernel_launch(void* const* d_in, const int* in_sizes, int n_in, void* d_out, int out_size, void* d_ws, size_t ws_size,
                              hipStream_t stream) {
  static int grid_blocks = 0;
  if (!grid_blocks) {
    int dev = 0, cus = 0, per_cu = 0;
    hipGetDevice(&dev);
    hipDeviceGetAttribute(&cus, hipDeviceAttributeMultiprocessorCount, dev);
    hipOccupancyMaxActiveBlocksPerMultiprocessor(&per_cu, mega_kernel, NTHR, 0);
    if (per_cu < 1) { fprintf(stderr, "occupancy query returned %d\n", per_cu); per_cu = 1; }
    if (per_cu > 1) per_cu = 1;
    grid_blocks = cus * per_cu;
    if (n_in != 45 || ws_size < WS_END) fprintf(stderr, "unexpected n_in %d / ws %zu (need %zu)\n", n_in, ws_size, (size_t)WS_END);
  }
  Params p{};
  for (int i = 0; i < 45; ++i) p.in[i] = (const float*)d_in[i];
  p.out = (float*)d_out;
  p.ws = (char*)d_ws;
  (void)hipMemsetAsync((char*)d_ws + OFF_BAR, 0, XCD_BAR_WORDS * 4, stream);
#if N_LAUNCH_MODE == 1
  p.ph_lo = 0; p.ph_hi = NPHASE;
  void* args[] = {&p};
  hipError_t e = hipLaunchCooperativeKernel((void*)mega_kernel, dim3(grid_blocks), dim3(NTHR), args, 0, stream);
  if (e != hipSuccess) fprintf(stderr, "cooperative launch failed: %s (grid %d)\n", hipGetErrorString(e), grid_blocks);
#else
  for (int ph = 0; ph < NPHASE; ++ph) {
    p.ph_lo = ph; p.ph_hi = ph + 1;
    hipLaunchKernelGGL(mega_kernel, dim3(grid_blocks), dim3(NTHR), 0, stream, p);
  }
#endif
}
```

```cpp
#include <hip/hip_runtime.h>
#include <hip/hip_cooperative_groups.h>
#include <cstdio>
#include <cstdint>
namespace cg = cooperative_groups;

#ifndef N_LAUNCH_MODE
#define N_LAUNCH_MODE 1
#endif

typedef unsigned short bf16_t;
typedef short bf16x8 __attribute__((ext_vector_type(8)));
typedef float f32x4 __attribute__((ext_vector_type(4)));
typedef float f32x16 __attribute__((ext_vector_type(16)));
typedef float f32x2 __attribute__((ext_vector_type(2)));
typedef unsigned u32x4 __attribute__((ext_vector_type(4)));
typedef unsigned u32x2 __attribute__((ext_vector_type(2)));

#define DEVI __device__ __forceinline__

constexpr int D = 1024, NB = 8, SEQ = 4096, CTX = 256;
constexpr int ML = NB * SEQ;
constexpr int MC = NB * CTX;
constexpr int MT = ML + MC;
constexpr int LW = 1408;
constexpr int NTHR = 512;
constexpr int NPHASE = 21;
constexpr int LDS_BYTES = 163840 - 16;
__device__ constexpr int REP[21] = {1,1,1,1,1,1,1,1,1,1,1,1,1,1,1,1,1,1,1,1,1};

constexpr size_t SZ_ACT = (size_t)MT * 1024 * 2;
constexpr size_t OFF_MOD = 0;
constexpr size_t OFF_BAR = 458752;
constexpr size_t OFF_W0IN = 524288;
constexpr size_t SZ_RWIN = (size_t)4352 * 1024 * 2;
constexpr size_t SZ_RWUP = (size_t)4 * 1024 * 64 * 2;
constexpr size_t SZ_SQ = (size_t)1024 * 1024 * 2;
constexpr size_t OFF_W0UP = OFF_W0IN + SZ_RWIN;
constexpr size_t OFF_W0OUT = OFF_W0UP + SZ_RWUP;
constexpr size_t OFF_W3IN = OFF_W0OUT + SZ_SQ;
constexpr size_t OFF_W3UP = OFF_W3IN + SZ_RWIN;
constexpr size_t OFF_W3OUT = OFF_W3UP + SZ_RWUP;
constexpr size_t OFF_W1IN = OFF_W3OUT + SZ_SQ;
constexpr size_t OFF_W1G = OFF_W1IN + (size_t)2816 * 1024 * 2;
constexpr size_t OFF_W1OUT = OFF_W1G + (size_t)16 * 4 * 96 * 96 * 2;
constexpr size_t OFF_W2IN = OFF_W1OUT + (size_t)1024 * 1408 * 2;
constexpr size_t OFF_W2OUT = OFF_W2IN + (size_t)4096 * 1024 * 2;
constexpr size_t OFF_XC = OFF_W2OUT + SZ_SQ;
constexpr size_t OFF_BON = OFF_XC + (size_t)MC * 1024 * 4;
constexpr size_t OFF_BIG = OFF_BON + (size_t)2 * MT * 16 * 4;
constexpr size_t OFF_HB = OFF_BIG;
constexpr size_t OFF_A0 = OFF_BIG + SZ_ACT;
constexpr size_t OFF_A1 = OFF_A0 + SZ_ACT;
constexpr size_t OFF_A2 = OFF_A1 + SZ_ACT;
constexpr size_t OFF_A3 = OFF_A2 + SZ_ACT;
constexpr size_t OFF_A4 = OFF_A3 + SZ_ACT;
constexpr size_t OFF_WD = OFF_A4 + SZ_ACT;
constexpr size_t OFF_AD = OFF_WD + (size_t)MT * 128 * 2;
constexpr size_t WS_END = OFF_AD + (size_t)MT * 128 * 2;
constexpr size_t SZ_LRU = (size_t)MT * LW * 2;
constexpr size_t OFF_HS0 = OFF_BIG;
constexpr size_t OFF_XR = OFF_BIG + SZ_LRU;
constexpr size_t OFF_GG = OFF_XR + SZ_LRU;
constexpr size_t OFF_HS1 = OFF_GG + SZ_LRU;
static_assert(OFF_HS1 + SZ_LRU <= WS_END, "lru overlay");
static_assert(WS_END <= (size_t)536870912, "ws");

struct Params {
  const float* in[45];
  float* out;
  char* ws;
  int ph_lo, ph_hi;
};

DEVI u32x4 mk4(unsigned a, unsigned b, unsigned c, unsigned d) { u32x4 r = {a, b, c, d}; return r; }
DEVI int opaque_tid() { int t = threadIdx.x; asm volatile("" : "+v"(t)); return t; }
DEVI float bf_lo(unsigned u) { return __uint_as_float(u << 16); }
DEVI float bf_hi(unsigned u) { return __uint_as_float(u & 0xffff0000u); }
DEVI float bf2f(bf16_t h) { return __uint_as_float(((unsigned)h) << 16); }
typedef __bf16 bf16x2_t __attribute__((ext_vector_type(2)));
DEVI unsigned pk_bf16(float lo, float hi) { f32x2 f = {lo, hi}; bf16x2_t v = __builtin_convertvector(f, bf16x2_t); return __builtin_bit_cast(unsigned, v); }
DEVI bf16_t f2bf(float f) { return (bf16_t)(pk_bf16(f, 0.f) & 0xffffu); }
DEVI float wave_sum(float v) {
#pragma unroll
  for (int o = 32; o; o >>= 1) v += __shfl_xor(v, o);
  return v;
}
DEVI float sigmoidf_(float x) { return __builtin_amdgcn_rcpf(1.f + __expf(-x)); }
DEVI float siluf_(float x) { return x * __builtin_amdgcn_rcpf(1.f + __expf(-x)); }
DEVI float softplusf_(float x) { return fmaxf(x, 0.f) + __logf(1.f + __expf(-fabsf(x))); }
DEVI f32x16 mfma32(u32x4 a, u32x4 b, f32x16 c) {
  return __builtin_amdgcn_mfma_f32_32x32x16_bf16(__builtin_bit_cast(bf16x8, a), __builtin_bit_cast(bf16x8, b), c, 0, 0, 0);
}
DEVI f32x4 mfma16(u32x4 a, u32x4 b, f32x4 c) {
  return __builtin_amdgcn_mfma_f32_16x16x32_bf16(__builtin_bit_cast(bf16x8, a), __builtin_bit_cast(bf16x8, b), c, 0, 0, 0);
}
template <int CTRL> DEVI float dpp_f(float v) {
  return __int_as_float(__builtin_amdgcn_update_dpp(0, __float_as_int(v), CTRL, 0xf, 0xf, true));
}
DEVI float sum8(float v) {
  v += dpp_f<0xB1>(v);
  v += dpp_f<0x4E>(v);
  v += dpp_f<0x141>(v);
  return v;
}

#define XB_TMO      128
#define XB_XCNT(j)  (256  + 64 * (j))
#define XB_XSUB(j)  (1280 + 64 * (j))
#define XB_XGEN(j)  (2304 + 64 * (j))
#define XB_TOP      3328
#define XB_TOPGEN   3392
#define XCD_BAR_WORDS 3456
#define XB_SPIN_CAP (1u << 18)
#define LAS __attribute__((address_space(3)))

__device__ __forceinline__ unsigned xb_ld(unsigned* p)              { return __hip_atomic_load(p, __ATOMIC_RELAXED, __HIP_MEMORY_SCOPE_AGENT); }
__device__ __forceinline__ unsigned xb_add(unsigned* p, unsigned v) { return __hip_atomic_fetch_add(p, v, __ATOMIC_RELAXED, __HIP_MEMORY_SCOPE_AGENT); }
__device__ __forceinline__ unsigned xb_xcc_id() { return (unsigned)__builtin_amdgcn_s_getreg((3 << 11) | 20) & 0xFu; }
#define XB_SPIN(cond, bar) do { unsigned _sp = 0; while (cond) { __builtin_amdgcn_s_sleep(1); \
    if ((++_sp & 255u) == 0u) { if (xb_ld(&(bar)[XB_TMO])) break; if (_sp > XB_SPIN_CAP) { atomicAdd(&(bar)[XB_TMO], 1u); break; } } } } while (0)

struct XcdBarrier {
    unsigned* bar; unsigned x;
    volatile LAS unsigned* st;
};

__device__ __forceinline__ XcdBarrier xcd_barrier_post(unsigned* bar, volatile LAS unsigned* st) {
    XcdBarrier b; b.bar = bar; b.x = xb_xcc_id(); b.st = st;
    if (threadIdx.x == 0) (void)xb_add(&bar[XB_XCNT(b.x)], 1u);
    return b;
}
__device__ __forceinline__ void xcd_barrier_complete(unsigned* bar, unsigned x, unsigned& nloc, unsigned& nx) {
    const unsigned G = gridDim.x * gridDim.y * gridDim.z;
    unsigned sum, cnt, mine, sp = 0u;
    for (;;) {
        sum = 0u; cnt = 0u; mine = 0u;
#pragma unroll
        for (unsigned j = 0; j < 16; ++j) { const unsigned c = xb_ld(&bar[XB_XCNT(j)]); sum += c; cnt += (c > 0u) ? 1u : 0u; mine = (j == x) ? c : mine; }
        if (sum == G) break;
        __builtin_amdgcn_s_sleep(1);
        if ((++sp & 255u) == 0u) { if (xb_ld(&bar[XB_TMO])) break; if (sp > XB_SPIN_CAP) { atomicAdd(&bar[XB_TMO], 1u); break; } }
    }
    nloc = mine > 0u ? mine : 1u; nx = cnt > 0u ? cnt : 1u;
}

__device__ __forceinline__ void xcd_barrier(const XcdBarrier& b) {
    asm volatile("s_waitcnt vmcnt(0)" ::: "memory");
    __syncthreads();
    if (threadIdx.x == 0) {
        unsigned* bar = b.bar;
        __builtin_amdgcn_s_waitcnt(0);
        unsigned nloc = b.st[0], nx = b.st[1];
        if (nloc == 0u) { xcd_barrier_complete(bar, b.x, nloc, nx); b.st[0] = nloc; b.st[1] = nx; }
        const unsigned old = xb_add(&bar[XB_XSUB(b.x)], 1u);
        const unsigned gen = old / nloc;
        if (old + 1u == (gen + 1u) * nloc) {
            __builtin_amdgcn_fence(__ATOMIC_RELEASE, "agent");
            asm volatile("s_waitcnt vmcnt(0)" ::: "memory");
            const unsigned og = xb_add(&bar[XB_TOP], 1u);
            const unsigned tg = og / nx;
            if (og + 1u == (tg + 1u) * nx) xb_add(&bar[XB_TOPGEN], 1u);
            else XB_SPIN(xb_ld(&bar[XB_TOPGEN]) == tg, bar);
            __builtin_amdgcn_fence(__ATOMIC_ACQUIRE, "agent");
            xb_add(&bar[XB_XGEN(b.x)], 1u);
            asm volatile("s_waitcnt vmcnt(0)" ::: "memory");
        } else {
            XB_SPIN(xb_ld(&bar[XB_XGEN(b.x)]) == gen, bar);
            __builtin_amdgcn_fence(__ATOMIC_ACQUIRE, "agent");
            asm volatile("s_waitcnt vmcnt(0)" ::: "memory");
        }
    }
    __syncthreads();
}


struct TJob { const float* src; int K, N; bf16_t* dst; int ldd; };

DEVI TJob get_tjob(const Params& p, int j) {
  TJob t;
  if (j < 26) {
    const int l = j / 13, jj = j % 13;
    const int ib = l ? 33 : 4;
    bf16_t* win = (bf16_t*)(p.ws + (l ? OFF_W3IN : OFF_W0IN));
    bf16_t* wup = (bf16_t*)(p.ws + (l ? OFF_W3UP : OFF_W0UP));
    bf16_t* wout = (bf16_t*)(p.ws + (l ? OFF_W3OUT : OFF_W0OUT));
    if (jj < 4) { t.src = p.in[ib + 3] + (size_t)jj * 1048576; t.K = 1024; t.N = 1024; t.dst = win + (size_t)jj * 1048576; t.ldd = 1024; }
    else if (jj < 8) { const int idx = jj - 4, d = idx >> 1, kind = idx & 1;
      t.src = p.in[ib + 6] + (size_t)idx * 65536; t.K = 1024; t.N = 64; t.dst = win + (size_t)(4096 + kind * 128 + d * 64) * 1024; t.ldd = 1024; }
    else if (jj < 12) { const int idx = jj - 8;
      t.src = p.in[ib + 7] + (size_t)idx * 65536; t.K = 64; t.N = 1024; t.dst = wup + (size_t)idx * 65536; t.ldd = 64; }
    else { t.src = p.in[ib + 11]; t.K = 1024; t.N = 1024; t.dst = wout; t.ldd = 1024; }
  } else if (j == 26) { t.src = p.in[19]; t.K = 1024; t.N = 2816; t.dst = (bf16_t*)(p.ws + OFF_W1IN); t.ldd = 1024; }
  else if (j == 27) { t.src = p.in[25]; t.K = 1408; t.N = 1024; t.dst = (bf16_t*)(p.ws + OFF_W1OUT); t.ldd = 1408; }
  else if (j == 28) { t.src = p.in[29]; t.K = 1024; t.N = 4096; t.dst = (bf16_t*)(p.ws + OFF_W2IN); t.ldd = 1024; }
  else { t.src = p.in[32]; t.K = 1024; t.N = 1024; t.dst = (bf16_t*)(p.ws + OFF_W2OUT); t.ldd = 1024; }
  return t;
}

__device__ __forceinline__ void phase0(const Params& p, char* lds) {
  const int tid = opaque_tid();
  {
    bf16_t* wg = (bf16_t*)(p.ws + OFF_W1G);
    const float* gw = p.in[22];
    const int total = 16 * 4 * 96 * 96;
    for (int e = blockIdx.x * NTHR + tid; e < total; e += gridDim.x * NTHR) {
      const int k = e % 96, n = (e / 96) % 96, dg = (e / 9216) & 3, blk = e / 36864;
      float v = 0.f;
      if (k < 88 && n < 88) v = gw[((size_t)(dg * 16 + blk) * 88 + k) * 88 + n];
      wg[e] = f2bf(v);
    }
  }
  constexpr int N_MOD_ITEMS = 96;
  constexpr int N_TILES = 5152;
  float* act = (float*)lds;
  float* red = (float*)(lds + 36864);
  float* tl = (float*)lds;
  for (int item = blockIdx.x; item < N_MOD_ITEMS; item += gridDim.x) {
    __syncthreads();
    {
      const int L = item / 24, nc = item % 24;
      const int ib = (L == 0) ? 4 : (L == 1) ? 16 : (L == 2) ? 26 : 33;
      const float* ada_w = p.in[ib + 1];
      const float* ada_b = p.in[ib + 2];
      for (int e = tid; e < 9 * 1024; e += NTHR) {
        const int i = e >> 10, k = e & 1023;
        const float c = (i < 8) ? p.in[1][i * 1024 + k] : p.in[3][k];
        act[e] = siluf_(c);
      }
      __syncthreads();
      const int kq = tid >> 7, nl = tid & 127, n = nc * 128 + nl;
      float acc[9];
#pragma unroll
      for (int i = 0; i < 9; ++i) acc[i] = 0.f;
      for (int k0 = kq * 256; k0 < kq * 256 + 256; k0 += 16) {
        float w[16];
#pragma unroll
        for (int u = 0; u < 16; ++u) w[u] = ada_w[(size_t)(k0 + u) * 3072 + n];
#pragma unroll
        for (int u = 0; u < 16; ++u)
#pragma unroll
          for (int i = 0; i < 9; ++i) acc[i] += act[i * 1024 + k0 + u] * w[u];
      }
#pragma unroll
      for (int i = 0; i < 9; ++i) red[(kq * 9 + i) * 128 + nl] = acc[i];
      __syncthreads();
      float* mod = (float*)(p.ws + OFF_MOD) + (size_t)L * 9 * 3072;
      for (int e = tid; e < 9 * 128; e += NTHR) {
        const int i = e >> 7, c = e & 127;
        const float s = red[(0 * 9 + i) * 128 + c] + red[(1 * 9 + i) * 128 + c] + red[(2 * 9 + i) * 128 + c] + red[(3 * 9 + i) * 128 + c];
        mod[i * 3072 + nc * 128 + c] = s + ada_b[nc * 128 + c];
      }
    }
  }
  {
    struct TileRef { const float* src; bf16_t* dst; int N, ldd, k0, n0; };
    auto decode = [&](int t, TileRef& r) {
      int j = 0;
      TJob job = get_tjob(p, 0);
      for (;;) {
        const int nt = (job.K >> 6) * (job.N >> 6);
        if (t < nt) break;
        t -= nt; ++j; job = get_tjob(p, j);
      }
      const int ntn = job.N >> 6;
      r.src = job.src; r.dst = job.dst; r.N = job.N; r.ldd = job.ldd; r.k0 = (t / ntn) * 64; r.n0 = (t % ntn) * 64;
    };
    const int kk = tid >> 4, n4 = (tid & 15) * 4;
    int t = (int)(gridDim.x - 1 - blockIdx.x);
    TileRef cur, nxt;
    float4 v0 = make_float4(0.f, 0.f, 0.f, 0.f), v1 = v0;
    if (t < N_TILES) {
      decode(t, cur);
      v0 = *(const float4*)(cur.src + (size_t)(cur.k0 + kk) * cur.N + cur.n0 + n4);
      v1 = *(const float4*)(cur.src + (size_t)(cur.k0 + kk + 32) * cur.N + cur.n0 + n4);
    }
    while (t < N_TILES) {
      const int tn = t + (int)gridDim.x;
      float4 w0 = v0, w1 = v1;
      if (tn < N_TILES) {
        decode(tn, nxt);
        w0 = *(const float4*)(nxt.src + (size_t)(nxt.k0 + kk) * nxt.N + nxt.n0 + n4);
        w1 = *(const float4*)(nxt.src + (size_t)(nxt.k0 + kk + 32) * nxt.N + nxt.n0 + n4);
      }
      __builtin_amdgcn_sched_barrier(0);
      __syncthreads();
      tl[kk * 65 + n4 + 0] = v0.x; tl[kk * 65 + n4 + 1] = v0.y; tl[kk * 65 + n4 + 2] = v0.z; tl[kk * 65 + n4 + 3] = v0.w;
      tl[(kk + 32) * 65 + n4 + 0] = v1.x; tl[(kk + 32) * 65 + n4 + 1] = v1.y; tl[(kk + 32) * 65 + n4 + 2] = v1.z; tl[(kk + 32) * 65 + n4 + 3] = v1.w;
      __syncthreads();
      const int n = tid >> 3, k8 = (tid & 7) * 8;
      u32x4 o;
      o.x = pk_bf16(tl[(k8 + 0) * 65 + n], tl[(k8 + 1) * 65 + n]);
      o.y = pk_bf16(tl[(k8 + 2) * 65 + n], tl[(k8 + 3) * 65 + n]);
      o.z = pk_bf16(tl[(k8 + 4) * 65 + n], tl[(k8 + 5) * 65 + n]);
      o.w = pk_bf16(tl[(k8 + 6) * 65 + n], tl[(k8 + 7) * 65 + n]);
      *(u32x4*)(cur.dst + (size_t)(cur.n0 + n) * cur.ldd + cur.k0 + k8) = o;
      v0 = w0; v1 = w1; cur = nxt; t = tn;
    }
  }
}

DEVI void norm_row(const float* __restrict__ xr, const float* __restrict__ g, const float* __restrict__ mod, int lane, float (&h)[16]) {
  float4 x[4];
  float ss = 0.f;
#pragma unroll
  for (int i = 0; i < 4; ++i) {
    x[i] = *(const float4*)(xr + lane * 4 + 256 * i);
    ss += x[i].x * x[i].x + x[i].y * x[i].y + x[i].z * x[i].z + x[i].w * x[i].w;
  }
  ss = wave_sum(ss);
  const float rstd = rsqrtf(ss * (1.f / 1024.f) + 1e-6f);
#pragma unroll
  for (int i = 0; i < 4; ++i) {
    const int c = lane * 4 + 256 * i;
    const float4 gg = *(const float4*)(g + c);
    const float4 sh = *(const float4*)(mod + c);
    const float4 sc = *(const float4*)(mod + 1024 + c);
    h[i * 4 + 0] = x[i].x * rstd * gg.x * (1.f + sc.x) + sh.x;
    h[i * 4 + 1] = x[i].y * rstd * gg.y * (1.f + sc.y) + sh.y;
    h[i * 4 + 2] = x[i].z * rstd * gg.z * (1.f + sc.z) + sh.z;
    h[i * 4 + 3] = x[i].w * rstd * gg.w * (1.f + sc.w) + sh.w;
  }
}

template <bool WITH_HS>
__device__ __forceinline__ void norm_phase(const float* __restrict__ xl, const float* __restrict__ xc, const float* __restrict__ g,
                           const float* __restrict__ modL, bf16_t* __restrict__ H, bf16_t* __restrict__ HS) {
  const int tidx = opaque_tid();
  const int lane = tidx & 63;
  const int gw = blockIdx.x * (NTHR / 64) + (tidx >> 6), nw = gridDim.x * (NTHR / 64);
  for (int row = gw; row < MT; row += nw) {
    const bool lat = row < ML;
    const float* xbase = lat ? xl + (size_t)row * 1024 : xc + (size_t)(row - ML) * 1024;
    const float* mod = modL + (lat ? (row >> 12) : 8) * 3072;
    float h[16];
    norm_row(xbase, g, mod, lane, h);
#pragma unroll
    for (int i = 0; i < 4; ++i) {
      u32x2 o; o.x = pk_bf16(h[i * 4], h[i * 4 + 1]); o.y = pk_bf16(h[i * 4 + 2], h[i * 4 + 3]);
      *(u32x2*)(H + (size_t)row * 1024 + lane * 4 + 256 * i) = o;
    }
    if (WITH_HS) {
      const int t = lat ? (row & 4095) : ((row - ML) & 255);
      const int T = lat ? 4096 : 256;
      float s[16];
#pragma unroll
      for (int i = 0; i < 16; ++i) s[i] = 0.f;
      if (t > 0) { float hp[16]; norm_row(xbase - 1024, g, mod, lane, hp);
#pragma unroll
        for (int i = 0; i < 16; ++i) s[i] += hp[i]; }
      if (t < T - 1) { float hn[16]; norm_row(xbase + 1024, g, mod, lane, hn);
#pragma unroll
        for (int i = 0; i < 16; ++i) s[i] += hn[i]; }
#pragma unroll
      for (int i = 0; i < 4; ++i) {
        u32x2 o; o.x = pk_bf16(0.5f * s[i * 4], 0.5f * s[i * 4 + 1]); o.y = pk_bf16(0.5f * s[i * 4 + 2], 0.5f * s[i * 4 + 3]);
        *(u32x2*)(HS + (size_t)row * 1024 + lane * 4 + 256 * i) = o;
      }
    }
  }
}

struct ALPlain {
  const bf16_t* A; int lda;
  typedef u32x4 Regs;
  DEVI void stage(float*, int) const {}
  DEVI void issue(Regs& r, int row, int k) const { r = *(const u32x4*)(A + (size_t)row * lda + k); }
  DEVI u32x4 finish(const Regs& r, const float*, int) const { return r; }
};
struct ALMix {
  const bf16_t* H; const bf16_t* HS; const float* mu;
  struct Regs { u32x4 h, s; };
  DEVI void stage(float* sMu, int n0) const {
    const int grp = n0 >> 10;
    const int j = grp == 0 ? 0 : grp == 1 ? 2 : grp == 2 ? 3 : grp == 3 ? 5 : (n0 - 4096) < 128 ? 1 : 4;
    for (int e = threadIdx.x; e < 1024; e += NTHR) sMu[e] = mu[j * 1024 + e];
  }
  DEVI void issue(Regs& r, int row, int k) const {
    r.h = *(const u32x4*)(H + (size_t)row * 1024 + k);
    r.s = *(const u32x4*)(HS + (size_t)row * 1024 + k);
  }
  DEVI unsigned mix2(unsigned h, unsigned s, float m0, float m1) const {
    const float h0 = bf_lo(h), h1 = bf_hi(h), s0 = bf_lo(s), s1 = bf_hi(s);
    return pk_bf16(h0 + (s0 - h0) * m0, h1 + (s1 - h1) * m1);
  }
  DEVI u32x4 finish(const Regs& r, const float* sMu, int k) const {
    const float4 ma = *(const float4*)(sMu + k), mb = *(const float4*)(sMu + k + 4);
    u32x4 o;
    o.x = mix2(r.h.x, r.s.x, ma.x, ma.y); o.y = mix2(r.h.y, r.s.y, ma.z, ma.w);
    o.z = mix2(r.h.z, r.s.z, mb.x, mb.y); o.w = mix2(r.h.w, r.s.w, mb.z, mb.w);
    return o;
  }
};

template <class AL, class EP>
__device__ __forceinline__ void gemm_phase(char* lds, const bf16_t* __restrict__ Bt, int K, int mtiles, int ntiles, const AL al, const EP ep, int n_base = 0, bool reverse = false, int mt_base = 0) {
  bf16_t* sA = (bf16_t*)lds;
  bf16_t* sB = (bf16_t*)(lds + 73728);
  float* sMu = (float*)(lds + 110592);
  const int tid = opaque_tid(), lane = tid & 63, wv = tid >> 6, wm = wv >> 1, wn = wv & 1;
  const int l31 = lane & 31, lh = lane >> 5;
  const int nk = K >> 6;
  const int ldrow = tid >> 3, ldk = (tid & 7) * 8;
  const int total = mtiles * ntiles;
  const int bid = reverse ? (int)(gridDim.x - 1 - blockIdx.x) : (int)blockIdx.x;
  const int nslots = gridDim.x >> 3, xcd = bid & 7, slot = bid >> 3;
  const int gm = 4 * ntiles;
  for (int chunk = xcd; chunk * nslots < total; chunk += 8) {
    const int tile = chunk * nslots + slot;
    if (tile >= total) break;
    const int grp = tile / gm, rem = tile - grp * gm;
    const int mt = grp * 4 + (rem & 3), nt = rem >> 2;
    const int m0 = (mt_base + mt) * 256, n0 = n_base + nt * 128;
    __syncthreads();
    al.stage(sMu, n0);
    f32x16 acc[2][2];
#pragma unroll
    for (int a = 0; a < 2; ++a)
#pragma unroll
      for (int b = 0; b < 2; ++b)
#pragma unroll
        for (int r = 0; r < 16; ++r) acc[a][b][r] = 0.f;
    typename AL::Regs ar[4];
    u32x4 br[2];
#pragma unroll
    for (int i = 0; i < 4; ++i) al.issue(ar[i], m0 + ldrow + 64 * i, ldk);
#pragma unroll
    for (int i = 0; i < 2; ++i) br[i] = *(const u32x4*)(Bt + (size_t)(n0 + ldrow + 64 * i) * K + ldk);
    __syncthreads();
#pragma unroll
    for (int i = 0; i < 4; ++i) *(u32x4*)(sA + (ldrow + 64 * i) * 72 + ldk) = al.finish(ar[i], sMu, ldk);
#pragma unroll
    for (int i = 0; i < 2; ++i) *(u32x4*)(sB + (ldrow + 64 * i) * 72 + ldk) = br[i];
    __syncthreads();
    for (int kt = 0; kt < nk; ++kt) {
      const int cur = kt & 1;
      const bool more = (kt + 1) < nk;
      const int k0n = (kt + 1) * 64 + ldk;
      if (more) {
#pragma unroll
        for (int i = 0; i < 4; ++i) al.issue(ar[i], m0 + ldrow + 64 * i, k0n);
#pragma unroll
        for (int i = 0; i < 2; ++i) br[i] = *(const u32x4*)(Bt + (size_t)(n0 + ldrow + 64 * i) * K + k0n);
      }
      __builtin_amdgcn_sched_barrier(0);
      const bf16_t* a_ = sA + cur * (256 * 72);
      const bf16_t* b_ = sB + cur * (128 * 72);
#pragma unroll
      for (int kk = 0; kk < 4; ++kk) {
        u32x4 af[2], bfr[2];
#pragma unroll
        for (int mi = 0; mi < 2; ++mi) af[mi] = *(const u32x4*)(a_ + (wm * 64 + mi * 32 + l31) * 72 + kk * 16 + lh * 8);
#pragma unroll
        for (int ni = 0; ni < 2; ++ni) bfr[ni] = *(const u32x4*)(b_ + (wn * 64 + ni * 32 + l31) * 72 + kk * 16 + lh * 8);
#pragma unroll
        for (int mi = 0; mi < 2; ++mi)
#pragma unroll
          for (int ni = 0; ni < 2; ++ni) acc[mi][ni] = mfma32(bfr[ni], af[mi], acc[mi][ni]);
      }
      __builtin_amdgcn_sched_barrier(0);
      if (more) {
        bf16_t* an = sA + (cur ^ 1) * (256 * 72);
        bf16_t* bn = sB + (cur ^ 1) * (128 * 72);
#pragma unroll
        for (int i = 0; i < 4; ++i) *(u32x4*)(an + (ldrow + 64 * i) * 72 + ldk) = al.finish(ar[i], sMu, k0n);
#pragma unroll
        for (int i = 0; i < 2; ++i) *(u32x4*)(bn + (ldrow + 64 * i) * 72 + ldk) = br[i];
      }
      __syncthreads();
    }
#pragma unroll
    for (int mi = 0; mi < 2; ++mi)
#pragma unroll
      for (int ni = 0; ni < 2; ++ni)
#pragma unroll
        for (int q = 0; q < 4; ++q) {
          const int row = m0 + wm * 64 + mi * 32 + l31;
          const int col = n0 + wn * 64 + ni * 32 + 8 * q + 4 * lh;
          f32x4 v = {acc[mi][ni][4 * q], acc[mi][ni][4 * q + 1], acc[mi][ni][4 * q + 2], acc[mi][ni][4 * q + 3]};
          ep(row, col, v);
        }
  }
}


template <class AL, class EP>
__device__ __forceinline__ void gemm256_phase(char* lds, const bf16_t* __restrict__ Bt, int K, int mtiles, int ntiles, const AL al, const EP ep) {
  bf16_t* sA = (bf16_t*)lds;
  bf16_t* sB = (bf16_t*)(lds + 73728);
  float* sMu = (float*)(lds + 147456);
  const int tid = opaque_tid(), lane = tid & 63, wv = tid >> 6, wm = wv >> 1, wn = wv & 1;
  const int l31 = lane & 31, lh = lane >> 5;
  const int nk = K >> 6;
  const int ldrow = tid >> 3, ldk = (tid & 7) * 8;
  const int total = mtiles * ntiles;
  const int nslots = gridDim.x >> 3, xcd = blockIdx.x & 7, slot = blockIdx.x >> 3;
  const int gm = 4 * ntiles;
  for (int chunk = xcd; chunk * nslots < total; chunk += 8) {
    const int tile = chunk * nslots + slot;
    if (tile >= total) break;
    const int grp = tile / gm, rem = tile - grp * gm;
    const int mt = grp * 4 + (rem & 3), nt = rem >> 2;
    const int m0 = mt * 256, n0 = nt * 256;
    __syncthreads();
    al.stage(sMu, n0);
    f32x16 acc[2][4];
#pragma unroll
    for (int a = 0; a < 2; ++a)
#pragma unroll
      for (int b = 0; b < 4; ++b)
#pragma unroll
        for (int r = 0; r < 16; ++r) acc[a][b][r] = 0.f;
    typename AL::Regs ar[4];
    u32x4 br[4];
#pragma unroll
    for (int i = 0; i < 4; ++i) al.issue(ar[i], m0 + ldrow + 64 * i, ldk);
#pragma unroll
    for (int i = 0; i < 4; ++i) br[i] = *(const u32x4*)(Bt + (size_t)(n0 + ldrow + 64 * i) * K + ldk);
    __syncthreads();
#pragma unroll
    for (int i = 0; i < 4; ++i) *(u32x4*)(sA + (ldrow + 64 * i) * 72 + ldk) = al.finish(ar[i], sMu, ldk);
#pragma unroll
    for (int i = 0; i < 4; ++i) *(u32x4*)(sB + (ldrow + 64 * i) * 72 + ldk) = br[i];
    __syncthreads();
    const int half = __builtin_amdgcn_readfirstlane(wv >> 2);
    if (half == 1 && nk > 1) {
#pragma unroll
      for (int i = 0; i < 4; ++i) al.issue(ar[i], m0 + ldrow + 64 * i, 64 + ldk);
#pragma unroll
      for (int i = 0; i < 4; ++i) br[i] = *(const u32x4*)(Bt + (size_t)(n0 + ldrow + 64 * i) * K + 64 + ldk);
    }
    for (int step = 0; step < 2 * nk; ++step) {
      const int kc = step >> 1;
      if ((step & 1) == half) {
        const int kl = kc + 1 + half;
        if (kl < nk) {
          const int k0n = kl * 64 + ldk;
#pragma unroll
          for (int i = 0; i < 4; ++i) al.issue(ar[i], m0 + ldrow + 64 * i, k0n);
#pragma unroll
          for (int i = 0; i < 4; ++i) br[i] = *(const u32x4*)(Bt + (size_t)(n0 + ldrow + 64 * i) * K + k0n);
        }
        __builtin_amdgcn_sched_barrier(0);
        const bf16_t* a_ = sA + (kc & 1) * (256 * 72);
        const bf16_t* b_ = sB + (kc & 1) * (256 * 72);
#pragma unroll
        for (int kk = 0; kk < 4; ++kk) {
          u32x4 af[2];
#pragma unroll
          for (int mi = 0; mi < 2; ++mi) af[mi] = *(const u32x4*)(a_ + (wm * 64 + mi * 32 + l31) * 72 + kk * 16 + lh * 8);
#pragma unroll
          for (int ni = 0; ni < 4; ++ni) {
            const u32x4 bfr = *(const u32x4*)(b_ + (wn * 128 + ni * 32 + l31) * 72 + kk * 16 + lh * 8);
#pragma unroll
            for (int mi = 0; mi < 2; ++mi) acc[mi][ni] = mfma32(bfr, af[mi], acc[mi][ni]);
          }
        }
        __builtin_amdgcn_sched_barrier(0);
      } else {
        const int kf = kc + 1;
        if (kf < nk) {
          bf16_t* an = sA + (kf & 1) * (256 * 72);
          bf16_t* bn = sB + (kf & 1) * (256 * 72);
          const int k0n = kf * 64 + ldk;
#pragma unroll
          for (int i = 0; i < 4; ++i) *(u32x4*)(an + (ldrow + 64 * i) * 72 + ldk) = al.finish(ar[i], sMu, k0n);
#pragma unroll
          for (int i = 0; i < 4; ++i) *(u32x4*)(bn + (ldrow + 64 * i) * 72 + ldk) = br[i];
        }
      }
      __syncthreads();
    }
    if constexpr (EP::VIA_LDS) {
      float* reg = (float*)(lds + wv * 16896);
#pragma unroll
      for (int mi = 0; mi < 2; ++mi) {
#pragma unroll
        for (int ni = 0; ni < 4; ++ni)
#pragma unroll
          for (int q = 0; q < 4; ++q) {
            f32x4 v = {acc[mi][ni][4 * q], acc[mi][ni][4 * q + 1], acc[mi][ni][4 * q + 2], acc[mi][ni][4 * q + 3]};
            *(f32x4*)(reg + l31 * 132 + ni * 32 + 8 * q + 4 * lh) = v;
          }
#pragma unroll 4
        for (int it = 0; it < 16; ++it) {
          const int rl = it * 2 + lh;
          const f32x4 v = *(const f32x4*)(reg + rl * 132 + l31 * 4);
          ep(m0 + wm * 64 + mi * 32 + rl, n0 + wn * 128 + l31 * 4, v);
        }
      }
    } else
#pragma unroll
    for (int mi = 0; mi < 2; ++mi)
#pragma unroll
      for (int ni = 0; ni < 4; ++ni) {
#pragma unroll
        for (int q = 0; q < 4; ++q) {
          const int row = m0 + wm * 64 + mi * 32 + l31;
          const int col = n0 + wn * 128 + ni * 32 + 8 * q + 4 * lh;
          f32x4 v = {acc[mi][ni][4 * q], acc[mi][ni][4 * q + 1], acc[mi][ni][4 * q + 2], acc[mi][ni][4 * q + 3]};
          ep(row, col, v);
        }
        __builtin_amdgcn_sched_barrier(0);
      }
  }
}

DEVI void st_bf16x4(bf16_t* p, f32x4 v) { u32x2 o; o.x = pk_bf16(v[0], v[1]); o.y = pk_bf16(v[2], v[3]); *(u32x2*)p = o; }

struct EpRwkvIn {
  static constexpr bool VIA_LDS = false;
  bf16_t *R, *K, *V, *G, *WD, *AD;
  DEVI void operator()(int row, int col, f32x4 v) const {
    const int grp = col >> 10;
    if (grp < 4) {
      const int c = col & 1023;
      bf16_t* dst = grp == 0 ? R : grp == 1 ? K : grp == 2 ? V : G;
      if (grp == 3) { v[0] = siluf_(v[0]); v[1] = siluf_(v[1]); v[2] = siluf_(v[2]); v[3] = siluf_(v[3]); }
      st_bf16x4(dst + (size_t)row * 1024 + c, v);
    } else {
      const int c = col - 4096;
      if (c < 128) {
#pragma unroll
        for (int i = 0; i < 4; ++i) { const float t = __expf(2.f * v[i]); v[i] = 1.f - 2.f / (t + 1.f); }
        st_bf16x4(WD + (size_t)row * 128 + c, v);
      } else st_bf16x4(AD + (size_t)row * 128 + (c - 128), v);
    }
  }
};
struct EpRes {
  static constexpr bool VIA_LDS = false;
  const float* xl_src; const float* xc_src; float* xl_dst; float* xc_dst; const float* modL;
  DEVI void operator()(int row, int col, f32x4 v) const {
    const bool lat = row < ML;
    const size_t off = lat ? (size_t)row * 1024 + col : (size_t)(row - ML) * 1024 + col;
    const float* src = (lat ? xl_src : xc_src) + off;
    float* dst = (lat ? xl_dst : xc_dst) + off;
    const f32x4 g = *(const f32x4*)(modL + (lat ? (row >> 12) : 8) * 3072 + 2048 + col);
    f32x4 x = *(const f32x4*)src;
    x += g * v;
    *(f32x4*)dst = x;
  }
};
struct EpLruIn {
  static constexpr bool VIA_LDS = false;
  bf16_t *XR, *GG;
  DEVI void operator()(int row, int col, f32x4 v) const {
    if (col < LW) st_bf16x4(XR + (size_t)row * LW + col, v);
    else { v[0] = siluf_(v[0]); v[1] = siluf_(v[1]); v[2] = siluf_(v[2]); v[3] = siluf_(v[3]); st_bf16x4(GG + (size_t)row * LW + (col - LW), v); }
  }
};
struct EpNatIn {
  static constexpr bool VIA_LDS = false;
  bf16_t *Q, *K, *VT, *G;
  DEVI void operator()(int row, int col, f32x4 v) const {
    const int grp = col >> 10, c = col & 1023;
    if (grp == 0) st_bf16x4(Q + (size_t)row * 1024 + c, v);
    else if (grp == 1) st_bf16x4(K + (size_t)row * 1024 + c, v);
    else if (grp == 3) { v[0] = siluf_(v[0]); v[1] = siluf_(v[1]); v[2] = siluf_(v[2]); v[3] = siluf_(v[3]); st_bf16x4(G + (size_t)row * 1024 + c, v); }
    else {
      unsigned idx, T;
      if (row < ML) { const unsigned b = row >> 12, t = row & 4095; T = 4096u; idx = ((b * 1024u + (unsigned)c) << 12) + t; }
      else { const unsigned r2 = row - ML; const unsigned b = r2 >> 8, t = r2 & 255; T = 256u; idx = (unsigned)ML * 1024u + ((b * 1024u + (unsigned)c) << 8) + t; }
#pragma unroll
      for (int i = 0; i < 4; ++i) VT[idx + (unsigned)i * T] = f2bf(v[i]);
    }
  }
};

DEVI int rwkv_row(int b, int d, int s) {
  if (s < 256) return ML + b * 256 + (d ? 255 - s : s);
  const int t = s - 256;
  return b * 4096 + (d ? 4095 - t : t);
}

constexpr int PSTR = 456, PREC_Y = 64, PREC_V0 = 192, PREC_V1 = 256, PREC_SC = 320, PREC_BF = 328;
constexpr int TSTR = 388;
struct ScanRec { u32x4 a1, a2; float v0, v1; f32x4 s0, s1; f32x4 ww[4]; u32x2 y[4]; };
DEVI void scan_load(ScanRec& R, const float* rec, int g, int c16, int role_off, int srow) {
  const char* ab = (const char*)(rec + PREC_BF) + role_off + g * 16;
  R.a1 = *(const u32x4*)ab; R.a2 = *(const u32x4*)(ab + 64);
  R.v0 = rec[PREC_V0 + srow]; R.v1 = rec[PREC_V1 + srow];
  R.s0 = *(const f32x4*)(rec + PREC_SC); R.s1 = *(const f32x4*)(rec + PREC_SC + 4);
#pragma unroll
  for (int nt = 0; nt < 4; ++nt) {
    R.ww[nt] = *(const f32x4*)(rec + 16 * nt + 4 * g);
    R.y[nt] = *(const u32x2*)((const char*)(rec + PREC_Y) + (16 * nt + c16) * 8);
  }
}
DEVI void scan_step2(f32x4 (&S)[4], const ScanRec& R, bool g0, float* yout) {
  const u32x4 b1 = mk4(pk_bf16(S[0][0], S[0][1]), pk_bf16(S[0][2], S[0][3]), pk_bf16(S[1][0], S[1][1]), pk_bf16(S[1][2], S[1][3]));
  const u32x4 b2 = mk4(pk_bf16(S[2][0], S[2][1]), pk_bf16(S[2][2], S[2][3]), pk_bf16(S[3][0], S[3][1]), pk_bf16(S[3][2], S[3][3]));
  f32x4 D = {0.f, 0.f, 0.f, 0.f};
  D = mfma16(R.a1, b1, D);
  D = mfma16(R.a2, b2, D);
  const float v0 = R.v0, v1 = R.v1;
  const float sa0 = D[0];
  const float sa1 = D[2] + sa0 * R.s0[2] + v0 * R.s0[3];
  const unsigned x0 = pk_bf16(sa0, v0), x1 = pk_bf16(sa1, v1);
  const u32x4 xb = mk4(g0 ? x0 : 0u, g0 ? x1 : 0u, 0u, 0u);
#pragma unroll
  for (int nt = 0; nt < 4; ++nt) S[nt] = mfma16(mk4(R.y[nt].x, R.y[nt].y, 0u, 0u), xb, S[nt] * R.ww[nt]);
  yout[0] = D[1] + sa0 * R.s0[0] + v0 * R.s0[1];
  yout[256] = D[3] + sa0 * R.s1[0] + v0 * R.s1[1] + sa1 * R.s1[2] + v1 * R.s1[3];
}
DEVI float sum16(float v) { v = sum8(v); v += dpp_f<0x140>(v); return v; }

__device__ __forceinline__ void rwkv_scan_phase(char* lds, const bf16_t* __restrict__ R, const bf16_t* __restrict__ Kb, const bf16_t* __restrict__ V,
                                const bf16_t* __restrict__ WD, const bf16_t* __restrict__ AD, const bf16_t* __restrict__ Wup,
                                const float* __restrict__ b0, const float* __restrict__ k_ka, const float* __restrict__ r_k,
                                bf16_t* __restrict__ Y0, bf16_t* __restrict__ Y1, float* __restrict__ BON) {
  float* stepbuf = (float*)lds;
  float* tokbuf = stepbuf + 2 * 8 * PSTR;
  float* wbuf = tokbuf + 2 * 16 * TSTR;
  float* abuf = wbuf + 1024;
  float* ybuf = abuf + 1024;
  const int tid = opaque_tid(), lane = tid & 63, wv = tid >> 6;
  constexpr int NCH = (256 + 4096) / 16;
  for (int chain = blockIdx.x; chain < 256; chain += gridDim.x) {
    const int d = chain & 1, h = (chain >> 1) & 15, b = chain >> 5;
    __syncthreads();
    if (wv < 4) {
      const int kq = lane >> 4, c16 = lane & 15, srow = wv * 16 + c16;
      const int role_off = (lane & 3) * 128;
      const bool g0 = kq == 0;
      f32x4 S[4];
#pragma unroll
      for (int j = 0; j < 4; ++j) S[j] = (f32x4){0.f, 0.f, 0.f, 0.f};
      __syncthreads();
      __syncthreads();
      __syncthreads();
      __syncthreads();
      for (int c = 0; c < NCH; ++c) {
        const float* sb = stepbuf + (c & 1) * 8 * PSTR;
        float* yb = ybuf + (c & 1) * 4096 + kq * 64 + srow;
        ScanRec ra, rb;
        scan_load(ra, sb, kq, c16, role_off, srow);
#pragma unroll
        for (int i = 0; i < 4; i += 2) {
          scan_load(rb, sb + (i + 1) * PSTR, kq, c16, role_off, srow);
          scan_step2(S, ra, g0, yb + i * 512);
          scan_load(ra, sb + (i + 2) * PSTR, kq, c16, role_off, srow);
          scan_step2(S, rb, g0, yb + (i + 1) * 512);
        }
        __syncthreads();
#pragma unroll
        for (int i = 4; i < 8; i += 2) {
          scan_load(rb, sb + (i + 1) * PSTR, kq, c16, role_off, srow);
          scan_step2(S, ra, g0, yb + i * 512);
          if (i + 2 < 8) scan_load(ra, sb + (i + 2) * PSTR, kq, c16, role_off, srow);
          scan_step2(S, rb, g0, yb + (i + 1) * 512);
        }
        __syncthreads();
      }
    } else {
      const int ptid = tid - 256, pw = wv - 4;
      bf16_t* Y = d ? Y1 : Y0;
      const int ncol = h * 64 + pw * 16 + (lane & 15);
      u32x4 bu[2][2];
      float bias_u[2];
#pragma unroll
      for (int kind = 0; kind < 2; ++kind) {
        const bf16_t* wu = Wup + ((size_t)(d * 2 + kind) * 1024 + ncol) * 64 + 8 * (lane >> 4);
        bu[kind][0] = *(const u32x4*)wu; bu[kind][1] = *(const u32x4*)(wu + 32);
        bias_u[kind] = b0[(d * 2 + kind) * 1024 + ncol];
      }
      const int ti = ptid >> 4, dq = ptid & 15;
      const int hc = h * 64 + 4 * dq;
      const f32x4 kkv = *(const f32x4*)(k_ka + hc), kav = *(const f32x4*)(k_ka + 1024 + hc), rkv = *(const f32x4*)(r_k + hc);
      u32x4 xw0, xw1, xa0, xa1; u32x2 rr, kr, vr;
      auto issue = [&](int c) {
        const int rowA = rwkv_row(b, d, c * 16 + (lane & 15));
        const bf16_t* xp = WD + (size_t)rowA * 128 + d * 64 + 8 * (lane >> 4);
        const bf16_t* xq = AD + (size_t)rowA * 128 + d * 64 + 8 * (lane >> 4);
        xw0 = *(const u32x4*)xp; xw1 = *(const u32x4*)(xp + 32);
        xa0 = *(const u32x4*)xq; xa1 = *(const u32x4*)(xq + 32);
        const int rowB = rwkv_row(b, d, c * 16 + ti);
        rr = *(const u32x2*)(R + (size_t)rowB * 1024 + hc);
        kr = *(const u32x2*)(Kb + (size_t)rowB * 1024 + hc);
        vr = *(const u32x2*)(V + (size_t)rowB * 1024 + hc);
      };
      auto stepA = [&]() {
        f32x4 accw = {0.f, 0.f, 0.f, 0.f}, acca = {0.f, 0.f, 0.f, 0.f};
        accw = mfma16(xw0, bu[0][0], accw); accw = mfma16(xw1, bu[0][1], accw);
        acca = mfma16(xa0, bu[1][0], acca); acca = mfma16(xa1, bu[1][1], acca);
#pragma unroll
        for (int r = 0; r < 4; ++r) {
          const int o = ((lane >> 4) * 4 + r) * 64 + pw * 16 + (lane & 15);
          const float x = -(accw[r] + bias_u[0]);
          const float sp = fmaxf(x, 0.f) + 0.6931471805599453f * __builtin_amdgcn_logf(1.f + __builtin_amdgcn_exp2f(-1.4426950408889634f * fabsf(x)));
          const float ew = __builtin_amdgcn_exp2f(-1.4426950408889634f * (sp + 0.5f));
          wbuf[o] = __builtin_amdgcn_exp2f(-1.4426950408889634f * ew);
          abuf[o] = __builtin_amdgcn_rcpf(1.f + __builtin_amdgcn_exp2f(-1.4426950408889634f * (acca[r] + bias_u[1])));
        }
      };
      auto stepB1 = [&](int c) {
        const float rv[4] = {bf_lo(rr.x), bf_hi(rr.x), bf_lo(rr.y), bf_hi(rr.y)};
        const float kv[4] = {bf_lo(kr.x), bf_hi(kr.x), bf_lo(kr.y), bf_hi(kr.y)};
        const float vv[4] = {bf_lo(vr.x), bf_hi(vr.x), bf_lo(vr.y), bf_hi(vr.y)};
        const f32x4 av = *(const f32x4*)(abuf + ti * 64 + 4 * dq), wv4 = *(const f32x4*)(wbuf + ti * 64 + 4 * dq);
        float q[4], ss = 0.f;
#pragma unroll
        for (int i = 0; i < 4; ++i) { q[i] = kv[i] * kkv[i]; ss += q[i] * q[i]; }
        ss = sum16(ss);
        const float inv = __builtin_amdgcn_rsqf(fmaxf(ss, 1e-24f));
        f32x4 nk, wrr, ka, kd, vo;
        float c1 = 0.f, c2 = 0.f, bn = 0.f;
#pragma unroll
        for (int i = 0; i < 4; ++i) {
          const float n = q[i] * inv;
          kd[i] = kv[i] * (1.f + (av[i] - 1.f) * kav[i]);
          ka[i] = n * av[i];
          nk[i] = -n; wrr[i] = wv4[i] * rv[i]; vo[i] = vv[i];
          c1 += ka[i] * rv[i]; c2 += kd[i] * rv[i]; bn += rv[i] * kd[i] * rkv[i];
        }
        c1 = sum16(c1); c2 = sum16(c2); bn = sum16(bn);
        float* rec = tokbuf + ((c & 1) * 16 + ti) * TSTR;
        *(f32x4*)(rec + 4 * dq) = nk;
        *(f32x4*)(rec + 64 + 4 * dq) = wrr;
        *(f32x4*)(rec + 128 + 4 * dq) = wv4;
        *(f32x4*)(rec + 192 + 4 * dq) = ka;
        *(f32x4*)(rec + 256 + 4 * dq) = kd;
        *(f32x4*)(rec + 320 + 4 * dq) = vo;
        if (dq == 0) {
          *(f32x2*)(rec + 384) = (f32x2){c1, c2};
          BON[((size_t)d * MT + rwkv_row(b, d, c * 16 + ti)) * 16 + h] = bn;
        }
      };
      auto stepB2 = [&](int c) {
        const int pp = ptid >> 5, dp = ptid & 31;
        const float* t0 = tokbuf + ((c & 1) * 16 + 2 * pp) * TSTR + 2 * dp;
        const float* t1 = t0 + TSTR;
        const f32x2 a0 = *(const f32x2*)(t0), wr0 = *(const f32x2*)(t0 + 64), w0 = *(const f32x2*)(t0 + 128);
        const f32x2 b0_ = *(const f32x2*)(t0 + 192), k0_ = *(const f32x2*)(t0 + 256), v0 = *(const f32x2*)(t0 + 320);
        const f32x2 a1 = *(const f32x2*)(t1), wr1 = *(const f32x2*)(t1 + 64), w1 = *(const f32x2*)(t1 + 128);
        const f32x2 b1_ = *(const f32x2*)(t1 + 192), k1_ = *(const f32x2*)(t1 + 256), v1 = *(const f32x2*)(t1 + 320);
        float c3 = b0_[0] * a1[0] + b0_[1] * a1[1], c4 = k0_[0] * a1[0] + k0_[1] * a1[1];
        float c5 = b0_[0] * wr1[0] + b0_[1] * wr1[1], c6 = k0_[0] * wr1[0] + k0_[1] * wr1[1];
        c3 = sum16(c3); c4 = sum16(c4); c5 = sum16(c5); c6 = sum16(c6);
        c3 += __shfl_xor(c3, 16); c4 += __shfl_xor(c4, 16); c5 += __shfl_xor(c5, 16); c6 += __shfl_xor(c6, 16);
        float* rec = stepbuf + ((c & 1) * 8 + pp) * PSTR;
        *(f32x2*)(rec + 2 * dp) = w0 * w1;
        {
          const f32x2 bw = b0_ * w1, kw = k0_ * w1;
          *(u32x4*)((char*)(rec + PREC_Y) + 16 * dp) = mk4(pk_bf16(bw[0], kw[0]), pk_bf16(b1_[0], k1_[0]), pk_bf16(bw[1], kw[1]), pk_bf16(b1_[1], k1_[1]));
        }
        *(f32x2*)(rec + PREC_V0 + 2 * dp) = v0;
        *(f32x2*)(rec + PREC_V1 + 2 * dp) = v1;
        unsigned* bb = (unsigned*)(rec + PREC_BF);
        const f32x2 wa = w0 * a1, wwr = w0 * wr1;
        const int kk = (2 * dp) & 31;
        const int pos = ((2 * dp) & 32) + (kk < 16 ? 8 * (kk >> 2) + (kk & 3) : 8 * ((kk - 16) >> 2) + 4 + (kk & 3));
        const int pu = pos >> 1;
        bb[pu] = pk_bf16(a0[0], a0[1]);
        bb[32 + pu] = pk_bf16(wr0[0], wr0[1]);
        bb[64 + pu] = pk_bf16(wa[0], wa[1]);
        bb[96 + pu] = pk_bf16(wwr[0], wwr[1]);
        if (dp == 0) {
          const f32x2 cc0 = *(const f32x2*)(t0 + 384), cc1 = *(const f32x2*)(t1 + 384);
          *(f32x4*)(rec + PREC_SC) = (f32x4){cc0[0], cc0[1], c3, c4};
          *(f32x4*)(rec + PREC_SC + 4) = (f32x4){c5, c6, cc1[0], cc1[1]};
        }
      };
      auto storeY = [&](int c) {
        const f32x4 yv = *(const f32x4*)(ybuf + (c & 1) * 4096 + ti * 256 + 4 * dq);
        u32x2 o; o.x = pk_bf16(yv[0], yv[1]); o.y = pk_bf16(yv[2], yv[3]);
        *(u32x2*)(Y + (size_t)rwkv_row(b, d, c * 16 + ti) * 1024 + hc) = o;
      };
      issue(0);
      stepA();
      __syncthreads();
      stepB1(0);
      issue(1);
      __syncthreads();
      stepA();
      __syncthreads();
      stepB1(1);
      stepB2(0);
      issue(2);
      __builtin_amdgcn_sched_barrier(0);
      __syncthreads();
      __builtin_amdgcn_sched_barrier(0);
      for (int c = 0; c < NCH; ++c) {
        if (c + 2 < NCH) stepA();
        if (c + 1 < NCH) stepB2(c + 1);
        if (c >= 1) storeY(c - 1);
        __syncthreads();
        if (c + 2 < NCH) stepB1(c + 2);
        if (c + 3 < NCH) issue(c + 3);
        __builtin_amdgcn_sched_barrier(0);
        __syncthreads();
        __builtin_amdgcn_sched_barrier(0);
      }
      storeY(NCH - 1);
    }
  }
}

__device__ __forceinline__ void rwkv_post_phase(const bf16_t* __restrict__ Y0, const bf16_t* __restrict__ Y1, const bf16_t* __restrict__ V,
                                bf16_t* __restrict__ G, const float* __restrict__ BON, const float* __restrict__ gn, int nrows) {
  const int tidx = opaque_tid();
  const int lane = tidx & 63;
  const int gw = blockIdx.x * (NTHR / 64) + (tidx >> 6), nw = gridDim.x * (NTHR / 64);
  const int head = lane >> 2, c0 = lane * 16;
  for (int row = gw; row < nrows; row += nw) {
    const size_t off = (size_t)row * 1024 + c0;
    float y[16], v[16], g[16];
#pragma unroll
    for (int i = 0; i < 2; ++i) {
      const u32x4 a0 = *(const u32x4*)(Y0 + off + 8 * i), a1 = *(const u32x4*)(Y1 + off + 8 * i);
      const u32x4 av = *(const u32x4*)(V + off + 8 * i), ag = *(const u32x4*)(G + off + 8 * i);
      y[8 * i + 0] = bf_lo(a0.x) + bf_lo(a1.x); y[8 * i + 1] = bf_hi(a0.x) + bf_hi(a1.x);
      y[8 * i + 2] = bf_lo(a0.y) + bf_lo(a1.y); y[8 * i + 3] = bf_hi(a0.y) + bf_hi(a1.y);
      y[8 * i + 4] = bf_lo(a0.z) + bf_lo(a1.z); y[8 * i + 5] = bf_hi(a0.z) + bf_hi(a1.z);
      y[8 * i + 6] = bf_lo(a0.w) + bf_lo(a1.w); y[8 * i + 7] = bf_hi(a0.w) + bf_hi(a1.w);
      v[8 * i + 0] = bf_lo(av.x); v[8 * i + 1] = bf_hi(av.x); v[8 * i + 2] = bf_lo(av.y); v[8 * i + 3] = bf_hi(av.y);
      v[8 * i + 4] = bf_lo(av.z); v[8 * i + 5] = bf_hi(av.z); v[8 * i + 6] = bf_lo(av.w); v[8 * i + 7] = bf_hi(av.w);
      g[8 * i + 0] = bf_lo(ag.x); g[8 * i + 1] = bf_hi(ag.x); g[8 * i + 2] = bf_lo(ag.y); g[8 * i + 3] = bf_hi(ag.y);
      g[8 * i + 4] = bf_lo(ag.z); g[8 * i + 5] = bf_hi(ag.z); g[8 * i + 6] = bf_lo(ag.w); g[8 * i + 7] = bf_hi(ag.w);
    }
    float s = 0.f;
#pragma unroll
    for (int i = 0; i < 16; ++i) s += y[i];
    s += __shfl_xor(s, 1); s += __shfl_xor(s, 2);
    const float mean = s * (1.f / 64.f);
    float q = 0.f;
#pragma unroll
    for (int i = 0; i < 16; ++i) { const float dlt = y[i] - mean; q += dlt * dlt; }
    q += __shfl_xor(q, 1); q += __shfl_xor(q, 2);
    const float rstd = rsqrtf(q * (1.f / 64.f) + 64e-5f);
    const float bonus = BON[(size_t)row * 16 + head] + BON[((size_t)MT + row) * 16 + head];
    unsigned o[8];
#pragma unroll
    for (int i = 0; i < 8; ++i) {
      const float z0 = ((y[2 * i] - mean) * rstd * gn[c0 + 2 * i] + gn[1024 + c0 + 2 * i] + bonus * v[2 * i]) * g[2 * i];
      const float z1 = ((y[2 * i + 1] - mean) * rstd * gn[c0 + 2 * i + 1] + gn[1024 + c0 + 2 * i + 1] + bonus * v[2 * i + 1]) * g[2 * i + 1];
      o[i] = pk_bf16(z0, z1);
    }
    *(u32x4*)(G + off) = mk4(o[0], o[1], o[2], o[3]);
    *(u32x4*)(G + off + 8) = mk4(o[4], o[5], o[6], o[7]);
  }
}

__device__ __forceinline__ void rglru_phase(char* lds, const bf16_t* __restrict__ XR, const bf16_t* __restrict__ Wg, const float* __restrict__ conv_w,
                            const float* __restrict__ conv_b, const float* __restrict__ gate_b, const float* __restrict__ lam,
                            bf16_t* __restrict__ HS0, bf16_t* __restrict__ HS1) {
  bf16_t* xcT = (bf16_t*)lds;
  f32x2* AB = (f32x2*)(lds + 26624);
  bf16_t* raw = (bf16_t*)(lds + 26624);
  float* segP = (float*)(lds + 116736);
  float* segH = segP + 352;
  float* segC = segH + 352;
  bf16_t* wgs = (bf16_t*)(lds + 120960);
  float* cws = (float*)(lds + 160896);
  const int tid = opaque_tid(), lane = tid & 63, wv = tid >> 6;
  for (int chain = blockIdx.x; chain < 256; chain += gridDim.x) {
    const int d = chain & 1, blk = (chain >> 1) & 15, b = chain >> 5;
    bf16_t* HS = d ? HS1 : HS0;
    float carry = 0.f;
    __syncthreads();
    for (int q = tid; q < 2 * 96 * 12; q += NTHR) {
      const int g = q / 1152, rem = q - g * 1152, n = rem / 12, k8 = rem - n * 12;
      *(u32x4*)(wgs + (g * 96 + n) * 104 + k8 * 8) = *(const u32x4*)(Wg + ((size_t)((blk * 4 + d * 2 + g) * 96 + n)) * 96 + k8 * 8);
    }
    for (int e = tid; e < 5 * 88; e += NTHR) {
      const int j = e / 88, c = e - j * 88;
      cws[e] = j < 4 ? conv_w[j * LW + blk * 88 + c] : conv_b[blk * 88 + c];
    }
    for (int e = tid; e < 128 * 8; e += NTHR) xcT[(e >> 3) * 104 + 88 + (e & 7)] = 0;
    u32x4 pre[3];
    auto tile_geom = [&](int ti, int& seqbase, int& t0, int& T) {
      if (ti < 2) { seqbase = ML + b * 256; T = 256; t0 = (d ? 1 - ti : ti) * 128; }
      else { seqbase = b * 4096; T = 4096; t0 = (d ? 31 - (ti - 2) : (ti - 2)) * 128; }
    };
    auto prefetch = [&](int ti) {
      int seqbase, t0, T; tile_geom(ti, seqbase, t0, T);
#pragma unroll
      for (int i = 0; i < 3; ++i) {
        const int q = tid + NTHR * i;
        const int row = q / 11, cc = q - row * 11, t = t0 - 2 + row;
        u32x4 v = {0u, 0u, 0u, 0u};
        if (q < 131 * 11 && t >= 0 && t < T) v = *(const u32x4*)(XR + (size_t)(seqbase + t) * LW + blk * 88 + cc * 8);
        pre[i] = v;
      }
    };
    prefetch(0);
    for (int ti = 0; ti < 34; ++ti) {
      int seqbase, t0, T; tile_geom(ti, seqbase, t0, T);
      __syncthreads();
#pragma unroll
      for (int i = 0; i < 3; ++i) {
        const int q = tid + NTHR * i;
        if (q < 131 * 11) *(u32x4*)(raw + q * 8) = pre[i];
      }
      if (ti + 1 < 34) prefetch(ti + 1);
      __builtin_amdgcn_sched_barrier(0);
      __syncthreads();
      for (int e = tid; e < 128 * 44; e += NTHR) {
        const int tl = e / 44, c2 = (e - tl * 44) * 2;
        float a0 = cws[4 * 88 + c2], a1 = cws[4 * 88 + c2 + 1];
#pragma unroll
        for (int j = 0; j < 4; ++j) {
          const unsigned x = *(const unsigned*)(raw + (tl + j) * 88 + c2);
          a0 += bf_lo(x) * cws[j * 88 + c2]; a1 += bf_hi(x) * cws[j * 88 + c2 + 1];
        }
        *(unsigned*)(xcT + tl * 104 + c2) = pk_bf16(a0, a1);
      }
      __syncthreads();
      {
        const int tok = wv * 16 + (lane & 15);
        u32x4 af[3];
#pragma unroll
        for (int kk = 0; kk < 3; ++kk) af[kk] = *(const u32x4*)(xcT + tok * 104 + kk * 32 + 8 * (lane >> 4));
#pragma unroll
        for (int n6 = 0; n6 < 6; ++n6) {
          f32x4 accr = {0.f, 0.f, 0.f, 0.f}, acci = {0.f, 0.f, 0.f, 0.f};
          const int ncol = n6 * 16 + (lane & 15);
          const bf16_t* wr_ = wgs + ncol * 104 + 8 * (lane >> 4);
          const bf16_t* wi_ = wgs + (96 + ncol) * 104 + 8 * (lane >> 4);
#pragma unroll
          for (int kk = 0; kk < 3; ++kk) {
            accr = mfma16(af[kk], *(const u32x4*)(wr_ + kk * 32), accr);
            acci = mfma16(af[kk], *(const u32x4*)(wi_ + kk * 32), acci);
          }
          if (ncol < 88) {
            const int ch = blk * 88 + ncol;
            const float gbr = gate_b[(d * 2 + 0) * LW + ch], gbi = gate_b[(d * 2 + 1) * LW + ch];
            const float spl = softplusf_(-lam[d * LW + ch]);
#pragma unroll
            for (int r = 0; r < 4; ++r) {
              const int tk = wv * 16 + (lane >> 4) * 4 + r;
              const float rg = sigmoidf_(accr[r] + gbr), ig = sigmoidf_(acci[r] + gbi);
              const float a = __expf(-8.f * rg * spl);
              const float bb = sqrtf(fmaxf(1.f - a * a, 0.f)) * ig * bf2f(xcT[tk * 104 + ncol]);
              AB[tk * 88 + ncol] = (f32x2){a, bb};
            }
          }
        }
      }
      __syncthreads();
      if (tid < 352) {
        const int seg = tid / 88, c = tid - seg * 88;
        float hl = 0.f, P = 1.f;
        for (int u0 = seg * 32; u0 < seg * 32 + 32; u0 += 8) {
          f32x2 ab[8];
#pragma unroll
          for (int i = 0; i < 8; ++i) { const int tl = d ? 127 - (u0 + i) : (u0 + i); ab[i] = AB[tl * 88 + c]; }
#pragma unroll
          for (int i = 0; i < 8; ++i) { hl = ab[i][0] * hl + ab[i][1]; P *= ab[i][0]; ab[i] = (f32x2){hl, P}; }
#pragma unroll
          for (int i = 0; i < 8; ++i) { const int tl = d ? 127 - (u0 + i) : (u0 + i); AB[tl * 88 + c] = ab[i]; }
        }
        segH[seg * 88 + c] = hl; segP[seg * 88 + c] = P;
      }
      __syncthreads();
      if (tid < 88) {
        float cur = carry;
#pragma unroll
        for (int seg = 0; seg < 4; ++seg) { segC[seg * 88 + tid] = cur; cur = segP[seg * 88 + tid] * cur + segH[seg * 88 + tid]; }
        carry = cur;
      }
      __syncthreads();
      for (int q = tid; q < 128 * 11; q += NTHR) {
        const int tl = q / 11, c8 = (q - tl * 11) * 8;
        const int u = d ? 127 - tl : tl;
        const float* sc = segC + (u >> 5) * 88 + c8;
        float hv[8];
#pragma unroll
        for (int i = 0; i < 8; ++i) { const f32x2 hp = AB[tl * 88 + c8 + i]; hv[i] = hp[0] + hp[1] * sc[i]; }
        *(u32x4*)(HS + (size_t)(seqbase + t0 + tl) * LW + blk * 88 + c8) =
            mk4(pk_bf16(hv[0], hv[1]), pk_bf16(hv[2], hv[3]), pk_bf16(hv[4], hv[5]), pk_bf16(hv[6], hv[7]));
      }
    }
  }
}

__device__ __forceinline__ void lru_z_phase(const bf16_t* __restrict__ HS0, const bf16_t* __restrict__ HS1, bf16_t* __restrict__ GG) {
  const size_t n8 = (size_t)MT * LW / 8;
  for (size_t e = (size_t)blockIdx.x * NTHR + threadIdx.x; e < n8; e += (size_t)gridDim.x * NTHR) {
    const u32x4 a = *(const u32x4*)(HS0 + e * 8), b = *(const u32x4*)(HS1 + e * 8), g = *(const u32x4*)(GG + e * 8);
    u32x4 o;
    o.x = pk_bf16((bf_lo(a.x) + bf_lo(b.x)) * bf_lo(g.x), (bf_hi(a.x) + bf_hi(b.x)) * bf_hi(g.x));
    o.y = pk_bf16((bf_lo(a.y) + bf_lo(b.y)) * bf_lo(g.y), (bf_hi(a.y) + bf_hi(b.y)) * bf_hi(g.y));
    o.z = pk_bf16((bf_lo(a.z) + bf_lo(b.z)) * bf_lo(g.z), (bf_hi(a.z) + bf_hi(b.z)) * bf_hi(g.z));
    o.w = pk_bf16((bf_lo(a.w) + bf_lo(b.w)) * bf_lo(g.w), (bf_hi(a.w) + bf_hi(b.w)) * bf_hi(g.w));
    *(u32x4*)(GG + e * 8) = o;
  }
}

__device__ __forceinline__ void nat_qk_phase(bf16_t* __restrict__ Q, bf16_t* __restrict__ Kb, bf16_t* __restrict__ QR, const float* __restrict__ qk_g) {
  const int tidx = opaque_tid();
  const int lane = tidx & 63;
  const int gw = blockIdx.x * (NTHR / 64) + (tidx >> 6), nw = gridDim.x * (NTHR / 64);
  const int qd = lane & 3;
  float gq[16], gk[16], inv[16];
#pragma unroll
  for (int i = 0; i < 16; ++i) { gq[i] = qk_g[qd * 16 + i]; gk[i] = qk_g[64 + qd * 16 + i]; inv[i] = exp2f(-(float)i * (13.287712379549449f / 16.f)); }
  for (int row = gw; row < MT; row += nw) {
    const bool lat = row < ML;
    const size_t off = (size_t)row * 1024 + lane * 16;
    float cs[16], sn[16];
    if (lat) {
      const int t = row & 4095;
      const float pos = (float)((qd >> 1) ? (t & 63) : (t >> 6));
#pragma unroll
      for (int i = 0; i < 16; ++i) {
        float rev = pos * inv[i] * 0.15915494309189535f;
        rev -= floorf(rev);
        sn[i] = __builtin_amdgcn_sinf(rev); cs[i] = __builtin_amdgcn_cosf(rev);
      }
    }
#pragma unroll
    for (int which = 0; which < 2; ++which) {
      bf16_t* P = which ? Kb : Q;
      const u32x4 a = *(const u32x4*)(P + off), b2 = *(const u32x4*)(P + off + 8);
      const unsigned u[8] = {a.x, a.y, a.z, a.w, b2.x, b2.y, b2.z, b2.w};
      float x[16];
#pragma unroll
      for (int i = 0; i < 8; ++i) { x[2 * i] = bf_lo(u[i]); x[2 * i + 1] = bf_hi(u[i]); }
      float ss = 0.f;
#pragma unroll
      for (int i = 0; i < 16; ++i) ss += x[i] * x[i];
      ss += __shfl_xor(ss, 1); ss += __shfl_xor(ss, 2);
      const float rstd = rsqrtf(ss * (1.f / 64.f) + 1e-6f);
#pragma unroll
      for (int i = 0; i < 16; ++i) x[i] = x[i] * rstd * (which ? gk[i] : gq[i]);
      unsigned pl[8];
#pragma unroll
      for (int i = 0; i < 8; ++i) pl[i] = pk_bf16(x[2 * i], x[2 * i + 1]);
      unsigned rt[8];
      if (lat) {
        float y[16];
#pragma unroll
        for (int i = 0; i < 16; ++i) {
          const float pr = __shfl_xor(x[i], 1);
          y[i] = x[i] * cs[i] + ((qd & 1) ? pr * sn[i] : -pr * sn[i]);
        }
#pragma unroll
        for (int i = 0; i < 8; ++i) rt[i] = pk_bf16(y[2 * i], y[2 * i + 1]);
      }
      if (which == 0) {
        *(u32x4*)(Q + off) = mk4(pl[0], pl[1], pl[2], pl[3]);
        *(u32x4*)(Q + off + 8) = mk4(pl[4], pl[5], pl[6], pl[7]);
        if (lat) { *(u32x4*)(QR + off) = mk4(rt[0], rt[1], rt[2], rt[3]); *(u32x4*)(QR + off + 8) = mk4(rt[4], rt[5], rt[6], rt[7]); }
      } else {
        if (lat) { *(u32x4*)(Kb + off) = mk4(rt[0], rt[1], rt[2], rt[3]); *(u32x4*)(Kb + off + 8) = mk4(rt[4], rt[5], rt[6], rt[7]); }
        else { *(u32x4*)(Kb + off) = mk4(pl[0], pl[1], pl[2], pl[3]); *(u32x4*)(Kb + off + 8) = mk4(pl[4], pl[5], pl[6], pl[7]); }
      }
    }
  }
}

struct AttnState { f32x16 O[2][2]; float m[2], l[2]; };

DEVI void attn_load_k(u32x4 (&kf)[4], const bf16_t* __restrict__ kbase, int lane) {
  const int l31 = lane & 31, lh = lane >> 5;
#pragma unroll
  for (int ks = 0; ks < 4; ++ks) kf[ks] = *(const u32x4*)(kbase + (size_t)l31 * 1024 + ks * 16 + 8 * lh);
}

DEVI void attn_compute(AttnState& st, const u32x4* qs, const bf16_t* __restrict__ kbase, const bf16_t* __restrict__ vtbase, int vtT,
                       const float* __restrict__ rpbs, bool band, int brow, int half, int lane) {
  const int l31 = lane & 31, lh = lane >> 5;
  u32x4 kf[4];
  attn_load_k(kf, kbase, lane);
  u32x4 vf[4];
#pragma unroll
  for (int dt = 0; dt < 2; ++dt)
#pragma unroll
    for (int s = 0; s < 2; ++s) {
      const bf16_t* vp = vtbase + (size_t)(dt * 32 + l31) * vtT + 16 * s + 4 * lh;
      const u32x2 lo = *(const u32x2*)vp, hi = *(const u32x2*)(vp + 8);
      vf[dt * 2 + s] = mk4(lo.x, lo.y, hi.x, hi.y);
    }
  __builtin_amdgcn_sched_barrier(0);
  constexpr float SC = 0.125f * 1.4426950408889634f;
  u32x4 pf[2][2];
#pragma unroll
  for (int qt = 0; qt < 2; ++qt) {
    f32x16 S;
#pragma unroll
    for (int r = 0; r < 16; ++r) S[r] = 0.f;
#pragma unroll
    for (int ks = 0; ks < 4; ++ks) S = mfma32(kf[ks], qs[(qt * 4 + ks) * 64], S);
    float cmax = -INFINITY;
    if (band) {
      const int qc = qt * 32 + l31;
      const int cst = min(max(qc - 8, 0), 48);
#pragma unroll
      for (int r = 0; r < 16; ++r) {
        const int key = (r & 3) + 8 * (r >> 2) + 4 * lh;
        const int kc = half * 32 + key;
        const bool ok = (kc >= cst) && (kc < cst + 16);
        const int bi = ok ? (brow * 31 + kc - qc + 15) : 0;
        const float sv = S[r] * SC + rpbs[bi];
        S[r] = ok ? sv : -INFINITY;
        cmax = fmaxf(cmax, S[r]);
      }
    } else {
#pragma unroll
      for (int r = 0; r < 16; ++r) { S[r] *= SC; cmax = fmaxf(cmax, S[r]); }
    }
    cmax = fmaxf(cmax, __shfl_xor(cmax, 32));
    const float mnew = fmaxf(st.m[qt], cmax);
    const float alpha = __builtin_amdgcn_exp2f(st.m[qt] - mnew);
    const bool grew = mnew > st.m[qt];
    st.m[qt] = mnew;
    float ps = 0.f;
#pragma unroll
    for (int r = 0; r < 16; ++r) { S[r] = __builtin_amdgcn_exp2f(S[r] - mnew); ps += S[r]; }
    st.l[qt] = st.l[qt] * alpha + ps;
    if (__any(grew)) {
#pragma unroll
      for (int dt = 0; dt < 2; ++dt)
#pragma unroll
        for (int r = 0; r < 16; ++r) st.O[qt][dt][r] *= alpha;
    }
    pf[qt][0] = mk4(pk_bf16(S[0], S[1]), pk_bf16(S[2], S[3]), pk_bf16(S[4], S[5]), pk_bf16(S[6], S[7]));
    pf[qt][1] = mk4(pk_bf16(S[8], S[9]), pk_bf16(S[10], S[11]), pk_bf16(S[12], S[13]), pk_bf16(S[14], S[15]));
  }
#pragma unroll
  for (int dt = 0; dt < 2; ++dt)
#pragma unroll
    for (int s = 0; s < 2; ++s) {
      st.O[0][dt] = mfma32(vf[dt * 2 + s], pf[0][s], st.O[0][dt]);
      st.O[1][dt] = mfma32(vf[dt * 2 + s], pf[1][s], st.O[1][dt]);
    }
}

__device__ __forceinline__ void natten_phase(char* lds, const bf16_t* __restrict__ Q, const bf16_t* __restrict__ QR, const bf16_t* __restrict__ Kb,
                             const bf16_t* __restrict__ VT, bf16_t* __restrict__ G, const float* __restrict__ rpb, bf16_t* __restrict__ Zd) {
  float* rpbs = (float*)lds;
  __syncthreads();
  for (int e = threadIdx.x; e < 16 * 465; e += NTHR) rpbs[e] = rpb[e] * 1.4426950408889634f;
  __syncthreads();
  const int tidx = opaque_tid();
  const int lane = tidx & 63, l31 = lane & 31, lh = lane >> 5;
  const int gw = blockIdx.x * (NTHR / 64) + (tidx >> 6), nw = gridDim.x * (NTHR / 64);
  const bf16_t* VTC = VT + (size_t)ML * 1024;
  u32x4* qs = (u32x4*)(lds + 32768) + (tidx >> 6) * 512 + lane;
  const int xcd = blockIdx.x & 7, wx = (blockIdx.x >> 3) * (NTHR / 64) + (tidx >> 6), nwx = (gridDim.x >> 3) * (NTHR / 64);
  for (int i = wx; i < 1024 + 64; i += nwx) {
    const bool lat = i < 1024;
    int b, h, r = 0, qrow0;
    if (lat) { const int pair = xcd * 16 + (i >> 6); r = i & 63; b = pair >> 4; h = pair & 15; qrow0 = b * 4096 + r * 64; }
    else { const int it = i - 1024; const int pair = xcd * 16 + (it >> 2); const int qt64 = it & 3; b = pair >> 4; h = pair & 15; qrow0 = ML + b * 256 + qt64 * 64; }
    const int start = min(max(r - 4, 0), 56);
    const int nchunks = lat ? 24 : 8;
    AttnState st;
#pragma unroll
    for (int a = 0; a < 2; ++a) { st.m[a] = -INFINITY; st.l[a] = 0.f;
#pragma unroll
      for (int c = 0; c < 2; ++c)
#pragma unroll
        for (int rr = 0; rr < 16; ++rr) st.O[a][c][rr] = 0.f; }
#pragma unroll
    for (int qt = 0; qt < 2; ++qt)
#pragma unroll
      for (int ks = 0; ks < 4; ++ks) qs[(qt * 4 + ks) * 64] = *(const u32x4*)(Q + (size_t)(qrow0 + qt * 32 + l31) * 1024 + h * 64 + ks * 16 + 8 * lh);
    for (int j = 0; j < nchunks; ++j) {
      if (j == 8) {
#pragma unroll
        for (int qt = 0; qt < 2; ++qt)
#pragma unroll
          for (int ks = 0; ks < 4; ++ks) qs[(qt * 4 + ks) * 64] = *(const u32x4*)(QR + (size_t)(qrow0 + qt * 32 + l31) * 1024 + h * 64 + ks * 16 + 8 * lh);
      }
      const bool band = j >= 8;
      const int ii = j - 8, kr = start + (ii >> 1), half = band ? (ii & 1) : 0;
      const size_t krow = band ? (size_t)(b * 4096 + kr * 64 + half * 32) : (size_t)(ML + b * 256 + j * 32);
      const bf16_t* kbase = Kb + krow * 1024 + h * 64;
      const bf16_t* vtb = band ? VT + (size_t)(b * 16 + h) * 64 * 4096 + kr * 64 + half * 32 : VTC + (size_t)(b * 16 + h) * 64 * 256 + j * 32;
      attn_compute(st, qs, kbase, vtb, band ? 4096 : 256, rpbs, band, band ? h * 15 + (kr - r + 7) : 0, half, lane);
    }
#pragma unroll
    for (int qt = 0; qt < 2; ++qt) {
      const float lt = st.l[qt] + __shfl_xor(st.l[qt], 32);
      const float inv = 1.f / lt;
      bf16_t* grow = G + (size_t)(qrow0 + qt * 32 + l31) * 1024 + h * 64;
#pragma unroll
      for (int dt = 0; dt < 2; ++dt)
#pragma unroll
        for (int q4 = 0; q4 < 4; ++q4) {
          bf16_t* gp = grow + dt * 32 + 8 * q4 + 4 * lh;
          bf16_t* zp = Zd + (gp - G);
          const u32x2 gv = *(const u32x2*)gp;
          u32x2 o;
          o.x = pk_bf16(st.O[qt][dt][4 * q4] * inv * bf_lo(gv.x), st.O[qt][dt][4 * q4 + 1] * inv * bf_hi(gv.x));
          o.y = pk_bf16(st.O[qt][dt][4 * q4 + 2] * inv * bf_lo(gv.y), st.O[qt][dt][4 * q4 + 3] * inv * bf_hi(gv.y));
          *(u32x2*)zp = o;
        }
    }
  }
}

namespace pg8 {
#define PG8_LAS __attribute__((address_space(3)))
typedef unsigned short bf16_t;
typedef short bf16x8 __attribute__((ext_vector_type(8)));
typedef float f32x4 __attribute__((ext_vector_type(4)));
typedef unsigned u32x4 __attribute__((ext_vector_type(4)));
constexpr int BM = 256, BK = 64, HALF = 128, HTB = HALF * BK * 2  , STAGE_BYTES = 8 * HTB, NXCD = 8, WGM = 8;

__host__ __device__ __forceinline__ int lds_byte(int r, int c) { const int st = (r >> 4) * 2 + (c >> 5), rr = r & 15, cc = c & 31, ob = rr * 64 + cc * 2; return st * 1024 + (ob ^ (((ob >> 9) & 1) << 5)); }
__host__ __device__ __forceinline__ void stage_rc(int b, int& R, int& C) { const int st = b / 1024, sb = b % 1024, swz = sb ^ (((sb >> 9) & 1) << 5); R = (st >> 1) * 16 + swz / 64; C = (st & 1) * 32 + (swz % 64) / 2; }
__host__ __device__ __forceinline__ int perm32(int rho) { const int n = rho >> 4, i = rho & 15; return 8 * (i >> 2) + 4 * n + (i & 3); }

struct Unit { int pm, pn; };
struct Gemm { const bf16_t* A; const bf16_t* Bt; int M, N, K; };

struct StaticOrder {
    int nM, nN, nwg, G, c;
    __host__ __device__ void init(int M, int N, int G_, int c_) { nM = M / BM; nN = N / BM; nwg = nM * nN; G = G_; c = c_; }
    __host__ __device__ bool next(int i, Unit& u) const {
        const long L = (long)i * G + c; if (L >= nwg) return false;
        int wgid = (int)L; { const int q = nwg / NXCD, r = nwg % NXCD, xcd = wgid % NXCD, off = wgid / NXCD; wgid = (xcd < r ? xcd * (q + 1) : r * (q + 1) + (xcd - r) * q) + off; }
        const int nig = WGM * nN, gid = wgid / nig, fm = gid * WGM, gsz = (nM - fm) < WGM ? (nM - fm) : WGM;
        u.pm = fm + ((wgid % nig) % gsz); u.pn = (wgid % nig) / gsz; return true;
    }
    __device__ __forceinline__ void a_ready(const Unit&) const {}
    __device__ __forceinline__ void done(const Unit&) const {}
};
template <class Epi, class Sched, bool STAMP = false>
__device__ __forceinline__ void gemm_phase(PG8_LAS unsigned char* lds, const Gemm g, const Sched& S, const Epi& E, unsigned long long* stamps) {
    const int tid = threadIdx.x, wid = __builtin_amdgcn_readfirstlane(tid >> 6), lane = tid & 63, wr = wid >> 2, wc = wid & 3, fr = lane & 15, fq = lane >> 4;
    const int K = g.K, nt = K / BK;
    int ts_lo = 0, ts_hi = 0, nts = 0; const unsigned long long rt_entry = STAMP ? (unsigned long long)wall_clock64() : 0ull;
#define PG8_STAMP() do { if (STAMP && wid == 0 && nts < 64) { const unsigned long long _c = (unsigned long long)clock64(); \
        ts_lo = (lane == nts) ? (int)(unsigned)_c : ts_lo; ts_hi = (lane == nts) ? (int)(unsigned)(_c >> 32) : ts_hi; ++nts; } } while (0)
    PG8_STAMP();
    unsigned voffA[2], voffB[2];
#pragma unroll
    for (int i = 0; i < 2; ++i) { int R, C; stage_rc(tid * 16 + i * 8192, R, C); const int Rb = Epi::PERM ? ((R & ~31) + perm32(R & 31)) : R;
        voffA[i] = (unsigned)(R * K + C) * 2u; voffB[i] = (unsigned)(Rb * K + C) * 2u; }
    const size_t kstep = (size_t)(BK * 2);
    const size_t hstep = (size_t)HALF * K * 2;
    const size_t tstep = 2 * hstep;
    const unsigned ldsw = (unsigned)wid * 1024u;
    const int aoff = lds_byte(wr * 64 + fr, fq * 8), boff = lds_byte(wc * 32 + fr, fq * 8);
#define PG8_SA(b, h) (((b) * 2 + (h)) * HTB)
#define PG8_SB(b, h) ((4 + (b) * 2 + (h)) * HTB)
#define PG8_STAGE(bufoff, gbase, voff) do { _Pragma("unroll") for (int _i = 0; _i < 2; ++_i) \
        __builtin_amdgcn_global_load_lds((const unsigned*)((const char*)(gbase) + (voff)[_i]), (PG8_LAS unsigned*)(lds + (bufoff) + ldsw + _i * 8192), 16, 0, 0); } while (0)
#define PG8_LDA(dst, b, h) do { _Pragma("unroll") for (int m = 0; m < 4; ++m) _Pragma("unroll") for (int k = 0; k < 2; ++k) dst[m][k] = *(const PG8_LAS bf16x8*)(lds + PG8_SA(b, h) + aoff + m * 2048 + k * 1024); } while (0)
#define PG8_LDB(dst, b, h) do { _Pragma("unroll") for (int n = 0; n < 2; ++n) _Pragma("unroll") for (int k = 0; k < 2; ++k) dst[n][k] = *(const PG8_LAS bf16x8*)(lds + PG8_SB(b, h) + boff + n * 2048 + k * 1024); } while (0)
#define PG8_MMA(ai, bj, At, Bt) do { __builtin_amdgcn_s_setprio(1); _Pragma("unroll") for (int m = 0; m < 4; ++m) _Pragma("unroll") for (int n = 0; n < 2; ++n) _Pragma("unroll") for (int k = 0; k < 2; ++k) \
        acc[ai][bj][m][n] = __builtin_amdgcn_mfma_f32_16x16x32_bf16(Bt[n][k], At[m][k], acc[ai][bj][m][n], 0, 0, 0); __builtin_amdgcn_s_setprio(0); } while (0)
#define PG8_WAIT_V(n) asm volatile("s_waitcnt vmcnt(" #n ")" ::: "memory")
#define PG8_WAIT_L(n) asm volatile("s_waitcnt lgkmcnt(" #n ")" ::: "memory")
#define PG8_BAR __builtin_amdgcn_s_barrier()
#define PG8_SCHED __builtin_amdgcn_sched_barrier(0)
    Unit cur, nxt; int ui = 0;
    if (!S.next(0, cur)) return;
    f32x4 acc[2][2][4][2];
#pragma unroll
    for (int a = 0; a < 2; ++a)
#pragma unroll
        for (int b = 0; b < 2; ++b)
#pragma unroll
            for (int m = 0; m < 4; ++m)
#pragma unroll
                for (int n = 0; n < 2; ++n) acc[a][b][m][n] = (f32x4){0.f, 0.f, 0.f, 0.f};
    bf16x8 At[4][2], B0[2][2], B1[2][2];
    const char* cA = (const char*)g.A + (size_t)cur.pm * tstep; const char* cB = (const char*)g.Bt + (size_t)cur.pn * tstep;
    S.a_ready(cur);
    PG8_STAGE(PG8_SB(0, 0), cB, voffB); PG8_STAGE(PG8_SA(0, 0), cA, voffA); PG8_STAGE(PG8_SB(0, 1), cB + hstep, voffB); PG8_STAGE(PG8_SA(0, 1), cA + hstep, voffA);
    if (wr == 1) PG8_BAR;
    PG8_WAIT_V(4); PG8_BAR;
    PG8_STAGE(PG8_SB(1, 0), cB + kstep, voffB); PG8_STAGE(PG8_SA(1, 0), cA + kstep, voffA); PG8_STAGE(PG8_SB(1, 1), cB + hstep + kstep, voffB);
    PG8_WAIT_V(6); PG8_BAR;
    PG8_STAMP();
    for (;;) {
        const bool has_next = S.next(ui + 1, nxt);
        const char* nA = has_next ? (const char*)g.A + (size_t)nxt.pm * tstep : cA; const char* nB = has_next ? (const char*)g.Bt + (size_t)nxt.pn * tstep : cB;
        for (int t = 0; t < nt; t += 2) {
            const bool last = (t == nt - 2);
            const char* a1 = cA + (size_t)(t + 1) * kstep;
            const char* a2 = last ? nA : cA + (size_t)(t + 2) * kstep; const char* b2 = last ? nB : cB + (size_t)(t + 2) * kstep;
            const char* a3 = a2 + kstep; const char* b3 = b2 + kstep;
            if (last && has_next) S.a_ready(nxt);
            PG8_LDB(B0, 0, 0); PG8_SCHED; PG8_LDA(At, 0, 0); PG8_STAGE(PG8_SA(1, 1), a1 + hstep, voffA);
            PG8_WAIT_L(8); PG8_BAR; PG8_WAIT_L(0); PG8_MMA(0, 0, At, B0); PG8_BAR; PG8_SCHED;
            PG8_LDB(B1, 0, 1); PG8_STAGE(PG8_SB(0, 0), b2, voffB);
            PG8_BAR; PG8_WAIT_L(0); PG8_MMA(0, 1, At, B1); PG8_BAR;
            PG8_LDA(At, 0, 1); PG8_STAGE(PG8_SA(0, 0), a2, voffA);
            PG8_BAR; PG8_WAIT_L(0); PG8_MMA(1, 0, At, B0); PG8_BAR; PG8_SCHED;
            PG8_STAGE(PG8_SB(0, 1), b2 + hstep, voffB);
            PG8_WAIT_V(6); PG8_BAR; PG8_MMA(1, 1, At, B1); PG8_BAR;
            PG8_LDB(B0, 1, 0); PG8_SCHED; PG8_LDA(At, 1, 0); PG8_STAGE(PG8_SA(0, 1), a2 + hstep, voffA);
            PG8_WAIT_L(8); PG8_BAR; PG8_WAIT_L(0); PG8_MMA(0, 0, At, B0); PG8_BAR; PG8_SCHED;
            PG8_LDB(B1, 1, 1); PG8_STAGE(PG8_SB(1, 0), b3, voffB);
            PG8_BAR; PG8_WAIT_L(0); PG8_MMA(0, 1, At, B1); PG8_BAR;
            PG8_LDA(At, 1, 1); PG8_STAGE(PG8_SA(1, 0), a3, voffA);
            PG8_BAR; PG8_WAIT_L(0); PG8_MMA(1, 0, At, B0); PG8_BAR; PG8_SCHED;
            PG8_STAGE(PG8_SB(1, 1), b3 + hstep, voffB);
            PG8_WAIT_V(6); PG8_BAR; PG8_MMA(1, 1, At, B1); PG8_BAR;
        }
        PG8_STAMP();
        if constexpr (!Epi::AFTER_DRAIN) { E(acc, cur, wr, wc, fr, fq); S.done(cur); }
        PG8_STAMP();
        if (!has_next) break;
#pragma unroll
        for (int a = 0; a < 2; ++a)
#pragma unroll
            for (int b = 0; b < 2; ++b)
#pragma unroll
                for (int m = 0; m < 4; ++m)
#pragma unroll
                    for (int n = 0; n < 2; ++n) acc[a][b][m][n] = (f32x4){0.f, 0.f, 0.f, 0.f};
        cur = nxt; cA = nA; cB = nB; ++ui;
    }
    PG8_WAIT_V(0);
    if (wr == 0) PG8_BAR;
    PG8_BAR;
    if constexpr (Epi::AFTER_DRAIN) { E.fused(acc, cur, wr, wc, fr, fq, lds, wid, lane); S.done(cur); }
    PG8_STAMP();
    if (STAMP && wid == 0) { stamps[lane] = lane < nts ? (((unsigned long long)(unsigned)ts_hi << 32) | (unsigned)ts_lo) : 0ull;
        if (lane == 62) stamps[62] = rt_entry; if (lane == 63) stamps[63] = (unsigned long long)wall_clock64(); }
#undef PG8_STAMP
#undef PG8_SA
#undef PG8_SB
#undef PG8_STAGE
#undef PG8_LDA
#undef PG8_LDB
#undef PG8_MMA
#undef PG8_WAIT_V
#undef PG8_WAIT_L
#undef PG8_BAR
#undef PG8_SCHED
}
}

template <class EP> struct Pg8Epi {
  static constexpr bool PERM = false, AFTER_DRAIN = false;
  EP ep;
  __device__ __forceinline__ void operator()(const pg8::f32x4 (&acc)[2][2][4][2], const pg8::Unit& u, int wr, int wc, int fr, int fq) const {
#pragma unroll
    for (int ai = 0; ai < 2; ++ai)
#pragma unroll
      for (int m = 0; m < 4; ++m)
#pragma unroll
        for (int bj = 0; bj < 2; ++bj)
#pragma unroll
          for (int n = 0; n < 2; ++n) {
            const int row = u.pm * 256 + ai * 128 + wr * 64 + m * 16 + fr;
            const int col = u.pn * 256 + bj * 128 + wc * 32 + n * 16 + fq * 4;
            ep(row, col, acc[ai][bj][m][n]);
          }
  }
};
template <class EP>
__device__ __forceinline__ void pg8_gemm(char* lds, const bf16_t* A, const bf16_t* Bt, int M, int N, int K, const EP ep) {
  __syncthreads();
  pg8::Gemm g{A, Bt, M, N, K};
  pg8::StaticOrder S; S.init(M, N, (int)gridDim.x, (int)blockIdx.x);
  Pg8Epi<EP> E{ep};
  pg8::gemm_phase<Pg8Epi<EP>, pg8::StaticOrder, false>((PG8_LAS unsigned char*)lds, g, S, E, nullptr);
  __syncthreads();
}

template <int ph>
__device__ __forceinline__ void run_phase(const Params& p, char* lds, bool last_rep) {
  char* ws = p.ws;
  const float* MOD = (const float*)(ws + OFF_MOD);
  float* XC = (float*)(ws + OFF_XC);
  bf16_t* HB = (bf16_t*)(ws + OFF_HB);
  bf16_t* A0 = (bf16_t*)(ws + OFF_A0); bf16_t* A1 = (bf16_t*)(ws + OFF_A1); bf16_t* A2 = (bf16_t*)(ws + OFF_A2);
  bf16_t* A3 = (bf16_t*)(ws + OFF_A3); bf16_t* A4 = (bf16_t*)(ws + OFF_A4);
  bf16_t* WD = (bf16_t*)(ws + OFF_WD); bf16_t* AD = (bf16_t*)(ws + OFF_AD);
  float* BON = (float*)(ws + OFF_BON);
  if (ph == 0) { phase0(p, lds); return; }
  constexpr int layer = (ph - 1) / 5, sub = (ph - 1) % 5;
  const float* modL = MOD + (size_t)layer * 9 * 3072;
  const float* xl_cur = layer == 0 ? p.in[0] : p.out;
  const float* xc_cur = layer == 0 ? p.in[2] : XC;
  if (layer == 0 || layer == 3) {
    const int ib = layer ? 33 : 4;
    const bf16_t* WIN = (const bf16_t*)(ws + (layer ? OFF_W3IN : OFF_W0IN));
    const bf16_t* WUP = (const bf16_t*)(ws + (layer ? OFF_W3UP : OFF_W0UP));
    const bf16_t* WOUT = (const bf16_t*)(ws + (layer ? OFF_W3OUT : OFF_W0OUT));
    if (sub == 0) norm_phase<true>(xl_cur, xc_cur, p.in[ib], modL, HB, A4);
    else if (sub == 1) { ALMix al{HB, A4, p.in[ib + 4]}; EpRwkvIn ep{A0, A1, A2, A3, WD, AD}; gemm256_phase(lds, WIN, 1024, MT / 256, 16, al, ep); gemm_phase(lds, WIN, 1024, MT / 256, 2, al, ep, 4096, true); }
    else if (sub == 2) rwkv_scan_phase(lds, A0, A1, A2, WD, AD, WUP, p.in[ib + 5], p.in[ib + 8], p.in[ib + 9], HB, A4, BON);
    else if (sub == 3) rwkv_post_phase(HB, A4, A2, A3, BON, p.in[ib + 10], layer == 3 ? ML : MT);
    else { ALPlain al{A3, 1024}; EpRes ep{xl_cur, xc_cur, p.out, XC, modL}; pg8_gemm(lds, A3, WOUT, ML, 1024, 1024, ep); if (layer != 3) gemm_phase(lds, WOUT, 1024, MC / 256, 8, al, ep, 0, false, ML / 256); }
  } else if (layer == 1) {
    bf16_t* HS0 = (bf16_t*)(ws + OFF_HS0); bf16_t* XR = (bf16_t*)(ws + OFF_XR); bf16_t* GG = (bf16_t*)(ws + OFF_GG); bf16_t* HS1 = (bf16_t*)(ws + OFF_HS1);
    if (sub == 0) norm_phase<false>(xl_cur, xc_cur, p.in[16], modL, HB, nullptr);
    else if (sub == 1) { ALPlain al{HB, 1024}; EpLruIn ep{XR, GG}; pg8_gemm(lds, HB, (const bf16_t*)(ws + OFF_W1IN), MT, 2816, 1024, ep); }
    else if (sub == 2) rglru_phase(lds, XR, (const bf16_t*)(ws + OFF_W1G), p.in[20], p.in[21], p.in[23], p.in[24], HS0, HS1);
    else if (sub == 3) lru_z_phase(HS0, HS1, GG);
    else { ALPlain al{GG, LW}; EpRes ep{xl_cur, xc_cur, p.out, XC, modL}; pg8_gemm(lds, GG, (const bf16_t*)(ws + OFF_W1OUT), ML, 1024, LW, ep); gemm_phase(lds, (const bf16_t*)(ws + OFF_W1OUT), LW, MC / 256, 8, al, ep, 0, false, ML / 256); }
  } else {
    if (sub == 0) norm_phase<false>(xl_cur, xc_cur, p.in[26], modL, HB, nullptr);
    else if (sub == 1) { ALPlain al{HB, 1024}; EpNatIn ep{A0, A1, A2, A3}; pg8_gemm(lds, HB, (const bf16_t*)(ws + OFF_W2IN), MT, 4096, 1024, ep); }
    else if (sub == 2) nat_qk_phase(A0, A1, A4, p.in[30]);
    else if (sub == 3) natten_phase(lds, A0, A4, A1, A2, A3, p.in[31], last_rep ? A3 : HB);
    else { ALPlain al{A3, 1024}; EpRes ep{xl_cur, xc_cur, p.out, XC, modL}; pg8_gemm(lds, A3, (const bf16_t*)(ws + OFF_W2OUT), ML, 1024, 1024, ep); gemm_phase(lds, (const bf16_t*)(ws + OFF_W2OUT), 1024, MC / 256, 8, al, ep, 0, false, ML / 256); }
  }
}

__global__ void __launch_bounds__(NTHR) mega_kernel(Params p) {
  __shared__ __attribute__((aligned(16))) char lds[LDS_BYTES];
  __shared__ u32x4 xb_words;
  cg::grid_group grid = cg::this_grid();
  if (threadIdx.x == 0) xb_words = (u32x4){0u, 0u, 0u, 0u};
  __syncthreads();
  const XcdBarrier xb = xcd_barrier_post((unsigned*)(p.ws + OFF_BAR), (volatile LAS unsigned*)&xb_words);
#define PHASE(k) if (p.ph_lo <= k && k < p.ph_hi) { for (int rep = 0; rep < REP[k]; ++rep) { run_phase<k>(p, lds, rep + 1 == REP[k]); if (rep + 1 < REP[k] || k + 1 < p.ph_hi) { if (k == 0) grid.sync(); else xcd_barrier(xb); } } }
  PHASE(0) PHASE(1) PHASE(2) PHASE(3) PHASE(4) PHASE(5) PHASE(6) PHASE(7) PHASE(8) PHASE(9) PHASE(10)
  PHASE(11) PHASE(12) PHASE(13) PHASE(14) PHASE(15) PHASE(16) PHASE(17) PHASE(18) PHASE(19) PHASE(20)
#undef PHASE
}

extern "C" void kernel_launch(void* const* d_in, const int* in_sizes, int n_in, void* d_out, int out_size, void* d_ws, size_t ws_size,
                              hipStream_t stream) {
  static int grid_blocks = 0;
  if (!grid_blocks) {
    int dev = 0, cus = 0, per_cu = 0;
    hipGetDevice(&dev);
    hipDeviceGetAttribute(&cus, hipDeviceAttributeMultiprocessorCount, dev);
    hipOccupancyMaxActiveBlocksPerMultiprocessor(&per_cu, mega_kernel, NTHR, 0);
    if (per_cu < 1) { fprintf(stderr, "occupancy query returned %d\n", per_cu); per_cu = 1; }
    if (per_cu > 1) per_cu = 1;
    grid_blocks = cus * per_cu;
    if (n_in != 45 || ws_size < WS_END) fprintf(stderr, "unexpected n_in %d / ws %zu (need %zu)\n", n_in, ws_size, (size_t)WS_END);
  }
  Params p{};
  for (int i = 0; i < 45; ++i) p.in[i] = (const float*)d_in[i];
  p.out = (float*)d_out;
  p.ws = (char*)d_ws;
  (void)hipMemsetAsync((char*)d_ws + OFF_BAR, 0, XCD_BAR_WORDS * 4, stream);
#if N_LAUNCH_MODE == 1
  p.ph_lo = 0; p.ph_hi = NPHASE;
  void* args[] = {&p};
  hipError_t e = hipLaunchCooperativeKernel((void*)mega_kernel, dim3(grid_blocks), dim3(NTHR), args, 0, stream);
  if (e != hipSuccess) fprintf(stderr, "cooperative launch failed: %s (grid %d)\n", hipGetErrorString(e), grid_blocks);
#else
  for (int ph = 0; ph < NPHASE; ++ph) {
    p.ph_lo = ph; p.ph_hi = ph + 1;
    hipLaunchKernelGGL(mega_kernel, dim3(grid_blocks), dim3(NTHR), 0, stream, p);
  }
#endif
}
```

```cpp
#include <hip/hip_runtime.h>
#include <hip/hip_cooperative_groups.h>
#include <cstdio>
#include <cstdint>
namespace cg = cooperative_groups;

#ifndef N_LAUNCH_MODE
#define N_LAUNCH_MODE 1
#endif

typedef unsigned short bf16_t;
typedef short bf16x8 __attribute__((ext_vector_type(8)));
typedef float f32x4 __attribute__((ext_vector_type(4)));
typedef float f32x16 __attribute__((ext_vector_type(16)));
typedef float f32x2 __attribute__((ext_vector_type(2)));
typedef unsigned u32x4 __attribute__((ext_vector_type(4)));
typedef unsigned u32x2 __attribute__((ext_vector_type(2)));

#define DEVI __device__ __forceinline__

constexpr int D = 1024, NB = 8, SEQ = 4096, CTX = 256;
constexpr int ML = NB * SEQ;
constexpr int MC = NB * CTX;
constexpr int MT = ML + MC;
constexpr int LW = 1408;
constexpr int NTHR = 512;
constexpr int NPHASE = 21;
constexpr int LDS_BYTES = 163840 - 16;
__device__ constexpr int REP[21] = {1,1,1,1,1,1,1,1,1,1,1,1,1,1,1,1,1,1,1,1,1};

constexpr size_t SZ_ACT = (size_t)MT * 1024 * 2;
constexpr size_t OFF_MOD = 0;
constexpr size_t OFF_BAR = 458752;
constexpr size_t OFF_W0IN = 524288;
constexpr size_t SZ_RWIN = (size_t)4352 * 1024 * 2;
constexpr size_t SZ_RWUP = (size_t)4 * 1024 * 64 * 2;
constexpr size_t SZ_SQ = (size_t)1024 * 1024 * 2;
constexpr size_t OFF_W0UP = OFF_W0IN + SZ_RWIN;
constexpr size_t OFF_W0OUT = OFF_W0UP + SZ_RWUP;
constexpr size_t OFF_W3IN = OFF_W0OUT + SZ_SQ;
constexpr size_t OFF_W3UP = OFF_W3IN + SZ_RWIN;
constexpr size_t OFF_W3OUT = OFF_W3UP + SZ_RWUP;
constexpr size_t OFF_W1IN = OFF_W3OUT + SZ_SQ;
constexpr size_t OFF_W1G = OFF_W1IN + (size_t)2816 * 1024 * 2;
constexpr size_t OFF_W1OUT = OFF_W1G + (size_t)16 * 4 * 96 * 96 * 2;
constexpr size_t OFF_W2IN = OFF_W1OUT + (size_t)1024 * 1408 * 2;
constexpr size_t OFF_W2OUT = OFF_W2IN + (size_t)4096 * 1024 * 2;
constexpr size_t OFF_XC = OFF_W2OUT + SZ_SQ;
constexpr size_t OFF_BON = OFF_XC + (size_t)MC * 1024 * 4;
constexpr size_t OFF_BIG = OFF_BON + (size_t)2 * MT * 16 * 4;
constexpr size_t OFF_HB = OFF_BIG;
constexpr size_t OFF_A0 = OFF_BIG + SZ_ACT;
constexpr size_t OFF_A1 = OFF_A0 + SZ_ACT;
constexpr size_t OFF_A2 = OFF_A1 + SZ_ACT;
constexpr size_t OFF_A3 = OFF_A2 + SZ_ACT;
constexpr size_t OFF_A4 = OFF_A3 + SZ_ACT;
constexpr size_t OFF_WD = OFF_A4 + SZ_ACT;
constexpr size_t OFF_AD = OFF_WD + (size_t)MT * 128 * 2;
constexpr size_t WS_END = OFF_AD + (size_t)MT * 128 * 2;
constexpr size_t SZ_LRU = (size_t)MT * LW * 2;
constexpr size_t OFF_HS0 = OFF_BIG;
constexpr size_t OFF_XR = OFF_BIG + SZ_LRU;
constexpr size_t OFF_GG = OFF_XR + SZ_LRU;
constexpr size_t OFF_HS1 = OFF_GG + SZ_LRU;
static_assert(OFF_HS1 + SZ_LRU <= WS_END, "lru overlay");
static_assert(WS_END <= (size_t)536870912, "ws");

struct Params {
  const float* in[45];
  float* out;
  char* ws;
  int ph_lo, ph_hi;
};

DEVI u32x4 mk4(unsigned a, unsigned b, unsigned c, unsigned d) { u32x4 r = {a, b, c, d}; return r; }
DEVI int opaque_tid() { int t = threadIdx.x; asm volatile("" : "+v"(t)); return t; }
DEVI float bf_lo(unsigned u) { return __uint_as_float(u << 16); }
DEVI float bf_hi(unsigned u) { return __uint_as_float(u & 0xffff0000u); }
DEVI float bf2f(bf16_t h) { return __uint_as_float(((unsigned)h) << 16); }
typedef __bf16 bf16x2_t __attribute__((ext_vector_type(2)));
DEVI unsigned pk_bf16(float lo, float hi) { f32x2 f = {lo, hi}; bf16x2_t v = __builtin_convertvector(f, bf16x2_t); return __builtin_bit_cast(unsigned, v); }
DEVI bf16_t f2bf(float f) { return (bf16_t)(pk_bf16(f, 0.f) & 0xffffu); }
DEVI float wave_sum(float v) {
#pragma unroll
  for (int o = 32; o; o >>= 1) v += __shfl_xor(v, o);
  return v;
}
DEVI float sigmoidf_(float x) { return __builtin_amdgcn_rcpf(1.f + __expf(-x)); }
DEVI float siluf_(float x) { return x * __builtin_amdgcn_rcpf(1.f + __expf(-x)); }
DEVI float softplusf_(float x) { return fmaxf(x, 0.f) + __logf(1.f + __expf(-fabsf(x))); }
DEVI f32x16 mfma32(u32x4 a, u32x4 b, f32x16 c) {
  return __builtin_amdgcn_mfma_f32_32x32x16_bf16(__builtin_bit_cast(bf16x8, a), __builtin_bit_cast(bf16x8, b), c, 0, 0, 0);
}
DEVI f32x4 mfma16(u32x4 a, u32x4 b, f32x4 c) {
  return __builtin_amdgcn_mfma_f32_16x16x32_bf16(__builtin_bit_cast(bf16x8, a), __builtin_bit_cast(bf16x8, b), c, 0, 0, 0);
}
template <int CTRL> DEVI float dpp_f(float v) {
  return __int_as_float(__builtin_amdgcn_update_dpp(0, __float_as_int(v), CTRL, 0xf, 0xf, true));
}
DEVI float sum8(float v) {
  v += dpp_f<0xB1>(v);
  v += dpp_f<0x4E>(v);
  v += dpp_f<0x141>(v);
  return v;
}

#define XB_TMO      128
#define XB_XCNT(j)  (256  + 64 * (j))
#define XB_XSUB(j)  (1280 + 64 * (j))
#define XB_XGEN(j)  (2304 + 64 * (j))
#define XB_TOP      3328
#define XB_TOPGEN   3392
#define XCD_BAR_WORDS 3456
#define XB_SPIN_CAP (1u << 18)
#define LAS __attribute__((address_space(3)))

__device__ __forceinline__ unsigned xb_ld(unsigned* p)              { return __hip_atomic_load(p, __ATOMIC_RELAXED, __HIP_MEMORY_SCOPE_AGENT); }
__device__ __forceinline__ unsigned xb_add(unsigned* p, unsigned v) { return __hip_atomic_fetch_add(p, v, __ATOMIC_RELAXED, __HIP_MEMORY_SCOPE_AGENT); }
__device__ __forceinline__ unsigned xb_xcc_id() { return (unsigned)__builtin_amdgcn_s_getreg((3 << 11) | 20) & 0xFu; }
#define XB_SPIN(cond, bar) do { unsigned _sp = 0; while (cond) { __builtin_amdgcn_s_sleep(1); \
    if ((++_sp & 255u) == 0u) { if (xb_ld(&(bar)[XB_TMO])) break; if (_sp > XB_SPIN_CAP) { atomicAdd(&(bar)[XB_TMO], 1u); break; } } } } while (0)

struct XcdBarrier {
    unsigned* bar; unsigned x;
    volatile LAS unsigned* st;
};

__device__ __forceinline__ XcdBarrier xcd_barrier_post(unsigned* bar, volatile LAS unsigned* st) {
    XcdBarrier b; b.bar = bar; b.x = xb_xcc_id(); b.st = st;
    if (threadIdx.x == 0) (void)xb_add(&bar[XB_XCNT(b.x)], 1u);
    return b;
}
__device__ __forceinline__ void xcd_barrier_complete(unsigned* bar, unsigned x, unsigned& nloc, unsigned& nx) {
    const unsigned G = gridDim.x * gridDim.y * gridDim.z;
    unsigned sum, cnt, mine, sp = 0u;
    for (;;) {
        sum = 0u; cnt = 0u; mine = 0u;
#pragma unroll
        for (unsigned j = 0; j < 16; ++j) { const unsigned c = xb_ld(&bar[XB_XCNT(j)]); sum += c; cnt += (c > 0u) ? 1u : 0u; mine = (j == x) ? c : mine; }
        if (sum == G) break;
        __builtin_amdgcn_s_sleep(1);
        if ((++sp & 255u) == 0u) { if (xb_ld(&bar[XB_TMO])) break; if (sp > XB_SPIN_CAP) { atomicAdd(&bar[XB_TMO], 1u); break; } }
    }
    nloc = mine > 0u ? mine : 1u; nx = cnt > 0u ? cnt : 1u;
}

__device__ __forceinline__ void xcd_barrier(const XcdBarrier& b) {
    asm volatile("s_waitcnt vmcnt(0)" ::: "memory");
    __syncthreads();
    if (threadIdx.x == 0) {
        unsigned* bar = b.bar;
        __builtin_amdgcn_s_waitcnt(0);
        unsigned nloc = b.st[0], nx = b.st[1];
        if (nloc == 0u) { xcd_barrier_complete(bar, b.x, nloc, nx); b.st[0] = nloc; b.st[1] = nx; }
        const unsigned old = xb_add(&bar[XB_XSUB(b.x)], 1u);
        const unsigned gen = old / nloc;
        if (old + 1u == (gen + 1u) * nloc) {
            __builtin_amdgcn_fence(__ATOMIC_RELEASE, "agent");
            asm volatile("s_waitcnt vmcnt(0)" ::: "memory");
            const unsigned og = xb_add(&bar[XB_TOP], 1u);
            const unsigned tg = og / nx;
            if (og + 1u == (tg + 1u) * nx) xb_add(&bar[XB_TOPGEN], 1u);
            else XB_SPIN(xb_ld(&bar[XB_TOPGEN]) == tg, bar);
            __builtin_amdgcn_fence(__ATOMIC_ACQUIRE, "agent");
            xb_add(&bar[XB_XGEN(b.x)], 1u);
            asm volatile("s_waitcnt vmcnt(0)" ::: "memory");
        } else {
            XB_SPIN(xb_ld(&bar[XB_XGEN(b.x)]) == gen, bar);
            __builtin_amdgcn_fence(__ATOMIC_ACQUIRE, "agent");
            asm volatile("s_waitcnt vmcnt(0)" ::: "memory");
        }
    }
    __syncthreads();
}


struct TJob { const float* src; int K, N; bf16_t* dst; int ldd; };

DEVI TJob get_tjob(const Params& p, int j) {
  TJob t;
  if (j < 26) {
    const int l = j / 13, jj = j % 13;
    const int ib = l ? 33 : 4;
    bf16_t* win = (bf16_t*)(p.ws + (l ? OFF_W3IN : OFF_W0IN));
    bf16_t* wup = (bf16_t*)(p.ws + (l ? OFF_W3UP : OFF_W0UP));
    bf16_t* wout = (bf16_t*)(p.ws + (l ? OFF_W3OUT : OFF_W0OUT));
    if (jj < 4) { t.src = p.in[ib + 3] + (size_t)jj * 1048576; t.K = 1024; t.N = 1024; t.dst = win + (size_t)jj * 1048576; t.ldd = 1024; }
    else if (jj < 8) { const int idx = jj - 4, d = idx >> 1, kind = idx & 1;
      t.src = p.in[ib + 6] + (size_t)idx * 65536; t.K = 1024; t.N = 64; t.dst = win + (size_t)(4096 + kind * 128 + d * 64) * 1024; t.ldd = 1024; }
    else if (jj < 12) { const int idx = jj - 8;
      t.src = p.in[ib + 7] + (size_t)idx * 65536; t.K = 64; t.N = 1024; t.dst = wup + (size_t)idx * 65536; t.ldd = 64; }
    else { t.src = p.in[ib + 11]; t.K = 1024; t.N = 1024; t.dst = wout; t.ldd = 1024; }
  } else if (j == 26) { t.src = p.in[19]; t.K = 1024; t.N = 2816; t.dst = (bf16_t*)(p.ws + OFF_W1IN); t.ldd = 1024; }
  else if (j == 27) { t.src = p.in[25]; t.K = 1408; t.N = 1024; t.dst = (bf16_t*)(p.ws + OFF_W1OUT); t.ldd = 1408; }
  else if (j == 28) { t.src = p.in[29]; t.K = 1024; t.N = 4096; t.dst = (bf16_t*)(p.ws + OFF_W2IN); t.ldd = 1024; }
  else { t.src = p.in[32]; t.K = 1024; t.N = 1024; t.dst = (bf16_t*)(p.ws + OFF_W2OUT); t.ldd = 1024; }
  return t;
}

__device__ __forceinline__ void phase0(const Params& p, char* lds) {
  const int tid = opaque_tid();
  {
    bf16_t* wg = (bf16_t*)(p.ws + OFF_W1G);
    const float* gw = p.in[22];
    const int total = 16 * 4 * 96 * 96;
    for (int e = blockIdx.x * NTHR + tid; e < total; e += gridDim.x * NTHR) {
      const int k = e % 96, n = (e / 96) % 96, dg = (e / 9216) & 3, blk = e / 36864;
      float v = 0.f;
      if (k < 88 && n < 88) v = gw[((size_t)(dg * 16 + blk) * 88 + k) * 88 + n];
      wg[e] = f2bf(v);
    }
  }
  constexpr int N_MOD_ITEMS = 96;
  constexpr int N_TILES = 5152;
  float* act = (float*)lds;
  float* red = (float*)(lds + 36864);
  float* tl = (float*)lds;
  for (int item = blockIdx.x; item < N_MOD_ITEMS; item += gridDim.x) {
    __syncthreads();
    {
      const int L = item / 24, nc = item % 24;
      const int ib = (L == 0) ? 4 : (L == 1) ? 16 : (L == 2) ? 26 : 33;
      const float* ada_w = p.in[ib + 1];
      const float* ada_b = p.in[ib + 2];
      for (int e = tid; e < 9 * 1024; e += NTHR) {
        const int i = e >> 10, k = e & 1023;
        const float c = (i < 8) ? p.in[1][i * 1024 + k] : p.in[3][k];
        act[e] = siluf_(c);
      }
      __syncthreads();
      const int kq = tid >> 7, nl = tid & 127, n = nc * 128 + nl;
      float acc[9];
#pragma unroll
      for (int i = 0; i < 9; ++i) acc[i] = 0.f;
      for (int k0 = kq * 256; k0 < kq * 256 + 256; k0 += 16) {
        float w[16];
#pragma unroll
        for (int u = 0; u < 16; ++u) w[u] = ada_w[(size_t)(k0 + u) * 3072 + n];
#pragma unroll
        for (int u = 0; u < 16; ++u)
#pragma unroll
          for (int i = 0; i < 9; ++i) acc[i] += act[i * 1024 + k0 + u] * w[u];
      }
#pragma unroll
      for (int i = 0; i < 9; ++i) red[(kq * 9 + i) * 128 + nl] = acc[i];
      __syncthreads();
      float* mod = (float*)(p.ws + OFF_MOD) + (size_t)L * 9 * 3072;
      for (int e = tid; e < 9 * 128; e += NTHR) {
        const int i = e >> 7, c = e & 127;
        const float s = red[(0 * 9 + i) * 128 + c] + red[(1 * 9 + i) * 128 + c] + red[(2 * 9 + i) * 128 + c] + red[(3 * 9 + i) * 128 + c];
        mod[i * 3072 + nc * 128 + c] = s + ada_b[nc * 128 + c];
      }
    }
  }
  {
    struct TileRef { const float* src; bf16_t* dst; int N, ldd, k0, n0; };
    auto decode = [&](int t, TileRef& r) {
      int j = 0;
      TJob job = get_tjob(p, 0);
      for (;;) {
        const int nt = (job.K >> 6) * (job.N >> 6);
        if (t < nt) break;
        t -= nt; ++j; job = get_tjob(p, j);
      }
      const int ntn = job.N >> 6;
      r.src = job.src; r.dst = job.dst; r.N = job.N; r.ldd = job.ldd; r.k0 = (t / ntn) * 64; r.n0 = (t % ntn) * 64;
    };
    const int kk = tid >> 4, n4 = (tid & 15) * 4;
    int t = (int)(gridDim.x - 1 - blockIdx.x);
    TileRef cur, nxt;
    float4 v0 = make_float4(0.f, 0.f, 0.f, 0.f), v1 = v0;
    if (t < N_TILES) {
      decode(t, cur);
      v0 = *(const float4*)(cur.src + (size_t)(cur.k0 + kk) * cur.N + cur.n0 + n4);
      v1 = *(const float4*)(cur.src + (size_t)(cur.k0 + kk + 32) * cur.N + cur.n0 + n4);
    }
    while (t < N_TILES) {
      const int tn = t + (int)gridDim.x;
      float4 w0 = v0, w1 = v1;
      if (tn < N_TILES) {
        decode(tn, nxt);
        w0 = *(const float4*)(nxt.src + (size_t)(nxt.k0 + kk) * nxt.N + nxt.n0 + n4);
        w1 = *(const float4*)(nxt.src + (size_t)(nxt.k0 + kk + 32) * nxt.N + nxt.n0 + n4);
      }
      __builtin_amdgcn_sched_barrier(0);
      __syncthreads();
      tl[kk * 65 + n4 + 0] = v0.x; tl[kk * 65 + n4 + 1] = v0.y; tl[kk * 65 + n4 + 2] = v0.z; tl[kk * 65 + n4 + 3] = v0.w;
      tl[(kk + 32) * 65 + n4 + 0] = v1.x; tl[(kk + 32) * 65 + n4 + 1] = v1.y; tl[(kk + 32) * 65 + n4 + 2] = v1.z; tl[(kk + 32) * 65 + n4 + 3] = v1.w;
      __syncthreads();
      const int n = tid >> 3, k8 = (tid & 7) * 8;
      u32x4 o;
      o.x = pk_bf16(tl[(k8 + 0) * 65 + n], tl[(k8 + 1) * 65 + n]);
      o.y = pk_bf16(tl[(k8 + 2) * 65 + n], tl[(k8 + 3) * 65 + n]);
      o.z = pk_bf16(tl[(k8 + 4) * 65 + n], tl[(k8 + 5) * 65 + n]);
      o.w = pk_bf16(tl[(k8 + 6) * 65 + n], tl[(k8 + 7) * 65 + n]);
      *(u32x4*)(cur.dst + (size_t)(cur.n0 + n) * cur.ldd + cur.k0 + k8) = o;
      v0 = w0; v1 = w1; cur = nxt; t = tn;
    }
  }
}

DEVI void norm_row(const float* __restrict__ xr, const float* __restrict__ g, const float* __restrict__ mod, int lane, float (&h)[16]) {
  float4 x[4];
  float ss = 0.f;
#pragma unroll
  for (int i = 0; i < 4; ++i) {
    x[i] = *(const float4*)(xr + lane * 4 + 256 * i);
    ss += x[i].x * x[i].x + x[i].y * x[i].y + x[i].z * x[i].z + x[i].w * x[i].w;
  }
  ss = wave_sum(ss);
  const float rstd = rsqrtf(ss * (1.f / 1024.f) + 1e-6f);
#pragma unroll
  for (int i = 0; i < 4; ++i) {
    const int c = lane * 4 + 256 * i;
    const float4 gg = *(const float4*)(g + c);
    const float4 sh = *(const float4*)(mod + c);
    const float4 sc = *(const float4*)(mod + 1024 + c);
    h[i * 4 + 0] = x[i].x * rstd * gg.x * (1.f + sc.x) + sh.x;
    h[i * 4 + 1] = x[i].y * rstd * gg.y * (1.f + sc.y) + sh.y;
    h[i * 4 + 2] = x[i].z * rstd * gg.z * (1.f + sc.z) + sh.z;
    h[i * 4 + 3] = x[i].w * rstd * gg.w * (1.f + sc.w) + sh.w;
  }
}

template <bool WITH_HS>
__device__ __forceinline__ void norm_phase(const float* __restrict__ xl, const float* __restrict__ xc, const float* __restrict__ g,
                           const float* __restrict__ modL, bf16_t* __restrict__ H, bf16_t* __restrict__ HS) {
  const int tidx = opaque_tid();
  const int lane = tidx & 63;
  const int gw = blockIdx.x * (NTHR / 64) + (tidx >> 6), nw = gridDim.x * (NTHR / 64);
  for (int row = gw; row < MT; row += nw) {
    const bool lat = row < ML;
    const float* xbase = lat ? xl + (size_t)row * 1024 : xc + (size_t)(row - ML) * 1024;
    const float* mod = modL + (lat ? (row >> 12) : 8) * 3072;
    float h[16];
    norm_row(xbase, g, mod, lane, h);
#pragma unroll
    for (int i = 0; i < 4; ++i) {
      u32x2 o; o.x = pk_bf16(h[i * 4], h[i * 4 + 1]); o.y = pk_bf16(h[i * 4 + 2], h[i * 4 + 3]);
      *(u32x2*)(H + (size_t)row * 1024 + lane * 4 + 256 * i) = o;
    }
    if (WITH_HS) {
      const int t = lat ? (row & 4095) : ((row - ML) & 255);
      const int T = lat ? 4096 : 256;
      float s[16];
#pragma unroll
      for (int i = 0; i < 16; ++i) s[i] = 0.f;
      if (t > 0) { float hp[16]; norm_row(xbase - 1024, g, mod, lane, hp);
#pragma unroll
        for (int i = 0; i < 16; ++i) s[i] += hp[i]; }
      if (t < T - 1) { float hn[16]; norm_row(xbase + 1024, g, mod, lane, hn);
#pragma unroll
        for (int i = 0; i < 16; ++i) s[i] += hn[i]; }
#pragma unroll
      for (int i = 0; i < 4; ++i) {
        u32x2 o; o.x = pk_bf16(0.5f * s[i * 4], 0.5f * s[i * 4 + 1]); o.y = pk_bf16(0.5f * s[i * 4 + 2], 0.5f * s[i * 4 + 3]);
        *(u32x2*)(HS + (size_t)row * 1024 + lane * 4 + 256 * i) = o;
      }
    }
  }
}

struct ALPlain {
  const bf16_t* A; int lda;
  typedef u32x4 Regs;
  DEVI void stage(float*, int) const {}
  DEVI void issue(Regs& r, int row, int k) const { r = *(const u32x4*)(A + (size_t)row * lda + k); }
  DEVI u32x4 finish(const Regs& r, const float*, int) const { return r; }
};
struct ALMix {
  const bf16_t* H; const bf16_t* HS; const float* mu;
  struct Regs { u32x4 h, s; };
  DEVI void stage(float* sMu, int n0) const {
    const int grp = n0 >> 10;
    const int j = grp == 0 ? 0 : grp == 1 ? 2 : grp == 2 ? 3 : grp == 3 ? 5 : (n0 - 4096) < 128 ? 1 : 4;
    for (int e = threadIdx.x; e < 1024; e += NTHR) sMu[e] = mu[j * 1024 + e];
  }
  DEVI void issue(Regs& r, int row, int k) const {
    r.h = *(const u32x4*)(H + (size_t)row * 1024 + k);
    r.s = *(const u32x4*)(HS + (size_t)row * 1024 + k);
  }
  DEVI unsigned mix2(unsigned h, unsigned s, float m0, float m1) const {
    const float h0 = bf_lo(h), h1 = bf_hi(h), s0 = bf_lo(s), s1 = bf_hi(s);
    return pk_bf16(h0 + (s0 - h0) * m0, h1 + (s1 - h1) * m1);
  }
  DEVI u32x4 finish(const Regs& r, const float* sMu, int k) const {
    const float4 ma = *(const float4*)(sMu + k), mb = *(const float4*)(sMu + k + 4);
    u32x4 o;
    o.x = mix2(r.h.x, r.s.x, ma.x, ma.y); o.y = mix2(r.h.y, r.s.y, ma.z, ma.w);
    o.z = mix2(r.h.z, r.s.z, mb.x, mb.y); o.w = mix2(r.h.w, r.s.w, mb.z, mb.w);
    return o;
  }
};

template <class AL, class EP>
__device__ __forceinline__ void gemm_phase(char* lds, const bf16_t* __restrict__ Bt, int K, int mtiles, int ntiles, const AL al, const EP ep, int n_base = 0, bool reverse = false, int mt_base = 0) {
  bf16_t* sA = (bf16_t*)lds;
  bf16_t* sB = (bf16_t*)(lds + 73728);
  float* sMu = (float*)(lds + 110592);
  const int tid = opaque_tid(), lane = tid & 63, wv = tid >> 6, wm = wv >> 1, wn = wv & 1;
  const int l31 = lane & 31, lh = lane >> 5;
  const int nk = K >> 6;
  const int ldrow = tid >> 3, ldk = (tid & 7) * 8;
  const int total = mtiles * ntiles;
  const int bid = reverse ? (int)(gridDim.x - 1 - blockIdx.x) : (int)blockIdx.x;
  const int nslots = gridDim.x >> 3, xcd = bid & 7, slot = bid >> 3;
  const int gm = 4 * ntiles;
  for (int chunk = xcd; chunk * nslots < total; chunk += 8) {
    const int tile = chunk * nslots + slot;
    if (tile >= total) break;
    const int grp = tile / gm, rem = tile - grp * gm;
    const int mt = grp * 4 + (rem & 3), nt = rem >> 2;
    const int m0 = (mt_base + mt) * 256, n0 = n_base + nt * 128;
    __syncthreads();
    al.stage(sMu, n0);
    f32x16 acc[2][2];
#pragma unroll
    for (int a = 0; a < 2; ++a)
#pragma unroll
      for (int b = 0; b < 2; ++b)
#pragma unroll
        for (int r = 0; r < 16; ++r) acc[a][b][r] = 0.f;
    typename AL::Regs ar[4];
    u32x4 br[2];
#pragma unroll
    for (int i = 0; i < 4; ++i) al.issue(ar[i], m0 + ldrow + 64 * i, ldk);
#pragma unroll
    for (int i = 0; i < 2; ++i) br[i] = *(const u32x4*)(Bt + (size_t)(n0 + ldrow + 64 * i) * K + ldk);
    __syncthreads();
#pragma unroll
    for (int i = 0; i < 4; ++i) *(u32x4*)(sA + (ldrow + 64 * i) * 72 + ldk) = al.finish(ar[i], sMu, ldk);
#pragma unroll
    for (int i = 0; i < 2; ++i) *(u32x4*)(sB + (ldrow + 64 * i) * 72 + ldk) = br[i];
    __syncthreads();
    for (int kt = 0; kt < nk; ++kt) {
      const int cur = kt & 1;
      const bool more = (kt + 1) < nk;
      const int k0n = (kt + 1) * 64 + ldk;
      if (more) {
#pragma unroll
        for (int i = 0; i < 4; ++i) al.issue(ar[i], m0 + ldrow + 64 * i, k0n);
#pragma unroll
        for (int i = 0; i < 2; ++i) br[i] = *(const u32x4*)(Bt + (size_t)(n0 + ldrow + 64 * i) * K + k0n);
      }
      __builtin_amdgcn_sched_barrier(0);
      const bf16_t* a_ = sA + cur * (256 * 72);
      const bf16_t* b_ = sB + cur * (128 * 72);
#pragma unroll
      for (int kk = 0; kk < 4; ++kk) {
        u32x4 af[2], bfr[2];
#pragma unroll
        for (int mi = 0; mi < 2; ++mi) af[mi] = *(const u32x4*)(a_ + (wm * 64 + mi * 32 + l31) * 72 + kk * 16 + lh * 8);
#pragma unroll
        for (int ni = 0; ni < 2; ++ni) bfr[ni] = *(const u32x4*)(b_ + (wn * 64 + ni * 32 + l31) * 72 + kk * 16 + lh * 8);
#pragma unroll
        for (int mi = 0; mi < 2; ++mi)
#pragma unroll
          for (int ni = 0; ni < 2; ++ni) acc[mi][ni] = mfma32(bfr[ni], af[mi], acc[mi][ni]);
      }
      __builtin_amdgcn_sched_barrier(0);
      if (more) {
        bf16_t* an = sA + (cur ^ 1) * (256 * 72);
        bf16_t* bn = sB + (cur ^ 1) * (128 * 72);
#pragma unroll
        for (int i = 0; i < 4; ++i) *(u32x4*)(an + (ldrow + 64 * i) * 72 + ldk) = al.finish(ar[i], sMu, k0n);
#pragma unroll
        for (int i = 0; i < 2; ++i) *(u32x4*)(bn + (ldrow + 64 * i) * 72 + ldk) = br[i];
      }
      __syncthreads();
    }
#pragma unroll
    for (int mi = 0; mi < 2; ++mi)
#pragma unroll
      for (int ni = 0; ni < 2; ++ni)
#pragma unroll
        for (int q = 0; q < 4; ++q) {
          const int row = m0 + wm * 64 + mi * 32 + l31;
          const int col = n0 + wn * 64 + ni * 32 + 8 * q + 4 * lh;
          f32x4 v = {acc[mi][ni][4 * q], acc[mi][ni][4 * q + 1], acc[mi][ni][4 * q + 2], acc[mi][ni][4 * q + 3]};
          ep(row, col, v);
        }
  }
}


template <class AL, class EP>
__device__ __forceinline__ void gemm256_phase(char* lds, const bf16_t* __restrict__ Bt, int K, int mtiles, int ntiles, const AL al, const EP ep) {
  bf16_t* sA = (bf16_t*)lds;
  bf16_t* sB = (bf16_t*)(lds + 73728);
  float* sMu = (float*)(lds + 147456);
  const int tid = opaque_tid(), lane = tid & 63, wv = tid >> 6, wm = wv >> 1, wn = wv & 1;
  const int l31 = lane & 31, lh = lane >> 5;
  const int nk = K >> 6;
  const int ldrow = tid >> 3, ldk = (tid & 7) * 8;
  const int total = mtiles * ntiles;
  const int nslots = gridDim.x >> 3, xcd = blockIdx.x & 7, slot = blockIdx.x >> 3;
  const int gm = 4 * ntiles;
  for (int chunk = xcd; chunk * nslots < total; chunk += 8) {
    const int tile = chunk * nslots + slot;
    if (tile >= total) break;
    const int grp = tile / gm, rem = tile - grp * gm;
    const int mt = grp * 4 + (rem & 3), nt = rem >> 2;
    const int m0 = mt * 256, n0 = nt * 256;
    __syncthreads();
    al.stage(sMu, n0);
    f32x16 acc[2][4];
#pragma unroll
    for (int a = 0; a < 2; ++a)
#pragma unroll
      for (int b = 0; b < 4; ++b)
#pragma unroll
        for (int r = 0; r < 16; ++r) acc[a][b][r] = 0.f;
    typename AL::Regs ar[4];
    u32x4 br[4];
#pragma unroll
    for (int i = 0; i < 4; ++i) al.issue(ar[i], m0 + ldrow + 64 * i, ldk);
#pragma unroll
    for (int i = 0; i < 4; ++i) br[i] = *(const u32x4*)(Bt + (size_t)(n0 + ldrow + 64 * i) * K + ldk);
    __syncthreads();
#pragma unroll
    for (int i = 0; i < 4; ++i) *(u32x4*)(sA + (ldrow + 64 * i) * 72 + ldk) = al.finish(ar[i], sMu, ldk);
#pragma unroll
    for (int i = 0; i < 4; ++i) *(u32x4*)(sB + (ldrow + 64 * i) * 72 + ldk) = br[i];
    __syncthreads();
    const int half = __builtin_amdgcn_readfirstlane(wv >> 2);
    if (half == 1 && nk > 1) {
#pragma unroll
      for (int i = 0; i < 4; ++i) al.issue(ar[i], m0 + ldrow + 64 * i, 64 + ldk);
#pragma unroll
      for (int i = 0; i < 4; ++i) br[i] = *(const u32x4*)(Bt + (size_t)(n0 + ldrow + 64 * i) * K + 64 + ldk);
    }
    for (int step = 0; step < 2 * nk; ++step) {
      const int kc = step >> 1;
      if ((step & 1) == half) {
        const int kl = kc + 1 + half;
        if (kl < nk) {
          const int k0n = kl * 64 + ldk;
#pragma unroll
          for (int i = 0; i < 4; ++i) al.issue(ar[i], m0 + ldrow + 64 * i, k0n);
#pragma unroll
          for (int i = 0; i < 4; ++i) br[i] = *(const u32x4*)(Bt + (size_t)(n0 + ldrow + 64 * i) * K + k0n);
        }
        __builtin_amdgcn_sched_barrier(0);
        const bf16_t* a_ = sA + (kc & 1) * (256 * 72);
        const bf16_t* b_ = sB + (kc & 1) * (256 * 72);
#pragma unroll
        for (int kk = 0; kk < 4; ++kk) {
          u32x4 af[2];
#pragma unroll
          for (int mi = 0; mi < 2; ++mi) af[mi] = *(const u32x4*)(a_ + (wm * 64 + mi * 32 + l31) * 72 + kk * 16 + lh * 8);
#pragma unroll
          for (int ni = 0; ni < 4; ++ni) {
            const u32x4 bfr = *(const u32x4*)(b_ + (wn * 128 + ni * 32 + l31) * 72 + kk * 16 + lh * 8);
#pragma unroll
            for (int mi = 0; mi < 2; ++mi) acc[mi][ni] = mfma32(bfr, af[mi], acc[mi][ni]);
          }
        }
        __builtin_amdgcn_sched_barrier(0);
      } else {
        const int kf = kc + 1;
        if (kf < nk) {
          bf16_t* an = sA + (kf & 1) * (256 * 72);
          bf16_t* bn = sB + (kf & 1) * (256 * 72);
          const int k0n = kf * 64 + ldk;
#pragma unroll
          for (int i = 0; i < 4; ++i) *(u32x4*)(an + (ldrow + 64 * i) * 72 + ldk) = al.finish(ar[i], sMu, k0n);
#pragma unroll
          for (int i = 0; i < 4; ++i) *(u32x4*)(bn + (ldrow + 64 * i) * 72 + ldk) = br[i];
        }
      }
      __syncthreads();
    }
    if constexpr (EP::VIA_LDS) {
      float* reg = (float*)(lds + wv * 16896);
#pragma unroll
      for (int mi = 0; mi < 2; ++mi) {
#pragma unroll
        for (int ni = 0; ni < 4; ++ni)
#pragma unroll
          for (int q = 0; q < 4; ++q) {
            f32x4 v = {acc[mi][ni][4 * q], acc[mi][ni][4 * q + 1], acc[mi][ni][4 * q + 2], acc[mi][ni][4 * q + 3]};
            *(f32x4*)(reg + l31 * 132 + ni * 32 + 8 * q + 4 * lh) = v;
          }
#pragma unroll 4
        for (int it = 0; it < 16; ++it) {
          const int rl = it * 2 + lh;
          const f32x4 v = *(const f32x4*)(reg + rl * 132 + l31 * 4);
          ep(m0 + wm * 64 + mi * 32 + rl, n0 + wn * 128 + l31 * 4, v);
        }
      }
    } else
#pragma unroll
    for (int mi = 0; mi < 2; ++mi)
#pragma unroll
      for (int ni = 0; ni < 4; ++ni) {
#pragma unroll
        for (int q = 0; q < 4; ++q) {
          const int row = m0 + wm * 64 + mi * 32 + l31;
          const int col = n0 + wn * 128 + ni * 32 + 8 * q + 4 * lh;
          f32x4 v = {acc[mi][ni][4 * q], acc[mi][ni][4 * q + 1], acc[mi][ni][4 * q + 2], acc[mi][ni][4 * q + 3]};
          ep(row, col, v);
        }
        __builtin_amdgcn_sched_barrier(0);
      }
  }
}

DEVI void st_bf16x4(bf16_t* p, f32x4 v) { u32x2 o; o.x = pk_bf16(v[0], v[1]); o.y = pk_bf16(v[2], v[3]); *(u32x2*)p = o; }

struct EpRwkvIn {
  static constexpr bool VIA_LDS = false;
  bf16_t *R, *K, *V, *G, *WD, *AD;
  DEVI void operator()(int row, int col, f32x4 v) const {
    const int grp = col >> 10;
    if (grp < 4) {
      const int c = col & 1023;
      bf16_t* dst = grp == 0 ? R : grp == 1 ? K : grp == 2 ? V : G;
      if (grp == 3) { v[0] = siluf_(v[0]); v[1] = siluf_(v[1]); v[2] = siluf_(v[2]); v[3] = siluf_(v[3]); }
      st_bf16x4(dst + (size_t)row * 1024 + c, v);
    } else {
      const int c = col - 4096;
      if (c < 128) {
#pragma unroll
        for (int i = 0; i < 4; ++i) { const float t = __expf(2.f * v[i]); v[i] = 1.f - 2.f / (t + 1.f); }
        st_bf16x4(WD + (size_t)row * 128 + c, v);
      } else st_bf16x4(AD + (size_t)row * 128 + (c - 128), v);
    }
  }
};
struct EpRes {
  static constexpr bool VIA_LDS = false;
  const float* xl_src; const float* xc_src; float* xl_dst; float* xc_dst; const float* modL;
  DEVI void operator()(int row, int col, f32x4 v) const {
    const bool lat = row < ML;
    const size_t off = lat ? (size_t)row * 1024 + col : (size_t)(row - ML) * 1024 + col;
    const float* src = (lat ? xl_src : xc_src) + off;
    float* dst = (lat ? xl_dst : xc_dst) + off;
    const f32x4 g = *(const f32x4*)(modL + (lat ? (row >> 12) : 8) * 3072 + 2048 + col);
    f32x4 x = *(const f32x4*)src;
    x += g * v;
    *(f32x4*)dst = x;
  }
};
struct EpLruIn {
  static constexpr bool VIA_LDS = false;
  bf16_t *XR, *GG;
  DEVI void operator()(int row, int col, f32x4 v) const {
    if (col < LW) st_bf16x4(XR + (size_t)row * LW + col, v);
    else { v[0] = siluf_(v[0]); v[1] = siluf_(v[1]); v[2] = siluf_(v[2]); v[3] = siluf_(v[3]); st_bf16x4(GG + (size_t)row * LW + (col - LW), v); }
  }
};
struct EpNatIn {
  static constexpr bool VIA_LDS = false;
  bf16_t *Q, *K, *VT, *G;
  DEVI void operator()(int row, int col, f32x4 v) const {
    const int grp = col >> 10, c = col & 1023;
    if (grp == 0) st_bf16x4(Q + (size_t)row * 1024 + c, v);
    else if (grp == 1) st_bf16x4(K + (size_t)row * 1024 + c, v);
    else if (grp == 3) { v[0] = siluf_(v[0]); v[1] = siluf_(v[1]); v[2] = siluf_(v[2]); v[3] = siluf_(v[3]); st_bf16x4(G + (size_t)row * 1024 + c, v); }
    else {
      unsigned idx, T;
      if (row < ML) { const unsigned b = row >> 12, t = row & 4095; T = 4096u; idx = ((b * 1024u + (unsigned)c) << 12) + t; }
      else { const unsigned r2 = row - ML; const unsigned b = r2 >> 8, t = r2 & 255; T = 256u; idx = (unsigned)ML * 1024u + ((b * 1024u + (unsigned)c) << 8) + t; }
#pragma unroll
      for (int i = 0; i < 4; ++i) VT[idx + (unsigned)i * T] = f2bf(v[i]);
    }
  }
};

DEVI int rwkv_row(int b, int d, int s) {
  if (s < 256) return ML + b * 256 + (d ? 255 - s : s);
  const int t = s - 256;
  return b * 4096 + (d ? 4095 - t : t);
}

constexpr int PSTR = 456, PREC_Y = 64, PREC_V0 = 192, PREC_V1 = 256, PREC_SC = 320, PREC_BF = 328;
constexpr int TSTR = 388;
struct ScanRec { u32x4 a1, a2; float v0, v1; f32x4 s0, s1; f32x4 ww[4]; u32x2 y[4]; };
DEVI void scan_load(ScanRec& R, const float* rec, int g, int c16, int role_off, int srow) {
  const char* ab = (const char*)(rec + PREC_BF) + role_off + g * 16;
  R.a1 = *(const u32x4*)ab; R.a2 = *(const u32x4*)(ab + 64);
  R.v0 = rec[PREC_V0 + srow]; R.v1 = rec[PREC_V1 + srow];
  R.s0 = *(const f32x4*)(rec + PREC_SC); R.s1 = *(const f32x4*)(rec + PREC_SC + 4);
#pragma unroll
  for (int nt = 0; nt < 4; ++nt) {
    R.ww[nt] = *(const f32x4*)(rec + 16 * nt + 4 * g);
    R.y[nt] = *(const u32x2*)((const char*)(rec + PREC_Y) + (16 * nt + c16) * 8);
  }
}
DEVI void scan_step2(f32x4 (&S)[4], const ScanRec& R, bool g0, float* yout) {
  const u32x4 b1 = mk4(pk_bf16(S[0][0], S[0][1]), pk_bf16(S[0][2], S[0][3]), pk_bf16(S[1][0], S[1][1]), pk_bf16(S[1][2], S[1][3]));
  const u32x4 b2 = mk4(pk_bf16(S[2][0], S[2][1]), pk_bf16(S[2][2], S[2][3]), pk_bf16(S[3][0], S[3][1]), pk_bf16(S[3][2], S[3][3]));
  f32x4 D = {0.f, 0.f, 0.f, 0.f};
  D = mfma16(R.a1, b1, D);
  D = mfma16(R.a2, b2, D);
  const float v0 = R.v0, v1 = R.v1;
  const float sa0 = D[0];
  const float sa1 = D[2] + sa0 * R.s0[2] + v0 * R.s0[3];
  const unsigned x0 = pk_bf16(sa0, v0), x1 = pk_bf16(sa1, v1);
  const u32x4 xb = mk4(g0 ? x0 : 0u, g0 ? x1 : 0u, 0u, 0u);
#pragma unroll
  for (int nt = 0; nt < 4; ++nt) S[nt] = mfma16(mk4(R.y[nt].x, R.y[nt].y, 0u, 0u), xb, S[nt] * R.ww[nt]);
  yout[0] = D[1] + sa0 * R.s0[0] + v0 * R.s0[1];
  yout[256] = D[3] + sa0 * R.s1[0] + v0 * R.s1[1] + sa1 * R.s1[2] + v1 * R.s1[3];
}
DEVI float sum16(float v) { v = sum8(v); v += dpp_f<0x140>(v); return v; }

__device__ __forceinline__ void rwkv_scan_phase(char* lds, const bf16_t* __restrict__ R, const bf16_t* __restrict__ Kb, const bf16_t* __restrict__ V,
                                const bf16_t* __restrict__ WD, const bf16_t* __restrict__ AD, const bf16_t* __restrict__ Wup,
                                const float* __restrict__ b0, const float* __restrict__ k_ka, const float* __restrict__ r_k,
                                bf16_t* __restrict__ Y0, bf16_t* __restrict__ Y1, float* __restrict__ BON) {
  float* stepbuf = (float*)lds;
  float* tokbuf = stepbuf + 2 * 8 * PSTR;
  float* wabuf = tokbuf + 2 * 16 * TSTR;
  float* ybuf = wabuf + 4096;
  const int tid = opaque_tid(), lane = tid & 63, wv = tid >> 6;
  constexpr int NCH = (256 + 4096) / 16;
  for (int chain = blockIdx.x; chain < 256; chain += gridDim.x) {
    const int d = chain & 1, h = (chain >> 1) & 15, b = chain >> 5;
    __syncthreads();
    if (wv < 4) {
      const int kq = lane >> 4, c16 = lane & 15, srow = wv * 16 + c16;
      const int role_off = (lane & 3) * 128;
      const bool g0 = kq == 0;
      f32x4 S[4];
#pragma unroll
      for (int j = 0; j < 4; ++j) S[j] = (f32x4){0.f, 0.f, 0.f, 0.f};
      __syncthreads();
      __syncthreads();
      __syncthreads();
      for (int c = 0; c < NCH; ++c) {
        const float* sb = stepbuf + (c & 1) * 8 * PSTR;
        float* yb = ybuf + (c & 1) * 4096 + kq * 64 + srow;
        ScanRec ra, rb;
        scan_load(ra, sb, kq, c16, role_off, srow);
#pragma unroll
        for (int i = 0; i < 4; i += 2) {
          scan_load(rb, sb + (i + 1) * PSTR, kq, c16, role_off, srow);
          scan_step2(S, ra, g0, yb + i * 512);
          scan_load(ra, sb + (i + 2) * PSTR, kq, c16, role_off, srow);
          scan_step2(S, rb, g0, yb + (i + 1) * 512);
        }
#pragma unroll
        for (int i = 4; i < 8; i += 2) {
          scan_load(rb, sb + (i + 1) * PSTR, kq, c16, role_off, srow);
          scan_step2(S, ra, g0, yb + i * 512);
          if (i + 2 < 8) scan_load(ra, sb + (i + 2) * PSTR, kq, c16, role_off, srow);
          scan_step2(S, rb, g0, yb + (i + 1) * 512);
        }
        __syncthreads();
      }
    } else {
      const int ptid = tid - 256, pw = wv - 4;
      bf16_t* Y = d ? Y1 : Y0;
      const int ncol = h * 64 + pw * 16 + (lane & 15);
      u32x4 bu[2][2];
      float bias_u[2];
#pragma unroll
      for (int kind = 0; kind < 2; ++kind) {
        const bf16_t* wu = Wup + ((size_t)(d * 2 + kind) * 1024 + ncol) * 64 + 8 * (lane >> 4);
        bu[kind][0] = *(const u32x4*)wu; bu[kind][1] = *(const u32x4*)(wu + 32);
        bias_u[kind] = b0[(d * 2 + kind) * 1024 + ncol];
      }
      const int ti = ptid >> 4, dq = ptid & 15;
      const int hc = h * 64 + 4 * dq;
      const f32x4 kkv = *(const f32x4*)(k_ka + hc), kav = *(const f32x4*)(k_ka + 1024 + hc), rkv = *(const f32x4*)(r_k + hc);
      u32x4 xw0, xw1, xa0, xa1; u32x2 rr, kr, vr;
      auto issueL = [&](int c) {
        const int rowA = rwkv_row(b, d, c * 16 + (lane & 15));
        const bf16_t* xp = WD + (size_t)rowA * 128 + d * 64 + 8 * (lane >> 4);
        const bf16_t* xq = AD + (size_t)rowA * 128 + d * 64 + 8 * (lane >> 4);
        xw0 = *(const u32x4*)xp; xw1 = *(const u32x4*)(xp + 32);
        xa0 = *(const u32x4*)xq; xa1 = *(const u32x4*)(xq + 32);
      };
      auto issueT = [&](int c) {
        const int rowB = rwkv_row(b, d, c * 16 + ti);
        rr = *(const u32x2*)(R + (size_t)rowB * 1024 + hc);
        kr = *(const u32x2*)(Kb + (size_t)rowB * 1024 + hc);
        vr = *(const u32x2*)(V + (size_t)rowB * 1024 + hc);
      };
      auto stepA = [&](int c) {
        float* wbuf = wabuf + (c & 1) * 2048; float* abuf = wbuf + 1024;
        f32x4 accw = {0.f, 0.f, 0.f, 0.f}, acca = {0.f, 0.f, 0.f, 0.f};
        accw = mfma16(xw0, bu[0][0], accw); accw = mfma16(xw1, bu[0][1], accw);
        acca = mfma16(xa0, bu[1][0], acca); acca = mfma16(xa1, bu[1][1], acca);
#pragma unroll
        for (int r = 0; r < 4; ++r) {
          const int o = ((lane >> 4) * 4 + r) * 64 + pw * 16 + (lane & 15);
          const float x = -(accw[r] + bias_u[0]);
          const float sp = fmaxf(x, 0.f) + 0.6931471805599453f * __builtin_amdgcn_logf(1.f + __builtin_amdgcn_exp2f(-1.4426950408889634f * fabsf(x)));
          const float ew = __builtin_amdgcn_exp2f(-1.4426950408889634f * (sp + 0.5f));
          wbuf[o] = __builtin_amdgcn_exp2f(-1.4426950408889634f * ew);
          abuf[o] = __builtin_amdgcn_rcpf(1.f + __builtin_amdgcn_exp2f(-1.4426950408889634f * (acca[r] + bias_u[1])));
        }
      };
      auto stepB1 = [&](int c) {
        const float rv[4] = {bf_lo(rr.x), bf_hi(rr.x), bf_lo(rr.y), bf_hi(rr.y)};
        const float kv[4] = {bf_lo(kr.x), bf_hi(kr.x), bf_lo(kr.y), bf_hi(kr.y)};
        const float vv[4] = {bf_lo(vr.x), bf_hi(vr.x), bf_lo(vr.y), bf_hi(vr.y)};
        const float* wbuf = wabuf + (c & 1) * 2048; const float* abuf = wbuf + 1024;
        const f32x4 av = *(const f32x4*)(abuf + ti * 64 + 4 * dq), wv4 = *(const f32x4*)(wbuf + ti * 64 + 4 * dq);
        float q[4], ss = 0.f;
#pragma unroll
        for (int i = 0; i < 4; ++i) { q[i] = kv[i] * kkv[i]; ss += q[i] * q[i]; }
        ss = sum16(ss);
        const float inv = __builtin_amdgcn_rsqf(fmaxf(ss, 1e-24f));
        f32x4 nk, wrr, ka, kd, vo;
        float c1 = 0.f, c2 = 0.f, bn = 0.f;
#pragma unroll
        for (int i = 0; i < 4; ++i) {
          const float n = q[i] * inv;
          kd[i] = kv[i] * (1.f + (av[i] - 1.f) * kav[i]);
          ka[i] = n * av[i];
          nk[i] = -n; wrr[i] = wv4[i] * rv[i]; vo[i] = vv[i];
          c1 += ka[i] * rv[i]; c2 += kd[i] * rv[i]; bn += rv[i] * kd[i] * rkv[i];
        }
        c1 = sum16(c1); c2 = sum16(c2); bn = sum16(bn);
        float* rec = tokbuf + ((c & 1) * 16 + ti) * TSTR;
        *(f32x4*)(rec + 4 * dq) = nk;
        *(f32x4*)(rec + 64 + 4 * dq) = wrr;
        *(f32x4*)(rec + 128 + 4 * dq) = wv4;
        *(f32x4*)(rec + 192 + 4 * dq) = ka;
        *(f32x4*)(rec + 256 + 4 * dq) = kd;
        *(f32x4*)(rec + 320 + 4 * dq) = vo;
        if (dq == 0) {
          *(f32x2*)(rec + 384) = (f32x2){c1, c2};
          BON[((size_t)d * MT + rwkv_row(b, d, c * 16 + ti)) * 16 + h] = bn;
        }
      };
      auto stepB2 = [&](int c) {
        const int pp = ptid >> 5, dp = ptid & 31;
        const float* t0 = tokbuf + ((c & 1) * 16 + 2 * pp) * TSTR + 2 * dp;
        const float* t1 = t0 + TSTR;
        const f32x2 a0 = *(const f32x2*)(t0), wr0 = *(const f32x2*)(t0 + 64), w0 = *(const f32x2*)(t0 + 128);
        const f32x2 b0_ = *(const f32x2*)(t0 + 192), k0_ = *(const f32x2*)(t0 + 256), v0 = *(const f32x2*)(t0 + 320);
        const f32x2 a1 = *(const f32x2*)(t1), wr1 = *(const f32x2*)(t1 + 64), w1 = *(const f32x2*)(t1 + 128);
        const f32x2 b1_ = *(const f32x2*)(t1 + 192), k1_ = *(const f32x2*)(t1 + 256), v1 = *(const f32x2*)(t1 + 320);
        float c3 = b0_[0] * a1[0] + b0_[1] * a1[1], c4 = k0_[0] * a1[0] + k0_[1] * a1[1];
        float c5 = b0_[0] * wr1[0] + b0_[1] * wr1[1], c6 = k0_[0] * wr1[0] + k0_[1] * wr1[1];
        c3 = sum16(c3); c4 = sum16(c4); c5 = sum16(c5); c6 = sum16(c6);
        c3 += __shfl_xor(c3, 16); c4 += __shfl_xor(c4, 16); c5 += __shfl_xor(c5, 16); c6 += __shfl_xor(c6, 16);
        float* rec = stepbuf + ((c & 1) * 8 + pp) * PSTR;
        *(f32x2*)(rec + 2 * dp) = w0 * w1;
        {
          const f32x2 bw = b0_ * w1, kw = k0_ * w1;
          *(u32x4*)((char*)(rec + PREC_Y) + 16 * dp) = mk4(pk_bf16(bw[0], kw[0]), pk_bf16(b1_[0], k1_[0]), pk_bf16(bw[1], kw[1]), pk_bf16(b1_[1], k1_[1]));
        }
        *(f32x2*)(rec + PREC_V0 + 2 * dp) = v0;
        *(f32x2*)(rec + PREC_V1 + 2 * dp) = v1;
        unsigned* bb = (unsigned*)(rec + PREC_BF);
        const f32x2 wa = w0 * a1, wwr = w0 * wr1;
        const int kk = (2 * dp) & 31;
        const int pos = ((2 * dp) & 32) + (kk < 16 ? 8 * (kk >> 2) + (kk & 3) : 8 * ((kk - 16) >> 2) + 4 + (kk & 3));
        const int pu = pos >> 1;
        bb[pu] = pk_bf16(a0[0], a0[1]);
        bb[32 + pu] = pk_bf16(wr0[0], wr0[1]);
        bb[64 + pu] = pk_bf16(wa[0], wa[1]);
        bb[96 + pu] = pk_bf16(wwr[0], wwr[1]);
        if (dp == 0) {
          const f32x2 cc0 = *(const f32x2*)(t0 + 384), cc1 = *(const f32x2*)(t1 + 384);
          *(f32x4*)(rec + PREC_SC) = (f32x4){cc0[0], cc0[1], c3, c4};
          *(f32x4*)(rec + PREC_SC + 4) = (f32x4){c5, c6, cc1[0], cc1[1]};
        }
      };
      auto storeY = [&](int c) {
        const f32x4 yv = *(const f32x4*)(ybuf + (c & 1) * 4096 + ti * 256 + 4 * dq);
        u32x2 o; o.x = pk_bf16(yv[0], yv[1]); o.y = pk_bf16(yv[2], yv[3]);
        *(u32x2*)(Y + (size_t)rwkv_row(b, d, c * 16 + ti) * 1024 + hc) = o;
      };
      issueL(0); issueT(0);
      stepA(0);
      issueL(1);
      __syncthreads();
      stepB1(0); issueT(1);
      stepA(1); issueL(2);
      __syncthreads();
      stepB2(0);
      stepB1(1); issueT(2);
      stepA(2); issueL(3);
      __builtin_amdgcn_sched_barrier(0);
      __syncthreads();
      __builtin_amdgcn_sched_barrier(0);
      for (int c = 0; c < NCH; ++c) {
        if (c + 3 < NCH) stepA(c + 3);
        if (c + 4 < NCH) issueL(c + 4);
        if (c + 2 < NCH) stepB1(c + 2);
        if (c + 3 < NCH) issueT(c + 3);
        if (c + 1 < NCH) stepB2(c + 1);
        if (c >= 1) storeY(c - 1);
        __builtin_amdgcn_sched_barrier(0);
        __syncthreads();
        __builtin_amdgcn_sched_barrier(0);
      }
      storeY(NCH - 1);
    }
  }
}

__device__ __forceinline__ void rwkv_post_phase(const bf16_t* __restrict__ Y0, const bf16_t* __restrict__ Y1, const bf16_t* __restrict__ V,
                                bf16_t* __restrict__ G, const float* __restrict__ BON, const float* __restrict__ gn, int nrows) {
  const int tidx = opaque_tid();
  const int lane = tidx & 63;
  const int gw = blockIdx.x * (NTHR / 64) + (tidx >> 6), nw = gridDim.x * (NTHR / 64);
  const int head = lane >> 2, c0 = lane * 16;
  for (int row = gw; row < nrows; row += nw) {
    const size_t off = (size_t)row * 1024 + c0;
    float y[16], v[16], g[16];
#pragma unroll
    for (int i = 0; i < 2; ++i) {
      const u32x4 a0 = *(const u32x4*)(Y0 + off + 8 * i), a1 = *(const u32x4*)(Y1 + off + 8 * i);
      const u32x4 av = *(const u32x4*)(V + off + 8 * i), ag = *(const u32x4*)(G + off + 8 * i);
      y[8 * i + 0] = bf_lo(a0.x) + bf_lo(a1.x); y[8 * i + 1] = bf_hi(a0.x) + bf_hi(a1.x);
      y[8 * i + 2] = bf_lo(a0.y) + bf_lo(a1.y); y[8 * i + 3] = bf_hi(a0.y) + bf_hi(a1.y);
      y[8 * i + 4] = bf_lo(a0.z) + bf_lo(a1.z); y[8 * i + 5] = bf_hi(a0.z) + bf_hi(a1.z);
      y[8 * i + 6] = bf_lo(a0.w) + bf_lo(a1.w); y[8 * i + 7] = bf_hi(a0.w) + bf_hi(a1.w);
      v[8 * i + 0] = bf_lo(av.x); v[8 * i + 1] = bf_hi(av.x); v[8 * i + 2] = bf_lo(av.y); v[8 * i + 3] = bf_hi(av.y);
      v[8 * i + 4] = bf_lo(av.z); v[8 * i + 5] = bf_hi(av.z); v[8 * i + 6] = bf_lo(av.w); v[8 * i + 7] = bf_hi(av.w);
      g[8 * i + 0] = bf_lo(ag.x); g[8 * i + 1] = bf_hi(ag.x); g[8 * i + 2] = bf_lo(ag.y); g[8 * i + 3] = bf_hi(ag.y);
      g[8 * i + 4] = bf_lo(ag.z); g[8 * i + 5] = bf_hi(ag.z); g[8 * i + 6] = bf_lo(ag.w); g[8 * i + 7] = bf_hi(ag.w);
    }
    float s = 0.f;
#pragma unroll
    for (int i = 0; i < 16; ++i) s += y[i];
    s += __shfl_xor(s, 1); s += __shfl_xor(s, 2);
    const float mean = s * (1.f / 64.f);
    float q = 0.f;
#pragma unroll
    for (int i = 0; i < 16; ++i) { const float dlt = y[i] - mean; q += dlt * dlt; }
    q += __shfl_xor(q, 1); q += __shfl_xor(q, 2);
    const float rstd = rsqrtf(q * (1.f / 64.f) + 64e-5f);
    const float bonus = BON[(size_t)row * 16 + head] + BON[((size_t)MT + row) * 16 + head];
    unsigned o[8];
#pragma unroll
    for (int i = 0; i < 8; ++i) {
      const float z0 = ((y[2 * i] - mean) * rstd * gn[c0 + 2 * i] + gn[1024 + c0 + 2 * i] + bonus * v[2 * i]) * g[2 * i];
      const float z1 = ((y[2 * i + 1] - mean) * rstd * gn[c0 + 2 * i + 1] + gn[1024 + c0 + 2 * i + 1] + bonus * v[2 * i + 1]) * g[2 * i + 1];
      o[i] = pk_bf16(z0, z1);
    }
    *(u32x4*)(G + off) = mk4(o[0], o[1], o[2], o[3]);
    *(u32x4*)(G + off + 8) = mk4(o[4], o[5], o[6], o[7]);
  }
}

__device__ __forceinline__ void rglru_phase(char* lds, const bf16_t* __restrict__ XR, const bf16_t* __restrict__ Wg, const float* __restrict__ conv_w,
                            const float* __restrict__ conv_b, const float* __restrict__ gate_b, const float* __restrict__ lam,
                            bf16_t* __restrict__ HS0, bf16_t* __restrict__ HS1) {
  bf16_t* xcT = (bf16_t*)lds;
  f32x2* AB = (f32x2*)(lds + 26624);
  bf16_t* raw = (bf16_t*)(lds + 26624);
  float* segP = (float*)(lds + 116736);
  float* segH = segP + 352;
  float* segC = segH + 352;
  bf16_t* wgs = (bf16_t*)(lds + 120960);
  float* cws = (float*)(lds + 160896);
  const int tid = opaque_tid(), lane = tid & 63, wv = tid >> 6;
  for (int chain = blockIdx.x; chain < 256; chain += gridDim.x) {
    const int d = chain & 1, blk = (chain >> 1) & 15, b = chain >> 5;
    bf16_t* HS = d ? HS1 : HS0;
    float carry = 0.f;
    __syncthreads();
    for (int q = tid; q < 2 * 96 * 12; q += NTHR) {
      const int g = q / 1152, rem = q - g * 1152, n = rem / 12, k8 = rem - n * 12;
      *(u32x4*)(wgs + (g * 96 + n) * 104 + k8 * 8) = *(const u32x4*)(Wg + ((size_t)((blk * 4 + d * 2 + g) * 96 + n)) * 96 + k8 * 8);
    }
    for (int e = tid; e < 5 * 88; e += NTHR) {
      const int j = e / 88, c = e - j * 88;
      cws[e] = j < 4 ? conv_w[j * LW + blk * 88 + c] : conv_b[blk * 88 + c];
    }
    for (int e = tid; e < 128 * 8; e += NTHR) xcT[(e >> 3) * 104 + 88 + (e & 7)] = 0;
    u32x4 pre[3];
    auto tile_geom = [&](int ti, int& seqbase, int& t0, int& T) {
      if (ti < 2) { seqbase = ML + b * 256; T = 256; t0 = (d ? 1 - ti : ti) * 128; }
      else { seqbase = b * 4096; T = 4096; t0 = (d ? 31 - (ti - 2) : (ti - 2)) * 128; }
    };
    auto prefetch = [&](int ti) {
      int seqbase, t0, T; tile_geom(ti, seqbase, t0, T);
#pragma unroll
      for (int i = 0; i < 3; ++i) {
        const int q = tid + NTHR * i;
        const int row = q / 11, cc = q - row * 11, t = t0 - 2 + row;
        u32x4 v = {0u, 0u, 0u, 0u};
        if (q < 131 * 11 && t >= 0 && t < T) v = *(const u32x4*)(XR + (size_t)(seqbase + t) * LW + blk * 88 + cc * 8);
        pre[i] = v;
      }
    };
    prefetch(0);
    for (int ti = 0; ti < 34; ++ti) {
      int seqbase, t0, T; tile_geom(ti, seqbase, t0, T);
      __syncthreads();
#pragma unroll
      for (int i = 0; i < 3; ++i) {
        const int q = tid + NTHR * i;
        if (q < 131 * 11) *(u32x4*)(raw + q * 8) = pre[i];
      }
      if (ti + 1 < 34) prefetch(ti + 1);
      __builtin_amdgcn_sched_barrier(0);
      __syncthreads();
      for (int e = tid; e < 128 * 44; e += NTHR) {
        const int tl = e / 44, c2 = (e - tl * 44) * 2;
        float a0 = cws[4 * 88 + c2], a1 = cws[4 * 88 + c2 + 1];
#pragma unroll
        for (int j = 0; j < 4; ++j) {
          const unsigned x = *(const unsigned*)(raw + (tl + j) * 88 + c2);
          a0 += bf_lo(x) * cws[j * 88 + c2]; a1 += bf_hi(x) * cws[j * 88 + c2 + 1];
        }
        *(unsigned*)(xcT + tl * 104 + c2) = pk_bf16(a0, a1);
      }
      __syncthreads();
      {
        const int tok = wv * 16 + (lane & 15);
        u32x4 af[3];
#pragma unroll
        for (int kk = 0; kk < 3; ++kk) af[kk] = *(const u32x4*)(xcT + tok * 104 + kk * 32 + 8 * (lane >> 4));
#pragma unroll
        for (int n6 = 0; n6 < 6; ++n6) {
          f32x4 accr = {0.f, 0.f, 0.f, 0.f}, acci = {0.f, 0.f, 0.f, 0.f};
          const int ncol = n6 * 16 + (lane & 15);
          const bf16_t* wr_ = wgs + ncol * 104 + 8 * (lane >> 4);
          const bf16_t* wi_ = wgs + (96 + ncol) * 104 + 8 * (lane >> 4);
#pragma unroll
          for (int kk = 0; kk < 3; ++kk) {
            accr = mfma16(af[kk], *(const u32x4*)(wr_ + kk * 32), accr);
            acci = mfma16(af[kk], *(const u32x4*)(wi_ + kk * 32), acci);
          }
          if (ncol < 88) {
            const int ch = blk * 88 + ncol;
            const float gbr = gate_b[(d * 2 + 0) * LW + ch], gbi = gate_b[(d * 2 + 1) * LW + ch];
            const float spl = softplusf_(-lam[d * LW + ch]);
#pragma unroll
            for (int r = 0; r < 4; ++r) {
              const int tk = wv * 16 + (lane >> 4) * 4 + r;
              const float rg = sigmoidf_(accr[r] + gbr), ig = sigmoidf_(acci[r] + gbi);
              const float a = __expf(-8.f * rg * spl);
              const float bb = sqrtf(fmaxf(1.f - a * a, 0.f)) * ig * bf2f(xcT[tk * 104 + ncol]);
              AB[tk * 88 + ncol] = (f32x2){a, bb};
            }
          }
        }
      }
      __syncthreads();
      if (tid < 352) {
        const int seg = tid / 88, c = tid - seg * 88;
        float hl = 0.f, P = 1.f;
        for (int u0 = seg * 32; u0 < seg * 32 + 32; u0 += 8) {
          f32x2 ab[8];
#pragma unroll
          for (int i = 0; i < 8; ++i) { const int tl = d ? 127 - (u0 + i) : (u0 + i); ab[i] = AB[tl * 88 + c]; }
#pragma unroll
          for (int i = 0; i < 8; ++i) { hl = ab[i][0] * hl + ab[i][1]; P *= ab[i][0]; ab[i] = (f32x2){hl, P}; }
#pragma unroll
          for (int i = 0; i < 8; ++i) { const int tl = d ? 127 - (u0 + i) : (u0 + i); AB[tl * 88 + c] = ab[i]; }
        }
        segH[seg * 88 + c] = hl; segP[seg * 88 + c] = P;
      }
      __syncthreads();
      if (tid < 88) {
        float cur = carry;
#pragma unroll
        for (int seg = 0; seg < 4; ++seg) { segC[seg * 88 + tid] = cur; cur = segP[seg * 88 + tid] * cur + segH[seg * 88 + tid]; }
        carry = cur;
      }
      __syncthreads();
      for (int q = tid; q < 128 * 11; q += NTHR) {
        const int tl = q / 11, c8 = (q - tl * 11) * 8;
        const int u = d ? 127 - tl : tl;
        const float* sc = segC + (u >> 5) * 88 + c8;
        float hv[8];
#pragma unroll
        for (int i = 0; i < 8; ++i) { const f32x2 hp = AB[tl * 88 + c8 + i]; hv[i] = hp[0] + hp[1] * sc[i]; }
        *(u32x4*)(HS + (size_t)(seqbase + t0 + tl) * LW + blk * 88 + c8) =
            mk4(pk_bf16(hv[0], hv[1]), pk_bf16(hv[2], hv[3]), pk_bf16(hv[4], hv[5]), pk_bf16(hv[6], hv[7]));
      }
    }
  }
}

__device__ __forceinline__ void lru_z_phase(const bf16_t* __restrict__ HS0, const bf16_t* __restrict__ HS1, bf16_t* __restrict__ GG) {
  const size_t n8 = (size_t)MT * LW / 8;
  for (size_t e = (size_t)blockIdx.x * NTHR + threadIdx.x; e < n8; e += (size_t)gridDim.x * NTHR) {
    const u32x4 a = *(const u32x4*)(HS0 + e * 8), b = *(const u32x4*)(HS1 + e * 8), g = *(const u32x4*)(GG + e * 8);
    u32x4 o;
    o.x = pk_bf16((bf_lo(a.x) + bf_lo(b.x)) * bf_lo(g.x), (bf_hi(a.x) + bf_hi(b.x)) * bf_hi(g.x));
    o.y = pk_bf16((bf_lo(a.y) + bf_lo(b.y)) * bf_lo(g.y), (bf_hi(a.y) + bf_hi(b.y)) * bf_hi(g.y));
    o.z = pk_bf16((bf_lo(a.z) + bf_lo(b.z)) * bf_lo(g.z), (bf_hi(a.z) + bf_hi(b.z)) * bf_hi(g.z));
    o.w = pk_bf16((bf_lo(a.w) + bf_lo(b.w)) * bf_lo(g.w), (bf_hi(a.w) + bf_hi(b.w)) * bf_hi(g.w));
    *(u32x4*)(GG + e * 8) = o;
  }
}

__device__ __forceinline__ void nat_qk_phase(bf16_t* __restrict__ Q, bf16_t* __restrict__ Kb, bf16_t* __restrict__ QR, const float* __restrict__ qk_g) {
  const int tidx = opaque_tid();
  const int lane = tidx & 63;
  const int gw = blockIdx.x * (NTHR / 64) + (tidx >> 6), nw = gridDim.x * (NTHR / 64);
  const int qd = lane & 3;
  float gq[16], gk[16], inv[16];
#pragma unroll
  for (int i = 0; i < 16; ++i) { gq[i] = qk_g[qd * 16 + i]; gk[i] = qk_g[64 + qd * 16 + i]; inv[i] = exp2f(-(float)i * (13.287712379549449f / 16.f)); }
  for (int row = gw; row < MT; row += nw) {
    const bool lat = row < ML;
    const size_t off = (size_t)row * 1024 + lane * 16;
    float cs[16], sn[16];
    if (lat) {
      const int t = row & 4095;
      const float pos = (float)((qd >> 1) ? (t & 63) : (t >> 6));
#pragma unroll
      for (int i = 0; i < 16; ++i) {
        float rev = pos * inv[i] * 0.15915494309189535f;
        rev -= floorf(rev);
        sn[i] = __builtin_amdgcn_sinf(rev); cs[i] = __builtin_amdgcn_cosf(rev);
      }
    }
#pragma unroll
    for (int which = 0; which < 2; ++which) {
      bf16_t* P = which ? Kb : Q;
      const u32x4 a = *(const u32x4*)(P + off), b2 = *(const u32x4*)(P + off + 8);
      const unsigned u[8] = {a.x, a.y, a.z, a.w, b2.x, b2.y, b2.z, b2.w};
      float x[16];
#pragma unroll
      for (int i = 0; i < 8; ++i) { x[2 * i] = bf_lo(u[i]); x[2 * i + 1] = bf_hi(u[i]); }
      float ss = 0.f;
#pragma unroll
      for (int i = 0; i < 16; ++i) ss += x[i] * x[i];
      ss += __shfl_xor(ss, 1); ss += __shfl_xor(ss, 2);
      const float rstd = rsqrtf(ss * (1.f / 64.f) + 1e-6f);
#pragma unroll
      for (int i = 0; i < 16; ++i) x[i] = x[i] * rstd * (which ? gk[i] : gq[i]);
      unsigned pl[8];
#pragma unroll
      for (int i = 0; i < 8; ++i) pl[i] = pk_bf16(x[2 * i], x[2 * i + 1]);
      unsigned rt[8];
      if (lat) {
        float y[16];
#pragma unroll
        for (int i = 0; i < 16; ++i) {
          const float pr = __shfl_xor(x[i], 1);
          y[i] = x[i] * cs[i] + ((qd & 1) ? pr * sn[i] : -pr * sn[i]);
        }
#pragma unroll
        for (int i = 0; i < 8; ++i) rt[i] = pk_bf16(y[2 * i], y[2 * i + 1]);
      }
      if (which == 0) {
        *(u32x4*)(Q + off) = mk4(pl[0], pl[1], pl[2], pl[3]);
        *(u32x4*)(Q + off + 8) = mk4(pl[4], pl[5], pl[6], pl[7]);
        if (lat) { *(u32x4*)(QR + off) = mk4(rt[0], rt[1], rt[2], rt[3]); *(u32x4*)(QR + off + 8) = mk4(rt[4], rt[5], rt[6], rt[7]); }
      } else {
        if (lat) { *(u32x4*)(Kb + off) = mk4(rt[0], rt[1], rt[2], rt[3]); *(u32x4*)(Kb + off + 8) = mk4(rt[4], rt[5], rt[6], rt[7]); }
        else { *(u32x4*)(Kb + off) = mk4(pl[0], pl[1], pl[2], pl[3]); *(u32x4*)(Kb + off + 8) = mk4(pl[4], pl[5], pl[6], pl[7]); }
      }
    }
  }
}

struct AttnState { f32x16 O[2][2]; float m[2], l[2]; };

DEVI void attn_load_k(u32x4 (&kf)[4], const bf16_t* __restrict__ kbase, int lane) {
  const int l31 = lane & 31, lh = lane >> 5;
#pragma unroll
  for (int ks = 0; ks < 4; ++ks) kf[ks] = *(const u32x4*)(kbase + (size_t)l31 * 1024 + ks * 16 + 8 * lh);
}

DEVI void attn_compute(AttnState& st, const u32x4* qs, const bf16_t* __restrict__ kbase, const bf16_t* __restrict__ vtbase, int vtT,
                       const float* __restrict__ rpbs, bool band, int brow, int half, int lane) {
  const int l31 = lane & 31, lh = lane >> 5;
  u32x4 kf[4];
  attn_load_k(kf, kbase, lane);
  u32x4 vf[4];
#pragma unroll
  for (int dt = 0; dt < 2; ++dt)
#pragma unroll
    for (int s = 0; s < 2; ++s) {
      const bf16_t* vp = vtbase + (size_t)(dt * 32 + l31) * vtT + 16 * s + 4 * lh;
      const u32x2 lo = *(const u32x2*)vp, hi = *(const u32x2*)(vp + 8);
      vf[dt * 2 + s] = mk4(lo.x, lo.y, hi.x, hi.y);
    }
  __builtin_amdgcn_sched_barrier(0);
  constexpr float SC = 0.125f * 1.4426950408889634f;
  u32x4 pf[2][2];
#pragma unroll
  for (int qt = 0; qt < 2; ++qt) {
    f32x16 S;
#pragma unroll
    for (int r = 0; r < 16; ++r) S[r] = 0.f;
#pragma unroll
    for (int ks = 0; ks < 4; ++ks) S = mfma32(kf[ks], qs[(qt * 4 + ks) * 64], S);
    float cmax = -INFINITY;
    if (band) {
      const int qc = qt * 32 + l31;
      const int cst = min(max(qc - 8, 0), 48);
#pragma unroll
      for (int r = 0; r < 16; ++r) {
        const int key = (r & 3) + 8 * (r >> 2) + 4 * lh;
        const int kc = half * 32 + key;
        const bool ok = (kc >= cst) && (kc < cst + 16);
        const int bi = ok ? (brow * 31 + kc - qc + 15) : 0;
        const float sv = S[r] * SC + rpbs[bi];
        S[r] = ok ? sv : -INFINITY;
        cmax = fmaxf(cmax, S[r]);
      }
    } else {
#pragma unroll
      for (int r = 0; r < 16; ++r) { S[r] *= SC; cmax = fmaxf(cmax, S[r]); }
    }
    cmax = fmaxf(cmax, __shfl_xor(cmax, 32));
    const float mnew = fmaxf(st.m[qt], cmax);
    const float alpha = __builtin_amdgcn_exp2f(st.m[qt] - mnew);
    const bool grew = mnew > st.m[qt];
    st.m[qt] = mnew;
    float ps = 0.f;
#pragma unroll
    for (int r = 0; r < 16; ++r) { S[r] = __builtin_amdgcn_exp2f(S[r] - mnew); ps += S[r]; }
    st.l[qt] = st.l[qt] * alpha + ps;
    if (__any(grew)) {
#pragma unroll
      for (int dt = 0; dt < 2; ++dt)
#pragma unroll
        for (int r = 0; r < 16; ++r) st.O[qt][dt][r] *= alpha;
    }
    pf[qt][0] = mk4(pk_bf16(S[0], S[1]), pk_bf16(S[2], S[3]), pk_bf16(S[4], S[5]), pk_bf16(S[6], S[7]));
    pf[qt][1] = mk4(pk_bf16(S[8], S[9]), pk_bf16(S[10], S[11]), pk_bf16(S[12], S[13]), pk_bf16(S[14], S[15]));
  }
#pragma unroll
  for (int dt = 0; dt < 2; ++dt)
#pragma unroll
    for (int s = 0; s < 2; ++s) {
      st.O[0][dt] = mfma32(vf[dt * 2 + s], pf[0][s], st.O[0][dt]);
      st.O[1][dt] = mfma32(vf[dt * 2 + s], pf[1][s], st.O[1][dt]);
    }
}

__device__ __forceinline__ void natten_phase(char* lds, const bf16_t* __restrict__ Q, const bf16_t* __restrict__ QR, const bf16_t* __restrict__ Kb,
                             const bf16_t* __restrict__ VT, bf16_t* __restrict__ G, const float* __restrict__ rpb, bf16_t* __restrict__ Zd) {
  float* rpbs = (float*)lds;
  __syncthreads();
  for (int e = threadIdx.x; e < 16 * 465; e += NTHR) rpbs[e] = rpb[e] * 1.4426950408889634f;
  __syncthreads();
  const int tidx = opaque_tid();
  const int lane = tidx & 63, l31 = lane & 31, lh = lane >> 5;
  const int gw = blockIdx.x * (NTHR / 64) + (tidx >> 6), nw = gridDim.x * (NTHR / 64);
  const bf16_t* VTC = VT + (size_t)ML * 1024;
  u32x4* qs = (u32x4*)(lds + 32768) + (tidx >> 6) * 512 + lane;
  const int xcd = blockIdx.x & 7, wx = (blockIdx.x >> 3) * (NTHR / 64) + (tidx >> 6), nwx = (gridDim.x >> 3) * (NTHR / 64);
  for (int i = wx; i < 1024 + 64; i += nwx) {
    const bool lat = i < 1024;
    int b, h, r = 0, qrow0;
    if (lat) { const int pair = xcd * 16 + (i >> 6); r = i & 63; b = pair >> 4; h = pair & 15; qrow0 = b * 4096 + r * 64; }
    else { const int it = i - 1024; const int pair = xcd * 16 + (it >> 2); const int qt64 = it & 3; b = pair >> 4; h = pair & 15; qrow0 = ML + b * 256 + qt64 * 64; }
    const int start = min(max(r - 4, 0), 56);
    const int nchunks = lat ? 24 : 8;
    AttnState st;
#pragma unroll
    for (int a = 0; a < 2; ++a) { st.m[a] = -INFINITY; st.l[a] = 0.f;
#pragma unroll
      for (int c = 0; c < 2; ++c)
#pragma unroll
        for (int rr = 0; rr < 16; ++rr) st.O[a][c][rr] = 0.f; }
#pragma unroll
    for (int qt = 0; qt < 2; ++qt)
#pragma unroll
      for (int ks = 0; ks < 4; ++ks) qs[(qt * 4 + ks) * 64] = *(const u32x4*)(Q + (size_t)(qrow0 + qt * 32 + l31) * 1024 + h * 64 + ks * 16 + 8 * lh);
    for (int j = 0; j < nchunks; ++j) {
      if (j == 8) {
#pragma unroll
        for (int qt = 0; qt < 2; ++qt)
#pragma unroll
          for (int ks = 0; ks < 4; ++ks) qs[(qt * 4 + ks) * 64] = *(const u32x4*)(QR + (size_t)(qrow0 + qt * 32 + l31) * 1024 + h * 64 + ks * 16 + 8 * lh);
      }
      const bool band = j >= 8;
      const int ii = j - 8, kr = start + (ii >> 1), half = band ? (ii & 1) : 0;
      const size_t krow = band ? (size_t)(b * 4096 + kr * 64 + half * 32) : (size_t)(ML + b * 256 + j * 32);
      const bf16_t* kbase = Kb + krow * 1024 + h * 64;
      const bf16_t* vtb = band ? VT + (size_t)(b * 16 + h) * 64 * 4096 + kr * 64 + half * 32 : VTC + (size_t)(b * 16 + h) * 64 * 256 + j * 32;
      attn_compute(st, qs, kbase, vtb, band ? 4096 : 256, rpbs, band, band ? h * 15 + (kr - r + 7) : 0, half, lane);
    }
#pragma unroll
    for (int qt = 0; qt < 2; ++qt) {
      const float lt = st.l[qt] + __shfl_xor(st.l[qt], 32);
      const float inv = 1.f / lt;
      bf16_t* grow = G + (size_t)(qrow0 + qt * 32 + l31) * 1024 + h * 64;
#pragma unroll
      for (int dt = 0; dt < 2; ++dt)
#pragma unroll
        for (int q4 = 0; q4 < 4; ++q4) {
          bf16_t* gp = grow + dt * 32 + 8 * q4 + 4 * lh;
          bf16_t* zp = Zd + (gp - G);
          const u32x2 gv = *(const u32x2*)gp;
          u32x2 o;
          o.x = pk_bf16(st.O[qt][dt][4 * q4] * inv * bf_lo(gv.x), st.O[qt][dt][4 * q4 + 1] * inv * bf_hi(gv.x));
          o.y = pk_bf16(st.O[qt][dt][4 * q4 + 2] * inv * bf_lo(gv.y), st.O[qt][dt][4 * q4 + 3] * inv * bf_hi(gv.y));
          *(u32x2*)zp = o;
        }
    }
  }
}

namespace pg8 {
#define PG8_LAS __attribute__((address_space(3)))
typedef unsigned short bf16_t;
typedef short bf16x8 __attribute__((ext_vector_type(8)));
typedef float f32x4 __attribute__((ext_vector_type(4)));
typedef unsigned u32x4 __attribute__((ext_vector_type(4)));
constexpr int BM = 256, BK = 64, HALF = 128, HTB = HALF * BK * 2  , STAGE_BYTES = 8 * HTB, NXCD = 8, WGM = 8;

__host__ __device__ __forceinline__ int lds_byte(int r, int c) { const int st = (r >> 4) * 2 + (c >> 5), rr = r & 15, cc = c & 31, ob = rr * 64 + cc * 2; return st * 1024 + (ob ^ (((ob >> 9) & 1) << 5)); }
__host__ __device__ __forceinline__ void stage_rc(int b, int& R, int& C) { const int st = b / 1024, sb = b % 1024, swz = sb ^ (((sb >> 9) & 1) << 5); R = (st >> 1) * 16 + swz / 64; C = (st & 1) * 32 + (swz % 64) / 2; }
__host__ __device__ __forceinline__ int perm32(int rho) { const int n = rho >> 4, i = rho & 15; return 8 * (i >> 2) + 4 * n + (i & 3); }

struct Unit { int pm, pn; };
struct Gemm { const bf16_t* A; const bf16_t* Bt; int M, N, K; };

struct StaticOrder {
    int nM, nN, nwg, G, c;
    __host__ __device__ void init(int M, int N, int G_, int c_) { nM = M / BM; nN = N / BM; nwg = nM * nN; G = G_; c = c_; }
    __host__ __device__ bool next(int i, Unit& u) const {
        const long L = (long)i * G + c; if (L >= nwg) return false;
        int wgid = (int)L; { const int q = nwg / NXCD, r = nwg % NXCD, xcd = wgid % NXCD, off = wgid / NXCD; wgid = (xcd < r ? xcd * (q + 1) : r * (q + 1) + (xcd - r) * q) + off; }
        const int nig = WGM * nN, gid = wgid / nig, fm = gid * WGM, gsz = (nM - fm) < WGM ? (nM - fm) : WGM;
        u.pm = fm + ((wgid % nig) % gsz); u.pn = (wgid % nig) / gsz; return true;
    }
    __device__ __forceinline__ void a_ready(const Unit&) const {}
    __device__ __forceinline__ void done(const Unit&) const {}
};
template <class Epi, class Sched, bool STAMP = false>
__device__ __forceinline__ void gemm_phase(PG8_LAS unsigned char* lds, const Gemm g, const Sched& S, const Epi& E, unsigned long long* stamps) {
    const int tid = threadIdx.x, wid = __builtin_amdgcn_readfirstlane(tid >> 6), lane = tid & 63, wr = wid >> 2, wc = wid & 3, fr = lane & 15, fq = lane >> 4;
    const int K = g.K, nt = K / BK;
    int ts_lo = 0, ts_hi = 0, nts = 0; const unsigned long long rt_entry = STAMP ? (unsigned long long)wall_clock64() : 0ull;
#define PG8_STAMP() do { if (STAMP && wid == 0 && nts < 64) { const unsigned long long _c = (unsigned long long)clock64(); \
        ts_lo = (lane == nts) ? (int)(unsigned)_c : ts_lo; ts_hi = (lane == nts) ? (int)(unsigned)(_c >> 32) : ts_hi; ++nts; } } while (0)
    PG8_STAMP();
    unsigned voffA[2], voffB[2];
#pragma unroll
    for (int i = 0; i < 2; ++i) { int R, C; stage_rc(tid * 16 + i * 8192, R, C); const int Rb = Epi::PERM ? ((R & ~31) + perm32(R & 31)) : R;
        voffA[i] = (unsigned)(R * K + C) * 2u; voffB[i] = (unsigned)(Rb * K + C) * 2u; }
    const size_t kstep = (size_t)(BK * 2);
    const size_t hstep = (size_t)HALF * K * 2;
    const size_t tstep = 2 * hstep;
    const unsigned ldsw = (unsigned)wid * 1024u;
    const int aoff = lds_byte(wr * 64 + fr, fq * 8), boff = lds_byte(wc * 32 + fr, fq * 8);
#define PG8_SA(b, h) (((b) * 2 + (h)) * HTB)
#define PG8_SB(b, h) ((4 + (b) * 2 + (h)) * HTB)
#define PG8_STAGE(bufoff, gbase, voff) do { _Pragma("unroll") for (int _i = 0; _i < 2; ++_i) \
        __builtin_amdgcn_global_load_lds((const unsigned*)((const char*)(gbase) + (voff)[_i]), (PG8_LAS unsigned*)(lds + (bufoff) + ldsw + _i * 8192), 16, 0, 0); } while (0)
#define PG8_LDA(dst, b, h) do { _Pragma("unroll") for (int m = 0; m < 4; ++m) _Pragma("unroll") for (int k = 0; k < 2; ++k) dst[m][k] = *(const PG8_LAS bf16x8*)(lds + PG8_SA(b, h) + aoff + m * 2048 + k * 1024); } while (0)
#define PG8_LDB(dst, b, h) do { _Pragma("unroll") for (int n = 0; n < 2; ++n) _Pragma("unroll") for (int k = 0; k < 2; ++k) dst[n][k] = *(const PG8_LAS bf16x8*)(lds + PG8_SB(b, h) + boff + n * 2048 + k * 1024); } while (0)
#define PG8_MMA(ai, bj, At, Bt) do { __builtin_amdgcn_s_setprio(1); _Pragma("unroll") for (int m = 0; m < 4; ++m) _Pragma("unroll") for (int n = 0; n < 2; ++n) _Pragma("unroll") for (int k = 0; k < 2; ++k) \
        acc[ai][bj][m][n] = __builtin_amdgcn_mfma_f32_16x16x32_bf16(Bt[n][k], At[m][k], acc[ai][bj][m][n], 0, 0, 0); __builtin_amdgcn_s_setprio(0); } while (0)
#define PG8_WAIT_V(n) asm volatile("s_waitcnt vmcnt(" #n ")" ::: "memory")
#define PG8_WAIT_L(n) asm volatile("s_waitcnt lgkmcnt(" #n ")" ::: "memory")
#define PG8_BAR __builtin_amdgcn_s_barrier()
#define PG8_SCHED __builtin_amdgcn_sched_barrier(0)
    Unit cur, nxt; int ui = 0;
    if (!S.next(0, cur)) return;
    f32x4 acc[2][2][4][2];
#pragma unroll
    for (int a = 0; a < 2; ++a)
#pragma unroll
        for (int b = 0; b < 2; ++b)
#pragma unroll
            for (int m = 0; m < 4; ++m)
#pragma unroll
                for (int n = 0; n < 2; ++n) acc[a][b][m][n] = (f32x4){0.f, 0.f, 0.f, 0.f};
    bf16x8 At[4][2], B0[2][2], B1[2][2];
    const char* cA = (const char*)g.A + (size_t)cur.pm * tstep; const char* cB = (const char*)g.Bt + (size_t)cur.pn * tstep;
    S.a_ready(cur);
    PG8_STAGE(PG8_SB(0, 0), cB, voffB); PG8_STAGE(PG8_SA(0, 0), cA, voffA); PG8_STAGE(PG8_SB(0, 1), cB + hstep, voffB); PG8_STAGE(PG8_SA(0, 1), cA + hstep, voffA);
    if (wr == 1) PG8_BAR;
    PG8_WAIT_V(4); PG8_BAR;
    PG8_STAGE(PG8_SB(1, 0), cB + kstep, voffB); PG8_STAGE(PG8_SA(1, 0), cA + kstep, voffA); PG8_STAGE(PG8_SB(1, 1), cB + hstep + kstep, voffB);
    PG8_WAIT_V(6); PG8_BAR;
    PG8_STAMP();
    for (;;) {
        const bool has_next = S.next(ui + 1, nxt);
        const char* nA = has_next ? (const char*)g.A + (size_t)nxt.pm * tstep : cA; const char* nB = has_next ? (const char*)g.Bt + (size_t)nxt.pn * tstep : cB;
        for (int t = 0; t < nt; t += 2) {
            const bool last = (t == nt - 2);
            const char* a1 = cA + (size_t)(t + 1) * kstep;
            const char* a2 = last ? nA : cA + (size_t)(t + 2) * kstep; const char* b2 = last ? nB : cB + (size_t)(t + 2) * kstep;
            const char* a3 = a2 + kstep; const char* b3 = b2 + kstep;
            if (last && has_next) S.a_ready(nxt);
            PG8_LDB(B0, 0, 0); PG8_SCHED; PG8_LDA(At, 0, 0); PG8_STAGE(PG8_SA(1, 1), a1 + hstep, voffA);
            PG8_WAIT_L(8); PG8_BAR; PG8_WAIT_L(0); PG8_MMA(0, 0, At, B0); PG8_BAR; PG8_SCHED;
            PG8_LDB(B1, 0, 1); PG8_STAGE(PG8_SB(0, 0), b2, voffB);
            PG8_BAR; PG8_WAIT_L(0); PG8_MMA(0, 1, At, B1); PG8_BAR;
            PG8_LDA(At, 0, 1); PG8_STAGE(PG8_SA(0, 0), a2, voffA);
            PG8_BAR; PG8_WAIT_L(0); PG8_MMA(1, 0, At, B0); PG8_BAR; PG8_SCHED;
            PG8_STAGE(PG8_SB(0, 1), b2 + hstep, voffB);
            PG8_WAIT_V(6); PG8_BAR; PG8_MMA(1, 1, At, B1); PG8_BAR;
            PG8_LDB(B0, 1, 0); PG8_SCHED; PG8_LDA(At, 1, 0); PG8_STAGE(PG8_SA(0, 1), a2 + hstep, voffA);
            PG8_WAIT_L(8); PG8_BAR; PG8_WAIT_L(0); PG8_MMA(0, 0, At, B0); PG8_BAR; PG8_SCHED;
            PG8_LDB(B1, 1, 1); PG8_STAGE(PG8_SB(1, 0), b3, voffB);
            PG8_BAR; PG8_WAIT_L(0); PG8_MMA(0, 1, At, B1); PG8_BAR;
            PG8_LDA(At, 1, 1); PG8_STAGE(PG8_SA(1, 0), a3, voffA);
            PG8_BAR; PG8_WAIT_L(0); PG8_MMA(1, 0, At, B0); PG8_BAR; PG8_SCHED;
            PG8_STAGE(PG8_SB(1, 1), b3 + hstep, voffB);
            PG8_WAIT_V(6); PG8_BAR; PG8_MMA(1, 1, At, B1); PG8_BAR;
        }
        PG8_STAMP();
        if constexpr (!Epi::AFTER_DRAIN) { E(acc, cur, wr, wc, fr, fq); S.done(cur); }
        PG8_STAMP();
        if (!has_next) break;
#pragma unroll
        for (int a = 0; a < 2; ++a)
#pragma unroll
            for (int b = 0; b < 2; ++b)
#pragma unroll
                for (int m = 0; m < 4; ++m)
#pragma unroll
                    for (int n = 0; n < 2; ++n) acc[a][b][m][n] = (f32x4){0.f, 0.f, 0.f, 0.f};
        cur = nxt; cA = nA; cB = nB; ++ui;
    }
    PG8_WAIT_V(0);
    if (wr == 0) PG8_BAR;
    PG8_BAR;
    if constexpr (Epi::AFTER_DRAIN) { E.fused(acc, cur, wr, wc, fr, fq, lds, wid, lane); S.done(cur); }
    PG8_STAMP();
    if (STAMP && wid == 0) { stamps[lane] = lane < nts ? (((unsigned long long)(unsigned)ts_hi << 32) | (unsigned)ts_lo) : 0ull;
        if (lane == 62) stamps[62] = rt_entry; if (lane == 63) stamps[63] = (unsigned long long)wall_clock64(); }
#undef PG8_STAMP
#undef PG8_SA
#undef PG8_SB
#undef PG8_STAGE
#undef PG8_LDA
#undef PG8_LDB
#undef PG8_MMA
#undef PG8_WAIT_V
#undef PG8_WAIT_L
#undef PG8_BAR
#undef PG8_SCHED
}
}

template <class EP> struct Pg8Epi {
  static constexpr bool PERM = false, AFTER_DRAIN = false;
  EP ep;
  __device__ __forceinline__ void operator()(const pg8::f32x4 (&acc)[2][2][4][2], const pg8::Unit& u, int wr, int wc, int fr, int fq) const {
#pragma unroll
    for (int ai = 0; ai < 2; ++ai)
#pragma unroll
      for (int m = 0; m < 4; ++m)
#pragma unroll
        for (int bj = 0; bj < 2; ++bj)
#pragma unroll
          for (int n = 0; n < 2; ++n) {
            const int row = u.pm * 256 + ai * 128 + wr * 64 + m * 16 + fr;
            const int col = u.pn * 256 + bj * 128 + wc * 32 + n * 16 + fq * 4;
            ep(row, col, acc[ai][bj][m][n]);
          }
  }
};
template <class EP>
__device__ __forceinline__ void pg8_gemm(char* lds, const bf16_t* A, const bf16_t* Bt, int M, int N, int K, const EP ep) {
  __syncthreads();
  pg8::Gemm g{A, Bt, M, N, K};
  pg8::StaticOrder S; S.init(M, N, (int)gridDim.x, (int)blockIdx.x);
  Pg8Epi<EP> E{ep};
  pg8::gemm_phase<Pg8Epi<EP>, pg8::StaticOrder, false>((PG8_LAS unsigned char*)lds, g, S, E, nullptr);
  __syncthreads();
}

template <int ph>
__device__ __forceinline__ void run_phase(const Params& p, char* lds, bool last_rep) {
  char* ws = p.ws;
  const float* MOD = (const float*)(ws + OFF_MOD);
  float* XC = (float*)(ws + OFF_XC);
  bf16_t* HB = (bf16_t*)(ws + OFF_HB);
  bf16_t* A0 = (bf16_t*)(ws + OFF_A0); bf16_t* A1 = (bf16_t*)(ws + OFF_A1); bf16_t* A2 = (bf16_t*)(ws + OFF_A2);
  bf16_t* A3 = (bf16_t*)(ws + OFF_A3); bf16_t* A4 = (bf16_t*)(ws + OFF_A4);
  bf16_t* WD = (bf16_t*)(ws + OFF_WD); bf16_t* AD = (bf16_t*)(ws + OFF_AD);
  float* BON = (float*)(ws + OFF_BON);
  if (ph == 0) { phase0(p, lds); return; }
  constexpr int layer = (ph - 1) / 5, sub = (ph - 1) % 5;
  const float* modL = MOD + (size_t)layer * 9 * 3072;
  const float* xl_cur = layer == 0 ? p.in[0] : p.out;
  const float* xc_cur = layer == 0 ? p.in[2] : XC;
  if (layer == 0 || layer == 3) {
    const int ib = layer ? 33 : 4;
    const bf16_t* WIN = (const bf16_t*)(ws + (layer ? OFF_W3IN : OFF_W0IN));
    const bf16_t* WUP = (const bf16_t*)(ws + (layer ? OFF_W3UP : OFF_W0UP));
    const bf16_t* WOUT = (const bf16_t*)(ws + (layer ? OFF_W3OUT : OFF_W0OUT));
    if (sub == 0) norm_phase<true>(xl_cur, xc_cur, p.in[ib], modL, HB, A4);
    else if (sub == 1) { ALMix al{HB, A4, p.in[ib + 4]}; EpRwkvIn ep{A0, A1, A2, A3, WD, AD}; gemm256_phase(lds, WIN, 1024, MT / 256, 16, al, ep); gemm_phase(lds, WIN, 1024, MT / 256, 2, al, ep, 4096, true); }
    else if (sub == 2) rwkv_scan_phase(lds, A0, A1, A2, WD, AD, WUP, p.in[ib + 5], p.in[ib + 8], p.in[ib + 9], HB, A4, BON);
    else if (sub == 3) rwkv_post_phase(HB, A4, A2, A3, BON, p.in[ib + 10], layer == 3 ? ML : MT);
    else { ALPlain al{A3, 1024}; EpRes ep{xl_cur, xc_cur, p.out, XC, modL}; pg8_gemm(lds, A3, WOUT, ML, 1024, 1024, ep); if (layer != 3) gemm_phase(lds, WOUT, 1024, MC / 256, 8, al, ep, 0, false, ML / 256); }
  } else if (layer == 1) {
    bf16_t* HS0 = (bf16_t*)(ws + OFF_HS0); bf16_t* XR = (bf16_t*)(ws + OFF_XR); bf16_t* GG = (bf16_t*)(ws + OFF_GG); bf16_t* HS1 = (bf16_t*)(ws + OFF_HS1);
    if (sub == 0) norm_phase<false>(xl_cur, xc_cur, p.in[16], modL, HB, nullptr);
    else if (sub == 1) { ALPlain al{HB, 1024}; EpLruIn ep{XR, GG}; pg8_gemm(lds, HB, (const bf16_t*)(ws + OFF_W1IN), MT, 2816, 1024, ep); }
    else if (sub == 2) rglru_phase(lds, XR, (const bf16_t*)(ws + OFF_W1G), p.in[20], p.in[21], p.in[23], p.in[24], HS0, HS1);
    else if (sub == 3) lru_z_phase(HS0, HS1, GG);
    else { ALPlain al{GG, LW}; EpRes ep{xl_cur, xc_cur, p.out, XC, modL}; pg8_gemm(lds, GG, (const bf16_t*)(ws + OFF_W1OUT), ML, 1024, LW, ep); gemm_phase(lds, (const bf16_t*)(ws + OFF_W1OUT), LW, MC / 256, 8, al, ep, 0, false, ML / 256); }
  } else {
    if (sub == 0) norm_phase<false>(xl_cur, xc_cur, p.in[26], modL, HB, nullptr);
    else if (sub == 1) { ALPlain al{HB, 1024}; EpNatIn ep{A0, A1, A2, A3}; pg8_gemm(lds, HB, (const bf16_t*)(ws + OFF_W2IN), MT, 4096, 1024, ep); }
    else if (sub == 2) nat_qk_phase(A0, A1, A4, p.in[30]);
    else if (sub == 3) natten_phase(lds, A0, A4, A1, A2, A3, p.in[31], last_rep ? A3 : HB);
    else { ALPlain al{A3, 1024}; EpRes ep{xl_cur, xc_cur, p.out, XC, modL}; pg8_gemm(lds, A3, (const bf16_t*)(ws + OFF_W2OUT), ML, 1024, 1024, ep); gemm_phase(lds, (const bf16_t*)(ws + OFF_W2OUT), 1024, MC / 256, 8, al, ep, 0, false, ML / 256); }
  }
}

__global__ void __launch_bounds__(NTHR) mega_kernel(Params p) {
  __shared__ __attribute__((aligned(16))) char lds[LDS_BYTES];
  __shared__ u32x4 xb_words;
  cg::grid_group grid = cg::this_grid();
  if (threadIdx.x == 0) xb_words = (u32x4){0u, 0u, 0u, 0u};
  __syncthreads();
  const XcdBarrier xb = xcd_barrier_post((unsigned*)(p.ws + OFF_BAR), (volatile LAS unsigned*)&xb_words);
#define PHASE(k) if (p.ph_lo <= k && k < p.ph_hi) { for (int rep = 0; rep < REP[k]; ++rep) { run_phase<k>(p, lds, rep + 1 == REP[k]); if (rep + 1 < REP[k] || k + 1 < p.ph_hi) { if (k == 0) grid.sync(); else xcd_barrier(xb); } } }
  PHASE(0) PHASE(1) PHASE(2) PHASE(3) PHASE(4) PHASE(5) PHASE(6) PHASE(7) PHASE(8) PHASE(9) PHASE(10)
  PHASE(11) PHASE(12) PHASE(13) PHASE(14) PHASE(15) PHASE(16) PHASE(17) PHASE(18) PHASE(19) PHASE(20)
#undef PHASE
}

extern "C" void kernel_launch(void* const* d_in, const int* in_sizes, int n_in, void* d_out, int out_size, void* d_ws, size_t ws_size,
                              hipStream_t stream) {
  static int grid_blocks = 0;
  if (!grid_blocks) {
    int dev = 0, cus = 0, per_cu = 0;
    hipGetDevice(&dev);
    hipDeviceGetAttribute(&cus, hipDeviceAttributeMultiprocessorCount, dev);
    hipOccupancyMaxActiveBlocksPerMultiprocessor(&per_cu, mega_kernel, NTHR, 0);
    if (per_cu < 1) { fprintf(stderr, "occupancy query returned %d\n", per_cu); per_cu = 1; }
    if (per_cu > 1) per_cu = 1;
    grid_blocks = cus * per_cu;
    if (n_in != 45 || ws_size < WS_END) fprintf(stderr, "unexpected n_in %d / ws %zu (need %zu)\n", n_in, ws_size, (size_t)WS_END);
  }
  Params p{};
  for (int i = 0; i < 45; ++i) p.in[i] = (const float*)d_in[i];
  p.out = (float*)d_out;
  p.ws = (char*)d_ws;
  (void)hipMemsetAsync((char*)d_ws + OFF_BAR, 0, XCD_BAR_WORDS * 4, stream);
#if N_LAUNCH_MODE == 1
  p.ph_lo = 0; p.ph_hi = NPHASE;
  void* args[] = {&p};
  hipError_t e = hipLaunchCooperativeKernel((void*)mega_kernel, dim3(grid_blocks), dim3(NTHR), args, 0, stream);
  if (e != hipSuccess) fprintf(stderr, "cooperative launch failed: %s (grid %d)\n", hipGetErrorString(e), grid_blocks);
#else
  for (int ph = 0; ph < NPHASE; ++ph) {
    p.ph_lo = ph; p.ph_hi = ph + 1;
    hipLaunchKernelGGL(mega_kernel, dim3(grid_blocks), dim3(NTHR), 0, stream, p);
  }
#endif
}
```

```cpp
#include <hip/hip_runtime.h>
#include <hip/hip_cooperative_groups.h>
#include <cstdio>
#include <cstdint>
namespace cg = cooperative_groups;

#ifndef N_LAUNCH_MODE
#define N_LAUNCH_MODE 1
#endif

typedef unsigned short bf16_t;
typedef short bf16x8 __attribute__((ext_vector_type(8)));
typedef float f32x4 __attribute__((ext_vector_type(4)));
typedef float f32x16 __attribute__((ext_vector_type(16)));
typedef float f32x2 __attribute__((ext_vector_type(2)));
typedef unsigned u32x4 __attribute__((ext_vector_type(4)));
typedef unsigned u32x2 __attribute__((ext_vector_type(2)));

#define DEVI __device__ __forceinline__

constexpr int D = 1024, NB = 8, SEQ = 4096, CTX = 256;
constexpr int ML = NB * SEQ;
constexpr int MC = NB * CTX;
constexpr int MT = ML + MC;
constexpr int LW = 1408;
constexpr int NTHR = 512;
constexpr int NPHASE = 21;
constexpr int LDS_BYTES = 163840 - 16;
__device__ constexpr int REP[21] = {1,1,1,1,1,1,1,1,1,1,1,1,1,1,1,1,1,1,1,1,1};

constexpr size_t SZ_ACT = (size_t)MT * 1024 * 2;
constexpr size_t OFF_MOD = 0;
constexpr size_t OFF_BAR = 458752;
constexpr size_t OFF_W0IN = 524288;
constexpr size_t SZ_RWIN = (size_t)4352 * 1024 * 2;
constexpr size_t SZ_RWUP = (size_t)4 * 1024 * 64 * 2;
constexpr size_t SZ_SQ = (size_t)1024 * 1024 * 2;
constexpr size_t OFF_W0UP = OFF_W0IN + SZ_RWIN;
constexpr size_t OFF_W0OUT = OFF_W0UP + SZ_RWUP;
constexpr size_t OFF_W3IN = OFF_W0OUT + SZ_SQ;
constexpr size_t OFF_W3UP = OFF_W3IN + SZ_RWIN;
constexpr size_t OFF_W3OUT = OFF_W3UP + SZ_RWUP;
constexpr size_t OFF_W1IN = OFF_W3OUT + SZ_SQ;
constexpr size_t OFF_W1G = OFF_W1IN + (size_t)2816 * 1024 * 2;
constexpr size_t OFF_W1OUT = OFF_W1G + (size_t)16 * 4 * 96 * 96 * 2;
constexpr size_t OFF_W2IN = OFF_W1OUT + (size_t)1024 * 1408 * 2;
constexpr size_t OFF_W2OUT = OFF_W2IN + (size_t)4096 * 1024 * 2;
constexpr size_t OFF_XC = OFF_W2OUT + SZ_SQ;
constexpr size_t OFF_BON = OFF_XC + (size_t)MC * 1024 * 4;
constexpr size_t OFF_BIG = OFF_BON + (size_t)2 * MT * 16 * 4;
constexpr size_t OFF_HB = OFF_BIG;
constexpr size_t OFF_A0 = OFF_BIG + SZ_ACT;
constexpr size_t OFF_A1 = OFF_A0 + SZ_ACT;
constexpr size_t OFF_A2 = OFF_A1 + SZ_ACT;
constexpr size_t OFF_A3 = OFF_A2 + SZ_ACT;
constexpr size_t OFF_A4 = OFF_A3 + SZ_ACT;
constexpr size_t OFF_WD = OFF_A4 + SZ_ACT;
constexpr size_t OFF_AD = OFF_WD + (size_t)MT * 128 * 2;
constexpr size_t WS_END = OFF_AD + (size_t)MT * 128 * 2;
constexpr size_t SZ_LRU = (size_t)MT * LW * 2;
constexpr size_t OFF_HS0 = OFF_BIG;
constexpr size_t OFF_XR = OFF_BIG + SZ_LRU;
constexpr size_t OFF_GG = OFF_XR + SZ_LRU;
constexpr size_t OFF_HS1 = OFF_GG + SZ_LRU;
static_assert(OFF_HS1 + SZ_LRU <= WS_END, "lru overlay");
static_assert(WS_END <= (size_t)536870912, "ws");

struct Params {
  const float* in[45];
  float* out;
  char* ws;
  int ph_lo, ph_hi;
};

DEVI u32x4 mk4(unsigned a, unsigned b, unsigned c, unsigned d) { u32x4 r = {a, b, c, d}; return r; }
DEVI int opaque_tid() { int t = threadIdx.x; asm volatile("" : "+v"(t)); return t; }
DEVI float bf_lo(unsigned u) { return __uint_as_float(u << 16); }
DEVI float bf_hi(unsigned u) { return __uint_as_float(u & 0xffff0000u); }
DEVI float bf2f(bf16_t h) { return __uint_as_float(((unsigned)h) << 16); }
typedef __bf16 bf16x2_t __attribute__((ext_vector_type(2)));
DEVI unsigned pk_bf16(float lo, float hi) { f32x2 f = {lo, hi}; bf16x2_t v = __builtin_convertvector(f, bf16x2_t); return __builtin_bit_cast(unsigned, v); }
DEVI bf16_t f2bf(float f) { return (bf16_t)(pk_bf16(f, 0.f) & 0xffffu); }
DEVI float wave_sum(float v) {
#pragma unroll
  for (int o = 32; o; o >>= 1) v += __shfl_xor(v, o);
  return v;
}
DEVI float sigmoidf_(float x) { return __builtin_amdgcn_rcpf(1.f + __expf(-x)); }
DEVI float siluf_(float x) { return x * __builtin_amdgcn_rcpf(1.f + __expf(-x)); }
DEVI float softplusf_(float x) { return fmaxf(x, 0.f) + __logf(1.f + __expf(-fabsf(x))); }
DEVI f32x16 mfma32(u32x4 a, u32x4 b, f32x16 c) {
  return __builtin_amdgcn_mfma_f32_32x32x16_bf16(__builtin_bit_cast(bf16x8, a), __builtin_bit_cast(bf16x8, b), c, 0, 0, 0);
}
DEVI f32x4 mfma16(u32x4 a, u32x4 b, f32x4 c) {
  return __builtin_amdgcn_mfma_f32_16x16x32_bf16(__builtin_bit_cast(bf16x8, a), __builtin_bit_cast(bf16x8, b), c, 0, 0, 0);
}
template <int CTRL> DEVI float dpp_f(float v) {
  return __int_as_float(__builtin_amdgcn_update_dpp(0, __float_as_int(v), CTRL, 0xf, 0xf, true));
}
DEVI float sum8(float v) {
  v += dpp_f<0xB1>(v);
  v += dpp_f<0x4E>(v);
  v += dpp_f<0x141>(v);
  return v;
}

#define XB_TMO      128
#define XB_XCNT(j)  (256  + 64 * (j))
#define XB_XSUB(j)  (1280 + 64 * (j))
#define XB_XGEN(j)  (2304 + 64 * (j))
#define XB_TOP      3328
#define XB_TOPGEN   3392
#define XCD_BAR_WORDS 3456
#define XB_SPIN_CAP (1u << 18)
#define LAS __attribute__((address_space(3)))

__device__ __forceinline__ unsigned xb_ld(unsigned* p)              { return __hip_atomic_load(p, __ATOMIC_RELAXED, __HIP_MEMORY_SCOPE_AGENT); }
__device__ __forceinline__ unsigned xb_add(unsigned* p, unsigned v) { return __hip_atomic_fetch_add(p, v, __ATOMIC_RELAXED, __HIP_MEMORY_SCOPE_AGENT); }
__device__ __forceinline__ unsigned xb_xcc_id() { return (unsigned)__builtin_amdgcn_s_getreg((3 << 11) | 20) & 0xFu; }
#define XB_SPIN(cond, bar) do { unsigned _sp = 0; while (cond) { __builtin_amdgcn_s_sleep(1); \
    if ((++_sp & 255u) == 0u) { if (xb_ld(&(bar)[XB_TMO])) break; if (_sp > XB_SPIN_CAP) { atomicAdd(&(bar)[XB_TMO], 1u); break; } } } } while (0)

struct XcdBarrier {
    unsigned* bar; unsigned x;
    volatile LAS unsigned* st;
};

__device__ __forceinline__ XcdBarrier xcd_barrier_post(unsigned* bar, volatile LAS unsigned* st) {
    XcdBarrier b; b.bar = bar; b.x = xb_xcc_id(); b.st = st;
    if (threadIdx.x == 0) (void)xb_add(&bar[XB_XCNT(b.x)], 1u);
    return b;
}
__device__ __forceinline__ void xcd_barrier_complete(unsigned* bar, unsigned x, unsigned& nloc, unsigned& nx) {
    const unsigned G = gridDim.x * gridDim.y * gridDim.z;
    unsigned sum, cnt, mine, sp = 0u;
    for (;;) {
        sum = 0u; cnt = 0u; mine = 0u;
#pragma unroll
        for (unsigned j = 0; j < 16; ++j) { const unsigned c = xb_ld(&bar[XB_XCNT(j)]); sum += c; cnt += (c > 0u) ? 1u : 0u; mine = (j == x) ? c : mine; }
        if (sum == G) break;
        __builtin_amdgcn_s_sleep(1);
        if ((++sp & 255u) == 0u) { if (xb_ld(&bar[XB_TMO])) break; if (sp > XB_SPIN_CAP) { atomicAdd(&bar[XB_TMO], 1u); break; } }
    }
    nloc = mine > 0u ? mine : 1u; nx = cnt > 0u ? cnt : 1u;
}

__device__ __forceinline__ void xcd_barrier(const XcdBarrier& b) {
    asm volatile("s_waitcnt vmcnt(0)" ::: "memory");
    __syncthreads();
    if (threadIdx.x == 0) {
        unsigned* bar = b.bar;
        __builtin_amdgcn_s_waitcnt(0);
        unsigned nloc = b.st[0], nx = b.st[1];
        if (nloc == 0u) { xcd_barrier_complete(bar, b.x, nloc, nx); b.st[0] = nloc; b.st[1] = nx; }
        const unsigned old = xb_add(&bar[XB_XSUB(b.x)], 1u);
        const unsigned gen = old / nloc;
        if (old + 1u == (gen + 1u) * nloc) {
            __builtin_amdgcn_fence(__ATOMIC_RELEASE, "agent");
            asm volatile("s_waitcnt vmcnt(0)" ::: "memory");
            const unsigned og = xb_add(&bar[XB_TOP], 1u);
            const unsigned tg = og / nx;
            if (og + 1u == (tg + 1u) * nx) xb_add(&bar[XB_TOPGEN], 1u);
            else XB_SPIN(xb_ld(&bar[XB_TOPGEN]) == tg, bar);
            __builtin_amdgcn_fence(__ATOMIC_ACQUIRE, "agent");
            xb_add(&bar[XB_XGEN(b.x)], 1u);
            asm volatile("s_waitcnt vmcnt(0)" ::: "memory");
        } else {
            XB_SPIN(xb_ld(&bar[XB_XGEN(b.x)]) == gen, bar);
            __builtin_amdgcn_fence(__ATOMIC_ACQUIRE, "agent");
            asm volatile("s_waitcnt vmcnt(0)" ::: "memory");
        }
    }
    __syncthreads();
}


struct TJob { const float* src; int K, N; bf16_t* dst; int ldd; };

DEVI TJob get_tjob(const Params& p, int j) {
  TJob t;
  if (j < 26) {
    const int l = j / 13, jj = j % 13;
    const int ib = l ? 33 : 4;
    bf16_t* win = (bf16_t*)(p.ws + (l ? OFF_W3IN : OFF_W0IN));
    bf16_t* wup = (bf16_t*)(p.ws + (l ? OFF_W3UP : OFF_W0UP));
    bf16_t* wout = (bf16_t*)(p.ws + (l ? OFF_W3OUT : OFF_W0OUT));
    if (jj < 4) { t.src = p.in[ib + 3] + (size_t)jj * 1048576; t.K = 1024; t.N = 1024; t.dst = win + (size_t)jj * 1048576; t.ldd = 1024; }
    else if (jj < 8) { const int idx = jj - 4, d = idx >> 1, kind = idx & 1;
      t.src = p.in[ib + 6] + (size_t)idx * 65536; t.K = 1024; t.N = 64; t.dst = win + (size_t)(4096 + kind * 128 + d * 64) * 1024; t.ldd = 1024; }
    else if (jj < 12) { const int idx = jj - 8;
      t.src = p.in[ib + 7] + (size_t)idx * 65536; t.K = 64; t.N = 1024; t.dst = wup + (size_t)idx * 65536; t.ldd = 64; }
    else { t.src = p.in[ib + 11]; t.K = 1024; t.N = 1024; t.dst = wout; t.ldd = 1024; }
  } else if (j == 26) { t.src = p.in[19]; t.K = 1024; t.N = 2816; t.dst = (bf16_t*)(p.ws + OFF_W1IN); t.ldd = 1024; }
  else if (j == 27) { t.src = p.in[25]; t.K = 1408; t.N = 1024; t.dst = (bf16_t*)(p.ws + OFF_W1OUT); t.ldd = 1408; }
  else if (j == 28) { t.src = p.in[29]; t.K = 1024; t.N = 4096; t.dst = (bf16_t*)(p.ws + OFF_W2IN); t.ldd = 1024; }
  else { t.src = p.in[32]; t.K = 1024; t.N = 1024; t.dst = (bf16_t*)(p.ws + OFF_W2OUT); t.ldd = 1024; }
  return t;
}

__device__ __forceinline__ void phase0(const Params& p, char* lds) {
  const int tid = opaque_tid();
  {
    bf16_t* wg = (bf16_t*)(p.ws + OFF_W1G);
    const float* gw = p.in[22];
    const int total = 16 * 4 * 96 * 96;
    for (int e = blockIdx.x * NTHR + tid; e < total; e += gridDim.x * NTHR) {
      const int k = e % 96, n = (e / 96) % 96, dg = (e / 9216) & 3, blk = e / 36864;
      float v = 0.f;
      if (k < 88 && n < 88) v = gw[((size_t)(dg * 16 + blk) * 88 + k) * 88 + n];
      wg[e] = f2bf(v);
    }
  }
  constexpr int N_MOD_ITEMS = 96;
  constexpr int N_TILES = 5152;
  float* act = (float*)lds;
  float* red = (float*)(lds + 36864);
  float* tl = (float*)lds;
  for (int item = blockIdx.x; item < N_MOD_ITEMS; item += gridDim.x) {
    __syncthreads();
    {
      const int L = item / 24, nc = item % 24;
      const int ib = (L == 0) ? 4 : (L == 1) ? 16 : (L == 2) ? 26 : 33;
      const float* ada_w = p.in[ib + 1];
      const float* ada_b = p.in[ib + 2];
      for (int e = tid; e < 9 * 1024; e += NTHR) {
        const int i = e >> 10, k = e & 1023;
        const float c = (i < 8) ? p.in[1][i * 1024 + k] : p.in[3][k];
        act[e] = siluf_(c);
      }
      __syncthreads();
      const int kq = tid >> 7, nl = tid & 127, n = nc * 128 + nl;
      float acc[9];
#pragma unroll
      for (int i = 0; i < 9; ++i) acc[i] = 0.f;
      for (int k0 = kq * 256; k0 < kq * 256 + 256; k0 += 16) {
        float w[16];
#pragma unroll
        for (int u = 0; u < 16; ++u) w[u] = ada_w[(size_t)(k0 + u) * 3072 + n];
#pragma unroll
        for (int u = 0; u < 16; ++u)
#pragma unroll
          for (int i = 0; i < 9; ++i) acc[i] += act[i * 1024 + k0 + u] * w[u];
      }
#pragma unroll
      for (int i = 0; i < 9; ++i) red[(kq * 9 + i) * 128 + nl] = acc[i];
      __syncthreads();
      float* mod = (float*)(p.ws + OFF_MOD) + (size_t)L * 9 * 3072;
      for (int e = tid; e < 9 * 128; e += NTHR) {
        const int i = e >> 7, c = e & 127;
        const float s = red[(0 * 9 + i) * 128 + c] + red[(1 * 9 + i) * 128 + c] + red[(2 * 9 + i) * 128 + c] + red[(3 * 9 + i) * 128 + c];
        mod[i * 3072 + nc * 128 + c] = s + ada_b[nc * 128 + c];
      }
    }
  }
  {
    struct TileRef { const float* src; bf16_t* dst; int N, ldd, k0, n0; };
    auto decode = [&](int t, TileRef& r) {
      int j = 0;
      TJob job = get_tjob(p, 0);
      for (;;) {
        const int nt = (job.K >> 6) * (job.N >> 6);
        if (t < nt) break;
        t -= nt; ++j; job = get_tjob(p, j);
      }
      const int ntn = job.N >> 6;
      r.src = job.src; r.dst = job.dst; r.N = job.N; r.ldd = job.ldd; r.k0 = (t / ntn) * 64; r.n0 = (t % ntn) * 64;
    };
    const int kk = tid >> 4, n4 = (tid & 15) * 4;
    int t = (int)(gridDim.x - 1 - blockIdx.x);
    TileRef cur, nxt;
    float4 v0 = make_float4(0.f, 0.f, 0.f, 0.f), v1 = v0;
    if (t < N_TILES) {
      decode(t, cur);
      v0 = *(const float4*)(cur.src + (size_t)(cur.k0 + kk) * cur.N + cur.n0 + n4);
      v1 = *(const float4*)(cur.src + (size_t)(cur.k0 + kk + 32) * cur.N + cur.n0 + n4);
    }
    while (t < N_TILES) {
      const int tn = t + (int)gridDim.x;
      float4 w0 = v0, w1 = v1;
      if (tn < N_TILES) {
        decode(tn, nxt);
        w0 = *(const float4*)(nxt.src + (size_t)(nxt.k0 + kk) * nxt.N + nxt.n0 + n4);
        w1 = *(const float4*)(nxt.src + (size_t)(nxt.k0 + kk + 32) * nxt.N + nxt.n0 + n4);
      }
      __builtin_amdgcn_sched_barrier(0);
      __syncthreads();
      tl[kk * 65 + n4 + 0] = v0.x; tl[kk * 65 + n4 + 1] = v0.y; tl[kk * 65 + n4 + 2] = v0.z; tl[kk * 65 + n4 + 3] = v0.w;
      tl[(kk + 32) * 65 + n4 + 0] = v1.x; tl[(kk + 32) * 65 + n4 + 1] = v1.y; tl[(kk + 32) * 65 + n4 + 2] = v1.z; tl[(kk + 32) * 65 + n4 + 3] = v1.w;
      __syncthreads();
      const int n = tid >> 3, k8 = (tid & 7) * 8;
      u32x4 o;
      o.x = pk_bf16(tl[(k8 + 0) * 65 + n], tl[(k8 + 1) * 65 + n]);
      o.y = pk_bf16(tl[(k8 + 2) * 65 + n], tl[(k8 + 3) * 65 + n]);
      o.z = pk_bf16(tl[(k8 + 4) * 65 + n], tl[(k8 + 5) * 65 + n]);
      o.w = pk_bf16(tl[(k8 + 6) * 65 + n], tl[(k8 + 7) * 65 + n]);
      *(u32x4*)(cur.dst + (size_t)(cur.n0 + n) * cur.ldd + cur.k0 + k8) = o;
      v0 = w0; v1 = w1; cur = nxt; t = tn;
    }
  }
}

DEVI void norm_row(const float* __restrict__ xr, const float* __restrict__ g, const float* __restrict__ mod, int lane, float (&h)[16]) {
  float4 x[4];
  float ss = 0.f;
#pragma unroll
  for (int i = 0; i < 4; ++i) {
    x[i] = *(const float4*)(xr + lane * 4 + 256 * i);
    ss += x[i].x * x[i].x + x[i].y * x[i].y + x[i].z * x[i].z + x[i].w * x[i].w;
  }
  ss = wave_sum(ss);
  const float rstd = rsqrtf(ss * (1.f / 1024.f) + 1e-6f);
#pragma unroll
  for (int i = 0; i < 4; ++i) {
    const int c = lane * 4 + 256 * i;
    const float4 gg = *(const float4*)(g + c);
    const float4 sh = *(const float4*)(mod + c);
    const float4 sc = *(const float4*)(mod + 1024 + c);
    h[i * 4 + 0] = x[i].x * rstd * gg.x * (1.f + sc.x) + sh.x;
    h[i * 4 + 1] = x[i].y * rstd * gg.y * (1.f + sc.y) + sh.y;
    h[i * 4 + 2] = x[i].z * rstd * gg.z * (1.f + sc.z) + sh.z;
    h[i * 4 + 3] = x[i].w * rstd * gg.w * (1.f + sc.w) + sh.w;
  }
}

template <bool WITH_HS>
__device__ __forceinline__ void norm_phase(const float* __restrict__ xl, const float* __restrict__ xc, const float* __restrict__ g,
                           const float* __restrict__ modL, bf16_t* __restrict__ H, bf16_t* __restrict__ HS) {
  const int tidx = opaque_tid();
  const int lane = tidx & 63;
  const int gw = blockIdx.x * (NTHR / 64) + (tidx >> 6), nw = gridDim.x * (NTHR / 64);
  for (int row = gw; row < MT; row += nw) {
    const bool lat = row < ML;
    const float* xbase = lat ? xl + (size_t)row * 1024 : xc + (size_t)(row - ML) * 1024;
    const float* mod = modL + (lat ? (row >> 12) : 8) * 3072;
    float h[16];
    norm_row(xbase, g, mod, lane, h);
#pragma unroll
    for (int i = 0; i < 4; ++i) {
      u32x2 o; o.x = pk_bf16(h[i * 4], h[i * 4 + 1]); o.y = pk_bf16(h[i * 4 + 2], h[i * 4 + 3]);
      *(u32x2*)(H + (size_t)row * 1024 + lane * 4 + 256 * i) = o;
    }
    if (WITH_HS) {
      const int t = lat ? (row & 4095) : ((row - ML) & 255);
      const int T = lat ? 4096 : 256;
      float s[16];
#pragma unroll
      for (int i = 0; i < 16; ++i) s[i] = 0.f;
      if (t > 0) { float hp[16]; norm_row(xbase - 1024, g, mod, lane, hp);
#pragma unroll
        for (int i = 0; i < 16; ++i) s[i] += hp[i]; }
      if (t < T - 1) { float hn[16]; norm_row(xbase + 1024, g, mod, lane, hn);
#pragma unroll
        for (int i = 0; i < 16; ++i) s[i] += hn[i]; }
#pragma unroll
      for (int i = 0; i < 4; ++i) {
        u32x2 o; o.x = pk_bf16(0.5f * s[i * 4], 0.5f * s[i * 4 + 1]); o.y = pk_bf16(0.5f * s[i * 4 + 2], 0.5f * s[i * 4 + 3]);
        *(u32x2*)(HS + (size_t)row * 1024 + lane * 4 + 256 * i) = o;
      }
    }
  }
}

struct ALPlain {
  const bf16_t* A; int lda;
  typedef u32x4 Regs;
  DEVI void stage(float*, int) const {}
  DEVI void issue(Regs& r, int row, int k) const { r = *(const u32x4*)(A + (size_t)row * lda + k); }
  DEVI u32x4 finish(const Regs& r, const float*, int) const { return r; }
};
struct ALMix {
  const bf16_t* H; const bf16_t* HS; const float* mu;
  struct Regs { u32x4 h, s; };
  DEVI void stage(float* sMu, int n0) const {
    const int grp = n0 >> 10;
    const int j = grp == 0 ? 0 : grp == 1 ? 2 : grp == 2 ? 3 : grp == 3 ? 5 : (n0 - 4096) < 128 ? 1 : 4;
    for (int e = threadIdx.x; e < 1024; e += NTHR) sMu[e] = mu[j * 1024 + e];
  }
  DEVI void issue(Regs& r, int row, int k) const {
    r.h = *(const u32x4*)(H + (size_t)row * 1024 + k);
    r.s = *(const u32x4*)(HS + (size_t)row * 1024 + k);
  }
  DEVI unsigned mix2(unsigned h, unsigned s, float m0, float m1) const {
    const float h0 = bf_lo(h), h1 = bf_hi(h), s0 = bf_lo(s), s1 = bf_hi(s);
    return pk_bf16(h0 + (s0 - h0) * m0, h1 + (s1 - h1) * m1);
  }
  DEVI u32x4 finish(const Regs& r, const float* sMu, int k) const {
    const float4 ma = *(const float4*)(sMu + k), mb = *(const float4*)(sMu + k + 4);
    u32x4 o;
    o.x = mix2(r.h.x, r.s.x, ma.x, ma.y); o.y = mix2(r.h.y, r.s.y, ma.z, ma.w);
    o.z = mix2(r.h.z, r.s.z, mb.x, mb.y); o.w = mix2(r.h.w, r.s.w, mb.z, mb.w);
    return o;
  }
};

template <class AL, class EP>
__device__ __forceinline__ void gemm_phase(char* lds, const bf16_t* __restrict__ Bt, int K, int mtiles, int ntiles, const AL al, const EP ep, int n_base = 0, bool reverse = false, int mt_base = 0) {
  bf16_t* sA = (bf16_t*)lds;
  bf16_t* sB = (bf16_t*)(lds + 73728);
  float* sMu = (float*)(lds + 110592);
  const int tid = opaque_tid(), lane = tid & 63, wv = tid >> 6, wm = wv >> 1, wn = wv & 1;
  const int l31 = lane & 31, lh = lane >> 5;
  const int nk = K >> 6;
  const int ldrow = tid >> 3, ldk = (tid & 7) * 8;
  const int total = mtiles * ntiles;
  const int bid = reverse ? (int)(gridDim.x - 1 - blockIdx.x) : (int)blockIdx.x;
  const int nslots = gridDim.x >> 3, xcd = bid & 7, slot = bid >> 3;
  const int gm = 4 * ntiles;
  for (int chunk = xcd; chunk * nslots < total; chunk += 8) {
    const int tile = chunk * nslots + slot;
    if (tile >= total) break;
    const int grp = tile / gm, rem = tile - grp * gm;
    const int mt = grp * 4 + (rem & 3), nt = rem >> 2;
    const int m0 = (mt_base + mt) * 256, n0 = n_base + nt * 128;
    __syncthreads();
    al.stage(sMu, n0);
    f32x16 acc[2][2];
#pragma unroll
    for (int a = 0; a < 2; ++a)
#pragma unroll
      for (int b = 0; b < 2; ++b)
#pragma unroll
        for (int r = 0; r < 16; ++r) acc[a][b][r] = 0.f;
    typename AL::Regs ar[4];
    u32x4 br[2];
#pragma unroll
    for (int i = 0; i < 4; ++i) al.issue(ar[i], m0 + ldrow + 64 * i, ldk);
#pragma unroll
    for (int i = 0; i < 2; ++i) br[i] = *(const u32x4*)(Bt + (size_t)(n0 + ldrow + 64 * i) * K + ldk);
    __syncthreads();
#pragma unroll
    for (int i = 0; i < 4; ++i) *(u32x4*)(sA + (ldrow + 64 * i) * 72 + ldk) = al.finish(ar[i], sMu, ldk);
#pragma unroll
    for (int i = 0; i < 2; ++i) *(u32x4*)(sB + (ldrow + 64 * i) * 72 + ldk) = br[i];
    __syncthreads();
    for (int kt = 0; kt < nk; ++kt) {
      const int cur = kt & 1;
      const bool more = (kt + 1) < nk;
      const int k0n = (kt + 1) * 64 + ldk;
      if (more) {
#pragma unroll
        for (int i = 0; i < 4; ++i) al.issue(ar[i], m0 + ldrow + 64 * i, k0n);
#pragma unroll
        for (int i = 0; i < 2; ++i) br[i] = *(const u32x4*)(Bt + (size_t)(n0 + ldrow + 64 * i) * K + k0n);
      }
      __builtin_amdgcn_sched_barrier(0);
      const bf16_t* a_ = sA + cur * (256 * 72);
      const bf16_t* b_ = sB + cur * (128 * 72);
#pragma unroll
      for (int kk = 0; kk < 4; ++kk) {
        u32x4 af[2], bfr[2];
#pragma unroll
        for (int mi = 0; mi < 2; ++mi) af[mi] = *(const u32x4*)(a_ + (wm * 64 + mi * 32 + l31) * 72 + kk * 16 + lh * 8);
#pragma unroll
        for (int ni = 0; ni < 2; ++ni) bfr[ni] = *(const u32x4*)(b_ + (wn * 64 + ni * 32 + l31) * 72 + kk * 16 + lh * 8);
#pragma unroll
        for (int mi = 0; mi < 2; ++mi)
#pragma unroll
          for (int ni = 0; ni < 2; ++ni) acc[mi][ni] = mfma32(bfr[ni], af[mi], acc[mi][ni]);
      }
      __builtin_amdgcn_sched_barrier(0);
      if (more) {
        bf16_t* an = sA + (cur ^ 1) * (256 * 72);
        bf16_t* bn = sB + (cur ^ 1) * (128 * 72);
#pragma unroll
        for (int i = 0; i < 4; ++i) *(u32x4*)(an + (ldrow + 64 * i) * 72 + ldk) = al.finish(ar[i], sMu, k0n);
#pragma unroll
        for (int i = 0; i < 2; ++i) *(u32x4*)(bn + (ldrow + 64 * i) * 72 + ldk) = br[i];
      }
      __syncthreads();
    }
#pragma unroll
    for (int mi = 0; mi < 2; ++mi)
#pragma unroll
      for (int ni = 0; ni < 2; ++ni)
#pragma unroll
        for (int q = 0; q < 4; ++q) {
          const int row = m0 + wm * 64 + mi * 32 + l31;
          const int col = n0 + wn * 64 + ni * 32 + 8 * q + 4 * lh;
          f32x4 v = {acc[mi][ni][4 * q], acc[mi][ni][4 * q + 1], acc[mi][ni][4 * q + 2], acc[mi][ni][4 * q + 3]};
          ep(row, col, v);
        }
  }
}


template <class AL, class EP>
__device__ __forceinline__ void gemm256_phase(char* lds, const bf16_t* __restrict__ Bt, int K, int mtiles, int ntiles, const AL al, const EP ep) {
  bf16_t* sA = (bf16_t*)lds;
  bf16_t* sB = (bf16_t*)(lds + 73728);
  float* sMu = (float*)(lds + 147456);
  const int tid = opaque_tid(), lane = tid & 63, wv = tid >> 6, wm = wv >> 1, wn = wv & 1;
  const int l31 = lane & 31, lh = lane >> 5;
  const int nk = K >> 6;
  const int ldrow = tid >> 3, ldk = (tid & 7) * 8;
  const int total = mtiles * ntiles;
  const int nslots = gridDim.x >> 3, xcd = blockIdx.x & 7, slot = blockIdx.x >> 3;
  const int gm = 4 * ntiles;
  for (int chunk = xcd; chunk * nslots < total; chunk += 8) {
    const int tile = chunk * nslots + slot;
    if (tile >= total) break;
    const int grp = tile / gm, rem = tile - grp * gm;
    const int mt = grp * 4 + (rem & 3), nt = rem >> 2;
    const int m0 = mt * 256, n0 = nt * 256;
    __syncthreads();
    al.stage(sMu, n0);
    f32x16 acc[2][4];
#pragma unroll
    for (int a = 0; a < 2; ++a)
#pragma unroll
      for (int b = 0; b < 4; ++b)
#pragma unroll
        for (int r = 0; r < 16; ++r) acc[a][b][r] = 0.f;
    typename AL::Regs ar[4];
    u32x4 br[4];
#pragma unroll
    for (int i = 0; i < 4; ++i) al.issue(ar[i], m0 + ldrow + 64 * i, ldk);
#pragma unroll
    for (int i = 0; i < 4; ++i) br[i] = *(const u32x4*)(Bt + (size_t)(n0 + ldrow + 64 * i) * K + ldk);
    __syncthreads();
#pragma unroll
    for (int i = 0; i < 4; ++i) *(u32x4*)(sA + (ldrow + 64 * i) * 72 + ldk) = al.finish(ar[i], sMu, ldk);
#pragma unroll
    for (int i = 0; i < 4; ++i) *(u32x4*)(sB + (ldrow + 64 * i) * 72 + ldk) = br[i];
    __syncthreads();
    const int half = __builtin_amdgcn_readfirstlane(wv >> 2);
    if (half == 1 && nk > 1) {
#pragma unroll
      for (int i = 0; i < 4; ++i) al.issue(ar[i], m0 + ldrow + 64 * i, 64 + ldk);
#pragma unroll
      for (int i = 0; i < 4; ++i) br[i] = *(const u32x4*)(Bt + (size_t)(n0 + ldrow + 64 * i) * K + 64 + ldk);
    }
    for (int step = 0; step < 2 * nk; ++step) {
      const int kc = step >> 1;
      if ((step & 1) == half) {
        const int kl = kc + 1 + half;
        if (kl < nk) {
          const int k0n = kl * 64 + ldk;
#pragma unroll
          for (int i = 0; i < 4; ++i) al.issue(ar[i], m0 + ldrow + 64 * i, k0n);
#pragma unroll
          for (int i = 0; i < 4; ++i) br[i] = *(const u32x4*)(Bt + (size_t)(n0 + ldrow + 64 * i) * K + k0n);
        }
        __builtin_amdgcn_sched_barrier(0);
        const bf16_t* a_ = sA + (kc & 1) * (256 * 72);
        const bf16_t* b_ = sB + (kc & 1) * (256 * 72);
#pragma unroll
        for (int kk = 0; kk < 4; ++kk) {
          u32x4 af[2];
#pragma unroll
          for (int mi = 0; mi < 2; ++mi) af[mi] = *(const u32x4*)(a_ + (wm * 64 + mi * 32 + l31) * 72 + kk * 16 + lh * 8);
#pragma unroll
          for (int ni = 0; ni < 4; ++ni) {
            const u32x4 bfr = *(const u32x4*)(b_ + (wn * 128 + ni * 32 + l31) * 72 + kk * 16 + lh * 8);
#pragma unroll
            for (int mi = 0; mi < 2; ++mi) acc[mi][ni] = mfma32(bfr, af[mi], acc[mi][ni]);
          }
        }
        __builtin_amdgcn_sched_barrier(0);
      } else {
        const int kf = kc + 1;
        if (kf < nk) {
          bf16_t* an = sA + (kf & 1) * (256 * 72);
          bf16_t* bn = sB + (kf & 1) * (256 * 72);
          const int k0n = kf * 64 + ldk;
#pragma unroll
          for (int i = 0; i < 4; ++i) *(u32x4*)(an + (ldrow + 64 * i) * 72 + ldk) = al.finish(ar[i], sMu, k0n);
#pragma unroll
          for (int i = 0; i < 4; ++i) *(u32x4*)(bn + (ldrow + 64 * i) * 72 + ldk) = br[i];
        }
      }
      __syncthreads();
    }
    if constexpr (EP::VIA_LDS) {
      float* reg = (float*)(lds + wv * 16896);
#pragma unroll
      for (int mi = 0; mi < 2; ++mi) {
#pragma unroll
        for (int ni = 0; ni < 4; ++ni)
#pragma unroll
          for (int q = 0; q < 4; ++q) {
            f32x4 v = {acc[mi][ni][4 * q], acc[mi][ni][4 * q + 1], acc[mi][ni][4 * q + 2], acc[mi][ni][4 * q + 3]};
            *(f32x4*)(reg + l31 * 132 + ni * 32 + 8 * q + 4 * lh) = v;
          }
#pragma unroll 4
        for (int it = 0; it < 16; ++it) {
          const int rl = it * 2 + lh;
          const f32x4 v = *(const f32x4*)(reg + rl * 132 + l31 * 4);
          ep(m0 + wm * 64 + mi * 32 + rl, n0 + wn * 128 + l31 * 4, v);
        }
      }
    } else
#pragma unroll
    for (int mi = 0; mi < 2; ++mi)
#pragma unroll
      for (int ni = 0; ni < 4; ++ni) {
#pragma unroll
        for (int q = 0; q < 4; ++q) {
          const int row = m0 + wm * 64 + mi * 32 + l31;
          const int col = n0 + wn * 128 + ni * 32 + 8 * q + 4 * lh;
          f32x4 v = {acc[mi][ni][4 * q], acc[mi][ni][4 * q + 1], acc[mi][ni][4 * q + 2], acc[mi][ni][4 * q + 3]};
          ep(row, col, v);
        }
        __builtin_amdgcn_sched_barrier(0);
      }
  }
}

DEVI void st_bf16x4(bf16_t* p, f32x4 v) { u32x2 o; o.x = pk_bf16(v[0], v[1]); o.y = pk_bf16(v[2], v[3]); *(u32x2*)p = o; }

struct EpRwkvIn {
  static constexpr bool VIA_LDS = false;
  bf16_t *R, *K, *V, *G, *WD, *AD;
  DEVI void operator()(int row, int col, f32x4 v) const {
    const int grp = col >> 10;
    if (grp < 4) {
      const int c = col & 1023;
      bf16_t* dst = grp == 0 ? R : grp == 1 ? K : grp == 2 ? V : G;
      if (grp == 3) { v[0] = siluf_(v[0]); v[1] = siluf_(v[1]); v[2] = siluf_(v[2]); v[3] = siluf_(v[3]); }
      st_bf16x4(dst + (size_t)row * 1024 + c, v);
    } else {
      const int c = col - 4096;
      if (c < 128) {
#pragma unroll
        for (int i = 0; i < 4; ++i) { const float t = __expf(2.f * v[i]); v[i] = 1.f - 2.f / (t + 1.f); }
        st_bf16x4(WD + (size_t)row * 128 + c, v);
      } else st_bf16x4(AD + (size_t)row * 128 + (c - 128), v);
    }
  }
};
struct EpRes {
  static constexpr bool VIA_LDS = false;
  const float* xl_src; const float* xc_src; float* xl_dst; float* xc_dst; const float* modL;
  DEVI void operator()(int row, int col, f32x4 v) const {
    const bool lat = row < ML;
    const size_t off = lat ? (size_t)row * 1024 + col : (size_t)(row - ML) * 1024 + col;
    const float* src = (lat ? xl_src : xc_src) + off;
    float* dst = (lat ? xl_dst : xc_dst) + off;
    const f32x4 g = *(const f32x4*)(modL + (lat ? (row >> 12) : 8) * 3072 + 2048 + col);
    f32x4 x = *(const f32x4*)src;
    x += g * v;
    *(f32x4*)dst = x;
  }
};
struct EpLruIn {
  static constexpr bool VIA_LDS = false;
  bf16_t *XR, *GG;
  DEVI void operator()(int row, int col, f32x4 v) const {
    if (col < LW) st_bf16x4(XR + (size_t)row * LW + col, v);
    else { v[0] = siluf_(v[0]); v[1] = siluf_(v[1]); v[2] = siluf_(v[2]); v[3] = siluf_(v[3]); st_bf16x4(GG + (size_t)row * LW + (col - LW), v); }
  }
};
struct EpNatIn {
  static constexpr bool VIA_LDS = false;
  bf16_t *Q, *K, *VT, *G;
  DEVI void operator()(int row, int col, f32x4 v) const {
    const int grp = col >> 10, c = col & 1023;
    if (grp == 0) st_bf16x4(Q + (size_t)row * 1024 + c, v);
    else if (grp == 1) st_bf16x4(K + (size_t)row * 1024 + c, v);
    else if (grp == 3) { v[0] = siluf_(v[0]); v[1] = siluf_(v[1]); v[2] = siluf_(v[2]); v[3] = siluf_(v[3]); st_bf16x4(G + (size_t)row * 1024 + c, v); }
    else {
      unsigned idx, T;
      if (row < ML) { const unsigned b = row >> 12, t = row & 4095; T = 4096u; idx = ((b * 1024u + (unsigned)c) << 12) + t; }
      else { const unsigned r2 = row - ML; const unsigned b = r2 >> 8, t = r2 & 255; T = 256u; idx = (unsigned)ML * 1024u + ((b * 1024u + (unsigned)c) << 8) + t; }
#pragma unroll
      for (int i = 0; i < 4; ++i) VT[idx + (unsigned)i * T] = f2bf(v[i]);
    }
  }
};

DEVI int rwkv_row(int b, int d, int s) {
  if (s < 256) return ML + b * 256 + (d ? 255 - s : s);
  const int t = s - 256;
  return b * 4096 + (d ? 4095 - t : t);
}

constexpr int PSTR = 456, PREC_Y = 64, PREC_V0 = 192, PREC_V1 = 256, PREC_SC = 320, PREC_BF = 328;
constexpr int TSTR = 388;
struct ScanRec { u32x4 a1, a2; float v0, v1; f32x4 s0, s1; f32x4 ww[4]; u32x2 y[4]; };
DEVI void scan_load(ScanRec& R, const float* rec, int g, int c16, int role_off, int srow) {
  const char* ab = (const char*)(rec + PREC_BF) + role_off + g * 16;
  R.a1 = *(const u32x4*)ab; R.a2 = *(const u32x4*)(ab + 64);
  R.v0 = rec[PREC_V0 + srow]; R.v1 = rec[PREC_V1 + srow];
  R.s0 = *(const f32x4*)(rec + PREC_SC); R.s1 = *(const f32x4*)(rec + PREC_SC + 4);
#pragma unroll
  for (int nt = 0; nt < 4; ++nt) {
    R.ww[nt] = *(const f32x4*)(rec + 16 * nt + 4 * g);
    R.y[nt] = *(const u32x2*)((const char*)(rec + PREC_Y) + (16 * nt + c16) * 8);
  }
}
DEVI void scan_step2(f32x4 (&S)[4], const ScanRec& R, bool g0, float* yout) {
  const u32x4 b1 = mk4(pk_bf16(S[0][0], S[0][1]), pk_bf16(S[0][2], S[0][3]), pk_bf16(S[1][0], S[1][1]), pk_bf16(S[1][2], S[1][3]));
  const u32x4 b2 = mk4(pk_bf16(S[2][0], S[2][1]), pk_bf16(S[2][2], S[2][3]), pk_bf16(S[3][0], S[3][1]), pk_bf16(S[3][2], S[3][3]));
  f32x4 D = {0.f, 0.f, 0.f, 0.f};
  D = mfma16(R.a1, b1, D);
  D = mfma16(R.a2, b2, D);
  const float v0 = R.v0, v1 = R.v1;
  const float sa0 = D[0];
  const float sa1 = D[2] + sa0 * R.s0[2] + v0 * R.s0[3];
  const unsigned x0 = pk_bf16(sa0, v0), x1 = pk_bf16(sa1, v1);
  const u32x4 xb = mk4(g0 ? x0 : 0u, g0 ? x1 : 0u, 0u, 0u);
#pragma unroll
  for (int nt = 0; nt < 4; ++nt) S[nt] = mfma16(mk4(R.y[nt].x, R.y[nt].y, 0u, 0u), xb, S[nt] * R.ww[nt]);
  yout[0] = D[1] + sa0 * R.s0[0] + v0 * R.s0[1];
  yout[256] = D[3] + sa0 * R.s1[0] + v0 * R.s1[1] + sa1 * R.s1[2] + v1 * R.s1[3];
}
DEVI float sum16(float v) { v = sum8(v); v += dpp_f<0x140>(v); return v; }

__device__ __forceinline__ void rwkv_scan_phase(char* lds, const bf16_t* __restrict__ R, const bf16_t* __restrict__ Kb, const bf16_t* __restrict__ V,
                                const bf16_t* __restrict__ WD, const bf16_t* __restrict__ AD, const bf16_t* __restrict__ Wup,
                                const float* __restrict__ b0, const float* __restrict__ k_ka, const float* __restrict__ r_k,
                                bf16_t* __restrict__ Y0, bf16_t* __restrict__ Y1, float* __restrict__ BON) {
  float* stepbuf = (float*)lds;
  float* tokbuf = stepbuf + 2 * 8 * PSTR;
  float* wabuf = tokbuf + 2 * 16 * TSTR;
  float* ybuf = wabuf + 4096;
  const int tid = opaque_tid(), lane = tid & 63, wv = tid >> 6;
  constexpr int NCH = (256 + 4096) / 16;
  for (int chain = blockIdx.x; chain < 256; chain += gridDim.x) {
    const int d = chain & 1, h = (chain >> 1) & 15, b = chain >> 5;
    __syncthreads();
    if (wv < 4) {
      const int kq = lane >> 4, c16 = lane & 15, srow = wv * 16 + c16;
      const int role_off = (lane & 3) * 128;
      const bool g0 = kq == 0;
      f32x4 S[4];
#pragma unroll
      for (int j = 0; j < 4; ++j) S[j] = (f32x4){0.f, 0.f, 0.f, 0.f};
      __syncthreads();
      __syncthreads();
      __syncthreads();
      for (int c = 0; c < NCH; ++c) {
        const float* sb = stepbuf + (c & 1) * 8 * PSTR;
        float* yb = ybuf + (c & 1) * 4096 + kq * 64 + srow;
        ScanRec ra, rb;
        scan_load(ra, sb, kq, c16, role_off, srow);
#pragma unroll
        for (int i = 0; i < 4; i += 2) {
          scan_load(rb, sb + (i + 1) * PSTR, kq, c16, role_off, srow);
          scan_step2(S, ra, g0, yb + i * 512);
          scan_load(ra, sb + (i + 2) * PSTR, kq, c16, role_off, srow);
          scan_step2(S, rb, g0, yb + (i + 1) * 512);
        }
#pragma unroll
        for (int i = 4; i < 8; i += 2) {
          scan_load(rb, sb + (i + 1) * PSTR, kq, c16, role_off, srow);
          scan_step2(S, ra, g0, yb + i * 512);
          if (i + 2 < 8) scan_load(ra, sb + (i + 2) * PSTR, kq, c16, role_off, srow);
          scan_step2(S, rb, g0, yb + (i + 1) * 512);
        }
        __syncthreads();
      }
    } else {
      const int ptid = tid - 256, pw = wv - 4;
      bf16_t* Y = d ? Y1 : Y0;
      const int ncol = h * 64 + pw * 16 + (lane & 15);
      u32x4 bu[2][2];
      float bias_u[2];
#pragma unroll
      for (int kind = 0; kind < 2; ++kind) {
        const bf16_t* wu = Wup + ((size_t)(d * 2 + kind) * 1024 + ncol) * 64 + 8 * (lane >> 4);
        bu[kind][0] = *(const u32x4*)wu; bu[kind][1] = *(const u32x4*)(wu + 32);
        bias_u[kind] = b0[(d * 2 + kind) * 1024 + ncol];
      }
      const int ti = ptid >> 4, dq = ptid & 15;
      const int hc = h * 64 + 4 * dq;
      const f32x4 kkv = *(const f32x4*)(k_ka + hc), kav = *(const f32x4*)(k_ka + 1024 + hc), rkv = *(const f32x4*)(r_k + hc);
      u32x4 xw0, xw1, xa0, xa1; u32x2 rr, kr, vr;
      auto issueL = [&](int c) {
        const int rowA = rwkv_row(b, d, c * 16 + (lane & 15));
        const bf16_t* xp = WD + (size_t)rowA * 128 + d * 64 + 8 * (lane >> 4);
        const bf16_t* xq = AD + (size_t)rowA * 128 + d * 64 + 8 * (lane >> 4);
        xw0 = *(const u32x4*)xp; xw1 = *(const u32x4*)(xp + 32);
        xa0 = *(const u32x4*)xq; xa1 = *(const u32x4*)(xq + 32);
      };
      auto issueT = [&](int c) {
        const int rowB = rwkv_row(b, d, c * 16 + ti);
        rr = *(const u32x2*)(R + (size_t)rowB * 1024 + hc);
        kr = *(const u32x2*)(Kb + (size_t)rowB * 1024 + hc);
        vr = *(const u32x2*)(V + (size_t)rowB * 1024 + hc);
      };
      auto stepA = [&](int c) {
        float* wbuf = wabuf + (c & 1) * 2048; float* abuf = wbuf + 1024;
        f32x4 accw = {0.f, 0.f, 0.f, 0.f}, acca = {0.f, 0.f, 0.f, 0.f};
        accw = mfma16(xw0, bu[0][0], accw); accw = mfma16(xw1, bu[0][1], accw);
        acca = mfma16(xa0, bu[1][0], acca); acca = mfma16(xa1, bu[1][1], acca);
#pragma unroll
        for (int r = 0; r < 4; ++r) {
          const int o = ((lane >> 4) * 4 + r) * 64 + pw * 16 + (lane & 15);
          const float x = -(accw[r] + bias_u[0]);
          const float sp = fmaxf(x, 0.f) + 0.6931471805599453f * __builtin_amdgcn_logf(1.f + __builtin_amdgcn_exp2f(-1.4426950408889634f * fabsf(x)));
          const float ew = __builtin_amdgcn_exp2f(-1.4426950408889634f * (sp + 0.5f));
          wbuf[o] = __builtin_amdgcn_exp2f(-1.4426950408889634f * ew);
          abuf[o] = __builtin_amdgcn_rcpf(1.f + __builtin_amdgcn_exp2f(-1.4426950408889634f * (acca[r] + bias_u[1])));
        }
      };
      auto stepB1 = [&](int c) {
        const float rv[4] = {bf_lo(rr.x), bf_hi(rr.x), bf_lo(rr.y), bf_hi(rr.y)};
        const float kv[4] = {bf_lo(kr.x), bf_hi(kr.x), bf_lo(kr.y), bf_hi(kr.y)};
        const float vv[4] = {bf_lo(vr.x), bf_hi(vr.x), bf_lo(vr.y), bf_hi(vr.y)};
        const float* wbuf = wabuf + (c & 1) * 2048; const float* abuf = wbuf + 1024;
        const f32x4 av = *(const f32x4*)(abuf + ti * 64 + 4 * dq), wv4 = *(const f32x4*)(wbuf + ti * 64 + 4 * dq);
        float q[4], ss = 0.f;
#pragma unroll
        for (int i = 0; i < 4; ++i) { q[i] = kv[i] * kkv[i]; ss += q[i] * q[i]; }
        ss = sum16(ss);
        const float inv = __builtin_amdgcn_rsqf(fmaxf(ss, 1e-24f));
        f32x4 nk, wrr, ka, kd, vo;
        float c1 = 0.f, c2 = 0.f, bn = 0.f;
#pragma unroll
        for (int i = 0; i < 4; ++i) {
          const float n = q[i] * inv;
          kd[i] = kv[i] * (1.f + (av[i] - 1.f) * kav[i]);
          ka[i] = n * av[i];
          nk[i] = -n; wrr[i] = wv4[i] * rv[i]; vo[i] = vv[i];
          c1 += ka[i] * rv[i]; c2 += kd[i] * rv[i]; bn += rv[i] * kd[i] * rkv[i];
        }
        c1 = sum16(c1); c2 = sum16(c2); bn = sum16(bn);
        float* rec = tokbuf + ((c & 1) * 16 + ti) * TSTR;
        *(f32x4*)(rec + 4 * dq) = nk;
        *(f32x4*)(rec + 64 + 4 * dq) = wrr;
        *(f32x4*)(rec + 128 + 4 * dq) = wv4;
        *(f32x4*)(rec + 192 + 4 * dq) = ka;
        *(f32x4*)(rec + 256 + 4 * dq) = kd;
        *(f32x4*)(rec + 320 + 4 * dq) = vo;
        if (dq == 0) {
          *(f32x2*)(rec + 384) = (f32x2){c1, c2};
          BON[((size_t)d * MT + rwkv_row(b, d, c * 16 + ti)) * 16 + h] = bn;
        }
      };
      auto stepB2 = [&](int c) {
        const int pp = ptid >> 5, dp = ptid & 31;
        const float* t0 = tokbuf + ((c & 1) * 16 + 2 * pp) * TSTR + 2 * dp;
        const float* t1 = t0 + TSTR;
        const f32x2 a0 = *(const f32x2*)(t0), wr0 = *(const f32x2*)(t0 + 64), w0 = *(const f32x2*)(t0 + 128);
        const f32x2 b0_ = *(const f32x2*)(t0 + 192), k0_ = *(const f32x2*)(t0 + 256), v0 = *(const f32x2*)(t0 + 320);
        const f32x2 a1 = *(const f32x2*)(t1), wr1 = *(const f32x2*)(t1 + 64), w1 = *(const f32x2*)(t1 + 128);
        const f32x2 b1_ = *(const f32x2*)(t1 + 192), k1_ = *(const f32x2*)(t1 + 256), v1 = *(const f32x2*)(t1 + 320);
        float c3 = b0_[0] * a1[0] + b0_[1] * a1[1], c4 = k0_[0] * a1[0] + k0_[1] * a1[1];
        float c5 = b0_[0] * wr1[0] + b0_[1] * wr1[1], c6 = k0_[0] * wr1[0] + k0_[1] * wr1[1];
        c3 = sum16(c3); c4 = sum16(c4); c5 = sum16(c5); c6 = sum16(c6);
        c3 += __shfl_xor(c3, 16); c4 += __shfl_xor(c4, 16); c5 += __shfl_xor(c5, 16); c6 += __shfl_xor(c6, 16);
        float* rec = stepbuf + ((c & 1) * 8 + pp) * PSTR;
        *(f32x2*)(rec + 2 * dp) = w0 * w1;
        {
          const f32x2 bw = b0_ * w1, kw = k0_ * w1;
          *(u32x4*)((char*)(rec + PREC_Y) + 16 * dp) = mk4(pk_bf16(bw[0], kw[0]), pk_bf16(b1_[0], k1_[0]), pk_bf16(bw[1], kw[1]), pk_bf16(b1_[1], k1_[1]));
        }
        *(f32x2*)(rec + PREC_V0 + 2 * dp) = v0;
        *(f32x2*)(rec + PREC_V1 + 2 * dp) = v1;
        unsigned* bb = (unsigned*)(rec + PREC_BF);
        const f32x2 wa = w0 * a1, wwr = w0 * wr1;
        const int kk = (2 * dp) & 31;
        const int pos = ((2 * dp) & 32) + (kk < 16 ? 8 * (kk >> 2) + (kk & 3) : 8 * ((kk - 16) >> 2) + 4 + (kk & 3));
        const int pu = pos >> 1;
        bb[pu] = pk_bf16(a0[0], a0[1]);
        bb[32 + pu] = pk_bf16(wr0[0], wr0[1]);
        bb[64 + pu] = pk_bf16(wa[0], wa[1]);
        bb[96 + pu] = pk_bf16(wwr[0], wwr[1]);
        if (dp == 0) {
          const f32x2 cc0 = *(const f32x2*)(t0 + 384), cc1 = *(const f32x2*)(t1 + 384);
          *(f32x4*)(rec + PREC_SC) = (f32x4){cc0[0], cc0[1], c3, c4};
          *(f32x4*)(rec + PREC_SC + 4) = (f32x4){c5, c6, cc1[0], cc1[1]};
        }
      };
      auto storeY = [&](int c) {
        const f32x4 yv = *(const f32x4*)(ybuf + (c & 1) * 4096 + ti * 256 + 4 * dq);
        u32x2 o; o.x = pk_bf16(yv[0], yv[1]); o.y = pk_bf16(yv[2], yv[3]);
        *(u32x2*)(Y + (size_t)rwkv_row(b, d, c * 16 + ti) * 1024 + hc) = o;
      };
      issueL(0); issueT(0);
      stepA(0);
      issueL(1);
      __syncthreads();
      stepB1(0); issueT(1);
      stepA(1); issueL(2);
      __syncthreads();
      stepB2(0);
      stepB1(1); issueT(2);
      stepA(2); issueL(3);
      __builtin_amdgcn_sched_barrier(0);
      __syncthreads();
      __builtin_amdgcn_sched_barrier(0);
      for (int c = 0; c < NCH; ++c) {
        if (c + 3 < NCH) stepA(c + 3);
        if (c + 4 < NCH) issueL(c + 4);
        if (c + 2 < NCH) stepB1(c + 2);
        if (c + 3 < NCH) issueT(c + 3);
        if (c + 1 < NCH) stepB2(c + 1);
        if (c >= 1) storeY(c - 1);
        __builtin_amdgcn_sched_barrier(0);
        __syncthreads();
        __builtin_amdgcn_sched_barrier(0);
      }
      storeY(NCH - 1);
    }
  }
}

__device__ __forceinline__ void rwkv_post_phase(const bf16_t* __restrict__ Y0, const bf16_t* __restrict__ Y1, const bf16_t* __restrict__ V,
                                bf16_t* __restrict__ G, const float* __restrict__ BON, const float* __restrict__ gn, int nrows) {
  const int tidx = opaque_tid();
  const int lane = tidx & 63;
  const int gw = blockIdx.x * (NTHR / 64) + (tidx >> 6), nw = gridDim.x * (NTHR / 64);
  const int head = lane >> 2, c0 = lane * 16;
  for (int row = gw; row < nrows; row += nw) {
    const size_t off = (size_t)row * 1024 + c0;
    float y[16], v[16], g[16];
#pragma unroll
    for (int i = 0; i < 2; ++i) {
      const u32x4 a0 = *(const u32x4*)(Y0 + off + 8 * i), a1 = *(const u32x4*)(Y1 + off + 8 * i);
      const u32x4 av = *(const u32x4*)(V + off + 8 * i), ag = *(const u32x4*)(G + off + 8 * i);
      y[8 * i + 0] = bf_lo(a0.x) + bf_lo(a1.x); y[8 * i + 1] = bf_hi(a0.x) + bf_hi(a1.x);
      y[8 * i + 2] = bf_lo(a0.y) + bf_lo(a1.y); y[8 * i + 3] = bf_hi(a0.y) + bf_hi(a1.y);
      y[8 * i + 4] = bf_lo(a0.z) + bf_lo(a1.z); y[8 * i + 5] = bf_hi(a0.z) + bf_hi(a1.z);
      y[8 * i + 6] = bf_lo(a0.w) + bf_lo(a1.w); y[8 * i + 7] = bf_hi(a0.w) + bf_hi(a1.w);
      v[8 * i + 0] = bf_lo(av.x); v[8 * i + 1] = bf_hi(av.x); v[8 * i + 2] = bf_lo(av.y); v[8 * i + 3] = bf_hi(av.y);
      v[8 * i + 4] = bf_lo(av.z); v[8 * i + 5] = bf_hi(av.z); v[8 * i + 6] = bf_lo(av.w); v[8 * i + 7] = bf_hi(av.w);
      g[8 * i + 0] = bf_lo(ag.x); g[8 * i + 1] = bf_hi(ag.x); g[8 * i + 2] = bf_lo(ag.y); g[8 * i + 3] = bf_hi(ag.y);
      g[8 * i + 4] = bf_lo(ag.z); g[8 * i + 5] = bf_hi(ag.z); g[8 * i + 6] = bf_lo(ag.w); g[8 * i + 7] = bf_hi(ag.w);
    }
    float s = 0.f;
#pragma unroll
    for (int i = 0; i < 16; ++i) s += y[i];
    s += __shfl_xor(s, 1); s += __shfl_xor(s, 2);
    const float mean = s * (1.f / 64.f);
    float q = 0.f;
#pragma unroll
    for (int i = 0; i < 16; ++i) { const float dlt = y[i] - mean; q += dlt * dlt; }
    q += __shfl_xor(q, 1); q += __shfl_xor(q, 2);
    const float rstd = rsqrtf(q * (1.f / 64.f) + 64e-5f);
    const float bonus = BON[(size_t)row * 16 + head] + BON[((size_t)MT + row) * 16 + head];
    unsigned o[8];
#pragma unroll
    for (int i = 0; i < 8; ++i) {
      const float z0 = ((y[2 * i] - mean) * rstd * gn[c0 + 2 * i] + gn[1024 + c0 + 2 * i] + bonus * v[2 * i]) * g[2 * i];
      const float z1 = ((y[2 * i + 1] - mean) * rstd * gn[c0 + 2 * i + 1] + gn[1024 + c0 + 2 * i + 1] + bonus * v[2 * i + 1]) * g[2 * i + 1];
      o[i] = pk_bf16(z0, z1);
    }
    *(u32x4*)(G + off) = mk4(o[0], o[1], o[2], o[3]);
    *(u32x4*)(G + off + 8) = mk4(o[4], o[5], o[6], o[7]);
  }
}

__device__ __forceinline__ void rglru_phase(char* lds, const bf16_t* __restrict__ XR, const bf16_t* __restrict__ Wg, const float* __restrict__ conv_w,
                            const float* __restrict__ conv_b, const float* __restrict__ gate_b, const float* __restrict__ lam,
                            bf16_t* __restrict__ HS0, bf16_t* __restrict__ HS1) {
  bf16_t* xcT = (bf16_t*)lds;
  f32x2* AB = (f32x2*)(lds + 26624);
  bf16_t* raw = (bf16_t*)(lds + 26624);
  float* segP = (float*)(lds + 116736);
  float* segH = segP + 352;
  float* segC = segH + 352;
  bf16_t* wgs = (bf16_t*)(lds + 120960);
  float* cws = (float*)(lds + 160896);
  const int tid = opaque_tid(), lane = tid & 63, wv = tid >> 6;
  for (int chain = blockIdx.x; chain < 256; chain += gridDim.x) {
    const int d = chain & 1, blk = (chain >> 1) & 15, b = chain >> 5;
    bf16_t* HS = d ? HS1 : HS0;
    float carry = 0.f;
    __syncthreads();
    for (int q = tid; q < 2 * 96 * 12; q += NTHR) {
      const int g = q / 1152, rem = q - g * 1152, n = rem / 12, k8 = rem - n * 12;
      *(u32x4*)(wgs + (g * 96 + n) * 104 + k8 * 8) = *(const u32x4*)(Wg + ((size_t)((blk * 4 + d * 2 + g) * 96 + n)) * 96 + k8 * 8);
    }
    for (int e = tid; e < 5 * 88; e += NTHR) {
      const int j = e / 88, c = e - j * 88;
      cws[e] = j < 4 ? conv_w[j * LW + blk * 88 + c] : conv_b[blk * 88 + c];
    }
    for (int e = tid; e < 128 * 8; e += NTHR) xcT[(e >> 3) * 104 + 88 + (e & 7)] = 0;
    u32x4 pre[3];
    auto tile_geom = [&](int ti, int& seqbase, int& t0, int& T) {
      if (ti < 2) { seqbase = ML + b * 256; T = 256; t0 = (d ? 1 - ti : ti) * 128; }
      else { seqbase = b * 4096; T = 4096; t0 = (d ? 31 - (ti - 2) : (ti - 2)) * 128; }
    };
    auto prefetch = [&](int ti) {
      int seqbase, t0, T; tile_geom(ti, seqbase, t0, T);
#pragma unroll
      for (int i = 0; i < 3; ++i) {
        const int q = tid + NTHR * i;
        const int row = q / 11, cc = q - row * 11, t = t0 - 2 + row;
        u32x4 v = {0u, 0u, 0u, 0u};
        if (q < 131 * 11 && t >= 0 && t < T) v = *(const u32x4*)(XR + (size_t)(seqbase + t) * LW + blk * 88 + cc * 8);
        pre[i] = v;
      }
    };
    prefetch(0);
    for (int ti = 0; ti < 34; ++ti) {
      int seqbase, t0, T; tile_geom(ti, seqbase, t0, T);
      __syncthreads();
#pragma unroll
      for (int i = 0; i < 3; ++i) {
        const int q = tid + NTHR * i;
        if (q < 131 * 11) *(u32x4*)(raw + q * 8) = pre[i];
      }
      if (ti + 1 < 34) prefetch(ti + 1);
      __builtin_amdgcn_sched_barrier(0);
      __syncthreads();
      for (int e = tid; e < 128 * 44; e += NTHR) {
        const int tl = e / 44, c2 = (e - tl * 44) * 2;
        float a0 = cws[4 * 88 + c2], a1 = cws[4 * 88 + c2 + 1];
#pragma unroll
        for (int j = 0; j < 4; ++j) {
          const unsigned x = *(const unsigned*)(raw + (tl + j) * 88 + c2);
          a0 += bf_lo(x) * cws[j * 88 + c2]; a1 += bf_hi(x) * cws[j * 88 + c2 + 1];
        }
        *(unsigned*)(xcT + tl * 104 + c2) = pk_bf16(a0, a1);
      }
      __syncthreads();
      {
        const int tok = wv * 16 + (lane & 15);
        u32x4 af[3];
#pragma unroll
        for (int kk = 0; kk < 3; ++kk) af[kk] = *(const u32x4*)(xcT + tok * 104 + kk * 32 + 8 * (lane >> 4));
#pragma unroll
        for (int n6 = 0; n6 < 6; ++n6) {
          f32x4 accr = {0.f, 0.f, 0.f, 0.f}, acci = {0.f, 0.f, 0.f, 0.f};
          const int ncol = n6 * 16 + (lane & 15);
          const bf16_t* wr_ = wgs + ncol * 104 + 8 * (lane >> 4);
          const bf16_t* wi_ = wgs + (96 + ncol) * 104 + 8 * (lane >> 4);
#pragma unroll
          for (int kk = 0; kk < 3; ++kk) {
            accr = mfma16(af[kk], *(const u32x4*)(wr_ + kk * 32), accr);
            acci = mfma16(af[kk], *(const u32x4*)(wi_ + kk * 32), acci);
          }
          if (ncol < 88) {
            const int ch = blk * 88 + ncol;
            const float gbr = gate_b[(d * 2 + 0) * LW + ch], gbi = gate_b[(d * 2 + 1) * LW + ch];
            const float spl = softplusf_(-lam[d * LW + ch]);
#pragma unroll
            for (int r = 0; r < 4; ++r) {
              const int tk = wv * 16 + (lane >> 4) * 4 + r;
              const float rg = sigmoidf_(accr[r] + gbr), ig = sigmoidf_(acci[r] + gbi);
              const float a = __expf(-8.f * rg * spl);
              const float bb = sqrtf(fmaxf(1.f - a * a, 0.f)) * ig * bf2f(xcT[tk * 104 + ncol]);
              AB[tk * 88 + ncol] = (f32x2){a, bb};
            }
          }
        }
      }
      __syncthreads();
      if (tid < 352) {
        const int seg = tid / 88, c = tid - seg * 88;
        float hl = 0.f, P = 1.f;
        for (int u0 = seg * 32; u0 < seg * 32 + 32; u0 += 8) {
          f32x2 ab[8];
#pragma unroll
          for (int i = 0; i < 8; ++i) { const int tl = d ? 127 - (u0 + i) : (u0 + i); ab[i] = AB[tl * 88 + c]; }
#pragma unroll
          for (int i = 0; i < 8; ++i) { hl = ab[i][0] * hl + ab[i][1]; P *= ab[i][0]; ab[i] = (f32x2){hl, P}; }
#pragma unroll
          for (int i = 0; i < 8; ++i) { const int tl = d ? 127 - (u0 + i) : (u0 + i); AB[tl * 88 + c] = ab[i]; }
        }
        segH[seg * 88 + c] = hl; segP[seg * 88 + c] = P;
      }
      __syncthreads();
      if (tid < 88) {
        float cur = carry;
#pragma unroll
        for (int seg = 0; seg < 4; ++seg) { segC[seg * 88 + tid] = cur; cur = segP[seg * 88 + tid] * cur + segH[seg * 88 + tid]; }
        carry = cur;
      }
      __syncthreads();
      for (int q = tid; q < 128 * 11; q += NTHR) {
        const int tl = q / 11, c8 = (q - tl * 11) * 8;
        const int u = d ? 127 - tl : tl;
        const float* sc = segC + (u >> 5) * 88 + c8;
        float hv[8];
#pragma unroll
        for (int i = 0; i < 8; ++i) { const f32x2 hp = AB[tl * 88 + c8 + i]; hv[i] = hp[0] + hp[1] * sc[i]; }
        *(u32x4*)(HS + (size_t)(seqbase + t0 + tl) * LW + blk * 88 + c8) =
            mk4(pk_bf16(hv[0], hv[1]), pk_bf16(hv[2], hv[3]), pk_bf16(hv[4], hv[5]), pk_bf16(hv[6], hv[7]));
      }
    }
  }
}

__device__ __forceinline__ void lru_z_phase(const bf16_t* __restrict__ HS0, const bf16_t* __restrict__ HS1, bf16_t* __restrict__ GG) {
  const size_t n8 = (size_t)MT * LW / 8;
  for (size_t e = (size_t)blockIdx.x * NTHR + threadIdx.x; e < n8; e += (size_t)gridDim.x * NTHR) {
    const u32x4 a = *(const u32x4*)(HS0 + e * 8), b = *(const u32x4*)(HS1 + e * 8), g = *(const u32x4*)(GG + e * 8);
    u32x4 o;
    o.x = pk_bf16((bf_lo(a.x) + bf_lo(b.x)) * bf_lo(g.x), (bf_hi(a.x) + bf_hi(b.x)) * bf_hi(g.x));
    o.y = pk_bf16((bf_lo(a.y) + bf_lo(b.y)) * bf_lo(g.y), (bf_hi(a.y) + bf_hi(b.y)) * bf_hi(g.y));
    o.z = pk_bf16((bf_lo(a.z) + bf_lo(b.z)) * bf_lo(g.z), (bf_hi(a.z) + bf_hi(b.z)) * bf_hi(g.z));
    o.w = pk_bf16((bf_lo(a.w) + bf_lo(b.w)) * bf_lo(g.w), (bf_hi(a.w) + bf_hi(b.w)) * bf_hi(g.w));
    *(u32x4*)(GG + e * 8) = o;
  }
}

__device__ __forceinline__ void nat_qk_phase(bf16_t* __restrict__ Q, bf16_t* __restrict__ Kb, bf16_t* __restrict__ QR, const float* __restrict__ qk_g) {
  const int tidx = opaque_tid();
  const int lane = tidx & 63;
  const int gw = blockIdx.x * (NTHR / 64) + (tidx >> 6), nw = gridDim.x * (NTHR / 64);
  const int qd = lane & 3;
  float gq[16], gk[16], inv[16];
#pragma unroll
  for (int i = 0; i < 16; ++i) { gq[i] = qk_g[qd * 16 + i]; gk[i] = qk_g[64 + qd * 16 + i]; inv[i] = exp2f(-(float)i * (13.287712379549449f / 16.f)); }
  for (int row = gw; row < MT; row += nw) {
    const bool lat = row < ML;
    const size_t off = (size_t)row * 1024 + lane * 16;
    float cs[16], sn[16];
    if (lat) {
      const int t = row & 4095;
      const float pos = (float)((qd >> 1) ? (t & 63) : (t >> 6));
#pragma unroll
      for (int i = 0; i < 16; ++i) {
        float rev = pos * inv[i] * 0.15915494309189535f;
        rev -= floorf(rev);
        sn[i] = __builtin_amdgcn_sinf(rev); cs[i] = __builtin_amdgcn_cosf(rev);
      }
    }
#pragma unroll
    for (int which = 0; which < 2; ++which) {
      bf16_t* P = which ? Kb : Q;
      const u32x4 a = *(const u32x4*)(P + off), b2 = *(const u32x4*)(P + off + 8);
      const unsigned u[8] = {a.x, a.y, a.z, a.w, b2.x, b2.y, b2.z, b2.w};
      float x[16];
#pragma unroll
      for (int i = 0; i < 8; ++i) { x[2 * i] = bf_lo(u[i]); x[2 * i + 1] = bf_hi(u[i]); }
      float ss = 0.f;
#pragma unroll
      for (int i = 0; i < 16; ++i) ss += x[i] * x[i];
      ss += __shfl_xor(ss, 1); ss += __shfl_xor(ss, 2);
      const float rstd = rsqrtf(ss * (1.f / 64.f) + 1e-6f);
#pragma unroll
      for (int i = 0; i < 16; ++i) x[i] = x[i] * rstd * (which ? gk[i] : gq[i]);
      unsigned pl[8];
#pragma unroll
      for (int i = 0; i < 8; ++i) pl[i] = pk_bf16(x[2 * i], x[2 * i + 1]);
      unsigned rt[8];
      if (lat) {
        float y[16];
#pragma unroll
        for (int i = 0; i < 16; ++i) {
          const float pr = __shfl_xor(x[i], 1);
          y[i] = x[i] * cs[i] + ((qd & 1) ? pr * sn[i] : -pr * sn[i]);
        }
#pragma unroll
        for (int i = 0; i < 8; ++i) rt[i] = pk_bf16(y[2 * i], y[2 * i + 1]);
      }
      if (which == 0) {
        *(u32x4*)(Q + off) = mk4(pl[0], pl[1], pl[2], pl[3]);
        *(u32x4*)(Q + off + 8) = mk4(pl[4], pl[5], pl[6], pl[7]);
        if (lat) { *(u32x4*)(QR + off) = mk4(rt[0], rt[1], rt[2], rt[3]); *(u32x4*)(QR + off + 8) = mk4(rt[4], rt[5], rt[6], rt[7]); }
      } else {
        if (lat) { *(u32x4*)(Kb + off) = mk4(rt[0], rt[1], rt[2], rt[3]); *(u32x4*)(Kb + off + 8) = mk4(rt[4], rt[5], rt[6], rt[7]); }
        else { *(u32x4*)(Kb + off) = mk4(pl[0], pl[1], pl[2], pl[3]); *(u32x4*)(Kb + off + 8) = mk4(pl[4], pl[5], pl[6], pl[7]); }
      }
    }
  }
}

struct AttnState { f32x16 O[2][2]; float m[2], l[2]; };

DEVI void attn_load_k(u32x4 (&kf)[4], const bf16_t* __restrict__ kbase, int lane) {
  const int l31 = lane & 31, lh = lane >> 5;
#pragma unroll
  for (int ks = 0; ks < 4; ++ks) kf[ks] = *(const u32x4*)(kbase + (size_t)l31 * 1024 + ks * 16 + 8 * lh);
}

DEVI void attn_compute(AttnState& st, const u32x4* qs, const bf16_t* __restrict__ kbase, const bf16_t* __restrict__ vtbase, int vtT,
                       const float* __restrict__ rpbs, bool band, int brow, int half, int lane) {
  const int l31 = lane & 31, lh = lane >> 5;
  u32x4 kf[4];
  attn_load_k(kf, kbase, lane);
  u32x4 vf[4];
#pragma unroll
  for (int dt = 0; dt < 2; ++dt)
#pragma unroll
    for (int s = 0; s < 2; ++s) {
      const bf16_t* vp = vtbase + (size_t)(dt * 32 + l31) * vtT + 16 * s + 4 * lh;
      const u32x2 lo = *(const u32x2*)vp, hi = *(const u32x2*)(vp + 8);
      vf[dt * 2 + s] = mk4(lo.x, lo.y, hi.x, hi.y);
    }
  __builtin_amdgcn_sched_barrier(0);
  constexpr float SC = 0.125f * 1.4426950408889634f;
  u32x4 pf[2][2];
#pragma unroll
  for (int qt = 0; qt < 2; ++qt) {
    f32x16 S;
#pragma unroll
    for (int r = 0; r < 16; ++r) S[r] = 0.f;
#pragma unroll
    for (int ks = 0; ks < 4; ++ks) S = mfma32(kf[ks], qs[(qt * 4 + ks) * 64], S);
    float cmax = -INFINITY;
    if (band) {
      const int qc = qt * 32 + l31;
      const int cst = min(max(qc - 8, 0), 48);
#pragma unroll
      for (int r = 0; r < 16; ++r) {
        const int key = (r & 3) + 8 * (r >> 2) + 4 * lh;
        const int kc = half * 32 + key;
        const bool ok = (kc >= cst) && (kc < cst + 16);
        const int bi = ok ? (brow * 31 + kc - qc + 15) : 0;
        const float sv = S[r] * SC + rpbs[bi];
        S[r] = ok ? sv : -INFINITY;
        cmax = fmaxf(cmax, S[r]);
      }
    } else {
#pragma unroll
      for (int r = 0; r < 16; ++r) { S[r] *= SC; cmax = fmaxf(cmax, S[r]); }
    }
    cmax = fmaxf(cmax, __shfl_xor(cmax, 32));
    const float mnew = fmaxf(st.m[qt], cmax);
    const float alpha = __builtin_amdgcn_exp2f(st.m[qt] - mnew);
    const bool grew = mnew > st.m[qt];
    st.m[qt] = mnew;
    float ps = 0.f;
#pragma unroll
    for (int r = 0; r < 16; ++r) { S[r] = __builtin_amdgcn_exp2f(S[r] - mnew); ps += S[r]; }
    st.l[qt] = st.l[qt] * alpha + ps;
    if (__any(grew)) {
#pragma unroll
      for (int dt = 0; dt < 2; ++dt)
#pragma unroll
        for (int r = 0; r < 16; ++r) st.O[qt][dt][r] *= alpha;
    }
    pf[qt][0] = mk4(pk_bf16(S[0], S[1]), pk_bf16(S[2], S[3]), pk_bf16(S[4], S[5]), pk_bf16(S[6], S[7]));
    pf[qt][1] = mk4(pk_bf16(S[8], S[9]), pk_bf16(S[10], S[11]), pk_bf16(S[12], S[13]), pk_bf16(S[14], S[15]));
  }
#pragma unroll
  for (int dt = 0; dt < 2; ++dt)
#pragma unroll
    for (int s = 0; s < 2; ++s) {
      st.O[0][dt] = mfma32(vf[dt * 2 + s], pf[0][s], st.O[0][dt]);
      st.O[1][dt] = mfma32(vf[dt * 2 + s], pf[1][s], st.O[1][dt]);
    }
}

__device__ __forceinline__ void natten_phase(char* lds, const bf16_t* __restrict__ Q, const bf16_t* __restrict__ QR, const bf16_t* __restrict__ Kb,
                             const bf16_t* __restrict__ VT, bf16_t* __restrict__ G, const float* __restrict__ rpb, bf16_t* __restrict__ Zd) {
  float* rpbs = (float*)lds;
  __syncthreads();
  for (int e = threadIdx.x; e < 16 * 465; e += NTHR) rpbs[e] = rpb[e] * 1.4426950408889634f;
  __syncthreads();
  const int tidx = opaque_tid();
  const int lane = tidx & 63, l31 = lane & 31, lh = lane >> 5;
  const int gw = blockIdx.x * (NTHR / 64) + (tidx >> 6), nw = gridDim.x * (NTHR / 64);
  const bf16_t* VTC = VT + (size_t)ML * 1024;
  u32x4* qs = (u32x4*)(lds + 32768) + (tidx >> 6) * 512 + lane;
  const int xcd = blockIdx.x & 7, wx = (blockIdx.x >> 3) * (NTHR / 64) + (tidx >> 6), nwx = (gridDim.x >> 3) * (NTHR / 64);
  for (int i = wx; i < 1024 + 64; i += nwx) {
    const bool lat = i < 1024;
    int b, h, r = 0, qrow0;
    if (lat) { const int pair = xcd * 16 + (i >> 6); r = i & 63; b = pair >> 4; h = pair & 15; qrow0 = b * 4096 + r * 64; }
    else { const int it = i - 1024; const int pair = xcd * 16 + (it >> 2); const int qt64 = it & 3; b = pair >> 4; h = pair & 15; qrow0 = ML + b * 256 + qt64 * 64; }
    const int start = min(max(r - 4, 0), 56);
    const int nchunks = lat ? 24 : 8;
    AttnState st;
#pragma unroll
    for (int a = 0; a < 2; ++a) { st.m[a] = -INFINITY; st.l[a] = 0.f;
#pragma unroll
      for (int c = 0; c < 2; ++c)
#pragma unroll
        for (int rr = 0; rr < 16; ++rr) st.O[a][c][rr] = 0.f; }
#pragma unroll
    for (int qt = 0; qt < 2; ++qt)
#pragma unroll
      for (int ks = 0; ks < 4; ++ks) qs[(qt * 4 + ks) * 64] = *(const u32x4*)(Q + (size_t)(qrow0 + qt * 32 + l31) * 1024 + h * 64 + ks * 16 + 8 * lh);
    for (int j = 0; j < nchunks; ++j) {
      if (j == 8) {
#pragma unroll
        for (int qt = 0; qt < 2; ++qt)
#pragma unroll
          for (int ks = 0; ks < 4; ++ks) qs[(qt * 4 + ks) * 64] = *(const u32x4*)(QR + (size_t)(qrow0 + qt * 32 + l31) * 1024 + h * 64 + ks * 16 + 8 * lh);
      }
      const bool band = j >= 8;
      const int ii = j - 8, kr = start + (ii >> 1), half = band ? (ii & 1) : 0;
      const size_t krow = band ? (size_t)(b * 4096 + kr * 64 + half * 32) : (size_t)(ML + b * 256 + j * 32);
      const bf16_t* kbase = Kb + krow * 1024 + h * 64;
      const bf16_t* vtb = band ? VT + (size_t)(b * 16 + h) * 64 * 4096 + kr * 64 + half * 32 : VTC + (size_t)(b * 16 + h) * 64 * 256 + j * 32;
      attn_compute(st, qs, kbase, vtb, band ? 4096 : 256, rpbs, band, band ? h * 15 + (kr - r + 7) : 0, half, lane);
    }
#pragma unroll
    for (int qt = 0; qt < 2; ++qt) {
      const float lt = st.l[qt] + __shfl_xor(st.l[qt], 32);
      const float inv = 1.f / lt;
      bf16_t* grow = G + (size_t)(qrow0 + qt * 32 + l31) * 1024 + h * 64;
#pragma unroll
      for (int dt = 0; dt < 2; ++dt)
#pragma unroll
        for (int q4 = 0; q4 < 4; ++q4) {
          bf16_t* gp = grow + dt * 32 + 8 * q4 + 4 * lh;
          bf16_t* zp = Zd + (gp - G);
          const u32x2 gv = *(const u32x2*)gp;
          u32x2 o;
          o.x = pk_bf16(st.O[qt][dt][4 * q4] * inv * bf_lo(gv.x), st.O[qt][dt][4 * q4 + 1] * inv * bf_hi(gv.x));
          o.y = pk_bf16(st.O[qt][dt][4 * q4 + 2] * inv * bf_lo(gv.y), st.O[qt][dt][4 * q4 + 3] * inv * bf_hi(gv.y));
          *(u32x2*)zp = o;
        }
    }
  }
}

namespace pg8 {
#define PG8_LAS __attribute__((address_space(3)))
typedef unsigned short bf16_t;
typedef short bf16x8 __attribute__((ext_vector_type(8)));
typedef float f32x4 __attribute__((ext_vector_type(4)));
typedef unsigned u32x4 __attribute__((ext_vector_type(4)));
constexpr int BM = 256, BK = 64, HALF = 128, HTB = HALF * BK * 2  , STAGE_BYTES = 8 * HTB, NXCD = 8, WGM = 8;

__host__ __device__ __forceinline__ int lds_byte(int r, int c) { const int st = (r >> 4) * 2 + (c >> 5), rr = r & 15, cc = c & 31, ob = rr * 64 + cc * 2; return st * 1024 + (ob ^ (((ob >> 9) & 1) << 5)); }
__host__ __device__ __forceinline__ void stage_rc(int b, int& R, int& C) { const int st = b / 1024, sb = b % 1024, swz = sb ^ (((sb >> 9) & 1) << 5); R = (st >> 1) * 16 + swz / 64; C = (st & 1) * 32 + (swz % 64) / 2; }
__host__ __device__ __forceinline__ int perm32(int rho) { const int n = rho >> 4, i = rho & 15; return 8 * (i >> 2) + 4 * n + (i & 3); }

struct Unit { int pm, pn; };
struct Gemm { const bf16_t* A; const bf16_t* Bt; int M, N, K; };

struct StaticOrder {
    int nM, nN, nwg, G, c;
    __host__ __device__ void init(int M, int N, int G_, int c_) { nM = M / BM; nN = N / BM; nwg = nM * nN; G = G_; c = c_; }
    __host__ __device__ bool next(int i, Unit& u) const {
        const long L = (long)i * G + c; if (L >= nwg) return false;
        int wgid = (int)L; { const int q = nwg / NXCD, r = nwg % NXCD, xcd = wgid % NXCD, off = wgid / NXCD; wgid = (xcd < r ? xcd * (q + 1) : r * (q + 1) + (xcd - r) * q) + off; }
        const int nig = WGM * nN, gid = wgid / nig, fm = gid * WGM, gsz = (nM - fm) < WGM ? (nM - fm) : WGM;
        u.pm = fm + ((wgid % nig) % gsz); u.pn = (wgid % nig) / gsz; return true;
    }
    __device__ __forceinline__ void a_ready(const Unit&) const {}
    __device__ __forceinline__ void done(const Unit&) const {}
};
template <class Epi, class Sched, bool STAMP = false>
__device__ __forceinline__ void gemm_phase(PG8_LAS unsigned char* lds, const Gemm g, const Sched& S, const Epi& E, unsigned long long* stamps) {
    const int tid = threadIdx.x, wid = __builtin_amdgcn_readfirstlane(tid >> 6), lane = tid & 63, wr = wid >> 2, wc = wid & 3, fr = lane & 15, fq = lane >> 4;
    const int K = g.K, nt = K / BK;
    int ts_lo = 0, ts_hi = 0, nts = 0; const unsigned long long rt_entry = STAMP ? (unsigned long long)wall_clock64() : 0ull;
#define PG8_STAMP() do { if (STAMP && wid == 0 && nts < 64) { const unsigned long long _c = (unsigned long long)clock64(); \
        ts_lo = (lane == nts) ? (int)(unsigned)_c : ts_lo; ts_hi = (lane == nts) ? (int)(unsigned)(_c >> 32) : ts_hi; ++nts; } } while (0)
    PG8_STAMP();
    unsigned voffA[2], voffB[2];
#pragma unroll
    for (int i = 0; i < 2; ++i) { int R, C; stage_rc(tid * 16 + i * 8192, R, C); const int Rb = Epi::PERM ? ((R & ~31) + perm32(R & 31)) : R;
        voffA[i] = (unsigned)(R * K + C) * 2u; voffB[i] = (unsigned)(Rb * K + C) * 2u; }
    const size_t kstep = (size_t)(BK * 2);
    const size_t hstep = (size_t)HALF * K * 2;
    const size_t tstep = 2 * hstep;
    const unsigned ldsw = (unsigned)wid * 1024u;
    const int aoff = lds_byte(wr * 64 + fr, fq * 8), boff = lds_byte(wc * 32 + fr, fq * 8);
#define PG8_SA(b, h) (((b) * 2 + (h)) * HTB)
#define PG8_SB(b, h) ((4 + (b) * 2 + (h)) * HTB)
#define PG8_STAGE(bufoff, gbase, voff) do { _Pragma("unroll") for (int _i = 0; _i < 2; ++_i) \
        __builtin_amdgcn_global_load_lds((const unsigned*)((const char*)(gbase) + (voff)[_i]), (PG8_LAS unsigned*)(lds + (bufoff) + ldsw + _i * 8192), 16, 0, 0); } while (0)
#define PG8_LDA(dst, b, h) do { _Pragma("unroll") for (int m = 0; m < 4; ++m) _Pragma("unroll") for (int k = 0; k < 2; ++k) dst[m][k] = *(const PG8_LAS bf16x8*)(lds + PG8_SA(b, h) + aoff + m * 2048 + k * 1024); } while (0)
#define PG8_LDB(dst, b, h) do { _Pragma("unroll") for (int n = 0; n < 2; ++n) _Pragma("unroll") for (int k = 0; k < 2; ++k) dst[n][k] = *(const PG8_LAS bf16x8*)(lds + PG8_SB(b, h) + boff + n * 2048 + k * 1024); } while (0)
#define PG8_MMA(ai, bj, At, Bt) do { __builtin_amdgcn_s_setprio(1); _Pragma("unroll") for (int m = 0; m < 4; ++m) _Pragma("unroll") for (int n = 0; n < 2; ++n) _Pragma("unroll") for (int k = 0; k < 2; ++k) \
        acc[ai][bj][m][n] = __builtin_amdgcn_mfma_f32_16x16x32_bf16(Bt[n][k], At[m][k], acc[ai][bj][m][n], 0, 0, 0); __builtin_amdgcn_s_setprio(0); } while (0)
#define PG8_WAIT_V(n) asm volatile("s_waitcnt vmcnt(" #n ")" ::: "memory")
#define PG8_WAIT_L(n) asm volatile("s_waitcnt lgkmcnt(" #n ")" ::: "memory")
#define PG8_BAR __builtin_amdgcn_s_barrier()
#define PG8_SCHED __builtin_amdgcn_sched_barrier(0)
    Unit cur, nxt; int ui = 0;
    if (!S.next(0, cur)) return;
    f32x4 acc[2][2][4][2];
#pragma unroll
    for (int a = 0; a < 2; ++a)
#pragma unroll
        for (int b = 0; b < 2; ++b)
#pragma unroll
            for (int m = 0; m < 4; ++m)
#pragma unroll
                for (int n = 0; n < 2; ++n) acc[a][b][m][n] = (f32x4){0.f, 0.f, 0.f, 0.f};
    bf16x8 At[4][2], B0[2][2], B1[2][2];
    const char* cA = (const char*)g.A + (size_t)cur.pm * tstep; const char* cB = (const char*)g.Bt + (size_t)cur.pn * tstep;
    S.a_ready(cur);
    PG8_STAGE(PG8_SB(0, 0), cB, voffB); PG8_STAGE(PG8_SA(0, 0), cA, voffA); PG8_STAGE(PG8_SB(0, 1), cB + hstep, voffB); PG8_STAGE(PG8_SA(0, 1), cA + hstep, voffA);
    if (wr == 1) PG8_BAR;
    PG8_WAIT_V(4); PG8_BAR;
    PG8_STAGE(PG8_SB(1, 0), cB + kstep, voffB); PG8_STAGE(PG8_SA(1, 0), cA + kstep, voffA); PG8_STAGE(PG8_SB(1, 1), cB + hstep + kstep, voffB);
    PG8_WAIT_V(6); PG8_BAR;
    PG8_STAMP();
    for (;;) {
        const bool has_next = S.next(ui + 1, nxt);
        const char* nA = has_next ? (const char*)g.A + (size_t)nxt.pm * tstep : cA; const char* nB = has_next ? (const char*)g.Bt + (size_t)nxt.pn * tstep : cB;
        for (int t = 0; t < nt; t += 2) {
            const bool last = (t == nt - 2);
            const char* a1 = cA + (size_t)(t + 1) * kstep;
            const char* a2 = last ? nA : cA + (size_t)(t + 2) * kstep; const char* b2 = last ? nB : cB + (size_t)(t + 2) * kstep;
            const char* a3 = a2 + kstep; const char* b3 = b2 + kstep;
            if (last && has_next) S.a_ready(nxt);
            PG8_LDB(B0, 0, 0); PG8_SCHED; PG8_LDA(At, 0, 0); PG8_STAGE(PG8_SA(1, 1), a1 + hstep, voffA);
            PG8_WAIT_L(8); PG8_BAR; PG8_WAIT_L(0); PG8_MMA(0, 0, At, B0); PG8_BAR; PG8_SCHED;
            PG8_LDB(B1, 0, 1); PG8_STAGE(PG8_SB(0, 0), b2, voffB);
            PG8_BAR; PG8_WAIT_L(0); PG8_MMA(0, 1, At, B1); PG8_BAR;
            PG8_LDA(At, 0, 1); PG8_STAGE(PG8_SA(0, 0), a2, voffA);
            PG8_BAR; PG8_WAIT_L(0); PG8_MMA(1, 0, At, B0); PG8_BAR; PG8_SCHED;
            PG8_STAGE(PG8_SB(0, 1), b2 + hstep, voffB);
            PG8_WAIT_V(6); PG8_BAR; PG8_MMA(1, 1, At, B1); PG8_BAR;
            PG8_LDB(B0, 1, 0); PG8_SCHED; PG8_LDA(At, 1, 0); PG8_STAGE(PG8_SA(0, 1), a2 + hstep, voffA);
            PG8_WAIT_L(8); PG8_BAR; PG8_WAIT_L(0); PG8_MMA(0, 0, At, B0); PG8_BAR; PG8_SCHED;
            PG8_LDB(B1, 1, 1); PG8_STAGE(PG8_SB(1, 0), b3, voffB);
            PG8_BAR; PG8_WAIT_L(0); PG8_MMA(0, 1, At, B1); PG8_BAR;
            PG8_LDA(At, 1, 1); PG8_STAGE(PG8_SA(1, 0), a3, voffA);
            PG8_BAR; PG8_WAIT_L(0); PG8_MMA(1, 0, At, B0); PG8_BAR; PG8_SCHED;
            PG8_STAGE(PG8_SB(1, 1), b3 + hstep, voffB);
            PG8_WAIT_V(6); PG8_BAR; PG8_MMA(1, 1, At, B1); PG8_BAR;
        }
        PG8_STAMP();
        if constexpr (!Epi::AFTER_DRAIN) { E(acc, cur, wr, wc, fr, fq); S.done(cur); }
        PG8_STAMP();
        if (!has_next) break;
#pragma unroll
        for (int a = 0; a < 2; ++a)
#pragma unroll
            for (int b = 0; b < 2; ++b)
#pragma unroll
                for (int m = 0; m < 4; ++m)
#pragma unroll
                    for (int n = 0; n < 2; ++n) acc[a][b][m][n] = (f32x4){0.f, 0.f, 0.f, 0.f};
        cur = nxt; cA = nA; cB = nB; ++ui;
    }
    PG8_WAIT_V(0);
    if (wr == 0) PG8_BAR;
    PG8_BAR;
    if constexpr (Epi::AFTER_DRAIN) { E.fused(acc, cur, wr, wc, fr, fq, lds, wid, lane); S.done(cur); }
    PG8_STAMP();
    if (STAMP && wid == 0) { stamps[lane] = lane < nts ? (((unsigned long long)(unsigned)ts_hi << 32) | (unsigned)ts_lo) : 0ull;
        if (lane == 62) stamps[62] = rt_entry; if (lane == 63) stamps[63] = (unsigned long long)wall_clock64(); }
#undef PG8_STAMP
#undef PG8_SA
#undef PG8_SB
#undef PG8_STAGE
#undef PG8_LDA
#undef PG8_LDB
#undef PG8_MMA
#undef PG8_WAIT_V
#undef PG8_WAIT_L
#undef PG8_BAR
#undef PG8_SCHED
}
}

template <class EP> struct Pg8Epi {
  static constexpr bool PERM = false, AFTER_DRAIN = false;
  EP ep;
  __device__ __forceinline__ void operator()(const pg8::f32x4 (&acc)[2][2][4][2], const pg8::Unit& u, int wr, int wc, int fr, int fq) const {
#pragma unroll
    for (int ai = 0; ai < 2; ++ai)
#pragma unroll
      for (int m = 0; m < 4; ++m)
#pragma unroll
        for (int bj = 0; bj < 2; ++bj)
#pragma unroll
          for (int n = 0; n < 2; ++n) {
            const int row = u.pm * 256 + ai * 128 + wr * 64 + m * 16 + fr;
            const int col = u.pn * 256 + bj * 128 + wc * 32 + n * 16 + fq * 4;
            ep(row, col, acc[ai][bj][m][n]);
          }
  }
};
struct Pg8EpiRes {
  static constexpr bool PERM = false, AFTER_DRAIN = false;
  EpRes ep;
  __device__ __forceinline__ void operator()(const pg8::f32x4 (&acc)[2][2][4][2], const pg8::Unit& u, int wr, int wc, int fr, int fq) const {
    const int bidx = (u.pm * 256) >> 12;
    const float* gbase = ep.modL + bidx * 3072 + 2048 + u.pn * 256 + wc * 32 + fq * 4;
    f32x4 g[2][2];
#pragma unroll
    for (int bj = 0; bj < 2; ++bj)
#pragma unroll
      for (int n = 0; n < 2; ++n) g[bj][n] = *(const f32x4*)(gbase + bj * 128 + n * 16);
#pragma unroll
    for (int ai = 0; ai < 2; ++ai)
#pragma unroll
      for (int m = 0; m < 4; ++m) {
        const size_t roff = (size_t)(u.pm * 256 + ai * 128 + wr * 64 + m * 16 + fr) * 1024 + u.pn * 256 + wc * 32 + fq * 4;
#pragma unroll
        for (int bj = 0; bj < 2; ++bj)
#pragma unroll
          for (int n = 0; n < 2; ++n) {
            const size_t off = roff + bj * 128 + n * 16;
            f32x4 x = *(const f32x4*)(ep.xl_src + off);
            x += g[bj][n] * acc[ai][bj][m][n];
            *(f32x4*)(ep.xl_dst + off) = x;
          }
      }
  }
};
__device__ __forceinline__ void pg8_gemm_res(char* lds, const bf16_t* A, const bf16_t* Bt, int M, int N, int K, const EpRes ep) {
  __syncthreads();
  pg8::Gemm g{A, Bt, M, N, K};
  pg8::StaticOrder S; S.init(M, N, (int)gridDim.x, (int)blockIdx.x);
  Pg8EpiRes E{ep};
  pg8::gemm_phase<Pg8EpiRes, pg8::StaticOrder, false>((PG8_LAS unsigned char*)lds, g, S, E, nullptr);
  __syncthreads();
}
template <class EP>
__device__ __forceinline__ void pg8_gemm(char* lds, const bf16_t* A, const bf16_t* Bt, int M, int N, int K, const EP ep) {
  __syncthreads();
  pg8::Gemm g{A, Bt, M, N, K};
  pg8::StaticOrder S; S.init(M, N, (int)gridDim.x, (int)blockIdx.x);
  Pg8Epi<EP> E{ep};
  pg8::gemm_phase<Pg8Epi<EP>, pg8::StaticOrder, false>((PG8_LAS unsigned char*)lds, g, S, E, nullptr);
  __syncthreads();
}

template <int ph>
__device__ __forceinline__ void run_phase(const Params& p, char* lds, bool last_rep) {
  char* ws = p.ws;
  const float* MOD = (const float*)(ws + OFF_MOD);
  float* XC = (float*)(ws + OFF_XC);
  bf16_t* HB = (bf16_t*)(ws + OFF_HB);
  bf16_t* A0 = (bf16_t*)(ws + OFF_A0); bf16_t* A1 = (bf16_t*)(ws + OFF_A1); bf16_t* A2 = (bf16_t*)(ws + OFF_A2);
  bf16_t* A3 = (bf16_t*)(ws + OFF_A3); bf16_t* A4 = (bf16_t*)(ws + OFF_A4);
  bf16_t* WD = (bf16_t*)(ws + OFF_WD); bf16_t* AD = (bf16_t*)(ws + OFF_AD);
  float* BON = (float*)(ws + OFF_BON);
  if (ph == 0) { phase0(p, lds); return; }
  constexpr int layer = (ph - 1) / 5, sub = (ph - 1) % 5;
  const float* modL = MOD + (size_t)layer * 9 * 3072;
  const float* xl_cur = layer == 0 ? p.in[0] : p.out;
  const float* xc_cur = layer == 0 ? p.in[2] : XC;
  if (layer == 0 || layer == 3) {
    const int ib = layer ? 33 : 4;
    const bf16_t* WIN = (const bf16_t*)(ws + (layer ? OFF_W3IN : OFF_W0IN));
    const bf16_t* WUP = (const bf16_t*)(ws + (layer ? OFF_W3UP : OFF_W0UP));
    const bf16_t* WOUT = (const bf16_t*)(ws + (layer ? OFF_W3OUT : OFF_W0OUT));
    if (sub == 0) norm_phase<true>(xl_cur, xc_cur, p.in[ib], modL, HB, A4);
    else if (sub == 1) { ALMix al{HB, A4, p.in[ib + 4]}; EpRwkvIn ep{A0, A1, A2, A3, WD, AD}; gemm256_phase(lds, WIN, 1024, MT / 256, 16, al, ep); gemm_phase(lds, WIN, 1024, MT / 256, 2, al, ep, 4096, true); }
    else if (sub == 2) rwkv_scan_phase(lds, A0, A1, A2, WD, AD, WUP, p.in[ib + 5], p.in[ib + 8], p.in[ib + 9], HB, A4, BON);
    else if (sub == 3) rwkv_post_phase(HB, A4, A2, A3, BON, p.in[ib + 10], layer == 3 ? ML : MT);
    else { ALPlain al{A3, 1024}; EpRes ep{xl_cur, xc_cur, p.out, XC, modL}; pg8_gemm_res(lds, A3, WOUT, ML, 1024, 1024, ep); if (layer != 3) gemm_phase(lds, WOUT, 1024, MC / 256, 8, al, ep, 0, false, ML / 256); }
  } else if (layer == 1) {
    bf16_t* HS0 = (bf16_t*)(ws + OFF_HS0); bf16_t* XR = (bf16_t*)(ws + OFF_XR); bf16_t* GG = (bf16_t*)(ws + OFF_GG); bf16_t* HS1 = (bf16_t*)(ws + OFF_HS1);
    if (sub == 0) norm_phase<false>(xl_cur, xc_cur, p.in[16], modL, HB, nullptr);
    else if (sub == 1) { ALPlain al{HB, 1024}; EpLruIn ep{XR, GG}; pg8_gemm(lds, HB, (const bf16_t*)(ws + OFF_W1IN), MT, 2816, 1024, ep); }
    else if (sub == 2) rglru_phase(lds, XR, (const bf16_t*)(ws + OFF_W1G), p.in[20], p.in[21], p.in[23], p.in[24], HS0, HS1);
    else if (sub == 3) lru_z_phase(HS0, HS1, GG);
    else { ALPlain al{GG, LW}; EpRes ep{xl_cur, xc_cur, p.out, XC, modL}; pg8_gemm_res(lds, GG, (const bf16_t*)(ws + OFF_W1OUT), ML, 1024, LW, ep); gemm_phase(lds, (const bf16_t*)(ws + OFF_W1OUT), LW, MC / 256, 8, al, ep, 0, false, ML / 256); }
  } else {
    if (sub == 0) norm_phase<false>(xl_cur, xc_cur, p.in[26], modL, HB, nullptr);
    else if (sub == 1) { ALPlain al{HB, 1024}; EpNatIn ep{A0, A1, A2, A3}; pg8_gemm(lds, HB, (const bf16_t*)(ws + OFF_W2IN), MT, 4096, 1024, ep); }
    else if (sub == 2) nat_qk_phase(A0, A1, A4, p.in[30]);
    else if (sub == 3) natten_phase(lds, A0, A4, A1, A2, A3, p.in[31], last_rep ? A3 : HB);
    else { ALPlain al{A3, 1024}; EpRes ep{xl_cur, xc_cur, p.out, XC, modL}; pg8_gemm_res(lds, A3, (const bf16_t*)(ws + OFF_W2OUT), ML, 1024, 1024, ep); gemm_phase(lds, (const bf16_t*)(ws + OFF_W2OUT), 1024, MC / 256, 8, al, ep, 0, false, ML / 256); }
  }
}

__global__ void __launch_bounds__(NTHR) mega_kernel(Params p) {
  __shared__ __attribute__((aligned(16))) char lds[LDS_BYTES];
  __shared__ u32x4 xb_words;
  cg::grid_group grid = cg::this_grid();
  if (threadIdx.x == 0) xb_words = (u32x4){0u, 0u, 0u, 0u};
  __syncthreads();
  const XcdBarrier xb = xcd_barrier_post((unsigned*)(p.ws + OFF_BAR), (volatile LAS unsigned*)&xb_words);
#define PHASE(k) if (p.ph_lo <= k && k < p.ph_hi) { for (int rep = 0; rep < REP[k]; ++rep) { run_phase<k>(p, lds, rep + 1 == REP[k]); if (rep + 1 < REP[k] || k + 1 < p.ph_hi) { if (k == 0) grid.sync(); else xcd_barrier(xb); } } }
  PHASE(0) PHASE(1) PHASE(2) PHASE(3) PHASE(4) PHASE(5) PHASE(6) PHASE(7) PHASE(8) PHASE(9) PHASE(10)
  PHASE(11) PHASE(12) PHASE(13) PHASE(14) PHASE(15) PHASE(16) PHASE(17) PHASE(18) PHASE(19) PHASE(20)
#undef PHASE
}

extern "C" void kernel_launch(void* const* d_in, const int* in_sizes, int n_in, void* d_out, int out_size, void* d_ws, size_t ws_size,
                              hipStream_t stream) {
  static int grid_blocks = 0;
  if (!grid_blocks) {
    int dev = 0, cus = 0, per_cu = 0;
    hipGetDevice(&dev);
    hipDeviceGetAttribute(&cus, hipDeviceAttributeMultiprocessorCount, dev);
    hipOccupancyMaxActiveBlocksPerMultiprocessor(&per_cu, mega_kernel, NTHR, 0);
    if (per_cu < 1) { fprintf(stderr, "occupancy query returned %d\n", per_cu); per_cu = 1; }
    if (per_cu > 1) per_cu = 1;
    grid_blocks = cus * per_cu;
    if (n_in != 45 || ws_size < WS_END) fprintf(stderr, "unexpected n_in %d / ws %zu (need %zu)\n", n_in, ws_size, (size_t)WS_END);
  }
  Params p{};
  for (int i = 0; i < 45; ++i) p.in[i] = (const float*)d_in[i];
  p.out = (float*)d_out;
  p.ws = (char*)d_ws;
  (void)hipMemsetAsync((char*)d_ws + OFF_BAR, 0, XCD_BAR_WORDS * 4, stream);
#if N_LAUNCH_MODE == 1
  p.ph_lo = 0; p.ph_hi = NPHASE;
  void* args[] = {&p};
  hipError_t e = hipLaunchCooperativeKernel((void*)mega_kernel, dim3(grid_blocks), dim3(NTHR), args, 0, stream);
  if (e != hipSuccess) fprintf(stderr, "cooperative launch failed: %s (grid %d)\n", hipGetErrorString(e), grid_blocks);
#else
  for (int ph = 0; ph < NPHASE; ++ph) {
    p.ph_lo = ph; p.ph_hi = ph + 1;
    hipLaunchKernelGGL(mega_kernel, dim3(grid_blocks), dim3(NTHR), 0, stream, p);
  }
#endif
}
```

```cpp
#include <hip/hip_runtime.h>
#include <hip/hip_cooperative_groups.h>
#include <cstdio>
#include <cstdint>
namespace cg = cooperative_groups;

#ifndef N_LAUNCH_MODE
#define N_LAUNCH_MODE 1
#endif

typedef unsigned short bf16_t;
typedef short bf16x8 __attribute__((ext_vector_type(8)));
typedef float f32x4 __attribute__((ext_vector_type(4)));
typedef float f32x16 __attribute__((ext_vector_type(16)));
typedef float f32x2 __attribute__((ext_vector_type(2)));
typedef unsigned u32x4 __attribute__((ext_vector_type(4)));
typedef unsigned u32x2 __attribute__((ext_vector_type(2)));

#define DEVI __device__ __forceinline__

constexpr int D = 1024, NB = 8, SEQ = 4096, CTX = 256;
constexpr int ML = NB * SEQ;
constexpr int MC = NB * CTX;
constexpr int MT = ML + MC;
constexpr int LW = 1408;
constexpr int NTHR = 512;
constexpr int NPHASE = 21;
constexpr int LDS_BYTES = 163840 - 16;
__device__ constexpr int REP[21] = {1,1,1,1,1,1,1,1,1,1,1,1,1,1,1,1,1,1,1,1,1};

constexpr size_t SZ_ACT = (size_t)MT * 1024 * 2;
constexpr size_t OFF_MOD = 0;
constexpr size_t OFF_BAR = 458752;
constexpr size_t OFF_W0IN = 524288;
constexpr size_t SZ_RWIN = (size_t)4352 * 1024 * 2;
constexpr size_t SZ_RWUP = (size_t)4 * 1024 * 64 * 2;
constexpr size_t SZ_SQ = (size_t)1024 * 1024 * 2;
constexpr size_t OFF_W0UP = OFF_W0IN + SZ_RWIN;
constexpr size_t OFF_W0OUT = OFF_W0UP + SZ_RWUP;
constexpr size_t OFF_W3IN = OFF_W0OUT + SZ_SQ;
constexpr size_t OFF_W3UP = OFF_W3IN + SZ_RWIN;
constexpr size_t OFF_W3OUT = OFF_W3UP + SZ_RWUP;
constexpr size_t OFF_W1IN = OFF_W3OUT + SZ_SQ;
constexpr size_t OFF_W1G = OFF_W1IN + (size_t)2816 * 1024 * 2;
constexpr size_t OFF_W1OUT = OFF_W1G + (size_t)16 * 4 * 96 * 96 * 2;
constexpr size_t OFF_W2IN = OFF_W1OUT + (size_t)1024 * 1408 * 2;
constexpr size_t OFF_W2OUT = OFF_W2IN + (size_t)4096 * 1024 * 2;
constexpr size_t OFF_XC = OFF_W2OUT + SZ_SQ;
constexpr size_t OFF_BON = OFF_XC + (size_t)MC * 1024 * 4;
constexpr size_t OFF_BIG = OFF_BON + (size_t)2 * MT * 16 * 4;
constexpr size_t OFF_HB = OFF_BIG;
constexpr size_t OFF_A0 = OFF_BIG + SZ_ACT;
constexpr size_t OFF_A1 = OFF_A0 + SZ_ACT;
constexpr size_t OFF_A2 = OFF_A1 + SZ_ACT;
constexpr size_t OFF_A3 = OFF_A2 + SZ_ACT;
constexpr size_t OFF_A4 = OFF_A3 + SZ_ACT;
constexpr size_t OFF_WD = OFF_A4 + SZ_ACT;
constexpr size_t OFF_AD = OFF_WD + (size_t)MT * 128 * 2;
constexpr size_t WS_END = OFF_AD + (size_t)MT * 128 * 2;
constexpr size_t SZ_LRU = (size_t)MT * LW * 2;
constexpr size_t OFF_HS0 = OFF_BIG;
constexpr size_t OFF_XR = OFF_BIG + SZ_LRU;
constexpr size_t OFF_GG = OFF_XR + SZ_LRU;
constexpr size_t OFF_HS1 = OFF_GG + SZ_LRU;
static_assert(OFF_HS1 + SZ_LRU <= WS_END, "lru overlay");
static_assert(WS_END <= (size_t)536870912, "ws");

struct Params {
  const float* in[45];
  float* out;
  char* ws;
  int ph_lo, ph_hi;
};

DEVI u32x4 mk4(unsigned a, unsigned b, unsigned c, unsigned d) { u32x4 r = {a, b, c, d}; return r; }
DEVI int opaque_tid() { int t = threadIdx.x; asm volatile("" : "+v"(t)); return t; }
DEVI float bf_lo(unsigned u) { return __uint_as_float(u << 16); }
DEVI float bf_hi(unsigned u) { return __uint_as_float(u & 0xffff0000u); }
DEVI float bf2f(bf16_t h) { return __uint_as_float(((unsigned)h) << 16); }
typedef __bf16 bf16x2_t __attribute__((ext_vector_type(2)));
DEVI unsigned pk_bf16(float lo, float hi) { f32x2 f = {lo, hi}; bf16x2_t v = __builtin_convertvector(f, bf16x2_t); return __builtin_bit_cast(unsigned, v); }
DEVI bf16_t f2bf(float f) { return (bf16_t)(pk_bf16(f, 0.f) & 0xffffu); }
DEVI float wave_sum(float v) {
#pragma unroll
  for (int o = 32; o; o >>= 1) v += __shfl_xor(v, o);
  return v;
}
DEVI float sigmoidf_(float x) { return __builtin_amdgcn_rcpf(1.f + __expf(-x)); }
DEVI float siluf_(float x) { return x * __builtin_amdgcn_rcpf(1.f + __expf(-x)); }
DEVI float softplusf_(float x) { return fmaxf(x, 0.f) + __logf(1.f + __expf(-fabsf(x))); }
DEVI f32x16 mfma32(u32x4 a, u32x4 b, f32x16 c) {
  return __builtin_amdgcn_mfma_f32_32x32x16_bf16(__builtin_bit_cast(bf16x8, a), __builtin_bit_cast(bf16x8, b), c, 0, 0, 0);
}
DEVI f32x4 mfma16(u32x4 a, u32x4 b, f32x4 c) {
  return __builtin_amdgcn_mfma_f32_16x16x32_bf16(__builtin_bit_cast(bf16x8, a), __builtin_bit_cast(bf16x8, b), c, 0, 0, 0);
}
template <int CTRL> DEVI float dpp_f(float v) {
  return __int_as_float(__builtin_amdgcn_update_dpp(0, __float_as_int(v), CTRL, 0xf, 0xf, true));
}
DEVI float sum8(float v) {
  v += dpp_f<0xB1>(v);
  v += dpp_f<0x4E>(v);
  v += dpp_f<0x141>(v);
  return v;
}

#define XB_TMO      128
#define XB_XCNT(j)  (256  + 64 * (j))
#define XB_XSUB(j)  (1280 + 64 * (j))
#define XB_XGEN(j)  (2304 + 64 * (j))
#define XB_TOP      3328
#define XB_TOPGEN   3392
#define XCD_BAR_WORDS 3456
#define XB_SPIN_CAP (1u << 18)
#define LAS __attribute__((address_space(3)))

__device__ __forceinline__ unsigned xb_ld(unsigned* p)              { return __hip_atomic_load(p, __ATOMIC_RELAXED, __HIP_MEMORY_SCOPE_AGENT); }
__device__ __forceinline__ unsigned xb_add(unsigned* p, unsigned v) { return __hip_atomic_fetch_add(p, v, __ATOMIC_RELAXED, __HIP_MEMORY_SCOPE_AGENT); }
__device__ __forceinline__ unsigned xb_xcc_id() { return (unsigned)__builtin_amdgcn_s_getreg((3 << 11) | 20) & 0xFu; }
#define XB_SPIN(cond, bar) do { unsigned _sp = 0; while (cond) { __builtin_amdgcn_s_sleep(1); \
    if ((++_sp & 255u) == 0u) { if (xb_ld(&(bar)[XB_TMO])) break; if (_sp > XB_SPIN_CAP) { atomicAdd(&(bar)[XB_TMO], 1u); break; } } } } while (0)

struct XcdBarrier {
    unsigned* bar; unsigned x;
    volatile LAS unsigned* st;
};

__device__ __forceinline__ XcdBarrier xcd_barrier_post(unsigned* bar, volatile LAS unsigned* st) {
    XcdBarrier b; b.bar = bar; b.x = xb_xcc_id(); b.st = st;
    if (threadIdx.x == 0) (void)xb_add(&bar[XB_XCNT(b.x)], 1u);
    return b;
}
__device__ __forceinline__ void xcd_barrier_complete(unsigned* bar, unsigned x, unsigned& nloc, unsigned& nx) {
    const unsigned G = gridDim.x * gridDim.y * gridDim.z;
    unsigned sum, cnt, mine, sp = 0u;
    for (;;) {
        sum = 0u; cnt = 0u; mine = 0u;
#pragma unroll
        for (unsigned j = 0; j < 16; ++j) { const unsigned c = xb_ld(&bar[XB_XCNT(j)]); sum += c; cnt += (c > 0u) ? 1u : 0u; mine = (j == x) ? c : mine; }
        if (sum == G) break;
        __builtin_amdgcn_s_sleep(1);
        if ((++sp & 255u) == 0u) { if (xb_ld(&bar[XB_TMO])) break; if (sp > XB_SPIN_CAP) { atomicAdd(&bar[XB_TMO], 1u); break; } }
    }
    nloc = mine > 0u ? mine : 1u; nx = cnt > 0u ? cnt : 1u;
}

__device__ __forceinline__ void xcd_barrier(const XcdBarrier& b) {
    asm volatile("s_waitcnt vmcnt(0)" ::: "memory");
    __syncthreads();
    if (threadIdx.x == 0) {
        unsigned* bar = b.bar;
        __builtin_amdgcn_s_waitcnt(0);
        unsigned nloc = b.st[0], nx = b.st[1];
        if (nloc == 0u) { xcd_barrier_complete(bar, b.x, nloc, nx); b.st[0] = nloc; b.st[1] = nx; }
        const unsigned old = xb_add(&bar[XB_XSUB(b.x)], 1u);
        const unsigned gen = old / nloc;
        if (old + 1u == (gen + 1u) * nloc) {
            __builtin_amdgcn_fence(__ATOMIC_RELEASE, "agent");
            asm volatile("s_waitcnt vmcnt(0)" ::: "memory");
            const unsigned og = xb_add(&bar[XB_TOP], 1u);
            const unsigned tg = og / nx;
            if (og + 1u == (tg + 1u) * nx) xb_add(&bar[XB_TOPGEN], 1u);
            else XB_SPIN(xb_ld(&bar[XB_TOPGEN]) == tg, bar);
            __builtin_amdgcn_fence(__ATOMIC_ACQUIRE, "agent");
            xb_add(&bar[XB_XGEN(b.x)], 1u);
            asm volatile("s_waitcnt vmcnt(0)" ::: "memory");
        } else {
            XB_SPIN(xb_ld(&bar[XB_XGEN(b.x)]) == gen, bar);
            __builtin_amdgcn_fence(__ATOMIC_ACQUIRE, "agent");
            asm volatile("s_waitcnt vmcnt(0)" ::: "memory");
        }
    }
    __syncthreads();
}


struct TJob { const float* src; int K, N; bf16_t* dst; int ldd; };

DEVI TJob get_tjob(const Params& p, int j) {
  TJob t;
  if (j < 26) {
    const int l = j / 13, jj = j % 13;
    const int ib = l ? 33 : 4;
    bf16_t* win = (bf16_t*)(p.ws + (l ? OFF_W3IN : OFF_W0IN));
    bf16_t* wup = (bf16_t*)(p.ws + (l ? OFF_W3UP : OFF_W0UP));
    bf16_t* wout = (bf16_t*)(p.ws + (l ? OFF_W3OUT : OFF_W0OUT));
    if (jj < 4) { t.src = p.in[ib + 3] + (size_t)jj * 1048576; t.K = 1024; t.N = 1024; t.dst = win + (size_t)jj * 1048576; t.ldd = 1024; }
    else if (jj < 8) { const int idx = jj - 4, d = idx >> 1, kind = idx & 1;
      t.src = p.in[ib + 6] + (size_t)idx * 65536; t.K = 1024; t.N = 64; t.dst = win + (size_t)(4096 + kind * 128 + d * 64) * 1024; t.ldd = 1024; }
    else if (jj < 12) { const int idx = jj - 8;
      t.src = p.in[ib + 7] + (size_t)idx * 65536; t.K = 64; t.N = 1024; t.dst = wup + (size_t)idx * 65536; t.ldd = 64; }
    else { t.src = p.in[ib + 11]; t.K = 1024; t.N = 1024; t.dst = wout; t.ldd = 1024; }
  } else if (j == 26) { t.src = p.in[19]; t.K = 1024; t.N = 2816; t.dst = (bf16_t*)(p.ws + OFF_W1IN); t.ldd = 1024; }
  else if (j == 27) { t.src = p.in[25]; t.K = 1408; t.N = 1024; t.dst = (bf16_t*)(p.ws + OFF_W1OUT); t.ldd = 1408; }
  else if (j == 28) { t.src = p.in[29]; t.K = 1024; t.N = 4096; t.dst = (bf16_t*)(p.ws + OFF_W2IN); t.ldd = 1024; }
  else { t.src = p.in[32]; t.K = 1024; t.N = 1024; t.dst = (bf16_t*)(p.ws + OFF_W2OUT); t.ldd = 1024; }
  return t;
}

__device__ __forceinline__ void phase0(const Params& p, char* lds) {
  const int tid = opaque_tid();
  {
    bf16_t* wg = (bf16_t*)(p.ws + OFF_W1G);
    const float* gw = p.in[22];
    const int total = 16 * 4 * 96 * 96;
    for (int e = blockIdx.x * NTHR + tid; e < total; e += gridDim.x * NTHR) {
      const int k = e % 96, n = (e / 96) % 96, dg = (e / 9216) & 3, blk = e / 36864;
      float v = 0.f;
      if (k < 88 && n < 88) v = gw[((size_t)(dg * 16 + blk) * 88 + k) * 88 + n];
      wg[e] = f2bf(v);
    }
  }
  constexpr int N_MOD_ITEMS = 96;
  constexpr int N_TILES = 5152;
  float* act = (float*)lds;
  float* red = (float*)(lds + 36864);
  float* tl = (float*)lds;
  for (int item = blockIdx.x; item < N_MOD_ITEMS; item += gridDim.x) {
    __syncthreads();
    {
      const int L = item / 24, nc = item % 24;
      const int ib = (L == 0) ? 4 : (L == 1) ? 16 : (L == 2) ? 26 : 33;
      const float* ada_w = p.in[ib + 1];
      const float* ada_b = p.in[ib + 2];
      for (int e = tid; e < 9 * 1024; e += NTHR) {
        const int i = e >> 10, k = e & 1023;
        const float c = (i < 8) ? p.in[1][i * 1024 + k] : p.in[3][k];
        act[e] = siluf_(c);
      }
      __syncthreads();
      const int kq = tid >> 7, nl = tid & 127, n = nc * 128 + nl;
      float acc[9];
#pragma unroll
      for (int i = 0; i < 9; ++i) acc[i] = 0.f;
      for (int k0 = kq * 256; k0 < kq * 256 + 256; k0 += 16) {
        float w[16];
#pragma unroll
        for (int u = 0; u < 16; ++u) w[u] = ada_w[(size_t)(k0 + u) * 3072 + n];
#pragma unroll
        for (int u = 0; u < 16; ++u)
#pragma unroll
          for (int i = 0; i < 9; ++i) acc[i] += act[i * 1024 + k0 + u] * w[u];
      }
#pragma unroll
      for (int i = 0; i < 9; ++i) red[(kq * 9 + i) * 128 + nl] = acc[i];
      __syncthreads();
      float* mod = (float*)(p.ws + OFF_MOD) + (size_t)L * 9 * 3072;
      for (int e = tid; e < 9 * 128; e += NTHR) {
        const int i = e >> 7, c = e & 127;
        const float s = red[(0 * 9 + i) * 128 + c] + red[(1 * 9 + i) * 128 + c] + red[(2 * 9 + i) * 128 + c] + red[(3 * 9 + i) * 128 + c];
        mod[i * 3072 + nc * 128 + c] = s + ada_b[nc * 128 + c];
      }
    }
  }
  {
    struct TileRef { const float* src; bf16_t* dst; int N, ldd, k0, n0; };
    auto decode = [&](int t, TileRef& r) {
      int j = 0;
      TJob job = get_tjob(p, 0);
      for (;;) {
        const int nt = (job.K >> 6) * (job.N >> 6);
        if (t < nt) break;
        t -= nt; ++j; job = get_tjob(p, j);
      }
      const int ntn = job.N >> 6;
      r.src = job.src; r.dst = job.dst; r.N = job.N; r.ldd = job.ldd; r.k0 = (t / ntn) * 64; r.n0 = (t % ntn) * 64;
    };
    const int kk = tid >> 4, n4 = (tid & 15) * 4;
    int t = (int)(gridDim.x - 1 - blockIdx.x);
    TileRef cur, nxt;
    float4 v0 = make_float4(0.f, 0.f, 0.f, 0.f), v1 = v0;
    if (t < N_TILES) {
      decode(t, cur);
      v0 = *(const float4*)(cur.src + (size_t)(cur.k0 + kk) * cur.N + cur.n0 + n4);
      v1 = *(const float4*)(cur.src + (size_t)(cur.k0 + kk + 32) * cur.N + cur.n0 + n4);
    }
    while (t < N_TILES) {
      const int tn = t + (int)gridDim.x;
      float4 w0 = v0, w1 = v1;
      if (tn < N_TILES) {
        decode(tn, nxt);
        w0 = *(const float4*)(nxt.src + (size_t)(nxt.k0 + kk) * nxt.N + nxt.n0 + n4);
        w1 = *(const float4*)(nxt.src + (size_t)(nxt.k0 + kk + 32) * nxt.N + nxt.n0 + n4);
      }
      __builtin_amdgcn_sched_barrier(0);
      __syncthreads();
      tl[kk * 65 + n4 + 0] = v0.x; tl[kk * 65 + n4 + 1] = v0.y; tl[kk * 65 + n4 + 2] = v0.z; tl[kk * 65 + n4 + 3] = v0.w;
      tl[(kk + 32) * 65 + n4 + 0] = v1.x; tl[(kk + 32) * 65 + n4 + 1] = v1.y; tl[(kk + 32) * 65 + n4 + 2] = v1.z; tl[(kk + 32) * 65 + n4 + 3] = v1.w;
      __syncthreads();
      const int n = tid >> 3, k8 = (tid & 7) * 8;
      u32x4 o;
      o.x = pk_bf16(tl[(k8 + 0) * 65 + n], tl[(k8 + 1) * 65 + n]);
      o.y = pk_bf16(tl[(k8 + 2) * 65 + n], tl[(k8 + 3) * 65 + n]);
      o.z = pk_bf16(tl[(k8 + 4) * 65 + n], tl[(k8 + 5) * 65 + n]);
      o.w = pk_bf16(tl[(k8 + 6) * 65 + n], tl[(k8 + 7) * 65 + n]);
      *(u32x4*)(cur.dst + (size_t)(cur.n0 + n) * cur.ldd + cur.k0 + k8) = o;
      v0 = w0; v1 = w1; cur = nxt; t = tn;
    }
  }
}

DEVI void norm_row(const float* __restrict__ xr, const float* __restrict__ g, const float* __restrict__ mod, int lane, float (&h)[16]) {
  float4 x[4];
  float ss = 0.f;
#pragma unroll
  for (int i = 0; i < 4; ++i) {
    x[i] = *(const float4*)(xr + lane * 4 + 256 * i);
    ss += x[i].x * x[i].x + x[i].y * x[i].y + x[i].z * x[i].z + x[i].w * x[i].w;
  }
  ss = wave_sum(ss);
  const float rstd = rsqrtf(ss * (1.f / 1024.f) + 1e-6f);
#pragma unroll
  for (int i = 0; i < 4; ++i) {
    const int c = lane * 4 + 256 * i;
    const float4 gg = *(const float4*)(g + c);
    const float4 sh = *(const float4*)(mod + c);
    const float4 sc = *(const float4*)(mod + 1024 + c);
    h[i * 4 + 0] = x[i].x * rstd * gg.x * (1.f + sc.x) + sh.x;
    h[i * 4 + 1] = x[i].y * rstd * gg.y * (1.f + sc.y) + sh.y;
    h[i * 4 + 2] = x[i].z * rstd * gg.z * (1.f + sc.z) + sh.z;
    h[i * 4 + 3] = x[i].w * rstd * gg.w * (1.f + sc.w) + sh.w;
  }
}

template <bool WITH_HS>
__device__ __forceinline__ void norm_phase(const float* __restrict__ xl, const float* __restrict__ xc, const float* __restrict__ g,
                           const float* __restrict__ modL, bf16_t* __restrict__ H, bf16_t* __restrict__ HS) {
  const int tidx = opaque_tid();
  const int lane = tidx & 63;
  const int gw = blockIdx.x * (NTHR / 64) + (tidx >> 6), nw = gridDim.x * (NTHR / 64);
  for (int row = gw; row < MT; row += nw) {
    const bool lat = row < ML;
    const float* xbase = lat ? xl + (size_t)row * 1024 : xc + (size_t)(row - ML) * 1024;
    const float* mod = modL + (lat ? (row >> 12) : 8) * 3072;
    float h[16];
    norm_row(xbase, g, mod, lane, h);
#pragma unroll
    for (int i = 0; i < 4; ++i) {
      u32x2 o; o.x = pk_bf16(h[i * 4], h[i * 4 + 1]); o.y = pk_bf16(h[i * 4 + 2], h[i * 4 + 3]);
      *(u32x2*)(H + (size_t)row * 1024 + lane * 4 + 256 * i) = o;
    }
    if (WITH_HS) {
      const int t = lat ? (row & 4095) : ((row - ML) & 255);
      const int T = lat ? 4096 : 256;
      float s[16];
#pragma unroll
      for (int i = 0; i < 16; ++i) s[i] = 0.f;
      if (t > 0) { float hp[16]; norm_row(xbase - 1024, g, mod, lane, hp);
#pragma unroll
        for (int i = 0; i < 16; ++i) s[i] += hp[i]; }
      if (t < T - 1) { float hn[16]; norm_row(xbase + 1024, g, mod, lane, hn);
#pragma unroll
        for (int i = 0; i < 16; ++i) s[i] += hn[i]; }
#pragma unroll
      for (int i = 0; i < 4; ++i) {
        u32x2 o; o.x = pk_bf16(0.5f * s[i * 4], 0.5f * s[i * 4 + 1]); o.y = pk_bf16(0.5f * s[i * 4 + 2], 0.5f * s[i * 4 + 3]);
        *(u32x2*)(HS + (size_t)row * 1024 + lane * 4 + 256 * i) = o;
      }
    }
  }
}

struct ALPlain {
  const bf16_t* A; int lda;
  typedef u32x4 Regs;
  DEVI void stage(float*, int) const {}
  DEVI void issue(Regs& r, int row, int k) const { r = *(const u32x4*)(A + (size_t)row * lda + k); }
  DEVI u32x4 finish(const Regs& r, const float*, int) const { return r; }
};
struct ALMix {
  const bf16_t* H; const bf16_t* HS; const float* mu;
  struct Regs { u32x4 h, s; };
  DEVI void stage(float* sMu, int n0) const {
    const int grp = n0 >> 10;
    const int j = grp == 0 ? 0 : grp == 1 ? 2 : grp == 2 ? 3 : grp == 3 ? 5 : (n0 - 4096) < 128 ? 1 : 4;
    for (int e = threadIdx.x; e < 1024; e += NTHR) sMu[e] = mu[j * 1024 + e];
  }
  DEVI void issue(Regs& r, int row, int k) const {
    r.h = *(const u32x4*)(H + (size_t)row * 1024 + k);
    r.s = *(const u32x4*)(HS + (size_t)row * 1024 + k);
  }
  DEVI unsigned mix2(unsigned h, unsigned s, float m0, float m1) const {
    const float h0 = bf_lo(h), h1 = bf_hi(h), s0 = bf_lo(s), s1 = bf_hi(s);
    return pk_bf16(h0 + (s0 - h0) * m0, h1 + (s1 - h1) * m1);
  }
  DEVI u32x4 finish(const Regs& r, const float* sMu, int k) const {
    const float4 ma = *(const float4*)(sMu + k), mb = *(const float4*)(sMu + k + 4);
    u32x4 o;
    o.x = mix2(r.h.x, r.s.x, ma.x, ma.y); o.y = mix2(r.h.y, r.s.y, ma.z, ma.w);
    o.z = mix2(r.h.z, r.s.z, mb.x, mb.y); o.w = mix2(r.h.w, r.s.w, mb.z, mb.w);
    return o;
  }
};

template <class AL, class EP>
__device__ __forceinline__ void gemm_phase(char* lds, const bf16_t* __restrict__ Bt, int K, int mtiles, int ntiles, const AL al, const EP ep, int n_base = 0, bool reverse = false, int mt_base = 0) {
  bf16_t* sA = (bf16_t*)lds;
  bf16_t* sB = (bf16_t*)(lds + 73728);
  float* sMu = (float*)(lds + 110592);
  const int tid = opaque_tid(), lane = tid & 63, wv = tid >> 6, wm = wv >> 1, wn = wv & 1;
  const int l31 = lane & 31, lh = lane >> 5;
  const int nk = K >> 6;
  const int ldrow = tid >> 3, ldk = (tid & 7) * 8;
  const int total = mtiles * ntiles;
  const int bid = reverse ? (int)(gridDim.x - 1 - blockIdx.x) : (int)blockIdx.x;
  const int nslots = gridDim.x >> 3, xcd = bid & 7, slot = bid >> 3;
  const int gm = 4 * ntiles;
  for (int chunk = xcd; chunk * nslots < total; chunk += 8) {
    const int tile = chunk * nslots + slot;
    if (tile >= total) break;
    const int grp = tile / gm, rem = tile - grp * gm;
    const int mt = grp * 4 + (rem & 3), nt = rem >> 2;
    const int m0 = (mt_base + mt) * 256, n0 = n_base + nt * 128;
    __syncthreads();
    al.stage(sMu, n0);
    f32x16 acc[2][2];
#pragma unroll
    for (int a = 0; a < 2; ++a)
#pragma unroll
      for (int b = 0; b < 2; ++b)
#pragma unroll
        for (int r = 0; r < 16; ++r) acc[a][b][r] = 0.f;
    typename AL::Regs ar[4];
    u32x4 br[2];
#pragma unroll
    for (int i = 0; i < 4; ++i) al.issue(ar[i], m0 + ldrow + 64 * i, ldk);
#pragma unroll
    for (int i = 0; i < 2; ++i) br[i] = *(const u32x4*)(Bt + (size_t)(n0 + ldrow + 64 * i) * K + ldk);
    __syncthreads();
#pragma unroll
    for (int i = 0; i < 4; ++i) *(u32x4*)(sA + (ldrow + 64 * i) * 72 + ldk) = al.finish(ar[i], sMu, ldk);
#pragma unroll
    for (int i = 0; i < 2; ++i) *(u32x4*)(sB + (ldrow + 64 * i) * 72 + ldk) = br[i];
    __syncthreads();
    for (int kt = 0; kt < nk; ++kt) {
      const int cur = kt & 1;
      const bool more = (kt + 1) < nk;
      const int k0n = (kt + 1) * 64 + ldk;
      if (more) {
#pragma unroll
        for (int i = 0; i < 4; ++i) al.issue(ar[i], m0 + ldrow + 64 * i, k0n);
#pragma unroll
        for (int i = 0; i < 2; ++i) br[i] = *(const u32x4*)(Bt + (size_t)(n0 + ldrow + 64 * i) * K + k0n);
      }
      __builtin_amdgcn_sched_barrier(0);
      const bf16_t* a_ = sA + cur * (256 * 72);
      const bf16_t* b_ = sB + cur * (128 * 72);
#pragma unroll
      for (int kk = 0; kk < 4; ++kk) {
        u32x4 af[2], bfr[2];
#pragma unroll
        for (int mi = 0; mi < 2; ++mi) af[mi] = *(const u32x4*)(a_ + (wm * 64 + mi * 32 + l31) * 72 + kk * 16 + lh * 8);
#pragma unroll
        for (int ni = 0; ni < 2; ++ni) bfr[ni] = *(const u32x4*)(b_ + (wn * 64 + ni * 32 + l31) * 72 + kk * 16 + lh * 8);
#pragma unroll
        for (int mi = 0; mi < 2; ++mi)
#pragma unroll
          for (int ni = 0; ni < 2; ++ni) acc[mi][ni] = mfma32(bfr[ni], af[mi], acc[mi][ni]);
      }
      __builtin_amdgcn_sched_barrier(0);
      if (more) {
        bf16_t* an = sA + (cur ^ 1) * (256 * 72);
        bf16_t* bn = sB + (cur ^ 1) * (128 * 72);
#pragma unroll
        for (int i = 0; i < 4; ++i) *(u32x4*)(an + (ldrow + 64 * i) * 72 + ldk) = al.finish(ar[i], sMu, k0n);
#pragma unroll
        for (int i = 0; i < 2; ++i) *(u32x4*)(bn + (ldrow + 64 * i) * 72 + ldk) = br[i];
      }
      __syncthreads();
    }
#pragma unroll
    for (int mi = 0; mi < 2; ++mi)
#pragma unroll
      for (int ni = 0; ni < 2; ++ni)
#pragma unroll
        for (int q = 0; q < 4; ++q) {
          const int row = m0 + wm * 64 + mi * 32 + l31;
          const int col = n0 + wn * 64 + ni * 32 + 8 * q + 4 * lh;
          f32x4 v = {acc[mi][ni][4 * q], acc[mi][ni][4 * q + 1], acc[mi][ni][4 * q + 2], acc[mi][ni][4 * q + 3]};
          ep(row, col, v);
        }
  }
}


template <class AL, class EP>
__device__ __forceinline__ void gemm256_phase(char* lds, const bf16_t* __restrict__ Bt, int K, int mtiles, int ntiles, const AL al, const EP ep) {
  bf16_t* sA = (bf16_t*)lds;
  bf16_t* sB = (bf16_t*)(lds + 73728);
  float* sMu = (float*)(lds + 147456);
  const int tid = opaque_tid(), lane = tid & 63, wv = tid >> 6, wm = wv >> 1, wn = wv & 1;
  const int l31 = lane & 31, lh = lane >> 5;
  const int nk = K >> 6;
  const int ldrow = tid >> 3, ldk = (tid & 7) * 8;
  const int total = mtiles * ntiles;
  const int nslots = gridDim.x >> 3, xcd = blockIdx.x & 7, slot = blockIdx.x >> 3;
  const int gm = 4 * ntiles;
  for (int chunk = xcd; chunk * nslots < total; chunk += 8) {
    const int tile = chunk * nslots + slot;
    if (tile >= total) break;
    const int grp = tile / gm, rem = tile - grp * gm;
    const int mt = grp * 4 + (rem & 3), nt = rem >> 2;
    const int m0 = mt * 256, n0 = nt * 256;
    __syncthreads();
    al.stage(sMu, n0);
    f32x16 acc[2][4];
#pragma unroll
    for (int a = 0; a < 2; ++a)
#pragma unroll
      for (int b = 0; b < 4; ++b)
#pragma unroll
        for (int r = 0; r < 16; ++r) acc[a][b][r] = 0.f;
    typename AL::Regs ar[4];
    u32x4 br[4];
#pragma unroll
    for (int i = 0; i < 4; ++i) al.issue(ar[i], m0 + ldrow + 64 * i, ldk);
#pragma unroll
    for (int i = 0; i < 4; ++i) br[i] = *(const u32x4*)(Bt + (size_t)(n0 + ldrow + 64 * i) * K + ldk);
    __syncthreads();
#pragma unroll
    for (int i = 0; i < 4; ++i) *(u32x4*)(sA + (ldrow + 64 * i) * 72 + ldk) = al.finish(ar[i], sMu, ldk);
#pragma unroll
    for (int i = 0; i < 4; ++i) *(u32x4*)(sB + (ldrow + 64 * i) * 72 + ldk) = br[i];
    __syncthreads();
    const int half = __builtin_amdgcn_readfirstlane(wv >> 2);
    if (half == 1 && nk > 1) {
#pragma unroll
      for (int i = 0; i < 4; ++i) al.issue(ar[i], m0 + ldrow + 64 * i, 64 + ldk);
#pragma unroll
      for (int i = 0; i < 4; ++i) br[i] = *(const u32x4*)(Bt + (size_t)(n0 + ldrow + 64 * i) * K + 64 + ldk);
    }
    for (int step = 0; step < 2 * nk; ++step) {
      const int kc = step >> 1;
      if ((step & 1) == half) {
        const int kl = kc + 1 + half;
        if (kl < nk) {
          const int k0n = kl * 64 + ldk;
#pragma unroll
          for (int i = 0; i < 4; ++i) al.issue(ar[i], m0 + ldrow + 64 * i, k0n);
#pragma unroll
          for (int i = 0; i < 4; ++i) br[i] = *(const u32x4*)(Bt + (size_t)(n0 + ldrow + 64 * i) * K + k0n);
        }
        __builtin_amdgcn_sched_barrier(0);
        const bf16_t* a_ = sA + (kc & 1) * (256 * 72);
        const bf16_t* b_ = sB + (kc & 1) * (256 * 72);
#pragma unroll
        for (int kk = 0; kk < 4; ++kk) {
          u32x4 af[2];
#pragma unroll
          for (int mi = 0; mi < 2; ++mi) af[mi] = *(const u32x4*)(a_ + (wm * 64 + mi * 32 + l31) * 72 + kk * 16 + lh * 8);
#pragma unroll
          for (int ni = 0; ni < 4; ++ni) {
            const u32x4 bfr = *(const u32x4*)(b_ + (wn * 128 + ni * 32 + l31) * 72 + kk * 16 + lh * 8);
#pragma unroll
            for (int mi = 0; mi < 2; ++mi) acc[mi][ni] = mfma32(bfr, af[mi], acc[mi][ni]);
          }
        }
        __builtin_amdgcn_sched_barrier(0);
      } else {
        const int kf = kc + 1;
        if (kf < nk) {
          bf16_t* an = sA + (kf & 1) * (256 * 72);
          bf16_t* bn = sB + (kf & 1) * (256 * 72);
          const int k0n = kf * 64 + ldk;
#pragma unroll
          for (int i = 0; i < 4; ++i) *(u32x4*)(an + (ldrow + 64 * i) * 72 + ldk) = al.finish(ar[i], sMu, k0n);
#pragma unroll
          for (int i = 0; i < 4; ++i) *(u32x4*)(bn + (ldrow + 64 * i) * 72 + ldk) = br[i];
        }
      }
      __syncthreads();
    }
    if constexpr (EP::VIA_LDS) {
      float* reg = (float*)(lds + wv * 16896);
#pragma unroll
      for (int mi = 0; mi < 2; ++mi) {
#pragma unroll
        for (int ni = 0; ni < 4; ++ni)
#pragma unroll
          for (int q = 0; q < 4; ++q) {
            f32x4 v = {acc[mi][ni][4 * q], acc[mi][ni][4 * q + 1], acc[mi][ni][4 * q + 2], acc[mi][ni][4 * q + 3]};
            *(f32x4*)(reg + l31 * 132 + ni * 32 + 8 * q + 4 * lh) = v;
          }
#pragma unroll 4
        for (int it = 0; it < 16; ++it) {
          const int rl = it * 2 + lh;
          const f32x4 v = *(const f32x4*)(reg + rl * 132 + l31 * 4);
          ep(m0 + wm * 64 + mi * 32 + rl, n0 + wn * 128 + l31 * 4, v);
        }
      }
    } else
#pragma unroll
    for (int mi = 0; mi < 2; ++mi)
#pragma unroll
      for (int ni = 0; ni < 4; ++ni) {
#pragma unroll
        for (int q = 0; q < 4; ++q) {
          const int row = m0 + wm * 64 + mi * 32 + l31;
          const int col = n0 + wn * 128 + ni * 32 + 8 * q + 4 * lh;
          f32x4 v = {acc[mi][ni][4 * q], acc[mi][ni][4 * q + 1], acc[mi][ni][4 * q + 2], acc[mi][ni][4 * q + 3]};
          ep(row, col, v);
        }
        __builtin_amdgcn_sched_barrier(0);
      }
  }
}

DEVI void st_bf16x4(bf16_t* p, f32x4 v) { u32x2 o; o.x = pk_bf16(v[0], v[1]); o.y = pk_bf16(v[2], v[3]); *(u32x2*)p = o; }

struct EpRwkvIn {
  static constexpr bool VIA_LDS = false;
  bf16_t *R, *K, *V, *G, *WD, *AD;
  DEVI void operator()(int row, int col, f32x4 v) const {
    const int grp = col >> 10;
    if (grp < 4) {
      const int c = col & 1023;
      bf16_t* dst = grp == 0 ? R : grp == 1 ? K : grp == 2 ? V : G;
      if (grp == 3) { v[0] = siluf_(v[0]); v[1] = siluf_(v[1]); v[2] = siluf_(v[2]); v[3] = siluf_(v[3]); }
      st_bf16x4(dst + (size_t)row * 1024 + c, v);
    } else {
      const int c = col - 4096;
      if (c < 128) {
#pragma unroll
        for (int i = 0; i < 4; ++i) { const float t = __expf(2.f * v[i]); v[i] = 1.f - 2.f / (t + 1.f); }
        st_bf16x4(WD + (size_t)row * 128 + c, v);
      } else st_bf16x4(AD + (size_t)row * 128 + (c - 128), v);
    }
  }
};
struct EpRes {
  static constexpr bool VIA_LDS = false;
  const float* xl_src; const float* xc_src; float* xl_dst; float* xc_dst; const float* modL;
  DEVI void operator()(int row, int col, f32x4 v) const {
    const bool lat = row < ML;
    const size_t off = lat ? (size_t)row * 1024 + col : (size_t)(row - ML) * 1024 + col;
    const float* src = (lat ? xl_src : xc_src) + off;
    float* dst = (lat ? xl_dst : xc_dst) + off;
    const f32x4 g = *(const f32x4*)(modL + (lat ? (row >> 12) : 8) * 3072 + 2048 + col);
    f32x4 x = *(const f32x4*)src;
    x += g * v;
    *(f32x4*)dst = x;
  }
};
struct EpLruIn {
  static constexpr bool VIA_LDS = false;
  bf16_t *XR, *GG;
  DEVI void operator()(int row, int col, f32x4 v) const {
    if (col < LW) st_bf16x4(XR + (size_t)row * LW + col, v);
    else { v[0] = siluf_(v[0]); v[1] = siluf_(v[1]); v[2] = siluf_(v[2]); v[3] = siluf_(v[3]); st_bf16x4(GG + (size_t)row * LW + (col - LW), v); }
  }
};
struct EpNatIn {
  static constexpr bool VIA_LDS = false;
  bf16_t *Q, *K, *VT, *G;
  DEVI void operator()(int row, int col, f32x4 v) const {
    const int grp = col >> 10, c = col & 1023;
    if (grp == 0) st_bf16x4(Q + (size_t)row * 1024 + c, v);
    else if (grp == 1) st_bf16x4(K + (size_t)row * 1024 + c, v);
    else if (grp == 3) { v[0] = siluf_(v[0]); v[1] = siluf_(v[1]); v[2] = siluf_(v[2]); v[3] = siluf_(v[3]); st_bf16x4(G + (size_t)row * 1024 + c, v); }
    else {
      unsigned idx, T;
      if (row < ML) { const unsigned b = row >> 12, t = row & 4095; T = 4096u; idx = ((b * 1024u + (unsigned)c) << 12) + t; }
      else { const unsigned r2 = row - ML; const unsigned b = r2 >> 8, t = r2 & 255; T = 256u; idx = (unsigned)ML * 1024u + ((b * 1024u + (unsigned)c) << 8) + t; }
#pragma unroll
      for (int i = 0; i < 4; ++i) VT[idx + (unsigned)i * T] = f2bf(v[i]);
    }
  }
};

DEVI int rwkv_row(int b, int d, int s) {
  if (s < 256) return ML + b * 256 + (d ? 255 - s : s);
  const int t = s - 256;
  return b * 4096 + (d ? 4095 - t : t);
}

constexpr int PSTR = 456, PREC_Y = 64, PREC_V0 = 192, PREC_V1 = 256, PREC_SC = 320, PREC_BF = 328;
constexpr int TSTR = 388;
struct ScanRec { u32x4 a1, a2; float v0, v1; f32x4 s0, s1; f32x4 ww[4]; u32x2 y[4]; };
DEVI void scan_load(ScanRec& R, const float* rec, int g, int c16, int role_off, int srow) {
  const char* ab = (const char*)(rec + PREC_BF) + role_off + g * 16;
  R.a1 = *(const u32x4*)ab; R.a2 = *(const u32x4*)(ab + 64);
  R.v0 = rec[PREC_V0 + srow]; R.v1 = rec[PREC_V1 + srow];
  R.s0 = *(const f32x4*)(rec + PREC_SC); R.s1 = *(const f32x4*)(rec + PREC_SC + 4);
#pragma unroll
  for (int nt = 0; nt < 4; ++nt) {
    R.ww[nt] = *(const f32x4*)(rec + 16 * nt + 4 * g);
    R.y[nt] = *(const u32x2*)((const char*)(rec + PREC_Y) + (16 * nt + c16) * 8);
  }
}
DEVI void scan_step2(f32x4 (&S)[4], const ScanRec& R, bool g0, float* yout) {
  const u32x4 b1 = mk4(pk_bf16(S[0][0], S[0][1]), pk_bf16(S[0][2], S[0][3]), pk_bf16(S[1][0], S[1][1]), pk_bf16(S[1][2], S[1][3]));
  const u32x4 b2 = mk4(pk_bf16(S[2][0], S[2][1]), pk_bf16(S[2][2], S[2][3]), pk_bf16(S[3][0], S[3][1]), pk_bf16(S[3][2], S[3][3]));
  f32x4 D = {0.f, 0.f, 0.f, 0.f};
  D = mfma16(R.a1, b1, D);
  D = mfma16(R.a2, b2, D);
  const float v0 = R.v0, v1 = R.v1;
  const float sa0 = D[0];
  const float sa1 = D[2] + sa0 * R.s0[2] + v0 * R.s0[3];
  const unsigned x0 = pk_bf16(sa0, v0), x1 = pk_bf16(sa1, v1);
  const u32x4 xb = mk4(g0 ? x0 : 0u, g0 ? x1 : 0u, 0u, 0u);
#pragma unroll
  for (int nt = 0; nt < 4; ++nt) S[nt] = mfma16(mk4(R.y[nt].x, R.y[nt].y, 0u, 0u), xb, S[nt] * R.ww[nt]);
  yout[0] = D[1] + sa0 * R.s0[0] + v0 * R.s0[1];
  yout[256] = D[3] + sa0 * R.s1[0] + v0 * R.s1[1] + sa1 * R.s1[2] + v1 * R.s1[3];
}
DEVI float sum16(float v) { v = sum8(v); v += dpp_f<0x140>(v); return v; }

__device__ __forceinline__ void rwkv_scan_phase(char* lds, const bf16_t* __restrict__ R, const bf16_t* __restrict__ Kb, const bf16_t* __restrict__ V,
                                const bf16_t* __restrict__ WD, const bf16_t* __restrict__ AD, const bf16_t* __restrict__ Wup,
                                const float* __restrict__ b0, const float* __restrict__ k_ka, const float* __restrict__ r_k,
                                bf16_t* __restrict__ Y0, bf16_t* __restrict__ Y1, float* __restrict__ BON) {
  float* stepbuf = (float*)lds;
  float* tokbuf = stepbuf + 2 * 8 * PSTR;
  float* wabuf = tokbuf + 2 * 16 * TSTR;
  float* ybuf = wabuf + 4096;
  const int tid = opaque_tid(), lane = tid & 63, wv = tid >> 6;
  constexpr int NCH = (256 + 4096) / 16;
  for (int chain = blockIdx.x; chain < 256; chain += gridDim.x) {
    const int d = chain & 1, h = (chain >> 1) & 15, b = chain >> 5;
    __syncthreads();
    if (wv < 4) {
      const int kq = lane >> 4, c16 = lane & 15, srow = wv * 16 + c16;
      const int role_off = (lane & 3) * 128;
      const bool g0 = kq == 0;
      f32x4 S[4];
#pragma unroll
      for (int j = 0; j < 4; ++j) S[j] = (f32x4){0.f, 0.f, 0.f, 0.f};
      __syncthreads();
      __syncthreads();
      __syncthreads();
      for (int c = 0; c < NCH; ++c) {
        const float* sb = stepbuf + (c & 1) * 8 * PSTR;
        float* yb = ybuf + (c & 1) * 4096 + kq * 64 + srow;
        ScanRec ra, rb;
        scan_load(ra, sb, kq, c16, role_off, srow);
#pragma unroll
        for (int i = 0; i < 4; i += 2) {
          scan_load(rb, sb + (i + 1) * PSTR, kq, c16, role_off, srow);
          scan_step2(S, ra, g0, yb + i * 512);
          scan_load(ra, sb + (i + 2) * PSTR, kq, c16, role_off, srow);
          scan_step2(S, rb, g0, yb + (i + 1) * 512);
        }
#pragma unroll
        for (int i = 4; i < 8; i += 2) {
          scan_load(rb, sb + (i + 1) * PSTR, kq, c16, role_off, srow);
          scan_step2(S, ra, g0, yb + i * 512);
          if (i + 2 < 8) scan_load(ra, sb + (i + 2) * PSTR, kq, c16, role_off, srow);
          scan_step2(S, rb, g0, yb + (i + 1) * 512);
        }
        __syncthreads();
      }
    } else {
      const int ptid = tid - 256, pw = wv - 4;
      bf16_t* Y = d ? Y1 : Y0;
      const int ncol = h * 64 + pw * 16 + (lane & 15);
      u32x4 bu[2][2];
      float bias_u[2];
#pragma unroll
      for (int kind = 0; kind < 2; ++kind) {
        const bf16_t* wu = Wup + ((size_t)(d * 2 + kind) * 1024 + ncol) * 64 + 8 * (lane >> 4);
        bu[kind][0] = *(const u32x4*)wu; bu[kind][1] = *(const u32x4*)(wu + 32);
        bias_u[kind] = b0[(d * 2 + kind) * 1024 + ncol];
      }
      const int ti = ptid >> 4, dq = ptid & 15;
      const int hc = h * 64 + 4 * dq;
      const f32x4 kkv = *(const f32x4*)(k_ka + hc), kav = *(const f32x4*)(k_ka + 1024 + hc), rkv = *(const f32x4*)(r_k + hc);
      u32x4 xw0, xw1, xa0, xa1; u32x2 rr, kr, vr;
      auto issueL = [&](int c) {
        const int rowA = rwkv_row(b, d, c * 16 + (lane & 15));
        const bf16_t* xp = WD + (size_t)rowA * 128 + d * 64 + 8 * (lane >> 4);
        const bf16_t* xq = AD + (size_t)rowA * 128 + d * 64 + 8 * (lane >> 4);
        xw0 = *(const u32x4*)xp; xw1 = *(const u32x4*)(xp + 32);
        xa0 = *(const u32x4*)xq; xa1 = *(const u32x4*)(xq + 32);
      };
      auto issueT = [&](int c) {
        const int rowB = rwkv_row(b, d, c * 16 + ti);
        rr = *(const u32x2*)(R + (size_t)rowB * 1024 + hc);
        kr = *(const u32x2*)(Kb + (size_t)rowB * 1024 + hc);
        vr = *(const u32x2*)(V + (size_t)rowB * 1024 + hc);
      };
      auto stepA = [&](int c) {
        float* wbuf = wabuf + (c & 1) * 2048; float* abuf = wbuf + 1024;
        f32x4 accw = {0.f, 0.f, 0.f, 0.f}, acca = {0.f, 0.f, 0.f, 0.f};
        accw = mfma16(xw0, bu[0][0], accw); accw = mfma16(xw1, bu[0][1], accw);
        acca = mfma16(xa0, bu[1][0], acca); acca = mfma16(xa1, bu[1][1], acca);
#pragma unroll
        for (int r = 0; r < 4; ++r) {
          const int o = ((lane >> 4) * 4 + r) * 64 + pw * 16 + (lane & 15);
          const float x = -(accw[r] + bias_u[0]);
          const float sp = fmaxf(x, 0.f) + 0.6931471805599453f * __builtin_amdgcn_logf(1.f + __builtin_amdgcn_exp2f(-1.4426950408889634f * fabsf(x)));
          const float ew = __builtin_amdgcn_exp2f(-1.4426950408889634f * (sp + 0.5f));
          wbuf[o] = __builtin_amdgcn_exp2f(-1.4426950408889634f * ew);
          abuf[o] = __builtin_amdgcn_rcpf(1.f + __builtin_amdgcn_exp2f(-1.4426950408889634f * (acca[r] + bias_u[1])));
        }
      };
      auto stepB1 = [&](int c) {
        const float rv[4] = {bf_lo(rr.x), bf_hi(rr.x), bf_lo(rr.y), bf_hi(rr.y)};
        const float kv[4] = {bf_lo(kr.x), bf_hi(kr.x), bf_lo(kr.y), bf_hi(kr.y)};
        const float vv[4] = {bf_lo(vr.x), bf_hi(vr.x), bf_lo(vr.y), bf_hi(vr.y)};
        const float* wbuf = wabuf + (c & 1) * 2048; const float* abuf = wbuf + 1024;
        const f32x4 av = *(const f32x4*)(abuf + ti * 64 + 4 * dq), wv4 = *(const f32x4*)(wbuf + ti * 64 + 4 * dq);
        float q[4], ss = 0.f;
#pragma unroll
        for (int i = 0; i < 4; ++i) { q[i] = kv[i] * kkv[i]; ss += q[i] * q[i]; }
        ss = sum16(ss);
        const float inv = __builtin_amdgcn_rsqf(fmaxf(ss, 1e-24f));
        f32x4 nk, wrr, ka, kd, vo;
        float c1 = 0.f, c2 = 0.f, bn = 0.f;
#pragma unroll
        for (int i = 0; i < 4; ++i) {
          const float n = q[i] * inv;
          kd[i] = kv[i] * (1.f + (av[i] - 1.f) * kav[i]);
          ka[i] = n * av[i];
          nk[i] = -n; wrr[i] = wv4[i] * rv[i]; vo[i] = vv[i];
          c1 += ka[i] * rv[i]; c2 += kd[i] * rv[i]; bn += rv[i] * kd[i] * rkv[i];
        }
        c1 = sum16(c1); c2 = sum16(c2); bn = sum16(bn);
        float* rec = tokbuf + ((c & 1) * 16 + ti) * TSTR;
        *(f32x4*)(rec + 4 * dq) = nk;
        *(f32x4*)(rec + 64 + 4 * dq) = wrr;
        *(f32x4*)(rec + 128 + 4 * dq) = wv4;
        *(f32x4*)(rec + 192 + 4 * dq) = ka;
        *(f32x4*)(rec + 256 + 4 * dq) = kd;
        *(f32x4*)(rec + 320 + 4 * dq) = vo;
        if (dq == 0) {
          *(f32x2*)(rec + 384) = (f32x2){c1, c2};
          BON[((size_t)d * MT + rwkv_row(b, d, c * 16 + ti)) * 16 + h] = bn;
        }
      };
      auto stepB2 = [&](int c) {
        const int pp = ptid >> 5, dp = ptid & 31;
        const float* t0 = tokbuf + ((c & 1) * 16 + 2 * pp) * TSTR + 2 * dp;
        const float* t1 = t0 + TSTR;
        const f32x2 a0 = *(const f32x2*)(t0), wr0 = *(const f32x2*)(t0 + 64), w0 = *(const f32x2*)(t0 + 128);
        const f32x2 b0_ = *(const f32x2*)(t0 + 192), k0_ = *(const f32x2*)(t0 + 256), v0 = *(const f32x2*)(t0 + 320);
        const f32x2 a1 = *(const f32x2*)(t1), wr1 = *(const f32x2*)(t1 + 64), w1 = *(const f32x2*)(t1 + 128);
        const f32x2 b1_ = *(const f32x2*)(t1 + 192), k1_ = *(const f32x2*)(t1 + 256), v1 = *(const f32x2*)(t1 + 320);
        float c3 = b0_[0] * a1[0] + b0_[1] * a1[1], c4 = k0_[0] * a1[0] + k0_[1] * a1[1];
        float c5 = b0_[0] * wr1[0] + b0_[1] * wr1[1], c6 = k0_[0] * wr1[0] + k0_[1] * wr1[1];
        c3 = sum16(c3); c4 = sum16(c4); c5 = sum16(c5); c6 = sum16(c6);
        c3 += __shfl_xor(c3, 16); c4 += __shfl_xor(c4, 16); c5 += __shfl_xor(c5, 16); c6 += __shfl_xor(c6, 16);
        float* rec = stepbuf + ((c & 1) * 8 + pp) * PSTR;
        *(f32x2*)(rec + 2 * dp) = w0 * w1;
        {
          const f32x2 bw = b0_ * w1, kw = k0_ * w1;
          *(u32x4*)((char*)(rec + PREC_Y) + 16 * dp) = mk4(pk_bf16(bw[0], kw[0]), pk_bf16(b1_[0], k1_[0]), pk_bf16(bw[1], kw[1]), pk_bf16(b1_[1], k1_[1]));
        }
        *(f32x2*)(rec + PREC_V0 + 2 * dp) = v0;
        *(f32x2*)(rec + PREC_V1 + 2 * dp) = v1;
        unsigned* bb = (unsigned*)(rec + PREC_BF);
        const f32x2 wa = w0 * a1, wwr = w0 * wr1;
        const int kk = (2 * dp) & 31;
        const int pos = ((2 * dp) & 32) + (kk < 16 ? 8 * (kk >> 2) + (kk & 3) : 8 * ((kk - 16) >> 2) + 4 + (kk & 3));
        const int pu = pos >> 1;
        bb[pu] = pk_bf16(a0[0], a0[1]);
        bb[32 + pu] = pk_bf16(wr0[0], wr0[1]);
        bb[64 + pu] = pk_bf16(wa[0], wa[1]);
        bb[96 + pu] = pk_bf16(wwr[0], wwr[1]);
        if (dp == 0) {
          const f32x2 cc0 = *(const f32x2*)(t0 + 384), cc1 = *(const f32x2*)(t1 + 384);
          *(f32x4*)(rec + PREC_SC) = (f32x4){cc0[0], cc0[1], c3, c4};
          *(f32x4*)(rec + PREC_SC + 4) = (f32x4){c5, c6, cc1[0], cc1[1]};
        }
      };
      auto storeY = [&](int c) {
        const f32x4 yv = *(const f32x4*)(ybuf + (c & 1) * 4096 + ti * 256 + 4 * dq);
        u32x2 o; o.x = pk_bf16(yv[0], yv[1]); o.y = pk_bf16(yv[2], yv[3]);
        *(u32x2*)(Y + (size_t)rwkv_row(b, d, c * 16 + ti) * 1024 + hc) = o;
      };
      issueL(0); issueT(0);
      stepA(0);
      issueL(1);
      __syncthreads();
      stepB1(0); issueT(1);
      stepA(1); issueL(2);
      __syncthreads();
      stepB2(0);
      stepB1(1); issueT(2);
      stepA(2); issueL(3);
      __builtin_amdgcn_sched_barrier(0);
      __syncthreads();
      __builtin_amdgcn_sched_barrier(0);
      for (int c = 0; c < NCH; ++c) {
        if (c + 3 < NCH) stepA(c + 3);
        if (c + 4 < NCH) issueL(c + 4);
        if (c + 2 < NCH) stepB1(c + 2);
        if (c + 3 < NCH) issueT(c + 3);
        if (c + 1 < NCH) stepB2(c + 1);
        if (c >= 1) storeY(c - 1);
        __builtin_amdgcn_sched_barrier(0);
        __syncthreads();
        __builtin_amdgcn_sched_barrier(0);
      }
      storeY(NCH - 1);
    }
  }
}

__device__ __forceinline__ void rwkv_post_phase(const bf16_t* __restrict__ Y0, const bf16_t* __restrict__ Y1, const bf16_t* __restrict__ V,
                                bf16_t* __restrict__ G, const float* __restrict__ BON, const float* __restrict__ gn, int nrows) {
  const int tidx = opaque_tid();
  const int lane = tidx & 63;
  const int gw = blockIdx.x * (NTHR / 64) + (tidx >> 6), nw = gridDim.x * (NTHR / 64);
  const int head = lane >> 2, c0 = lane * 16;
  for (int row = gw; row < nrows; row += nw) {
    const size_t off = (size_t)row * 1024 + c0;
    float y[16], v[16], g[16];
#pragma unroll
    for (int i = 0; i < 2; ++i) {
      const u32x4 a0 = *(const u32x4*)(Y0 + off + 8 * i), a1 = *(const u32x4*)(Y1 + off + 8 * i);
      const u32x4 av = *(const u32x4*)(V + off + 8 * i), ag = *(const u32x4*)(G + off + 8 * i);
      y[8 * i + 0] = bf_lo(a0.x) + bf_lo(a1.x); y[8 * i + 1] = bf_hi(a0.x) + bf_hi(a1.x);
      y[8 * i + 2] = bf_lo(a0.y) + bf_lo(a1.y); y[8 * i + 3] = bf_hi(a0.y) + bf_hi(a1.y);
      y[8 * i + 4] = bf_lo(a0.z) + bf_lo(a1.z); y[8 * i + 5] = bf_hi(a0.z) + bf_hi(a1.z);
      y[8 * i + 6] = bf_lo(a0.w) + bf_lo(a1.w); y[8 * i + 7] = bf_hi(a0.w) + bf_hi(a1.w);
      v[8 * i + 0] = bf_lo(av.x); v[8 * i + 1] = bf_hi(av.x); v[8 * i + 2] = bf_lo(av.y); v[8 * i + 3] = bf_hi(av.y);
      v[8 * i + 4] = bf_lo(av.z); v[8 * i + 5] = bf_hi(av.z); v[8 * i + 6] = bf_lo(av.w); v[8 * i + 7] = bf_hi(av.w);
      g[8 * i + 0] = bf_lo(ag.x); g[8 * i + 1] = bf_hi(ag.x); g[8 * i + 2] = bf_lo(ag.y); g[8 * i + 3] = bf_hi(ag.y);
      g[8 * i + 4] = bf_lo(ag.z); g[8 * i + 5] = bf_hi(ag.z); g[8 * i + 6] = bf_lo(ag.w); g[8 * i + 7] = bf_hi(ag.w);
    }
    float s = 0.f;
#pragma unroll
    for (int i = 0; i < 16; ++i) s += y[i];
    s += __shfl_xor(s, 1); s += __shfl_xor(s, 2);
    const float mean = s * (1.f / 64.f);
    float q = 0.f;
#pragma unroll
    for (int i = 0; i < 16; ++i) { const float dlt = y[i] - mean; q += dlt * dlt; }
    q += __shfl_xor(q, 1); q += __shfl_xor(q, 2);
    const float rstd = rsqrtf(q * (1.f / 64.f) + 64e-5f);
    const float bonus = BON[(size_t)row * 16 + head] + BON[((size_t)MT + row) * 16 + head];
    unsigned o[8];
#pragma unroll
    for (int i = 0; i < 8; ++i) {
      const float z0 = ((y[2 * i] - mean) * rstd * gn[c0 + 2 * i] + gn[1024 + c0 + 2 * i] + bonus * v[2 * i]) * g[2 * i];
      const float z1 = ((y[2 * i + 1] - mean) * rstd * gn[c0 + 2 * i + 1] + gn[1024 + c0 + 2 * i + 1] + bonus * v[2 * i + 1]) * g[2 * i + 1];
      o[i] = pk_bf16(z0, z1);
    }
    *(u32x4*)(G + off) = mk4(o[0], o[1], o[2], o[3]);
    *(u32x4*)(G + off + 8) = mk4(o[4], o[5], o[6], o[7]);
  }
}

__device__ __forceinline__ void rglru_phase(char* lds, const bf16_t* __restrict__ XR, const bf16_t* __restrict__ Wg, const float* __restrict__ conv_w,
                            const float* __restrict__ conv_b, const float* __restrict__ gate_b, const float* __restrict__ lam,
                            bf16_t* __restrict__ HS0, bf16_t* __restrict__ HS1) {
  bf16_t* xcT = (bf16_t*)lds;
  f32x2* AB = (f32x2*)(lds + 26624);
  bf16_t* raw = (bf16_t*)(lds + 26624);
  float* segP = (float*)(lds + 116736);
  float* segH = segP + 352;
  float* segC = segH + 352;
  bf16_t* wgs = (bf16_t*)(lds + 120960);
  float* cws = (float*)(lds + 160896);
  const int tid = opaque_tid(), lane = tid & 63, wv = tid >> 6;
  for (int chain = blockIdx.x; chain < 256; chain += gridDim.x) {
    const int d = chain & 1, blk = (chain >> 1) & 15, b = chain >> 5;
    bf16_t* HS = d ? HS1 : HS0;
    float carry = 0.f;
    __syncthreads();
    for (int q = tid; q < 2 * 96 * 12; q += NTHR) {
      const int g = q / 1152, rem = q - g * 1152, n = rem / 12, k8 = rem - n * 12;
      *(u32x4*)(wgs + (g * 96 + n) * 104 + k8 * 8) = *(const u32x4*)(Wg + ((size_t)((blk * 4 + d * 2 + g) * 96 + n)) * 96 + k8 * 8);
    }
    for (int e = tid; e < 5 * 88; e += NTHR) {
      const int j = e / 88, c = e - j * 88;
      cws[e] = j < 4 ? conv_w[j * LW + blk * 88 + c] : conv_b[blk * 88 + c];
    }
    for (int e = tid; e < 128 * 8; e += NTHR) xcT[(e >> 3) * 104 + 88 + (e & 7)] = 0;
    u32x4 pre[3];
    auto tile_geom = [&](int ti, int& seqbase, int& t0, int& T) {
      if (ti < 2) { seqbase = ML + b * 256; T = 256; t0 = (d ? 1 - ti : ti) * 128; }
      else { seqbase = b * 4096; T = 4096; t0 = (d ? 31 - (ti - 2) : (ti - 2)) * 128; }
    };
    auto prefetch = [&](int ti) {
      int seqbase, t0, T; tile_geom(ti, seqbase, t0, T);
#pragma unroll
      for (int i = 0; i < 3; ++i) {
        const int q = tid + NTHR * i;
        const int row = q / 11, cc = q - row * 11, t = t0 - 2 + row;
        u32x4 v = {0u, 0u, 0u, 0u};
        if (q < 131 * 11 && t >= 0 && t < T) v = *(const u32x4*)(XR + (size_t)(seqbase + t) * LW + blk * 88 + cc * 8);
        pre[i] = v;
      }
    };
    prefetch(0);
    for (int ti = 0; ti < 34; ++ti) {
      int seqbase, t0, T; tile_geom(ti, seqbase, t0, T);
      __syncthreads();
#pragma unroll
      for (int i = 0; i < 3; ++i) {
        const int q = tid + NTHR * i;
        if (q < 131 * 11) *(u32x4*)(raw + q * 8) = pre[i];
      }
      if (ti + 1 < 34) prefetch(ti + 1);
      __builtin_amdgcn_sched_barrier(0);
      __syncthreads();
      for (int e = tid; e < 128 * 44; e += NTHR) {
        const int tl = e / 44, c2 = (e - tl * 44) * 2;
        float a0 = cws[4 * 88 + c2], a1 = cws[4 * 88 + c2 + 1];
#pragma unroll
        for (int j = 0; j < 4; ++j) {
          const unsigned x = *(const unsigned*)(raw + (tl + j) * 88 + c2);
          a0 += bf_lo(x) * cws[j * 88 + c2]; a1 += bf_hi(x) * cws[j * 88 + c2 + 1];
        }
        *(unsigned*)(xcT + tl * 104 + c2) = pk_bf16(a0, a1);
      }
      __syncthreads();
      {
        const int tok = wv * 16 + (lane & 15);
        u32x4 af[3];
#pragma unroll
        for (int kk = 0; kk < 3; ++kk) af[kk] = *(const u32x4*)(xcT + tok * 104 + kk * 32 + 8 * (lane >> 4));
#pragma unroll
        for (int n6 = 0; n6 < 6; ++n6) {
          f32x4 accr = {0.f, 0.f, 0.f, 0.f}, acci = {0.f, 0.f, 0.f, 0.f};
          const int ncol = n6 * 16 + (lane & 15);
          const bf16_t* wr_ = wgs + ncol * 104 + 8 * (lane >> 4);
          const bf16_t* wi_ = wgs + (96 + ncol) * 104 + 8 * (lane >> 4);
#pragma unroll
          for (int kk = 0; kk < 3; ++kk) {
            accr = mfma16(af[kk], *(const u32x4*)(wr_ + kk * 32), accr);
            acci = mfma16(af[kk], *(const u32x4*)(wi_ + kk * 32), acci);
          }
          if (ncol < 88) {
            const int ch = blk * 88 + ncol;
            const float gbr = gate_b[(d * 2 + 0) * LW + ch], gbi = gate_b[(d * 2 + 1) * LW + ch];
            const float spl = softplusf_(-lam[d * LW + ch]);
#pragma unroll
            for (int r = 0; r < 4; ++r) {
              const int tk = wv * 16 + (lane >> 4) * 4 + r;
              const float rg = sigmoidf_(accr[r] + gbr), ig = sigmoidf_(acci[r] + gbi);
              const float a = __expf(-8.f * rg * spl);
              const float bb = sqrtf(fmaxf(1.f - a * a, 0.f)) * ig * bf2f(xcT[tk * 104 + ncol]);
              AB[tk * 88 + ncol] = (f32x2){a, bb};
            }
          }
        }
      }
      __syncthreads();
      if (tid < 352) {
        const int seg = tid / 88, c = tid - seg * 88;
        float hl = 0.f, P = 1.f;
        for (int u0 = seg * 32; u0 < seg * 32 + 32; u0 += 8) {
          f32x2 ab[8];
#pragma unroll
          for (int i = 0; i < 8; ++i) { const int tl = d ? 127 - (u0 + i) : (u0 + i); ab[i] = AB[tl * 88 + c]; }
#pragma unroll
          for (int i = 0; i < 8; ++i) { hl = ab[i][0] * hl + ab[i][1]; P *= ab[i][0]; ab[i] = (f32x2){hl, P}; }
#pragma unroll
          for (int i = 0; i < 8; ++i) { const int tl = d ? 127 - (u0 + i) : (u0 + i); AB[tl * 88 + c] = ab[i]; }
        }
        segH[seg * 88 + c] = hl; segP[seg * 88 + c] = P;
      }
      __syncthreads();
      if (tid < 88) {
        float cur = carry;
#pragma unroll
        for (int seg = 0; seg < 4; ++seg) { segC[seg * 88 + tid] = cur; cur = segP[seg * 88 + tid] * cur + segH[seg * 88 + tid]; }
        carry = cur;
      }
      __syncthreads();
      for (int q = tid; q < 128 * 11; q += NTHR) {
        const int tl = q / 11, c8 = (q - tl * 11) * 8;
        const int u = d ? 127 - tl : tl;
        const float* sc = segC + (u >> 5) * 88 + c8;
        float hv[8];
#pragma unroll
        for (int i = 0; i < 8; ++i) { const f32x2 hp = AB[tl * 88 + c8 + i]; hv[i] = hp[0] + hp[1] * sc[i]; }
        *(u32x4*)(HS + (size_t)(seqbase + t0 + tl) * LW + blk * 88 + c8) =
            mk4(pk_bf16(hv[0], hv[1]), pk_bf16(hv[2], hv[3]), pk_bf16(hv[4], hv[5]), pk_bf16(hv[6], hv[7]));
      }
    }
  }
}

__device__ __forceinline__ void lru_z_phase(const bf16_t* __restrict__ HS0, const bf16_t* __restrict__ HS1, bf16_t* __restrict__ GG) {
  const size_t n8 = (size_t)MT * LW / 8;
  for (size_t e = (size_t)blockIdx.x * NTHR + threadIdx.x; e < n8; e += (size_t)gridDim.x * NTHR) {
    const u32x4 a = *(const u32x4*)(HS0 + e * 8), b = *(const u32x4*)(HS1 + e * 8), g = *(const u32x4*)(GG + e * 8);
    u32x4 o;
    o.x = pk_bf16((bf_lo(a.x) + bf_lo(b.x)) * bf_lo(g.x), (bf_hi(a.x) + bf_hi(b.x)) * bf_hi(g.x));
    o.y = pk_bf16((bf_lo(a.y) + bf_lo(b.y)) * bf_lo(g.y), (bf_hi(a.y) + bf_hi(b.y)) * bf_hi(g.y));
    o.z = pk_bf16((bf_lo(a.z) + bf_lo(b.z)) * bf_lo(g.z), (bf_hi(a.z) + bf_hi(b.z)) * bf_hi(g.z));
    o.w = pk_bf16((bf_lo(a.w) + bf_lo(b.w)) * bf_lo(g.w), (bf_hi(a.w) + bf_hi(b.w)) * bf_hi(g.w));
    *(u32x4*)(GG + e * 8) = o;
  }
}

__device__ __forceinline__ void nat_qk_phase(bf16_t* __restrict__ Q, bf16_t* __restrict__ Kb, bf16_t* __restrict__ QR, const float* __restrict__ qk_g) {
  const int tidx = opaque_tid();
  const int lane = tidx & 63;
  const int gw = blockIdx.x * (NTHR / 64) + (tidx >> 6), nw = gridDim.x * (NTHR / 64);
  const int qd = lane & 3;
  float gq[16], gk[16], inv[16];
#pragma unroll
  for (int i = 0; i < 16; ++i) { gq[i] = qk_g[qd * 16 + i]; gk[i] = qk_g[64 + qd * 16 + i]; inv[i] = exp2f(-(float)i * (13.287712379549449f / 16.f)); }
  for (int row = gw; row < MT; row += nw) {
    const bool lat = row < ML;
    const size_t off = (size_t)row * 1024 + lane * 16;
    float cs[16], sn[16];
    if (lat) {
      const int t = row & 4095;
      const float pos = (float)((qd >> 1) ? (t & 63) : (t >> 6));
#pragma unroll
      for (int i = 0; i < 16; ++i) {
        float rev = pos * inv[i] * 0.15915494309189535f;
        rev -= floorf(rev);
        sn[i] = __builtin_amdgcn_sinf(rev); cs[i] = __builtin_amdgcn_cosf(rev);
      }
    }
#pragma unroll
    for (int which = 0; which < 2; ++which) {
      bf16_t* P = which ? Kb : Q;
      const u32x4 a = *(const u32x4*)(P + off), b2 = *(const u32x4*)(P + off + 8);
      const unsigned u[8] = {a.x, a.y, a.z, a.w, b2.x, b2.y, b2.z, b2.w};
      float x[16];
#pragma unroll
      for (int i = 0; i < 8; ++i) { x[2 * i] = bf_lo(u[i]); x[2 * i + 1] = bf_hi(u[i]); }
      float ss = 0.f;
#pragma unroll
      for (int i = 0; i < 16; ++i) ss += x[i] * x[i];
      ss += __shfl_xor(ss, 1); ss += __shfl_xor(ss, 2);
      const float rstd = rsqrtf(ss * (1.f / 64.f) + 1e-6f);
#pragma unroll
      for (int i = 0; i < 16; ++i) x[i] = x[i] * rstd * (which ? gk[i] : gq[i]);
      unsigned pl[8];
#pragma unroll
      for (int i = 0; i < 8; ++i) pl[i] = pk_bf16(x[2 * i], x[2 * i + 1]);
      unsigned rt[8];
      if (lat) {
        float y[16];
#pragma unroll
        for (int i = 0; i < 16; ++i) {
          const float pr = __shfl_xor(x[i], 1);
          y[i] = x[i] * cs[i] + ((qd & 1) ? pr * sn[i] : -pr * sn[i]);
        }
#pragma unroll
        for (int i = 0; i < 8; ++i) rt[i] = pk_bf16(y[2 * i], y[2 * i + 1]);
      }
      if (which == 0) {
        *(u32x4*)(Q + off) = mk4(pl[0], pl[1], pl[2], pl[3]);
        *(u32x4*)(Q + off + 8) = mk4(pl[4], pl[5], pl[6], pl[7]);
        if (lat) { *(u32x4*)(QR + off) = mk4(rt[0], rt[1], rt[2], rt[3]); *(u32x4*)(QR + off + 8) = mk4(rt[4], rt[5], rt[6], rt[7]); }
      } else {
        if (lat) { *(u32x4*)(Kb + off) = mk4(rt[0], rt[1], rt[2], rt[3]); *(u32x4*)(Kb + off + 8) = mk4(rt[4], rt[5], rt[6], rt[7]); }
        else { *(u32x4*)(Kb + off) = mk4(pl[0], pl[1], pl[2], pl[3]); *(u32x4*)(Kb + off + 8) = mk4(pl[4], pl[5], pl[6], pl[7]); }
      }
    }
  }
}

struct AttnState { f32x16 O[2][2]; float m[2], l[2]; };

DEVI void attn_load_k(u32x4 (&kf)[4], const bf16_t* __restrict__ kbase, int lane) {
  const int l31 = lane & 31, lh = lane >> 5;
#pragma unroll
  for (int ks = 0; ks < 4; ++ks) kf[ks] = *(const u32x4*)(kbase + (size_t)l31 * 1024 + ks * 16 + 8 * lh);
}

DEVI void attn_compute(AttnState& st, const u32x4* qs, const bf16_t* __restrict__ kbase, const bf16_t* __restrict__ vtbase, int vtT,
                       const float* __restrict__ rpbs, bool band, int brow, int half, int lane) {
  const int l31 = lane & 31, lh = lane >> 5;
  u32x4 kf[4];
  attn_load_k(kf, kbase, lane);
  u32x4 vf[4];
#pragma unroll
  for (int dt = 0; dt < 2; ++dt)
#pragma unroll
    for (int s = 0; s < 2; ++s) {
      const bf16_t* vp = vtbase + (size_t)(dt * 32 + l31) * vtT + 16 * s + 4 * lh;
      const u32x2 lo = *(const u32x2*)vp, hi = *(const u32x2*)(vp + 8);
      vf[dt * 2 + s] = mk4(lo.x, lo.y, hi.x, hi.y);
    }
  __builtin_amdgcn_sched_barrier(0);
  constexpr float SC = 0.125f * 1.4426950408889634f;
  u32x4 pf[2][2];
#pragma unroll
  for (int qt = 0; qt < 2; ++qt) {
    f32x16 S;
#pragma unroll
    for (int r = 0; r < 16; ++r) S[r] = 0.f;
#pragma unroll
    for (int ks = 0; ks < 4; ++ks) S = mfma32(kf[ks], qs[(qt * 4 + ks) * 64], S);
    float cmax = -INFINITY;
    if (band) {
      const int qc = qt * 32 + l31;
      const int cst = min(max(qc - 8, 0), 48);
#pragma unroll
      for (int r = 0; r < 16; ++r) {
        const int key = (r & 3) + 8 * (r >> 2) + 4 * lh;
        const int kc = half * 32 + key;
        const bool ok = (kc >= cst) && (kc < cst + 16);
        const int bi = ok ? (brow * 31 + kc - qc + 15) : 0;
        const float sv = S[r] * SC + rpbs[bi];
        S[r] = ok ? sv : -INFINITY;
        cmax = fmaxf(cmax, S[r]);
      }
    } else {
#pragma unroll
      for (int r = 0; r < 16; ++r) { S[r] *= SC; cmax = fmaxf(cmax, S[r]); }
    }
    cmax = fmaxf(cmax, __shfl_xor(cmax, 32));
    const float mnew = fmaxf(st.m[qt], cmax);
    const float alpha = __builtin_amdgcn_exp2f(st.m[qt] - mnew);
    const bool grew = mnew > st.m[qt];
    st.m[qt] = mnew;
    float ps = 0.f;
#pragma unroll
    for (int r = 0; r < 16; ++r) { S[r] = __builtin_amdgcn_exp2f(S[r] - mnew); ps += S[r]; }
    st.l[qt] = st.l[qt] * alpha + ps;
    if (__any(grew)) {
#pragma unroll
      for (int dt = 0; dt < 2; ++dt)
#pragma unroll
        for (int r = 0; r < 16; ++r) st.O[qt][dt][r] *= alpha;
    }
    pf[qt][0] = mk4(pk_bf16(S[0], S[1]), pk_bf16(S[2], S[3]), pk_bf16(S[4], S[5]), pk_bf16(S[6], S[7]));
    pf[qt][1] = mk4(pk_bf16(S[8], S[9]), pk_bf16(S[10], S[11]), pk_bf16(S[12], S[13]), pk_bf16(S[14], S[15]));
  }
#pragma unroll
  for (int dt = 0; dt < 2; ++dt)
#pragma unroll
    for (int s = 0; s < 2; ++s) {
      st.O[0][dt] = mfma32(vf[dt * 2 + s], pf[0][s], st.O[0][dt]);
      st.O[1][dt] = mfma32(vf[dt * 2 + s], pf[1][s], st.O[1][dt]);
    }
}

__device__ __forceinline__ void natten_phase(char* lds, const bf16_t* __restrict__ Q, const bf16_t* __restrict__ QR, const bf16_t* __restrict__ Kb,
                             const bf16_t* __restrict__ VT, bf16_t* __restrict__ G, const float* __restrict__ rpb, bf16_t* __restrict__ Zd) {
  float* rpbs = (float*)lds;
  __syncthreads();
  for (int e = threadIdx.x; e < 16 * 465; e += NTHR) rpbs[e] = rpb[e] * 1.4426950408889634f;
  __syncthreads();
  const int tidx = opaque_tid();
  const int lane = tidx & 63, l31 = lane & 31, lh = lane >> 5;
  const int gw = blockIdx.x * (NTHR / 64) + (tidx >> 6), nw = gridDim.x * (NTHR / 64);
  const bf16_t* VTC = VT + (size_t)ML * 1024;
  u32x4* qs = (u32x4*)(lds + 32768) + (tidx >> 6) * 512 + lane;
  const int xcd = blockIdx.x & 7, wx = (blockIdx.x >> 3) * (NTHR / 64) + (tidx >> 6), nwx = (gridDim.x >> 3) * (NTHR / 64);
  for (int i = wx; i < 1024 + 64; i += nwx) {
    const bool lat = i < 1024;
    int b, h, r = 0, qrow0;
    if (lat) { const int pair = xcd * 16 + (i >> 6); r = i & 63; b = pair >> 4; h = pair & 15; qrow0 = b * 4096 + r * 64; }
    else { const int it = i - 1024; const int pair = xcd * 16 + (it >> 2); const int qt64 = it & 3; b = pair >> 4; h = pair & 15; qrow0 = ML + b * 256 + qt64 * 64; }
    const int start = min(max(r - 4, 0), 56);
    const int nchunks = lat ? 24 : 8;
    AttnState st;
#pragma unroll
    for (int a = 0; a < 2; ++a) { st.m[a] = -INFINITY; st.l[a] = 0.f;
#pragma unroll
      for (int c = 0; c < 2; ++c)
#pragma unroll
        for (int rr = 0; rr < 16; ++rr) st.O[a][c][rr] = 0.f; }
#pragma unroll
    for (int qt = 0; qt < 2; ++qt)
#pragma unroll
      for (int ks = 0; ks < 4; ++ks) qs[(qt * 4 + ks) * 64] = *(const u32x4*)(Q + (size_t)(qrow0 + qt * 32 + l31) * 1024 + h * 64 + ks * 16 + 8 * lh);
    for (int j = 0; j < nchunks; ++j) {
      if (j == 8) {
#pragma unroll
        for (int qt = 0; qt < 2; ++qt)
#pragma unroll
          for (int ks = 0; ks < 4; ++ks) qs[(qt * 4 + ks) * 64] = *(const u32x4*)(QR + (size_t)(qrow0 + qt * 32 + l31) * 1024 + h * 64 + ks * 16 + 8 * lh);
      }
      const bool band = j >= 8;
      const int ii = j - 8, kr = start + (ii >> 1), half = band ? (ii & 1) : 0;
      const size_t krow = band ? (size_t)(b * 4096 + kr * 64 + half * 32) : (size_t)(ML + b * 256 + j * 32);
      const bf16_t* kbase = Kb + krow * 1024 + h * 64;
      const bf16_t* vtb = band ? VT + (size_t)(b * 16 + h) * 64 * 4096 + kr * 64 + half * 32 : VTC + (size_t)(b * 16 + h) * 64 * 256 + j * 32;
      attn_compute(st, qs, kbase, vtb, band ? 4096 : 256, rpbs, band, band ? h * 15 + (kr - r + 7) : 0, half, lane);
    }
#pragma unroll
    for (int qt = 0; qt < 2; ++qt) {
      const float lt = st.l[qt] + __shfl_xor(st.l[qt], 32);
      const float inv = 1.f / lt;
      bf16_t* grow = G + (size_t)(qrow0 + qt * 32 + l31) * 1024 + h * 64;
      u32x2 gvs[2][4];
#pragma unroll
      for (int dt = 0; dt < 2; ++dt)
#pragma unroll
        for (int q4 = 0; q4 < 4; ++q4) gvs[dt][q4] = *(const u32x2*)(grow + dt * 32 + 8 * q4 + 4 * lh);
#pragma unroll
      for (int dt = 0; dt < 2; ++dt)
#pragma unroll
        for (int q4 = 0; q4 < 4; ++q4) {
          bf16_t* gp = grow + dt * 32 + 8 * q4 + 4 * lh;
          bf16_t* zp = Zd + (gp - G);
          const u32x2 gv = gvs[dt][q4];
          u32x2 o;
          o.x = pk_bf16(st.O[qt][dt][4 * q4] * inv * bf_lo(gv.x), st.O[qt][dt][4 * q4 + 1] * inv * bf_hi(gv.x));
          o.y = pk_bf16(st.O[qt][dt][4 * q4 + 2] * inv * bf_lo(gv.y), st.O[qt][dt][4 * q4 + 3] * inv * bf_hi(gv.y));
          *(u32x2*)zp = o;
        }
    }
  }
}

namespace pg8 {
#define PG8_LAS __attribute__((address_space(3)))
typedef unsigned short bf16_t;
typedef short bf16x8 __attribute__((ext_vector_type(8)));
typedef float f32x4 __attribute__((ext_vector_type(4)));
typedef unsigned u32x4 __attribute__((ext_vector_type(4)));
constexpr int BM = 256, BK = 64, HALF = 128, HTB = HALF * BK * 2  , STAGE_BYTES = 8 * HTB, NXCD = 8, WGM = 8;

__host__ __device__ __forceinline__ int lds_byte(int r, int c) { const int st = (r >> 4) * 2 + (c >> 5), rr = r & 15, cc = c & 31, ob = rr * 64 + cc * 2; return st * 1024 + (ob ^ (((ob >> 9) & 1) << 5)); }
__host__ __device__ __forceinline__ void stage_rc(int b, int& R, int& C) { const int st = b / 1024, sb = b % 1024, swz = sb ^ (((sb >> 9) & 1) << 5); R = (st >> 1) * 16 + swz / 64; C = (st & 1) * 32 + (swz % 64) / 2; }
__host__ __device__ __forceinline__ int perm32(int rho) { const int n = rho >> 4, i = rho & 15; return 8 * (i >> 2) + 4 * n + (i & 3); }

struct Unit { int pm, pn; };
struct Gemm { const bf16_t* A; const bf16_t* Bt; int M, N, K; };

struct StaticOrder {
    int nM, nN, nwg, G, c;
    __host__ __device__ void init(int M, int N, int G_, int c_) { nM = M / BM; nN = N / BM; nwg = nM * nN; G = G_; c = c_; }
    __host__ __device__ bool next(int i, Unit& u) const {
        const long L = (long)i * G + c; if (L >= nwg) return false;
        int wgid = (int)L; { const int q = nwg / NXCD, r = nwg % NXCD, xcd = wgid % NXCD, off = wgid / NXCD; wgid = (xcd < r ? xcd * (q + 1) : r * (q + 1) + (xcd - r) * q) + off; }
        const int nig = WGM * nN, gid = wgid / nig, fm = gid * WGM, gsz = (nM - fm) < WGM ? (nM - fm) : WGM;
        u.pm = fm + ((wgid % nig) % gsz); u.pn = (wgid % nig) / gsz; return true;
    }
    __device__ __forceinline__ void a_ready(const Unit&) const {}
    __device__ __forceinline__ void done(const Unit&) const {}
};
template <class Epi, class Sched, bool STAMP = false>
__device__ __forceinline__ void gemm_phase(PG8_LAS unsigned char* lds, const Gemm g, const Sched& S, const Epi& E, unsigned long long* stamps) {
    const int tid = threadIdx.x, wid = __builtin_amdgcn_readfirstlane(tid >> 6), lane = tid & 63, wr = wid >> 2, wc = wid & 3, fr = lane & 15, fq = lane >> 4;
    const int K = g.K, nt = K / BK;
    int ts_lo = 0, ts_hi = 0, nts = 0; const unsigned long long rt_entry = STAMP ? (unsigned long long)wall_clock64() : 0ull;
#define PG8_STAMP() do { if (STAMP && wid == 0 && nts < 64) { const unsigned long long _c = (unsigned long long)clock64(); \
        ts_lo = (lane == nts) ? (int)(unsigned)_c : ts_lo; ts_hi = (lane == nts) ? (int)(unsigned)(_c >> 32) : ts_hi; ++nts; } } while (0)
    PG8_STAMP();
    unsigned voffA[2], voffB[2];
#pragma unroll
    for (int i = 0; i < 2; ++i) { int R, C; stage_rc(tid * 16 + i * 8192, R, C); const int Rb = Epi::PERM ? ((R & ~31) + perm32(R & 31)) : R;
        voffA[i] = (unsigned)(R * K + C) * 2u; voffB[i] = (unsigned)(Rb * K + C) * 2u; }
    const size_t kstep = (size_t)(BK * 2);
    const size_t hstep = (size_t)HALF * K * 2;
    const size_t tstep = 2 * hstep;
    const unsigned ldsw = (unsigned)wid * 1024u;
    const int aoff = lds_byte(wr * 64 + fr, fq * 8), boff = lds_byte(wc * 32 + fr, fq * 8);
#define PG8_SA(b, h) (((b) * 2 + (h)) * HTB)
#define PG8_SB(b, h) ((4 + (b) * 2 + (h)) * HTB)
#define PG8_STAGE(bufoff, gbase, voff) do { _Pragma("unroll") for (int _i = 0; _i < 2; ++_i) \
        __builtin_amdgcn_global_load_lds((const unsigned*)((const char*)(gbase) + (voff)[_i]), (PG8_LAS unsigned*)(lds + (bufoff) + ldsw + _i * 8192), 16, 0, 0); } while (0)
#define PG8_LDA(dst, b, h) do { _Pragma("unroll") for (int m = 0; m < 4; ++m) _Pragma("unroll") for (int k = 0; k < 2; ++k) dst[m][k] = *(const PG8_LAS bf16x8*)(lds + PG8_SA(b, h) + aoff + m * 2048 + k * 1024); } while (0)
#define PG8_LDB(dst, b, h) do { _Pragma("unroll") for (int n = 0; n < 2; ++n) _Pragma("unroll") for (int k = 0; k < 2; ++k) dst[n][k] = *(const PG8_LAS bf16x8*)(lds + PG8_SB(b, h) + boff + n * 2048 + k * 1024); } while (0)
#define PG8_MMA(ai, bj, At, Bt) do { __builtin_amdgcn_s_setprio(1); _Pragma("unroll") for (int m = 0; m < 4; ++m) _Pragma("unroll") for (int n = 0; n < 2; ++n) _Pragma("unroll") for (int k = 0; k < 2; ++k) \
        acc[ai][bj][m][n] = __builtin_amdgcn_mfma_f32_16x16x32_bf16(Bt[n][k], At[m][k], acc[ai][bj][m][n], 0, 0, 0); __builtin_amdgcn_s_setprio(0); } while (0)
#define PG8_WAIT_V(n) asm volatile("s_waitcnt vmcnt(" #n ")" ::: "memory")
#define PG8_WAIT_L(n) asm volatile("s_waitcnt lgkmcnt(" #n ")" ::: "memory")
#define PG8_BAR __builtin_amdgcn_s_barrier()
#define PG8_SCHED __builtin_amdgcn_sched_barrier(0)
    Unit cur, nxt; int ui = 0;
    if (!S.next(0, cur)) return;
    f32x4 acc[2][2][4][2];
#pragma unroll
    for (int a = 0; a < 2; ++a)
#pragma unroll
        for (int b = 0; b < 2; ++b)
#pragma unroll
            for (int m = 0; m < 4; ++m)
#pragma unroll
                for (int n = 0; n < 2; ++n) acc[a][b][m][n] = (f32x4){0.f, 0.f, 0.f, 0.f};
    bf16x8 At[4][2], B0[2][2], B1[2][2];
    const char* cA = (const char*)g.A + (size_t)cur.pm * tstep; const char* cB = (const char*)g.Bt + (size_t)cur.pn * tstep;
    S.a_ready(cur);
    PG8_STAGE(PG8_SB(0, 0), cB, voffB); PG8_STAGE(PG8_SA(0, 0), cA, voffA); PG8_STAGE(PG8_SB(0, 1), cB + hstep, voffB); PG8_STAGE(PG8_SA(0, 1), cA + hstep, voffA);
    if (wr == 1) PG8_BAR;
    PG8_WAIT_V(4); PG8_BAR;
    PG8_STAGE(PG8_SB(1, 0), cB + kstep, voffB); PG8_STAGE(PG8_SA(1, 0), cA + kstep, voffA); PG8_STAGE(PG8_SB(1, 1), cB + hstep + kstep, voffB);
    PG8_WAIT_V(6); PG8_BAR;
    PG8_STAMP();
    for (;;) {
        const bool has_next = S.next(ui + 1, nxt);
        const char* nA = has_next ? (const char*)g.A + (size_t)nxt.pm * tstep : cA; const char* nB = has_next ? (const char*)g.Bt + (size_t)nxt.pn * tstep : cB;
        for (int t = 0; t < nt; t += 2) {
            const bool last = (t == nt - 2);
            const char* a1 = cA + (size_t)(t + 1) * kstep;
            const char* a2 = last ? nA : cA + (size_t)(t + 2) * kstep; const char* b2 = last ? nB : cB + (size_t)(t + 2) * kstep;
            const char* a3 = a2 + kstep; const char* b3 = b2 + kstep;
            if (last && has_next) S.a_ready(nxt);
            PG8_LDB(B0, 0, 0); PG8_SCHED; PG8_LDA(At, 0, 0); PG8_STAGE(PG8_SA(1, 1), a1 + hstep, voffA);
            PG8_WAIT_L(8); PG8_BAR; PG8_WAIT_L(0); PG8_MMA(0, 0, At, B0); PG8_BAR; PG8_SCHED;
            PG8_LDB(B1, 0, 1); PG8_STAGE(PG8_SB(0, 0), b2, voffB);
            PG8_BAR; PG8_WAIT_L(0); PG8_MMA(0, 1, At, B1); PG8_BAR;
            PG8_LDA(At, 0, 1); PG8_STAGE(PG8_SA(0, 0), a2, voffA);
            PG8_BAR; PG8_WAIT_L(0); PG8_MMA(1, 0, At, B0); PG8_BAR; PG8_SCHED;
            PG8_STAGE(PG8_SB(0, 1), b2 + hstep, voffB);
            PG8_WAIT_V(6); PG8_BAR; PG8_MMA(1, 1, At, B1); PG8_BAR;
            PG8_LDB(B0, 1, 0); PG8_SCHED; PG8_LDA(At, 1, 0); PG8_STAGE(PG8_SA(0, 1), a2 + hstep, voffA);
            PG8_WAIT_L(8); PG8_BAR; PG8_WAIT_L(0); PG8_MMA(0, 0, At, B0); PG8_BAR; PG8_SCHED;
            PG8_LDB(B1, 1, 1); PG8_STAGE(PG8_SB(1, 0), b3, voffB);
            PG8_BAR; PG8_WAIT_L(0); PG8_MMA(0, 1, At, B1); PG8_BAR;
            PG8_LDA(At, 1, 1); PG8_STAGE(PG8_SA(1, 0), a3, voffA);
            PG8_BAR; PG8_WAIT_L(0); PG8_MMA(1, 0, At, B0); PG8_BAR; PG8_SCHED;
            PG8_STAGE(PG8_SB(1, 1), b3 + hstep, voffB);
            PG8_WAIT_V(6); PG8_BAR; PG8_MMA(1, 1, At, B1); PG8_BAR;
        }
        PG8_STAMP();
        if constexpr (!Epi::AFTER_DRAIN) { E(acc, cur, wr, wc, fr, fq); S.done(cur); }
        PG8_STAMP();
        if (!has_next) break;
#pragma unroll
        for (int a = 0; a < 2; ++a)
#pragma unroll
            for (int b = 0; b < 2; ++b)
#pragma unroll
                for (int m = 0; m < 4; ++m)
#pragma unroll
                    for (int n = 0; n < 2; ++n) acc[a][b][m][n] = (f32x4){0.f, 0.f, 0.f, 0.f};
        cur = nxt; cA = nA; cB = nB; ++ui;
    }
    PG8_WAIT_V(0);
    if (wr == 0) PG8_BAR;
    PG8_BAR;
    if constexpr (Epi::AFTER_DRAIN) { E.fused(acc, cur, wr, wc, fr, fq, lds, wid, lane); S.done(cur); }
    PG8_STAMP();
    if (STAMP && wid == 0) { stamps[lane] = lane < nts ? (((unsigned long long)(unsigned)ts_hi << 32) | (unsigned)ts_lo) : 0ull;
        if (lane == 62) stamps[62] = rt_entry; if (lane == 63) stamps[63] = (unsigned long long)wall_clock64(); }
#undef PG8_STAMP
#undef PG8_SA
#undef PG8_SB
#undef PG8_STAGE
#undef PG8_LDA
#undef PG8_LDB
#undef PG8_MMA
#undef PG8_WAIT_V
#undef PG8_WAIT_L
#undef PG8_BAR
#undef PG8_SCHED
}
}

template <class EP> struct Pg8Epi {
  static constexpr bool PERM = false, AFTER_DRAIN = false;
  EP ep;
  __device__ __forceinline__ void operator()(const pg8::f32x4 (&acc)[2][2][4][2], const pg8::Unit& u, int wr, int wc, int fr, int fq) const {
#pragma unroll
    for (int ai = 0; ai < 2; ++ai)
#pragma unroll
      for (int m = 0; m < 4; ++m)
#pragma unroll
        for (int bj = 0; bj < 2; ++bj)
#pragma unroll
          for (int n = 0; n < 2; ++n) {
            const int row = u.pm * 256 + ai * 128 + wr * 64 + m * 16 + fr;
            const int col = u.pn * 256 + bj * 128 + wc * 32 + n * 16 + fq * 4;
            ep(row, col, acc[ai][bj][m][n]);
          }
  }
};
struct Pg8EpiRes {
  static constexpr bool PERM = false, AFTER_DRAIN = false;
  EpRes ep;
  __device__ __forceinline__ void operator()(const pg8::f32x4 (&acc)[2][2][4][2], const pg8::Unit& u, int wr, int wc, int fr, int fq) const {
    const int bidx = (u.pm * 256) >> 12;
    const float* gbase = ep.modL + bidx * 3072 + 2048 + u.pn * 256 + wc * 32 + fq * 4;
    f32x4 g[2][2];
#pragma unroll
    for (int bj = 0; bj < 2; ++bj)
#pragma unroll
      for (int n = 0; n < 2; ++n) g[bj][n] = *(const f32x4*)(gbase + bj * 128 + n * 16);
#pragma unroll
    for (int ai = 0; ai < 2; ++ai)
#pragma unroll
      for (int mp = 0; mp < 2; ++mp) {
        f32x4 x[2][2][2];
        size_t roff[2];
#pragma unroll
        for (int mm = 0; mm < 2; ++mm) {
          roff[mm] = (size_t)(u.pm * 256 + ai * 128 + wr * 64 + (mp * 2 + mm) * 16 + fr) * 1024 + u.pn * 256 + wc * 32 + fq * 4;
#pragma unroll
          for (int bj = 0; bj < 2; ++bj)
#pragma unroll
            for (int n = 0; n < 2; ++n) x[mm][bj][n] = *(const f32x4*)(ep.xl_src + roff[mm] + bj * 128 + n * 16);
        }
#pragma unroll
        for (int mm = 0; mm < 2; ++mm)
#pragma unroll
          for (int bj = 0; bj < 2; ++bj)
#pragma unroll
            for (int n = 0; n < 2; ++n) *(f32x4*)(ep.xl_dst + roff[mm] + bj * 128 + n * 16) = x[mm][bj][n] + g[bj][n] * acc[ai][bj][mp * 2 + mm][n];
      }
  }
};
__device__ __forceinline__ void pg8_gemm_res(char* lds, const bf16_t* A, const bf16_t* Bt, int M, int N, int K, const EpRes ep) {
  __syncthreads();
  pg8::Gemm g{A, Bt, M, N, K};
  pg8::StaticOrder S; S.init(M, N, (int)gridDim.x, (int)blockIdx.x);
  Pg8EpiRes E{ep};
  pg8::gemm_phase<Pg8EpiRes, pg8::StaticOrder, false>((PG8_LAS unsigned char*)lds, g, S, E, nullptr);
  __syncthreads();
}
template <class EP>
__device__ __forceinline__ void pg8_gemm(char* lds, const bf16_t* A, const bf16_t* Bt, int M, int N, int K, const EP ep) {
  __syncthreads();
  pg8::Gemm g{A, Bt, M, N, K};
  pg8::StaticOrder S; S.init(M, N, (int)gridDim.x, (int)blockIdx.x);
  Pg8Epi<EP> E{ep};
  pg8::gemm_phase<Pg8Epi<EP>, pg8::StaticOrder, false>((PG8_LAS unsigned char*)lds, g, S, E, nullptr);
  __syncthreads();
}

template <int ph>
__device__ __forceinline__ void run_phase(const Params& p, char* lds, bool last_rep) {
  char* ws = p.ws;
  const float* MOD = (const float*)(ws + OFF_MOD);
  float* XC = (float*)(ws + OFF_XC);
  bf16_t* HB = (bf16_t*)(ws + OFF_HB);
  bf16_t* A0 = (bf16_t*)(ws + OFF_A0); bf16_t* A1 = (bf16_t*)(ws + OFF_A1); bf16_t* A2 = (bf16_t*)(ws + OFF_A2);
  bf16_t* A3 = (bf16_t*)(ws + OFF_A3); bf16_t* A4 = (bf16_t*)(ws + OFF_A4);
  bf16_t* WD = (bf16_t*)(ws + OFF_WD); bf16_t* AD = (bf16_t*)(ws + OFF_AD);
  float* BON = (float*)(ws + OFF_BON);
  if (ph == 0) { phase0(p, lds); return; }
  constexpr int layer = (ph - 1) / 5, sub = (ph - 1) % 5;
  const float* modL = MOD + (size_t)layer * 9 * 3072;
  const float* xl_cur = layer == 0 ? p.in[0] : p.out;
  const float* xc_cur = layer == 0 ? p.in[2] : XC;
  if (layer == 0 || layer == 3) {
    const int ib = layer ? 33 : 4;
    const bf16_t* WIN = (const bf16_t*)(ws + (layer ? OFF_W3IN : OFF_W0IN));
    const bf16_t* WUP = (const bf16_t*)(ws + (layer ? OFF_W3UP : OFF_W0UP));
    const bf16_t* WOUT = (const bf16_t*)(ws + (layer ? OFF_W3OUT : OFF_W0OUT));
    if (sub == 0) norm_phase<true>(xl_cur, xc_cur, p.in[ib], modL, HB, A4);
    else if (sub == 1) { ALMix al{HB, A4, p.in[ib + 4]}; EpRwkvIn ep{A0, A1, A2, A3, WD, AD}; gemm256_phase(lds, WIN, 1024, MT / 256, 16, al, ep); gemm_phase(lds, WIN, 1024, MT / 256, 2, al, ep, 4096, true); }
    else if (sub == 2) rwkv_scan_phase(lds, A0, A1, A2, WD, AD, WUP, p.in[ib + 5], p.in[ib + 8], p.in[ib + 9], HB, A4, BON);
    else if (sub == 3) rwkv_post_phase(HB, A4, A2, A3, BON, p.in[ib + 10], layer == 3 ? ML : MT);
    else { ALPlain al{A3, 1024}; EpRes ep{xl_cur, xc_cur, p.out, XC, modL}; pg8_gemm_res(lds, A3, WOUT, ML, 1024, 1024, ep); if (layer != 3) gemm_phase(lds, WOUT, 1024, MC / 256, 8, al, ep, 0, false, ML / 256); }
  } else if (layer == 1) {
    bf16_t* HS0 = (bf16_t*)(ws + OFF_HS0); bf16_t* XR = (bf16_t*)(ws + OFF_XR); bf16_t* GG = (bf16_t*)(ws + OFF_GG); bf16_t* HS1 = (bf16_t*)(ws + OFF_HS1);
    if (sub == 0) norm_phase<false>(xl_cur, xc_cur, p.in[16], modL, HB, nullptr);
    else if (sub == 1) { ALPlain al{HB, 1024}; EpLruIn ep{XR, GG}; pg8_gemm(lds, HB, (const bf16_t*)(ws + OFF_W1IN), MT, 2816, 1024, ep); }
    else if (sub == 2) rglru_phase(lds, XR, (const bf16_t*)(ws + OFF_W1G), p.in[20], p.in[21], p.in[23], p.in[24], HS0, HS1);
    else if (sub == 3) lru_z_phase(HS0, HS1, GG);
    else { ALPlain al{GG, LW}; EpRes ep{xl_cur, xc_cur, p.out, XC, modL}; pg8_gemm_res(lds, GG, (const bf16_t*)(ws + OFF_W1OUT), ML, 1024, LW, ep); gemm_phase(lds, (const bf16_t*)(ws + OFF_W1OUT), LW, MC / 256, 8, al, ep, 0, false, ML / 256); }
  } else {
    if (sub == 0) norm_phase<false>(xl_cur, xc_cur, p.in[26], modL, HB, nullptr);
    else if (sub == 1) { ALPlain al{HB, 1024}; EpNatIn ep{A0, A1, A2, A3}; pg8_gemm(lds, HB, (const bf16_t*)(ws + OFF_W2IN), MT, 4096, 1024, ep); }
    else if (sub == 2) nat_qk_phase(A0, A1, A4, p.in[30]);
    else if (sub == 3) natten_phase(lds, A0, A4, A1, A2, A3, p.in[31], last_rep ? A3 : HB);
    else { ALPlain al{A3, 1024}; EpRes ep{xl_cur, xc_cur, p.out, XC, modL}; pg8_gemm_res(lds, A3, (const bf16_t*)(ws + OFF_W2OUT), ML, 1024, 1024, ep); gemm_phase(lds, (const bf16_t*)(ws + OFF_W2OUT), 1024, MC / 256, 8, al, ep, 0, false, ML / 256); }
  }
}

__global__ void __launch_bounds__(NTHR) mega_kernel(Params p) {
  __shared__ __attribute__((aligned(16))) char lds[LDS_BYTES];
  __shared__ u32x4 xb_words;
  cg::grid_group grid = cg::this_grid();
  if (threadIdx.x == 0) xb_words = (u32x4){0u, 0u, 0u, 0u};
  __syncthreads();
  const XcdBarrier xb = xcd_barrier_post((unsigned*)(p.ws + OFF_BAR), (volatile LAS unsigned*)&xb_words);
#define PHASE(k) if (p.ph_lo <= k && k < p.ph_hi) { for (int rep = 0; rep < REP[k]; ++rep) { run_phase<k>(p, lds, rep + 1 == REP[k]); if (rep + 1 < REP[k] || k + 1 < p.ph_hi) { if (k == 0) grid.sync(); else xcd_barrier(xb); } } }
  PHASE(0) PHASE(1) PHASE(2) PHASE(3) PHASE(4) PHASE(5) PHASE(6) PHASE(7) PHASE(8) PHASE(9) PHASE(10)
  PHASE(11) PHASE(12) PHASE(13) PHASE(14) PHASE(15) PHASE(16) PHASE(17) PHASE(18) PHASE(19) PHASE(20)
#undef PHASE
}

extern "C" void kernel_launch(void* const* d_in, const int* in_sizes, int n_in, void* d_out, int out_size, void* d_ws, size_t ws_size,
                              hipStream_t stream) {
  static int grid_blocks = 0;
  if (!grid_blocks) {
    int dev = 0, cus = 0, per_cu = 0;
    hipGetDevice(&dev);
    hipDeviceGetAttribute(&cus, hipDeviceAttributeMultiprocessorCount, dev);
    hipOccupancyMaxActiveBlocksPerMultiprocessor(&per_cu, mega_kernel, NTHR, 0);
    if (per_cu < 1) { fprintf(stderr, "occupancy query returned %d\n", per_cu); per_cu = 1; }
    if (per_cu > 1) per_cu = 1;
    grid_blocks = cus * per_cu;
    if (n_in != 45 || ws_size < WS_END) fprintf(stderr, "unexpected n_in %d / ws %zu (need %zu)\n", n_in, ws_size, (size_t)WS_END);
  }
  Params p{};
  for (int i = 0; i < 45; ++i) p.in[i] = (const float*)d_in[i];
  p.out = (float*)d_out;
  p.ws = (char*)d_ws;
  (void)hipMemsetAsync((char*)d_ws + OFF_BAR, 0, XCD_BAR_WORDS * 4, stream);
#if N_LAUNCH_MODE == 1
  p.ph_lo = 0; p.ph_hi = NPHASE;
  void* args[] = {&p};
  hipError_t e = hipLaunchCooperativeKernel((void*)mega_kernel, dim3(grid_blocks), dim3(NTHR), args, 0, stream);
  if (e != hipSuccess) fprintf(stderr, "cooperative launch failed: %s (grid %d)\n", hipGetErrorString(e), grid_blocks);
#else
  for (int ph = 0; ph < NPHASE; ++ph) {
    p.ph_lo = ph; p.ph_hi = ph + 1;
    hipLaunchKernelGGL(mega_kernel, dim3(grid_blocks), dim3(NTHR), 0, stream, p);
  }
#endif
}
```

```cpp
#include <hip/hip_runtime.h>
#include <hip/hip_cooperative_groups.h>
#include <cstdio>
#include <cstdint>
namespace cg = cooperative_groups;

#ifndef N_LAUNCH_MODE
#define N_LAUNCH_MODE 1
#endif

typedef unsigned short bf16_t;
typedef short bf16x8 __attribute__((ext_vector_type(8)));
typedef float f32x4 __attribute__((ext_vector_type(4)));
typedef float f32x16 __attribute__((ext_vector_type(16)));
typedef float f32x2 __attribute__((ext_vector_type(2)));
typedef unsigned u32x4 __attribute__((ext_vector_type(4)));
typedef unsigned u32x2 __attribute__((ext_vector_type(2)));

#define DEVI __device__ __forceinline__

constexpr int D = 1024, NB = 8, SEQ = 4096, CTX = 256;
constexpr int ML = NB * SEQ;
constexpr int MC = NB * CTX;
constexpr int MT = ML + MC;
constexpr int LW = 1408;
constexpr int NTHR = 512;
constexpr int NPHASE = 21;
constexpr int LDS_BYTES = 163840 - 16;
__device__ constexpr int REP[21] = {1,1,1,1,1,1,1,1,1,1,1,1,1,1,1,1,1,1,1,1,1};

constexpr size_t SZ_ACT = (size_t)MT * 1024 * 2;
constexpr size_t OFF_MOD = 0;
constexpr size_t OFF_BAR = 458752;
constexpr size_t OFF_W0IN = 524288;
constexpr size_t SZ_RWIN = (size_t)4352 * 1024 * 2;
constexpr size_t SZ_RWUP = (size_t)4 * 1024 * 64 * 2;
constexpr size_t SZ_SQ = (size_t)1024 * 1024 * 2;
constexpr size_t OFF_W0UP = OFF_W0IN + SZ_RWIN;
constexpr size_t OFF_W0OUT = OFF_W0UP + SZ_RWUP;
constexpr size_t OFF_W3IN = OFF_W0OUT + SZ_SQ;
constexpr size_t OFF_W3UP = OFF_W3IN + SZ_RWIN;
constexpr size_t OFF_W3OUT = OFF_W3UP + SZ_RWUP;
constexpr size_t OFF_W1IN = OFF_W3OUT + SZ_SQ;
constexpr size_t OFF_W1G = OFF_W1IN + (size_t)2816 * 1024 * 2;
constexpr size_t OFF_W1OUT = OFF_W1G + (size_t)16 * 4 * 96 * 96 * 2;
constexpr size_t OFF_W2IN = OFF_W1OUT + (size_t)1024 * 1408 * 2;
constexpr size_t OFF_W2OUT = OFF_W2IN + (size_t)4096 * 1024 * 2;
constexpr size_t OFF_XC = OFF_W2OUT + SZ_SQ;
constexpr size_t OFF_BON = OFF_XC + (size_t)MC * 1024 * 4;
constexpr size_t OFF_BIG = OFF_BON + (size_t)2 * MT * 16 * 4;
constexpr size_t OFF_HB = OFF_BIG;
constexpr size_t OFF_A0 = OFF_BIG + SZ_ACT;
constexpr size_t OFF_A1 = OFF_A0 + SZ_ACT;
constexpr size_t OFF_A2 = OFF_A1 + SZ_ACT;
constexpr size_t OFF_A3 = OFF_A2 + SZ_ACT;
constexpr size_t OFF_A4 = OFF_A3 + SZ_ACT;
constexpr size_t OFF_WD = OFF_A4 + SZ_ACT;
constexpr size_t OFF_AD = OFF_WD + (size_t)MT * 128 * 2;
constexpr size_t WS_END = OFF_AD + (size_t)MT * 128 * 2;
constexpr size_t SZ_LRU = (size_t)MT * LW * 2;
constexpr size_t OFF_HS0 = OFF_BIG;
constexpr size_t OFF_XR = OFF_BIG + SZ_LRU;
constexpr size_t OFF_GG = OFF_XR + SZ_LRU;
constexpr size_t OFF_HS1 = OFF_GG + SZ_LRU;
static_assert(OFF_HS1 + SZ_LRU <= WS_END, "lru overlay");
static_assert(WS_END <= (size_t)536870912, "ws");

struct Params {
  const float* in[45];
  float* out;
  char* ws;
  int ph_lo, ph_hi;
};

DEVI u32x4 mk4(unsigned a, unsigned b, unsigned c, unsigned d) { u32x4 r = {a, b, c, d}; return r; }
DEVI int opaque_tid() { int t = threadIdx.x; asm volatile("" : "+v"(t)); return t; }
DEVI float bf_lo(unsigned u) { return __uint_as_float(u << 16); }
DEVI float bf_hi(unsigned u) { return __uint_as_float(u & 0xffff0000u); }
DEVI float bf2f(bf16_t h) { return __uint_as_float(((unsigned)h) << 16); }
typedef __bf16 bf16x2_t __attribute__((ext_vector_type(2)));
DEVI unsigned pk_bf16(float lo, float hi) { f32x2 f = {lo, hi}; bf16x2_t v = __builtin_convertvector(f, bf16x2_t); return __builtin_bit_cast(unsigned, v); }
DEVI bf16_t f2bf(float f) { return (bf16_t)(pk_bf16(f, 0.f) & 0xffffu); }
DEVI float wave_sum(float v) {
#pragma unroll
  for (int o = 32; o; o >>= 1) v += __shfl_xor(v, o);
  return v;
}
DEVI float sigmoidf_(float x) { return __builtin_amdgcn_rcpf(1.f + __expf(-x)); }
DEVI float siluf_(float x) { return x * __builtin_amdgcn_rcpf(1.f + __expf(-x)); }
DEVI float softplusf_(float x) { return fmaxf(x, 0.f) + __logf(1.f + __expf(-fabsf(x))); }
DEVI f32x16 mfma32(u32x4 a, u32x4 b, f32x16 c) {
  return __builtin_amdgcn_mfma_f32_32x32x16_bf16(__builtin_bit_cast(bf16x8, a), __builtin_bit_cast(bf16x8, b), c, 0, 0, 0);
}
DEVI f32x4 mfma16(u32x4 a, u32x4 b, f32x4 c) {
  return __builtin_amdgcn_mfma_f32_16x16x32_bf16(__builtin_bit_cast(bf16x8, a), __builtin_bit_cast(bf16x8, b), c, 0, 0, 0);
}
template <int CTRL> DEVI float dpp_f(float v) {
  return __int_as_float(__builtin_amdgcn_update_dpp(0, __float_as_int(v), CTRL, 0xf, 0xf, true));
}
DEVI float sum8(float v) {
  v += dpp_f<0xB1>(v);
  v += dpp_f<0x4E>(v);
  v += dpp_f<0x141>(v);
  return v;
}

#define XB_TMO      128
#define XB_XCNT(j)  (256  + 64 * (j))
#define XB_XSUB(j)  (1280 + 64 * (j))
#define XB_XGEN(j)  (2304 + 64 * (j))
#define XB_TOP      3328
#define XB_TOPGEN   3392
#define XCD_BAR_WORDS 3456
#define XB_SPIN_CAP (1u << 18)
#define LAS __attribute__((address_space(3)))

__device__ __forceinline__ unsigned xb_ld(unsigned* p)              { return __hip_atomic_load(p, __ATOMIC_RELAXED, __HIP_MEMORY_SCOPE_AGENT); }
__device__ __forceinline__ unsigned xb_add(unsigned* p, unsigned v) { return __hip_atomic_fetch_add(p, v, __ATOMIC_RELAXED, __HIP_MEMORY_SCOPE_AGENT); }
__device__ __forceinline__ unsigned xb_xcc_id() { return (unsigned)__builtin_amdgcn_s_getreg((3 << 11) | 20) & 0xFu; }
#define XB_SPIN(cond, bar) do { unsigned _sp = 0; while (cond) { __builtin_amdgcn_s_sleep(1); \
    if ((++_sp & 255u) == 0u) { if (xb_ld(&(bar)[XB_TMO])) break; if (_sp > XB_SPIN_CAP) { atomicAdd(&(bar)[XB_TMO], 1u); break; } } } } while (0)

struct XcdBarrier {
    unsigned* bar; unsigned x;
    volatile LAS unsigned* st;
};

__device__ __forceinline__ XcdBarrier xcd_barrier_post(unsigned* bar, volatile LAS unsigned* st) {
    XcdBarrier b; b.bar = bar; b.x = xb_xcc_id(); b.st = st;
    if (threadIdx.x == 0) (void)xb_add(&bar[XB_XCNT(b.x)], 1u);
    return b;
}
__device__ __forceinline__ void xcd_barrier_complete(unsigned* bar, unsigned x, unsigned& nloc, unsigned& nx) {
    const unsigned G = gridDim.x * gridDim.y * gridDim.z;
    unsigned sum, cnt, mine, sp = 0u;
    for (;;) {
        sum = 0u; cnt = 0u; mine = 0u;
#pragma unroll
        for (unsigned j = 0; j < 16; ++j) { const unsigned c = xb_ld(&bar[XB_XCNT(j)]); sum += c; cnt += (c > 0u) ? 1u : 0u; mine = (j == x) ? c : mine; }
        if (sum == G) break;
        __builtin_amdgcn_s_sleep(1);
        if ((++sp & 255u) == 0u) { if (xb_ld(&bar[XB_TMO])) break; if (sp > XB_SPIN_CAP) { atomicAdd(&bar[XB_TMO], 1u); break; } }
    }
    nloc = mine > 0u ? mine : 1u; nx = cnt > 0u ? cnt : 1u;
}

__device__ __forceinline__ void xcd_barrier(const XcdBarrier& b) {
    asm volatile("s_waitcnt vmcnt(0)" ::: "memory");
    __syncthreads();
    if (threadIdx.x == 0) {
        unsigned* bar = b.bar;
        __builtin_amdgcn_s_waitcnt(0);
        unsigned nloc = b.st[0], nx = b.st[1];
        if (nloc == 0u) { xcd_barrier_complete(bar, b.x, nloc, nx); b.st[0] = nloc; b.st[1] = nx; }
        const unsigned old = xb_add(&bar[XB_XSUB(b.x)], 1u);
        const unsigned gen = old / nloc;
        if (old + 1u == (gen + 1u) * nloc) {
            __builtin_amdgcn_fence(__ATOMIC_RELEASE, "agent");
            asm volatile("s_waitcnt vmcnt(0)" ::: "memory");
            const unsigned og = xb_add(&bar[XB_TOP], 1u);
            const unsigned tg = og / nx;
            if (og + 1u == (tg + 1u) * nx) xb_add(&bar[XB_TOPGEN], 1u);
            else XB_SPIN(xb_ld(&bar[XB_TOPGEN]) == tg, bar);
            __builtin_amdgcn_fence(__ATOMIC_ACQUIRE, "agent");
            xb_add(&bar[XB_XGEN(b.x)], 1u);
            asm volatile("s_waitcnt vmcnt(0)" ::: "memory");
        } else {
            XB_SPIN(xb_ld(&bar[XB_XGEN(b.x)]) == gen, bar);
            __builtin_amdgcn_fence(__ATOMIC_ACQUIRE, "agent");
            asm volatile("s_waitcnt vmcnt(0)" ::: "memory");
        }
    }
    __syncthreads();
}


struct TJob { const float* src; int K, N; bf16_t* dst; int ldd; };

DEVI TJob get_tjob(const Params& p, int j) {
  TJob t;
  if (j < 26) {
    const int l = j / 13, jj = j % 13;
    const int ib = l ? 33 : 4;
    bf16_t* win = (bf16_t*)(p.ws + (l ? OFF_W3IN : OFF_W0IN));
    bf16_t* wup = (bf16_t*)(p.ws + (l ? OFF_W3UP : OFF_W0UP));
    bf16_t* wout = (bf16_t*)(p.ws + (l ? OFF_W3OUT : OFF_W0OUT));
    if (jj < 4) { t.src = p.in[ib + 3] + (size_t)jj * 1048576; t.K = 1024; t.N = 1024; t.dst = win + (size_t)jj * 1048576; t.ldd = 1024; }
    else if (jj < 8) { const int idx = jj - 4, d = idx >> 1, kind = idx & 1;
      t.src = p.in[ib + 6] + (size_t)idx * 65536; t.K = 1024; t.N = 64; t.dst = win + (size_t)(4096 + kind * 128 + d * 64) * 1024; t.ldd = 1024; }
    else if (jj < 12) { const int idx = jj - 8;
      t.src = p.in[ib + 7] + (size_t)idx * 65536; t.K = 64; t.N = 1024; t.dst = wup + (size_t)idx * 65536; t.ldd = 64; }
    else { t.src = p.in[ib + 11]; t.K = 1024; t.N = 1024; t.dst = wout; t.ldd = 1024; }
  } else if (j == 26) { t.src = p.in[19]; t.K = 1024; t.N = 2816; t.dst = (bf16_t*)(p.ws + OFF_W1IN); t.ldd = 1024; }
  else if (j == 27) { t.src = p.in[25]; t.K = 1408; t.N = 1024; t.dst = (bf16_t*)(p.ws + OFF_W1OUT); t.ldd = 1408; }
  else if (j == 28) { t.src = p.in[29]; t.K = 1024; t.N = 4096; t.dst = (bf16_t*)(p.ws + OFF_W2IN); t.ldd = 1024; }
  else { t.src = p.in[32]; t.K = 1024; t.N = 1024; t.dst = (bf16_t*)(p.ws + OFF_W2OUT); t.ldd = 1024; }
  return t;
}

__device__ __forceinline__ void phase0(const Params& p, char* lds) {
  const int tid = opaque_tid();
  {
    bf16_t* wg = (bf16_t*)(p.ws + OFF_W1G);
    const float* gw = p.in[22];
    const int total = 16 * 4 * 96 * 96;
    for (int e = blockIdx.x * NTHR + tid; e < total; e += gridDim.x * NTHR) {
      const int k = e % 96, n = (e / 96) % 96, dg = (e / 9216) & 3, blk = e / 36864;
      float v = 0.f;
      if (k < 88 && n < 88) v = gw[((size_t)(dg * 16 + blk) * 88 + k) * 88 + n];
      wg[e] = f2bf(v);
    }
  }
  constexpr int N_MOD_ITEMS = 96;
  constexpr int N_TILES = 5152;
  float* act = (float*)lds;
  float* red = (float*)(lds + 36864);
  float* tl = (float*)lds;
  for (int item = blockIdx.x; item < N_MOD_ITEMS; item += gridDim.x) {
    __syncthreads();
    {
      const int L = item / 24, nc = item % 24;
      const int ib = (L == 0) ? 4 : (L == 1) ? 16 : (L == 2) ? 26 : 33;
      const float* ada_w = p.in[ib + 1];
      const float* ada_b = p.in[ib + 2];
      for (int e = tid; e < 9 * 1024; e += NTHR) {
        const int i = e >> 10, k = e & 1023;
        const float c = (i < 8) ? p.in[1][i * 1024 + k] : p.in[3][k];
        act[e] = siluf_(c);
      }
      __syncthreads();
      const int kq = tid >> 7, nl = tid & 127, n = nc * 128 + nl;
      float acc[9];
#pragma unroll
      for (int i = 0; i < 9; ++i) acc[i] = 0.f;
      for (int k0 = kq * 256; k0 < kq * 256 + 256; k0 += 16) {
        float w[16];
#pragma unroll
        for (int u = 0; u < 16; ++u) w[u] = ada_w[(size_t)(k0 + u) * 3072 + n];
#pragma unroll
        for (int u = 0; u < 16; ++u)
#pragma unroll
          for (int i = 0; i < 9; ++i) acc[i] += act[i * 1024 + k0 + u] * w[u];
      }
#pragma unroll
      for (int i = 0; i < 9; ++i) red[(kq * 9 + i) * 128 + nl] = acc[i];
      __syncthreads();
      float* mod = (float*)(p.ws + OFF_MOD) + (size_t)L * 9 * 3072;
      for (int e = tid; e < 9 * 128; e += NTHR) {
        const int i = e >> 7, c = e & 127;
        const float s = red[(0 * 9 + i) * 128 + c] + red[(1 * 9 + i) * 128 + c] + red[(2 * 9 + i) * 128 + c] + red[(3 * 9 + i) * 128 + c];
        mod[i * 3072 + nc * 128 + c] = s + ada_b[nc * 128 + c];
      }
    }
  }
  {
    struct TileRef { const float* src; bf16_t* dst; int N, ldd, k0, n0; };
    auto decode = [&](int t, TileRef& r) {
      int j = 0;
      TJob job = get_tjob(p, 0);
      for (;;) {
        const int nt = (job.K >> 6) * (job.N >> 6);
        if (t < nt) break;
        t -= nt; ++j; job = get_tjob(p, j);
      }
      const int ntn = job.N >> 6;
      r.src = job.src; r.dst = job.dst; r.N = job.N; r.ldd = job.ldd; r.k0 = (t / ntn) * 64; r.n0 = (t % ntn) * 64;
    };
    const int kk = tid >> 4, n4 = (tid & 15) * 4;
    int t = (int)(gridDim.x - 1 - blockIdx.x);
    TileRef cur, nxt;
    float4 v0 = make_float4(0.f, 0.f, 0.f, 0.f), v1 = v0;
    if (t < N_TILES) {
      decode(t, cur);
      v0 = *(const float4*)(cur.src + (size_t)(cur.k0 + kk) * cur.N + cur.n0 + n4);
      v1 = *(const float4*)(cur.src + (size_t)(cur.k0 + kk + 32) * cur.N + cur.n0 + n4);
    }
    while (t < N_TILES) {
      const int tn = t + (int)gridDim.x;
      float4 w0 = v0, w1 = v1;
      if (tn < N_TILES) {
        decode(tn, nxt);
        w0 = *(const float4*)(nxt.src + (size_t)(nxt.k0 + kk) * nxt.N + nxt.n0 + n4);
        w1 = *(const float4*)(nxt.src + (size_t)(nxt.k0 + kk + 32) * nxt.N + nxt.n0 + n4);
      }
      __builtin_amdgcn_sched_barrier(0);
      __syncthreads();
      tl[kk * 65 + n4 + 0] = v0.x; tl[kk * 65 + n4 + 1] = v0.y; tl[kk * 65 + n4 + 2] = v0.z; tl[kk * 65 + n4 + 3] = v0.w;
      tl[(kk + 32) * 65 + n4 + 0] = v1.x; tl[(kk + 32) * 65 + n4 + 1] = v1.y; tl[(kk + 32) * 65 + n4 + 2] = v1.z; tl[(kk + 32) * 65 + n4 + 3] = v1.w;
      __syncthreads();
      const int n = tid >> 3, k8 = (tid & 7) * 8;
      u32x4 o;
      o.x = pk_bf16(tl[(k8 + 0) * 65 + n], tl[(k8 + 1) * 65 + n]);
      o.y = pk_bf16(tl[(k8 + 2) * 65 + n], tl[(k8 + 3) * 65 + n]);
      o.z = pk_bf16(tl[(k8 + 4) * 65 + n], tl[(k8 + 5) * 65 + n]);
      o.w = pk_bf16(tl[(k8 + 6) * 65 + n], tl[(k8 + 7) * 65 + n]);
      *(u32x4*)(cur.dst + (size_t)(cur.n0 + n) * cur.ldd + cur.k0 + k8) = o;
      v0 = w0; v1 = w1; cur = nxt; t = tn;
    }
  }
}

DEVI void norm_row(const float* __restrict__ xr, const float* __restrict__ g, const float* __restrict__ mod, int lane, float (&h)[16]) {
  float4 x[4];
  float ss = 0.f;
#pragma unroll
  for (int i = 0; i < 4; ++i) {
    x[i] = *(const float4*)(xr + lane * 4 + 256 * i);
    ss += x[i].x * x[i].x + x[i].y * x[i].y + x[i].z * x[i].z + x[i].w * x[i].w;
  }
  ss = wave_sum(ss);
  const float rstd = rsqrtf(ss * (1.f / 1024.f) + 1e-6f);
#pragma unroll
  for (int i = 0; i < 4; ++i) {
    const int c = lane * 4 + 256 * i;
    const float4 gg = *(const float4*)(g + c);
    const float4 sh = *(const float4*)(mod + c);
    const float4 sc = *(const float4*)(mod + 1024 + c);
    h[i * 4 + 0] = x[i].x * rstd * gg.x * (1.f + sc.x) + sh.x;
    h[i * 4 + 1] = x[i].y * rstd * gg.y * (1.f + sc.y) + sh.y;
    h[i * 4 + 2] = x[i].z * rstd * gg.z * (1.f + sc.z) + sh.z;
    h[i * 4 + 3] = x[i].w * rstd * gg.w * (1.f + sc.w) + sh.w;
  }
}

template <bool WITH_HS>
__device__ __forceinline__ void norm_phase(const float* __restrict__ xl, const float* __restrict__ xc, const float* __restrict__ g,
                           const float* __restrict__ modL, bf16_t* __restrict__ H, bf16_t* __restrict__ HS) {
  const int tidx = opaque_tid();
  const int lane = tidx & 63;
  const int gw = blockIdx.x * (NTHR / 64) + (tidx >> 6), nw = gridDim.x * (NTHR / 64);
  for (int row = gw; row < MT; row += nw) {
    const bool lat = row < ML;
    const float* xbase = lat ? xl + (size_t)row * 1024 : xc + (size_t)(row - ML) * 1024;
    const float* mod = modL + (lat ? (row >> 12) : 8) * 3072;
    float h[16];
    norm_row(xbase, g, mod, lane, h);
#pragma unroll
    for (int i = 0; i < 4; ++i) {
      u32x2 o; o.x = pk_bf16(h[i * 4], h[i * 4 + 1]); o.y = pk_bf16(h[i * 4 + 2], h[i * 4 + 3]);
      *(u32x2*)(H + (size_t)row * 1024 + lane * 4 + 256 * i) = o;
    }
    if (WITH_HS) {
      const int t = lat ? (row & 4095) : ((row - ML) & 255);
      const int T = lat ? 4096 : 256;
      float s[16];
#pragma unroll
      for (int i = 0; i < 16; ++i) s[i] = 0.f;
      if (t > 0) { float hp[16]; norm_row(xbase - 1024, g, mod, lane, hp);
#pragma unroll
        for (int i = 0; i < 16; ++i) s[i] += hp[i]; }
      if (t < T - 1) { float hn[16]; norm_row(xbase + 1024, g, mod, lane, hn);
#pragma unroll
        for (int i = 0; i < 16; ++i) s[i] += hn[i]; }
#pragma unroll
      for (int i = 0; i < 4; ++i) {
        u32x2 o; o.x = pk_bf16(0.5f * s[i * 4], 0.5f * s[i * 4 + 1]); o.y = pk_bf16(0.5f * s[i * 4 + 2], 0.5f * s[i * 4 + 3]);
        *(u32x2*)(HS + (size_t)row * 1024 + lane * 4 + 256 * i) = o;
      }
    }
  }
}

struct ALPlain {
  const bf16_t* A; int lda;
  typedef u32x4 Regs;
  DEVI void stage(float*, int) const {}
  DEVI void issue(Regs& r, int row, int k) const { r = *(const u32x4*)(A + (size_t)row * lda + k); }
  DEVI u32x4 finish(const Regs& r, const float*, int) const { return r; }
};
struct ALMix {
  const bf16_t* H; const bf16_t* HS; const float* mu;
  struct Regs { u32x4 h, s; };
  DEVI void stage(float* sMu, int n0) const {
    const int grp = n0 >> 10;
    const int j = grp == 0 ? 0 : grp == 1 ? 2 : grp == 2 ? 3 : grp == 3 ? 5 : (n0 - 4096) < 128 ? 1 : 4;
    for (int e = threadIdx.x; e < 1024; e += NTHR) sMu[e] = mu[j * 1024 + e];
  }
  DEVI void issue(Regs& r, int row, int k) const {
    r.h = *(const u32x4*)(H + (size_t)row * 1024 + k);
    r.s = *(const u32x4*)(HS + (size_t)row * 1024 + k);
  }
  DEVI unsigned mix2(unsigned h, unsigned s, float m0, float m1) const {
    const float h0 = bf_lo(h), h1 = bf_hi(h), s0 = bf_lo(s), s1 = bf_hi(s);
    return pk_bf16(h0 + (s0 - h0) * m0, h1 + (s1 - h1) * m1);
  }
  DEVI u32x4 finish(const Regs& r, const float* sMu, int k) const {
    const float4 ma = *(const float4*)(sMu + k), mb = *(const float4*)(sMu + k + 4);
    u32x4 o;
    o.x = mix2(r.h.x, r.s.x, ma.x, ma.y); o.y = mix2(r.h.y, r.s.y, ma.z, ma.w);
    o.z = mix2(r.h.z, r.s.z, mb.x, mb.y); o.w = mix2(r.h.w, r.s.w, mb.z, mb.w);
    return o;
  }
};

template <class AL, class EP>
__device__ __forceinline__ void gemm_phase(char* lds, const bf16_t* __restrict__ Bt, int K, int mtiles, int ntiles, const AL al, const EP ep, int n_base = 0, bool reverse = false, int mt_base = 0) {
  bf16_t* sA = (bf16_t*)lds;
  bf16_t* sB = (bf16_t*)(lds + 73728);
  float* sMu = (float*)(lds + 110592);
  const int tid = opaque_tid(), lane = tid & 63, wv = tid >> 6, wm = wv >> 1, wn = wv & 1;
  const int l31 = lane & 31, lh = lane >> 5;
  const int nk = K >> 6;
  const int ldrow = tid >> 3, ldk = (tid & 7) * 8;
  const int total = mtiles * ntiles;
  const int bid = reverse ? (int)(gridDim.x - 1 - blockIdx.x) : (int)blockIdx.x;
  const int nslots = gridDim.x >> 3, xcd = bid & 7, slot = bid >> 3;
  const int gm = 4 * ntiles;
  for (int chunk = xcd; chunk * nslots < total; chunk += 8) {
    const int tile = chunk * nslots + slot;
    if (tile >= total) break;
    const int grp = tile / gm, rem = tile - grp * gm;
    const int mt = grp * 4 + (rem & 3), nt = rem >> 2;
    const int m0 = (mt_base + mt) * 256, n0 = n_base + nt * 128;
    __syncthreads();
    al.stage(sMu, n0);
    f32x16 acc[2][2];
#pragma unroll
    for (int a = 0; a < 2; ++a)
#pragma unroll
      for (int b = 0; b < 2; ++b)
#pragma unroll
        for (int r = 0; r < 16; ++r) acc[a][b][r] = 0.f;
    typename AL::Regs ar[4];
    u32x4 br[2];
#pragma unroll
    for (int i = 0; i < 4; ++i) al.issue(ar[i], m0 + ldrow + 64 * i, ldk);
#pragma unroll
    for (int i = 0; i < 2; ++i) br[i] = *(const u32x4*)(Bt + (size_t)(n0 + ldrow + 64 * i) * K + ldk);
    __syncthreads();
#pragma unroll
    for (int i = 0; i < 4; ++i) *(u32x4*)(sA + (ldrow + 64 * i) * 72 + ldk) = al.finish(ar[i], sMu, ldk);
#pragma unroll
    for (int i = 0; i < 2; ++i) *(u32x4*)(sB + (ldrow + 64 * i) * 72 + ldk) = br[i];
    __syncthreads();
    for (int kt = 0; kt < nk; ++kt) {
      const int cur = kt & 1;
      const bool more = (kt + 1) < nk;
      const int k0n = (kt + 1) * 64 + ldk;
      if (more) {
#pragma unroll
        for (int i = 0; i < 4; ++i) al.issue(ar[i], m0 + ldrow + 64 * i, k0n);
#pragma unroll
        for (int i = 0; i < 2; ++i) br[i] = *(const u32x4*)(Bt + (size_t)(n0 + ldrow + 64 * i) * K + k0n);
      }
      __builtin_amdgcn_sched_barrier(0);
      const bf16_t* a_ = sA + cur * (256 * 72);
      const bf16_t* b_ = sB + cur * (128 * 72);
#pragma unroll
      for (int kk = 0; kk < 4; ++kk) {
        u32x4 af[2], bfr[2];
#pragma unroll
        for (int mi = 0; mi < 2; ++mi) af[mi] = *(const u32x4*)(a_ + (wm * 64 + mi * 32 + l31) * 72 + kk * 16 + lh * 8);
#pragma unroll
        for (int ni = 0; ni < 2; ++ni) bfr[ni] = *(const u32x4*)(b_ + (wn * 64 + ni * 32 + l31) * 72 + kk * 16 + lh * 8);
#pragma unroll
        for (int mi = 0; mi < 2; ++mi)
#pragma unroll
          for (int ni = 0; ni < 2; ++ni) acc[mi][ni] = mfma32(bfr[ni], af[mi], acc[mi][ni]);
      }
      __builtin_amdgcn_sched_barrier(0);
      if (more) {
        bf16_t* an = sA + (cur ^ 1) * (256 * 72);
        bf16_t* bn = sB + (cur ^ 1) * (128 * 72);
#pragma unroll
        for (int i = 0; i < 4; ++i) *(u32x4*)(an + (ldrow + 64 * i) * 72 + ldk) = al.finish(ar[i], sMu, k0n);
#pragma unroll
        for (int i = 0; i < 2; ++i) *(u32x4*)(bn + (ldrow + 64 * i) * 72 + ldk) = br[i];
      }
      __syncthreads();
    }
#pragma unroll
    for (int mi = 0; mi < 2; ++mi)
#pragma unroll
      for (int ni = 0; ni < 2; ++ni)
#pragma unroll
        for (int q = 0; q < 4; ++q) {
          const int row = m0 + wm * 64 + mi * 32 + l31;
          const int col = n0 + wn * 64 + ni * 32 + 8 * q + 4 * lh;
          f32x4 v = {acc[mi][ni][4 * q], acc[mi][ni][4 * q + 1], acc[mi][ni][4 * q + 2], acc[mi][ni][4 * q + 3]};
          ep(row, col, v);
        }
  }
}


template <class AL, class EP>
__device__ __forceinline__ void gemm256_phase(char* lds, const bf16_t* __restrict__ Bt, int K, int mtiles, int ntiles, const AL al, const EP ep) {
  bf16_t* sA = (bf16_t*)lds;
  bf16_t* sB = (bf16_t*)(lds + 73728);
  float* sMu = (float*)(lds + 147456);
  const int tid = opaque_tid(), lane = tid & 63, wv = tid >> 6, wm = wv >> 1, wn = wv & 1;
  const int l31 = lane & 31, lh = lane >> 5;
  const int nk = K >> 6;
  const int ldrow = tid >> 3, ldk = (tid & 7) * 8;
  const int total = mtiles * ntiles;
  const int nslots = gridDim.x >> 3, xcd = blockIdx.x & 7, slot = blockIdx.x >> 3;
  const int gm = 4 * ntiles;
  for (int chunk = xcd; chunk * nslots < total; chunk += 8) {
    const int tile = chunk * nslots + slot;
    if (tile >= total) break;
    const int grp = tile / gm, rem = tile - grp * gm;
    const int mt = grp * 4 + (rem & 3), nt = rem >> 2;
    const int m0 = mt * 256, n0 = nt * 256;
    __syncthreads();
    al.stage(sMu, n0);
    f32x16 acc[2][4];
#pragma unroll
    for (int a = 0; a < 2; ++a)
#pragma unroll
      for (int b = 0; b < 4; ++b)
#pragma unroll
        for (int r = 0; r < 16; ++r) acc[a][b][r] = 0.f;
    typename AL::Regs ar[4];
    u32x4 br[4];
#pragma unroll
    for (int i = 0; i < 4; ++i) al.issue(ar[i], m0 + ldrow + 64 * i, ldk);
#pragma unroll
    for (int i = 0; i < 4; ++i) br[i] = *(const u32x4*)(Bt + (size_t)(n0 + ldrow + 64 * i) * K + ldk);
    __syncthreads();
#pragma unroll
    for (int i = 0; i < 4; ++i) *(u32x4*)(sA + (ldrow + 64 * i) * 72 + ldk) = al.finish(ar[i], sMu, ldk);
#pragma unroll
    for (int i = 0; i < 4; ++i) *(u32x4*)(sB + (ldrow + 64 * i) * 72 + ldk) = br[i];
    __syncthreads();
    const int half = __builtin_amdgcn_readfirstlane(wv >> 2);
    if (half == 1 && nk > 1) {
#pragma unroll
      for (int i = 0; i < 4; ++i) al.issue(ar[i], m0 + ldrow + 64 * i, 64 + ldk);
#pragma unroll
      for (int i = 0; i < 4; ++i) br[i] = *(const u32x4*)(Bt + (size_t)(n0 + ldrow + 64 * i) * K + 64 + ldk);
    }
    for (int step = 0; step < 2 * nk; ++step) {
      const int kc = step >> 1;
      if ((step & 1) == half) {
        const int kl = kc + 1 + half;
        if (kl < nk) {
          const int k0n = kl * 64 + ldk;
#pragma unroll
          for (int i = 0; i < 4; ++i) al.issue(ar[i], m0 + ldrow + 64 * i, k0n);
#pragma unroll
          for (int i = 0; i < 4; ++i) br[i] = *(const u32x4*)(Bt + (size_t)(n0 + ldrow + 64 * i) * K + k0n);
        }
        __builtin_amdgcn_sched_barrier(0);
        const bf16_t* a_ = sA + (kc & 1) * (256 * 72);
        const bf16_t* b_ = sB + (kc & 1) * (256 * 72);
#pragma unroll
        for (int kk = 0; kk < 4; ++kk) {
          u32x4 af[2];
#pragma unroll
          for (int mi = 0; mi < 2; ++mi) af[mi] = *(const u32x4*)(a_ + (wm * 64 + mi * 32 + l31) * 72 + kk * 16 + lh * 8);
#pragma unroll
          for (int ni = 0; ni < 4; ++ni) {
            const u32x4 bfr = *(const u32x4*)(b_ + (wn * 128 + ni * 32 + l31) * 72 + kk * 16 + lh * 8);
#pragma unroll
            for (int mi = 0; mi < 2; ++mi) acc[mi][ni] = mfma32(bfr, af[mi], acc[mi][ni]);
          }
        }
        __builtin_amdgcn_sched_barrier(0);
      } else {
        const int kf = kc + 1;
        if (kf < nk) {
          bf16_t* an = sA + (kf & 1) * (256 * 72);
          bf16_t* bn = sB + (kf & 1) * (256 * 72);
          const int k0n = kf * 64 + ldk;
#pragma unroll
          for (int i = 0; i < 4; ++i) *(u32x4*)(an + (ldrow + 64 * i) * 72 + ldk) = al.finish(ar[i], sMu, k0n);
#pragma unroll
          for (int i = 0; i < 4; ++i) *(u32x4*)(bn + (ldrow + 64 * i) * 72 + ldk) = br[i];
        }
      }
      __syncthreads();
    }
    if constexpr (EP::VIA_LDS) {
      float* reg = (float*)(lds + wv * 16896);
#pragma unroll
      for (int mi = 0; mi < 2; ++mi) {
#pragma unroll
        for (int ni = 0; ni < 4; ++ni)
#pragma unroll
          for (int q = 0; q < 4; ++q) {
            f32x4 v = {acc[mi][ni][4 * q], acc[mi][ni][4 * q + 1], acc[mi][ni][4 * q + 2], acc[mi][ni][4 * q + 3]};
            *(f32x4*)(reg + l31 * 132 + ni * 32 + 8 * q + 4 * lh) = v;
          }
#pragma unroll 4
        for (int it = 0; it < 16; ++it) {
          const int rl = it * 2 + lh;
          const f32x4 v = *(const f32x4*)(reg + rl * 132 + l31 * 4);
          ep(m0 + wm * 64 + mi * 32 + rl, n0 + wn * 128 + l31 * 4, v);
        }
      }
    } else
#pragma unroll
    for (int mi = 0; mi < 2; ++mi)
#pragma unroll
      for (int ni = 0; ni < 4; ++ni) {
#pragma unroll
        for (int q = 0; q < 4; ++q) {
          const int row = m0 + wm * 64 + mi * 32 + l31;
          const int col = n0 + wn * 128 + ni * 32 + 8 * q + 4 * lh;
          f32x4 v = {acc[mi][ni][4 * q], acc[mi][ni][4 * q + 1], acc[mi][ni][4 * q + 2], acc[mi][ni][4 * q + 3]};
          ep(row, col, v);
        }
        __builtin_amdgcn_sched_barrier(0);
      }
  }
}

DEVI void st_bf16x4(bf16_t* p, f32x4 v) { u32x2 o; o.x = pk_bf16(v[0], v[1]); o.y = pk_bf16(v[2], v[3]); *(u32x2*)p = o; }

struct EpRwkvIn {
  static constexpr bool VIA_LDS = false;
  bf16_t *R, *K, *V, *G, *WD, *AD;
  DEVI void operator()(int row, int col, f32x4 v) const {
    const int grp = col >> 10;
    if (grp < 4) {
      const int c = col & 1023;
      bf16_t* dst = grp == 0 ? R : grp == 1 ? K : grp == 2 ? V : G;
      if (grp == 3) { v[0] = siluf_(v[0]); v[1] = siluf_(v[1]); v[2] = siluf_(v[2]); v[3] = siluf_(v[3]); }
      st_bf16x4(dst + (size_t)row * 1024 + c, v);
    } else {
      const int c = col - 4096;
      if (c < 128) {
#pragma unroll
        for (int i = 0; i < 4; ++i) { const float t = __expf(2.f * v[i]); v[i] = 1.f - 2.f / (t + 1.f); }
        st_bf16x4(WD + (size_t)row * 128 + c, v);
      } else st_bf16x4(AD + (size_t)row * 128 + (c - 128), v);
    }
  }
};
struct EpRes {
  static constexpr bool VIA_LDS = false;
  const float* xl_src; const float* xc_src; float* xl_dst; float* xc_dst; const float* modL;
  DEVI void operator()(int row, int col, f32x4 v) const {
    const bool lat = row < ML;
    const size_t off = lat ? (size_t)row * 1024 + col : (size_t)(row - ML) * 1024 + col;
    const float* src = (lat ? xl_src : xc_src) + off;
    float* dst = (lat ? xl_dst : xc_dst) + off;
    const f32x4 g = *(const f32x4*)(modL + (lat ? (row >> 12) : 8) * 3072 + 2048 + col);
    f32x4 x = *(const f32x4*)src;
    x += g * v;
    *(f32x4*)dst = x;
  }
};
struct EpLruIn {
  static constexpr bool VIA_LDS = false;
  bf16_t *XR, *GG;
  DEVI void operator()(int row, int col, f32x4 v) const {
    if (col < LW) st_bf16x4(XR + (size_t)row * LW + col, v);
    else { v[0] = siluf_(v[0]); v[1] = siluf_(v[1]); v[2] = siluf_(v[2]); v[3] = siluf_(v[3]); st_bf16x4(GG + (size_t)row * LW + (col - LW), v); }
  }
};
struct EpNatIn {
  static constexpr bool VIA_LDS = false;
  bf16_t *Q, *K, *VT, *G;
  DEVI void operator()(int row, int col, f32x4 v) const {
    const int grp = col >> 10, c = col & 1023;
    if (grp == 0) st_bf16x4(Q + (size_t)row * 1024 + c, v);
    else if (grp == 1) st_bf16x4(K + (size_t)row * 1024 + c, v);
    else if (grp == 3) { v[0] = siluf_(v[0]); v[1] = siluf_(v[1]); v[2] = siluf_(v[2]); v[3] = siluf_(v[3]); st_bf16x4(G + (size_t)row * 1024 + c, v); }
    else {
      unsigned idx, T;
      if (row < ML) { const unsigned b = row >> 12, t = row & 4095; T = 4096u; idx = ((b * 1024u + (unsigned)c) << 12) + t; }
      else { const unsigned r2 = row - ML; const unsigned b = r2 >> 8, t = r2 & 255; T = 256u; idx = (unsigned)ML * 1024u + ((b * 1024u + (unsigned)c) << 8) + t; }
#pragma unroll
      for (int i = 0; i < 4; ++i) VT[idx + (unsigned)i * T] = f2bf(v[i]);
    }
  }
};

DEVI int rwkv_row(int b, int d, int s) {
  if (s < 256) return ML + b * 256 + (d ? 255 - s : s);
  const int t = s - 256;
  return b * 4096 + (d ? 4095 - t : t);
}

constexpr int PSTR = 456, PREC_Y = 64, PREC_V0 = 192, PREC_V1 = 256, PREC_SC = 320, PREC_BF = 328;
constexpr int TSTR = 388;
struct ScanRec { u32x4 a1, a2; float v0, v1; f32x4 s0, s1; f32x4 ww[4]; u32x2 y[4]; };
DEVI void scan_load(ScanRec& R, const float* rec, int g, int c16, int role_off, int srow) {
  const char* ab = (const char*)(rec + PREC_BF) + role_off + g * 16;
  R.a1 = *(const u32x4*)ab; R.a2 = *(const u32x4*)(ab + 64);
  R.v0 = rec[PREC_V0 + srow]; R.v1 = rec[PREC_V1 + srow];
  R.s0 = *(const f32x4*)(rec + PREC_SC); R.s1 = *(const f32x4*)(rec + PREC_SC + 4);
#pragma unroll
  for (int nt = 0; nt < 4; ++nt) {
    R.ww[nt] = *(const f32x4*)(rec + 16 * nt + 4 * g);
    R.y[nt] = *(const u32x2*)((const char*)(rec + PREC_Y) + (16 * nt + c16) * 8);
  }
}
DEVI void scan_step2(f32x4 (&S)[4], const ScanRec& R, bool g0, float* yout) {
  const u32x4 b1 = mk4(pk_bf16(S[0][0], S[0][1]), pk_bf16(S[0][2], S[0][3]), pk_bf16(S[1][0], S[1][1]), pk_bf16(S[1][2], S[1][3]));
  const u32x4 b2 = mk4(pk_bf16(S[2][0], S[2][1]), pk_bf16(S[2][2], S[2][3]), pk_bf16(S[3][0], S[3][1]), pk_bf16(S[3][2], S[3][3]));
  f32x4 D = {0.f, 0.f, 0.f, 0.f};
  D = mfma16(R.a1, b1, D);
  D = mfma16(R.a2, b2, D);
  const float v0 = R.v0, v1 = R.v1;
  const float sa0 = D[0];
  const float sa1 = D[2] + sa0 * R.s0[2] + v0 * R.s0[3];
  const unsigned x0 = pk_bf16(sa0, v0), x1 = pk_bf16(sa1, v1);
  const u32x4 xb = mk4(g0 ? x0 : 0u, g0 ? x1 : 0u, 0u, 0u);
#pragma unroll
  for (int nt = 0; nt < 4; ++nt) S[nt] = mfma16(mk4(R.y[nt].x, R.y[nt].y, 0u, 0u), xb, S[nt] * R.ww[nt]);
  yout[0] = D[1] + sa0 * R.s0[0] + v0 * R.s0[1];
  yout[256] = D[3] + sa0 * R.s1[0] + v0 * R.s1[1] + sa1 * R.s1[2] + v1 * R.s1[3];
}
DEVI float sum16(float v) { v = sum8(v); v += dpp_f<0x140>(v); return v; }

__device__ __forceinline__ void rwkv_scan_phase(char* lds, const bf16_t* __restrict__ R, const bf16_t* __restrict__ Kb, const bf16_t* __restrict__ V,
                                const bf16_t* __restrict__ WD, const bf16_t* __restrict__ AD, const bf16_t* __restrict__ Wup,
                                const float* __restrict__ b0, const float* __restrict__ k_ka, const float* __restrict__ r_k,
                                bf16_t* __restrict__ Y0, bf16_t* __restrict__ Y1, float* __restrict__ BON) {
  float* stepbuf = (float*)lds;
  float* tokbuf = stepbuf + 2 * 8 * PSTR;
  float* wabuf = tokbuf + 2 * 16 * TSTR;
  float* ybuf = wabuf + 4096;
  const int tid = opaque_tid(), lane = tid & 63, wv = tid >> 6;
  constexpr int NCH = (256 + 4096) / 16;
  for (int chain = blockIdx.x; chain < 256; chain += gridDim.x) {
    const int d = chain & 1, h = (chain >> 1) & 15, b = chain >> 5;
    __syncthreads();
    if (wv < 4) {
      const int kq = lane >> 4, c16 = lane & 15, srow = wv * 16 + c16;
      const int role_off = (lane & 3) * 128;
      const bool g0 = kq == 0;
      f32x4 S[4];
#pragma unroll
      for (int j = 0; j < 4; ++j) S[j] = (f32x4){0.f, 0.f, 0.f, 0.f};
      __syncthreads();
      __syncthreads();
      __syncthreads();
      for (int c = 0; c < NCH; ++c) {
        const float* sb = stepbuf + (c & 1) * 8 * PSTR;
        float* yb = ybuf + (c & 1) * 4096 + kq * 64 + srow;
        ScanRec ra, rb;
        scan_load(ra, sb, kq, c16, role_off, srow);
#pragma unroll
        for (int i = 0; i < 4; i += 2) {
          scan_load(rb, sb + (i + 1) * PSTR, kq, c16, role_off, srow);
          scan_step2(S, ra, g0, yb + i * 512);
          scan_load(ra, sb + (i + 2) * PSTR, kq, c16, role_off, srow);
          scan_step2(S, rb, g0, yb + (i + 1) * 512);
        }
#pragma unroll
        for (int i = 4; i < 8; i += 2) {
          scan_load(rb, sb + (i + 1) * PSTR, kq, c16, role_off, srow);
          scan_step2(S, ra, g0, yb + i * 512);
          if (i + 2 < 8) scan_load(ra, sb + (i + 2) * PSTR, kq, c16, role_off, srow);
          scan_step2(S, rb, g0, yb + (i + 1) * 512);
        }
        __syncthreads();
      }
    } else {
      const int ptid = tid - 256, pw = wv - 4;
      bf16_t* Y = d ? Y1 : Y0;
      const int ncol = h * 64 + pw * 16 + (lane & 15);
      u32x4 bu[2][2];
      float bias_u[2];
#pragma unroll
      for (int kind = 0; kind < 2; ++kind) {
        const bf16_t* wu = Wup + ((size_t)(d * 2 + kind) * 1024 + ncol) * 64 + 8 * (lane >> 4);
        bu[kind][0] = *(const u32x4*)wu; bu[kind][1] = *(const u32x4*)(wu + 32);
        bias_u[kind] = b0[(d * 2 + kind) * 1024 + ncol];
      }
      const int ti = ptid >> 4, dq = ptid & 15;
      const int hc = h * 64 + 4 * dq;
      const f32x4 kkv = *(const f32x4*)(k_ka + hc), kav = *(const f32x4*)(k_ka + 1024 + hc), rkv = *(const f32x4*)(r_k + hc);
      u32x4 xw0, xw1, xa0, xa1; u32x2 rr, kr, vr;
      auto issueL = [&](int c) {
        const int rowA = rwkv_row(b, d, c * 16 + (lane & 15));
        const bf16_t* xp = WD + (size_t)rowA * 128 + d * 64 + 8 * (lane >> 4);
        const bf16_t* xq = AD + (size_t)rowA * 128 + d * 64 + 8 * (lane >> 4);
        xw0 = *(const u32x4*)xp; xw1 = *(const u32x4*)(xp + 32);
        xa0 = *(const u32x4*)xq; xa1 = *(const u32x4*)(xq + 32);
      };
      auto issueT = [&](int c) {
        const int rowB = rwkv_row(b, d, c * 16 + ti);
        rr = *(const u32x2*)(R + (size_t)rowB * 1024 + hc);
        kr = *(const u32x2*)(Kb + (size_t)rowB * 1024 + hc);
        vr = *(const u32x2*)(V + (size_t)rowB * 1024 + hc);
      };
      auto stepA = [&](int c) {
        float* wbuf = wabuf + (c & 1) * 2048; float* abuf = wbuf + 1024;
        f32x4 accw = {0.f, 0.f, 0.f, 0.f}, acca = {0.f, 0.f, 0.f, 0.f};
        accw = mfma16(xw0, bu[0][0], accw); accw = mfma16(xw1, bu[0][1], accw);
        acca = mfma16(xa0, bu[1][0], acca); acca = mfma16(xa1, bu[1][1], acca);
#pragma unroll
        for (int r = 0; r < 4; ++r) {
          const int o = ((lane >> 4) * 4 + r) * 64 + pw * 16 + (lane & 15);
          const float x = -(accw[r] + bias_u[0]);
          const float sp = fmaxf(x, 0.f) + 0.6931471805599453f * __builtin_amdgcn_logf(1.f + __builtin_amdgcn_exp2f(-1.4426950408889634f * fabsf(x)));
          const float ew = __builtin_amdgcn_exp2f(-1.4426950408889634f * (sp + 0.5f));
          wbuf[o] = __builtin_amdgcn_exp2f(-1.4426950408889634f * ew);
          abuf[o] = __builtin_amdgcn_rcpf(1.f + __builtin_amdgcn_exp2f(-1.4426950408889634f * (acca[r] + bias_u[1])));
        }
      };
      auto stepB1 = [&](int c) {
        const float rv[4] = {bf_lo(rr.x), bf_hi(rr.x), bf_lo(rr.y), bf_hi(rr.y)};
        const float kv[4] = {bf_lo(kr.x), bf_hi(kr.x), bf_lo(kr.y), bf_hi(kr.y)};
        const float vv[4] = {bf_lo(vr.x), bf_hi(vr.x), bf_lo(vr.y), bf_hi(vr.y)};
        const float* wbuf = wabuf + (c & 1) * 2048; const float* abuf = wbuf + 1024;
        const f32x4 av = *(const f32x4*)(abuf + ti * 64 + 4 * dq), wv4 = *(const f32x4*)(wbuf + ti * 64 + 4 * dq);
        float q[4], ss = 0.f;
#pragma unroll
        for (int i = 0; i < 4; ++i) { q[i] = kv[i] * kkv[i]; ss += q[i] * q[i]; }
        ss = sum16(ss);
        const float inv = __builtin_amdgcn_rsqf(fmaxf(ss, 1e-24f));
        f32x4 nk, wrr, ka, kd, vo;
        float c1 = 0.f, c2 = 0.f, bn = 0.f;
#pragma unroll
        for (int i = 0; i < 4; ++i) {
          const float n = q[i] * inv;
          kd[i] = kv[i] * (1.f + (av[i] - 1.f) * kav[i]);
          ka[i] = n * av[i];
          nk[i] = -n; wrr[i] = wv4[i] * rv[i]; vo[i] = vv[i];
          c1 += ka[i] * rv[i]; c2 += kd[i] * rv[i]; bn += rv[i] * kd[i] * rkv[i];
        }
        c1 = sum16(c1); c2 = sum16(c2); bn = sum16(bn);
        float* rec = tokbuf + ((c & 1) * 16 + ti) * TSTR;
        *(f32x4*)(rec + 4 * dq) = nk;
        *(f32x4*)(rec + 64 + 4 * dq) = wrr;
        *(f32x4*)(rec + 128 + 4 * dq) = wv4;
        *(f32x4*)(rec + 192 + 4 * dq) = ka;
        *(f32x4*)(rec + 256 + 4 * dq) = kd;
        *(f32x4*)(rec + 320 + 4 * dq) = vo;
        if (dq == 0) {
          *(f32x2*)(rec + 384) = (f32x2){c1, c2};
          BON[((size_t)d * MT + rwkv_row(b, d, c * 16 + ti)) * 16 + h] = bn;
        }
      };
      auto stepB2 = [&](int c) {
        const int pp = ptid >> 5, dp = ptid & 31;
        const float* t0 = tokbuf + ((c & 1) * 16 + 2 * pp) * TSTR + 2 * dp;
        const float* t1 = t0 + TSTR;
        const f32x2 a0 = *(const f32x2*)(t0), wr0 = *(const f32x2*)(t0 + 64), w0 = *(const f32x2*)(t0 + 128);
        const f32x2 b0_ = *(const f32x2*)(t0 + 192), k0_ = *(const f32x2*)(t0 + 256), v0 = *(const f32x2*)(t0 + 320);
        const f32x2 a1 = *(const f32x2*)(t1), wr1 = *(const f32x2*)(t1 + 64), w1 = *(const f32x2*)(t1 + 128);
        const f32x2 b1_ = *(const f32x2*)(t1 + 192), k1_ = *(const f32x2*)(t1 + 256), v1 = *(const f32x2*)(t1 + 320);
        float c3 = b0_[0] * a1[0] + b0_[1] * a1[1], c4 = k0_[0] * a1[0] + k0_[1] * a1[1];
        float c5 = b0_[0] * wr1[0] + b0_[1] * wr1[1], c6 = k0_[0] * wr1[0] + k0_[1] * wr1[1];
        c3 = sum16(c3); c4 = sum16(c4); c5 = sum16(c5); c6 = sum16(c6);
        c3 += __shfl_xor(c3, 16); c4 += __shfl_xor(c4, 16); c5 += __shfl_xor(c5, 16); c6 += __shfl_xor(c6, 16);
        float* rec = stepbuf + ((c & 1) * 8 + pp) * PSTR;
        *(f32x2*)(rec + 2 * dp) = w0 * w1;
        {
          const f32x2 bw = b0_ * w1, kw = k0_ * w1;
          *(u32x4*)((char*)(rec + PREC_Y) + 16 * dp) = mk4(pk_bf16(bw[0], kw[0]), pk_bf16(b1_[0], k1_[0]), pk_bf16(bw[1], kw[1]), pk_bf16(b1_[1], k1_[1]));
        }
        *(f32x2*)(rec + PREC_V0 + 2 * dp) = v0;
        *(f32x2*)(rec + PREC_V1 + 2 * dp) = v1;
        unsigned* bb = (unsigned*)(rec + PREC_BF);
        const f32x2 wa = w0 * a1, wwr = w0 * wr1;
        const int kk = (2 * dp) & 31;
        const int pos = ((2 * dp) & 32) + (kk < 16 ? 8 * (kk >> 2) + (kk & 3) : 8 * ((kk - 16) >> 2) + 4 + (kk & 3));
        const int pu = pos >> 1;
        bb[pu] = pk_bf16(a0[0], a0[1]);
        bb[32 + pu] = pk_bf16(wr0[0], wr0[1]);
        bb[64 + pu] = pk_bf16(wa[0], wa[1]);
        bb[96 + pu] = pk_bf16(wwr[0], wwr[1]);
        if (dp == 0) {
          const f32x2 cc0 = *(const f32x2*)(t0 + 384), cc1 = *(const f32x2*)(t1 + 384);
          *(f32x4*)(rec + PREC_SC) = (f32x4){cc0[0], cc0[1], c3, c4};
          *(f32x4*)(rec + PREC_SC + 4) = (f32x4){c5, c6, cc1[0], cc1[1]};
        }
      };
      auto storeY = [&](int c) {
        const f32x4 yv = *(const f32x4*)(ybuf + (c & 1) * 4096 + ti * 256 + 4 * dq);
        u32x2 o; o.x = pk_bf16(yv[0], yv[1]); o.y = pk_bf16(yv[2], yv[3]);
        *(u32x2*)(Y + (size_t)rwkv_row(b, d, c * 16 + ti) * 1024 + hc) = o;
      };
      issueL(0); issueT(0);
      stepA(0);
      issueL(1);
      __syncthreads();
      stepB1(0); issueT(1);
      stepA(1); issueL(2);
      __syncthreads();
      stepB2(0);
      stepB1(1); issueT(2);
      stepA(2); issueL(3);
      __builtin_amdgcn_sched_barrier(0);
      __syncthreads();
      __builtin_amdgcn_sched_barrier(0);
      for (int c = 0; c < NCH; ++c) {
        if (c + 3 < NCH) stepA(c + 3);
        if (c + 4 < NCH) issueL(c + 4);
        if (c + 2 < NCH) stepB1(c + 2);
        if (c + 3 < NCH) issueT(c + 3);
        if (c + 1 < NCH) stepB2(c + 1);
        if (c >= 1) storeY(c - 1);
        __builtin_amdgcn_sched_barrier(0);
        __syncthreads();
        __builtin_amdgcn_sched_barrier(0);
      }
      storeY(NCH - 1);
    }
  }
}

__device__ __forceinline__ void rwkv_post_phase(const bf16_t* __restrict__ Y0, const bf16_t* __restrict__ Y1, const bf16_t* __restrict__ V,
                                bf16_t* __restrict__ G, const float* __restrict__ BON, const float* __restrict__ gn, int nrows) {
  const int tidx = opaque_tid();
  const int lane = tidx & 63;
  const int gw = blockIdx.x * (NTHR / 64) + (tidx >> 6), nw = gridDim.x * (NTHR / 64);
  const int head = lane >> 2, c0 = lane * 16;
  for (int row = gw; row < nrows; row += nw) {
    const size_t off = (size_t)row * 1024 + c0;
    float y[16], v[16], g[16];
#pragma unroll
    for (int i = 0; i < 2; ++i) {
      const u32x4 a0 = *(const u32x4*)(Y0 + off + 8 * i), a1 = *(const u32x4*)(Y1 + off + 8 * i);
      const u32x4 av = *(const u32x4*)(V + off + 8 * i), ag = *(const u32x4*)(G + off + 8 * i);
      y[8 * i + 0] = bf_lo(a0.x) + bf_lo(a1.x); y[8 * i + 1] = bf_hi(a0.x) + bf_hi(a1.x);
      y[8 * i + 2] = bf_lo(a0.y) + bf_lo(a1.y); y[8 * i + 3] = bf_hi(a0.y) + bf_hi(a1.y);
      y[8 * i + 4] = bf_lo(a0.z) + bf_lo(a1.z); y[8 * i + 5] = bf_hi(a0.z) + bf_hi(a1.z);
      y[8 * i + 6] = bf_lo(a0.w) + bf_lo(a1.w); y[8 * i + 7] = bf_hi(a0.w) + bf_hi(a1.w);
      v[8 * i + 0] = bf_lo(av.x); v[8 * i + 1] = bf_hi(av.x); v[8 * i + 2] = bf_lo(av.y); v[8 * i + 3] = bf_hi(av.y);
      v[8 * i + 4] = bf_lo(av.z); v[8 * i + 5] = bf_hi(av.z); v[8 * i + 6] = bf_lo(av.w); v[8 * i + 7] = bf_hi(av.w);
      g[8 * i + 0] = bf_lo(ag.x); g[8 * i + 1] = bf_hi(ag.x); g[8 * i + 2] = bf_lo(ag.y); g[8 * i + 3] = bf_hi(ag.y);
      g[8 * i + 4] = bf_lo(ag.z); g[8 * i + 5] = bf_hi(ag.z); g[8 * i + 6] = bf_lo(ag.w); g[8 * i + 7] = bf_hi(ag.w);
    }
    float s = 0.f;
#pragma unroll
    for (int i = 0; i < 16; ++i) s += y[i];
    s += __shfl_xor(s, 1); s += __shfl_xor(s, 2);
    const float mean = s * (1.f / 64.f);
    float q = 0.f;
#pragma unroll
    for (int i = 0; i < 16; ++i) { const float dlt = y[i] - mean; q += dlt * dlt; }
    q += __shfl_xor(q, 1); q += __shfl_xor(q, 2);
    const float rstd = rsqrtf(q * (1.f / 64.f) + 64e-5f);
    const float bonus = BON[(size_t)row * 16 + head] + BON[((size_t)MT + row) * 16 + head];
    unsigned o[8];
#pragma unroll
    for (int i = 0; i < 8; ++i) {
      const float z0 = ((y[2 * i] - mean) * rstd * gn[c0 + 2 * i] + gn[1024 + c0 + 2 * i] + bonus * v[2 * i]) * g[2 * i];
      const float z1 = ((y[2 * i + 1] - mean) * rstd * gn[c0 + 2 * i + 1] + gn[1024 + c0 + 2 * i + 1] + bonus * v[2 * i + 1]) * g[2 * i + 1];
      o[i] = pk_bf16(z0, z1);
    }
    *(u32x4*)(G + off) = mk4(o[0], o[1], o[2], o[3]);
    *(u32x4*)(G + off + 8) = mk4(o[4], o[5], o[6], o[7]);
  }
}

__device__ __forceinline__ void rglru_phase(char* lds, const bf16_t* __restrict__ XR, const bf16_t* __restrict__ Wg, const float* __restrict__ conv_w,
                            const float* __restrict__ conv_b, const float* __restrict__ gate_b, const float* __restrict__ lam,
                            bf16_t* __restrict__ HS0, bf16_t* __restrict__ HS1) {
  bf16_t* xcT = (bf16_t*)lds;
  f32x2* AB = (f32x2*)(lds + 26624);
  bf16_t* raw = (bf16_t*)(lds + 26624);
  float* segP = (float*)(lds + 116736);
  float* segH = segP + 352;
  float* segC = segH + 352;
  bf16_t* wgs = (bf16_t*)(lds + 120960);
  float* cws = (float*)(lds + 160896);
  const int tid = opaque_tid(), lane = tid & 63, wv = tid >> 6;
  for (int chain = blockIdx.x; chain < 256; chain += gridDim.x) {
    const int d = chain & 1, blk = (chain >> 1) & 15, b = chain >> 5;
    bf16_t* HS = d ? HS1 : HS0;
    float carry = 0.f;
    __syncthreads();
    for (int q = tid; q < 2 * 96 * 12; q += NTHR) {
      const int g = q / 1152, rem = q - g * 1152, n = rem / 12, k8 = rem - n * 12;
      *(u32x4*)(wgs + (g * 96 + n) * 104 + k8 * 8) = *(const u32x4*)(Wg + ((size_t)((blk * 4 + d * 2 + g) * 96 + n)) * 96 + k8 * 8);
    }
    for (int e = tid; e < 5 * 88; e += NTHR) {
      const int j = e / 88, c = e - j * 88;
      cws[e] = j < 4 ? conv_w[j * LW + blk * 88 + c] : conv_b[blk * 88 + c];
    }
    for (int e = tid; e < 128 * 8; e += NTHR) xcT[(e >> 3) * 104 + 88 + (e & 7)] = 0;
    u32x4 pre[3];
    auto tile_geom = [&](int ti, int& seqbase, int& t0, int& T) {
      if (ti < 2) { seqbase = ML + b * 256; T = 256; t0 = (d ? 1 - ti : ti) * 128; }
      else { seqbase = b * 4096; T = 4096; t0 = (d ? 31 - (ti - 2) : (ti - 2)) * 128; }
    };
    auto prefetch = [&](int ti) {
      int seqbase, t0, T; tile_geom(ti, seqbase, t0, T);
#pragma unroll
      for (int i = 0; i < 3; ++i) {
        const int q = tid + NTHR * i;
        const int row = q / 11, cc = q - row * 11, t = t0 - 2 + row;
        u32x4 v = {0u, 0u, 0u, 0u};
        if (q < 131 * 11 && t >= 0 && t < T) v = *(const u32x4*)(XR + (size_t)(seqbase + t) * LW + blk * 88 + cc * 8);
        pre[i] = v;
      }
    };
    prefetch(0);
    for (int ti = 0; ti < 34; ++ti) {
      int seqbase, t0, T; tile_geom(ti, seqbase, t0, T);
      __syncthreads();
#pragma unroll
      for (int i = 0; i < 3; ++i) {
        const int q = tid + NTHR * i;
        if (q < 131 * 11) *(u32x4*)(raw + q * 8) = pre[i];
      }
      if (ti + 1 < 34) prefetch(ti + 1);
      __builtin_amdgcn_sched_barrier(0);
      __syncthreads();
      for (int e = tid; e < 128 * 44; e += NTHR) {
        const int tl = e / 44, c2 = (e - tl * 44) * 2;
        float a0 = cws[4 * 88 + c2], a1 = cws[4 * 88 + c2 + 1];
#pragma unroll
        for (int j = 0; j < 4; ++j) {
          const unsigned x = *(const unsigned*)(raw + (tl + j) * 88 + c2);
          a0 += bf_lo(x) * cws[j * 88 + c2]; a1 += bf_hi(x) * cws[j * 88 + c2 + 1];
        }
        *(unsigned*)(xcT + tl * 104 + c2) = pk_bf16(a0, a1);
      }
      __syncthreads();
      {
        const int tok = wv * 16 + (lane & 15);
        u32x4 af[3];
#pragma unroll
        for (int kk = 0; kk < 3; ++kk) af[kk] = *(const u32x4*)(xcT + tok * 104 + kk * 32 + 8 * (lane >> 4));
#pragma unroll
        for (int n6 = 0; n6 < 6; ++n6) {
          f32x4 accr = {0.f, 0.f, 0.f, 0.f}, acci = {0.f, 0.f, 0.f, 0.f};
          const int ncol = n6 * 16 + (lane & 15);
          const bf16_t* wr_ = wgs + ncol * 104 + 8 * (lane >> 4);
          const bf16_t* wi_ = wgs + (96 + ncol) * 104 + 8 * (lane >> 4);
#pragma unroll
          for (int kk = 0; kk < 3; ++kk) {
            accr = mfma16(af[kk], *(const u32x4*)(wr_ + kk * 32), accr);
            acci = mfma16(af[kk], *(const u32x4*)(wi_ + kk * 32), acci);
          }
          if (ncol < 88) {
            const int ch = blk * 88 + ncol;
            const float gbr = gate_b[(d * 2 + 0) * LW + ch], gbi = gate_b[(d * 2 + 1) * LW + ch];
            const float spl = softplusf_(-lam[d * LW + ch]);
#pragma unroll
            for (int r = 0; r < 4; ++r) {
              const int tk = wv * 16 + (lane >> 4) * 4 + r;
              const float rg = sigmoidf_(accr[r] + gbr), ig = sigmoidf_(acci[r] + gbi);
              const float a = __expf(-8.f * rg * spl);
              const float bb = sqrtf(fmaxf(1.f - a * a, 0.f)) * ig * bf2f(xcT[tk * 104 + ncol]);
              AB[tk * 88 + ncol] = (f32x2){a, bb};
            }
          }
        }
      }
      __syncthreads();
      if (tid < 352) {
        const int seg = tid / 88, c = tid - seg * 88;
        float hl = 0.f, P = 1.f;
        for (int u0 = seg * 32; u0 < seg * 32 + 32; u0 += 8) {
          f32x2 ab[8];
#pragma unroll
          for (int i = 0; i < 8; ++i) { const int tl = d ? 127 - (u0 + i) : (u0 + i); ab[i] = AB[tl * 88 + c]; }
#pragma unroll
          for (int i = 0; i < 8; ++i) { hl = ab[i][0] * hl + ab[i][1]; P *= ab[i][0]; ab[i] = (f32x2){hl, P}; }
#pragma unroll
          for (int i = 0; i < 8; ++i) { const int tl = d ? 127 - (u0 + i) : (u0 + i); AB[tl * 88 + c] = ab[i]; }
        }
        segH[seg * 88 + c] = hl; segP[seg * 88 + c] = P;
      }
      __syncthreads();
      if (tid < 88) {
        float cur = carry;
#pragma unroll
        for (int seg = 0; seg < 4; ++seg) { segC[seg * 88 + tid] = cur; cur = segP[seg * 88 + tid] * cur + segH[seg * 88 + tid]; }
        carry = cur;
      }
      __syncthreads();
      for (int q = tid; q < 128 * 11; q += NTHR) {
        const int tl = q / 11, c8 = (q - tl * 11) * 8;
        const int u = d ? 127 - tl : tl;
        const float* sc = segC + (u >> 5) * 88 + c8;
        float hv[8];
#pragma unroll
        for (int i = 0; i < 8; ++i) { const f32x2 hp = AB[tl * 88 + c8 + i]; hv[i] = hp[0] + hp[1] * sc[i]; }
        *(u32x4*)(HS + (size_t)(seqbase + t0 + tl) * LW + blk * 88 + c8) =
            mk4(pk_bf16(hv[0], hv[1]), pk_bf16(hv[2], hv[3]), pk_bf16(hv[4], hv[5]), pk_bf16(hv[6], hv[7]));
      }
    }
  }
}

__device__ __forceinline__ void lru_z_phase(const bf16_t* __restrict__ HS0, const bf16_t* __restrict__ HS1, bf16_t* __restrict__ GG) {
  const size_t n8 = (size_t)MT * LW / 8;
  for (size_t e = (size_t)blockIdx.x * NTHR + threadIdx.x; e < n8; e += (size_t)gridDim.x * NTHR) {
    const u32x4 a = *(const u32x4*)(HS0 + e * 8), b = *(const u32x4*)(HS1 + e * 8), g = *(const u32x4*)(GG + e * 8);
    u32x4 o;
    o.x = pk_bf16((bf_lo(a.x) + bf_lo(b.x)) * bf_lo(g.x), (bf_hi(a.x) + bf_hi(b.x)) * bf_hi(g.x));
    o.y = pk_bf16((bf_lo(a.y) + bf_lo(b.y)) * bf_lo(g.y), (bf_hi(a.y) + bf_hi(b.y)) * bf_hi(g.y));
    o.z = pk_bf16((bf_lo(a.z) + bf_lo(b.z)) * bf_lo(g.z), (bf_hi(a.z) + bf_hi(b.z)) * bf_hi(g.z));
    o.w = pk_bf16((bf_lo(a.w) + bf_lo(b.w)) * bf_lo(g.w), (bf_hi(a.w) + bf_hi(b.w)) * bf_hi(g.w));
    *(u32x4*)(GG + e * 8) = o;
  }
}

__device__ __forceinline__ void nat_qk_phase(bf16_t* __restrict__ Q, bf16_t* __restrict__ Kb, bf16_t* __restrict__ QR, const float* __restrict__ qk_g) {
  const int tidx = opaque_tid();
  const int lane = tidx & 63;
  const int gw = blockIdx.x * (NTHR / 64) + (tidx >> 6), nw = gridDim.x * (NTHR / 64);
  const int qd = lane & 3;
  float gq[16], gk[16], inv[16];
#pragma unroll
  for (int i = 0; i < 16; ++i) { gq[i] = qk_g[qd * 16 + i]; gk[i] = qk_g[64 + qd * 16 + i]; inv[i] = exp2f(-(float)i * (13.287712379549449f / 16.f)); }
  for (int row = gw; row < MT; row += nw) {
    const bool lat = row < ML;
    const size_t off = (size_t)row * 1024 + lane * 16;
    float cs[16], sn[16];
    if (lat) {
      const int t = row & 4095;
      const float pos = (float)((qd >> 1) ? (t & 63) : (t >> 6));
#pragma unroll
      for (int i = 0; i < 16; ++i) {
        float rev = pos * inv[i] * 0.15915494309189535f;
        rev -= floorf(rev);
        sn[i] = __builtin_amdgcn_sinf(rev); cs[i] = __builtin_amdgcn_cosf(rev);
      }
    }
#pragma unroll
    for (int which = 0; which < 2; ++which) {
      bf16_t* P = which ? Kb : Q;
      const u32x4 a = *(const u32x4*)(P + off), b2 = *(const u32x4*)(P + off + 8);
      const unsigned u[8] = {a.x, a.y, a.z, a.w, b2.x, b2.y, b2.z, b2.w};
      float x[16];
#pragma unroll
      for (int i = 0; i < 8; ++i) { x[2 * i] = bf_lo(u[i]); x[2 * i + 1] = bf_hi(u[i]); }
      float ss = 0.f;
#pragma unroll
      for (int i = 0; i < 16; ++i) ss += x[i] * x[i];
      ss += __shfl_xor(ss, 1); ss += __shfl_xor(ss, 2);
      const float rstd = rsqrtf(ss * (1.f / 64.f) + 1e-6f);
#pragma unroll
      for (int i = 0; i < 16; ++i) x[i] = x[i] * rstd * (which ? gk[i] : gq[i]);
      unsigned pl[8];
#pragma unroll
      for (int i = 0; i < 8; ++i) pl[i] = pk_bf16(x[2 * i], x[2 * i + 1]);
      unsigned rt[8];
      if (lat) {
        float y[16];
#pragma unroll
        for (int i = 0; i < 16; ++i) {
          const float pr = __shfl_xor(x[i], 1);
          y[i] = x[i] * cs[i] + ((qd & 1) ? pr * sn[i] : -pr * sn[i]);
        }
#pragma unroll
        for (int i = 0; i < 8; ++i) rt[i] = pk_bf16(y[2 * i], y[2 * i + 1]);
      }
      if (which == 0) {
        *(u32x4*)(Q + off) = mk4(pl[0], pl[1], pl[2], pl[3]);
        *(u32x4*)(Q + off + 8) = mk4(pl[4], pl[5], pl[6], pl[7]);
        if (lat) { *(u32x4*)(QR + off) = mk4(rt[0], rt[1], rt[2], rt[3]); *(u32x4*)(QR + off + 8) = mk4(rt[4], rt[5], rt[6], rt[7]); }
      } else {
        if (lat) { *(u32x4*)(Kb + off) = mk4(rt[0], rt[1], rt[2], rt[3]); *(u32x4*)(Kb + off + 8) = mk4(rt[4], rt[5], rt[6], rt[7]); }
        else { *(u32x4*)(Kb + off) = mk4(pl[0], pl[1], pl[2], pl[3]); *(u32x4*)(Kb + off + 8) = mk4(pl[4], pl[5], pl[6], pl[7]); }
      }
    }
  }
}

struct AttnState { f32x16 O[2][2]; float m[2], l[2]; };

DEVI void attn_load_k(u32x4 (&kf)[4], const bf16_t* __restrict__ kbase, int lane) {
  const int l31 = lane & 31, lh = lane >> 5;
#pragma unroll
  for (int ks = 0; ks < 4; ++ks) kf[ks] = *(const u32x4*)(kbase + (size_t)l31 * 1024 + ks * 16 + 8 * lh);
}

DEVI void attn_compute(AttnState& st, const u32x4* qs, const bf16_t* __restrict__ kbase, const bf16_t* __restrict__ vtbase, int vtT,
                       const float* __restrict__ rpbs, bool band, int brow, int half, int lane) {
  const int l31 = lane & 31, lh = lane >> 5;
  u32x4 kf[4];
  attn_load_k(kf, kbase, lane);
  u32x4 vf[4];
#pragma unroll
  for (int dt = 0; dt < 2; ++dt)
#pragma unroll
    for (int s = 0; s < 2; ++s) {
      const bf16_t* vp = vtbase + (size_t)(dt * 32 + l31) * vtT + 16 * s + 4 * lh;
      const u32x2 lo = *(const u32x2*)vp, hi = *(const u32x2*)(vp + 8);
      vf[dt * 2 + s] = mk4(lo.x, lo.y, hi.x, hi.y);
    }
  __builtin_amdgcn_sched_barrier(0);
  constexpr float SC = 0.125f * 1.4426950408889634f;
  u32x4 pf[2][2];
#pragma unroll
  for (int qt = 0; qt < 2; ++qt) {
    f32x16 S;
#pragma unroll
    for (int r = 0; r < 16; ++r) S[r] = 0.f;
#pragma unroll
    for (int ks = 0; ks < 4; ++ks) S = mfma32(kf[ks], qs[(qt * 4 + ks) * 64], S);
    float cmax = -INFINITY;
    if (band) {
      const int qc = qt * 32 + l31;
      const int cst = min(max(qc - 8, 0), 48);
#pragma unroll
      for (int r = 0; r < 16; ++r) {
        const int key = (r & 3) + 8 * (r >> 2) + 4 * lh;
        const int kc = half * 32 + key;
        const bool ok = (kc >= cst) && (kc < cst + 16);
        const int bi = ok ? (brow * 31 + kc - qc + 15) : 0;
        const float sv = S[r] * SC + rpbs[bi];
        S[r] = ok ? sv : -INFINITY;
        cmax = fmaxf(cmax, S[r]);
      }
    } else {
#pragma unroll
      for (int r = 0; r < 16; ++r) { S[r] *= SC; cmax = fmaxf(cmax, S[r]); }
    }
    cmax = fmaxf(cmax, __shfl_xor(cmax, 32));
    const float mnew = fmaxf(st.m[qt], cmax);
    const float alpha = __builtin_amdgcn_exp2f(st.m[qt] - mnew);
    const bool grew = mnew > st.m[qt];
    st.m[qt] = mnew;
    float ps = 0.f;
#pragma unroll
    for (int r = 0; r < 16; ++r) { S[r] = __builtin_amdgcn_exp2f(S[r] - mnew); ps += S[r]; }
    st.l[qt] = st.l[qt] * alpha + ps;
    if (__any(grew)) {
#pragma unroll
      for (int dt = 0; dt < 2; ++dt)
#pragma unroll
        for (int r = 0; r < 16; ++r) st.O[qt][dt][r] *= alpha;
    }
    pf[qt][0] = mk4(pk_bf16(S[0], S[1]), pk_bf16(S[2], S[3]), pk_bf16(S[4], S[5]), pk_bf16(S[6], S[7]));
    pf[qt][1] = mk4(pk_bf16(S[8], S[9]), pk_bf16(S[10], S[11]), pk_bf16(S[12], S[13]), pk_bf16(S[14], S[15]));
  }
#pragma unroll
  for (int dt = 0; dt < 2; ++dt)
#pragma unroll
    for (int s = 0; s < 2; ++s) {
      st.O[0][dt] = mfma32(vf[dt * 2 + s], pf[0][s], st.O[0][dt]);
      st.O[1][dt] = mfma32(vf[dt * 2 + s], pf[1][s], st.O[1][dt]);
    }
}

__device__ __forceinline__ void natten_phase(char* lds, const bf16_t* __restrict__ Q, const bf16_t* __restrict__ QR, const bf16_t* __restrict__ Kb,
                             const bf16_t* __restrict__ VT, bf16_t* __restrict__ G, const float* __restrict__ rpb, bf16_t* __restrict__ Zd) {
  float* rpbs = (float*)lds;
  __syncthreads();
  for (int e = threadIdx.x; e < 16 * 465; e += NTHR) rpbs[e] = rpb[e] * 1.4426950408889634f;
  __syncthreads();
  const int tidx = opaque_tid();
  const int lane = tidx & 63, l31 = lane & 31, lh = lane >> 5;
  const int gw = blockIdx.x * (NTHR / 64) + (tidx >> 6), nw = gridDim.x * (NTHR / 64);
  const bf16_t* VTC = VT + (size_t)ML * 1024;
  u32x4* qs = (u32x4*)(lds + 32768) + (tidx >> 6) * 512 + lane;
  const int xcd = blockIdx.x & 7, wx = (blockIdx.x >> 3) * (NTHR / 64) + (tidx >> 6), nwx = (gridDim.x >> 3) * (NTHR / 64);
  for (int i = wx; i < 1024 + 64; i += nwx) {
    const bool lat = i < 1024;
    int b, h, r = 0, qrow0;
    if (lat) { const int pair = xcd * 16 + (i >> 6); r = i & 63; b = pair >> 4; h = pair & 15; qrow0 = b * 4096 + r * 64; }
    else { const int it = i - 1024; const int pair = xcd * 16 + (it >> 2); const int qt64 = it & 3; b = pair >> 4; h = pair & 15; qrow0 = ML + b * 256 + qt64 * 64; }
    const int start = min(max(r - 4, 0), 56);
    const int nchunks = lat ? 24 : 8;
    AttnState st;
#pragma unroll
    for (int a = 0; a < 2; ++a) { st.m[a] = -INFINITY; st.l[a] = 0.f;
#pragma unroll
      for (int c = 0; c < 2; ++c)
#pragma unroll
        for (int rr = 0; rr < 16; ++rr) st.O[a][c][rr] = 0.f; }
#pragma unroll
    for (int qt = 0; qt < 2; ++qt)
#pragma unroll
      for (int ks = 0; ks < 4; ++ks) qs[(qt * 4 + ks) * 64] = *(const u32x4*)(Q + (size_t)(qrow0 + qt * 32 + l31) * 1024 + h * 64 + ks * 16 + 8 * lh);
    for (int j = 0; j < nchunks; ++j) {
      if (j == 8) {
#pragma unroll
        for (int qt = 0; qt < 2; ++qt)
#pragma unroll
          for (int ks = 0; ks < 4; ++ks) qs[(qt * 4 + ks) * 64] = *(const u32x4*)(QR + (size_t)(qrow0 + qt * 32 + l31) * 1024 + h * 64 + ks * 16 + 8 * lh);
      }
      const bool band = j >= 8;
      const int ii = j - 8, kr = start + (ii >> 1), half = band ? (ii & 1) : 0;
      const size_t krow = band ? (size_t)(b * 4096 + kr * 64 + half * 32) : (size_t)(ML + b * 256 + j * 32);
      const bf16_t* kbase = Kb + krow * 1024 + h * 64;
      const bf16_t* vtb = band ? VT + (size_t)(b * 16 + h) * 64 * 4096 + kr * 64 + half * 32 : VTC + (size_t)(b * 16 + h) * 64 * 256 + j * 32;
      attn_compute(st, qs, kbase, vtb, band ? 4096 : 256, rpbs, band, band ? h * 15 + (kr - r + 7) : 0, half, lane);
    }
#pragma unroll
    for (int qt = 0; qt < 2; ++qt) {
      const float lt = st.l[qt] + __shfl_xor(st.l[qt], 32);
      const float inv = 1.f / lt;
      bf16_t* grow = G + (size_t)(qrow0 + qt * 32 + l31) * 1024 + h * 64;
      u32x2 gvs[2][4];
#pragma unroll
      for (int dt = 0; dt < 2; ++dt)
#pragma unroll
        for (int q4 = 0; q4 < 4; ++q4) gvs[dt][q4] = *(const u32x2*)(grow + dt * 32 + 8 * q4 + 4 * lh);
#pragma unroll
      for (int dt = 0; dt < 2; ++dt)
#pragma unroll
        for (int q4 = 0; q4 < 4; ++q4) {
          bf16_t* gp = grow + dt * 32 + 8 * q4 + 4 * lh;
          bf16_t* zp = Zd + (gp - G);
          const u32x2 gv = gvs[dt][q4];
          u32x2 o;
          o.x = pk_bf16(st.O[qt][dt][4 * q4] * inv * bf_lo(gv.x), st.O[qt][dt][4 * q4 + 1] * inv * bf_hi(gv.x));
          o.y = pk_bf16(st.O[qt][dt][4 * q4 + 2] * inv * bf_lo(gv.y), st.O[qt][dt][4 * q4 + 3] * inv * bf_hi(gv.y));
          *(u32x2*)zp = o;
        }
    }
  }
}

namespace pg8 {
#define PG8_LAS __attribute__((address_space(3)))
typedef unsigned short bf16_t;
typedef short bf16x8 __attribute__((ext_vector_type(8)));
typedef float f32x4 __attribute__((ext_vector_type(4)));
typedef unsigned u32x4 __attribute__((ext_vector_type(4)));
constexpr int BM = 256, BK = 64, HALF = 128, HTB = HALF * BK * 2  , STAGE_BYTES = 8 * HTB, NXCD = 8, WGM = 8;

__host__ __device__ __forceinline__ int lds_byte(int r, int c) { const int st = (r >> 4) * 2 + (c >> 5), rr = r & 15, cc = c & 31, ob = rr * 64 + cc * 2; return st * 1024 + (ob ^ (((ob >> 9) & 1) << 5)); }
__host__ __device__ __forceinline__ void stage_rc(int b, int& R, int& C) { const int st = b / 1024, sb = b % 1024, swz = sb ^ (((sb >> 9) & 1) << 5); R = (st >> 1) * 16 + swz / 64; C = (st & 1) * 32 + (swz % 64) / 2; }
__host__ __device__ __forceinline__ int perm32(int rho) { const int n = rho >> 4, i = rho & 15; return 8 * (i >> 2) + 4 * n + (i & 3); }

struct Unit { int pm, pn; };
struct Gemm { const bf16_t* A; const bf16_t* Bt; int M, N, K; };

struct StaticOrder {
    int nM, nN, nwg, G, c;
    __host__ __device__ void init(int M, int N, int G_, int c_) { nM = M / BM; nN = N / BM; nwg = nM * nN; G = G_; c = c_; }
    __host__ __device__ bool next(int i, Unit& u) const {
        const long L = (long)i * G + c; if (L >= nwg) return false;
        int wgid = (int)L; { const int q = nwg / NXCD, r = nwg % NXCD, xcd = wgid % NXCD, off = wgid / NXCD; wgid = (xcd < r ? xcd * (q + 1) : r * (q + 1) + (xcd - r) * q) + off; }
        const int nig = WGM * nN, gid = wgid / nig, fm = gid * WGM, gsz = (nM - fm) < WGM ? (nM - fm) : WGM;
        u.pm = fm + ((wgid % nig) % gsz); u.pn = (wgid % nig) / gsz; return true;
    }
    __device__ __forceinline__ void a_ready(const Unit&) const {}
    __device__ __forceinline__ void done(const Unit&) const {}
};
template <class Epi, class Sched, bool STAMP = false>
__device__ __forceinline__ void gemm_phase(PG8_LAS unsigned char* lds, const Gemm g, const Sched& S, const Epi& E, unsigned long long* stamps) {
    const int tid = threadIdx.x, wid = __builtin_amdgcn_readfirstlane(tid >> 6), lane = tid & 63, wr = wid >> 2, wc = wid & 3, fr = lane & 15, fq = lane >> 4;
    const int K = g.K, nt = K / BK;
    int ts_lo = 0, ts_hi = 0, nts = 0; const unsigned long long rt_entry = STAMP ? (unsigned long long)wall_clock64() : 0ull;
#define PG8_STAMP() do { if (STAMP && wid == 0 && nts < 64) { const unsigned long long _c = (unsigned long long)clock64(); \
        ts_lo = (lane == nts) ? (int)(unsigned)_c : ts_lo; ts_hi = (lane == nts) ? (int)(unsigned)(_c >> 32) : ts_hi; ++nts; } } while (0)
    PG8_STAMP();
    unsigned voffA[2], voffB[2];
#pragma unroll
    for (int i = 0; i < 2; ++i) { int R, C; stage_rc(tid * 16 + i * 8192, R, C); const int Rb = Epi::PERM ? ((R & ~31) + perm32(R & 31)) : R;
        voffA[i] = (unsigned)(R * K + C) * 2u; voffB[i] = (unsigned)(Rb * K + C) * 2u; }
    const size_t kstep = (size_t)(BK * 2);
    const size_t hstep = (size_t)HALF * K * 2;
    const size_t tstep = 2 * hstep;
    const unsigned ldsw = (unsigned)wid * 1024u;
    const int aoff = lds_byte(wr * 64 + fr, fq * 8), boff = lds_byte(wc * 32 + fr, fq * 8);
#define PG8_SA(b, h) (((b) * 2 + (h)) * HTB)
#define PG8_SB(b, h) ((4 + (b) * 2 + (h)) * HTB)
#define PG8_STAGE(bufoff, gbase, voff) do { _Pragma("unroll") for (int _i = 0; _i < 2; ++_i) \
        __builtin_amdgcn_global_load_lds((const unsigned*)((const char*)(gbase) + (voff)[_i]), (PG8_LAS unsigned*)(lds + (bufoff) + ldsw + _i * 8192), 16, 0, 0); } while (0)
#define PG8_LDA(dst, b, h) do { _Pragma("unroll") for (int m = 0; m < 4; ++m) _Pragma("unroll") for (int k = 0; k < 2; ++k) dst[m][k] = *(const PG8_LAS bf16x8*)(lds + PG8_SA(b, h) + aoff + m * 2048 + k * 1024); } while (0)
#define PG8_LDB(dst, b, h) do { _Pragma("unroll") for (int n = 0; n < 2; ++n) _Pragma("unroll") for (int k = 0; k < 2; ++k) dst[n][k] = *(const PG8_LAS bf16x8*)(lds + PG8_SB(b, h) + boff + n * 2048 + k * 1024); } while (0)
#define PG8_MMA(ai, bj, At, Bt) do { __builtin_amdgcn_s_setprio(1); _Pragma("unroll") for (int m = 0; m < 4; ++m) _Pragma("unroll") for (int n = 0; n < 2; ++n) _Pragma("unroll") for (int k = 0; k < 2; ++k) \
        acc[ai][bj][m][n] = __builtin_amdgcn_mfma_f32_16x16x32_bf16(Bt[n][k], At[m][k], acc[ai][bj][m][n], 0, 0, 0); __builtin_amdgcn_s_setprio(0); } while (0)
#define PG8_WAIT_V(n) asm volatile("s_waitcnt vmcnt(" #n ")" ::: "memory")
#define PG8_WAIT_L(n) asm volatile("s_waitcnt lgkmcnt(" #n ")" ::: "memory")
#define PG8_BAR __builtin_amdgcn_s_barrier()
#define PG8_SCHED __builtin_amdgcn_sched_barrier(0)
    Unit cur, nxt; int ui = 0;
    if (!S.next(0, cur)) return;
    f32x4 acc[2][2][4][2];
#pragma unroll
    for (int a = 0; a < 2; ++a)
#pragma unroll
        for (int b = 0; b < 2; ++b)
#pragma unroll
            for (int m = 0; m < 4; ++m)
#pragma unroll
                for (int n = 0; n < 2; ++n) acc[a][b][m][n] = (f32x4){0.f, 0.f, 0.f, 0.f};
    bf16x8 At[4][2], B0[2][2], B1[2][2];
    const char* cA = (const char*)g.A + (size_t)cur.pm * tstep; const char* cB = (const char*)g.Bt + (size_t)cur.pn * tstep;
    S.a_ready(cur);
    PG8_STAGE(PG8_SB(0, 0), cB, voffB); PG8_STAGE(PG8_SA(0, 0), cA, voffA); PG8_STAGE(PG8_SB(0, 1), cB + hstep, voffB); PG8_STAGE(PG8_SA(0, 1), cA + hstep, voffA);
    if (wr == 1) PG8_BAR;
    PG8_WAIT_V(4); PG8_BAR;
    PG8_STAGE(PG8_SB(1, 0), cB + kstep, voffB); PG8_STAGE(PG8_SA(1, 0), cA + kstep, voffA); PG8_STAGE(PG8_SB(1, 1), cB + hstep + kstep, voffB);
    PG8_WAIT_V(6); PG8_BAR;
    PG8_STAMP();
    for (;;) {
        const bool has_next = S.next(ui + 1, nxt);
        const char* nA = has_next ? (const char*)g.A + (size_t)nxt.pm * tstep : cA; const char* nB = has_next ? (const char*)g.Bt + (size_t)nxt.pn * tstep : cB;
        for (int t = 0; t < nt; t += 2) {
            const bool last = (t == nt - 2);
            const char* a1 = cA + (size_t)(t + 1) * kstep;
            const char* a2 = last ? nA : cA + (size_t)(t + 2) * kstep; const char* b2 = last ? nB : cB + (size_t)(t + 2) * kstep;
            const char* a3 = a2 + kstep; const char* b3 = b2 + kstep;
            if (last && has_next) S.a_ready(nxt);
            PG8_LDB(B0, 0, 0); PG8_SCHED; PG8_LDA(At, 0, 0); PG8_STAGE(PG8_SA(1, 1), a1 + hstep, voffA);
            PG8_WAIT_L(8); PG8_BAR; PG8_WAIT_L(0); PG8_MMA(0, 0, At, B0); PG8_BAR; PG8_SCHED;
            PG8_LDB(B1, 0, 1); PG8_STAGE(PG8_SB(0, 0), b2, voffB);
            PG8_BAR; PG8_WAIT_L(0); PG8_MMA(0, 1, At, B1); PG8_BAR;
            PG8_LDA(At, 0, 1); PG8_STAGE(PG8_SA(0, 0), a2, voffA);
            PG8_BAR; PG8_WAIT_L(0); PG8_MMA(1, 0, At, B0); PG8_BAR; PG8_SCHED;
            PG8_STAGE(PG8_SB(0, 1), b2 + hstep, voffB);
            PG8_WAIT_V(6); PG8_BAR; PG8_MMA(1, 1, At, B1); PG8_BAR;
            PG8_LDB(B0, 1, 0); PG8_SCHED; PG8_LDA(At, 1, 0); PG8_STAGE(PG8_SA(0, 1), a2 + hstep, voffA);
            PG8_WAIT_L(8); PG8_BAR; PG8_WAIT_L(0); PG8_MMA(0, 0, At, B0); PG8_BAR; PG8_SCHED;
            PG8_LDB(B1, 1, 1); PG8_STAGE(PG8_SB(1, 0), b3, voffB);
            PG8_BAR; PG8_WAIT_L(0); PG8_MMA(0, 1, At, B1); PG8_BAR;
            PG8_LDA(At, 1, 1); PG8_STAGE(PG8_SA(1, 0), a3, voffA);
            PG8_BAR; PG8_WAIT_L(0); PG8_MMA(1, 0, At, B0); PG8_BAR; PG8_SCHED;
            PG8_STAGE(PG8_SB(1, 1), b3 + hstep, voffB);
            PG8_WAIT_V(6); PG8_BAR; PG8_MMA(1, 1, At, B1); PG8_BAR;
        }
        PG8_STAMP();
        if constexpr (!Epi::AFTER_DRAIN) { E(acc, cur, wr, wc, fr, fq); S.done(cur); }
        PG8_STAMP();
        if (!has_next) break;
#pragma unroll
        for (int a = 0; a < 2; ++a)
#pragma unroll
            for (int b = 0; b < 2; ++b)
#pragma unroll
                for (int m = 0; m < 4; ++m)
#pragma unroll
                    for (int n = 0; n < 2; ++n) acc[a][b][m][n] = (f32x4){0.f, 0.f, 0.f, 0.f};
        cur = nxt; cA = nA; cB = nB; ++ui;
    }
    PG8_WAIT_V(0);
    if (wr == 0) PG8_BAR;
    PG8_BAR;
    if constexpr (Epi::AFTER_DRAIN) { E.fused(acc, cur, wr, wc, fr, fq, lds, wid, lane); S.done(cur); }
    PG8_STAMP();
    if (STAMP && wid == 0) { stamps[lane] = lane < nts ? (((unsigned long long)(unsigned)ts_hi << 32) | (unsigned)ts_lo) : 0ull;
        if (lane == 62) stamps[62] = rt_entry; if (lane == 63) stamps[63] = (unsigned long long)wall_clock64(); }
#undef PG8_STAMP
#undef PG8_SA
#undef PG8_SB
#undef PG8_STAGE
#undef PG8_LDA
#undef PG8_LDB
#undef PG8_MMA
#undef PG8_WAIT_V
#undef PG8_WAIT_L
#undef PG8_BAR
#undef PG8_SCHED
}
}

template <class EP> struct Pg8Epi {
  static constexpr bool PERM = false, AFTER_DRAIN = false;
  EP ep;
  __device__ __forceinline__ void operator()(const pg8::f32x4 (&acc)[2][2][4][2], const pg8::Unit& u, int wr, int wc, int fr, int fq) const {
#pragma unroll
    for (int ai = 0; ai < 2; ++ai)
#pragma unroll
      for (int m = 0; m < 4; ++m)
#pragma unroll
        for (int bj = 0; bj < 2; ++bj)
#pragma unroll
          for (int n = 0; n < 2; ++n) {
            const int row = u.pm * 256 + ai * 128 + wr * 64 + m * 16 + fr;
            const int col = u.pn * 256 + bj * 128 + wc * 32 + n * 16 + fq * 4;
            ep(row, col, acc[ai][bj][m][n]);
          }
  }
};
struct Pg8EpiRes {
  static constexpr bool PERM = false, AFTER_DRAIN = false;
  EpRes ep;
  __device__ __forceinline__ void operator()(const pg8::f32x4 (&acc)[2][2][4][2], const pg8::Unit& u, int wr, int wc, int fr, int fq) const {
    const int bidx = (u.pm * 256) >> 12;
    const float* gbase = ep.modL + bidx * 3072 + 2048 + u.pn * 256 + wc * 32 + fq * 4;
    f32x4 g[2][2];
#pragma unroll
    for (int bj = 0; bj < 2; ++bj)
#pragma unroll
      for (int n = 0; n < 2; ++n) g[bj][n] = *(const f32x4*)(gbase + bj * 128 + n * 16);
#pragma unroll
    for (int ai = 0; ai < 2; ++ai)
#pragma unroll
      for (int mp = 0; mp < 2; ++mp) {
        f32x4 x[2][2][2];
        size_t roff[2];
#pragma unroll
        for (int mm = 0; mm < 2; ++mm) {
          roff[mm] = (size_t)(u.pm * 256 + ai * 128 + wr * 64 + (mp * 2 + mm) * 16 + fr) * 1024 + u.pn * 256 + wc * 32 + fq * 4;
#pragma unroll
          for (int bj = 0; bj < 2; ++bj)
#pragma unroll
            for (int n = 0; n < 2; ++n) x[mm][bj][n] = *(const f32x4*)(ep.xl_src + roff[mm] + bj * 128 + n * 16);
        }
#pragma unroll
        for (int mm = 0; mm < 2; ++mm)
#pragma unroll
          for (int bj = 0; bj < 2; ++bj)
#pragma unroll
            for (int n = 0; n < 2; ++n) *(f32x4*)(ep.xl_dst + roff[mm] + bj * 128 + n * 16) = x[mm][bj][n] + g[bj][n] * acc[ai][bj][mp * 2 + mm][n];
      }
  }
};
__device__ __forceinline__ void pg8_gemm_res(char* lds, const bf16_t* A, const bf16_t* Bt, int M, int N, int K, const EpRes ep) {
  __syncthreads();
  pg8::Gemm g{A, Bt, M, N, K};
  pg8::StaticOrder S; S.init(M, N, (int)gridDim.x, (int)blockIdx.x);
  Pg8EpiRes E{ep};
  pg8::gemm_phase<Pg8EpiRes, pg8::StaticOrder, false>((PG8_LAS unsigned char*)lds, g, S, E, nullptr);
  __syncthreads();
}
template <class EP>
__device__ __forceinline__ void pg8_gemm(char* lds, const bf16_t* A, const bf16_t* Bt, int M, int N, int K, const EP ep) {
  __syncthreads();
  pg8::Gemm g{A, Bt, M, N, K};
  pg8::StaticOrder S; S.init(M, N, (int)gridDim.x, (int)blockIdx.x);
  Pg8Epi<EP> E{ep};
  pg8::gemm_phase<Pg8Epi<EP>, pg8::StaticOrder, false>((PG8_LAS unsigned char*)lds, g, S, E, nullptr);
  __syncthreads();
}


__device__ __forceinline__ void gemm64_res_phase(char* lds, const bf16_t* __restrict__ A, int lda, const bf16_t* __restrict__ Bt, int K,
                                                 int row_base, int mtiles, const EpRes ep) {
  bf16_t* sA = (bf16_t*)lds;
  bf16_t* sB = (bf16_t*)(lds + 18432);
  const int tid = opaque_tid(), lane = tid & 63, wv = tid >> 6, wm = wv >> 2, wn = wv & 3;
  const int l31 = lane & 31, lh = lane >> 5;
  const int nk = K >> 6;
  const int ldrow = tid >> 3, ldk = (tid & 7) * 8;
  const int total = mtiles * 8;
  for (int tile = blockIdx.x; tile < total; tile += gridDim.x) {
    const int mt = tile >> 3, nt = tile & 7;
    const int m0 = row_base + mt * 64, n0 = nt * 128;
    __syncthreads();
    f32x16 acc;
#pragma unroll
    for (int r = 0; r < 16; ++r) acc[r] = 0.f;
    u32x4 ar = *(const u32x4*)(A + (size_t)(m0 + ldrow) * lda + ldk);
    u32x4 br0 = *(const u32x4*)(Bt + (size_t)(n0 + ldrow) * K + ldk), br1 = *(const u32x4*)(Bt + (size_t)(n0 + ldrow + 64) * K + ldk);
    *(u32x4*)(sA + ldrow * 72 + ldk) = ar;
    *(u32x4*)(sB + ldrow * 72 + ldk) = br0;
    *(u32x4*)(sB + (ldrow + 64) * 72 + ldk) = br1;
    __syncthreads();
    for (int kt = 0; kt < nk; ++kt) {
      const int cur = kt & 1;
      const bool more = (kt + 1) < nk;
      const int k0n = (kt + 1) * 64 + ldk;
      if (more) {
        ar = *(const u32x4*)(A + (size_t)(m0 + ldrow) * lda + k0n);
        br0 = *(const u32x4*)(Bt + (size_t)(n0 + ldrow) * K + k0n); br1 = *(const u32x4*)(Bt + (size_t)(n0 + ldrow + 64) * K + k0n);
      }
      __builtin_amdgcn_sched_barrier(0);
      const bf16_t* a_ = sA + cur * (64 * 72);
      const bf16_t* b_ = sB + cur * (128 * 72);
#pragma unroll
      for (int kk = 0; kk < 4; ++kk) {
        const u32x4 af = *(const u32x4*)(a_ + (wm * 32 + l31) * 72 + kk * 16 + lh * 8);
        const u32x4 bfr = *(const u32x4*)(b_ + (wn * 32 + l31) * 72 + kk * 16 + lh * 8);
        acc = mfma32(bfr, af, acc);
      }
      __builtin_amdgcn_sched_barrier(0);
      if (more) {
        bf16_t* an = sA + (cur ^ 1) * (64 * 72);
        bf16_t* bn = sB + (cur ^ 1) * (128 * 72);
        *(u32x4*)(an + ldrow * 72 + ldk) = ar;
        *(u32x4*)(bn + ldrow * 72 + ldk) = br0;
        *(u32x4*)(bn + (ldrow + 64) * 72 + ldk) = br1;
      }
      __syncthreads();
    }
    const int row = m0 + wm * 32 + l31;
    const size_t roff = (size_t)(row - ML) * 1024 + n0 + wn * 32 + 4 * lh;
    const float* gp = ep.modL + 8 * 3072 + 2048 + n0 + wn * 32 + 4 * lh;
    f32x4 x[4];
#pragma unroll
    for (int q = 0; q < 4; ++q) x[q] = *(const f32x4*)(ep.xc_src + roff + 8 * q);
#pragma unroll
    for (int q = 0; q < 4; ++q) {
      const f32x4 g = *(const f32x4*)(gp + 8 * q);
      const f32x4 v = {acc[4 * q], acc[4 * q + 1], acc[4 * q + 2], acc[4 * q + 3]};
      *(f32x4*)(ep.xc_dst + roff + 8 * q) = x[q] + g * v;
    }
  }
}

template <int ph>
__device__ __forceinline__ void run_phase(const Params& p, char* lds, bool last_rep) {
  char* ws = p.ws;
  const float* MOD = (const float*)(ws + OFF_MOD);
  float* XC = (float*)(ws + OFF_XC);
  bf16_t* HB = (bf16_t*)(ws + OFF_HB);
  bf16_t* A0 = (bf16_t*)(ws + OFF_A0); bf16_t* A1 = (bf16_t*)(ws + OFF_A1); bf16_t* A2 = (bf16_t*)(ws + OFF_A2);
  bf16_t* A3 = (bf16_t*)(ws + OFF_A3); bf16_t* A4 = (bf16_t*)(ws + OFF_A4);
  bf16_t* WD = (bf16_t*)(ws + OFF_WD); bf16_t* AD = (bf16_t*)(ws + OFF_AD);
  float* BON = (float*)(ws + OFF_BON);
  if (ph == 0) { phase0(p, lds); return; }
  constexpr int layer = (ph - 1) / 5, sub = (ph - 1) % 5;
  const float* modL = MOD + (size_t)layer * 9 * 3072;
  const float* xl_cur = layer == 0 ? p.in[0] : p.out;
  const float* xc_cur = layer == 0 ? p.in[2] : XC;
  if (layer == 0 || layer == 3) {
    const int ib = layer ? 33 : 4;
    const bf16_t* WIN = (const bf16_t*)(ws + (layer ? OFF_W3IN : OFF_W0IN));
    const bf16_t* WUP = (const bf16_t*)(ws + (layer ? OFF_W3UP : OFF_W0UP));
    const bf16_t* WOUT = (const bf16_t*)(ws + (layer ? OFF_W3OUT : OFF_W0OUT));
    if (sub == 0) norm_phase<true>(xl_cur, xc_cur, p.in[ib], modL, HB, A4);
    else if (sub == 1) { ALMix al{HB, A4, p.in[ib + 4]}; EpRwkvIn ep{A0, A1, A2, A3, WD, AD}; gemm256_phase(lds, WIN, 1024, MT / 256, 16, al, ep); gemm_phase(lds, WIN, 1024, MT / 256, 2, al, ep, 4096, true); }
    else if (sub == 2) rwkv_scan_phase(lds, A0, A1, A2, WD, AD, WUP, p.in[ib + 5], p.in[ib + 8], p.in[ib + 9], HB, A4, BON);
    else if (sub == 3) rwkv_post_phase(HB, A4, A2, A3, BON, p.in[ib + 10], layer == 3 ? ML : MT);
    else { ALPlain al{A3, 1024}; EpRes ep{xl_cur, xc_cur, p.out, XC, modL}; pg8_gemm_res(lds, A3, WOUT, ML, 1024, 1024, ep); if (layer != 3) gemm64_res_phase(lds, A3, 1024, WOUT, 1024, ML, MC / 64, ep); }
  } else if (layer == 1) {
    bf16_t* HS0 = (bf16_t*)(ws + OFF_HS0); bf16_t* XR = (bf16_t*)(ws + OFF_XR); bf16_t* GG = (bf16_t*)(ws + OFF_GG); bf16_t* HS1 = (bf16_t*)(ws + OFF_HS1);
    if (sub == 0) norm_phase<false>(xl_cur, xc_cur, p.in[16], modL, HB, nullptr);
    else if (sub == 1) { ALPlain al{HB, 1024}; EpLruIn ep{XR, GG}; pg8_gemm(lds, HB, (const bf16_t*)(ws + OFF_W1IN), MT, 2816, 1024, ep); }
    else if (sub == 2) rglru_phase(lds, XR, (const bf16_t*)(ws + OFF_W1G), p.in[20], p.in[21], p.in[23], p.in[24], HS0, HS1);
    else if (sub == 3) lru_z_phase(HS0, HS1, GG);
    else { ALPlain al{GG, LW}; EpRes ep{xl_cur, xc_cur, p.out, XC, modL}; pg8_gemm_res(lds, GG, (const bf16_t*)(ws + OFF_W1OUT), ML, 1024, LW, ep); gemm64_res_phase(lds, GG, LW, (const bf16_t*)(ws + OFF_W1OUT), LW, ML, MC / 64, ep); }
  } else {
    if (sub == 0) norm_phase<false>(xl_cur, xc_cur, p.in[26], modL, HB, nullptr);
    else if (sub == 1) { ALPlain al{HB, 1024}; EpNatIn ep{A0, A1, A2, A3}; pg8_gemm(lds, HB, (const bf16_t*)(ws + OFF_W2IN), MT, 4096, 1024, ep); }
    else if (sub == 2) nat_qk_phase(A0, A1, A4, p.in[30]);
    else if (sub == 3) natten_phase(lds, A0, A4, A1, A2, A3, p.in[31], last_rep ? A3 : HB);
    else { ALPlain al{A3, 1024}; EpRes ep{xl_cur, xc_cur, p.out, XC, modL}; pg8_gemm_res(lds, A3, (const bf16_t*)(ws + OFF_W2OUT), ML, 1024, 1024, ep); gemm64_res_phase(lds, A3, 1024, (const bf16_t*)(ws + OFF_W2OUT), 1024, ML, MC / 64, ep); }
  }
}

__global__ void __launch_bounds__(NTHR) mega_kernel(Params p) {
  __shared__ __attribute__((aligned(16))) char lds[LDS_BYTES];
  __shared__ u32x4 xb_words;
  cg::grid_group grid = cg::this_grid();
  if (threadIdx.x == 0) xb_words = (u32x4){0u, 0u, 0u, 0u};
  __syncthreads();
  const XcdBarrier xb = xcd_barrier_post((unsigned*)(p.ws + OFF_BAR), (volatile LAS unsigned*)&xb_words);
#define PHASE(k) if (p.ph_lo <= k && k < p.ph_hi) { for (int rep = 0; rep < REP[k]; ++rep) { run_phase<k>(p, lds, rep + 1 == REP[k]); if (rep + 1 < REP[k] || k + 1 < p.ph_hi) { if (k == 0) grid.sync(); else xcd_barrier(xb); } } }
  PHASE(0) PHASE(1) PHASE(2) PHASE(3) PHASE(4) PHASE(5) PHASE(6) PHASE(7) PHASE(8) PHASE(9) PHASE(10)
  PHASE(11) PHASE(12) PHASE(13) PHASE(14) PHASE(15) PHASE(16) PHASE(17) PHASE(18) PHASE(19) PHASE(20)
#undef PHASE
}

extern "C" void kernel_launch(void* const* d_in, const int* in_sizes, int n_in, void* d_out, int out_size, void* d_ws, size_t ws_size,
                              hipStream_t stream) {
  static int grid_blocks = 0;
  if (!grid_blocks) {
    int dev = 0, cus = 0, per_cu = 0;
    hipGetDevice(&dev);
    hipDeviceGetAttribute(&cus, hipDeviceAttributeMultiprocessorCount, dev);
    hipOccupancyMaxActiveBlocksPerMultiprocessor(&per_cu, mega_kernel, NTHR, 0);
    if (per_cu < 1) { fprintf(stderr, "occupancy query returned %d\n", per_cu); per_cu = 1; }
    if (per_cu > 1) per_cu = 1;
    grid_blocks = cus * per_cu;
    if (n_in != 45 || ws_size < WS_END) fprintf(stderr, "unexpected n_in %d / ws %zu (need %zu)\n", n_in, ws_size, (size_t)WS_END);
  }
  Params p{};
  for (int i = 0; i < 45; ++i) p.in[i] = (const float*)d_in[i];
  p.out = (float*)d_out;
  p.ws = (char*)d_ws;
  (void)hipMemsetAsync((char*)d_ws + OFF_BAR, 0, XCD_BAR_WORDS * 4, stream);
#if N_LAUNCH_MODE == 1
  p.ph_lo = 0; p.ph_hi = NPHASE;
  void* args[] = {&p};
  hipError_t e = hipLaunchCooperativeKernel((void*)mega_kernel, dim3(grid_blocks), dim3(NTHR), args, 0, stream);
  if (e != hipSuccess) fprintf(stderr, "cooperative launch failed: %s (grid %d)\n", hipGetErrorString(e), grid_blocks);
#else
  for (int ph = 0; ph < NPHASE; ++ph) {
    p.ph_lo = ph; p.ph_hi = ph + 1;
    hipLaunchKernelGGL(mega_kernel, dim3(grid_blocks), dim3(NTHR), 0, stream, p);
  }
#endif
}
```

```cpp
#include <hip/hip_runtime.h>
#include <hip/hip_cooperative_groups.h>
#include <cstdio>
#include <cstdint>
namespace cg = cooperative_groups;

#ifndef N_LAUNCH_MODE
#define N_LAUNCH_MODE 1
#endif

typedef unsigned short bf16_t;
typedef short bf16x8 __attribute__((ext_vector_type(8)));
typedef float f32x4 __attribute__((ext_vector_type(4)));
typedef float f32x16 __attribute__((ext_vector_type(16)));
typedef float f32x2 __attribute__((ext_vector_type(2)));
typedef unsigned u32x4 __attribute__((ext_vector_type(4)));
typedef unsigned u32x2 __attribute__((ext_vector_type(2)));

#define DEVI __device__ __forceinline__

constexpr int D = 1024, NB = 8, SEQ = 4096, CTX = 256;
constexpr int ML = NB * SEQ;
constexpr int MC = NB * CTX;
constexpr int MT = ML + MC;
constexpr int LW = 1408;
constexpr int NTHR = 512;
constexpr int NPHASE = 21;
constexpr int LDS_BYTES = 163840 - 16;
__device__ constexpr int REP[21] = {1,1,1,1,1,1,1,1,1,1,1,1,1,1,1,1,1,1,1,1,1};

constexpr size_t SZ_ACT = (size_t)MT * 1024 * 2;
constexpr size_t OFF_MOD = 0;
constexpr size_t OFF_BAR = 458752;
constexpr size_t OFF_W0IN = 524288;
constexpr size_t SZ_RWIN = (size_t)4352 * 1024 * 2;
constexpr size_t SZ_RWUP = (size_t)4 * 1024 * 64 * 2;
constexpr size_t SZ_SQ = (size_t)1024 * 1024 * 2;
constexpr size_t OFF_W0UP = OFF_W0IN + SZ_RWIN;
constexpr size_t OFF_W0OUT = OFF_W0UP + SZ_RWUP;
constexpr size_t OFF_W3IN = OFF_W0OUT + SZ_SQ;
constexpr size_t OFF_W3UP = OFF_W3IN + SZ_RWIN;
constexpr size_t OFF_W3OUT = OFF_W3UP + SZ_RWUP;
constexpr size_t OFF_W1IN = OFF_W3OUT + SZ_SQ;
constexpr size_t OFF_W1G = OFF_W1IN + (size_t)2816 * 1024 * 2;
constexpr size_t OFF_W1OUT = OFF_W1G + (size_t)16 * 4 * 96 * 96 * 2;
constexpr size_t OFF_W2IN = OFF_W1OUT + (size_t)1024 * 1408 * 2;
constexpr size_t OFF_W2OUT = OFF_W2IN + (size_t)4096 * 1024 * 2;
constexpr size_t OFF_XC = OFF_W2OUT + SZ_SQ;
constexpr size_t OFF_BON = OFF_XC + (size_t)MC * 1024 * 4;
constexpr size_t OFF_BIG = OFF_BON + (size_t)2 * MT * 16 * 4;
constexpr size_t OFF_HB = OFF_BIG;
constexpr size_t OFF_A0 = OFF_BIG + SZ_ACT;
constexpr size_t OFF_A1 = OFF_A0 + SZ_ACT;
constexpr size_t OFF_A2 = OFF_A1 + SZ_ACT;
constexpr size_t OFF_A3 = OFF_A2 + SZ_ACT;
constexpr size_t OFF_A4 = OFF_A3 + SZ_ACT;
constexpr size_t OFF_WD = OFF_A4 + SZ_ACT;
constexpr size_t OFF_AD = OFF_WD + (size_t)MT * 128 * 2;
constexpr size_t WS_END = OFF_AD + (size_t)MT * 128 * 2;
constexpr size_t SZ_LRU = (size_t)MT * LW * 2;
constexpr size_t OFF_HS0 = OFF_BIG;
constexpr size_t OFF_XR = OFF_BIG + SZ_LRU;
constexpr size_t OFF_GG = OFF_XR + SZ_LRU;
constexpr size_t OFF_HS1 = OFF_GG + SZ_LRU;
static_assert(OFF_HS1 + SZ_LRU <= WS_END, "lru overlay");
static_assert(WS_END <= (size_t)536870912, "ws");

struct Params {
  const float* in[45];
  float* out;
  char* ws;
  int ph_lo, ph_hi;
};

DEVI u32x4 mk4(unsigned a, unsigned b, unsigned c, unsigned d) { u32x4 r = {a, b, c, d}; return r; }
DEVI int opaque_tid() { int t = threadIdx.x; asm volatile("" : "+v"(t)); return t; }
DEVI float bf_lo(unsigned u) { return __uint_as_float(u << 16); }
DEVI float bf_hi(unsigned u) { return __uint_as_float(u & 0xffff0000u); }
DEVI float bf2f(bf16_t h) { return __uint_as_float(((unsigned)h) << 16); }
typedef __bf16 bf16x2_t __attribute__((ext_vector_type(2)));
DEVI unsigned pk_bf16(float lo, float hi) { f32x2 f = {lo, hi}; bf16x2_t v = __builtin_convertvector(f, bf16x2_t); return __builtin_bit_cast(unsigned, v); }
DEVI bf16_t f2bf(float f) { return (bf16_t)(pk_bf16(f, 0.f) & 0xffffu); }
DEVI float wave_sum(float v) {
#pragma unroll
  for (int o = 32; o; o >>= 1) v += __shfl_xor(v, o);
  return v;
}
DEVI float sigmoidf_(float x) { return __builtin_amdgcn_rcpf(1.f + __expf(-x)); }
DEVI float siluf_(float x) { return x * __builtin_amdgcn_rcpf(1.f + __expf(-x)); }
DEVI float softplusf_(float x) { return fmaxf(x, 0.f) + __logf(1.f + __expf(-fabsf(x))); }
DEVI f32x16 mfma32(u32x4 a, u32x4 b, f32x16 c) {
  return __builtin_amdgcn_mfma_f32_32x32x16_bf16(__builtin_bit_cast(bf16x8, a), __builtin_bit_cast(bf16x8, b), c, 0, 0, 0);
}
DEVI f32x4 mfma16(u32x4 a, u32x4 b, f32x4 c) {
  return __builtin_amdgcn_mfma_f32_16x16x32_bf16(__builtin_bit_cast(bf16x8, a), __builtin_bit_cast(bf16x8, b), c, 0, 0, 0);
}
template <int CTRL> DEVI float dpp_f(float v) {
  return __int_as_float(__builtin_amdgcn_update_dpp(0, __float_as_int(v), CTRL, 0xf, 0xf, true));
}
DEVI float sum8(float v) {
  v += dpp_f<0xB1>(v);
  v += dpp_f<0x4E>(v);
  v += dpp_f<0x141>(v);
  return v;
}

#define XB_TMO      128
#define XB_XCNT(j)  (256  + 64 * (j))
#define XB_XSUB(j)  (1280 + 64 * (j))
#define XB_XGEN(j)  (2304 + 64 * (j))
#define XB_TOP      3328
#define XB_TOPGEN   3392
#define XCD_BAR_WORDS 3456
#define XB_SPIN_CAP (1u << 18)
#define LAS __attribute__((address_space(3)))

__device__ __forceinline__ unsigned xb_ld(unsigned* p)              { return __hip_atomic_load(p, __ATOMIC_RELAXED, __HIP_MEMORY_SCOPE_AGENT); }
__device__ __forceinline__ unsigned xb_add(unsigned* p, unsigned v) { return __hip_atomic_fetch_add(p, v, __ATOMIC_RELAXED, __HIP_MEMORY_SCOPE_AGENT); }
__device__ __forceinline__ unsigned xb_xcc_id() { return (unsigned)__builtin_amdgcn_s_getreg((3 << 11) | 20) & 0xFu; }
#define XB_SPIN(cond, bar) do { unsigned _sp = 0; while (cond) { __builtin_amdgcn_s_sleep(1); \
    if ((++_sp & 255u) == 0u) { if (xb_ld(&(bar)[XB_TMO])) break; if (_sp > XB_SPIN_CAP) { atomicAdd(&(bar)[XB_TMO], 1u); break; } } } } while (0)

struct XcdBarrier {
    unsigned* bar; unsigned x;
    volatile LAS unsigned* st;
};

__device__ __forceinline__ XcdBarrier xcd_barrier_post(unsigned* bar, volatile LAS unsigned* st) {
    XcdBarrier b; b.bar = bar; b.x = xb_xcc_id(); b.st = st;
    if (threadIdx.x == 0) (void)xb_add(&bar[XB_XCNT(b.x)], 1u);
    return b;
}
__device__ __forceinline__ void xcd_barrier_complete(unsigned* bar, unsigned x, unsigned& nloc, unsigned& nx) {
    const unsigned G = gridDim.x * gridDim.y * gridDim.z;
    unsigned sum, cnt, mine, sp = 0u;
    for (;;) {
        sum = 0u; cnt = 0u; mine = 0u;
#pragma unroll
        for (unsigned j = 0; j < 16; ++j) { const unsigned c = xb_ld(&bar[XB_XCNT(j)]); sum += c; cnt += (c > 0u) ? 1u : 0u; mine = (j == x) ? c : mine; }
        if (sum == G) break;
        __builtin_amdgcn_s_sleep(1);
        if ((++sp & 255u) == 0u) { if (xb_ld(&bar[XB_TMO])) break; if (sp > XB_SPIN_CAP) { atomicAdd(&bar[XB_TMO], 1u); break; } }
    }
    nloc = mine > 0u ? mine : 1u; nx = cnt > 0u ? cnt : 1u;
}

__device__ __forceinline__ void xcd_barrier(const XcdBarrier& b) {
    asm volatile("s_waitcnt vmcnt(0)" ::: "memory");
    __syncthreads();
    if (threadIdx.x == 0) {
        unsigned* bar = b.bar;
        __builtin_amdgcn_s_waitcnt(0);
        unsigned nloc = b.st[0], nx = b.st[1];
        if (nloc == 0u) { xcd_barrier_complete(bar, b.x, nloc, nx); b.st[0] = nloc; b.st[1] = nx; }
        const unsigned old = xb_add(&bar[XB_XSUB(b.x)], 1u);
        const unsigned gen = old / nloc;
        if (old + 1u == (gen + 1u) * nloc) {
            __builtin_amdgcn_fence(__ATOMIC_RELEASE, "agent");
            asm volatile("s_waitcnt vmcnt(0)" ::: "memory");
            const unsigned og = xb_add(&bar[XB_TOP], 1u);
            const unsigned tg = og / nx;
            if (og + 1u == (tg + 1u) * nx) xb_add(&bar[XB_TOPGEN], 1u);
            else XB_SPIN(xb_ld(&bar[XB_TOPGEN]) == tg, bar);
            __builtin_amdgcn_fence(__ATOMIC_ACQUIRE, "agent");
            xb_add(&bar[XB_XGEN(b.x)], 1u);
            asm volatile("s_waitcnt vmcnt(0)" ::: "memory");
        } else {
            XB_SPIN(xb_ld(&bar[XB_XGEN(b.x)]) == gen, bar);
            __builtin_amdgcn_fence(__ATOMIC_ACQUIRE, "agent");
            asm volatile("s_waitcnt vmcnt(0)" ::: "memory");
        }
    }
    __syncthreads();
}


struct TJob { const float* src; int K, N; bf16_t* dst; int ldd; };

DEVI TJob get_tjob(const Params& p, int j) {
  TJob t;
  if (j < 26) {
    const int l = j / 13, jj = j % 13;
    const int ib = l ? 33 : 4;
    bf16_t* win = (bf16_t*)(p.ws + (l ? OFF_W3IN : OFF_W0IN));
    bf16_t* wup = (bf16_t*)(p.ws + (l ? OFF_W3UP : OFF_W0UP));
    bf16_t* wout = (bf16_t*)(p.ws + (l ? OFF_W3OUT : OFF_W0OUT));
    if (jj < 4) { t.src = p.in[ib + 3] + (size_t)jj * 1048576; t.K = 1024; t.N = 1024; t.dst = win + (size_t)jj * 1048576; t.ldd = 1024; }
    else if (jj < 8) { const int idx = jj - 4, d = idx >> 1, kind = idx & 1;
      t.src = p.in[ib + 6] + (size_t)idx * 65536; t.K = 1024; t.N = 64; t.dst = win + (size_t)(4096 + kind * 128 + d * 64) * 1024; t.ldd = 1024; }
    else if (jj < 12) { const int idx = jj - 8;
      t.src = p.in[ib + 7] + (size_t)idx * 65536; t.K = 64; t.N = 1024; t.dst = wup + (size_t)idx * 65536; t.ldd = 64; }
    else { t.src = p.in[ib + 11]; t.K = 1024; t.N = 1024; t.dst = wout; t.ldd = 1024; }
  } else if (j == 26) { t.src = p.in[19]; t.K = 1024; t.N = 2816; t.dst = (bf16_t*)(p.ws + OFF_W1IN); t.ldd = 1024; }
  else if (j == 27) { t.src = p.in[25]; t.K = 1408; t.N = 1024; t.dst = (bf16_t*)(p.ws + OFF_W1OUT); t.ldd = 1408; }
  else if (j == 28) { t.src = p.in[29]; t.K = 1024; t.N = 4096; t.dst = (bf16_t*)(p.ws + OFF_W2IN); t.ldd = 1024; }
  else { t.src = p.in[32]; t.K = 1024; t.N = 1024; t.dst = (bf16_t*)(p.ws + OFF_W2OUT); t.ldd = 1024; }
  return t;
}

__device__ __forceinline__ void phase0(const Params& p, char* lds) {
  const int tid = opaque_tid();
  {
    bf16_t* wg = (bf16_t*)(p.ws + OFF_W1G);
    const float* gw = p.in[22];
    const int total = 16 * 4 * 96 * 96;
    for (int e = blockIdx.x * NTHR + tid; e < total; e += gridDim.x * NTHR) {
      const int k = e % 96, n = (e / 96) % 96, dg = (e / 9216) & 3, blk = e / 36864;
      float v = 0.f;
      if (k < 88 && n < 88) v = gw[((size_t)(dg * 16 + blk) * 88 + k) * 88 + n];
      wg[e] = f2bf(v);
    }
  }
  constexpr int N_MOD_ITEMS = 96;
  constexpr int N_TILES = 5152;
  float* act = (float*)lds;
  float* red = (float*)(lds + 36864);
  float* tl = (float*)lds;
  for (int item = blockIdx.x; item < N_MOD_ITEMS; item += gridDim.x) {
    __syncthreads();
    {
      const int L = item / 24, nc = item % 24;
      const int ib = (L == 0) ? 4 : (L == 1) ? 16 : (L == 2) ? 26 : 33;
      const float* ada_w = p.in[ib + 1];
      const float* ada_b = p.in[ib + 2];
      for (int e = tid; e < 9 * 1024; e += NTHR) {
        const int i = e >> 10, k = e & 1023;
        const float c = (i < 8) ? p.in[1][i * 1024 + k] : p.in[3][k];
        act[e] = siluf_(c);
      }
      __syncthreads();
      const int kq = tid >> 7, nl = tid & 127, n = nc * 128 + nl;
      float acc[9];
#pragma unroll
      for (int i = 0; i < 9; ++i) acc[i] = 0.f;
      for (int k0 = kq * 256; k0 < kq * 256 + 256; k0 += 16) {
        float w[16];
#pragma unroll
        for (int u = 0; u < 16; ++u) w[u] = ada_w[(size_t)(k0 + u) * 3072 + n];
#pragma unroll
        for (int u = 0; u < 16; ++u)
#pragma unroll
          for (int i = 0; i < 9; ++i) acc[i] += act[i * 1024 + k0 + u] * w[u];
      }
#pragma unroll
      for (int i = 0; i < 9; ++i) red[(kq * 9 + i) * 128 + nl] = acc[i];
      __syncthreads();
      float* mod = (float*)(p.ws + OFF_MOD) + (size_t)L * 9 * 3072;
      for (int e = tid; e < 9 * 128; e += NTHR) {
        const int i = e >> 7, c = e & 127;
        const float s = red[(0 * 9 + i) * 128 + c] + red[(1 * 9 + i) * 128 + c] + red[(2 * 9 + i) * 128 + c] + red[(3 * 9 + i) * 128 + c];
        mod[i * 3072 + nc * 128 + c] = s + ada_b[nc * 128 + c];
      }
    }
  }
  {
    struct TileRef { const float* src; bf16_t* dst; int N, ldd, k0, n0; };
    auto decode = [&](int t, TileRef& r) {
      int j = 0;
      TJob job = get_tjob(p, 0);
      for (;;) {
        const int nt = (job.K >> 6) * (job.N >> 6);
        if (t < nt) break;
        t -= nt; ++j; job = get_tjob(p, j);
      }
      const int ntn = job.N >> 6;
      r.src = job.src; r.dst = job.dst; r.N = job.N; r.ldd = job.ldd; r.k0 = (t / ntn) * 64; r.n0 = (t % ntn) * 64;
    };
    const int kk = tid >> 4, n4 = (tid & 15) * 4;
    int t = (int)(gridDim.x - 1 - blockIdx.x);
    TileRef cur, nxt;
    float4 v0 = make_float4(0.f, 0.f, 0.f, 0.f), v1 = v0;
    if (t < N_TILES) {
      decode(t, cur);
      v0 = *(const float4*)(cur.src + (size_t)(cur.k0 + kk) * cur.N + cur.n0 + n4);
      v1 = *(const float4*)(cur.src + (size_t)(cur.k0 + kk + 32) * cur.N + cur.n0 + n4);
    }
    while (t < N_TILES) {
      const int tn = t + (int)gridDim.x;
      float4 w0 = v0, w1 = v1;
      if (tn < N_TILES) {
        decode(tn, nxt);
        w0 = *(const float4*)(nxt.src + (size_t)(nxt.k0 + kk) * nxt.N + nxt.n0 + n4);
        w1 = *(const float4*)(nxt.src + (size_t)(nxt.k0 + kk + 32) * nxt.N + nxt.n0 + n4);
      }
      __builtin_amdgcn_sched_barrier(0);
      __syncthreads();
      tl[kk * 65 + n4 + 0] = v0.x; tl[kk * 65 + n4 + 1] = v0.y; tl[kk * 65 + n4 + 2] = v0.z; tl[kk * 65 + n4 + 3] = v0.w;
      tl[(kk + 32) * 65 + n4 + 0] = v1.x; tl[(kk + 32) * 65 + n4 + 1] = v1.y; tl[(kk + 32) * 65 + n4 + 2] = v1.z; tl[(kk + 32) * 65 + n4 + 3] = v1.w;
      __syncthreads();
      const int n = tid >> 3, k8 = (tid & 7) * 8;
      u32x4 o;
      o.x = pk_bf16(tl[(k8 + 0) * 65 + n], tl[(k8 + 1) * 65 + n]);
      o.y = pk_bf16(tl[(k8 + 2) * 65 + n], tl[(k8 + 3) * 65 + n]);
      o.z = pk_bf16(tl[(k8 + 4) * 65 + n], tl[(k8 + 5) * 65 + n]);
      o.w = pk_bf16(tl[(k8 + 6) * 65 + n], tl[(k8 + 7) * 65 + n]);
      *(u32x4*)(cur.dst + (size_t)(cur.n0 + n) * cur.ldd + cur.k0 + k8) = o;
      v0 = w0; v1 = w1; cur = nxt; t = tn;
    }
  }
}

DEVI void norm_row(const float* __restrict__ xr, const float* __restrict__ g, const float* __restrict__ mod, int lane, float (&h)[16]) {
  float4 x[4];
  float ss = 0.f;
#pragma unroll
  for (int i = 0; i < 4; ++i) {
    x[i] = *(const float4*)(xr + lane * 4 + 256 * i);
    ss += x[i].x * x[i].x + x[i].y * x[i].y + x[i].z * x[i].z + x[i].w * x[i].w;
  }
  ss = wave_sum(ss);
  const float rstd = rsqrtf(ss * (1.f / 1024.f) + 1e-6f);
#pragma unroll
  for (int i = 0; i < 4; ++i) {
    const int c = lane * 4 + 256 * i;
    const float4 gg = *(const float4*)(g + c);
    const float4 sh = *(const float4*)(mod + c);
    const float4 sc = *(const float4*)(mod + 1024 + c);
    h[i * 4 + 0] = x[i].x * rstd * gg.x * (1.f + sc.x) + sh.x;
    h[i * 4 + 1] = x[i].y * rstd * gg.y * (1.f + sc.y) + sh.y;
    h[i * 4 + 2] = x[i].z * rstd * gg.z * (1.f + sc.z) + sh.z;
    h[i * 4 + 3] = x[i].w * rstd * gg.w * (1.f + sc.w) + sh.w;
  }
}

template <bool WITH_HS>
__device__ __forceinline__ void norm_phase(const float* __restrict__ xl, const float* __restrict__ xc, const float* __restrict__ g,
                           const float* __restrict__ modL, bf16_t* __restrict__ H, bf16_t* __restrict__ HS) {
  const int tidx = opaque_tid();
  const int lane = tidx & 63;
  const int gw = blockIdx.x * (NTHR / 64) + (tidx >> 6), nw = gridDim.x * (NTHR / 64);
  for (int row = gw; row < MT; row += nw) {
    const bool lat = row < ML;
    const float* xbase = lat ? xl + (size_t)row * 1024 : xc + (size_t)(row - ML) * 1024;
    const float* mod = modL + (lat ? (row >> 12) : 8) * 3072;
    float h[16];
    norm_row(xbase, g, mod, lane, h);
#pragma unroll
    for (int i = 0; i < 4; ++i) {
      u32x2 o; o.x = pk_bf16(h[i * 4], h[i * 4 + 1]); o.y = pk_bf16(h[i * 4 + 2], h[i * 4 + 3]);
      *(u32x2*)(H + (size_t)row * 1024 + lane * 4 + 256 * i) = o;
    }
    if (WITH_HS) {
      const int t = lat ? (row & 4095) : ((row - ML) & 255);
      const int T = lat ? 4096 : 256;
      float s[16];
#pragma unroll
      for (int i = 0; i < 16; ++i) s[i] = 0.f;
      if (t > 0) { float hp[16]; norm_row(xbase - 1024, g, mod, lane, hp);
#pragma unroll
        for (int i = 0; i < 16; ++i) s[i] += hp[i]; }
      if (t < T - 1) { float hn[16]; norm_row(xbase + 1024, g, mod, lane, hn);
#pragma unroll
        for (int i = 0; i < 16; ++i) s[i] += hn[i]; }
#pragma unroll
      for (int i = 0; i < 4; ++i) {
        u32x2 o; o.x = pk_bf16(0.5f * s[i * 4], 0.5f * s[i * 4 + 1]); o.y = pk_bf16(0.5f * s[i * 4 + 2], 0.5f * s[i * 4 + 3]);
        *(u32x2*)(HS + (size_t)row * 1024 + lane * 4 + 256 * i) = o;
      }
    }
  }
}

struct ALPlain {
  const bf16_t* A; int lda;
  typedef u32x4 Regs;
  DEVI void stage(float*, int) const {}
  DEVI void issue(Regs& r, int row, int k) const { r = *(const u32x4*)(A + (size_t)row * lda + k); }
  DEVI u32x4 finish(const Regs& r, const float*, int) const { return r; }
};
struct ALMix {
  const bf16_t* H; const bf16_t* HS; const float* mu;
  struct Regs { u32x4 h, s; };
  DEVI void stage(float* sMu, int n0) const {
    const int grp = n0 >> 10;
    const int j = grp == 0 ? 0 : grp == 1 ? 2 : grp == 2 ? 3 : grp == 3 ? 5 : (n0 - 4096) < 128 ? 1 : 4;
    for (int e = threadIdx.x; e < 1024; e += NTHR) sMu[e] = mu[j * 1024 + e];
  }
  DEVI void issue(Regs& r, int row, int k) const {
    r.h = *(const u32x4*)(H + (size_t)row * 1024 + k);
    r.s = *(const u32x4*)(HS + (size_t)row * 1024 + k);
  }
  DEVI unsigned mix2(unsigned h, unsigned s, float m0, float m1) const {
    const float h0 = bf_lo(h), h1 = bf_hi(h), s0 = bf_lo(s), s1 = bf_hi(s);
    return pk_bf16(h0 + (s0 - h0) * m0, h1 + (s1 - h1) * m1);
  }
  DEVI u32x4 finish(const Regs& r, const float* sMu, int k) const {
    const float4 ma = *(const float4*)(sMu + k), mb = *(const float4*)(sMu + k + 4);
    u32x4 o;
    o.x = mix2(r.h.x, r.s.x, ma.x, ma.y); o.y = mix2(r.h.y, r.s.y, ma.z, ma.w);
    o.z = mix2(r.h.z, r.s.z, mb.x, mb.y); o.w = mix2(r.h.w, r.s.w, mb.z, mb.w);
    return o;
  }
};

template <class AL, class EP>
__device__ __forceinline__ void gemm_phase(char* lds, const bf16_t* __restrict__ Bt, int K, int mtiles, int ntiles, const AL al, const EP ep, int n_base = 0, bool reverse = false, int mt_base = 0) {
  bf16_t* sA = (bf16_t*)lds;
  bf16_t* sB = (bf16_t*)(lds + 73728);
  float* sMu = (float*)(lds + 110592);
  const int tid = opaque_tid(), lane = tid & 63, wv = tid >> 6, wm = wv >> 1, wn = wv & 1;
  const int l31 = lane & 31, lh = lane >> 5;
  const int nk = K >> 6;
  const int ldrow = tid >> 3, ldk = (tid & 7) * 8;
  const int total = mtiles * ntiles;
  const int bid = reverse ? (int)(gridDim.x - 1 - blockIdx.x) : (int)blockIdx.x;
  const int nslots = gridDim.x >> 3, xcd = bid & 7, slot = bid >> 3;
  const int gm = 4 * ntiles;
  for (int chunk = xcd; chunk * nslots < total; chunk += 8) {
    const int tile = chunk * nslots + slot;
    if (tile >= total) break;
    const int grp = tile / gm, rem = tile - grp * gm;
    const int mt = grp * 4 + (rem & 3), nt = rem >> 2;
    const int m0 = (mt_base + mt) * 256, n0 = n_base + nt * 128;
    __syncthreads();
    al.stage(sMu, n0);
    f32x16 acc[2][2];
#pragma unroll
    for (int a = 0; a < 2; ++a)
#pragma unroll
      for (int b = 0; b < 2; ++b)
#pragma unroll
        for (int r = 0; r < 16; ++r) acc[a][b][r] = 0.f;
    typename AL::Regs ar[4];
    u32x4 br[2];
#pragma unroll
    for (int i = 0; i < 4; ++i) al.issue(ar[i], m0 + ldrow + 64 * i, ldk);
#pragma unroll
    for (int i = 0; i < 2; ++i) br[i] = *(const u32x4*)(Bt + (size_t)(n0 + ldrow + 64 * i) * K + ldk);
    __syncthreads();
#pragma unroll
    for (int i = 0; i < 4; ++i) *(u32x4*)(sA + (ldrow + 64 * i) * 72 + ldk) = al.finish(ar[i], sMu, ldk);
#pragma unroll
    for (int i = 0; i < 2; ++i) *(u32x4*)(sB + (ldrow + 64 * i) * 72 + ldk) = br[i];
    __syncthreads();
    for (int kt = 0; kt < nk; ++kt) {
      const int cur = kt & 1;
      const bool more = (kt + 1) < nk;
      const int k0n = (kt + 1) * 64 + ldk;
      if (more) {
#pragma unroll
        for (int i = 0; i < 4; ++i) al.issue(ar[i], m0 + ldrow + 64 * i, k0n);
#pragma unroll
        for (int i = 0; i < 2; ++i) br[i] = *(const u32x4*)(Bt + (size_t)(n0 + ldrow + 64 * i) * K + k0n);
      }
      __builtin_amdgcn_sched_barrier(0);
      const bf16_t* a_ = sA + cur * (256 * 72);
      const bf16_t* b_ = sB + cur * (128 * 72);
#pragma unroll
      for (int kk = 0; kk < 4; ++kk) {
        u32x4 af[2], bfr[2];
#pragma unroll
        for (int mi = 0; mi < 2; ++mi) af[mi] = *(const u32x4*)(a_ + (wm * 64 + mi * 32 + l31) * 72 + kk * 16 + lh * 8);
#pragma unroll
        for (int ni = 0; ni < 2; ++ni) bfr[ni] = *(const u32x4*)(b_ + (wn * 64 + ni * 32 + l31) * 72 + kk * 16 + lh * 8);
#pragma unroll
        for (int mi = 0; mi < 2; ++mi)
#pragma unroll
          for (int ni = 0; ni < 2; ++ni) acc[mi][ni] = mfma32(bfr[ni], af[mi], acc[mi][ni]);
      }
      __builtin_amdgcn_sched_barrier(0);
      if (more) {
        bf16_t* an = sA + (cur ^ 1) * (256 * 72);
        bf16_t* bn = sB + (cur ^ 1) * (128 * 72);
#pragma unroll
        for (int i = 0; i < 4; ++i) *(u32x4*)(an + (ldrow + 64 * i) * 72 + ldk) = al.finish(ar[i], sMu, k0n);
#pragma unroll
        for (int i = 0; i < 2; ++i) *(u32x4*)(bn + (ldrow + 64 * i) * 72 + ldk) = br[i];
      }
      __syncthreads();
    }
#pragma unroll
    for (int mi = 0; mi < 2; ++mi)
#pragma unroll
      for (int ni = 0; ni < 2; ++ni)
#pragma unroll
        for (int q = 0; q < 4; ++q) {
          const int row = m0 + wm * 64 + mi * 32 + l31;
          const int col = n0 + wn * 64 + ni * 32 + 8 * q + 4 * lh;
          f32x4 v = {acc[mi][ni][4 * q], acc[mi][ni][4 * q + 1], acc[mi][ni][4 * q + 2], acc[mi][ni][4 * q + 3]};
          ep(row, col, v);
        }
  }
}


template <class AL, class EP>
__device__ __forceinline__ void gemm256_phase(char* lds, const bf16_t* __restrict__ Bt, int K, int mtiles, int ntiles, const AL al, const EP ep) {
  bf16_t* sA = (bf16_t*)lds;
  bf16_t* sB = (bf16_t*)(lds + 73728);
  float* sMu = (float*)(lds + 147456);
  const int tid = opaque_tid(), lane = tid & 63, wv = tid >> 6, wm = wv >> 1, wn = wv & 1;
  const int l31 = lane & 31, lh = lane >> 5;
  const int nk = K >> 6;
  const int ldrow = tid >> 3, ldk = (tid & 7) * 8;
  const int total = mtiles * ntiles;
  const int nslots = gridDim.x >> 3, xcd = blockIdx.x & 7, slot = blockIdx.x >> 3;
  const int gm = 4 * ntiles;
  for (int chunk = xcd; chunk * nslots < total; chunk += 8) {
    const int tile = chunk * nslots + slot;
    if (tile >= total) break;
    const int grp = tile / gm, rem = tile - grp * gm;
    const int mt = grp * 4 + (rem & 3), nt = rem >> 2;
    const int m0 = mt * 256, n0 = nt * 256;
    __syncthreads();
    al.stage(sMu, n0);
    f32x16 acc[2][4];
#pragma unroll
    for (int a = 0; a < 2; ++a)
#pragma unroll
      for (int b = 0; b < 4; ++b)
#pragma unroll
        for (int r = 0; r < 16; ++r) acc[a][b][r] = 0.f;
    typename AL::Regs ar[4];
    u32x4 br[4];
#pragma unroll
    for (int i = 0; i < 4; ++i) al.issue(ar[i], m0 + ldrow + 64 * i, ldk);
#pragma unroll
    for (int i = 0; i < 4; ++i) br[i] = *(const u32x4*)(Bt + (size_t)(n0 + ldrow + 64 * i) * K + ldk);
    __syncthreads();
#pragma unroll
    for (int i = 0; i < 4; ++i) *(u32x4*)(sA + (ldrow + 64 * i) * 72 + ldk) = al.finish(ar[i], sMu, ldk);
#pragma unroll
    for (int i = 0; i < 4; ++i) *(u32x4*)(sB + (ldrow + 64 * i) * 72 + ldk) = br[i];
    __syncthreads();
    const int half = __builtin_amdgcn_readfirstlane(wv >> 2);
    if (half == 1 && nk > 1) {
#pragma unroll
      for (int i = 0; i < 4; ++i) al.issue(ar[i], m0 + ldrow + 64 * i, 64 + ldk);
#pragma unroll
      for (int i = 0; i < 4; ++i) br[i] = *(const u32x4*)(Bt + (size_t)(n0 + ldrow + 64 * i) * K + 64 + ldk);
    }
    for (int step = 0; step < 2 * nk; ++step) {
      const int kc = step >> 1;
      if ((step & 1) == half) {
        const int kl = kc + 1 + half;
        if (kl < nk) {
          const int k0n = kl * 64 + ldk;
#pragma unroll
          for (int i = 0; i < 4; ++i) al.issue(ar[i], m0 + ldrow + 64 * i, k0n);
#pragma unroll
          for (int i = 0; i < 4; ++i) br[i] = *(const u32x4*)(Bt + (size_t)(n0 + ldrow + 64 * i) * K + k0n);
        }
        __builtin_amdgcn_sched_barrier(0);
        const bf16_t* a_ = sA + (kc & 1) * (256 * 72);
        const bf16_t* b_ = sB + (kc & 1) * (256 * 72);
#pragma unroll
        for (int kk = 0; kk < 4; ++kk) {
          u32x4 af[2];
#pragma unroll
          for (int mi = 0; mi < 2; ++mi) af[mi] = *(const u32x4*)(a_ + (wm * 64 + mi * 32 + l31) * 72 + kk * 16 + lh * 8);
#pragma unroll
          for (int ni = 0; ni < 4; ++ni) {
            const u32x4 bfr = *(const u32x4*)(b_ + (wn * 128 + ni * 32 + l31) * 72 + kk * 16 + lh * 8);
#pragma unroll
            for (int mi = 0; mi < 2; ++mi) acc[mi][ni] = mfma32(bfr, af[mi], acc[mi][ni]);
          }
        }
        __builtin_amdgcn_sched_barrier(0);
      } else {
        const int kf = kc + 1;
        if (kf < nk) {
          bf16_t* an = sA + (kf & 1) * (256 * 72);
          bf16_t* bn = sB + (kf & 1) * (256 * 72);
          const int k0n = kf * 64 + ldk;
#pragma unroll
          for (int i = 0; i < 4; ++i) *(u32x4*)(an + (ldrow + 64 * i) * 72 + ldk) = al.finish(ar[i], sMu, k0n);
#pragma unroll
          for (int i = 0; i < 4; ++i) *(u32x4*)(bn + (ldrow + 64 * i) * 72 + ldk) = br[i];
        }
      }
      __syncthreads();
    }
    if constexpr (EP::VIA_LDS) {
      float* reg = (float*)(lds + wv * 16896);
#pragma unroll
      for (int mi = 0; mi < 2; ++mi) {
#pragma unroll
        for (int ni = 0; ni < 4; ++ni)
#pragma unroll
          for (int q = 0; q < 4; ++q) {
            f32x4 v = {acc[mi][ni][4 * q], acc[mi][ni][4 * q + 1], acc[mi][ni][4 * q + 2], acc[mi][ni][4 * q + 3]};
            *(f32x4*)(reg + l31 * 132 + ni * 32 + 8 * q + 4 * lh) = v;
          }
#pragma unroll 4
        for (int it = 0; it < 16; ++it) {
          const int rl = it * 2 + lh;
          const f32x4 v = *(const f32x4*)(reg + rl * 132 + l31 * 4);
          ep(m0 + wm * 64 + mi * 32 + rl, n0 + wn * 128 + l31 * 4, v);
        }
      }
    } else
#pragma unroll
    for (int mi = 0; mi < 2; ++mi)
#pragma unroll
      for (int ni = 0; ni < 4; ++ni) {
#pragma unroll
        for (int q = 0; q < 4; ++q) {
          const int row = m0 + wm * 64 + mi * 32 + l31;
          const int col = n0 + wn * 128 + ni * 32 + 8 * q + 4 * lh;
          f32x4 v = {acc[mi][ni][4 * q], acc[mi][ni][4 * q + 1], acc[mi][ni][4 * q + 2], acc[mi][ni][4 * q + 3]};
          ep(row, col, v);
        }
        __builtin_amdgcn_sched_barrier(0);
      }
  }
}

DEVI void st_bf16x4(bf16_t* p, f32x4 v) { u32x2 o; o.x = pk_bf16(v[0], v[1]); o.y = pk_bf16(v[2], v[3]); *(u32x2*)p = o; }

struct EpRwkvIn {
  static constexpr bool VIA_LDS = false;
  bf16_t *R, *K, *V, *G, *WD, *AD;
  DEVI void operator()(int row, int col, f32x4 v) const {
    const int grp = col >> 10;
    if (grp < 4) {
      const int c = col & 1023;
      bf16_t* dst = grp == 0 ? R : grp == 1 ? K : grp == 2 ? V : G;
      if (grp == 3) { v[0] = siluf_(v[0]); v[1] = siluf_(v[1]); v[2] = siluf_(v[2]); v[3] = siluf_(v[3]); }
      st_bf16x4(dst + (size_t)row * 1024 + c, v);
    } else {
      const int c = col - 4096;
      if (c < 128) {
#pragma unroll
        for (int i = 0; i < 4; ++i) { const float t = __expf(2.f * v[i]); v[i] = 1.f - 2.f / (t + 1.f); }
        st_bf16x4(WD + (size_t)row * 128 + c, v);
      } else st_bf16x4(AD + (size_t)row * 128 + (c - 128), v);
    }
  }
};
struct EpRes {
  static constexpr bool VIA_LDS = false;
  const float* xl_src; const float* xc_src; float* xl_dst; float* xc_dst; const float* modL;
  DEVI void operator()(int row, int col, f32x4 v) const {
    const bool lat = row < ML;
    const size_t off = lat ? (size_t)row * 1024 + col : (size_t)(row - ML) * 1024 + col;
    const float* src = (lat ? xl_src : xc_src) + off;
    float* dst = (lat ? xl_dst : xc_dst) + off;
    const f32x4 g = *(const f32x4*)(modL + (lat ? (row >> 12) : 8) * 3072 + 2048 + col);
    f32x4 x = *(const f32x4*)src;
    x += g * v;
    *(f32x4*)dst = x;
  }
};
struct EpLruIn {
  static constexpr bool VIA_LDS = false;
  bf16_t *XR, *GG;
  DEVI void operator()(int row, int col, f32x4 v) const {
    if (col < LW) st_bf16x4(XR + (size_t)row * LW + col, v);
    else { v[0] = siluf_(v[0]); v[1] = siluf_(v[1]); v[2] = siluf_(v[2]); v[3] = siluf_(v[3]); st_bf16x4(GG + (size_t)row * LW + (col - LW), v); }
  }
};
struct EpNatIn {
  static constexpr bool VIA_LDS = false;
  bf16_t *Q, *K, *VT, *G;
  DEVI void operator()(int row, int col, f32x4 v) const {
    const int grp = col >> 10, c = col & 1023;
    if (grp == 0) st_bf16x4(Q + (size_t)row * 1024 + c, v);
    else if (grp == 1) st_bf16x4(K + (size_t)row * 1024 + c, v);
    else if (grp == 3) { v[0] = siluf_(v[0]); v[1] = siluf_(v[1]); v[2] = siluf_(v[2]); v[3] = siluf_(v[3]); st_bf16x4(G + (size_t)row * 1024 + c, v); }
    else {
      unsigned idx, T;
      if (row < ML) { const unsigned b = row >> 12, t = row & 4095; T = 4096u; idx = ((b * 1024u + (unsigned)c) << 12) + t; }
      else { const unsigned r2 = row - ML; const unsigned b = r2 >> 8, t = r2 & 255; T = 256u; idx = (unsigned)ML * 1024u + ((b * 1024u + (unsigned)c) << 8) + t; }
#pragma unroll
      for (int i = 0; i < 4; ++i) VT[idx + (unsigned)i * T] = f2bf(v[i]);
    }
  }
};

DEVI int rwkv_row(int b, int d, int s) {
  if (s < 256) return ML + b * 256 + (d ? 255 - s : s);
  const int t = s - 256;
  return b * 4096 + (d ? 4095 - t : t);
}

constexpr int PSTR = 456, PREC_Y = 64, PREC_V0 = 192, PREC_V1 = 256, PREC_SC = 320, PREC_BF = 328;
constexpr int TSTR = 388;
struct ScanRec { u32x4 a1, a2; float v0, v1; f32x4 s0, s1; f32x4 ww[4]; u32x2 y[4]; };
DEVI void scan_load(ScanRec& R, const float* rec, int g, int c16, int role_off, int srow) {
  const char* ab = (const char*)(rec + PREC_BF) + role_off + g * 16;
  R.a1 = *(const u32x4*)ab; R.a2 = *(const u32x4*)(ab + 64);
  R.v0 = rec[PREC_V0 + srow]; R.v1 = rec[PREC_V1 + srow];
  R.s0 = *(const f32x4*)(rec + PREC_SC); R.s1 = *(const f32x4*)(rec + PREC_SC + 4);
#pragma unroll
  for (int nt = 0; nt < 4; ++nt) {
    R.ww[nt] = *(const f32x4*)(rec + 16 * nt + 4 * g);
    R.y[nt] = *(const u32x2*)((const char*)(rec + PREC_Y) + (16 * nt + c16) * 8);
  }
}
DEVI void scan_step2(f32x4 (&S)[4], const ScanRec& R, bool g0, float* yout) {
  const u32x4 b1 = mk4(pk_bf16(S[0][0], S[0][1]), pk_bf16(S[0][2], S[0][3]), pk_bf16(S[1][0], S[1][1]), pk_bf16(S[1][2], S[1][3]));
  const u32x4 b2 = mk4(pk_bf16(S[2][0], S[2][1]), pk_bf16(S[2][2], S[2][3]), pk_bf16(S[3][0], S[3][1]), pk_bf16(S[3][2], S[3][3]));
  f32x4 D = {0.f, 0.f, 0.f, 0.f};
  D = mfma16(R.a1, b1, D);
  D = mfma16(R.a2, b2, D);
  const float v0 = R.v0, v1 = R.v1;
  const float sa0 = D[0];
  const float sa1 = D[2] + sa0 * R.s0[2] + v0 * R.s0[3];
  const unsigned x0 = pk_bf16(sa0, v0), x1 = pk_bf16(sa1, v1);
  const u32x4 xb = mk4(g0 ? x0 : 0u, g0 ? x1 : 0u, 0u, 0u);
#pragma unroll
  for (int nt = 0; nt < 4; ++nt) S[nt] = mfma16(mk4(R.y[nt].x, R.y[nt].y, 0u, 0u), xb, S[nt] * R.ww[nt]);
  yout[0] = D[1] + sa0 * R.s0[0] + v0 * R.s0[1];
  yout[256] = D[3] + sa0 * R.s1[0] + v0 * R.s1[1] + sa1 * R.s1[2] + v1 * R.s1[3];
}
DEVI float sum16(float v) { v = sum8(v); v += dpp_f<0x140>(v); return v; }

__device__ __forceinline__ void rwkv_scan_phase(char* lds, const bf16_t* __restrict__ R, const bf16_t* __restrict__ Kb, const bf16_t* __restrict__ V,
                                const bf16_t* __restrict__ WD, const bf16_t* __restrict__ AD, const bf16_t* __restrict__ Wup,
                                const float* __restrict__ b0, const float* __restrict__ k_ka, const float* __restrict__ r_k,
                                bf16_t* __restrict__ Y0, bf16_t* __restrict__ Y1, float* __restrict__ BON) {
  float* stepbuf = (float*)lds;
  float* tokbuf = stepbuf + 2 * 8 * PSTR;
  float* wabuf = tokbuf + 2 * 16 * TSTR;
  float* ybuf = wabuf + 4096;
  const int tid = opaque_tid(), lane = tid & 63, wv = tid >> 6;
  constexpr int NCH = (256 + 4096) / 16;
  for (int chain = blockIdx.x; chain < 256; chain += gridDim.x) {
    const int d = chain & 1, h = (chain >> 1) & 15, b = chain >> 5;
    __syncthreads();
    if (wv < 4) {
      const int kq = lane >> 4, c16 = lane & 15, srow = wv * 16 + c16;
      const int role_off = (lane & 3) * 128;
      const bool g0 = kq == 0;
      f32x4 S[4];
#pragma unroll
      for (int j = 0; j < 4; ++j) S[j] = (f32x4){0.f, 0.f, 0.f, 0.f};
      __syncthreads();
      __syncthreads();
      __syncthreads();
      for (int c = 0; c < NCH; ++c) {
        const float* sb = stepbuf + (c & 1) * 8 * PSTR;
        float* yb = ybuf + (c & 1) * 4096 + kq * 64 + srow;
        ScanRec ra, rb;
        scan_load(ra, sb, kq, c16, role_off, srow);
#pragma unroll
        for (int i = 0; i < 4; i += 2) {
          scan_load(rb, sb + (i + 1) * PSTR, kq, c16, role_off, srow);
          scan_step2(S, ra, g0, yb + i * 512);
          scan_load(ra, sb + (i + 2) * PSTR, kq, c16, role_off, srow);
          scan_step2(S, rb, g0, yb + (i + 1) * 512);
        }
#pragma unroll
        for (int i = 4; i < 8; i += 2) {
          scan_load(rb, sb + (i + 1) * PSTR, kq, c16, role_off, srow);
          scan_step2(S, ra, g0, yb + i * 512);
          if (i + 2 < 8) scan_load(ra, sb + (i + 2) * PSTR, kq, c16, role_off, srow);
          scan_step2(S, rb, g0, yb + (i + 1) * 512);
        }
        __syncthreads();
      }
    } else {
      const int ptid = tid - 256, pw = wv - 4;
      bf16_t* Y = d ? Y1 : Y0;
      const int ncol = h * 64 + pw * 16 + (lane & 15);
      u32x4 bu[2][2];
      float bias_u[2];
#pragma unroll
      for (int kind = 0; kind < 2; ++kind) {
        const bf16_t* wu = Wup + ((size_t)(d * 2 + kind) * 1024 + ncol) * 64 + 8 * (lane >> 4);
        bu[kind][0] = *(const u32x4*)wu; bu[kind][1] = *(const u32x4*)(wu + 32);
        bias_u[kind] = b0[(d * 2 + kind) * 1024 + ncol];
      }
      const int ti = ptid >> 4, dq = ptid & 15;
      const int hc = h * 64 + 4 * dq;
      const f32x4 kkv = *(const f32x4*)(k_ka + hc), kav = *(const f32x4*)(k_ka + 1024 + hc), rkv = *(const f32x4*)(r_k + hc);
      u32x4 xw0, xw1, xa0, xa1; u32x2 rr, kr, vr;
      auto issueL = [&](int c) {
        const int rowA = rwkv_row(b, d, c * 16 + (lane & 15));
        const bf16_t* xp = WD + (size_t)rowA * 128 + d * 64 + 8 * (lane >> 4);
        const bf16_t* xq = AD + (size_t)rowA * 128 + d * 64 + 8 * (lane >> 4);
        xw0 = *(const u32x4*)xp; xw1 = *(const u32x4*)(xp + 32);
        xa0 = *(const u32x4*)xq; xa1 = *(const u32x4*)(xq + 32);
      };
      auto issueT = [&](int c) {
        const int rowB = rwkv_row(b, d, c * 16 + ti);
        rr = *(const u32x2*)(R + (size_t)rowB * 1024 + hc);
        kr = *(const u32x2*)(Kb + (size_t)rowB * 1024 + hc);
        vr = *(const u32x2*)(V + (size_t)rowB * 1024 + hc);
      };
      auto stepA = [&](int c) {
        float* wbuf = wabuf + (c & 1) * 2048; float* abuf = wbuf + 1024;
        f32x4 accw = {0.f, 0.f, 0.f, 0.f}, acca = {0.f, 0.f, 0.f, 0.f};
        accw = mfma16(xw0, bu[0][0], accw); accw = mfma16(xw1, bu[0][1], accw);
        acca = mfma16(xa0, bu[1][0], acca); acca = mfma16(xa1, bu[1][1], acca);
#pragma unroll
        for (int r = 0; r < 4; ++r) {
          const int o = ((lane >> 4) * 4 + r) * 64 + pw * 16 + (lane & 15);
          const float x = -(accw[r] + bias_u[0]);
          const float sp = fmaxf(x, 0.f) + 0.6931471805599453f * __builtin_amdgcn_logf(1.f + __builtin_amdgcn_exp2f(-1.4426950408889634f * fabsf(x)));
          const float ew = __builtin_amdgcn_exp2f(-1.4426950408889634f * (sp + 0.5f));
          wbuf[o] = __builtin_amdgcn_exp2f(-1.4426950408889634f * ew);
          abuf[o] = __builtin_amdgcn_rcpf(1.f + __builtin_amdgcn_exp2f(-1.4426950408889634f * (acca[r] + bias_u[1])));
        }
      };
      auto stepB1 = [&](int c) {
        const float rv[4] = {bf_lo(rr.x), bf_hi(rr.x), bf_lo(rr.y), bf_hi(rr.y)};
        const float kv[4] = {bf_lo(kr.x), bf_hi(kr.x), bf_lo(kr.y), bf_hi(kr.y)};
        const float vv[4] = {bf_lo(vr.x), bf_hi(vr.x), bf_lo(vr.y), bf_hi(vr.y)};
        const float* wbuf = wabuf + (c & 1) * 2048; const float* abuf = wbuf + 1024;
        const f32x4 av = *(const f32x4*)(abuf + ti * 64 + 4 * dq), wv4 = *(const f32x4*)(wbuf + ti * 64 + 4 * dq);
        float q[4], ss = 0.f;
#pragma unroll
        for (int i = 0; i < 4; ++i) { q[i] = kv[i] * kkv[i]; ss += q[i] * q[i]; }
        ss = sum16(ss);
        const float inv = __builtin_amdgcn_rsqf(fmaxf(ss, 1e-24f));
        f32x4 nk, wrr, ka, kd, vo;
        float c1 = 0.f, c2 = 0.f, bn = 0.f;
#pragma unroll
        for (int i = 0; i < 4; ++i) {
          const float n = q[i] * inv;
          kd[i] = kv[i] * (1.f + (av[i] - 1.f) * kav[i]);
          ka[i] = n * av[i];
          nk[i] = -n; wrr[i] = wv4[i] * rv[i]; vo[i] = vv[i];
          c1 += ka[i] * rv[i]; c2 += kd[i] * rv[i]; bn += rv[i] * kd[i] * rkv[i];
        }
        c1 = sum16(c1); c2 = sum16(c2); bn = sum16(bn);
        float* rec = tokbuf + ((c & 1) * 16 + ti) * TSTR;
        *(f32x4*)(rec + 4 * dq) = nk;
        *(f32x4*)(rec + 64 + 4 * dq) = wrr;
        *(f32x4*)(rec + 128 + 4 * dq) = wv4;
        *(f32x4*)(rec + 192 + 4 * dq) = ka;
        *(f32x4*)(rec + 256 + 4 * dq) = kd;
        *(f32x4*)(rec + 320 + 4 * dq) = vo;
        if (dq == 0) {
          *(f32x2*)(rec + 384) = (f32x2){c1, c2};
          BON[((size_t)d * MT + rwkv_row(b, d, c * 16 + ti)) * 16 + h] = bn;
        }
      };
      auto stepB2 = [&](int c) {
        const int pp = ptid >> 5, dp = ptid & 31;
        const float* t0 = tokbuf + ((c & 1) * 16 + 2 * pp) * TSTR + 2 * dp;
        const float* t1 = t0 + TSTR;
        const f32x2 a0 = *(const f32x2*)(t0), wr0 = *(const f32x2*)(t0 + 64), w0 = *(const f32x2*)(t0 + 128);
        const f32x2 b0_ = *(const f32x2*)(t0 + 192), k0_ = *(const f32x2*)(t0 + 256), v0 = *(const f32x2*)(t0 + 320);
        const f32x2 a1 = *(const f32x2*)(t1), wr1 = *(const f32x2*)(t1 + 64), w1 = *(const f32x2*)(t1 + 128);
        const f32x2 b1_ = *(const f32x2*)(t1 + 192), k1_ = *(const f32x2*)(t1 + 256), v1 = *(const f32x2*)(t1 + 320);
        float c3 = b0_[0] * a1[0] + b0_[1] * a1[1], c4 = k0_[0] * a1[0] + k0_[1] * a1[1];
        float c5 = b0_[0] * wr1[0] + b0_[1] * wr1[1], c6 = k0_[0] * wr1[0] + k0_[1] * wr1[1];
        c3 = sum16(c3); c4 = sum16(c4); c5 = sum16(c5); c6 = sum16(c6);
        c3 += __shfl_xor(c3, 16); c4 += __shfl_xor(c4, 16); c5 += __shfl_xor(c5, 16); c6 += __shfl_xor(c6, 16);
        float* rec = stepbuf + ((c & 1) * 8 + pp) * PSTR;
        *(f32x2*)(rec + 2 * dp) = w0 * w1;
        {
          const f32x2 bw = b0_ * w1, kw = k0_ * w1;
          *(u32x4*)((char*)(rec + PREC_Y) + 16 * dp) = mk4(pk_bf16(bw[0], kw[0]), pk_bf16(b1_[0], k1_[0]), pk_bf16(bw[1], kw[1]), pk_bf16(b1_[1], k1_[1]));
        }
        *(f32x2*)(rec + PREC_V0 + 2 * dp) = v0;
        *(f32x2*)(rec + PREC_V1 + 2 * dp) = v1;
        unsigned* bb = (unsigned*)(rec + PREC_BF);
        const f32x2 wa = w0 * a1, wwr = w0 * wr1;
        const int kk = (2 * dp) & 31;
        const int pos = ((2 * dp) & 32) + (kk < 16 ? 8 * (kk >> 2) + (kk & 3) : 8 * ((kk - 16) >> 2) + 4 + (kk & 3));
        const int pu = pos >> 1;
        bb[pu] = pk_bf16(a0[0], a0[1]);
        bb[32 + pu] = pk_bf16(wr0[0], wr0[1]);
        bb[64 + pu] = pk_bf16(wa[0], wa[1]);
        bb[96 + pu] = pk_bf16(wwr[0], wwr[1]);
        if (dp == 0) {
          const f32x2 cc0 = *(const f32x2*)(t0 + 384), cc1 = *(const f32x2*)(t1 + 384);
          *(f32x4*)(rec + PREC_SC) = (f32x4){cc0[0], cc0[1], c3, c4};
          *(f32x4*)(rec + PREC_SC + 4) = (f32x4){c5, c6, cc1[0], cc1[1]};
        }
      };
      auto storeY = [&](int c) {
        const f32x4 yv = *(const f32x4*)(ybuf + (c & 1) * 4096 + ti * 256 + 4 * dq);
        u32x2 o; o.x = pk_bf16(yv[0], yv[1]); o.y = pk_bf16(yv[2], yv[3]);
        *(u32x2*)(Y + (size_t)rwkv_row(b, d, c * 16 + ti) * 1024 + hc) = o;
      };
      issueL(0); issueT(0);
      stepA(0);
      issueL(1);
      __syncthreads();
      stepB1(0); issueT(1);
      stepA(1); issueL(2);
      __syncthreads();
      stepB2(0);
      stepB1(1); issueT(2);
      stepA(2); issueL(3);
      __builtin_amdgcn_sched_barrier(0);
      __syncthreads();
      __builtin_amdgcn_sched_barrier(0);
      for (int c = 0; c < NCH; ++c) {
        if (c + 3 < NCH) stepA(c + 3);
        if (c + 4 < NCH) issueL(c + 4);
        if (c + 2 < NCH) stepB1(c + 2);
        if (c + 3 < NCH) issueT(c + 3);
        if (c + 1 < NCH) stepB2(c + 1);
        if (c >= 1) storeY(c - 1);
        __builtin_amdgcn_sched_barrier(0);
        __syncthreads();
        __builtin_amdgcn_sched_barrier(0);
      }
      storeY(NCH - 1);
    }
  }
}

__device__ __forceinline__ void rwkv_post_phase(const bf16_t* __restrict__ Y0, const bf16_t* __restrict__ Y1, const bf16_t* __restrict__ V,
                                bf16_t* __restrict__ G, const float* __restrict__ BON, const float* __restrict__ gn, int nrows) {
  const int tidx = opaque_tid();
  const int lane = tidx & 63;
  const int gw = blockIdx.x * (NTHR / 64) + (tidx >> 6), nw = gridDim.x * (NTHR / 64);
  const int head = lane >> 2, c0 = lane * 16;
  for (int row = gw; row < nrows; row += nw) {
    const size_t off = (size_t)row * 1024 + c0;
    float y[16], v[16], g[16];
#pragma unroll
    for (int i = 0; i < 2; ++i) {
      const u32x4 a0 = *(const u32x4*)(Y0 + off + 8 * i), a1 = *(const u32x4*)(Y1 + off + 8 * i);
      const u32x4 av = *(const u32x4*)(V + off + 8 * i), ag = *(const u32x4*)(G + off + 8 * i);
      y[8 * i + 0] = bf_lo(a0.x) + bf_lo(a1.x); y[8 * i + 1] = bf_hi(a0.x) + bf_hi(a1.x);
      y[8 * i + 2] = bf_lo(a0.y) + bf_lo(a1.y); y[8 * i + 3] = bf_hi(a0.y) + bf_hi(a1.y);
      y[8 * i + 4] = bf_lo(a0.z) + bf_lo(a1.z); y[8 * i + 5] = bf_hi(a0.z) + bf_hi(a1.z);
      y[8 * i + 6] = bf_lo(a0.w) + bf_lo(a1.w); y[8 * i + 7] = bf_hi(a0.w) + bf_hi(a1.w);
      v[8 * i + 0] = bf_lo(av.x); v[8 * i + 1] = bf_hi(av.x); v[8 * i + 2] = bf_lo(av.y); v[8 * i + 3] = bf_hi(av.y);
      v[8 * i + 4] = bf_lo(av.z); v[8 * i + 5] = bf_hi(av.z); v[8 * i + 6] = bf_lo(av.w); v[8 * i + 7] = bf_hi(av.w);
      g[8 * i + 0] = bf_lo(ag.x); g[8 * i + 1] = bf_hi(ag.x); g[8 * i + 2] = bf_lo(ag.y); g[8 * i + 3] = bf_hi(ag.y);
      g[8 * i + 4] = bf_lo(ag.z); g[8 * i + 5] = bf_hi(ag.z); g[8 * i + 6] = bf_lo(ag.w); g[8 * i + 7] = bf_hi(ag.w);
    }
    float s = 0.f;
#pragma unroll
    for (int i = 0; i < 16; ++i) s += y[i];
    s += __shfl_xor(s, 1); s += __shfl_xor(s, 2);
    const float mean = s * (1.f / 64.f);
    float q = 0.f;
#pragma unroll
    for (int i = 0; i < 16; ++i) { const float dlt = y[i] - mean; q += dlt * dlt; }
    q += __shfl_xor(q, 1); q += __shfl_xor(q, 2);
    const float rstd = rsqrtf(q * (1.f / 64.f) + 64e-5f);
    const float bonus = BON[(size_t)row * 16 + head] + BON[((size_t)MT + row) * 16 + head];
    unsigned o[8];
#pragma unroll
    for (int i = 0; i < 8; ++i) {
      const float z0 = ((y[2 * i] - mean) * rstd * gn[c0 + 2 * i] + gn[1024 + c0 + 2 * i] + bonus * v[2 * i]) * g[2 * i];
      const float z1 = ((y[2 * i + 1] - mean) * rstd * gn[c0 + 2 * i + 1] + gn[1024 + c0 + 2 * i + 1] + bonus * v[2 * i + 1]) * g[2 * i + 1];
      o[i] = pk_bf16(z0, z1);
    }
    *(u32x4*)(G + off) = mk4(o[0], o[1], o[2], o[3]);
    *(u32x4*)(G + off + 8) = mk4(o[4], o[5], o[6], o[7]);
  }
}

__device__ __forceinline__ void rglru_phase(char* lds, const bf16_t* __restrict__ XR, const bf16_t* __restrict__ Wg, const float* __restrict__ conv_w,
                            const float* __restrict__ conv_b, const float* __restrict__ gate_b, const float* __restrict__ lam,
                            bf16_t* __restrict__ HS0, bf16_t* __restrict__ HS1) {
  bf16_t* xcT = (bf16_t*)lds;
  f32x2* AB = (f32x2*)(lds + 26624);
  bf16_t* raw = (bf16_t*)(lds + 26624);
  float* segP = (float*)(lds + 116736);
  float* segH = segP + 352;
  float* segC = segH + 352;
  bf16_t* wgs = (bf16_t*)(lds + 120960);
  float* cws = (float*)(lds + 160896);
  const int tid = opaque_tid(), lane = tid & 63, wv = tid >> 6;
  for (int chain = blockIdx.x; chain < 256; chain += gridDim.x) {
    const int d = chain & 1, blk = (chain >> 1) & 15, b = chain >> 5;
    bf16_t* HS = d ? HS1 : HS0;
    float carry = 0.f;
    __syncthreads();
    for (int q = tid; q < 2 * 96 * 12; q += NTHR) {
      const int g = q / 1152, rem = q - g * 1152, n = rem / 12, k8 = rem - n * 12;
      *(u32x4*)(wgs + (g * 96 + n) * 104 + k8 * 8) = *(const u32x4*)(Wg + ((size_t)((blk * 4 + d * 2 + g) * 96 + n)) * 96 + k8 * 8);
    }
    for (int e = tid; e < 5 * 88; e += NTHR) {
      const int j = e / 88, c = e - j * 88;
      cws[e] = j < 4 ? conv_w[j * LW + blk * 88 + c] : conv_b[blk * 88 + c];
    }
    for (int e = tid; e < 128 * 8; e += NTHR) xcT[(e >> 3) * 104 + 88 + (e & 7)] = 0;
    u32x4 pre[3];
    auto tile_geom = [&](int ti, int& seqbase, int& t0, int& T) {
      if (ti < 2) { seqbase = ML + b * 256; T = 256; t0 = (d ? 1 - ti : ti) * 128; }
      else { seqbase = b * 4096; T = 4096; t0 = (d ? 31 - (ti - 2) : (ti - 2)) * 128; }
    };
    auto prefetch = [&](int ti) {
      int seqbase, t0, T; tile_geom(ti, seqbase, t0, T);
#pragma unroll
      for (int i = 0; i < 3; ++i) {
        const int q = tid + NTHR * i;
        const int row = q / 11, cc = q - row * 11, t = t0 - 2 + row;
        u32x4 v = {0u, 0u, 0u, 0u};
        if (q < 131 * 11 && t >= 0 && t < T) v = *(const u32x4*)(XR + (size_t)(seqbase + t) * LW + blk * 88 + cc * 8);
        pre[i] = v;
      }
    };
    prefetch(0);
    for (int ti = 0; ti < 34; ++ti) {
      int seqbase, t0, T; tile_geom(ti, seqbase, t0, T);
      __syncthreads();
#pragma unroll
      for (int i = 0; i < 3; ++i) {
        const int q = tid + NTHR * i;
        if (q < 131 * 11) *(u32x4*)(raw + q * 8) = pre[i];
      }
      if (ti + 1 < 34) prefetch(ti + 1);
      __builtin_amdgcn_sched_barrier(0);
      __syncthreads();
      {
        unsigned xr[11][4];
#pragma unroll
        for (int it = 0; it < 11; ++it) {
          const int e = tid + it * NTHR, tl = e / 44, c2 = (e - tl * 44) * 2;
#pragma unroll
          for (int j = 0; j < 4; ++j) xr[it][j] = *(const unsigned*)(raw + (tl + j) * 88 + c2);
        }
#pragma unroll
        for (int it = 0; it < 11; ++it) {
          const int e = tid + it * NTHR, tl = e / 44, c2 = (e - tl * 44) * 2;
          float a0 = cws[4 * 88 + c2], a1 = cws[4 * 88 + c2 + 1];
#pragma unroll
          for (int j = 0; j < 4; ++j) { a0 += bf_lo(xr[it][j]) * cws[j * 88 + c2]; a1 += bf_hi(xr[it][j]) * cws[j * 88 + c2 + 1]; }
          *(unsigned*)(xcT + tl * 104 + c2) = pk_bf16(a0, a1);
        }
      }
      __syncthreads();
      {
        const int tok = wv * 16 + (lane & 15);
        u32x4 af[3];
#pragma unroll
        for (int kk = 0; kk < 3; ++kk) af[kk] = *(const u32x4*)(xcT + tok * 104 + kk * 32 + 8 * (lane >> 4));
        bf16_t xcv[6][4];
#pragma unroll
        for (int n6 = 0; n6 < 6; ++n6)
#pragma unroll
          for (int r = 0; r < 4; ++r) xcv[n6][r] = xcT[(wv * 16 + (lane >> 4) * 4 + r) * 104 + n6 * 16 + (lane & 15)];
#pragma unroll
        for (int n6 = 0; n6 < 6; ++n6) {
          f32x4 accr = {0.f, 0.f, 0.f, 0.f}, acci = {0.f, 0.f, 0.f, 0.f};
          const int ncol = n6 * 16 + (lane & 15);
          const bf16_t* wr_ = wgs + ncol * 104 + 8 * (lane >> 4);
          const bf16_t* wi_ = wgs + (96 + ncol) * 104 + 8 * (lane >> 4);
#pragma unroll
          for (int kk = 0; kk < 3; ++kk) {
            accr = mfma16(af[kk], *(const u32x4*)(wr_ + kk * 32), accr);
            acci = mfma16(af[kk], *(const u32x4*)(wi_ + kk * 32), acci);
          }
          if (ncol < 88) {
            const int ch = blk * 88 + ncol;
            const float gbr = gate_b[(d * 2 + 0) * LW + ch], gbi = gate_b[(d * 2 + 1) * LW + ch];
            const float spl = softplusf_(-lam[d * LW + ch]);
#pragma unroll
            for (int r = 0; r < 4; ++r) {
              const int tk = wv * 16 + (lane >> 4) * 4 + r;
              const float rg = sigmoidf_(accr[r] + gbr), ig = sigmoidf_(acci[r] + gbi);
              const float a = __expf(-8.f * rg * spl);
              const float bb = sqrtf(fmaxf(1.f - a * a, 0.f)) * ig * bf2f(xcv[n6][r]);
              AB[tk * 88 + ncol] = (f32x2){a, bb};
            }
          }
        }
      }
      __syncthreads();
      if (tid < 352) {
        const int seg = tid / 88, c = tid - seg * 88;
        float hl = 0.f, P = 1.f;
        for (int u0 = seg * 32; u0 < seg * 32 + 32; u0 += 8) {
          f32x2 ab[8];
#pragma unroll
          for (int i = 0; i < 8; ++i) { const int tl = d ? 127 - (u0 + i) : (u0 + i); ab[i] = AB[tl * 88 + c]; }
#pragma unroll
          for (int i = 0; i < 8; ++i) { hl = ab[i][0] * hl + ab[i][1]; P *= ab[i][0]; ab[i] = (f32x2){hl, P}; }
#pragma unroll
          for (int i = 0; i < 8; ++i) { const int tl = d ? 127 - (u0 + i) : (u0 + i); AB[tl * 88 + c] = ab[i]; }
        }
        segH[seg * 88 + c] = hl; segP[seg * 88 + c] = P;
      }
      __syncthreads();
      if (tid < 88) {
        float cur = carry;
#pragma unroll
        for (int seg = 0; seg < 4; ++seg) { segC[seg * 88 + tid] = cur; cur = segP[seg * 88 + tid] * cur + segH[seg * 88 + tid]; }
        carry = cur;
      }
      __syncthreads();
      for (int q = tid; q < 128 * 11; q += NTHR) {
        const int tl = q / 11, c8 = (q - tl * 11) * 8;
        const int u = d ? 127 - tl : tl;
        const float* sc = segC + (u >> 5) * 88 + c8;
        float hv[8];
#pragma unroll
        for (int i = 0; i < 8; ++i) { const f32x2 hp = AB[tl * 88 + c8 + i]; hv[i] = hp[0] + hp[1] * sc[i]; }
        *(u32x4*)(HS + (size_t)(seqbase + t0 + tl) * LW + blk * 88 + c8) =
            mk4(pk_bf16(hv[0], hv[1]), pk_bf16(hv[2], hv[3]), pk_bf16(hv[4], hv[5]), pk_bf16(hv[6], hv[7]));
      }
    }
  }
}

__device__ __forceinline__ void lru_z_phase(const bf16_t* __restrict__ HS0, const bf16_t* __restrict__ HS1, bf16_t* __restrict__ GG) {
  const size_t n8 = (size_t)MT * LW / 8;
  for (size_t e = (size_t)blockIdx.x * NTHR + threadIdx.x; e < n8; e += (size_t)gridDim.x * NTHR) {
    const u32x4 a = *(const u32x4*)(HS0 + e * 8), b = *(const u32x4*)(HS1 + e * 8), g = *(const u32x4*)(GG + e * 8);
    u32x4 o;
    o.x = pk_bf16((bf_lo(a.x) + bf_lo(b.x)) * bf_lo(g.x), (bf_hi(a.x) + bf_hi(b.x)) * bf_hi(g.x));
    o.y = pk_bf16((bf_lo(a.y) + bf_lo(b.y)) * bf_lo(g.y), (bf_hi(a.y) + bf_hi(b.y)) * bf_hi(g.y));
    o.z = pk_bf16((bf_lo(a.z) + bf_lo(b.z)) * bf_lo(g.z), (bf_hi(a.z) + bf_hi(b.z)) * bf_hi(g.z));
    o.w = pk_bf16((bf_lo(a.w) + bf_lo(b.w)) * bf_lo(g.w), (bf_hi(a.w) + bf_hi(b.w)) * bf_hi(g.w));
    *(u32x4*)(GG + e * 8) = o;
  }
}

__device__ __forceinline__ void nat_qk_phase(bf16_t* __restrict__ Q, bf16_t* __restrict__ Kb, bf16_t* __restrict__ QR, const float* __restrict__ qk_g) {
  const int tidx = opaque_tid();
  const int lane = tidx & 63;
  const int gw = blockIdx.x * (NTHR / 64) + (tidx >> 6), nw = gridDim.x * (NTHR / 64);
  const int qd = lane & 3;
  float gq[16], gk[16], inv[16];
#pragma unroll
  for (int i = 0; i < 16; ++i) { gq[i] = qk_g[qd * 16 + i]; gk[i] = qk_g[64 + qd * 16 + i]; inv[i] = exp2f(-(float)i * (13.287712379549449f / 16.f)); }
  for (int row = gw; row < MT; row += nw) {
    const bool lat = row < ML;
    const size_t off = (size_t)row * 1024 + lane * 16;
    float cs[16], sn[16];
    if (lat) {
      const int t = row & 4095;
      const float pos = (float)((qd >> 1) ? (t & 63) : (t >> 6));
#pragma unroll
      for (int i = 0; i < 16; ++i) {
        float rev = pos * inv[i] * 0.15915494309189535f;
        rev -= floorf(rev);
        sn[i] = __builtin_amdgcn_sinf(rev); cs[i] = __builtin_amdgcn_cosf(rev);
      }
    }
#pragma unroll
    for (int which = 0; which < 2; ++which) {
      bf16_t* P = which ? Kb : Q;
      const u32x4 a = *(const u32x4*)(P + off), b2 = *(const u32x4*)(P + off + 8);
      const unsigned u[8] = {a.x, a.y, a.z, a.w, b2.x, b2.y, b2.z, b2.w};
      float x[16];
#pragma unroll
      for (int i = 0; i < 8; ++i) { x[2 * i] = bf_lo(u[i]); x[2 * i + 1] = bf_hi(u[i]); }
      float ss = 0.f;
#pragma unroll
      for (int i = 0; i < 16; ++i) ss += x[i] * x[i];
      ss += __shfl_xor(ss, 1); ss += __shfl_xor(ss, 2);
      const float rstd = rsqrtf(ss * (1.f / 64.f) + 1e-6f);
#pragma unroll
      for (int i = 0; i < 16; ++i) x[i] = x[i] * rstd * (which ? gk[i] : gq[i]);
      unsigned pl[8];
#pragma unroll
      for (int i = 0; i < 8; ++i) pl[i] = pk_bf16(x[2 * i], x[2 * i + 1]);
      unsigned rt[8];
      if (lat) {
        float y[16];
#pragma unroll
        for (int i = 0; i < 16; ++i) {
          const float pr = __shfl_xor(x[i], 1);
          y[i] = x[i] * cs[i] + ((qd & 1) ? pr * sn[i] : -pr * sn[i]);
        }
#pragma unroll
        for (int i = 0; i < 8; ++i) rt[i] = pk_bf16(y[2 * i], y[2 * i + 1]);
      }
      if (which == 0) {
        *(u32x4*)(Q + off) = mk4(pl[0], pl[1], pl[2], pl[3]);
        *(u32x4*)(Q + off + 8) = mk4(pl[4], pl[5], pl[6], pl[7]);
        if (lat) { *(u32x4*)(QR + off) = mk4(rt[0], rt[1], rt[2], rt[3]); *(u32x4*)(QR + off + 8) = mk4(rt[4], rt[5], rt[6], rt[7]); }
      } else {
        if (lat) { *(u32x4*)(Kb + off) = mk4(rt[0], rt[1], rt[2], rt[3]); *(u32x4*)(Kb + off + 8) = mk4(rt[4], rt[5], rt[6], rt[7]); }
        else { *(u32x4*)(Kb + off) = mk4(pl[0], pl[1], pl[2], pl[3]); *(u32x4*)(Kb + off + 8) = mk4(pl[4], pl[5], pl[6], pl[7]); }
      }
    }
  }
}

struct AttnState { f32x16 O[2][2]; float m[2], l[2]; };

DEVI void attn_load_k(u32x4 (&kf)[4], const bf16_t* __restrict__ kbase, int lane) {
  const int l31 = lane & 31, lh = lane >> 5;
#pragma unroll
  for (int ks = 0; ks < 4; ++ks) kf[ks] = *(const u32x4*)(kbase + (size_t)l31 * 1024 + ks * 16 + 8 * lh);
}

DEVI void attn_compute(AttnState& st, const u32x4* qs, const bf16_t* __restrict__ kbase, const bf16_t* __restrict__ vtbase, int vtT,
                       const float* __restrict__ rpbs, bool band, int brow, int half, int lane) {
  const int l31 = lane & 31, lh = lane >> 5;
  u32x4 kf[4];
  attn_load_k(kf, kbase, lane);
  u32x4 vf[4];
#pragma unroll
  for (int dt = 0; dt < 2; ++dt)
#pragma unroll
    for (int s = 0; s < 2; ++s) {
      const bf16_t* vp = vtbase + (size_t)(dt * 32 + l31) * vtT + 16 * s + 4 * lh;
      const u32x2 lo = *(const u32x2*)vp, hi = *(const u32x2*)(vp + 8);
      vf[dt * 2 + s] = mk4(lo.x, lo.y, hi.x, hi.y);
    }
  __builtin_amdgcn_sched_barrier(0);
  constexpr float SC = 0.125f * 1.4426950408889634f;
  u32x4 pf[2][2];
#pragma unroll
  for (int qt = 0; qt < 2; ++qt) {
    f32x16 S;
#pragma unroll
    for (int r = 0; r < 16; ++r) S[r] = 0.f;
#pragma unroll
    for (int ks = 0; ks < 4; ++ks) S = mfma32(kf[ks], qs[(qt * 4 + ks) * 64], S);
    float cmax = -INFINITY;
    if (band) {
      const int qc = qt * 32 + l31;
      const int cst = min(max(qc - 8, 0), 48);
#pragma unroll
      for (int r = 0; r < 16; ++r) {
        const int key = (r & 3) + 8 * (r >> 2) + 4 * lh;
        const int kc = half * 32 + key;
        const bool ok = (kc >= cst) && (kc < cst + 16);
        const int bi = ok ? (brow * 31 + kc - qc + 15) : 0;
        const float sv = S[r] * SC + rpbs[bi];
        S[r] = ok ? sv : -INFINITY;
        cmax = fmaxf(cmax, S[r]);
      }
    } else {
#pragma unroll
      for (int r = 0; r < 16; ++r) { S[r] *= SC; cmax = fmaxf(cmax, S[r]); }
    }
    cmax = fmaxf(cmax, __shfl_xor(cmax, 32));
    const float mnew = fmaxf(st.m[qt], cmax);
    const float alpha = __builtin_amdgcn_exp2f(st.m[qt] - mnew);
    const bool grew = mnew > st.m[qt];
    st.m[qt] = mnew;
    float ps = 0.f;
#pragma unroll
    for (int r = 0; r < 16; ++r) { S[r] = __builtin_amdgcn_exp2f(S[r] - mnew); ps += S[r]; }
    st.l[qt] = st.l[qt] * alpha + ps;
    if (__any(grew)) {
#pragma unroll
      for (int dt = 0; dt < 2; ++dt)
#pragma unroll
        for (int r = 0; r < 16; ++r) st.O[qt][dt][r] *= alpha;
    }
    pf[qt][0] = mk4(pk_bf16(S[0], S[1]), pk_bf16(S[2], S[3]), pk_bf16(S[4], S[5]), pk_bf16(S[6], S[7]));
    pf[qt][1] = mk4(pk_bf16(S[8], S[9]), pk_bf16(S[10], S[11]), pk_bf16(S[12], S[13]), pk_bf16(S[14], S[15]));
  }
#pragma unroll
  for (int dt = 0; dt < 2; ++dt)
#pragma unroll
    for (int s = 0; s < 2; ++s) {
      st.O[0][dt] = mfma32(vf[dt * 2 + s], pf[0][s], st.O[0][dt]);
      st.O[1][dt] = mfma32(vf[dt * 2 + s], pf[1][s], st.O[1][dt]);
    }
}

__device__ __forceinline__ void natten_phase(char* lds, const bf16_t* __restrict__ Q, const bf16_t* __restrict__ QR, const bf16_t* __restrict__ Kb,
                             const bf16_t* __restrict__ VT, bf16_t* __restrict__ G, const float* __restrict__ rpb, bf16_t* __restrict__ Zd) {
  float* rpbs = (float*)lds;
  __syncthreads();
  for (int e = threadIdx.x; e < 16 * 465; e += NTHR) rpbs[e] = rpb[e] * 1.4426950408889634f;
  __syncthreads();
  const int tidx = opaque_tid();
  const int lane = tidx & 63, l31 = lane & 31, lh = lane >> 5;
  const int gw = blockIdx.x * (NTHR / 64) + (tidx >> 6), nw = gridDim.x * (NTHR / 64);
  const bf16_t* VTC = VT + (size_t)ML * 1024;
  u32x4* qs = (u32x4*)(lds + 32768) + (tidx >> 6) * 512 + lane;
  const int xcd = blockIdx.x & 7, wx = (blockIdx.x >> 3) * (NTHR / 64) + (tidx >> 6), nwx = (gridDim.x >> 3) * (NTHR / 64);
  for (int i = wx; i < 1024 + 64; i += nwx) {
    const bool lat = i < 1024;
    int b, h, r = 0, qrow0;
    if (lat) { const int pair = xcd * 16 + (i >> 6); r = i & 63; b = pair >> 4; h = pair & 15; qrow0 = b * 4096 + r * 64; }
    else { const int it = i - 1024; const int pair = xcd * 16 + (it >> 2); const int qt64 = it & 3; b = pair >> 4; h = pair & 15; qrow0 = ML + b * 256 + qt64 * 64; }
    const int start = min(max(r - 4, 0), 56);
    const int nchunks = lat ? 24 : 8;
    AttnState st;
#pragma unroll
    for (int a = 0; a < 2; ++a) { st.m[a] = -INFINITY; st.l[a] = 0.f;
#pragma unroll
      for (int c = 0; c < 2; ++c)
#pragma unroll
        for (int rr = 0; rr < 16; ++rr) st.O[a][c][rr] = 0.f; }
#pragma unroll
    for (int qt = 0; qt < 2; ++qt)
#pragma unroll
      for (int ks = 0; ks < 4; ++ks) qs[(qt * 4 + ks) * 64] = *(const u32x4*)(Q + (size_t)(qrow0 + qt * 32 + l31) * 1024 + h * 64 + ks * 16 + 8 * lh);
    for (int j = 0; j < nchunks; ++j) {
      if (j == 8) {
#pragma unroll
        for (int qt = 0; qt < 2; ++qt)
#pragma unroll
          for (int ks = 0; ks < 4; ++ks) qs[(qt * 4 + ks) * 64] = *(const u32x4*)(QR + (size_t)(qrow0 + qt * 32 + l31) * 1024 + h * 64 + ks * 16 + 8 * lh);
      }
      const bool band = j >= 8;
      const int ii = j - 8, kr = start + (ii >> 1), half = band ? (ii & 1) : 0;
      const size_t krow = band ? (size_t)(b * 4096 + kr * 64 + half * 32) : (size_t)(ML + b * 256 + j * 32);
      const bf16_t* kbase = Kb + krow * 1024 + h * 64;
      const bf16_t* vtb = band ? VT + (size_t)(b * 16 + h) * 64 * 4096 + kr * 64 + half * 32 : VTC + (size_t)(b * 16 + h) * 64 * 256 + j * 32;
      attn_compute(st, qs, kbase, vtb, band ? 4096 : 256, rpbs, band, band ? h * 15 + (kr - r + 7) : 0, half, lane);
    }
#pragma unroll
    for (int qt = 0; qt < 2; ++qt) {
      const float lt = st.l[qt] + __shfl_xor(st.l[qt], 32);
      const float inv = 1.f / lt;
      bf16_t* grow = G + (size_t)(qrow0 + qt * 32 + l31) * 1024 + h * 64;
      u32x2 gvs[2][4];
#pragma unroll
      for (int dt = 0; dt < 2; ++dt)
#pragma unroll
        for (int q4 = 0; q4 < 4; ++q4) gvs[dt][q4] = *(const u32x2*)(grow + dt * 32 + 8 * q4 + 4 * lh);
#pragma unroll
      for (int dt = 0; dt < 2; ++dt)
#pragma unroll
        for (int q4 = 0; q4 < 4; ++q4) {
          bf16_t* gp = grow + dt * 32 + 8 * q4 + 4 * lh;
          bf16_t* zp = Zd + (gp - G);
          const u32x2 gv = gvs[dt][q4];
          u32x2 o;
          o.x = pk_bf16(st.O[qt][dt][4 * q4] * inv * bf_lo(gv.x), st.O[qt][dt][4 * q4 + 1] * inv * bf_hi(gv.x));
          o.y = pk_bf16(st.O[qt][dt][4 * q4 + 2] * inv * bf_lo(gv.y), st.O[qt][dt][4 * q4 + 3] * inv * bf_hi(gv.y));
          *(u32x2*)zp = o;
        }
    }
  }
}

namespace pg8 {
#define PG8_LAS __attribute__((address_space(3)))
typedef unsigned short bf16_t;
typedef short bf16x8 __attribute__((ext_vector_type(8)));
typedef float f32x4 __attribute__((ext_vector_type(4)));
typedef unsigned u32x4 __attribute__((ext_vector_type(4)));
constexpr int BM = 256, BK = 64, HALF = 128, HTB = HALF * BK * 2  , STAGE_BYTES = 8 * HTB, NXCD = 8, WGM = 8;

__host__ __device__ __forceinline__ int lds_byte(int r, int c) { const int st = (r >> 4) * 2 + (c >> 5), rr = r & 15, cc = c & 31, ob = rr * 64 + cc * 2; return st * 1024 + (ob ^ (((ob >> 9) & 1) << 5)); }
__host__ __device__ __forceinline__ void stage_rc(int b, int& R, int& C) { const int st = b / 1024, sb = b % 1024, swz = sb ^ (((sb >> 9) & 1) << 5); R = (st >> 1) * 16 + swz / 64; C = (st & 1) * 32 + (swz % 64) / 2; }
__host__ __device__ __forceinline__ int perm32(int rho) { const int n = rho >> 4, i = rho & 15; return 8 * (i >> 2) + 4 * n + (i & 3); }

struct Unit { int pm, pn; };
struct Gemm { const bf16_t* A; const bf16_t* Bt; int M, N, K; };

struct StaticOrder {
    int nM, nN, nwg, G, c;
    __host__ __device__ void init(int M, int N, int G_, int c_) { nM = M / BM; nN = N / BM; nwg = nM * nN; G = G_; c = c_; }
    __host__ __device__ bool next(int i, Unit& u) const {
        const long L = (long)i * G + c; if (L >= nwg) return false;
        int wgid = (int)L; { const int q = nwg / NXCD, r = nwg % NXCD, xcd = wgid % NXCD, off = wgid / NXCD; wgid = (xcd < r ? xcd * (q + 1) : r * (q + 1) + (xcd - r) * q) + off; }
        const int nig = WGM * nN, gid = wgid / nig, fm = gid * WGM, gsz = (nM - fm) < WGM ? (nM - fm) : WGM;
        u.pm = fm + ((wgid % nig) % gsz); u.pn = (wgid % nig) / gsz; return true;
    }
    __device__ __forceinline__ void a_ready(const Unit&) const {}
    __device__ __forceinline__ void done(const Unit&) const {}
};
template <class Epi, class Sched, bool STAMP = false>
__device__ __forceinline__ void gemm_phase(PG8_LAS unsigned char* lds, const Gemm g, const Sched& S, const Epi& E, unsigned long long* stamps) {
    const int tid = threadIdx.x, wid = __builtin_amdgcn_readfirstlane(tid >> 6), lane = tid & 63, wr = wid >> 2, wc = wid & 3, fr = lane & 15, fq = lane >> 4;
    const int K = g.K, nt = K / BK;
    int ts_lo = 0, ts_hi = 0, nts = 0; const unsigned long long rt_entry = STAMP ? (unsigned long long)wall_clock64() : 0ull;
#define PG8_STAMP() do { if (STAMP && wid == 0 && nts < 64) { const unsigned long long _c = (unsigned long long)clock64(); \
        ts_lo = (lane == nts) ? (int)(unsigned)_c : ts_lo; ts_hi = (lane == nts) ? (int)(unsigned)(_c >> 32) : ts_hi; ++nts; } } while (0)
    PG8_STAMP();
    unsigned voffA[2], voffB[2];
#pragma unroll
    for (int i = 0; i < 2; ++i) { int R, C; stage_rc(tid * 16 + i * 8192, R, C); const int Rb = Epi::PERM ? ((R & ~31) + perm32(R & 31)) : R;
        voffA[i] = (unsigned)(R * K + C) * 2u; voffB[i] = (unsigned)(Rb * K + C) * 2u; }
    const size_t kstep = (size_t)(BK * 2);
    const size_t hstep = (size_t)HALF * K * 2;
    const size_t tstep = 2 * hstep;
    const unsigned ldsw = (unsigned)wid * 1024u;
    const int aoff = lds_byte(wr * 64 + fr, fq * 8), boff = lds_byte(wc * 32 + fr, fq * 8);
#define PG8_SA(b, h) (((b) * 2 + (h)) * HTB)
#define PG8_SB(b, h) ((4 + (b) * 2 + (h)) * HTB)
#define PG8_STAGE(bufoff, gbase, voff) do { _Pragma("unroll") for (int _i = 0; _i < 2; ++_i) \
        __builtin_amdgcn_global_load_lds((const unsigned*)((const char*)(gbase) + (voff)[_i]), (PG8_LAS unsigned*)(lds + (bufoff) + ldsw + _i * 8192), 16, 0, 0); } while (0)
#define PG8_LDA(dst, b, h) do { _Pragma("unroll") for (int m = 0; m < 4; ++m) _Pragma("unroll") for (int k = 0; k < 2; ++k) dst[m][k] = *(const PG8_LAS bf16x8*)(lds + PG8_SA(b, h) + aoff + m * 2048 + k * 1024); } while (0)
#define PG8_LDB(dst, b, h) do { _Pragma("unroll") for (int n = 0; n < 2; ++n) _Pragma("unroll") for (int k = 0; k < 2; ++k) dst[n][k] = *(const PG8_LAS bf16x8*)(lds + PG8_SB(b, h) + boff + n * 2048 + k * 1024); } while (0)
#define PG8_MMA(ai, bj, At, Bt) do { __builtin_amdgcn_s_setprio(1); _Pragma("unroll") for (int m = 0; m < 4; ++m) _Pragma("unroll") for (int n = 0; n < 2; ++n) _Pragma("unroll") for (int k = 0; k < 2; ++k) \
        acc[ai][bj][m][n] = __builtin_amdgcn_mfma_f32_16x16x32_bf16(Bt[n][k], At[m][k], acc[ai][bj][m][n], 0, 0, 0); __builtin_amdgcn_s_setprio(0); } while (0)
#define PG8_WAIT_V(n) asm volatile("s_waitcnt vmcnt(" #n ")" ::: "memory")
#define PG8_WAIT_L(n) asm volatile("s_waitcnt lgkmcnt(" #n ")" ::: "memory")
#define PG8_BAR __builtin_amdgcn_s_barrier()
#define PG8_SCHED __builtin_amdgcn_sched_barrier(0)
    Unit cur, nxt; int ui = 0;
    if (!S.next(0, cur)) return;
    f32x4 acc[2][2][4][2];
#pragma unroll
    for (int a = 0; a < 2; ++a)
#pragma unroll
        for (int b = 0; b < 2; ++b)
#pragma unroll
            for (int m = 0; m < 4; ++m)
#pragma unroll
                for (int n = 0; n < 2; ++n) acc[a][b][m][n] = (f32x4){0.f, 0.f, 0.f, 0.f};
    bf16x8 At[4][2], B0[2][2], B1[2][2];
    const char* cA = (const char*)g.A + (size_t)cur.pm * tstep; const char* cB = (const char*)g.Bt + (size_t)cur.pn * tstep;
    S.a_ready(cur);
    PG8_STAGE(PG8_SB(0, 0), cB, voffB); PG8_STAGE(PG8_SA(0, 0), cA, voffA); PG8_STAGE(PG8_SB(0, 1), cB + hstep, voffB); PG8_STAGE(PG8_SA(0, 1), cA + hstep, voffA);
    if (wr == 1) PG8_BAR;
    PG8_WAIT_V(4); PG8_BAR;
    PG8_STAGE(PG8_SB(1, 0), cB + kstep, voffB); PG8_STAGE(PG8_SA(1, 0), cA + kstep, voffA); PG8_STAGE(PG8_SB(1, 1), cB + hstep + kstep, voffB);
    PG8_WAIT_V(6); PG8_BAR;
    PG8_STAMP();
    for (;;) {
        const bool has_next = S.next(ui + 1, nxt);
        const char* nA = has_next ? (const char*)g.A + (size_t)nxt.pm * tstep : cA; const char* nB = has_next ? (const char*)g.Bt + (size_t)nxt.pn * tstep : cB;
        for (int t = 0; t < nt; t += 2) {
            const bool last = (t == nt - 2);
            const char* a1 = cA + (size_t)(t + 1) * kstep;
            const char* a2 = last ? nA : cA + (size_t)(t + 2) * kstep; const char* b2 = last ? nB : cB + (size_t)(t + 2) * kstep;
            const char* a3 = a2 + kstep; const char* b3 = b2 + kstep;
            if (last && has_next) S.a_ready(nxt);
            PG8_LDB(B0, 0, 0); PG8_SCHED; PG8_LDA(At, 0, 0); PG8_STAGE(PG8_SA(1, 1), a1 + hstep, voffA);
            PG8_WAIT_L(8); PG8_BAR; PG8_WAIT_L(0); PG8_MMA(0, 0, At, B0); PG8_BAR; PG8_SCHED;
            PG8_LDB(B1, 0, 1); PG8_STAGE(PG8_SB(0, 0), b2, voffB);
            PG8_BAR; PG8_WAIT_L(0); PG8_MMA(0, 1, At, B1); PG8_BAR;
            PG8_LDA(At, 0, 1); PG8_STAGE(PG8_SA(0, 0), a2, voffA);
            PG8_BAR; PG8_WAIT_L(0); PG8_MMA(1, 0, At, B0); PG8_BAR; PG8_SCHED;
            PG8_STAGE(PG8_SB(0, 1), b2 + hstep, voffB);
            PG8_WAIT_V(6); PG8_BAR; PG8_MMA(1, 1, At, B1); PG8_BAR;
            PG8_LDB(B0, 1, 0); PG8_SCHED; PG8_LDA(At, 1, 0); PG8_STAGE(PG8_SA(0, 1), a2 + hstep, voffA);
            PG8_WAIT_L(8); PG8_BAR; PG8_WAIT_L(0); PG8_MMA(0, 0, At, B0); PG8_BAR; PG8_SCHED;
            PG8_LDB(B1, 1, 1); PG8_STAGE(PG8_SB(1, 0), b3, voffB);
            PG8_BAR; PG8_WAIT_L(0); PG8_MMA(0, 1, At, B1); PG8_BAR;
            PG8_LDA(At, 1, 1); PG8_STAGE(PG8_SA(1, 0), a3, voffA);
            PG8_BAR; PG8_WAIT_L(0); PG8_MMA(1, 0, At, B0); PG8_BAR; PG8_SCHED;
            PG8_STAGE(PG8_SB(1, 1), b3 + hstep, voffB);
            PG8_WAIT_V(6); PG8_BAR; PG8_MMA(1, 1, At, B1); PG8_BAR;
        }
        PG8_STAMP();
        if constexpr (!Epi::AFTER_DRAIN) { E(acc, cur, wr, wc, fr, fq); S.done(cur); }
        PG8_STAMP();
        if (!has_next) break;
#pragma unroll
        for (int a = 0; a < 2; ++a)
#pragma unroll
            for (int b = 0; b < 2; ++b)
#pragma unroll
                for (int m = 0; m < 4; ++m)
#pragma unroll
                    for (int n = 0; n < 2; ++n) acc[a][b][m][n] = (f32x4){0.f, 0.f, 0.f, 0.f};
        cur = nxt; cA = nA; cB = nB; ++ui;
    }
    PG8_WAIT_V(0);
    if (wr == 0) PG8_BAR;
    PG8_BAR;
    if constexpr (Epi::AFTER_DRAIN) { E.fused(acc, cur, wr, wc, fr, fq, lds, wid, lane); S.done(cur); }
    PG8_STAMP();
    if (STAMP && wid == 0) { stamps[lane] = lane < nts ? (((unsigned long long)(unsigned)ts_hi << 32) | (unsigned)ts_lo) : 0ull;
        if (lane == 62) stamps[62] = rt_entry; if (lane == 63) stamps[63] = (unsigned long long)wall_clock64(); }
#undef PG8_STAMP
#undef PG8_SA
#undef PG8_SB
#undef PG8_STAGE
#undef PG8_LDA
#undef PG8_LDB
#undef PG8_MMA
#undef PG8_WAIT_V
#undef PG8_WAIT_L
#undef PG8_BAR
#undef PG8_SCHED
}
}

template <class EP> struct Pg8Epi {
  static constexpr bool PERM = false, AFTER_DRAIN = false;
  EP ep;
  __device__ __forceinline__ void operator()(const pg8::f32x4 (&acc)[2][2][4][2], const pg8::Unit& u, int wr, int wc, int fr, int fq) const {
#pragma unroll
    for (int ai = 0; ai < 2; ++ai)
#pragma unroll
      for (int m = 0; m < 4; ++m)
#pragma unroll
        for (int bj = 0; bj < 2; ++bj)
#pragma unroll
          for (int n = 0; n < 2; ++n) {
            const int row = u.pm * 256 + ai * 128 + wr * 64 + m * 16 + fr;
            const int col = u.pn * 256 + bj * 128 + wc * 32 + n * 16 + fq * 4;
            ep(row, col, acc[ai][bj][m][n]);
          }
  }
};
struct Pg8EpiRes {
  static constexpr bool PERM = false, AFTER_DRAIN = false;
  EpRes ep;
  __device__ __forceinline__ void operator()(const pg8::f32x4 (&acc)[2][2][4][2], const pg8::Unit& u, int wr, int wc, int fr, int fq) const {
    const int bidx = (u.pm * 256) >> 12;
    const float* gbase = ep.modL + bidx * 3072 + 2048 + u.pn * 256 + wc * 32 + fq * 4;
    f32x4 g[2][2];
#pragma unroll
    for (int bj = 0; bj < 2; ++bj)
#pragma unroll
      for (int n = 0; n < 2; ++n) g[bj][n] = *(const f32x4*)(gbase + bj * 128 + n * 16);
#pragma unroll
    for (int ai = 0; ai < 2; ++ai)
#pragma unroll
      for (int mp = 0; mp < 2; ++mp) {
        f32x4 x[2][2][2];
        size_t roff[2];
#pragma unroll
        for (int mm = 0; mm < 2; ++mm) {
          roff[mm] = (size_t)(u.pm * 256 + ai * 128 + wr * 64 + (mp * 2 + mm) * 16 + fr) * 1024 + u.pn * 256 + wc * 32 + fq * 4;
#pragma unroll
          for (int bj = 0; bj < 2; ++bj)
#pragma unroll
            for (int n = 0; n < 2; ++n) x[mm][bj][n] = *(const f32x4*)(ep.xl_src + roff[mm] + bj * 128 + n * 16);
        }
#pragma unroll
        for (int mm = 0; mm < 2; ++mm)
#pragma unroll
          for (int bj = 0; bj < 2; ++bj)
#pragma unroll
            for (int n = 0; n < 2; ++n) *(f32x4*)(ep.xl_dst + roff[mm] + bj * 128 + n * 16) = x[mm][bj][n] + g[bj][n] * acc[ai][bj][mp * 2 + mm][n];
      }
  }
};
__device__ __forceinline__ void pg8_gemm_res(char* lds, const bf16_t* A, const bf16_t* Bt, int M, int N, int K, const EpRes ep) {
  __syncthreads();
  pg8::Gemm g{A, Bt, M, N, K};
  pg8::StaticOrder S; S.init(M, N, (int)gridDim.x, (int)blockIdx.x);
  Pg8EpiRes E{ep};
  pg8::gemm_phase<Pg8EpiRes, pg8::StaticOrder, false>((PG8_LAS unsigned char*)lds, g, S, E, nullptr);
  __syncthreads();
}
template <class EP>
__device__ __forceinline__ void pg8_gemm(char* lds, const bf16_t* A, const bf16_t* Bt, int M, int N, int K, const EP ep) {
  __syncthreads();
  pg8::Gemm g{A, Bt, M, N, K};
  pg8::StaticOrder S; S.init(M, N, (int)gridDim.x, (int)blockIdx.x);
  Pg8Epi<EP> E{ep};
  pg8::gemm_phase<Pg8Epi<EP>, pg8::StaticOrder, false>((PG8_LAS unsigned char*)lds, g, S, E, nullptr);
  __syncthreads();
}


__device__ __forceinline__ void gemm64_res_phase(char* lds, const bf16_t* __restrict__ A, int lda, const bf16_t* __restrict__ Bt, int K,
                                                 int row_base, int mtiles, const EpRes ep) {
  bf16_t* sA = (bf16_t*)lds;
  bf16_t* sB = (bf16_t*)(lds + 18432);
  const int tid = opaque_tid(), lane = tid & 63, wv = tid >> 6, wm = wv >> 2, wn = wv & 3;
  const int l31 = lane & 31, lh = lane >> 5;
  const int nk = K >> 6;
  const int ldrow = tid >> 3, ldk = (tid & 7) * 8;
  const int total = mtiles * 8;
  for (int tile = blockIdx.x; tile < total; tile += gridDim.x) {
    const int mt = tile >> 3, nt = tile & 7;
    const int m0 = row_base + mt * 64, n0 = nt * 128;
    __syncthreads();
    f32x16 acc;
#pragma unroll
    for (int r = 0; r < 16; ++r) acc[r] = 0.f;
    u32x4 ar = *(const u32x4*)(A + (size_t)(m0 + ldrow) * lda + ldk);
    u32x4 br0 = *(const u32x4*)(Bt + (size_t)(n0 + ldrow) * K + ldk), br1 = *(const u32x4*)(Bt + (size_t)(n0 + ldrow + 64) * K + ldk);
    *(u32x4*)(sA + ldrow * 72 + ldk) = ar;
    *(u32x4*)(sB + ldrow * 72 + ldk) = br0;
    *(u32x4*)(sB + (ldrow + 64) * 72 + ldk) = br1;
    __syncthreads();
    for (int kt = 0; kt < nk; ++kt) {
      const int cur = kt & 1;
      const bool more = (kt + 1) < nk;
      const int k0n = (kt + 1) * 64 + ldk;
      if (more) {
        ar = *(const u32x4*)(A + (size_t)(m0 + ldrow) * lda + k0n);
        br0 = *(const u32x4*)(Bt + (size_t)(n0 + ldrow) * K + k0n); br1 = *(const u32x4*)(Bt + (size_t)(n0 + ldrow + 64) * K + k0n);
      }
      __builtin_amdgcn_sched_barrier(0);
      const bf16_t* a_ = sA + cur * (64 * 72);
      const bf16_t* b_ = sB + cur * (128 * 72);
#pragma unroll
      for (int kk = 0; kk < 4; ++kk) {
        const u32x4 af = *(const u32x4*)(a_ + (wm * 32 + l31) * 72 + kk * 16 + lh * 8);
        const u32x4 bfr = *(const u32x4*)(b_ + (wn * 32 + l31) * 72 + kk * 16 + lh * 8);
        acc = mfma32(bfr, af, acc);
      }
      __builtin_amdgcn_sched_barrier(0);
      if (more) {
        bf16_t* an = sA + (cur ^ 1) * (64 * 72);
        bf16_t* bn = sB + (cur ^ 1) * (128 * 72);
        *(u32x4*)(an + ldrow * 72 + ldk) = ar;
        *(u32x4*)(bn + ldrow * 72 + ldk) = br0;
        *(u32x4*)(bn + (ldrow + 64) * 72 + ldk) = br1;
      }
      __syncthreads();
    }
    const int row = m0 + wm * 32 + l31;
    const size_t roff = (size_t)(row - ML) * 1024 + n0 + wn * 32 + 4 * lh;
    const float* gp = ep.modL + 8 * 3072 + 2048 + n0 + wn * 32 + 4 * lh;
    f32x4 x[4];
#pragma unroll
    for (int q = 0; q < 4; ++q) x[q] = *(const f32x4*)(ep.xc_src + roff + 8 * q);
#pragma unroll
    for (int q = 0; q < 4; ++q) {
      const f32x4 g = *(const f32x4*)(gp + 8 * q);
      const f32x4 v = {acc[4 * q], acc[4 * q + 1], acc[4 * q + 2], acc[4 * q + 3]};
      *(f32x4*)(ep.xc_dst + roff + 8 * q) = x[q] + g * v;
    }
  }
}

template <int ph>
__device__ __forceinline__ void run_phase(const Params& p, char* lds, bool last_rep) {
  char* ws = p.ws;
  const float* MOD = (const float*)(ws + OFF_MOD);
  float* XC = (float*)(ws + OFF_XC);
  bf16_t* HB = (bf16_t*)(ws + OFF_HB);
  bf16_t* A0 = (bf16_t*)(ws + OFF_A0); bf16_t* A1 = (bf16_t*)(ws + OFF_A1); bf16_t* A2 = (bf16_t*)(ws + OFF_A2);
  bf16_t* A3 = (bf16_t*)(ws + OFF_A3); bf16_t* A4 = (bf16_t*)(ws + OFF_A4);
  bf16_t* WD = (bf16_t*)(ws + OFF_WD); bf16_t* AD = (bf16_t*)(ws + OFF_AD);
  float* BON = (float*)(ws + OFF_BON);
  if (ph == 0) { phase0(p, lds); return; }
  constexpr int layer = (ph - 1) / 5, sub = (ph - 1) % 5;
  const float* modL = MOD + (size_t)layer * 9 * 3072;
  const float* xl_cur = layer == 0 ? p.in[0] : p.out;
  const float* xc_cur = layer == 0 ? p.in[2] : XC;
  if (layer == 0 || layer == 3) {
    const int ib = layer ? 33 : 4;
    const bf16_t* WIN = (const bf16_t*)(ws + (layer ? OFF_W3IN : OFF_W0IN));
    const bf16_t* WUP = (const bf16_t*)(ws + (layer ? OFF_W3UP : OFF_W0UP));
    const bf16_t* WOUT = (const bf16_t*)(ws + (layer ? OFF_W3OUT : OFF_W0OUT));
    if (sub == 0) norm_phase<true>(xl_cur, xc_cur, p.in[ib], modL, HB, A4);
    else if (sub == 1) { ALMix al{HB, A4, p.in[ib + 4]}; EpRwkvIn ep{A0, A1, A2, A3, WD, AD}; gemm256_phase(lds, WIN, 1024, MT / 256, 16, al, ep); gemm_phase(lds, WIN, 1024, MT / 256, 2, al, ep, 4096, true); }
    else if (sub == 2) rwkv_scan_phase(lds, A0, A1, A2, WD, AD, WUP, p.in[ib + 5], p.in[ib + 8], p.in[ib + 9], HB, A4, BON);
    else if (sub == 3) rwkv_post_phase(HB, A4, A2, A3, BON, p.in[ib + 10], layer == 3 ? ML : MT);
    else { ALPlain al{A3, 1024}; EpRes ep{xl_cur, xc_cur, p.out, XC, modL}; pg8_gemm_res(lds, A3, WOUT, ML, 1024, 1024, ep); if (layer != 3) gemm64_res_phase(lds, A3, 1024, WOUT, 1024, ML, MC / 64, ep); }
  } else if (layer == 1) {
    bf16_t* HS0 = (bf16_t*)(ws + OFF_HS0); bf16_t* XR = (bf16_t*)(ws + OFF_XR); bf16_t* GG = (bf16_t*)(ws + OFF_GG); bf16_t* HS1 = (bf16_t*)(ws + OFF_HS1);
    if (sub == 0) norm_phase<false>(xl_cur, xc_cur, p.in[16], modL, HB, nullptr);
    else if (sub == 1) { ALPlain al{HB, 1024}; EpLruIn ep{XR, GG}; pg8_gemm(lds, HB, (const bf16_t*)(ws + OFF_W1IN), MT, 2816, 1024, ep); }
    else if (sub == 2) rglru_phase(lds, XR, (const bf16_t*)(ws + OFF_W1G), p.in[20], p.in[21], p.in[23], p.in[24], HS0, HS1);
    else if (sub == 3) lru_z_phase(HS0, HS1, GG);
    else { ALPlain al{GG, LW}; EpRes ep{xl_cur, xc_cur, p.out, XC, modL}; pg8_gemm_res(lds, GG, (const bf16_t*)(ws + OFF_W1OUT), ML, 1024, LW, ep); gemm64_res_phase(lds, GG, LW, (const bf16_t*)(ws + OFF_W1OUT), LW, ML, MC / 64, ep); }
  } else {
    if (sub == 0) norm_phase<false>(xl_cur, xc_cur, p.in[26], modL, HB, nullptr);
    else if (sub == 1) { ALPlain al{HB, 1024}; EpNatIn ep{A0, A1, A2, A3}; pg8_gemm(lds, HB, (const bf16_t*)(ws + OFF_W2IN), MT, 4096, 1024, ep); }
    else if (sub == 2) nat_qk_phase(A0, A1, A4, p.in[30]);
    else if (sub == 3) natten_phase(lds, A0, A4, A1, A2, A3, p.in[31], last_rep ? A3 : HB);
    else { ALPlain al{A3, 1024}; EpRes ep{xl_cur, xc_cur, p.out, XC, modL}; pg8_gemm_res(lds, A3, (const bf16_t*)(ws + OFF_W2OUT), ML, 1024, 1024, ep); gemm64_res_phase(lds, A3, 1024, (const bf16_t*)(ws + OFF_W2OUT), 1024, ML, MC / 64, ep); }
  }
}

__global__ void __launch_bounds__(NTHR) mega_kernel(Params p) {
  __shared__ __attribute__((aligned(16))) char lds[LDS_BYTES];
  __shared__ u32x4 xb_words;
  cg::grid_group grid = cg::this_grid();
  if (threadIdx.x == 0) xb_words = (u32x4){0u, 0u, 0u, 0u};
  __syncthreads();
  const XcdBarrier xb = xcd_barrier_post((unsigned*)(p.ws + OFF_BAR), (volatile LAS unsigned*)&xb_words);
#define PHASE(k) if (p.ph_lo <= k && k < p.ph_hi) { for (int rep = 0; rep < REP[k]; ++rep) { run_phase<k>(p, lds, rep + 1 == REP[k]); if (rep + 1 < REP[k] || k + 1 < p.ph_hi) { if (k == 0) grid.sync(); else xcd_barrier(xb); } } }
  PHASE(0) PHASE(1) PHASE(2) PHASE(3) PHASE(4) PHASE(5) PHASE(6) PHASE(7) PHASE(8) PHASE(9) PHASE(10)
  PHASE(11) PHASE(12) PHASE(13) PHASE(14) PHASE(15) PHASE(16) PHASE(17) PHASE(18) PHASE(19) PHASE(20)
#undef PHASE
}

extern "C" void kernel_launch(void* const* d_in, const int* in_sizes, int n_in, void* d_out, int out_size, void* d_ws, size_t ws_size,
                              hipStream_t stream) {
  static int grid_blocks = 0;
  if (!grid_blocks) {
    int dev = 0, cus = 0, per_cu = 0;
    hipGetDevice(&dev);
    hipDeviceGetAttribute(&cus, hipDeviceAttributeMultiprocessorCount, dev);
    hipOccupancyMaxActiveBlocksPerMultiprocessor(&per_cu, mega_kernel, NTHR, 0);
    if (per_cu < 1) { fprintf(stderr, "occupancy query returned %d\n", per_cu); per_cu = 1; }
    if (per_cu > 1) per_cu = 1;
    grid_blocks = cus * per_cu;
    if (n_in != 45 || ws_size < WS_END) fprintf(stderr, "unexpected n_in %d / ws %zu (need %zu)\n", n_in, ws_size, (size_t)WS_END);
  }
  Params p{};
  for (int i = 0; i < 45; ++i) p.in[i] = (const float*)d_in[i];
  p.out = (float*)d_out;
  p.ws = (char*)d_ws;
  (void)hipMemsetAsync((char*)d_ws + OFF_BAR, 0, XCD_BAR_WORDS * 4, stream);
#if N_LAUNCH_MODE == 1
  p.ph_lo = 0; p.ph_hi = NPHASE;
  void* args[] = {&p};
  hipError_t e = hipLaunchCooperativeKernel((void*)mega_kernel, dim3(grid_blocks), dim3(NTHR), args, 0, stream);
  if (e != hipSuccess) fprintf(stderr, "cooperative launch failed: %s (grid %d)\n", hipGetErrorString(e), grid_blocks);
#else
  for (int ph = 0; ph < NPHASE; ++ph) {
    p.ph_lo = ph; p.ph_hi = ph + 1;
    hipLaunchKernelGGL(mega_kernel, dim3(grid_blocks), dim3(NTHR), 0, stream, p);
  }
#endif
}
```

```cpp
#include <hip/hip_runtime.h>
#include <hip/hip_cooperative_groups.h>
#include <cstdio>
#include <cstdint>
namespace cg = cooperative_groups;

#ifndef N_LAUNCH_MODE
#define N_LAUNCH_MODE 1
#endif

typedef unsigned short bf16_t;
typedef short bf16x8 __attribute__((ext_vector_type(8)));
typedef float f32x4 __attribute__((ext_vector_type(4)));
typedef float f32x16 __attribute__((ext_vector_type(16)));
typedef float f32x2 __attribute__((ext_vector_type(2)));
typedef unsigned u32x4 __attribute__((ext_vector_type(4)));
typedef unsigned u32x2 __attribute__((ext_vector_type(2)));

#define DEVI __device__ __forceinline__

constexpr int D = 1024, NB = 8, SEQ = 4096, CTX = 256;
constexpr int ML = NB * SEQ;
constexpr int MC = NB * CTX;
constexpr int MT = ML + MC;
constexpr int LW = 1408;
constexpr int NTHR = 512;
constexpr int NPHASE = 21;
constexpr int LDS_BYTES = 163840 - 16;
__device__ constexpr int REP[21] = {1,1,1,1,1,1,1,1,1,1,1,1,1,1,1,1,1,1,1,1,1};

constexpr size_t SZ_ACT = (size_t)MT * 1024 * 2;
constexpr size_t OFF_MOD = 0;
constexpr size_t OFF_BAR = 458752;
constexpr size_t OFF_W0IN = 524288;
constexpr size_t SZ_RWIN = (size_t)4352 * 1024 * 2;
constexpr size_t SZ_RWUP = (size_t)4 * 1024 * 64 * 2;
constexpr size_t SZ_SQ = (size_t)1024 * 1024 * 2;
constexpr size_t OFF_W0UP = OFF_W0IN + SZ_RWIN;
constexpr size_t OFF_W0OUT = OFF_W0UP + SZ_RWUP;
constexpr size_t OFF_W3IN = OFF_W0OUT + SZ_SQ;
constexpr size_t OFF_W3UP = OFF_W3IN + SZ_RWIN;
constexpr size_t OFF_W3OUT = OFF_W3UP + SZ_RWUP;
constexpr size_t OFF_W1IN = OFF_W3OUT + SZ_SQ;
constexpr size_t OFF_W1G = OFF_W1IN + (size_t)2816 * 1024 * 2;
constexpr size_t OFF_W1OUT = OFF_W1G + (size_t)16 * 4 * 96 * 96 * 2;
constexpr size_t OFF_W2IN = OFF_W1OUT + (size_t)1024 * 1408 * 2;
constexpr size_t OFF_W2OUT = OFF_W2IN + (size_t)4096 * 1024 * 2;
constexpr size_t OFF_XC = OFF_W2OUT + SZ_SQ;
constexpr size_t OFF_BON = OFF_XC + (size_t)MC * 1024 * 4;
constexpr size_t OFF_BIG = OFF_BON + (size_t)2 * MT * 16 * 4;
constexpr size_t OFF_HB = OFF_BIG;
constexpr size_t OFF_A0 = OFF_BIG + SZ_ACT;
constexpr size_t OFF_A1 = OFF_A0 + SZ_ACT;
constexpr size_t OFF_A2 = OFF_A1 + SZ_ACT;
constexpr size_t OFF_A3 = OFF_A2 + SZ_ACT;
constexpr size_t OFF_A4 = OFF_A3 + SZ_ACT;
constexpr size_t OFF_WD = OFF_A4 + SZ_ACT;
constexpr size_t OFF_AD = OFF_WD + (size_t)MT * 128 * 2;
constexpr size_t WS_END = OFF_AD + (size_t)MT * 128 * 2;
constexpr size_t SZ_LRU = (size_t)MT * LW * 2;
constexpr size_t OFF_HS0 = OFF_BIG;
constexpr size_t OFF_XR = OFF_BIG + SZ_LRU;
constexpr size_t OFF_GG = OFF_XR + SZ_LRU;
constexpr size_t OFF_HS1 = OFF_GG + SZ_LRU;
static_assert(OFF_HS1 + SZ_LRU <= WS_END, "lru overlay");
static_assert(WS_END <= (size_t)536870912, "ws");

struct Params {
  const float* in[45];
  float* out;
  char* ws;
  int ph_lo, ph_hi;
};

DEVI u32x4 mk4(unsigned a, unsigned b, unsigned c, unsigned d) { u32x4 r = {a, b, c, d}; return r; }
DEVI int opaque_tid() { int t = threadIdx.x; asm volatile("" : "+v"(t)); return t; }
DEVI float bf_lo(unsigned u) { return __uint_as_float(u << 16); }
DEVI float bf_hi(unsigned u) { return __uint_as_float(u & 0xffff0000u); }
DEVI float bf2f(bf16_t h) { return __uint_as_float(((unsigned)h) << 16); }
typedef __bf16 bf16x2_t __attribute__((ext_vector_type(2)));
DEVI unsigned pk_bf16(float lo, float hi) { f32x2 f = {lo, hi}; bf16x2_t v = __builtin_convertvector(f, bf16x2_t); return __builtin_bit_cast(unsigned, v); }
DEVI bf16_t f2bf(float f) { return (bf16_t)(pk_bf16(f, 0.f) & 0xffffu); }
DEVI float wave_sum(float v) {
#pragma unroll
  for (int o = 32; o; o >>= 1) v += __shfl_xor(v, o);
  return v;
}
DEVI float sigmoidf_(float x) { return __builtin_amdgcn_rcpf(1.f + __expf(-x)); }
DEVI float siluf_(float x) { return x * __builtin_amdgcn_rcpf(1.f + __expf(-x)); }
DEVI float softplusf_(float x) { return fmaxf(x, 0.f) + __logf(1.f + __expf(-fabsf(x))); }
DEVI f32x16 mfma32(u32x4 a, u32x4 b, f32x16 c) {
  return __builtin_amdgcn_mfma_f32_32x32x16_bf16(__builtin_bit_cast(bf16x8, a), __builtin_bit_cast(bf16x8, b), c, 0, 0, 0);
}
DEVI f32x4 mfma16(u32x4 a, u32x4 b, f32x4 c) {
  return __builtin_amdgcn_mfma_f32_16x16x32_bf16(__builtin_bit_cast(bf16x8, a), __builtin_bit_cast(bf16x8, b), c, 0, 0, 0);
}
template <int CTRL> DEVI float dpp_f(float v) {
  return __int_as_float(__builtin_amdgcn_update_dpp(0, __float_as_int(v), CTRL, 0xf, 0xf, true));
}
DEVI float sum8(float v) {
  v += dpp_f<0xB1>(v);
  v += dpp_f<0x4E>(v);
  v += dpp_f<0x141>(v);
  return v;
}

#define XB_TMO      128
#define XB_XCNT(j)  (256  + 64 * (j))
#define XB_XSUB(j)  (1280 + 64 * (j))
#define XB_XGEN(j)  (2304 + 64 * (j))
#define XB_TOP      3328
#define XB_TOPGEN   3392
#define XCD_BAR_WORDS 3456
#define XB_SPIN_CAP (1u << 18)
#define LAS __attribute__((address_space(3)))

__device__ __forceinline__ unsigned xb_ld(unsigned* p)              { return __hip_atomic_load(p, __ATOMIC_RELAXED, __HIP_MEMORY_SCOPE_AGENT); }
__device__ __forceinline__ unsigned xb_add(unsigned* p, unsigned v) { return __hip_atomic_fetch_add(p, v, __ATOMIC_RELAXED, __HIP_MEMORY_SCOPE_AGENT); }
__device__ __forceinline__ unsigned xb_xcc_id() { return (unsigned)__builtin_amdgcn_s_getreg((3 << 11) | 20) & 0xFu; }
#define XB_SPIN(cond, bar) do { unsigned _sp = 0; while (cond) { __builtin_amdgcn_s_sleep(1); \
    if ((++_sp & 255u) == 0u) { if (xb_ld(&(bar)[XB_TMO])) break; if (_sp > XB_SPIN_CAP) { atomicAdd(&(bar)[XB_TMO], 1u); break; } } } } while (0)

struct XcdBarrier {
    unsigned* bar; unsigned x;
    volatile LAS unsigned* st;
};

__device__ __forceinline__ XcdBarrier xcd_barrier_post(unsigned* bar, volatile LAS unsigned* st) {
    XcdBarrier b; b.bar = bar; b.x = xb_xcc_id(); b.st = st;
    if (threadIdx.x == 0) (void)xb_add(&bar[XB_XCNT(b.x)], 1u);
    return b;
}
__device__ __forceinline__ void xcd_barrier_complete(unsigned* bar, unsigned x, unsigned& nloc, unsigned& nx) {
    const unsigned G = gridDim.x * gridDim.y * gridDim.z;
    unsigned sum, cnt, mine, sp = 0u;
    for (;;) {
        sum = 0u; cnt = 0u; mine = 0u;
#pragma unroll
        for (unsigned j = 0; j < 16; ++j) { const unsigned c = xb_ld(&bar[XB_XCNT(j)]); sum += c; cnt += (c > 0u) ? 1u : 0u; mine = (j == x) ? c : mine; }
        if (sum == G) break;
        __builtin_amdgcn_s_sleep(1);
        if ((++sp & 255u) == 0u) { if (xb_ld(&bar[XB_TMO])) break; if (sp > XB_SPIN_CAP) { atomicAdd(&bar[XB_TMO], 1u); break; } }
    }
    nloc = mine > 0u ? mine : 1u; nx = cnt > 0u ? cnt : 1u;
}

__device__ __forceinline__ void xcd_barrier(const XcdBarrier& b) {
    asm volatile("s_waitcnt vmcnt(0)" ::: "memory");
    __syncthreads();
    if (threadIdx.x == 0) {
        unsigned* bar = b.bar;
        __builtin_amdgcn_s_waitcnt(0);
        unsigned nloc = b.st[0], nx = b.st[1];
        if (nloc == 0u) { xcd_barrier_complete(bar, b.x, nloc, nx); b.st[0] = nloc; b.st[1] = nx; }
        const unsigned old = xb_add(&bar[XB_XSUB(b.x)], 1u);
        const unsigned gen = old / nloc;
        if (old + 1u == (gen + 1u) * nloc) {
            __builtin_amdgcn_fence(__ATOMIC_RELEASE, "agent");
            asm volatile("s_waitcnt vmcnt(0)" ::: "memory");
            const unsigned og = xb_add(&bar[XB_TOP], 1u);
            const unsigned tg = og / nx;
            if (og + 1u == (tg + 1u) * nx) xb_add(&bar[XB_TOPGEN], 1u);
            else XB_SPIN(xb_ld(&bar[XB_TOPGEN]) == tg, bar);
            __builtin_amdgcn_fence(__ATOMIC_ACQUIRE, "agent");
            xb_add(&bar[XB_XGEN(b.x)], 1u);
            asm volatile("s_waitcnt vmcnt(0)" ::: "memory");
        } else {
            XB_SPIN(xb_ld(&bar[XB_XGEN(b.x)]) == gen, bar);
            __builtin_amdgcn_fence(__ATOMIC_ACQUIRE, "agent");
            asm volatile("s_waitcnt vmcnt(0)" ::: "memory");
        }
    }
    __syncthreads();
}


struct TJob { const float* src; int K, N; bf16_t* dst; int ldd; };

DEVI TJob get_tjob(const Params& p, int j) {
  TJob t;
  if (j < 26) {
    const int l = j / 13, jj = j % 13;
    const int ib = l ? 33 : 4;
    bf16_t* win = (bf16_t*)(p.ws + (l ? OFF_W3IN : OFF_W0IN));
    bf16_t* wup = (bf16_t*)(p.ws + (l ? OFF_W3UP : OFF_W0UP));
    bf16_t* wout = (bf16_t*)(p.ws + (l ? OFF_W3OUT : OFF_W0OUT));
    if (jj < 4) { t.src = p.in[ib + 3] + (size_t)jj * 1048576; t.K = 1024; t.N = 1024; t.dst = win + (size_t)jj * 1048576; t.ldd = 1024; }
    else if (jj < 8) { const int idx = jj - 4, d = idx >> 1, kind = idx & 1;
      t.src = p.in[ib + 6] + (size_t)idx * 65536; t.K = 1024; t.N = 64; t.dst = win + (size_t)(4096 + kind * 128 + d * 64) * 1024; t.ldd = 1024; }
    else if (jj < 12) { const int idx = jj - 8;
      t.src = p.in[ib + 7] + (size_t)idx * 65536; t.K = 64; t.N = 1024; t.dst = wup + (size_t)idx * 65536; t.ldd = 64; }
    else { t.src = p.in[ib + 11]; t.K = 1024; t.N = 1024; t.dst = wout; t.ldd = 1024; }
  } else if (j == 26) { t.src = p.in[19]; t.K = 1024; t.N = 2816; t.dst = (bf16_t*)(p.ws + OFF_W1IN); t.ldd = 1024; }
  else if (j == 27) { t.src = p.in[25]; t.K = 1408; t.N = 1024; t.dst = (bf16_t*)(p.ws + OFF_W1OUT); t.ldd = 1408; }
  else if (j == 28) { t.src = p.in[29]; t.K = 1024; t.N = 4096; t.dst = (bf16_t*)(p.ws + OFF_W2IN); t.ldd = 1024; }
  else { t.src = p.in[32]; t.K = 1024; t.N = 1024; t.dst = (bf16_t*)(p.ws + OFF_W2OUT); t.ldd = 1024; }
  return t;
}

__device__ __forceinline__ void phase0(const Params& p, char* lds) {
  const int tid = opaque_tid();
  {
    bf16_t* wg = (bf16_t*)(p.ws + OFF_W1G);
    const float* gw = p.in[22];
    const int total = 16 * 4 * 96 * 96;
    for (int e = blockIdx.x * NTHR + tid; e < total; e += gridDim.x * NTHR) {
      const int k = e % 96, n = (e / 96) % 96, dg = (e / 9216) & 3, blk = e / 36864;
      float v = 0.f;
      if (k < 88 && n < 88) v = gw[((size_t)(dg * 16 + blk) * 88 + k) * 88 + n];
      wg[e] = f2bf(v);
    }
  }
  constexpr int N_MOD_ITEMS = 96;
  constexpr int N_TILES = 5152;
  float* act = (float*)lds;
  float* red = (float*)(lds + 36864);
  float* tl = (float*)lds;
  for (int item = blockIdx.x; item < N_MOD_ITEMS; item += gridDim.x) {
    __syncthreads();
    {
      const int L = item / 24, nc = item % 24;
      const int ib = (L == 0) ? 4 : (L == 1) ? 16 : (L == 2) ? 26 : 33;
      const float* ada_w = p.in[ib + 1];
      const float* ada_b = p.in[ib + 2];
      for (int e = tid; e < 9 * 1024; e += NTHR) {
        const int i = e >> 10, k = e & 1023;
        const float c = (i < 8) ? p.in[1][i * 1024 + k] : p.in[3][k];
        act[e] = siluf_(c);
      }
      __syncthreads();
      const int kq = tid >> 7, nl = tid & 127, n = nc * 128 + nl;
      float acc[9];
#pragma unroll
      for (int i = 0; i < 9; ++i) acc[i] = 0.f;
      for (int k0 = kq * 256; k0 < kq * 256 + 256; k0 += 16) {
        float w[16];
#pragma unroll
        for (int u = 0; u < 16; ++u) w[u] = ada_w[(size_t)(k0 + u) * 3072 + n];
#pragma unroll
        for (int u = 0; u < 16; ++u)
#pragma unroll
          for (int i = 0; i < 9; ++i) acc[i] += act[i * 1024 + k0 + u] * w[u];
      }
#pragma unroll
      for (int i = 0; i < 9; ++i) red[(kq * 9 + i) * 128 + nl] = acc[i];
      __syncthreads();
      float* mod = (float*)(p.ws + OFF_MOD) + (size_t)L * 9 * 3072;
      for (int e = tid; e < 9 * 128; e += NTHR) {
        const int i = e >> 7, c = e & 127;
        const float s = red[(0 * 9 + i) * 128 + c] + red[(1 * 9 + i) * 128 + c] + red[(2 * 9 + i) * 128 + c] + red[(3 * 9 + i) * 128 + c];
        mod[i * 3072 + nc * 128 + c] = s + ada_b[nc * 128 + c];
      }
    }
  }
  {
    struct TileRef { const float* src; bf16_t* dst; int N, ldd, k0, n0; };
    auto decode = [&](int t, TileRef& r) {
      int j = 0;
      TJob job = get_tjob(p, 0);
      for (;;) {
        const int nt = (job.K >> 6) * (job.N >> 6);
        if (t < nt) break;
        t -= nt; ++j; job = get_tjob(p, j);
      }
      const int ntn = job.N >> 6;
      r.src = job.src; r.dst = job.dst; r.N = job.N; r.ldd = job.ldd; r.k0 = (t / ntn) * 64; r.n0 = (t % ntn) * 64;
    };
    const int kk = tid >> 4, n4 = (tid & 15) * 4;
    int t = (int)(gridDim.x - 1 - blockIdx.x);
    TileRef cur, nxt;
    float4 v0 = make_float4(0.f, 0.f, 0.f, 0.f), v1 = v0;
    if (t < N_TILES) {
      decode(t, cur);
      v0 = *(const float4*)(cur.src + (size_t)(cur.k0 + kk) * cur.N + cur.n0 + n4);
      v1 = *(const float4*)(cur.src + (size_t)(cur.k0 + kk + 32) * cur.N + cur.n0 + n4);
    }
    while (t < N_TILES) {
      const int tn = t + (int)gridDim.x;
      float4 w0 = v0, w1 = v1;
      if (tn < N_TILES) {
        decode(tn, nxt);
        w0 = *(const float4*)(nxt.src + (size_t)(nxt.k0 + kk) * nxt.N + nxt.n0 + n4);
        w1 = *(const float4*)(nxt.src + (size_t)(nxt.k0 + kk + 32) * nxt.N + nxt.n0 + n4);
      }
      __builtin_amdgcn_sched_barrier(0);
      __syncthreads();
      tl[kk * 65 + n4 + 0] = v0.x; tl[kk * 65 + n4 + 1] = v0.y; tl[kk * 65 + n4 + 2] = v0.z; tl[kk * 65 + n4 + 3] = v0.w;
      tl[(kk + 32) * 65 + n4 + 0] = v1.x; tl[(kk + 32) * 65 + n4 + 1] = v1.y; tl[(kk + 32) * 65 + n4 + 2] = v1.z; tl[(kk + 32) * 65 + n4 + 3] = v1.w;
      __syncthreads();
      const int n = tid >> 3, k8 = (tid & 7) * 8;
      u32x4 o;
      o.x = pk_bf16(tl[(k8 + 0) * 65 + n], tl[(k8 + 1) * 65 + n]);
      o.y = pk_bf16(tl[(k8 + 2) * 65 + n], tl[(k8 + 3) * 65 + n]);
      o.z = pk_bf16(tl[(k8 + 4) * 65 + n], tl[(k8 + 5) * 65 + n]);
      o.w = pk_bf16(tl[(k8 + 6) * 65 + n], tl[(k8 + 7) * 65 + n]);
      *(u32x4*)(cur.dst + (size_t)(cur.n0 + n) * cur.ldd + cur.k0 + k8) = o;
      v0 = w0; v1 = w1; cur = nxt; t = tn;
    }
  }
}

DEVI void norm_row(const float* __restrict__ xr, const float* __restrict__ g, const float* __restrict__ mod, int lane, float (&h)[16]) {
  float4 x[4];
  float ss = 0.f;
#pragma unroll
  for (int i = 0; i < 4; ++i) {
    x[i] = *(const float4*)(xr + lane * 4 + 256 * i);
    ss += x[i].x * x[i].x + x[i].y * x[i].y + x[i].z * x[i].z + x[i].w * x[i].w;
  }
  ss = wave_sum(ss);
  const float rstd = rsqrtf(ss * (1.f / 1024.f) + 1e-6f);
#pragma unroll
  for (int i = 0; i < 4; ++i) {
    const int c = lane * 4 + 256 * i;
    const float4 gg = *(const float4*)(g + c);
    const float4 sh = *(const float4*)(mod + c);
    const float4 sc = *(const float4*)(mod + 1024 + c);
    h[i * 4 + 0] = x[i].x * rstd * gg.x * (1.f + sc.x) + sh.x;
    h[i * 4 + 1] = x[i].y * rstd * gg.y * (1.f + sc.y) + sh.y;
    h[i * 4 + 2] = x[i].z * rstd * gg.z * (1.f + sc.z) + sh.z;
    h[i * 4 + 3] = x[i].w * rstd * gg.w * (1.f + sc.w) + sh.w;
  }
}

template <bool WITH_HS>
__device__ __forceinline__ void norm_phase(const float* __restrict__ xl, const float* __restrict__ xc, const float* __restrict__ g,
                           const float* __restrict__ modL, bf16_t* __restrict__ H, bf16_t* __restrict__ HS) {
  const int tidx = opaque_tid();
  const int lane = tidx & 63;
  const int gw = blockIdx.x * (NTHR / 64) + (tidx >> 6), nw = gridDim.x * (NTHR / 64);
  for (int row = gw; row < MT; row += nw) {
    const bool lat = row < ML;
    const float* xbase = lat ? xl + (size_t)row * 1024 : xc + (size_t)(row - ML) * 1024;
    const float* mod = modL + (lat ? (row >> 12) : 8) * 3072;
    float h[16];
    norm_row(xbase, g, mod, lane, h);
#pragma unroll
    for (int i = 0; i < 4; ++i) {
      u32x2 o; o.x = pk_bf16(h[i * 4], h[i * 4 + 1]); o.y = pk_bf16(h[i * 4 + 2], h[i * 4 + 3]);
      *(u32x2*)(H + (size_t)row * 1024 + lane * 4 + 256 * i) = o;
    }
    if (WITH_HS) {
      const int t = lat ? (row & 4095) : ((row - ML) & 255);
      const int T = lat ? 4096 : 256;
      float s[16];
#pragma unroll
      for (int i = 0; i < 16; ++i) s[i] = 0.f;
      if (t > 0) { float hp[16]; norm_row(xbase - 1024, g, mod, lane, hp);
#pragma unroll
        for (int i = 0; i < 16; ++i) s[i] += hp[i]; }
      if (t < T - 1) { float hn[16]; norm_row(xbase + 1024, g, mod, lane, hn);
#pragma unroll
        for (int i = 0; i < 16; ++i) s[i] += hn[i]; }
#pragma unroll
      for (int i = 0; i < 4; ++i) {
        u32x2 o; o.x = pk_bf16(0.5f * s[i * 4], 0.5f * s[i * 4 + 1]); o.y = pk_bf16(0.5f * s[i * 4 + 2], 0.5f * s[i * 4 + 3]);
        *(u32x2*)(HS + (size_t)row * 1024 + lane * 4 + 256 * i) = o;
      }
    }
  }
}

struct ALPlain {
  const bf16_t* A; int lda;
  typedef u32x4 Regs;
  DEVI void stage(float*, int) const {}
  DEVI void issue(Regs& r, int row, int k) const { r = *(const u32x4*)(A + (size_t)row * lda + k); }
  DEVI u32x4 finish(const Regs& r, const float*, int) const { return r; }
};
struct ALMix {
  const bf16_t* H; const bf16_t* HS; const float* mu;
  struct Regs { u32x4 h, s; };
  DEVI void stage(float* sMu, int n0) const {
    const int grp = n0 >> 10;
    const int j = grp == 0 ? 0 : grp == 1 ? 2 : grp == 2 ? 3 : grp == 3 ? 5 : (n0 - 4096) < 128 ? 1 : 4;
    for (int e = threadIdx.x; e < 1024; e += NTHR) sMu[e] = mu[j * 1024 + e];
  }
  DEVI void issue(Regs& r, int row, int k) const {
    r.h = *(const u32x4*)(H + (size_t)row * 1024 + k);
    r.s = *(const u32x4*)(HS + (size_t)row * 1024 + k);
  }
  DEVI unsigned mix2(unsigned h, unsigned s, float m0, float m1) const {
    const float h0 = bf_lo(h), h1 = bf_hi(h), s0 = bf_lo(s), s1 = bf_hi(s);
    return pk_bf16(h0 + (s0 - h0) * m0, h1 + (s1 - h1) * m1);
  }
  DEVI u32x4 finish(const Regs& r, const float* sMu, int k) const {
    const float4 ma = *(const float4*)(sMu + k), mb = *(const float4*)(sMu + k + 4);
    u32x4 o;
    o.x = mix2(r.h.x, r.s.x, ma.x, ma.y); o.y = mix2(r.h.y, r.s.y, ma.z, ma.w);
    o.z = mix2(r.h.z, r.s.z, mb.x, mb.y); o.w = mix2(r.h.w, r.s.w, mb.z, mb.w);
    return o;
  }
};

template <class AL, class EP>
__device__ __forceinline__ void gemm_phase(char* lds, const bf16_t* __restrict__ Bt, int K, int mtiles, int ntiles, const AL al, const EP ep, int n_base = 0, bool reverse = false, int mt_base = 0) {
  bf16_t* sA = (bf16_t*)lds;
  bf16_t* sB = (bf16_t*)(lds + 73728);
  float* sMu = (float*)(lds + 110592);
  const int tid = opaque_tid(), lane = tid & 63, wv = tid >> 6, wm = wv >> 1, wn = wv & 1;
  const int l31 = lane & 31, lh = lane >> 5;
  const int nk = K >> 6;
  const int ldrow = tid >> 3, ldk = (tid & 7) * 8;
  const int total = mtiles * ntiles;
  const int bid = reverse ? (int)(gridDim.x - 1 - blockIdx.x) : (int)blockIdx.x;
  const int nslots = gridDim.x >> 3, xcd = bid & 7, slot = bid >> 3;
  const int gm = 4 * ntiles;
  for (int chunk = xcd; chunk * nslots < total; chunk += 8) {
    const int tile = chunk * nslots + slot;
    if (tile >= total) break;
    const int grp = tile / gm, rem = tile - grp * gm;
    const int mt = grp * 4 + (rem & 3), nt = rem >> 2;
    const int m0 = (mt_base + mt) * 256, n0 = n_base + nt * 128;
    __syncthreads();
    al.stage(sMu, n0);
    f32x16 acc[2][2];
#pragma unroll
    for (int a = 0; a < 2; ++a)
#pragma unroll
      for (int b = 0; b < 2; ++b)
#pragma unroll
        for (int r = 0; r < 16; ++r) acc[a][b][r] = 0.f;
    typename AL::Regs ar[4];
    u32x4 br[2];
#pragma unroll
    for (int i = 0; i < 4; ++i) al.issue(ar[i], m0 + ldrow + 64 * i, ldk);
#pragma unroll
    for (int i = 0; i < 2; ++i) br[i] = *(const u32x4*)(Bt + (size_t)(n0 + ldrow + 64 * i) * K + ldk);
    __syncthreads();
#pragma unroll
    for (int i = 0; i < 4; ++i) *(u32x4*)(sA + (ldrow + 64 * i) * 72 + ldk) = al.finish(ar[i], sMu, ldk);
#pragma unroll
    for (int i = 0; i < 2; ++i) *(u32x4*)(sB + (ldrow + 64 * i) * 72 + ldk) = br[i];
    __syncthreads();
    for (int kt = 0; kt < nk; ++kt) {
      const int cur = kt & 1;
      const bool more = (kt + 1) < nk;
      const int k0n = (kt + 1) * 64 + ldk;
      if (more) {
#pragma unroll
        for (int i = 0; i < 4; ++i) al.issue(ar[i], m0 + ldrow + 64 * i, k0n);
#pragma unroll
        for (int i = 0; i < 2; ++i) br[i] = *(const u32x4*)(Bt + (size_t)(n0 + ldrow + 64 * i) * K + k0n);
      }
      __builtin_amdgcn_sched_barrier(0);
      const bf16_t* a_ = sA + cur * (256 * 72);
      const bf16_t* b_ = sB + cur * (128 * 72);
#pragma unroll
      for (int kk = 0; kk < 4; ++kk) {
        u32x4 af[2], bfr[2];
#pragma unroll
        for (int mi = 0; mi < 2; ++mi) af[mi] = *(const u32x4*)(a_ + (wm * 64 + mi * 32 + l31) * 72 + kk * 16 + lh * 8);
#pragma unroll
        for (int ni = 0; ni < 2; ++ni) bfr[ni] = *(const u32x4*)(b_ + (wn * 64 + ni * 32 + l31) * 72 + kk * 16 + lh * 8);
#pragma unroll
        for (int mi = 0; mi < 2; ++mi)
#pragma unroll
          for (int ni = 0; ni < 2; ++ni) acc[mi][ni] = mfma32(bfr[ni], af[mi], acc[mi][ni]);
      }
      __builtin_amdgcn_sched_barrier(0);
      if (more) {
        bf16_t* an = sA + (cur ^ 1) * (256 * 72);
        bf16_t* bn = sB + (cur ^ 1) * (128 * 72);
#pragma unroll
        for (int i = 0; i < 4; ++i) *(u32x4*)(an + (ldrow + 64 * i) * 72 + ldk) = al.finish(ar[i], sMu, k0n);
#pragma unroll
        for (int i = 0; i < 2; ++i) *(u32x4*)(bn + (ldrow + 64 * i) * 72 + ldk) = br[i];
      }
      __syncthreads();
    }
#pragma unroll
    for (int mi = 0; mi < 2; ++mi)
#pragma unroll
      for (int ni = 0; ni < 2; ++ni)
#pragma unroll
        for (int q = 0; q < 4; ++q) {
          const int row = m0 + wm * 64 + mi * 32 + l31;
          const int col = n0 + wn * 64 + ni * 32 + 8 * q + 4 * lh;
          f32x4 v = {acc[mi][ni][4 * q], acc[mi][ni][4 * q + 1], acc[mi][ni][4 * q + 2], acc[mi][ni][4 * q + 3]};
          ep(row, col, v);
        }
  }
}


template <class AL, class EP>
__device__ __forceinline__ void gemm256_phase(char* lds, const bf16_t* __restrict__ Bt, int K, int mtiles, int ntiles, const AL al, const EP ep) {
  bf16_t* sA = (bf16_t*)lds;
  bf16_t* sB = (bf16_t*)(lds + 73728);
  float* sMu = (float*)(lds + 147456);
  const int tid = opaque_tid(), lane = tid & 63, wv = tid >> 6, wm = wv >> 1, wn = wv & 1;
  const int l31 = lane & 31, lh = lane >> 5;
  const int nk = K >> 6;
  const int ldrow = tid >> 3, ldk = (tid & 7) * 8;
  const int total = mtiles * ntiles;
  const int nslots = gridDim.x >> 3, xcd = blockIdx.x & 7, slot = blockIdx.x >> 3;
  const int gm = 4 * ntiles;
  for (int chunk = xcd; chunk * nslots < total; chunk += 8) {
    const int tile = chunk * nslots + slot;
    if (tile >= total) break;
    const int grp = tile / gm, rem = tile - grp * gm;
    const int mt = grp * 4 + (rem & 3), nt = rem >> 2;
    const int m0 = mt * 256, n0 = nt * 256;
    __syncthreads();
    al.stage(sMu, n0);
    f32x16 acc[2][4];
#pragma unroll
    for (int a = 0; a < 2; ++a)
#pragma unroll
      for (int b = 0; b < 4; ++b)
#pragma unroll
        for (int r = 0; r < 16; ++r) acc[a][b][r] = 0.f;
    typename AL::Regs ar[4];
    u32x4 br[4];
#pragma unroll
    for (int i = 0; i < 4; ++i) al.issue(ar[i], m0 + ldrow + 64 * i, ldk);
#pragma unroll
    for (int i = 0; i < 4; ++i) br[i] = *(const u32x4*)(Bt + (size_t)(n0 + ldrow + 64 * i) * K + ldk);
    __syncthreads();
#pragma unroll
    for (int i = 0; i < 4; ++i) *(u32x4*)(sA + (ldrow + 64 * i) * 72 + ldk) = al.finish(ar[i], sMu, ldk);
#pragma unroll
    for (int i = 0; i < 4; ++i) *(u32x4*)(sB + (ldrow + 64 * i) * 72 + ldk) = br[i];
    __syncthreads();
    const int half = __builtin_amdgcn_readfirstlane(wv >> 2);
    if (half == 1 && nk > 1) {
#pragma unroll
      for (int i = 0; i < 4; ++i) al.issue(ar[i], m0 + ldrow + 64 * i, 64 + ldk);
#pragma unroll
      for (int i = 0; i < 4; ++i) br[i] = *(const u32x4*)(Bt + (size_t)(n0 + ldrow + 64 * i) * K + 64 + ldk);
    }
    for (int step = 0; step < 2 * nk; ++step) {
      const int kc = step >> 1;
      if ((step & 1) == half) {
        const int kl = kc + 1 + half;
        if (kl < nk) {
          const int k0n = kl * 64 + ldk;
#pragma unroll
          for (int i = 0; i < 4; ++i) al.issue(ar[i], m0 + ldrow + 64 * i, k0n);
#pragma unroll
          for (int i = 0; i < 4; ++i) br[i] = *(const u32x4*)(Bt + (size_t)(n0 + ldrow + 64 * i) * K + k0n);
        }
        __builtin_amdgcn_sched_barrier(0);
        const bf16_t* a_ = sA + (kc & 1) * (256 * 72);
        const bf16_t* b_ = sB + (kc & 1) * (256 * 72);
#pragma unroll
        for (int kk = 0; kk < 4; ++kk) {
          u32x4 af[2];
#pragma unroll
          for (int mi = 0; mi < 2; ++mi) af[mi] = *(const u32x4*)(a_ + (wm * 64 + mi * 32 + l31) * 72 + kk * 16 + lh * 8);
#pragma unroll
          for (int ni = 0; ni < 4; ++ni) {
            const u32x4 bfr = *(const u32x4*)(b_ + (wn * 128 + ni * 32 + l31) * 72 + kk * 16 + lh * 8);
#pragma unroll
            for (int mi = 0; mi < 2; ++mi) acc[mi][ni] = mfma32(bfr, af[mi], acc[mi][ni]);
          }
        }
        __builtin_amdgcn_sched_barrier(0);
      } else {
        const int kf = kc + 1;
        if (kf < nk) {
          bf16_t* an = sA + (kf & 1) * (256 * 72);
          bf16_t* bn = sB + (kf & 1) * (256 * 72);
          const int k0n = kf * 64 + ldk;
#pragma unroll
          for (int i = 0; i < 4; ++i) *(u32x4*)(an + (ldrow + 64 * i) * 72 + ldk) = al.finish(ar[i], sMu, k0n);
#pragma unroll
          for (int i = 0; i < 4; ++i) *(u32x4*)(bn + (ldrow + 64 * i) * 72 + ldk) = br[i];
        }
      }
      __syncthreads();
    }
    if constexpr (EP::VIA_LDS) {
      float* reg = (float*)(lds + wv * 16896);
#pragma unroll
      for (int mi = 0; mi < 2; ++mi) {
#pragma unroll
        for (int ni = 0; ni < 4; ++ni)
#pragma unroll
          for (int q = 0; q < 4; ++q) {
            f32x4 v = {acc[mi][ni][4 * q], acc[mi][ni][4 * q + 1], acc[mi][ni][4 * q + 2], acc[mi][ni][4 * q + 3]};
            *(f32x4*)(reg + l31 * 132 + ni * 32 + 8 * q + 4 * lh) = v;
          }
#pragma unroll 4
        for (int it = 0; it < 16; ++it) {
          const int rl = it * 2 + lh;
          const f32x4 v = *(const f32x4*)(reg + rl * 132 + l31 * 4);
          ep(m0 + wm * 64 + mi * 32 + rl, n0 + wn * 128 + l31 * 4, v);
        }
      }
    } else
#pragma unroll
    for (int mi = 0; mi < 2; ++mi)
#pragma unroll
      for (int ni = 0; ni < 4; ++ni) {
#pragma unroll
        for (int q = 0; q < 4; ++q) {
          const int row = m0 + wm * 64 + mi * 32 + l31;
          const int col = n0 + wn * 128 + ni * 32 + 8 * q + 4 * lh;
          f32x4 v = {acc[mi][ni][4 * q], acc[mi][ni][4 * q + 1], acc[mi][ni][4 * q + 2], acc[mi][ni][4 * q + 3]};
          ep(row, col, v);
        }
        __builtin_amdgcn_sched_barrier(0);
      }
  }
}

DEVI void st_bf16x4(bf16_t* p, f32x4 v) { u32x2 o; o.x = pk_bf16(v[0], v[1]); o.y = pk_bf16(v[2], v[3]); *(u32x2*)p = o; }

struct EpRwkvIn {
  static constexpr bool VIA_LDS = false;
  bf16_t *R, *K, *V, *G, *WD, *AD;
  DEVI void operator()(int row, int col, f32x4 v) const {
    const int grp = col >> 10;
    if (grp < 4) {
      const int c = col & 1023;
      bf16_t* dst = grp == 0 ? R : grp == 1 ? K : grp == 2 ? V : G;
      if (grp == 3) { v[0] = siluf_(v[0]); v[1] = siluf_(v[1]); v[2] = siluf_(v[2]); v[3] = siluf_(v[3]); }
      st_bf16x4(dst + (size_t)row * 1024 + c, v);
    } else {
      const int c = col - 4096;
      if (c < 128) {
#pragma unroll
        for (int i = 0; i < 4; ++i) { const float t = __expf(2.f * v[i]); v[i] = 1.f - 2.f / (t + 1.f); }
        st_bf16x4(WD + (size_t)row * 128 + c, v);
      } else st_bf16x4(AD + (size_t)row * 128 + (c - 128), v);
    }
  }
};
struct EpRes {
  static constexpr bool VIA_LDS = false;
  const float* xl_src; const float* xc_src; float* xl_dst; float* xc_dst; const float* modL;
  DEVI void operator()(int row, int col, f32x4 v) const {
    const bool lat = row < ML;
    const size_t off = lat ? (size_t)row * 1024 + col : (size_t)(row - ML) * 1024 + col;
    const float* src = (lat ? xl_src : xc_src) + off;
    float* dst = (lat ? xl_dst : xc_dst) + off;
    const f32x4 g = *(const f32x4*)(modL + (lat ? (row >> 12) : 8) * 3072 + 2048 + col);
    f32x4 x = *(const f32x4*)src;
    x += g * v;
    *(f32x4*)dst = x;
  }
};
struct EpLruIn {
  static constexpr bool VIA_LDS = false;
  bf16_t *XR, *GG;
  DEVI void operator()(int row, int col, f32x4 v) const {
    if (col < LW) st_bf16x4(XR + (size_t)row * LW + col, v);
    else { v[0] = siluf_(v[0]); v[1] = siluf_(v[1]); v[2] = siluf_(v[2]); v[3] = siluf_(v[3]); st_bf16x4(GG + (size_t)row * LW + (col - LW), v); }
  }
};
struct EpNatIn {
  static constexpr bool VIA_LDS = false;
  bf16_t *Q, *K, *VT, *G;
  DEVI void operator()(int row, int col, f32x4 v) const {
    const int grp = col >> 10, c = col & 1023;
    if (grp == 0) st_bf16x4(Q + (size_t)row * 1024 + c, v);
    else if (grp == 1) st_bf16x4(K + (size_t)row * 1024 + c, v);
    else if (grp == 3) { v[0] = siluf_(v[0]); v[1] = siluf_(v[1]); v[2] = siluf_(v[2]); v[3] = siluf_(v[3]); st_bf16x4(G + (size_t)row * 1024 + c, v); }
    else {
      unsigned idx, T;
      if (row < ML) { const unsigned b = row >> 12, t = row & 4095; T = 4096u; idx = ((b * 1024u + (unsigned)c) << 12) + t; }
      else { const unsigned r2 = row - ML; const unsigned b = r2 >> 8, t = r2 & 255; T = 256u; idx = (unsigned)ML * 1024u + ((b * 1024u + (unsigned)c) << 8) + t; }
#pragma unroll
      for (int i = 0; i < 4; ++i) VT[idx + (unsigned)i * T] = f2bf(v[i]);
    }
  }
};

DEVI int rwkv_row(int b, int d, int s) {
  if (s < 256) return ML + b * 256 + (d ? 255 - s : s);
  const int t = s - 256;
  return b * 4096 + (d ? 4095 - t : t);
}

constexpr int PSTR = 456, PREC_Y = 64, PREC_V0 = 192, PREC_V1 = 256, PREC_SC = 320, PREC_BF = 328;
constexpr int TSTR = 388;
struct ScanRec { u32x4 a1, a2; float v0, v1; f32x4 s0, s1; f32x4 ww[4]; u32x2 y[4]; };
DEVI void scan_load(ScanRec& R, const float* rec, int g, int c16, int role_off, int srow) {
  const char* ab = (const char*)(rec + PREC_BF) + role_off + g * 16;
  R.a1 = *(const u32x4*)ab; R.a2 = *(const u32x4*)(ab + 64);
  R.v0 = rec[PREC_V0 + srow]; R.v1 = rec[PREC_V1 + srow];
  R.s0 = *(const f32x4*)(rec + PREC_SC); R.s1 = *(const f32x4*)(rec + PREC_SC + 4);
#pragma unroll
  for (int nt = 0; nt < 4; ++nt) {
    R.ww[nt] = *(const f32x4*)(rec + 16 * nt + 4 * g);
    R.y[nt] = *(const u32x2*)((const char*)(rec + PREC_Y) + (16 * nt + c16) * 8);
  }
}
DEVI void scan_step2(f32x4 (&S)[4], const ScanRec& R, bool g0, float* yout) {
  const u32x4 b1 = mk4(pk_bf16(S[0][0], S[0][1]), pk_bf16(S[0][2], S[0][3]), pk_bf16(S[1][0], S[1][1]), pk_bf16(S[1][2], S[1][3]));
  const u32x4 b2 = mk4(pk_bf16(S[2][0], S[2][1]), pk_bf16(S[2][2], S[2][3]), pk_bf16(S[3][0], S[3][1]), pk_bf16(S[3][2], S[3][3]));
  f32x4 D = {0.f, 0.f, 0.f, 0.f};
  D = mfma16(R.a1, b1, D);
  D = mfma16(R.a2, b2, D);
  const float v0 = R.v0, v1 = R.v1;
  const float sa0 = D[0];
  const float sa1 = D[2] + sa0 * R.s0[2] + v0 * R.s0[3];
  const unsigned x0 = pk_bf16(sa0, v0), x1 = pk_bf16(sa1, v1);
  const u32x4 xb = mk4(g0 ? x0 : 0u, g0 ? x1 : 0u, 0u, 0u);
#pragma unroll
  for (int nt = 0; nt < 4; ++nt) S[nt] = mfma16(mk4(R.y[nt].x, R.y[nt].y, 0u, 0u), xb, S[nt] * R.ww[nt]);
  yout[0] = D[1] + sa0 * R.s0[0] + v0 * R.s0[1];
  yout[256] = D[3] + sa0 * R.s1[0] + v0 * R.s1[1] + sa1 * R.s1[2] + v1 * R.s1[3];
}
DEVI float sum16(float v) { v = sum8(v); v += dpp_f<0x140>(v); return v; }

__device__ __forceinline__ void rwkv_scan_phase(char* lds, const bf16_t* __restrict__ R, const bf16_t* __restrict__ Kb, const bf16_t* __restrict__ V,
                                const bf16_t* __restrict__ WD, const bf16_t* __restrict__ AD, const bf16_t* __restrict__ Wup,
                                const float* __restrict__ b0, const float* __restrict__ k_ka, const float* __restrict__ r_k,
                                bf16_t* __restrict__ Y0, bf16_t* __restrict__ Y1, float* __restrict__ BON) {
  float* stepbuf = (float*)lds;
  float* tokbuf = stepbuf + 2 * 8 * PSTR;
  float* wabuf = tokbuf + 2 * 16 * TSTR;
  float* ybuf = wabuf + 4096;
  const int tid = opaque_tid(), lane = tid & 63, wv = tid >> 6;
  constexpr int NCH = (256 + 4096) / 16;
  for (int chain = blockIdx.x; chain < 256; chain += gridDim.x) {
    const int d = chain & 1, h = (chain >> 1) & 15, b = chain >> 5;
    __syncthreads();
    if (wv < 4) {
      const int kq = lane >> 4, c16 = lane & 15, srow = wv * 16 + c16;
      const int role_off = (lane & 3) * 128;
      const bool g0 = kq == 0;
      f32x4 S[4];
#pragma unroll
      for (int j = 0; j < 4; ++j) S[j] = (f32x4){0.f, 0.f, 0.f, 0.f};
      __syncthreads();
      __syncthreads();
      __syncthreads();
      for (int c = 0; c < NCH; ++c) {
        const float* sb = stepbuf + (c & 1) * 8 * PSTR;
        float* yb = ybuf + (c & 1) * 4096 + kq * 64 + srow;
        ScanRec ra, rb;
        scan_load(ra, sb, kq, c16, role_off, srow);
#pragma unroll
        for (int i = 0; i < 4; i += 2) {
          scan_load(rb, sb + (i + 1) * PSTR, kq, c16, role_off, srow);
          scan_step2(S, ra, g0, yb + i * 512);
          scan_load(ra, sb + (i + 2) * PSTR, kq, c16, role_off, srow);
          scan_step2(S, rb, g0, yb + (i + 1) * 512);
        }
#pragma unroll
        for (int i = 4; i < 8; i += 2) {
          scan_load(rb, sb + (i + 1) * PSTR, kq, c16, role_off, srow);
          scan_step2(S, ra, g0, yb + i * 512);
          if (i + 2 < 8) scan_load(ra, sb + (i + 2) * PSTR, kq, c16, role_off, srow);
          scan_step2(S, rb, g0, yb + (i + 1) * 512);
        }
        __syncthreads();
      }
    } else {
      const int ptid = tid - 256, pw = wv - 4;
      bf16_t* Y = d ? Y1 : Y0;
      const int ncol = h * 64 + pw * 16 + (lane & 15);
      u32x4 bu[2][2];
      float bias_u[2];
#pragma unroll
      for (int kind = 0; kind < 2; ++kind) {
        const bf16_t* wu = Wup + ((size_t)(d * 2 + kind) * 1024 + ncol) * 64 + 8 * (lane >> 4);
        bu[kind][0] = *(const u32x4*)wu; bu[kind][1] = *(const u32x4*)(wu + 32);
        bias_u[kind] = b0[(d * 2 + kind) * 1024 + ncol];
      }
      const int ti = ptid >> 4, dq = ptid & 15;
      const int hc = h * 64 + 4 * dq;
      const f32x4 kkv = *(const f32x4*)(k_ka + hc), kav = *(const f32x4*)(k_ka + 1024 + hc), rkv = *(const f32x4*)(r_k + hc);
      u32x4 xw0, xw1, xa0, xa1; u32x2 rr, kr, vr;
      auto issueL = [&](int c) {
        const int rowA = rwkv_row(b, d, c * 16 + (lane & 15));
        const bf16_t* xp = WD + (size_t)rowA * 128 + d * 64 + 8 * (lane >> 4);
        const bf16_t* xq = AD + (size_t)rowA * 128 + d * 64 + 8 * (lane >> 4);
        xw0 = *(const u32x4*)xp; xw1 = *(const u32x4*)(xp + 32);
        xa0 = *(const u32x4*)xq; xa1 = *(const u32x4*)(xq + 32);
      };
      auto issueT = [&](int c) {
        const int rowB = rwkv_row(b, d, c * 16 + ti);
        rr = *(const u32x2*)(R + (size_t)rowB * 1024 + hc);
        kr = *(const u32x2*)(Kb + (size_t)rowB * 1024 + hc);
        vr = *(const u32x2*)(V + (size_t)rowB * 1024 + hc);
      };
      auto stepA = [&](int c) {
        float* wbuf = wabuf + (c & 1) * 2048; float* abuf = wbuf + 1024;
        f32x4 accw = {0.f, 0.f, 0.f, 0.f}, acca = {0.f, 0.f, 0.f, 0.f};
        accw = mfma16(xw0, bu[0][0], accw); accw = mfma16(xw1, bu[0][1], accw);
        acca = mfma16(xa0, bu[1][0], acca); acca = mfma16(xa1, bu[1][1], acca);
#pragma unroll
        for (int r = 0; r < 4; ++r) {
          const int o = ((lane >> 4) * 4 + r) * 64 + pw * 16 + (lane & 15);
          const float x = -(accw[r] + bias_u[0]);
          const float sp = fmaxf(x, 0.f) + 0.6931471805599453f * __builtin_amdgcn_logf(1.f + __builtin_amdgcn_exp2f(-1.4426950408889634f * fabsf(x)));
          const float ew = __builtin_amdgcn_exp2f(-1.4426950408889634f * (sp + 0.5f));
          wbuf[o] = __builtin_amdgcn_exp2f(-1.4426950408889634f * ew);
          abuf[o] = __builtin_amdgcn_rcpf(1.f + __builtin_amdgcn_exp2f(-1.4426950408889634f * (acca[r] + bias_u[1])));
        }
      };
      auto stepB1 = [&](int c) {
        const float rv[4] = {bf_lo(rr.x), bf_hi(rr.x), bf_lo(rr.y), bf_hi(rr.y)};
        const float kv[4] = {bf_lo(kr.x), bf_hi(kr.x), bf_lo(kr.y), bf_hi(kr.y)};
        const float vv[4] = {bf_lo(vr.x), bf_hi(vr.x), bf_lo(vr.y), bf_hi(vr.y)};
        const float* wbuf = wabuf + (c & 1) * 2048; const float* abuf = wbuf + 1024;
        const f32x4 av = *(const f32x4*)(abuf + ti * 64 + 4 * dq), wv4 = *(const f32x4*)(wbuf + ti * 64 + 4 * dq);
        float q[4], ss = 0.f;
#pragma unroll
        for (int i = 0; i < 4; ++i) { q[i] = kv[i] * kkv[i]; ss += q[i] * q[i]; }
        ss = sum16(ss);
        const float inv = __builtin_amdgcn_rsqf(fmaxf(ss, 1e-24f));
        f32x4 nk, wrr, ka, kd, vo;
        float c1 = 0.f, c2 = 0.f, bn = 0.f;
#pragma unroll
        for (int i = 0; i < 4; ++i) {
          const float n = q[i] * inv;
          kd[i] = kv[i] * (1.f + (av[i] - 1.f) * kav[i]);
          ka[i] = n * av[i];
          nk[i] = -n; wrr[i] = wv4[i] * rv[i]; vo[i] = vv[i];
          c1 += ka[i] * rv[i]; c2 += kd[i] * rv[i]; bn += rv[i] * kd[i] * rkv[i];
        }
        c1 = sum16(c1); c2 = sum16(c2); bn = sum16(bn);
        float* rec = tokbuf + ((c & 1) * 16 + ti) * TSTR;
        *(f32x4*)(rec + 4 * dq) = nk;
        *(f32x4*)(rec + 64 + 4 * dq) = wrr;
        *(f32x4*)(rec + 128 + 4 * dq) = wv4;
        *(f32x4*)(rec + 192 + 4 * dq) = ka;
        *(f32x4*)(rec + 256 + 4 * dq) = kd;
        *(f32x4*)(rec + 320 + 4 * dq) = vo;
        if (dq == 0) {
          *(f32x2*)(rec + 384) = (f32x2){c1, c2};
          BON[((size_t)d * MT + rwkv_row(b, d, c * 16 + ti)) * 16 + h] = bn;
        }
      };
      auto stepB2 = [&](int c) {
        const int pp = ptid >> 5, dp = ptid & 31;
        const float* t0 = tokbuf + ((c & 1) * 16 + 2 * pp) * TSTR + 2 * dp;
        const float* t1 = t0 + TSTR;
        const f32x2 a0 = *(const f32x2*)(t0), wr0 = *(const f32x2*)(t0 + 64), w0 = *(const f32x2*)(t0 + 128);
        const f32x2 b0_ = *(const f32x2*)(t0 + 192), k0_ = *(const f32x2*)(t0 + 256), v0 = *(const f32x2*)(t0 + 320);
        const f32x2 a1 = *(const f32x2*)(t1), wr1 = *(const f32x2*)(t1 + 64), w1 = *(const f32x2*)(t1 + 128);
        const f32x2 b1_ = *(const f32x2*)(t1 + 192), k1_ = *(const f32x2*)(t1 + 256), v1 = *(const f32x2*)(t1 + 320);
        float c3 = b0_[0] * a1[0] + b0_[1] * a1[1], c4 = k0_[0] * a1[0] + k0_[1] * a1[1];
        float c5 = b0_[0] * wr1[0] + b0_[1] * wr1[1], c6 = k0_[0] * wr1[0] + k0_[1] * wr1[1];
        c3 = sum16(c3); c4 = sum16(c4); c5 = sum16(c5); c6 = sum16(c6);
        c3 += __shfl_xor(c3, 16); c4 += __shfl_xor(c4, 16); c5 += __shfl_xor(c5, 16); c6 += __shfl_xor(c6, 16);
        float* rec = stepbuf + ((c & 1) * 8 + pp) * PSTR;
        *(f32x2*)(rec + 2 * dp) = w0 * w1;
        {
          const f32x2 bw = b0_ * w1, kw = k0_ * w1;
          *(u32x4*)((char*)(rec + PREC_Y) + 16 * dp) = mk4(pk_bf16(bw[0], kw[0]), pk_bf16(b1_[0], k1_[0]), pk_bf16(bw[1], kw[1]), pk_bf16(b1_[1], k1_[1]));
        }
        *(f32x2*)(rec + PREC_V0 + 2 * dp) = v0;
        *(f32x2*)(rec + PREC_V1 + 2 * dp) = v1;
        unsigned* bb = (unsigned*)(rec + PREC_BF);
        const f32x2 wa = w0 * a1, wwr = w0 * wr1;
        const int kk = (2 * dp) & 31;
        const int pos = ((2 * dp) & 32) + (kk < 16 ? 8 * (kk >> 2) + (kk & 3) : 8 * ((kk - 16) >> 2) + 4 + (kk & 3));
        const int pu = pos >> 1;
        bb[pu] = pk_bf16(a0[0], a0[1]);
        bb[32 + pu] = pk_bf16(wr0[0], wr0[1]);
        bb[64 + pu] = pk_bf16(wa[0], wa[1]);
        bb[96 + pu] = pk_bf16(wwr[0], wwr[1]);
        if (dp == 0) {
          const f32x2 cc0 = *(const f32x2*)(t0 + 384), cc1 = *(const f32x2*)(t1 + 384);
          *(f32x4*)(rec + PREC_SC) = (f32x4){cc0[0], cc0[1], c3, c4};
          *(f32x4*)(rec + PREC_SC + 4) = (f32x4){c5, c6, cc1[0], cc1[1]};
        }
      };
      auto storeY = [&](int c) {
        const f32x4 yv = *(const f32x4*)(ybuf + (c & 1) * 4096 + ti * 256 + 4 * dq);
        u32x2 o; o.x = pk_bf16(yv[0], yv[1]); o.y = pk_bf16(yv[2], yv[3]);
        *(u32x2*)(Y + (size_t)rwkv_row(b, d, c * 16 + ti) * 1024 + hc) = o;
      };
      issueL(0); issueT(0);
      stepA(0);
      issueL(1);
      __syncthreads();
      stepB1(0); issueT(1);
      stepA(1); issueL(2);
      __syncthreads();
      stepB2(0);
      stepB1(1); issueT(2);
      stepA(2); issueL(3);
      __builtin_amdgcn_sched_barrier(0);
      __syncthreads();
      __builtin_amdgcn_sched_barrier(0);
      for (int c = 0; c < NCH; ++c) {
        if (c >= 1) storeY(c - 1);
        if (c + 1 < NCH) stepB2(c + 1);
        if (c + 2 < NCH) stepB1(c + 2);
        if (c + 3 < NCH) issueT(c + 3);
        if (c + 3 < NCH) stepA(c + 3);
        if (c + 4 < NCH) issueL(c + 4);
        __builtin_amdgcn_sched_barrier(0);
        __syncthreads();
        __builtin_amdgcn_sched_barrier(0);
      }
      storeY(NCH - 1);
    }
  }
}

__device__ __forceinline__ void rwkv_post_phase(const bf16_t* __restrict__ Y0, const bf16_t* __restrict__ Y1, const bf16_t* __restrict__ V,
                                bf16_t* __restrict__ G, const float* __restrict__ BON, const float* __restrict__ gn, int nrows) {
  const int tidx = opaque_tid();
  const int lane = tidx & 63;
  const int gw = blockIdx.x * (NTHR / 64) + (tidx >> 6), nw = gridDim.x * (NTHR / 64);
  const int head = lane >> 2, c0 = lane * 16;
  for (int row = gw; row < nrows; row += nw) {
    const size_t off = (size_t)row * 1024 + c0;
    float y[16], v[16], g[16];
#pragma unroll
    for (int i = 0; i < 2; ++i) {
      const u32x4 a0 = *(const u32x4*)(Y0 + off + 8 * i), a1 = *(const u32x4*)(Y1 + off + 8 * i);
      const u32x4 av = *(const u32x4*)(V + off + 8 * i), ag = *(const u32x4*)(G + off + 8 * i);
      y[8 * i + 0] = bf_lo(a0.x) + bf_lo(a1.x); y[8 * i + 1] = bf_hi(a0.x) + bf_hi(a1.x);
      y[8 * i + 2] = bf_lo(a0.y) + bf_lo(a1.y); y[8 * i + 3] = bf_hi(a0.y) + bf_hi(a1.y);
      y[8 * i + 4] = bf_lo(a0.z) + bf_lo(a1.z); y[8 * i + 5] = bf_hi(a0.z) + bf_hi(a1.z);
      y[8 * i + 6] = bf_lo(a0.w) + bf_lo(a1.w); y[8 * i + 7] = bf_hi(a0.w) + bf_hi(a1.w);
      v[8 * i + 0] = bf_lo(av.x); v[8 * i + 1] = bf_hi(av.x); v[8 * i + 2] = bf_lo(av.y); v[8 * i + 3] = bf_hi(av.y);
      v[8 * i + 4] = bf_lo(av.z); v[8 * i + 5] = bf_hi(av.z); v[8 * i + 6] = bf_lo(av.w); v[8 * i + 7] = bf_hi(av.w);
      g[8 * i + 0] = bf_lo(ag.x); g[8 * i + 1] = bf_hi(ag.x); g[8 * i + 2] = bf_lo(ag.y); g[8 * i + 3] = bf_hi(ag.y);
      g[8 * i + 4] = bf_lo(ag.z); g[8 * i + 5] = bf_hi(ag.z); g[8 * i + 6] = bf_lo(ag.w); g[8 * i + 7] = bf_hi(ag.w);
    }
    float s = 0.f;
#pragma unroll
    for (int i = 0; i < 16; ++i) s += y[i];
    s += __shfl_xor(s, 1); s += __shfl_xor(s, 2);
    const float mean = s * (1.f / 64.f);
    float q = 0.f;
#pragma unroll
    for (int i = 0; i < 16; ++i) { const float dlt = y[i] - mean; q += dlt * dlt; }
    q += __shfl_xor(q, 1); q += __shfl_xor(q, 2);
    const float rstd = rsqrtf(q * (1.f / 64.f) + 64e-5f);
    const float bonus = BON[(size_t)row * 16 + head] + BON[((size_t)MT + row) * 16 + head];
    unsigned o[8];
#pragma unroll
    for (int i = 0; i < 8; ++i) {
      const float z0 = ((y[2 * i] - mean) * rstd * gn[c0 + 2 * i] + gn[1024 + c0 + 2 * i] + bonus * v[2 * i]) * g[2 * i];
      const float z1 = ((y[2 * i + 1] - mean) * rstd * gn[c0 + 2 * i + 1] + gn[1024 + c0 + 2 * i + 1] + bonus * v[2 * i + 1]) * g[2 * i + 1];
      o[i] = pk_bf16(z0, z1);
    }
    *(u32x4*)(G + off) = mk4(o[0], o[1], o[2], o[3]);
    *(u32x4*)(G + off + 8) = mk4(o[4], o[5], o[6], o[7]);
  }
}

__device__ __forceinline__ void rglru_phase(char* lds, const bf16_t* __restrict__ XR, const bf16_t* __restrict__ Wg, const float* __restrict__ conv_w,
                            const float* __restrict__ conv_b, const float* __restrict__ gate_b, const float* __restrict__ lam,
                            bf16_t* __restrict__ HS0, bf16_t* __restrict__ HS1) {
  bf16_t* xcT = (bf16_t*)lds;
  f32x2* AB = (f32x2*)(lds + 26624);
  bf16_t* raw = (bf16_t*)(lds + 26624);
  float* segP = (float*)(lds + 116736);
  float* segH = segP + 352;
  float* segC = segH + 352;
  bf16_t* wgs = (bf16_t*)(lds + 120960);
  float* cws = (float*)(lds + 160896);
  const int tid = opaque_tid(), lane = tid & 63, wv = tid >> 6;
  for (int chain = blockIdx.x; chain < 256; chain += gridDim.x) {
    const int d = chain & 1, blk = (chain >> 1) & 15, b = chain >> 5;
    bf16_t* HS = d ? HS1 : HS0;
    float carry = 0.f;
    __syncthreads();
    for (int q = tid; q < 2 * 96 * 12; q += NTHR) {
      const int g = q / 1152, rem = q - g * 1152, n = rem / 12, k8 = rem - n * 12;
      *(u32x4*)(wgs + (g * 96 + n) * 104 + k8 * 8) = *(const u32x4*)(Wg + ((size_t)((blk * 4 + d * 2 + g) * 96 + n)) * 96 + k8 * 8);
    }
    for (int e = tid; e < 5 * 88; e += NTHR) {
      const int j = e / 88, c = e - j * 88;
      cws[e] = j < 4 ? conv_w[j * LW + blk * 88 + c] : conv_b[blk * 88 + c];
    }
    for (int e = tid; e < 128 * 8; e += NTHR) xcT[(e >> 3) * 104 + 88 + (e & 7)] = 0;
    u32x4 pre[3];
    auto tile_geom = [&](int ti, int& seqbase, int& t0, int& T) {
      if (ti < 2) { seqbase = ML + b * 256; T = 256; t0 = (d ? 1 - ti : ti) * 128; }
      else { seqbase = b * 4096; T = 4096; t0 = (d ? 31 - (ti - 2) : (ti - 2)) * 128; }
    };
    auto prefetch = [&](int ti) {
      int seqbase, t0, T; tile_geom(ti, seqbase, t0, T);
#pragma unroll
      for (int i = 0; i < 3; ++i) {
        const int q = tid + NTHR * i;
        const int row = q / 11, cc = q - row * 11, t = t0 - 2 + row;
        u32x4 v = {0u, 0u, 0u, 0u};
        if (q < 131 * 11 && t >= 0 && t < T) v = *(const u32x4*)(XR + (size_t)(seqbase + t) * LW + blk * 88 + cc * 8);
        pre[i] = v;
      }
    };
    prefetch(0);
    for (int ti = 0; ti < 34; ++ti) {
      int seqbase, t0, T; tile_geom(ti, seqbase, t0, T);
      __syncthreads();
#pragma unroll
      for (int i = 0; i < 3; ++i) {
        const int q = tid + NTHR * i;
        if (q < 131 * 11) *(u32x4*)(raw + q * 8) = pre[i];
      }
      if (ti + 1 < 34) prefetch(ti + 1);
      __builtin_amdgcn_sched_barrier(0);
      __syncthreads();
      {
        unsigned xr[11][4];
#pragma unroll
        for (int it = 0; it < 11; ++it) {
          const int e = tid + it * NTHR, tl = e / 44, c2 = (e - tl * 44) * 2;
#pragma unroll
          for (int j = 0; j < 4; ++j) xr[it][j] = *(const unsigned*)(raw + (tl + j) * 88 + c2);
        }
#pragma unroll
        for (int it = 0; it < 11; ++it) {
          const int e = tid + it * NTHR, tl = e / 44, c2 = (e - tl * 44) * 2;
          float a0 = cws[4 * 88 + c2], a1 = cws[4 * 88 + c2 + 1];
#pragma unroll
          for (int j = 0; j < 4; ++j) { a0 += bf_lo(xr[it][j]) * cws[j * 88 + c2]; a1 += bf_hi(xr[it][j]) * cws[j * 88 + c2 + 1]; }
          *(unsigned*)(xcT + tl * 104 + c2) = pk_bf16(a0, a1);
        }
      }
      __syncthreads();
      {
        const int tok = wv * 16 + (lane & 15);
        u32x4 af[3];
#pragma unroll
        for (int kk = 0; kk < 3; ++kk) af[kk] = *(const u32x4*)(xcT + tok * 104 + kk * 32 + 8 * (lane >> 4));
        bf16_t xcv[6][4];
#pragma unroll
        for (int n6 = 0; n6 < 6; ++n6)
#pragma unroll
          for (int r = 0; r < 4; ++r) xcv[n6][r] = xcT[(wv * 16 + (lane >> 4) * 4 + r) * 104 + n6 * 16 + (lane & 15)];
#pragma unroll
        for (int n6 = 0; n6 < 6; ++n6) {
          f32x4 accr = {0.f, 0.f, 0.f, 0.f}, acci = {0.f, 0.f, 0.f, 0.f};
          const int ncol = n6 * 16 + (lane & 15);
          const bf16_t* wr_ = wgs + ncol * 104 + 8 * (lane >> 4);
          const bf16_t* wi_ = wgs + (96 + ncol) * 104 + 8 * (lane >> 4);
#pragma unroll
          for (int kk = 0; kk < 3; ++kk) {
            accr = mfma16(af[kk], *(const u32x4*)(wr_ + kk * 32), accr);
            acci = mfma16(af[kk], *(const u32x4*)(wi_ + kk * 32), acci);
          }
          if (ncol < 88) {
            const int ch = blk * 88 + ncol;
            const float gbr = gate_b[(d * 2 + 0) * LW + ch], gbi = gate_b[(d * 2 + 1) * LW + ch];
            const float spl = softplusf_(-lam[d * LW + ch]);
#pragma unroll
            for (int r = 0; r < 4; ++r) {
              const int tk = wv * 16 + (lane >> 4) * 4 + r;
              const float rg = sigmoidf_(accr[r] + gbr), ig = sigmoidf_(acci[r] + gbi);
              const float a = __expf(-8.f * rg * spl);
              const float bb = sqrtf(fmaxf(1.f - a * a, 0.f)) * ig * bf2f(xcv[n6][r]);
              AB[tk * 88 + ncol] = (f32x2){a, bb};
            }
          }
        }
      }
      __syncthreads();
      if (tid < 352) {
        const int seg = tid / 88, c = tid - seg * 88;
        float hl = 0.f, P = 1.f;
        for (int u0 = seg * 32; u0 < seg * 32 + 32; u0 += 8) {
          f32x2 ab[8];
#pragma unroll
          for (int i = 0; i < 8; ++i) { const int tl = d ? 127 - (u0 + i) : (u0 + i); ab[i] = AB[tl * 88 + c]; }
#pragma unroll
          for (int i = 0; i < 8; ++i) { hl = ab[i][0] * hl + ab[i][1]; P *= ab[i][0]; ab[i] = (f32x2){hl, P}; }
#pragma unroll
          for (int i = 0; i < 8; ++i) { const int tl = d ? 127 - (u0 + i) : (u0 + i); AB[tl * 88 + c] = ab[i]; }
        }
        segH[seg * 88 + c] = hl; segP[seg * 88 + c] = P;
      }
      __syncthreads();
      if (tid < 88) {
        float cur = carry;
#pragma unroll
        for (int seg = 0; seg < 4; ++seg) { segC[seg * 88 + tid] = cur; cur = segP[seg * 88 + tid] * cur + segH[seg * 88 + tid]; }
        carry = cur;
      }
      __syncthreads();
      for (int q = tid; q < 128 * 11; q += NTHR) {
        const int tl = q / 11, c8 = (q - tl * 11) * 8;
        const int u = d ? 127 - tl : tl;
        const float* sc = segC + (u >> 5) * 88 + c8;
        float hv[8];
#pragma unroll
        for (int i = 0; i < 8; ++i) { const f32x2 hp = AB[tl * 88 + c8 + i]; hv[i] = hp[0] + hp[1] * sc[i]; }
        *(u32x4*)(HS + (size_t)(seqbase + t0 + tl) * LW + blk * 88 + c8) =
            mk4(pk_bf16(hv[0], hv[1]), pk_bf16(hv[2], hv[3]), pk_bf16(hv[4], hv[5]), pk_bf16(hv[6], hv[7]));
      }
    }
  }
}

__device__ __forceinline__ void lru_z_phase(const bf16_t* __restrict__ HS0, const bf16_t* __restrict__ HS1, bf16_t* __restrict__ GG) {
  const size_t n8 = (size_t)MT * LW / 8;
  for (size_t e = (size_t)blockIdx.x * NTHR + threadIdx.x; e < n8; e += (size_t)gridDim.x * NTHR) {
    const u32x4 a = *(const u32x4*)(HS0 + e * 8), b = *(const u32x4*)(HS1 + e * 8), g = *(const u32x4*)(GG + e * 8);
    u32x4 o;
    o.x = pk_bf16((bf_lo(a.x) + bf_lo(b.x)) * bf_lo(g.x), (bf_hi(a.x) + bf_hi(b.x)) * bf_hi(g.x));
    o.y = pk_bf16((bf_lo(a.y) + bf_lo(b.y)) * bf_lo(g.y), (bf_hi(a.y) + bf_hi(b.y)) * bf_hi(g.y));
    o.z = pk_bf16((bf_lo(a.z) + bf_lo(b.z)) * bf_lo(g.z), (bf_hi(a.z) + bf_hi(b.z)) * bf_hi(g.z));
    o.w = pk_bf16((bf_lo(a.w) + bf_lo(b.w)) * bf_lo(g.w), (bf_hi(a.w) + bf_hi(b.w)) * bf_hi(g.w));
    *(u32x4*)(GG + e * 8) = o;
  }
}

__device__ __forceinline__ void nat_qk_phase(bf16_t* __restrict__ Q, bf16_t* __restrict__ Kb, bf16_t* __restrict__ QR, const float* __restrict__ qk_g) {
  const int tidx = opaque_tid();
  const int lane = tidx & 63;
  const int gw = blockIdx.x * (NTHR / 64) + (tidx >> 6), nw = gridDim.x * (NTHR / 64);
  const int qd = lane & 3;
  float gq[16], gk[16], inv[16];
#pragma unroll
  for (int i = 0; i < 16; ++i) { gq[i] = qk_g[qd * 16 + i]; gk[i] = qk_g[64 + qd * 16 + i]; inv[i] = exp2f(-(float)i * (13.287712379549449f / 16.f)); }
  for (int row = gw; row < MT; row += nw) {
    const bool lat = row < ML;
    const size_t off = (size_t)row * 1024 + lane * 16;
    float cs[16], sn[16];
    if (lat) {
      const int t = row & 4095;
      const float pos = (float)((qd >> 1) ? (t & 63) : (t >> 6));
#pragma unroll
      for (int i = 0; i < 16; ++i) {
        float rev = pos * inv[i] * 0.15915494309189535f;
        rev -= floorf(rev);
        sn[i] = __builtin_amdgcn_sinf(rev); cs[i] = __builtin_amdgcn_cosf(rev);
      }
    }
#pragma unroll
    for (int which = 0; which < 2; ++which) {
      bf16_t* P = which ? Kb : Q;
      const u32x4 a = *(const u32x4*)(P + off), b2 = *(const u32x4*)(P + off + 8);
      const unsigned u[8] = {a.x, a.y, a.z, a.w, b2.x, b2.y, b2.z, b2.w};
      float x[16];
#pragma unroll
      for (int i = 0; i < 8; ++i) { x[2 * i] = bf_lo(u[i]); x[2 * i + 1] = bf_hi(u[i]); }
      float ss = 0.f;
#pragma unroll
      for (int i = 0; i < 16; ++i) ss += x[i] * x[i];
      ss += __shfl_xor(ss, 1); ss += __shfl_xor(ss, 2);
      const float rstd = rsqrtf(ss * (1.f / 64.f) + 1e-6f);
#pragma unroll
      for (int i = 0; i < 16; ++i) x[i] = x[i] * rstd * (which ? gk[i] : gq[i]);
      unsigned pl[8];
#pragma unroll
      for (int i = 0; i < 8; ++i) pl[i] = pk_bf16(x[2 * i], x[2 * i + 1]);
      unsigned rt[8];
      if (lat) {
        float y[16];
#pragma unroll
        for (int i = 0; i < 16; ++i) {
          const float pr = __shfl_xor(x[i], 1);
          y[i] = x[i] * cs[i] + ((qd & 1) ? pr * sn[i] : -pr * sn[i]);
        }
#pragma unroll
        for (int i = 0; i < 8; ++i) rt[i] = pk_bf16(y[2 * i], y[2 * i + 1]);
      }
      if (which == 0) {
        *(u32x4*)(Q + off) = mk4(pl[0], pl[1], pl[2], pl[3]);
        *(u32x4*)(Q + off + 8) = mk4(pl[4], pl[5], pl[6], pl[7]);
        if (lat) { *(u32x4*)(QR + off) = mk4(rt[0], rt[1], rt[2], rt[3]); *(u32x4*)(QR + off + 8) = mk4(rt[4], rt[5], rt[6], rt[7]); }
      } else {
        if (lat) { *(u32x4*)(Kb + off) = mk4(rt[0], rt[1], rt[2], rt[3]); *(u32x4*)(Kb + off + 8) = mk4(rt[4], rt[5], rt[6], rt[7]); }
        else { *(u32x4*)(Kb + off) = mk4(pl[0], pl[1], pl[2], pl[3]); *(u32x4*)(Kb + off + 8) = mk4(pl[4], pl[5], pl[6], pl[7]); }
      }
    }
  }
}

struct AttnState { f32x16 O[2][2]; float m[2], l[2]; };

DEVI void attn_load_k(u32x4 (&kf)[4], const bf16_t* __restrict__ kbase, int lane) {
  const int l31 = lane & 31, lh = lane >> 5;
#pragma unroll
  for (int ks = 0; ks < 4; ++ks) kf[ks] = *(const u32x4*)(kbase + (size_t)l31 * 1024 + ks * 16 + 8 * lh);
}

DEVI void attn_compute(AttnState& st, const u32x4* qs, const bf16_t* __restrict__ kbase, const bf16_t* __restrict__ vtbase, int vtT,
                       const float* __restrict__ rpbs, bool band, int brow, int half, int lane) {
  const int l31 = lane & 31, lh = lane >> 5;
  u32x4 kf[4];
  attn_load_k(kf, kbase, lane);
  u32x4 vf[4];
#pragma unroll
  for (int dt = 0; dt < 2; ++dt)
#pragma unroll
    for (int s = 0; s < 2; ++s) {
      const bf16_t* vp = vtbase + (size_t)(dt * 32 + l31) * vtT + 16 * s + 4 * lh;
      const u32x2 lo = *(const u32x2*)vp, hi = *(const u32x2*)(vp + 8);
      vf[dt * 2 + s] = mk4(lo.x, lo.y, hi.x, hi.y);
    }
  __builtin_amdgcn_sched_barrier(0);
  constexpr float SC = 0.125f * 1.4426950408889634f;
  u32x4 pf[2][2];
#pragma unroll
  for (int qt = 0; qt < 2; ++qt) {
    f32x16 S;
#pragma unroll
    for (int r = 0; r < 16; ++r) S[r] = 0.f;
#pragma unroll
    for (int ks = 0; ks < 4; ++ks) S = mfma32(kf[ks], qs[(qt * 4 + ks) * 64], S);
    float cmax = -INFINITY;
    if (band) {
      const int qc = qt * 32 + l31;
      const int cst = min(max(qc - 8, 0), 48);
#pragma unroll
      for (int r = 0; r < 16; ++r) {
        const int key = (r & 3) + 8 * (r >> 2) + 4 * lh;
        const int kc = half * 32 + key;
        const bool ok = (kc >= cst) && (kc < cst + 16);
        const int bi = ok ? (brow * 31 + kc - qc + 15) : 0;
        const float sv = S[r] * SC + rpbs[bi];
        S[r] = ok ? sv : -INFINITY;
        cmax = fmaxf(cmax, S[r]);
      }
    } else {
#pragma unroll
      for (int r = 0; r < 16; ++r) { S[r] *= SC; cmax = fmaxf(cmax, S[r]); }
    }
    cmax = fmaxf(cmax, __shfl_xor(cmax, 32));
    const float mnew = fmaxf(st.m[qt], cmax);
    const float alpha = __builtin_amdgcn_exp2f(st.m[qt] - mnew);
    const bool grew = mnew > st.m[qt];
    st.m[qt] = mnew;
    float ps = 0.f;
#pragma unroll
    for (int r = 0; r < 16; ++r) { S[r] = __builtin_amdgcn_exp2f(S[r] - mnew); ps += S[r]; }
    st.l[qt] = st.l[qt] * alpha + ps;
    if (__any(grew)) {
#pragma unroll
      for (int dt = 0; dt < 2; ++dt)
#pragma unroll
        for (int r = 0; r < 16; ++r) st.O[qt][dt][r] *= alpha;
    }
    pf[qt][0] = mk4(pk_bf16(S[0], S[1]), pk_bf16(S[2], S[3]), pk_bf16(S[4], S[5]), pk_bf16(S[6], S[7]));
    pf[qt][1] = mk4(pk_bf16(S[8], S[9]), pk_bf16(S[10], S[11]), pk_bf16(S[12], S[13]), pk_bf16(S[14], S[15]));
  }
#pragma unroll
  for (int dt = 0; dt < 2; ++dt)
#pragma unroll
    for (int s = 0; s < 2; ++s) {
      st.O[0][dt] = mfma32(vf[dt * 2 + s], pf[0][s], st.O[0][dt]);
      st.O[1][dt] = mfma32(vf[dt * 2 + s], pf[1][s], st.O[1][dt]);
    }
}

__device__ __forceinline__ void natten_phase(char* lds, const bf16_t* __restrict__ Q, const bf16_t* __restrict__ QR, const bf16_t* __restrict__ Kb,
                             const bf16_t* __restrict__ VT, bf16_t* __restrict__ G, const float* __restrict__ rpb, bf16_t* __restrict__ Zd) {
  float* rpbs = (float*)lds;
  __syncthreads();
  for (int e = threadIdx.x; e < 16 * 465; e += NTHR) rpbs[e] = rpb[e] * 1.4426950408889634f;
  __syncthreads();
  const int tidx = opaque_tid();
  const int lane = tidx & 63, l31 = lane & 31, lh = lane >> 5;
  const int gw = blockIdx.x * (NTHR / 64) + (tidx >> 6), nw = gridDim.x * (NTHR / 64);
  const bf16_t* VTC = VT + (size_t)ML * 1024;
  u32x4* qs = (u32x4*)(lds + 32768) + (tidx >> 6) * 512 + lane;
  const int xcd = blockIdx.x & 7, wx = (blockIdx.x >> 3) * (NTHR / 64) + (tidx >> 6), nwx = (gridDim.x >> 3) * (NTHR / 64);
  for (int i = wx; i < 1024 + 64; i += nwx) {
    const bool lat = i < 1024;
    int b, h, r = 0, qrow0;
    if (lat) { const int pair = xcd * 16 + (i >> 6); r = i & 63; b = pair >> 4; h = pair & 15; qrow0 = b * 4096 + r * 64; }
    else { const int it = i - 1024; const int pair = xcd * 16 + (it >> 2); const int qt64 = it & 3; b = pair >> 4; h = pair & 15; qrow0 = ML + b * 256 + qt64 * 64; }
    const int start = min(max(r - 4, 0), 56);
    const int nchunks = lat ? 24 : 8;
    AttnState st;
#pragma unroll
    for (int a = 0; a < 2; ++a) { st.m[a] = -INFINITY; st.l[a] = 0.f;
#pragma unroll
      for (int c = 0; c < 2; ++c)
#pragma unroll
        for (int rr = 0; rr < 16; ++rr) st.O[a][c][rr] = 0.f; }
#pragma unroll
    for (int qt = 0; qt < 2; ++qt)
#pragma unroll
      for (int ks = 0; ks < 4; ++ks) qs[(qt * 4 + ks) * 64] = *(const u32x4*)(Q + (size_t)(qrow0 + qt * 32 + l31) * 1024 + h * 64 + ks * 16 + 8 * lh);
    for (int j = 0; j < nchunks; ++j) {
      if (j == 8) {
#pragma unroll
        for (int qt = 0; qt < 2; ++qt)
#pragma unroll
          for (int ks = 0; ks < 4; ++ks) qs[(qt * 4 + ks) * 64] = *(const u32x4*)(QR + (size_t)(qrow0 + qt * 32 + l31) * 1024 + h * 64 + ks * 16 + 8 * lh);
      }
      const bool band = j >= 8;
      const int ii = j - 8, kr = start + (ii >> 1), half = band ? (ii & 1) : 0;
      const size_t krow = band ? (size_t)(b * 4096 + kr * 64 + half * 32) : (size_t)(ML + b * 256 + j * 32);
      const bf16_t* kbase = Kb + krow * 1024 + h * 64;
      const bf16_t* vtb = band ? VT + (size_t)(b * 16 + h) * 64 * 4096 + kr * 64 + half * 32 : VTC + (size_t)(b * 16 + h) * 64 * 256 + j * 32;
      attn_compute(st, qs, kbase, vtb, band ? 4096 : 256, rpbs, band, band ? h * 15 + (kr - r + 7) : 0, half, lane);
    }
#pragma unroll
    for (int qt = 0; qt < 2; ++qt) {
      const float lt = st.l[qt] + __shfl_xor(st.l[qt], 32);
      const float inv = 1.f / lt;
      bf16_t* grow = G + (size_t)(qrow0 + qt * 32 + l31) * 1024 + h * 64;
      u32x2 gvs[2][4];
#pragma unroll
      for (int dt = 0; dt < 2; ++dt)
#pragma unroll
        for (int q4 = 0; q4 < 4; ++q4) gvs[dt][q4] = *(const u32x2*)(grow + dt * 32 + 8 * q4 + 4 * lh);
#pragma unroll
      for (int dt = 0; dt < 2; ++dt)
#pragma unroll
        for (int q4 = 0; q4 < 4; ++q4) {
          bf16_t* gp = grow + dt * 32 + 8 * q4 + 4 * lh;
          bf16_t* zp = Zd + (gp - G);
          const u32x2 gv = gvs[dt][q4];
          u32x2 o;
          o.x = pk_bf16(st.O[qt][dt][4 * q4] * inv * bf_lo(gv.x), st.O[qt][dt][4 * q4 + 1] * inv * bf_hi(gv.x));
          o.y = pk_bf16(st.O[qt][dt][4 * q4 + 2] * inv * bf_lo(gv.y), st.O[qt][dt][4 * q4 + 3] * inv * bf_hi(gv.y));
          *(u32x2*)zp = o;
        }
    }
  }
}

namespace pg8 {
#define PG8_LAS __attribute__((address_space(3)))
typedef unsigned short bf16_t;
typedef short bf16x8 __attribute__((ext_vector_type(8)));
typedef float f32x4 __attribute__((ext_vector_type(4)));
typedef unsigned u32x4 __attribute__((ext_vector_type(4)));
constexpr int BM = 256, BK = 64, HALF = 128, HTB = HALF * BK * 2  , STAGE_BYTES = 8 * HTB, NXCD = 8, WGM = 8;

__host__ __device__ __forceinline__ int lds_byte(int r, int c) { const int st = (r >> 4) * 2 + (c >> 5), rr = r & 15, cc = c & 31, ob = rr * 64 + cc * 2; return st * 1024 + (ob ^ (((ob >> 9) & 1) << 5)); }
__host__ __device__ __forceinline__ void stage_rc(int b, int& R, int& C) { const int st = b / 1024, sb = b % 1024, swz = sb ^ (((sb >> 9) & 1) << 5); R = (st >> 1) * 16 + swz / 64; C = (st & 1) * 32 + (swz % 64) / 2; }
__host__ __device__ __forceinline__ int perm32(int rho) { const int n = rho >> 4, i = rho & 15; return 8 * (i >> 2) + 4 * n + (i & 3); }

struct Unit { int pm, pn; };
struct Gemm { const bf16_t* A; const bf16_t* Bt; int M, N, K; };

struct StaticOrder {
    int nM, nN, nwg, G, c;
    __host__ __device__ void init(int M, int N, int G_, int c_) { nM = M / BM; nN = N / BM; nwg = nM * nN; G = G_; c = c_; }
    __host__ __device__ bool next(int i, Unit& u) const {
        const long L = (long)i * G + c; if (L >= nwg) return false;
        int wgid = (int)L; { const int q = nwg / NXCD, r = nwg % NXCD, xcd = wgid % NXCD, off = wgid / NXCD; wgid = (xcd < r ? xcd * (q + 1) : r * (q + 1) + (xcd - r) * q) + off; }
        const int nig = WGM * nN, gid = wgid / nig, fm = gid * WGM, gsz = (nM - fm) < WGM ? (nM - fm) : WGM;
        u.pm = fm + ((wgid % nig) % gsz); u.pn = (wgid % nig) / gsz; return true;
    }
    __device__ __forceinline__ void a_ready(const Unit&) const {}
    __device__ __forceinline__ void done(const Unit&) const {}
};
template <class Epi, class Sched, bool STAMP = false>
__device__ __forceinline__ void gemm_phase(PG8_LAS unsigned char* lds, const Gemm g, const Sched& S, const Epi& E, unsigned long long* stamps) {
    const int tid = threadIdx.x, wid = __builtin_amdgcn_readfirstlane(tid >> 6), lane = tid & 63, wr = wid >> 2, wc = wid & 3, fr = lane & 15, fq = lane >> 4;
    const int K = g.K, nt = K / BK;
    int ts_lo = 0, ts_hi = 0, nts = 0; const unsigned long long rt_entry = STAMP ? (unsigned long long)wall_clock64() : 0ull;
#define PG8_STAMP() do { if (STAMP && wid == 0 && nts < 64) { const unsigned long long _c = (unsigned long long)clock64(); \
        ts_lo = (lane == nts) ? (int)(unsigned)_c : ts_lo; ts_hi = (lane == nts) ? (int)(unsigned)(_c >> 32) : ts_hi; ++nts; } } while (0)
    PG8_STAMP();
    unsigned voffA[2], voffB[2];
#pragma unroll
    for (int i = 0; i < 2; ++i) { int R, C; stage_rc(tid * 16 + i * 8192, R, C); const int Rb = Epi::PERM ? ((R & ~31) + perm32(R & 31)) : R;
        voffA[i] = (unsigned)(R * K + C) * 2u; voffB[i] = (unsigned)(Rb * K + C) * 2u; }
    const size_t kstep = (size_t)(BK * 2);
    const size_t hstep = (size_t)HALF * K * 2;
    const size_t tstep = 2 * hstep;
    const unsigned ldsw = (unsigned)wid * 1024u;
    const int aoff = lds_byte(wr * 64 + fr, fq * 8), boff = lds_byte(wc * 32 + fr, fq * 8);
#define PG8_SA(b, h) (((b) * 2 + (h)) * HTB)
#define PG8_SB(b, h) ((4 + (b) * 2 + (h)) * HTB)
#define PG8_STAGE(bufoff, gbase, voff) do { _Pragma("unroll") for (int _i = 0; _i < 2; ++_i) \
        __builtin_amdgcn_global_load_lds((const unsigned*)((const char*)(gbase) + (voff)[_i]), (PG8_LAS unsigned*)(lds + (bufoff) + ldsw + _i * 8192), 16, 0, 0); } while (0)
#define PG8_LDA(dst, b, h) do { _Pragma("unroll") for (int m = 0; m < 4; ++m) _Pragma("unroll") for (int k = 0; k < 2; ++k) dst[m][k] = *(const PG8_LAS bf16x8*)(lds + PG8_SA(b, h) + aoff + m * 2048 + k * 1024); } while (0)
#define PG8_LDB(dst, b, h) do { _Pragma("unroll") for (int n = 0; n < 2; ++n) _Pragma("unroll") for (int k = 0; k < 2; ++k) dst[n][k] = *(const PG8_LAS bf16x8*)(lds + PG8_SB(b, h) + boff + n * 2048 + k * 1024); } while (0)
#define PG8_MMA(ai, bj, At, Bt) do { __builtin_amdgcn_s_setprio(1); _Pragma("unroll") for (int m = 0; m < 4; ++m) _Pragma("unroll") for (int n = 0; n < 2; ++n) _Pragma("unroll") for (int k = 0; k < 2; ++k) \
        acc[ai][bj][m][n] = __builtin_amdgcn_mfma_f32_16x16x32_bf16(Bt[n][k], At[m][k], acc[ai][bj][m][n], 0, 0, 0); __builtin_amdgcn_s_setprio(0); } while (0)
#define PG8_WAIT_V(n) asm volatile("s_waitcnt vmcnt(" #n ")" ::: "memory")
#define PG8_WAIT_L(n) asm volatile("s_waitcnt lgkmcnt(" #n ")" ::: "memory")
#define PG8_BAR __builtin_amdgcn_s_barrier()
#define PG8_SCHED __builtin_amdgcn_sched_barrier(0)
    Unit cur, nxt; int ui = 0;
    if (!S.next(0, cur)) return;
    f32x4 acc[2][2][4][2];
#pragma unroll
    for (int a = 0; a < 2; ++a)
#pragma unroll
        for (int b = 0; b < 2; ++b)
#pragma unroll
            for (int m = 0; m < 4; ++m)
#pragma unroll
                for (int n = 0; n < 2; ++n) acc[a][b][m][n] = (f32x4){0.f, 0.f, 0.f, 0.f};
    bf16x8 At[4][2], B0[2][2], B1[2][2];
    const char* cA = (const char*)g.A + (size_t)cur.pm * tstep; const char* cB = (const char*)g.Bt + (size_t)cur.pn * tstep;
    S.a_ready(cur);
    PG8_STAGE(PG8_SB(0, 0), cB, voffB); PG8_STAGE(PG8_SA(0, 0), cA, voffA); PG8_STAGE(PG8_SB(0, 1), cB + hstep, voffB); PG8_STAGE(PG8_SA(0, 1), cA + hstep, voffA);
    if (wr == 1) PG8_BAR;
    PG8_WAIT_V(4); PG8_BAR;
    PG8_STAGE(PG8_SB(1, 0), cB + kstep, voffB); PG8_STAGE(PG8_SA(1, 0), cA + kstep, voffA); PG8_STAGE(PG8_SB(1, 1), cB + hstep + kstep, voffB);
    PG8_WAIT_V(6); PG8_BAR;
    PG8_STAMP();
    for (;;) {
        const bool has_next = S.next(ui + 1, nxt);
        const char* nA = has_next ? (const char*)g.A + (size_t)nxt.pm * tstep : cA; const char* nB = has_next ? (const char*)g.Bt + (size_t)nxt.pn * tstep : cB;
        for (int t = 0; t < nt; t += 2) {
            const bool last = (t == nt - 2);
            const char* a1 = cA + (size_t)(t + 1) * kstep;
            const char* a2 = last ? nA : cA + (size_t)(t + 2) * kstep; const char* b2 = last ? nB : cB + (size_t)(t + 2) * kstep;
            const char* a3 = a2 + kstep; const char* b3 = b2 + kstep;
            if (last && has_next) S.a_ready(nxt);
            PG8_LDB(B0, 0, 0); PG8_SCHED; PG8_LDA(At, 0, 0); PG8_STAGE(PG8_SA(1, 1), a1 + hstep, voffA);
            PG8_WAIT_L(8); PG8_BAR; PG8_WAIT_L(0); PG8_MMA(0, 0, At, B0); PG8_BAR; PG8_SCHED;
            PG8_LDB(B1, 0, 1); PG8_STAGE(PG8_SB(0, 0), b2, voffB);
            PG8_BAR; PG8_WAIT_L(0); PG8_MMA(0, 1, At, B1); PG8_BAR;
            PG8_LDA(At, 0, 1); PG8_STAGE(PG8_SA(0, 0), a2, voffA);
            PG8_BAR; PG8_WAIT_L(0); PG8_MMA(1, 0, At, B0); PG8_BAR; PG8_SCHED;
            PG8_STAGE(PG8_SB(0, 1), b2 + hstep, voffB);
            PG8_WAIT_V(6); PG8_BAR; PG8_MMA(1, 1, At, B1); PG8_BAR;
            PG8_LDB(B0, 1, 0); PG8_SCHED; PG8_LDA(At, 1, 0); PG8_STAGE(PG8_SA(0, 1), a2 + hstep, voffA);
            PG8_WAIT_L(8); PG8_BAR; PG8_WAIT_L(0); PG8_MMA(0, 0, At, B0); PG8_BAR; PG8_SCHED;
            PG8_LDB(B1, 1, 1); PG8_STAGE(PG8_SB(1, 0), b3, voffB);
            PG8_BAR; PG8_WAIT_L(0); PG8_MMA(0, 1, At, B1); PG8_BAR;
            PG8_LDA(At, 1, 1); PG8_STAGE(PG8_SA(1, 0), a3, voffA);
            PG8_BAR; PG8_WAIT_L(0); PG8_MMA(1, 0, At, B0); PG8_BAR; PG8_SCHED;
            PG8_STAGE(PG8_SB(1, 1), b3 + hstep, voffB);
            PG8_WAIT_V(6); PG8_BAR; PG8_MMA(1, 1, At, B1); PG8_BAR;
        }
        PG8_STAMP();
        if constexpr (!Epi::AFTER_DRAIN) { E(acc, cur, wr, wc, fr, fq); S.done(cur); }
        PG8_STAMP();
        if (!has_next) break;
#pragma unroll
        for (int a = 0; a < 2; ++a)
#pragma unroll
            for (int b = 0; b < 2; ++b)
#pragma unroll
                for (int m = 0; m < 4; ++m)
#pragma unroll
                    for (int n = 0; n < 2; ++n) acc[a][b][m][n] = (f32x4){0.f, 0.f, 0.f, 0.f};
        cur = nxt; cA = nA; cB = nB; ++ui;
    }
    PG8_WAIT_V(0);
    if (wr == 0) PG8_BAR;
    PG8_BAR;
    if constexpr (Epi::AFTER_DRAIN) { E.fused(acc, cur, wr, wc, fr, fq, lds, wid, lane); S.done(cur); }
    PG8_STAMP();
    if (STAMP && wid == 0) { stamps[lane] = lane < nts ? (((unsigned long long)(unsigned)ts_hi << 32) | (unsigned)ts_lo) : 0ull;
        if (lane == 62) stamps[62] = rt_entry; if (lane == 63) stamps[63] = (unsigned long long)wall_clock64(); }
#undef PG8_STAMP
#undef PG8_SA
#undef PG8_SB
#undef PG8_STAGE
#undef PG8_LDA
#undef PG8_LDB
#undef PG8_MMA
#undef PG8_WAIT_V
#undef PG8_WAIT_L
#undef PG8_BAR
#undef PG8_SCHED
}
}

template <class EP> struct Pg8Epi {
  static constexpr bool PERM = false, AFTER_DRAIN = false;
  EP ep;
  __device__ __forceinline__ void operator()(const pg8::f32x4 (&acc)[2][2][4][2], const pg8::Unit& u, int wr, int wc, int fr, int fq) const {
#pragma unroll
    for (int ai = 0; ai < 2; ++ai)
#pragma unroll
      for (int m = 0; m < 4; ++m)
#pragma unroll
        for (int bj = 0; bj < 2; ++bj)
#pragma unroll
          for (int n = 0; n < 2; ++n) {
            const int row = u.pm * 256 + ai * 128 + wr * 64 + m * 16 + fr;
            const int col = u.pn * 256 + bj * 128 + wc * 32 + n * 16 + fq * 4;
            ep(row, col, acc[ai][bj][m][n]);
          }
  }
};
struct Pg8EpiRes {
  static constexpr bool PERM = false, AFTER_DRAIN = false;
  EpRes ep;
  __device__ __forceinline__ void operator()(const pg8::f32x4 (&acc)[2][2][4][2], const pg8::Unit& u, int wr, int wc, int fr, int fq) const {
    const int bidx = (u.pm * 256) >> 12;
    const float* gbase = ep.modL + bidx * 3072 + 2048 + u.pn * 256 + wc * 32 + fq * 4;
    f32x4 g[2][2];
#pragma unroll
    for (int bj = 0; bj < 2; ++bj)
#pragma unroll
      for (int n = 0; n < 2; ++n) g[bj][n] = *(const f32x4*)(gbase + bj * 128 + n * 16);
#pragma unroll
    for (int ai = 0; ai < 2; ++ai)
#pragma unroll
      for (int mp = 0; mp < 2; ++mp) {
        f32x4 x[2][2][2];
        size_t roff[2];
#pragma unroll
        for (int mm = 0; mm < 2; ++mm) {
          roff[mm] = (size_t)(u.pm * 256 + ai * 128 + wr * 64 + (mp * 2 + mm) * 16 + fr) * 1024 + u.pn * 256 + wc * 32 + fq * 4;
#pragma unroll
          for (int bj = 0; bj < 2; ++bj)
#pragma unroll
            for (int n = 0; n < 2; ++n) x[mm][bj][n] = *(const f32x4*)(ep.xl_src + roff[mm] + bj * 128 + n * 16);
        }
#pragma unroll
        for (int mm = 0; mm < 2; ++mm)
#pragma unroll
          for (int bj = 0; bj < 2; ++bj)
#pragma unroll
            for (int n = 0; n < 2; ++n) *(f32x4*)(ep.xl_dst + roff[mm] + bj * 128 + n * 16) = x[mm][bj][n] + g[bj][n] * acc[ai][bj][mp * 2 + mm][n];
      }
  }
};
__device__ __forceinline__ void pg8_gemm_res(char* lds, const bf16_t* A, const bf16_t* Bt, int M, int N, int K, const EpRes ep) {
  __syncthreads();
  pg8::Gemm g{A, Bt, M, N, K};
  pg8::StaticOrder S; S.init(M, N, (int)gridDim.x, (int)blockIdx.x);
  Pg8EpiRes E{ep};
  pg8::gemm_phase<Pg8EpiRes, pg8::StaticOrder, false>((PG8_LAS unsigned char*)lds, g, S, E, nullptr);
  __syncthreads();
}
template <class EP>
__device__ __forceinline__ void pg8_gemm(char* lds, const bf16_t* A, const bf16_t* Bt, int M, int N, int K, const EP ep) {
  __syncthreads();
  pg8::Gemm g{A, Bt, M, N, K};
  pg8::StaticOrder S; S.init(M, N, (int)gridDim.x, (int)blockIdx.x);
  Pg8Epi<EP> E{ep};
  pg8::gemm_phase<Pg8Epi<EP>, pg8::StaticOrder, false>((PG8_LAS unsigned char*)lds, g, S, E, nullptr);
  __syncthreads();
}


__device__ __forceinline__ void gemm64_res_phase(char* lds, const bf16_t* __restrict__ A, int lda, const bf16_t* __restrict__ Bt, int K,
                                                 int row_base, int mtiles, const EpRes ep) {
  bf16_t* sA = (bf16_t*)lds;
  bf16_t* sB = (bf16_t*)(lds + 18432);
  const int tid = opaque_tid(), lane = tid & 63, wv = tid >> 6, wm = wv >> 2, wn = wv & 3;
  const int l31 = lane & 31, lh = lane >> 5;
  const int nk = K >> 6;
  const int ldrow = tid >> 3, ldk = (tid & 7) * 8;
  const int total = mtiles * 8;
  for (int tile = blockIdx.x; tile < total; tile += gridDim.x) {
    const int mt = tile >> 3, nt = tile & 7;
    const int m0 = row_base + mt * 64, n0 = nt * 128;
    __syncthreads();
    f32x16 acc;
#pragma unroll
    for (int r = 0; r < 16; ++r) acc[r] = 0.f;
    u32x4 ar = *(const u32x4*)(A + (size_t)(m0 + ldrow) * lda + ldk);
    u32x4 br0 = *(const u32x4*)(Bt + (size_t)(n0 + ldrow) * K + ldk), br1 = *(const u32x4*)(Bt + (size_t)(n0 + ldrow + 64) * K + ldk);
    *(u32x4*)(sA + ldrow * 72 + ldk) = ar;
    *(u32x4*)(sB + ldrow * 72 + ldk) = br0;
    *(u32x4*)(sB + (ldrow + 64) * 72 + ldk) = br1;
    __syncthreads();
    for (int kt = 0; kt < nk; ++kt) {
      const int cur = kt & 1;
      const bool more = (kt + 1) < nk;
      const int k0n = (kt + 1) * 64 + ldk;
      if (more) {
        ar = *(const u32x4*)(A + (size_t)(m0 + ldrow) * lda + k0n);
        br0 = *(const u32x4*)(Bt + (size_t)(n0 + ldrow) * K + k0n); br1 = *(const u32x4*)(Bt + (size_t)(n0 + ldrow + 64) * K + k0n);
      }
      __builtin_amdgcn_sched_barrier(0);
      const bf16_t* a_ = sA + cur * (64 * 72);
      const bf16_t* b_ = sB + cur * (128 * 72);
#pragma unroll
      for (int kk = 0; kk < 4; ++kk) {
        const u32x4 af = *(const u32x4*)(a_ + (wm * 32 + l31) * 72 + kk * 16 + lh * 8);
        const u32x4 bfr = *(const u32x4*)(b_ + (wn * 32 + l31) * 72 + kk * 16 + lh * 8);
        acc = mfma32(bfr, af, acc);
      }
      __builtin_amdgcn_sched_barrier(0);
      if (more) {
        bf16_t* an = sA + (cur ^ 1) * (64 * 72);
        bf16_t* bn = sB + (cur ^ 1) * (128 * 72);
        *(u32x4*)(an + ldrow * 72 + ldk) = ar;
        *(u32x4*)(bn + ldrow * 72 + ldk) = br0;
        *(u32x4*)(bn + (ldrow + 64) * 72 + ldk) = br1;
      }
      __syncthreads();
    }
    const int row = m0 + wm * 32 + l31;
    const size_t roff = (size_t)(row - ML) * 1024 + n0 + wn * 32 + 4 * lh;
    const float* gp = ep.modL + 8 * 3072 + 2048 + n0 + wn * 32 + 4 * lh;
    f32x4 x[4];
#pragma unroll
    for (int q = 0; q < 4; ++q) x[q] = *(const f32x4*)(ep.xc_src + roff + 8 * q);
#pragma unroll
    for (int q = 0; q < 4; ++q) {
      const f32x4 g = *(const f32x4*)(gp + 8 * q);
      const f32x4 v = {acc[4 * q], acc[4 * q + 1], acc[4 * q + 2], acc[4 * q + 3]};
      *(f32x4*)(ep.xc_dst + roff + 8 * q) = x[q] + g * v;
    }
  }
}

template <int ph>
__device__ __forceinline__ void run_phase(const Params& p, char* lds, bool last_rep) {
  char* ws = p.ws;
  const float* MOD = (const float*)(ws + OFF_MOD);
  float* XC = (float*)(ws + OFF_XC);
  bf16_t* HB = (bf16_t*)(ws + OFF_HB);
  bf16_t* A0 = (bf16_t*)(ws + OFF_A0); bf16_t* A1 = (bf16_t*)(ws + OFF_A1); bf16_t* A2 = (bf16_t*)(ws + OFF_A2);
  bf16_t* A3 = (bf16_t*)(ws + OFF_A3); bf16_t* A4 = (bf16_t*)(ws + OFF_A4);
  bf16_t* WD = (bf16_t*)(ws + OFF_WD); bf16_t* AD = (bf16_t*)(ws + OFF_AD);
  float* BON = (float*)(ws + OFF_BON);
  if (ph == 0) { phase0(p, lds); return; }
  constexpr int layer = (ph - 1) / 5, sub = (ph - 1) % 5;
  const float* modL = MOD + (size_t)layer * 9 * 3072;
  const float* xl_cur = layer == 0 ? p.in[0] : p.out;
  const float* xc_cur = layer == 0 ? p.in[2] : XC;
  if (layer == 0 || layer == 3) {
    const int ib = layer ? 33 : 4;
    const bf16_t* WIN = (const bf16_t*)(ws + (layer ? OFF_W3IN : OFF_W0IN));
    const bf16_t* WUP = (const bf16_t*)(ws + (layer ? OFF_W3UP : OFF_W0UP));
    const bf16_t* WOUT = (const bf16_t*)(ws + (layer ? OFF_W3OUT : OFF_W0OUT));
    if (sub == 0) norm_phase<true>(xl_cur, xc_cur, p.in[ib], modL, HB, A4);
    else if (sub == 1) { ALMix al{HB, A4, p.in[ib + 4]}; EpRwkvIn ep{A0, A1, A2, A3, WD, AD}; gemm256_phase(lds, WIN, 1024, MT / 256, 16, al, ep); gemm_phase(lds, WIN, 1024, MT / 256, 2, al, ep, 4096, true); }
    else if (sub == 2) rwkv_scan_phase(lds, A0, A1, A2, WD, AD, WUP, p.in[ib + 5], p.in[ib + 8], p.in[ib + 9], HB, A4, BON);
    else if (sub == 3) rwkv_post_phase(HB, A4, A2, A3, BON, p.in[ib + 10], layer == 3 ? ML : MT);
    else { ALPlain al{A3, 1024}; EpRes ep{xl_cur, xc_cur, p.out, XC, modL}; pg8_gemm_res(lds, A3, WOUT, ML, 1024, 1024, ep); if (layer != 3) gemm64_res_phase(lds, A3, 1024, WOUT, 1024, ML, MC / 64, ep); }
  } else if (layer == 1) {
    bf16_t* HS0 = (bf16_t*)(ws + OFF_HS0); bf16_t* XR = (bf16_t*)(ws + OFF_XR); bf16_t* GG = (bf16_t*)(ws + OFF_GG); bf16_t* HS1 = (bf16_t*)(ws + OFF_HS1);
    if (sub == 0) norm_phase<false>(xl_cur, xc_cur, p.in[16], modL, HB, nullptr);
    else if (sub == 1) { ALPlain al{HB, 1024}; EpLruIn ep{XR, GG}; pg8_gemm(lds, HB, (const bf16_t*)(ws + OFF_W1IN), MT, 2816, 1024, ep); }
    else if (sub == 2) rglru_phase(lds, XR, (const bf16_t*)(ws + OFF_W1G), p.in[20], p.in[21], p.in[23], p.in[24], HS0, HS1);
    else if (sub == 3) lru_z_phase(HS0, HS1, GG);
    else { ALPlain al{GG, LW}; EpRes ep{xl_cur, xc_cur, p.out, XC, modL}; pg8_gemm_res(lds, GG, (const bf16_t*)(ws + OFF_W1OUT), ML, 1024, LW, ep); gemm64_res_phase(lds, GG, LW, (const bf16_t*)(ws + OFF_W1OUT), LW, ML, MC / 64, ep); }
  } else {
    if (sub == 0) norm_phase<false>(xl_cur, xc_cur, p.in[26], modL, HB, nullptr);
    else if (sub == 1) { ALPlain al{HB, 1024}; EpNatIn ep{A0, A1, A2, A3}; pg8_gemm(lds, HB, (const bf16_t*)(ws + OFF_W2IN), MT, 4096, 1024, ep); }
    else if (sub == 2) nat_qk_phase(A0, A1, A4, p.in[30]);
    else if (sub == 3) natten_phase(lds, A0, A4, A1, A2, A3, p.in[31], last_rep ? A3 : HB);
    else { ALPlain al{A3, 1024}; EpRes ep{xl_cur, xc_cur, p.out, XC, modL}; pg8_gemm_res(lds, A3, (const bf16_t*)(ws + OFF_W2OUT), ML, 1024, 1024, ep); gemm64_res_phase(lds, A3, 1024, (const bf16_t*)(ws + OFF_W2OUT), 1024, ML, MC / 64, ep); }
  }
}

__global__ void __launch_bounds__(NTHR) mega_kernel(Params p) {
  __shared__ __attribute__((aligned(16))) char lds[LDS_BYTES];
  __shared__ u32x4 xb_words;
  cg::grid_group grid = cg::this_grid();
  if (threadIdx.x == 0) xb_words = (u32x4){0u, 0u, 0u, 0u};
  __syncthreads();
  const XcdBarrier xb = xcd_barrier_post((unsigned*)(p.ws + OFF_BAR), (volatile LAS unsigned*)&xb_words);
#define PHASE(k) if (p.ph_lo <= k && k < p.ph_hi) { for (int rep = 0; rep < REP[k]; ++rep) { run_phase<k>(p, lds, rep + 1 == REP[k]); if (rep + 1 < REP[k] || k + 1 < p.ph_hi) { if (k == 0) grid.sync(); else xcd_barrier(xb); } } }
  PHASE(0) PHASE(1) PHASE(2) PHASE(3) PHASE(4) PHASE(5) PHASE(6) PHASE(7) PHASE(8) PHASE(9) PHASE(10)
  PHASE(11) PHASE(12) PHASE(13) PHASE(14) PHASE(15) PHASE(16) PHASE(17) PHASE(18) PHASE(19) PHASE(20)
#undef PHASE
}

extern "C" void kernel_launch(void* const* d_in, const int* in_sizes, int n_in, void* d_out, int out_size, void* d_ws, size_t ws_size,
                              hipStream_t stream) {
  static int grid_blocks = 0;
  if (!grid_blocks) {
    int dev = 0, cus = 0, per_cu = 0;
    hipGetDevice(&dev);
    hipDeviceGetAttribute(&cus, hipDeviceAttributeMultiprocessorCount, dev);
    hipOccupancyMaxActiveBlocksPerMultiprocessor(&per_cu, mega_kernel, NTHR, 0);
    if (per_cu < 1) { fprintf(stderr, "occupancy query returned %d\n", per_cu); per_cu = 1; }
    if (per_cu > 1) per_cu = 1;
    grid_blocks = cus * per_cu;
    if (n_in != 45 || ws_size < WS_END) fprintf(stderr, "unexpected n_in %d / ws %zu (need %zu)\n", n_in, ws_size, (size_t)WS_END);
  }
  Params p{};
  for (int i = 0; i < 45; ++i) p.in[i] = (const float*)d_in[i];
  p.out = (float*)d_out;
  p.ws = (char*)d_ws;
  (void)hipMemsetAsync((char*)d_ws + OFF_BAR, 0, XCD_BAR_WORDS * 4, stream);
#if N_LAUNCH_MODE == 1
  p.ph_lo = 0; p.ph_hi = NPHASE;
  void* args[] = {&p};
  hipError_t e = hipLaunchCooperativeKernel((void*)mega_kernel, dim3(grid_blocks), dim3(NTHR), args, 0, stream);
  if (e != hipSuccess) fprintf(stderr, "cooperative launch failed: %s (grid %d)\n", hipGetErrorString(e), grid_blocks);
#else
  for (int ph = 0; ph < NPHASE; ++ph) {
    p.ph_lo = ph; p.ph_hi = ph + 1;
    hipLaunchKernelGGL(mega_kernel, dim3(grid_blocks), dim3(NTHR), 0, stream, p);
  }
#endif
}
```
